# Optimizing an MI355X kernel written in HIP

```python
import math
import jax, jax.numpy as jnp
from jax import lax
import numpy as np

D_MODEL = 1024
BATCH = 8
SEQ = 2048
DEPTH = 1

HEAD_DIM = 64
N_HEADS_MOBA = 8
N_HEADS_SB = 8
D_MOBA = N_HEADS_MOBA * HEAD_DIM
D_SB = N_HEADS_SB * HEAD_DIM
D_MIX = D_MOBA + D_SB
MOBA_BLOCK = 256
MOBA_TOPK = 3
MOBA_Q_CHUNK = 128
SB_Q_BLOCK = 128
REL_BUCKETS = 32
REL_MAX_DIST = 128
PEER_HEADS = 8
PEER_N_KEYS = 128
PEER_N_EXPERTS = PEER_N_KEYS * PEER_N_KEYS
PEER_D_KEY = 256
PEER_TOPK = 16
PEER_TOKEN_CHUNK = 128
PLE_DIM = 256
EPS = 1e-6

kernel_name = "hybrid_moba_stickbreak_peer_layer"


def rms_norm(x, g):
    xf = x.astype(jnp.float32)
    y = xf * lax.rsqrt(jnp.mean(xf * xf, axis=-1, keepdims=True) + EPS)
    return (y * g.astype(jnp.float32)).astype(x.dtype)


def rel_bucket(dist):
    n = jnp.maximum(dist, 0)
    max_exact = REL_BUCKETS // 2
    nf = jnp.maximum(n, 1).astype(jnp.float32)
    large = max_exact + (jnp.log(nf / max_exact) / math.log(REL_MAX_DIST / max_exact)
                         * (REL_BUCKETS - max_exact)).astype(jnp.int32)
    large = jnp.minimum(large, REL_BUCKETS - 1)
    return jnp.where(n < max_exact, n, large)


def moba_attention(q, k, v, rel_bias):
    B, S, H, Dh = q.shape
    L, C = MOBA_BLOCK, MOBA_Q_CHUNK
    n_blk = -(-S // L)
    K = min(MOBA_TOPK, n_blk)
    pad = n_blk * L - S
    kp = jnp.pad(k, ((0, 0), (0, pad), (0, 0), (0, 0)))
    vp = jnp.pad(v, ((0, 0), (0, pad), (0, 0), (0, 0)))
    k_bh = kp.reshape(B, n_blk, L, H, Dh).transpose(0, 3, 1, 2, 4)
    v_bh = vp.reshape(B, n_blk, L, H, Dh).transpose(0, 3, 1, 2, 4)
    k_mean = jnp.mean(k_bh.astype(jnp.float32), axis=3)
    n_chunks = S // C
    q_r = q.reshape(B, n_chunks, C, H, Dh)
    scale = Dh ** -0.5
    bias_t = rel_bias.T.astype(jnp.float32)
    h_idx = jnp.arange(H)

    def one_chunk(args):
        bi, c = args
        q_c = q_r[bi, c].astype(jnp.float32)
        k_b, v_b = k_bh[bi], v_bh[bi]
        t = c * C + jnp.arange(C)
        blk = (c * C) // L
        gate = jnp.einsum('chd,hnd->hcn', q_c, k_mean[bi])
        gate = jnp.where(jnp.arange(n_blk) < blk, gate, -jnp.inf)
        _, sel = lax.top_k(gate, K)
        valid = jnp.arange(K) < blk
        k_sel = k_b[h_idx[:, None, None], sel].astype(jnp.float32)
        v_sel = v_b[h_idx[:, None, None], sel].astype(jnp.float32)
        pos_sel = sel[..., None] * L + jnp.arange(L)
        b_sel = bias_t[h_idx[:, None, None, None], rel_bucket(t[None, :, None, None] - pos_sel)]
        lg_sel = jnp.einsum('chd,hckld->hckl', q_c, k_sel) * scale + b_sel
        lg_sel = jnp.where(valid[None, None, :, None], lg_sel, -jnp.inf).reshape(H, C, K * L)
        k_own = k_b[:, blk].astype(jnp.float32)
        v_own = v_b[:, blk].astype(jnp.float32)
        dist_own = t[:, None] - (blk * L + jnp.arange(L))[None, :]
        lg_own = jnp.einsum('chd,hld->hcl', q_c, k_own) * scale + bias_t[:, rel_bucket(dist_own)]
        lg_own = jnp.where(dist_own[None] >= 0, lg_own, -jnp.inf)
        probs = jax.nn.softmax(jnp.concatenate([lg_sel, lg_own], axis=-1), axis=-1)
        p_sel, p_own = probs[..., :K * L], probs[..., K * L:]
        out = (jnp.einsum('hcm,hcmd->chd', p_sel, v_sel.reshape(H, C, K * L, Dh))
               + jnp.einsum('hcl,hld->chd', p_own, v_own))
        return out.astype(v.dtype)

    b_ids = jnp.repeat(jnp.arange(B), n_chunks)
    c_ids = jnp.tile(jnp.arange(n_chunks), B)
    out = lax.map(one_chunk, (b_ids, c_ids))
    return out.reshape(B, S, H, Dh)


def stick_breaking_attention(q, k, v):
    B, S, H, Dh = q.shape
    scale = Dh ** -0.5
    outs = []
    for qb in range(S // SB_Q_BLOCK):
        q0 = qb * SB_Q_BLOCK
        kv_len = q0 + SB_Q_BLOCK
        q_b = q[:, q0:kv_len].astype(jnp.float32)
        k_b = k[:, :kv_len].astype(jnp.float32)
        v_b = v[:, :kv_len].astype(jnp.float32)
        z = jnp.einsum('bthd,bshd->bhts', q_b, k_b) * scale
        t = q0 + jnp.arange(SB_Q_BLOCK)
        strict = jnp.arange(kv_len)[None, :] < t[:, None]
        log_1m = jnp.where(strict, jax.nn.log_sigmoid(-z), 0.0)
        acc = lax.cumsum(log_1m, axis=3, reverse=True) - log_1m
        w = jnp.where(strict, jnp.exp(jax.nn.log_sigmoid(z) + acc), 0.0)
        outs.append(jnp.einsum('bhts,bshd->bthd', w, v_b).astype(q.dtype))
    return jnp.concatenate(outs, axis=1)


def peer_ffn(x, w_query, sub_keys, u_table, v_table):
    B, S, D = x.shape
    T = B * S
    xf = x.reshape(T, D)
    qk = jnp.einsum('td,dhk->thk', xf, w_query).astype(jnp.float32)
    half = PEER_D_KEY // 2
    s1 = jnp.einsum('thk,nk->thn', qk[..., :half], sub_keys[0].astype(jnp.float32))
    s2 = jnp.einsum('thk,nk->thn', qk[..., half:], sub_keys[1].astype(jnp.float32))
    v1, i1 = lax.top_k(s1, PEER_TOPK)
    v2, i2 = lax.top_k(s2, PEER_TOPK)
    cand = (v1[..., :, None] + v2[..., None, :]).reshape(T, PEER_HEADS, PEER_TOPK * PEER_TOPK)
    cand_idx = (i1[..., :, None] * PEER_N_KEYS + i2[..., None, :]).reshape(T, PEER_HEADS, -1)
    top_s, top_pos = lax.top_k(cand, PEER_TOPK)
    e_idx = jnp.take_along_axis(cand_idx, top_pos, axis=-1)
    gates = jax.nn.softmax(top_s, axis=-1)
    E = PEER_HEADS * PEER_TOPK
    n_ch = T // PEER_TOKEN_CHUNK
    xs = (xf.reshape(n_ch, PEER_TOKEN_CHUNK, D),
          e_idx.reshape(n_ch, PEER_TOKEN_CHUNK, E),
          gates.reshape(n_ch, PEER_TOKEN_CHUNK, E).astype(x.dtype))

    def one_chunk(args):
        x_c, idx_c, g_c = args
        u = u_table[idx_c]
        hid = jax.nn.gelu(jnp.einsum('cd,ced->ce', x_c, u), approximate=False)
        return jnp.einsum('ce,ced->cd', g_c * hid, v_table[idx_c])

    return lax.map(one_chunk, xs).reshape(B, S, D)


def setup_inputs(seed: int = 0) -> dict:
    key = jax.random.key(seed)
    ks = jax.random.split(key, 20)
    f = jnp.float32
    nrm = lambda k, shape, s: jax.random.normal(k, shape, f) * s
    gain = lambda k, shape: 1.0 + 0.05 * jax.random.normal(k, shape, f)
    return {
        "x": nrm(ks[0], (BATCH, SEQ, D_MODEL), 1.0),
        "p": nrm(ks[1], (DEPTH, BATCH, SEQ, PLE_DIM), 1.0),
        "rel_bias": nrm(ks[2], (REL_BUCKETS, N_HEADS_MOBA), 0.5),
        "attn_norm": gain(ks[3], (DEPTH, D_MODEL)),
        "w_in": nrm(ks[4], (DEPTH, D_MODEL, 3 * D_MIX), D_MODEL ** -0.5),
        "q_norm": gain(ks[5], (DEPTH, HEAD_DIM)),
        "k_norm": gain(ks[6], (DEPTH, HEAD_DIM)),
        "out_norm_moba": gain(ks[7], (DEPTH, D_MOBA)),
        "out_norm_sb": gain(ks[8], (DEPTH, D_SB)),
        "w_out": nrm(ks[9], (DEPTH, D_MIX, D_MODEL), D_MIX ** -0.5),
        "ffn_norm": gain(ks[10], (DEPTH, D_MODEL)),
        "peer_query": nrm(ks[11], (DEPTH, D_MODEL, PEER_HEADS, PEER_D_KEY), D_MODEL ** -0.5),
        "peer_sub_keys": nrm(ks[12], (DEPTH, 2, PEER_N_KEYS, PEER_D_KEY // 2), (PEER_D_KEY // 2) ** -0.5),
        "peer_u": nrm(ks[13], (DEPTH, PEER_N_EXPERTS, D_MODEL), D_MODEL ** -0.5),
        "peer_v": nrm(ks[14], (DEPTH, PEER_N_EXPERTS, D_MODEL), PEER_HEADS ** -0.5),
        "ple_norm": gain(ks[15], (DEPTH, D_MODEL)),
        "w_ple_gate": nrm(ks[16], (DEPTH, D_MODEL, D_MODEL), D_MODEL ** -0.5),
        "w_ple": nrm(ks[17], (DEPTH, PLE_DIM, D_MODEL), PLE_DIM ** -0.5),
    }


def reference(x, p, rel_bias, attn_norm, w_in, q_norm, k_norm, out_norm_moba, out_norm_sb,
              w_out, ffn_norm, peer_query, peer_sub_keys, peer_u, peer_v, ple_norm,
              w_ple_gate, w_ple):
    B, S, _ = x.shape
    h = x
    for i in range(DEPTH):
        xn = rms_norm(h, attn_norm[i])
        proj = xn @ w_in[i]
        qm, km, vm, qs, ks_, vs = jnp.split(proj, 6, axis=-1)
        heads = lambda t, nh: t.reshape(B, S, nh, HEAD_DIM)
        qm = rms_norm(heads(qm, N_HEADS_MOBA), q_norm[i])
        km = rms_norm(heads(km, N_HEADS_MOBA), k_norm[i])
        o_m = moba_attention(qm, km, heads(vm, N_HEADS_MOBA), rel_bias)
        o_s = stick_breaking_attention(heads(qs, N_HEADS_SB), heads(ks_, N_HEADS_SB),
                                       heads(vs, N_HEADS_SB))
        o_m = rms_norm(o_m.reshape(B, S, D_MOBA), out_norm_moba[i])
        o_s = rms_norm(o_s.reshape(B, S, D_SB), out_norm_sb[i])
        h = h + jnp.concatenate([o_m, o_s], axis=-1) @ w_out[i]
        h = h + peer_ffn(rms_norm(h, ffn_norm[i]), peer_query[i], peer_sub_keys[i],
                         peer_u[i], peer_v[i])
        gate = jax.nn.sigmoid(rms_norm(h, ple_norm[i]) @ w_ple_gate[i])
        h = h + gate * (p[i] @ w_ple[i])
    return h
```

```cpp
#include <hip/hip_runtime.h>
#include <stdint.h>
#include <stdio.h>

#ifndef N_LAUNCHES
#define N_LAUNCHES 9
#endif

#define DI __device__ __forceinline__
#define LAS __attribute__((address_space(3)))

typedef unsigned short bf16_t;
typedef short bf16x8 __attribute__((ext_vector_type(8)));
typedef float f32x16 __attribute__((ext_vector_type(16)));
typedef float f32x4 __attribute__((ext_vector_type(4)));
typedef float f32x2 __attribute__((ext_vector_type(2)));
typedef unsigned u32x4 __attribute__((ext_vector_type(4)));
typedef unsigned u32x2 __attribute__((ext_vector_type(2)));
typedef __bf16 bf16x2_t __attribute__((ext_vector_type(2)));

constexpr int BATCH = 8, SEQ = 2048, DM = 1024, T = BATCH * SEQ;
constexpr int NPROJ = 3072;
constexpr float EPS = 1e-6f;
constexpr float LOG2E = 1.4426950408889634f;
constexpr float SCL2 = 0.125f * LOG2E;
constexpr int NPHASE = 9;

constexpr size_t MiB = 1u << 20;
constexpr size_t WS_CTL = 0, CTL_ZERO_BYTES = 65536;
constexpr size_t WS_KMEAN = 256 * 1024;
constexpr size_t WS_BIAS = 512 * 1024;
constexpr size_t WS_WIN = 1 * MiB, WS_WOUT = 7 * MiB, WS_WQ = 9 * MiB, WS_WG = 13 * MiB, WS_WPLE = 15 * MiB;
constexpr size_t WS_U = 16 * MiB, WS_V = 48 * MiB;
constexpr size_t WS_XN = 80 * MiB;
constexpr size_t WS_PB = 112 * MiB;
constexpr size_t WS_QM = 120 * MiB, WS_KM = 136 * MiB, WS_VTM = 152 * MiB, WS_QS = 168 * MiB, WS_KS = 184 * MiB, WS_VTS = 200 * MiB;
constexpr size_t WS_ORAW = 216 * MiB;
constexpr size_t WS_A2 = 120 * MiB;
constexpr size_t WS_SC = 120 * MiB;
constexpr size_t WS_END = 248 * MiB;

constexpr int CW_BAR = 4096;

constexpr int LDS_BYTES = 147456;

#define XB_TMO      128
#define XB_XCNT(j)  (256  + 64 * (j))
#define XB_XSUB(j)  (1280 + 64 * (j))
#define XB_XGEN(j)  (2304 + 64 * (j))
#define XB_TOP      3328
#define XB_TOPGEN   3392
#define XCD_BAR_WORDS 3456
#define XB_SPIN_CAP (1u << 18)

__device__ __forceinline__ unsigned xb_ld(unsigned* p)              { return __hip_atomic_load(p, __ATOMIC_RELAXED, __HIP_MEMORY_SCOPE_AGENT); }
__device__ __forceinline__ unsigned xb_add(unsigned* p, unsigned v) { return __hip_atomic_fetch_add(p, v, __ATOMIC_RELAXED, __HIP_MEMORY_SCOPE_AGENT); }
__device__ __forceinline__ unsigned xb_xcc_id() { return (unsigned)__builtin_amdgcn_s_getreg((3 << 11) | 20) & 0xFu; }
#define XB_SPIN(cond, bar) do { unsigned _sp = 0; while (cond) { __builtin_amdgcn_s_sleep(1); \
    if ((++_sp & 255u) == 0u) { if (xb_ld(&(bar)[XB_TMO])) break; if (_sp > XB_SPIN_CAP) { atomicAdd(&(bar)[XB_TMO], 1u); break; } } } } while (0)

struct XcdBarrier { unsigned* bar; unsigned x; volatile LAS unsigned* st; };

__device__ __forceinline__ XcdBarrier xcd_barrier_post(unsigned* bar, volatile LAS unsigned* st) {
    XcdBarrier b; b.bar = bar; b.x = xb_xcc_id(); b.st = st;
    if (threadIdx.x == 0) (void)xb_add(&bar[XB_XCNT(b.x)], 1u);
    return b;
}
__device__ __forceinline__ void xcd_barrier_complete(unsigned* bar, unsigned x, unsigned& nloc, unsigned& nx) {
    const unsigned G = gridDim.x * gridDim.y * gridDim.z;
    unsigned sum, cnt, mine, sp = 0u;
    for (;;) {
        sum = 0u; cnt = 0u; mine = 0u;
#pragma unroll
        for (unsigned j = 0; j < 16; ++j) { const unsigned c = xb_ld(&bar[XB_XCNT(j)]); sum += c; cnt += (c > 0u) ? 1u : 0u; mine = (j == x) ? c : mine; }
        if (sum == G) break;
        __builtin_amdgcn_s_sleep(1);
        if ((++sp & 255u) == 0u) { if (xb_ld(&bar[XB_TMO])) break; if (sp > XB_SPIN_CAP) { atomicAdd(&bar[XB_TMO], 1u); break; } }
    }
    nloc = mine > 0u ? mine : 1u; nx = cnt > 0u ? cnt : 1u;
}
__device__ __forceinline__ void xcd_barrier(const XcdBarrier& b) {
    asm volatile("s_waitcnt vmcnt(0)" ::: "memory");
    __syncthreads();
    if (threadIdx.x == 0) {
        unsigned* bar = b.bar;
        __builtin_amdgcn_s_waitcnt(0);
        unsigned nloc = b.st[0], nx = b.st[1];
        if (nloc == 0u) { xcd_barrier_complete(bar, b.x, nloc, nx); b.st[0] = nloc; b.st[1] = nx; }
        const unsigned old = xb_add(&bar[XB_XSUB(b.x)], 1u);
        const unsigned gen = old / nloc;
        if (old + 1u == (gen + 1u) * nloc) {
            __builtin_amdgcn_fence(__ATOMIC_RELEASE, "agent");
            asm volatile("s_waitcnt vmcnt(0)" ::: "memory");
            const unsigned og = xb_add(&bar[XB_TOP], 1u);
            const unsigned tg = og / nx;
            if (og + 1u == (tg + 1u) * nx) xb_add(&bar[XB_TOPGEN], 1u);
            else XB_SPIN(xb_ld(&bar[XB_TOPGEN]) == tg, bar);
            __builtin_amdgcn_fence(__ATOMIC_ACQUIRE, "agent");
            xb_add(&bar[XB_XGEN(b.x)], 1u);
            asm volatile("s_waitcnt vmcnt(0)" ::: "memory");
        } else {
            XB_SPIN(xb_ld(&bar[XB_XGEN(b.x)]) == gen, bar);
            __builtin_amdgcn_fence(__ATOMIC_ACQUIRE, "agent");
            asm volatile("s_waitcnt vmcnt(0)" ::: "memory");
        }
    }
    __syncthreads();
}

DI float bf2f(short v) { return __builtin_bit_cast(float, ((unsigned)(unsigned short)v) << 16); }
DI unsigned cvtpk(float lo, float hi) { f32x2 v = {lo, hi}; bf16x2_t b = __builtin_convertvector(v, bf16x2_t); return __builtin_bit_cast(unsigned, b); }
DI bf16_t f2bf(float f) { return (bf16_t)(cvtpk(f, 0.f) & 0xffffu); }
DI float wave_sum(float v) {
#pragma unroll
    for (int o = 1; o < 64; o <<= 1) v += __shfl_xor(v, o);
    return v;
}
DI int crow(int r, int hi) { return (r & 3) + 8 * (r >> 2) + 4 * hi; }
#define MFMA32(a, b, c) __builtin_amdgcn_mfma_f32_32x32x16_bf16((a), (b), (c), 0, 0, 0)
DI f32x16 zero16() { f32x16 z; for (int i = 0; i < 16; ++i) z[i] = 0.f; return z; }

struct Params {
    const float* in[18];
    float* out;
    unsigned char* ws;
    int ph_lo, ph_hi;
};

enum { IN_X = 0, IN_P, IN_RELB, IN_ATTN_NORM, IN_WIN, IN_QNORM, IN_KNORM, IN_ONM, IN_ONS, IN_WOUT, IN_FFN_NORM, IN_PQ, IN_SUBK, IN_PU, IN_PV, IN_PLE_NORM, IN_WPG, IN_WPLE };

DI void p0_transpose(const float* W, int K, int N, bf16_t* Wt, LAS float* scr, int tid, int wg, int nwg) {
    const int tn = N / 64, ntile = (K / 64) * tn;
    for (int tile = wg; tile < ntile; tile += nwg) {
        const int k0 = (tile / tn) * 64, n0 = (tile % tn) * 64;
#pragma unroll
        for (int i = 0; i < 8; ++i) { const int kk = (tid >> 6) + 8 * i, nn = tid & 63; scr[kk * 65 + nn] = W[(size_t)(k0 + kk) * N + n0 + nn]; }
        __syncthreads();
#pragma unroll
        for (int i = 0; i < 8; ++i) { const int nn = (tid >> 6) + 8 * i, kk = tid & 63; Wt[(size_t)(n0 + nn) * K + k0 + kk] = f2bf(scr[kk * 65 + nn]); }
        __syncthreads();
    }
}

DI void p0_fold(const float* wq, const float* sub, const float* gffn, bf16_t* WqT, LAS float* lds, int tid, int wg, int nwg) {
    LAS float* wqs = lds;
    LAS float* subs = lds + 128 * 65;
    for (int item = wg; item < 256; item += nwg) {
        const int dt = item & 15, hh = item >> 4, d0 = dt * 64, h = hh >> 1, half = hh & 1;
#pragma unroll
        for (int i = 0; i < 16; ++i) { const int k = tid & 127, dd = (tid >> 7) + 4 * i; wqs[k * 65 + dd] = wq[(size_t)(d0 + dd) * 2048 + h * 256 + half * 128 + k]; }
#pragma unroll
        for (int i = 0; i < 32; ++i) { const int idx = i * 512 + tid; subs[idx] = sub[half * 16384 + idx]; }
        __syncthreads();
        const int d = tid & 63, ng = tid >> 6;
        float acc[16];
#pragma unroll
        for (int i = 0; i < 16; ++i) acc[i] = 0.f;
        for (int k = 0; k < 128; k += 4) {
            const float a0 = wqs[(k + 0) * 65 + d], a1 = wqs[(k + 1) * 65 + d], a2 = wqs[(k + 2) * 65 + d], a3 = wqs[(k + 3) * 65 + d];
#pragma unroll
            for (int i = 0; i < 16; ++i) { const f32x4 s = *(const LAS f32x4*)(subs + (16 * ng + i) * 128 + k); acc[i] += a0 * s.x + a1 * s.y + a2 * s.z + a3 * s.w; }
        }
        const float g = gffn[d0 + d];
#pragma unroll
        for (int i = 0; i < 16; ++i) WqT[(size_t)(hh * 128 + 16 * ng + i) * 1024 + d0 + d] = f2bf(acc[i] * g);
        __syncthreads();
    }
}

DI void p0_convert(const float* src, bf16_t* dst, size_t n, size_t gtid, size_t nthreads) {
    for (size_t i = gtid * 8; i < n; i += nthreads * 8) {
        const f32x4 a = *(const f32x4*)(src + i), b = *(const f32x4*)(src + i + 4);
        u32x4 o; o.x = cvtpk(a.x, a.y); o.y = cvtpk(a.z, a.w); o.z = cvtpk(b.x, b.y); o.w = cvtpk(b.z, b.w);
        *(u32x4*)(dst + i) = o;
    }
}

DI void rmsnorm_row_bf16(const float* xrow, const float* g, bf16_t* orow, int lane) {
    f32x4 v[4]; float s = 0.f;
#pragma unroll
    for (int j = 0; j < 4; ++j) { v[j] = ((const f32x4*)xrow)[lane + 64 * j]; s += (v[j].x * v[j].x + v[j].y * v[j].y) + (v[j].z * v[j].z + v[j].w * v[j].w); }
    s = wave_sum(s);
    const float rs = rsqrtf(s * (1.f / 1024.f) + EPS);
#pragma unroll
    for (int j = 0; j < 4; ++j) { const f32x4 gv = ((const f32x4*)g)[lane + 64 * j];
        u32x2 o; o.x = cvtpk(v[j].x * rs * gv.x, v[j].y * rs * gv.y); o.y = cvtpk(v[j].z * rs * gv.z, v[j].w * rs * gv.w);
        ((u32x2*)orow)[lane + 64 * j] = o; }
}

template <class Epi>
DI void gemm_simple(const bf16_t* A, const bf16_t* Bt, int M, int N, int K, const Epi& epi, int gwave, int nwaves, int lane) {
    const int r32 = lane & 31, hi = lane >> 5;
    const int nNt = N / 64, total = (M / 32) * nNt;
    for (int tile = gwave; tile < total; tile += nwaves) {
        const int mt = tile / nNt, nt = tile - mt * nNt, m0 = mt * 32, n0 = nt * 64;
        const bf16_t* ap = A + (size_t)(m0 + r32) * K + 8 * hi;
        const bf16_t* b0p = Bt + (size_t)(n0 + r32) * K + 8 * hi;
        const bf16_t* b1p = b0p + (size_t)32 * K;
        f32x16 acc0 = zero16(), acc1 = zero16();
#pragma unroll 4
        for (int k = 0; k < K; k += 16) {
            const bf16x8 xa = *(const bf16x8*)(ap + k);
            const bf16x8 w0 = *(const bf16x8*)(b0p + k);
            const bf16x8 w1 = *(const bf16x8*)(b1p + k);
            acc0 = MFMA32(w0, xa, acc0);
            acc1 = MFMA32(w1, xa, acc1);
        }
        epi(m0 + r32, n0, hi, acc0, acc1);
    }
}

struct Epi1 {
    bf16_t* base6;
    const float *qn, *kn;
    DI void operator()(int tok, int n0, int hi, const f32x16& a0, const f32x16& a1) const {
        const int head48 = n0 >> 6, typ = head48 >> 3, h = head48 & 7;
        bf16_t* reg = base6 + (size_t)typ * (16u << 19);
        if (typ == 2 || typ == 5) {
            const int b = tok >> 11, s = tok & 2047;
            const int pos = (s & ~12) | ((s & 4) << 1) | ((s & 8) >> 1);
            bf16_t* base = reg + ((size_t)(b * 8 + h) * 64) * 2048 + pos;
#pragma unroll
            for (int r = 0; r < 16; ++r) { base[(size_t)crow(r, hi) * 2048] = f2bf(a0[r]); base[(size_t)(32 + crow(r, hi)) * 2048] = f2bf(a1[r]); }
        } else {
            float rs = 1.f;
            const bool nrm = (typ == 0 || typ == 1);
            if (nrm) { float ss = 0.f;
#pragma unroll
                for (int r = 0; r < 16; ++r) ss += a0[r] * a0[r] + a1[r] * a1[r];
                ss += __shfl_xor(ss, 32);
                rs = rsqrtf(ss * (1.f / 64.f) + EPS); }
            const float* g = (typ == 0) ? qn : kn;
            bf16_t* dst = reg + (size_t)tok * 512 + h * 64;
#pragma unroll
            for (int t = 0; t < 2; ++t)
#pragma unroll
                for (int g4 = 0; g4 < 4; ++g4) {
                    const int f0 = 32 * t + 8 * g4 + 4 * hi;
                    float v[4];
#pragma unroll
                    for (int i = 0; i < 4; ++i) { const float a = t ? a1[4 * g4 + i] : a0[4 * g4 + i]; v[i] = nrm ? a * rs * g[f0 + i] : a; }
                    u32x2 w; w.x = cvtpk(v[0], v[1]); w.y = cvtpk(v[2], v[3]);
                    *(u32x2*)(dst + f0) = w;
                }
        }
    }
};

struct Epi2 {
    const float* x; float* out; bf16_t* xn;
    DI void operator()(int tok, int n0, int hi, const f32x16& a0, const f32x16& a1) const {
#pragma unroll
        for (int t = 0; t < 2; ++t)
#pragma unroll
            for (int g4 = 0; g4 < 4; ++g4) {
                const size_t off = (size_t)tok * 1024 + n0 + 32 * t + 8 * g4 + 4 * hi;
                const f32x4 xv = *(const f32x4*)(x + off);
                f32x4 hv;
#pragma unroll
                for (int i = 0; i < 4; ++i) hv[i] = xv[i] + (t ? a1[4 * g4 + i] : a0[4 * g4 + i]);
                *(f32x4*)(out + off) = hv;
                u32x2 w; w.x = cvtpk(hv[0], hv[1]); w.y = cvtpk(hv[2], hv[3]);
                *(u32x2*)(xn + off) = w;
            }
    }
};

struct Epi3 {
    float* sc;
    DI void operator()(int tok, int n0, int hi, const f32x16& a0, const f32x16& a1) const {
#pragma unroll
        for (int t = 0; t < 2; ++t)
#pragma unroll
            for (int g4 = 0; g4 < 4; ++g4) {
                f32x4 v;
#pragma unroll
                for (int i = 0; i < 4; ++i) v[i] = t ? a1[4 * g4 + i] : a0[4 * g4 + i];
                *(f32x4*)(sc + (size_t)tok * 2048 + n0 + 32 * t + 8 * g4 + 4 * hi) = v;
            }
    }
};

DI void pv_accum(f32x16& o0, f32x16& o1, const f32x16& p, const bf16_t* vt_row) {
#pragma unroll
    for (int s = 0; s < 2; ++s) {
        u32x4 pk; pk.x = cvtpk(p[8 * s], p[8 * s + 1]); pk.y = cvtpk(p[8 * s + 2], p[8 * s + 3]); pk.z = cvtpk(p[8 * s + 4], p[8 * s + 5]); pk.w = cvtpk(p[8 * s + 6], p[8 * s + 7]);
        const bf16x8 pb = __builtin_bit_cast(bf16x8, pk);
        const bf16x8 v0 = *(const bf16x8*)(vt_row + 16 * s);
        const bf16x8 v1 = *(const bf16x8*)(vt_row + (size_t)32 * 2048 + 16 * s);
        o0 = MFMA32(v0, pb, o0);
        o1 = MFMA32(v1, pb, o1);
    }
}

DI void store_o(bf16_t* op, const f32x16& o0, const f32x16& o1, float inv, int hi) {
#pragma unroll
    for (int t = 0; t < 2; ++t)
#pragma unroll
        for (int g4 = 0; g4 < 4; ++g4) {
            u32x2 w;
            if (t == 0) { w.x = cvtpk(o0[4 * g4] * inv, o0[4 * g4 + 1] * inv); w.y = cvtpk(o0[4 * g4 + 2] * inv, o0[4 * g4 + 3] * inv); }
            else        { w.x = cvtpk(o1[4 * g4] * inv, o1[4 * g4 + 1] * inv); w.y = cvtpk(o1[4 * g4 + 2] * inv, o1[4 * g4 + 3] * inv); }
            *(u32x2*)(op + 32 * t + 8 * g4 + 4 * hi) = w;
        }
}

DI void moba_unit(int b, int h, int qt, const bf16_t* Qm, const bf16_t* Km, const bf16_t* VtM, const float* kmean, const float* biasTab, bf16_t* Oraw, int lane) {
    const int r32 = lane & 31, hi = lane >> 5;
    const int q0 = qt * 32, tq = q0 + r32, blk = q0 >> 8;
    const size_t qrow = (size_t)(b * 2048 + tq);
    const bf16_t* qp = Qm + qrow * 512 + h * 64;
    bf16x8 qf[4];
#pragma unroll
    for (int s = 0; s < 4; ++s) qf[s] = *(const bf16x8*)(qp + 16 * s + 8 * hi);
    unsigned selmask = 0;
    if (blk > 0) {
        float qv[32];
#pragma unroll
        for (int c = 0; c < 4; ++c) { const bf16x8 t = *(const bf16x8*)(qp + 32 * hi + 8 * c);
#pragma unroll
            for (int j = 0; j < 8; ++j) qv[8 * c + j] = bf2f(t[j]); }
        const float* km = kmean + (size_t)((b * 8 + h) * 8) * 64 + 32 * hi;
        float g[8];
#pragma unroll
        for (int n = 0; n < 8; ++n) {
            float a = 0.f;
            if (n < blk) {
#pragma unroll
                for (int d = 0; d < 32; ++d) a += qv[d] * km[n * 64 + d];
            }
            a += __shfl_xor(a, 32);
            g[n] = (n < blk) ? a : -INFINITY;
        }
#pragma unroll
        for (int n = 0; n < 8; ++n) {
            int rank = 0;
#pragma unroll
            for (int m = 0; m < 8; ++m) if (m != n) rank += ((g[m] > g[n]) || (g[m] == g[n] && m < n)) ? 1 : 0;
            if (n < blk && rank < 3) selmask |= 1u << n;
        }
    }
    float mrun = -1e30f, lsum = 0.f;
    f32x16 o0 = zero16(), o1 = zero16();
    const bf16_t* kbase = Km + (size_t)(b * 2048) * 512 + h * 64 + 8 * hi;
    const bf16_t* vbase = VtM + ((size_t)(b * 8 + h) * 64 + r32) * 2048 + 8 * hi;
    const float* bt = biasTab + h * 132;
    const float bfar = bt[128];
    for (int kt = qt; kt >= 0; --kt) {
        const int n = kt >> 3;
        const bool selq = (n == blk) || ((selmask >> n) & 1u);
        if (n < blk && !__any(selq ? 1 : 0)) { kt = n * 8; continue; }
        const int key0 = kt * 32;
        f32x16 st = zero16();
        const bf16_t* kp = kbase + (size_t)(key0 + r32) * 512;
#pragma unroll
        for (int s = 0; s < 4; ++s) { const bf16x8 kf = *(const bf16x8*)(kp + 16 * s); st = MFMA32(kf, qf[s], st); }
        const bool far = (q0 - (key0 + 31)) >= 128;
        float x[16]; float mx = -1e30f;
#pragma unroll
        for (int r = 0; r < 16; ++r) {
            const int dist = tq - (key0 + crow(r, hi));
            int di = dist < 0 ? 0 : (dist > 128 ? 128 : dist);
            const float bias = far ? bfar : bt[di];
            const bool ok = selq && (dist >= 0);
            const float v = st[r] * SCL2 + bias;
            x[r] = ok ? v : -1e30f;
            mx = fmaxf(mx, x[r]);
        }
        mx = fmaxf(mx, __shfl_xor(mx, 32));
        const float mnew = fmaxf(mrun, mx);
        const float alpha = __builtin_amdgcn_exp2f(mrun - mnew);
        f32x16 pr; float ps = 0.f;
#pragma unroll
        for (int r = 0; r < 16; ++r) { float e = __builtin_amdgcn_exp2f(x[r] - mnew); e = (x[r] > -1e29f) ? e : 0.f; pr[r] = e; ps += e; }
        lsum = lsum * alpha + ps; mrun = mnew;
#pragma unroll
        for (int r = 0; r < 16; ++r) { o0[r] *= alpha; o1[r] *= alpha; }
        pv_accum(o0, o1, pr, vbase + key0);
    }
    lsum += __shfl_xor(lsum, 32);
    const float inv = 1.f / lsum;
    store_o(Oraw + qrow * 1024 + h * 64, o0, o1, inv, hi);
}

DI void sb_unit(int b, int h, int qt, const bf16_t* Qs, const bf16_t* Ks, const bf16_t* VtS, bf16_t* Oraw, int lane) {
    const int r32 = lane & 31, hi = lane >> 5;
    const int q0 = qt * 32, tq = q0 + r32;
    const size_t qrow = (size_t)(b * 2048 + tq);
    const bf16_t* qp = Qs + qrow * 512 + h * 64;
    bf16x8 qf[4];
#pragma unroll
    for (int s = 0; s < 4; ++s) qf[s] = *(const bf16x8*)(qp + 16 * s + 8 * hi);
    f32x16 o0 = zero16(), o1 = zero16();
    const bf16_t* kbase = Ks + (size_t)(b * 2048) * 512 + h * 64 + 8 * hi;
    const bf16_t* vbase = VtS + ((size_t)(b * 8 + h) * 64 + r32) * 2048 + 8 * hi;
    float C = 1.f;
    for (int kt = qt; kt >= 0; --kt) {
        const int key0 = kt * 32;
        f32x16 st = zero16();
        const bf16_t* kp = kbase + (size_t)(key0 + r32) * 512;
#pragma unroll
        for (int s = 0; s < 4; ++s) { const bf16x8 kf = *(const bf16x8*)(kp + 16 * s); st = MFMA32(kf, qf[s], st); }
        float rr[16], be[16];
#pragma unroll
        for (int r = 0; r < 16; ++r) {
            const int key = key0 + crow(r, hi);
            const float y = fminf(st[r] * SCL2, 100.f);
            const float e = __builtin_amdgcn_exp2f(y);
            const float ri = __builtin_amdgcn_rcpf(1.f + e);
            const bool ok = key < tq;
            rr[r] = ok ? ri : 1.f;
            be[r] = ok ? e * ri : 0.f;
        }
        float G[4], ex[16], Gp[4], Tt[4], Suf[4];
#pragma unroll
        for (int a = 0; a < 4; ++a) {
            ex[4 * a + 3] = 1.f; ex[4 * a + 2] = rr[4 * a + 3]; ex[4 * a + 1] = ex[4 * a + 2] * rr[4 * a + 2]; ex[4 * a] = ex[4 * a + 1] * rr[4 * a + 1];
            G[a] = ex[4 * a] * rr[4 * a];
        }
#pragma unroll
        for (int a = 0; a < 4; ++a) { Gp[a] = __shfl_xor(G[a], 32); Tt[a] = G[a] * Gp[a]; }
        Suf[3] = 1.f; Suf[2] = Tt[3]; Suf[1] = Tt[3] * Tt[2]; Suf[0] = Suf[1] * Tt[1];
        f32x16 pr;
#pragma unroll
        for (int a = 0; a < 4; ++a) {
            const float after = Suf[a] * (hi == 0 ? Gp[a] : 1.f) * C;
#pragma unroll
            for (int i = 0; i < 4; ++i) pr[4 * a + i] = be[4 * a + i] * ex[4 * a + i] * after;
        }
        C = C * (Suf[0] * Tt[0]);
        pv_accum(o0, o1, pr, vbase + key0);
        if (__all(C == 0.f ? 1 : 0)) break;
    }
    store_o(Oraw + qrow * 1024 + 512 + h * 64, o0, o1, 1.f, hi);
}

DI float reduce16(const float (&p)[16], int lane) {
    const bool b3 = lane & 8, b2 = lane & 4, b1 = lane & 2, b0 = lane & 1;
    float q[8], r[4], s[2];
#pragma unroll
    for (int i = 0; i < 8; ++i) { const float mine = b3 ? p[i + 8] : p[i], send = b3 ? p[i] : p[i + 8]; q[i] = mine + __shfl_xor(send, 8); }
#pragma unroll
    for (int i = 0; i < 4; ++i) { const float mine = b2 ? q[i + 4] : q[i], send = b2 ? q[i] : q[i + 4]; r[i] = mine + __shfl_xor(send, 4); }
#pragma unroll
    for (int i = 0; i < 2; ++i) { const float mine = b1 ? r[i + 2] : r[i], send = b1 ? r[i] : r[i + 2]; s[i] = mine + __shfl_xor(send, 2); }
    const float mine = b0 ? s[1] : s[0], send = b0 ? s[0] : s[1];
    float t = mine + __shfl_xor(send, 1);
    t += __shfl_xor(t, 16);
    t += __shfl_xor(t, 32);
    return t;
}

DI void peer_token(int tok, float* out, const float* scores, const float* gffn, const float* gple, const bf16_t* Ub, const bf16_t* Vb, bf16_t* XN, LAS float* wl, int lane) {
    LAS int* eidx = (LAS int*)wl; LAS float* gts = wl + 128; LAS float* cvs = wl + 256;
    float* hrow = out + (size_t)tok * 1024;
    f32x4 hv[4];
    hv[0] = *(const f32x4*)(hrow + 8 * lane); hv[1] = *(const f32x4*)(hrow + 8 * lane + 4);
    hv[2] = *(const f32x4*)(hrow + 512 + 8 * lane); hv[3] = *(const f32x4*)(hrow + 512 + 8 * lane + 4);
    float ss = 0.f;
#pragma unroll
    for (int i = 0; i < 4; ++i) ss += (hv[i].x * hv[i].x + hv[i].y * hv[i].y) + (hv[i].z * hv[i].z + hv[i].w * hv[i].w);
    ss = wave_sum(ss);
    const float rs2 = rsqrtf(ss * (1.f / 1024.f) + EPS);
    float xn[16];
    {
        const f32x4 g0 = *(const f32x4*)(gffn + 8 * lane), g1 = *(const f32x4*)(gffn + 8 * lane + 4), g2 = *(const f32x4*)(gffn + 512 + 8 * lane), g3 = *(const f32x4*)(gffn + 512 + 8 * lane + 4);
#pragma unroll
        for (int j = 0; j < 4; ++j) { xn[j] = hv[0][j] * rs2 * g0[j]; xn[4 + j] = hv[1][j] * rs2 * g1[j]; xn[8 + j] = hv[2][j] * rs2 * g2[j]; xn[12 + j] = hv[3][j] * rs2 * g3[j]; }
    }
    const float* sc = scores + (size_t)tok * 2048;
    const int l32 = lane & 31, hf = lane >> 5;
    for (int hd = 0; hd < 8; ++hd) {
        const float* sp = sc + hd * 256 + hf * 128 + l32;
        float v0 = sp[0], v1 = sp[32], v2 = sp[64], v3 = sp[96];
        float topv = 0.f; int topi = 0;
        for (int it = 0; it < 16; ++it) {
            const float mloc = fmaxf(fmaxf(v0, v1), fmaxf(v2, v3));
            float wm = mloc;
#pragma unroll
            for (int o = 1; o < 32; o <<= 1) wm = fmaxf(wm, __shfl_xor(wm, o));
            const unsigned long long bal = __ballot(mloc == wm);
            const unsigned hb = hf ? (unsigned)(bal >> 32) : (unsigned)bal;
            const int ln = __ffs((int)hb) - 1;
            const int j = (v0 == wm) ? 0 : (v1 == wm) ? 1 : (v2 == wm) ? 2 : 3;
            const int idx = j * 32 + l32;
            const int idxb = __shfl(idx, (hf << 5) + (ln & 31));
            if (l32 == ln) { if (j == 0) v0 = -INFINITY; else if (j == 1) v1 = -INFINITY; else if (j == 2) v2 = -INFINITY; else v3 = -INFINITY; }
            if (l32 == it) { topv = wm; topi = idxb; }
        }
        const int c = lane;
        int ca, cb;
        if (c < 16) { ca = 0; cb = c; } else if (c < 24) { ca = 1; cb = c - 16; } else if (c < 29) { ca = 2; cb = c - 24; } else if (c < 33) { ca = 3; cb = c - 29; }
        else if (c < 36) { ca = 4; cb = c - 33; } else if (c < 42) { ca = 5 + ((c - 36) >> 1); cb = (c - 36) & 1; } else { ca = c - 34; cb = 0; }
        const bool cvalid = c < 50;
        ca &= 15; cb &= 15;
        float cv = __shfl(topv, ca) + __shfl(topv, 32 + cb);
        const int ce = __shfl(topi, ca) * 128 + __shfl(topi, 32 + cb);
        if (!cvalid) cv = -INFINITY;
        int rank = 0;
#pragma unroll
        for (int c2 = 0; c2 < 50; ++c2) { const float o = __builtin_bit_cast(float, __builtin_amdgcn_readlane(__builtin_bit_cast(int, cv), c2)); rank += ((o > cv) || (o == cv && c2 < c)) ? 1 : 0; }
        const float ts = cv * rs2;
        const unsigned long long b0m = __ballot(rank == 0);
        const int l0 = __ffsll((long long)b0m) - 1;
        const float mxv = __shfl(ts, l0 & 63);
        const float e = (rank < 16) ? __expf(ts - mxv) : 0.f;
        const float den = wave_sum(e);
        const float gate = e / den;
        if (rank < 16) { eidx[hd * 16 + rank] = ce; gts[hd * 16 + rank] = gate; }
    }
    asm volatile("s_waitcnt lgkmcnt(0)" ::: "memory");
    for (int g = 0; g < 8; ++g) {
        float part[16];
#pragma unroll
        for (int jj = 0; jj < 16; ++jj) {
            const int e = eidx[g * 16 + jj];
            const bf16_t* rp = Ub + (size_t)e * 1024 + 8 * lane;
            const bf16x8 a = *(const bf16x8*)rp, c = *(const bf16x8*)(rp + 512);
            float s = 0.f;
#pragma unroll
            for (int j = 0; j < 8; ++j) s += bf2f(a[j]) * xn[j];
#pragma unroll
            for (int j = 0; j < 8; ++j) s += bf2f(c[j]) * xn[8 + j];
            part[jj] = s;
        }
        const float hraw = reduce16(part, lane);
        const float hid = 0.5f * hraw * (1.f + erff(hraw * 0.70710678118654752f));
        const float cval = hid * gts[g * 16 + (lane & 15)];
        if (lane < 16) cvs[g * 16 + lane] = cval;
    }
    asm volatile("s_waitcnt lgkmcnt(0)" ::: "memory");
    float acc[16];
#pragma unroll
    for (int i = 0; i < 16; ++i) acc[i] = 0.f;
#pragma unroll 8
    for (int j = 0; j < 128; ++j) {
        const int e = eidx[j]; const float cj = cvs[j];
        const bf16_t* rp = Vb + (size_t)e * 1024 + 8 * lane;
        const bf16x8 a = *(const bf16x8*)rp, c = *(const bf16x8*)(rp + 512);
#pragma unroll
        for (int i = 0; i < 8; ++i) { acc[i] += cj * bf2f(a[i]); acc[8 + i] += cj * bf2f(c[i]); }
    }
    float h2[16]; float s2 = 0.f;
#pragma unroll
    for (int i = 0; i < 4; ++i)
#pragma unroll
        for (int j = 0; j < 4; ++j) { h2[4 * i + j] = hv[i][j] + acc[4 * i + j]; s2 += h2[4 * i + j] * h2[4 * i + j]; }
    s2 = wave_sum(s2);
    const float rs3 = rsqrtf(s2 * (1.f / 1024.f) + EPS);
    *(f32x4*)(hrow + 8 * lane) = (f32x4){h2[0], h2[1], h2[2], h2[3]};
    *(f32x4*)(hrow + 8 * lane + 4) = (f32x4){h2[4], h2[5], h2[6], h2[7]};
    *(f32x4*)(hrow + 512 + 8 * lane) = (f32x4){h2[8], h2[9], h2[10], h2[11]};
    *(f32x4*)(hrow + 512 + 8 * lane + 4) = (f32x4){h2[12], h2[13], h2[14], h2[15]};
    {
        const f32x4 g0 = *(const f32x4*)(gple + 8 * lane), g1 = *(const f32x4*)(gple + 8 * lane + 4), g2 = *(const f32x4*)(gple + 512 + 8 * lane), g3 = *(const f32x4*)(gple + 512 + 8 * lane + 4);
        u32x4 w0, w1;
        w0.x = cvtpk(h2[0] * rs3 * g0[0], h2[1] * rs3 * g0[1]); w0.y = cvtpk(h2[2] * rs3 * g0[2], h2[3] * rs3 * g0[3]);
        w0.z = cvtpk(h2[4] * rs3 * g1[0], h2[5] * rs3 * g1[1]); w0.w = cvtpk(h2[6] * rs3 * g1[2], h2[7] * rs3 * g1[3]);
        w1.x = cvtpk(h2[8] * rs3 * g2[0], h2[9] * rs3 * g2[1]); w1.y = cvtpk(h2[10] * rs3 * g2[2], h2[11] * rs3 * g2[3]);
        w1.z = cvtpk(h2[12] * rs3 * g3[0], h2[13] * rs3 * g3[1]); w1.w = cvtpk(h2[14] * rs3 * g3[2], h2[15] * rs3 * g3[3]);
        *(u32x4*)(XN + (size_t)tok * 1024 + 8 * lane) = w0;
        *(u32x4*)(XN + (size_t)tok * 1024 + 512 + 8 * lane) = w1;
    }
}

__global__ void __launch_bounds__(512, 2) fwd_kernel(Params P) {
    extern __shared__ __attribute__((aligned(16))) unsigned char lds_raw[];
    LAS unsigned char* lds = (LAS unsigned char*)lds_raw;
    const int tid = threadIdx.x, lane = tid & 63, wid = __builtin_amdgcn_readfirstlane(tid >> 6);
    const int wg = blockIdx.x, nwg = gridDim.x;
    const int gwave = wg * 8 + wid, nwaves = nwg * 8;
    const int lo = P.ph_lo, hi = P.ph_hi;
    unsigned char* ws = P.ws;

    volatile LAS unsigned* misc = (volatile LAS unsigned*)(lds + LDS_BYTES - 64);
    if (tid < 16) misc[tid] = 0u;
    __syncthreads();
    XcdBarrier bar; bar.bar = (unsigned*)(ws + WS_CTL) + CW_BAR; bar.x = 0; bar.st = misc;
    if (hi - lo > 1) bar = xcd_barrier_post((unsigned*)(ws + WS_CTL) + CW_BAR, misc);

    float* kmean = (float*)(ws + WS_KMEAN);
    float* biasTab = (float*)(ws + WS_BIAS);
    bf16_t* WinT = (bf16_t*)(ws + WS_WIN); bf16_t* WoutT = (bf16_t*)(ws + WS_WOUT); bf16_t* WqT = (bf16_t*)(ws + WS_WQ);
    bf16_t* WgT = (bf16_t*)(ws + WS_WG); bf16_t* WpleT = (bf16_t*)(ws + WS_WPLE);
    bf16_t* Ub = (bf16_t*)(ws + WS_U); bf16_t* Vb = (bf16_t*)(ws + WS_V);
    bf16_t* XN = (bf16_t*)(ws + WS_XN); bf16_t* PB = (bf16_t*)(ws + WS_PB);
    bf16_t* Qm = (bf16_t*)(ws + WS_QM); bf16_t* Km = (bf16_t*)(ws + WS_KM); bf16_t* VtM = (bf16_t*)(ws + WS_VTM);
    bf16_t* Qs = (bf16_t*)(ws + WS_QS); bf16_t* Ks = (bf16_t*)(ws + WS_KS); bf16_t* VtS = (bf16_t*)(ws + WS_VTS);
    bf16_t* Oraw = (bf16_t*)(ws + WS_ORAW); bf16_t* A2 = (bf16_t*)(ws + WS_A2);
    float* SC = (float*)(ws + WS_SC);

#define IN(k) (lo <= (k) && (k) < hi)
#define SEAM(k) do { if (IN(k) && IN((k) + 1)) xcd_barrier(bar); } while (0)

    if (IN(0)) {
        LAS float* scr = (LAS float*)lds;
        p0_transpose(P.in[IN_WIN], 1024, 3072, WinT, scr, tid, wg, nwg);
        p0_transpose(P.in[IN_WOUT], 1024, 1024, WoutT, scr, tid, wg, nwg);
        p0_transpose(P.in[IN_WPG], 1024, 1024, WgT, scr, tid, wg, nwg);
        p0_transpose(P.in[IN_WPLE], 256, 1024, WpleT, scr, tid, wg, nwg);
        p0_fold(P.in[IN_PQ], P.in[IN_SUBK], P.in[IN_FFN_NORM], WqT, scr, tid, wg, nwg);
        const size_t gtid = (size_t)wg * 512 + tid, nthr = (size_t)nwg * 512;
        p0_convert(P.in[IN_PU], Ub, (size_t)16384 * 1024, gtid, nthr);
        p0_convert(P.in[IN_PV], Vb, (size_t)16384 * 1024, gtid, nthr);
        p0_convert(P.in[IN_P], PB, (size_t)T * 256, gtid, nthr);
        for (int row = gwave; row < T; row += nwaves) rmsnorm_row_bf16(P.in[IN_X] + (size_t)row * 1024, P.in[IN_ATTN_NORM], XN + (size_t)row * 1024, lane);
        if (wg == 0) {
            for (int idx = tid; idx < 8 * 129; idx += 512) {
                const int h = idx / 129, dist = idx % 129;
                int bk;
                if (dist < 16) bk = dist;
                else { const float v = logf((float)dist / 16.f) / 2.0794415416798357f * 16.f; bk = 16 + (int)v; bk = bk > 31 ? 31 : bk; }
                biasTab[h * 132 + dist] = P.in[IN_RELB][bk * 8 + h] * LOG2E;
            }
        }
    }
    SEAM(0);
    if (IN(1)) {
        Epi1 E{Qm, P.in[IN_QNORM], P.in[IN_KNORM]};
        gemm_simple(XN, WinT, T, NPROJ, 1024, E, gwave, nwaves, lane);
    }
    SEAM(1);
    if (IN(2)) {
        for (int item = gwave; item < 512; item += nwaves) {
            const int b = item >> 6, h = (item >> 3) & 7, blk = item & 7;
            const int c = lane & 7, rr = lane >> 3;
            float s[8];
#pragma unroll
            for (int j = 0; j < 8; ++j) s[j] = 0.f;
            const bf16_t* base = Km + (size_t)(b * 2048 + blk * 256 + rr) * 512 + h * 64 + c * 8;
#pragma unroll 8
            for (int i = 0; i < 32; ++i) { const bf16x8 v = *(const bf16x8*)(base + (size_t)i * 8 * 512);
#pragma unroll
                for (int j = 0; j < 8; ++j) s[j] += bf2f(v[j]); }
#pragma unroll
            for (int j = 0; j < 8; ++j) { s[j] += __shfl_xor(s[j], 8); s[j] += __shfl_xor(s[j], 16); s[j] += __shfl_xor(s[j], 32); }
            if (lane < 8) {
#pragma unroll
                for (int j = 0; j < 8; ++j) kmean[(size_t)item * 64 + c * 8 + j] = s[j] * (1.f / 256.f);
            }
        }
    }
    SEAM(2);
    if (IN(3)) {
        for (int u = gwave; u < 8192; u += nwaves) {
            const int grp = u >> 12, i = u & 4095;
            const int half = i >> 11, j = i & 2047;
            const int qt = half ? (j >> 6) : 63 - (j >> 6), bh = j & 63;
            const int b = bh >> 3, h = bh & 7;
            if (grp == 0) moba_unit(b, h, qt, Qm, Km, VtM, kmean, biasTab, Oraw, lane);
            else sb_unit(b, h, qt, Qs, Ks, VtS, Oraw, lane);
        }
    }
    SEAM(3);
    if (IN(4)) {
        const float* gm = P.in[IN_ONM]; const float* gs = P.in[IN_ONS];
        for (int row = gwave; row < T; row += nwaves) {
            const bf16_t* o = Oraw + (size_t)row * 1024;
            const bf16x8 a = *(const bf16x8*)(o + lane * 8), c = *(const bf16x8*)(o + 512 + lane * 8);
            float fa[8], fc[8], sa = 0.f, sc = 0.f;
#pragma unroll
            for (int j = 0; j < 8; ++j) { fa[j] = bf2f(a[j]); fc[j] = bf2f(c[j]); sa += fa[j] * fa[j]; sc += fc[j] * fc[j]; }
            sa = wave_sum(sa); sc = wave_sum(sc);
            const float ra = rsqrtf(sa * (1.f / 512.f) + EPS), rc = rsqrtf(sc * (1.f / 512.f) + EPS);
            u32x4 wa, wc;
            wa.x = cvtpk(fa[0] * ra * gm[lane * 8 + 0], fa[1] * ra * gm[lane * 8 + 1]); wa.y = cvtpk(fa[2] * ra * gm[lane * 8 + 2], fa[3] * ra * gm[lane * 8 + 3]);
            wa.z = cvtpk(fa[4] * ra * gm[lane * 8 + 4], fa[5] * ra * gm[lane * 8 + 5]); wa.w = cvtpk(fa[6] * ra * gm[lane * 8 + 6], fa[7] * ra * gm[lane * 8 + 7]);
            wc.x = cvtpk(fc[0] * rc * gs[lane * 8 + 0], fc[1] * rc * gs[lane * 8 + 1]); wc.y = cvtpk(fc[2] * rc * gs[lane * 8 + 2], fc[3] * rc * gs[lane * 8 + 3]);
            wc.z = cvtpk(fc[4] * rc * gs[lane * 8 + 4], fc[5] * rc * gs[lane * 8 + 5]); wc.w = cvtpk(fc[6] * rc * gs[lane * 8 + 6], fc[7] * rc * gs[lane * 8 + 7]);
            *(u32x4*)(A2 + (size_t)row * 1024 + lane * 8) = wa;
            *(u32x4*)(A2 + (size_t)row * 1024 + 512 + lane * 8) = wc;
        }
    }
    SEAM(4);
    if (IN(5)) {
        Epi2 E{P.in[IN_X], P.out, XN};
        gemm_simple(A2, WoutT, T, 1024, 1024, E, gwave, nwaves, lane);
    }
    SEAM(5);
    if (IN(6)) {
        Epi3 E{SC};
        gemm_simple(XN, WqT, T, 2048, 1024, E, gwave, nwaves, lane);
    }
    SEAM(6);
    if (IN(7)) {
        LAS float* wl = (LAS float*)(lds + wid * 2048);
        for (int tok = gwave; tok < T; tok += nwaves)
            peer_token(tok, P.out, SC, P.in[IN_FFN_NORM], P.in[IN_PLE_NORM], Ub, Vb, XN, wl, lane);
    }
    SEAM(7);
    if (IN(8)) {
        const int r32 = lane & 31, hh = lane >> 5;
        const int nNt = 1024 / 64, total = (T / 32) * nNt;
        for (int tile = gwave; tile < total; tile += nwaves) {
            const int mt = tile / nNt, nt = tile - mt * nNt, m0 = mt * 32, n0 = nt * 64;
            f32x16 g0 = zero16(), g1 = zero16(), p0 = zero16(), p1 = zero16();
            {
                const bf16_t* ap = XN + (size_t)(m0 + r32) * 1024 + 8 * hh;
                const bf16_t* b0p = WgT + (size_t)(n0 + r32) * 1024 + 8 * hh;
                const bf16_t* b1p = b0p + (size_t)32 * 1024;
#pragma unroll 4
                for (int k = 0; k < 1024; k += 16) {
                    const bf16x8 xa = *(const bf16x8*)(ap + k), w0 = *(const bf16x8*)(b0p + k), w1 = *(const bf16x8*)(b1p + k);
                    g0 = MFMA32(w0, xa, g0); g1 = MFMA32(w1, xa, g1);
                }
            }
            {
                const bf16_t* ap = PB + (size_t)(m0 + r32) * 256 + 8 * hh;
                const bf16_t* b0p = WpleT + (size_t)(n0 + r32) * 256 + 8 * hh;
                const bf16_t* b1p = b0p + (size_t)32 * 256;
#pragma unroll 4
                for (int k = 0; k < 256; k += 16) {
                    const bf16x8 xa = *(const bf16x8*)(ap + k), w0 = *(const bf16x8*)(b0p + k), w1 = *(const bf16x8*)(b1p + k);
                    p0 = MFMA32(w0, xa, p0); p1 = MFMA32(w1, xa, p1);
                }
            }
            const int tok = m0 + r32;
#pragma unroll
            for (int t = 0; t < 2; ++t)
#pragma unroll
                for (int g4 = 0; g4 < 4; ++g4) {
                    float* op = P.out + (size_t)tok * 1024 + n0 + 32 * t + 8 * g4 + 4 * hh;
                    const f32x4 hv = *(const f32x4*)op;
                    f32x4 o;
#pragma unroll
                    for (int i = 0; i < 4; ++i) { const float gl = t ? g1[4 * g4 + i] : g0[4 * g4 + i], pw = t ? p1[4 * g4 + i] : p0[4 * g4 + i];
                        o[i] = hv[i] + pw / (1.f + __expf(-gl)); }
                    *(f32x4*)op = o;
                }
        }
    }
#undef IN
#undef SEAM
}

extern "C" void kernel_launch(void* const* d_in, const int* in_sizes, int n_in, void* d_out, int out_size, void* d_ws, size_t ws_size, hipStream_t stream) {
    static int grid = 0;
    if (grid == 0) {
        if (n_in != 18 || out_size != T * DM || ws_size < WS_END) { fprintf(stderr, "kernel_launch: unexpected shapes (n_in %d out %d ws %zu)\n", n_in, out_size, ws_size); grid = -1; return; }
        int dev = 0, cus = 0, per_cu = 0;
        if (hipGetDevice(&dev) != hipSuccess || hipDeviceGetAttribute(&cus, hipDeviceAttributeMultiprocessorCount, dev) != hipSuccess) { grid = -1; return; }
        if (hipFuncSetAttribute((const void*)fwd_kernel, hipFuncAttributeMaxDynamicSharedMemorySize, LDS_BYTES) != hipSuccess) { fprintf(stderr, "kernel_launch: hipFuncSetAttribute failed\n"); grid = -1; return; }
        if (hipOccupancyMaxActiveBlocksPerMultiprocessor(&per_cu, (const void*)fwd_kernel, 512, LDS_BYTES) != hipSuccess || per_cu < 1)
            fprintf(stderr, "kernel_launch: note: occupancy query reports %d\n", per_cu);
        (void)hipGetLastError();
        grid = cus;
    }
    if (grid < 0) return;
    if (hipMemsetAsync((char*)d_ws + WS_CTL, 0, CTL_ZERO_BYTES, stream) != hipSuccess) return;
    Params p{};
    for (int i = 0; i < 18; ++i) p.in[i] = (const float*)d_in[i];
    p.out = (float*)d_out; p.ws = (unsigned char*)d_ws;
#if N_LAUNCHES == 1
    p.ph_lo = 0; p.ph_hi = NPHASE;
    hipLaunchKernelGGL(fwd_kernel, dim3(grid), dim3(512), LDS_BYTES, stream, p);
#else
    for (int k = 0; k < NPHASE; ++k) { p.ph_lo = k; p.ph_hi = k + 1; hipLaunchKernelGGL(fwd_kernel, dim3(grid), dim3(512), LDS_BYTES, stream, p); }
#endif
}
```

```cpp
#include <hip/hip_runtime.h>
#include <stdint.h>
#include <stdio.h>

#ifndef N_LAUNCHES
#define N_LAUNCHES 1
#endif

#define DI __device__ __forceinline__
#define LAS __attribute__((address_space(3)))

typedef unsigned short bf16_t;
typedef short bf16x8 __attribute__((ext_vector_type(8)));
typedef float f32x16 __attribute__((ext_vector_type(16)));
typedef float f32x4 __attribute__((ext_vector_type(4)));
typedef float f32x2 __attribute__((ext_vector_type(2)));
typedef unsigned u32x4 __attribute__((ext_vector_type(4)));
typedef unsigned u32x2 __attribute__((ext_vector_type(2)));
typedef __bf16 bf16x2_t __attribute__((ext_vector_type(2)));

constexpr int BATCH = 8, SEQ = 2048, DM = 1024, T = BATCH * SEQ;
constexpr int NPROJ = 3072;
constexpr float EPS = 1e-6f;
constexpr float LOG2E = 1.4426950408889634f;
constexpr float SCL2 = 0.125f * LOG2E;
constexpr int NPHASE = 12;

constexpr size_t MiB = 1u << 20;
constexpr size_t WS_CTL = 0, CTL_ZERO_BYTES = 65536;
constexpr size_t WS_KMEAN = 256 * 1024;
constexpr size_t WS_BIAS = 512 * 1024;
constexpr size_t WS_WIN = 1 * MiB, WS_WOUT = 7 * MiB, WS_WQ = 9 * MiB, WS_WG = 13 * MiB, WS_WPLE = 15 * MiB;
constexpr size_t WS_U = 16 * MiB, WS_V = 32 * MiB;
constexpr size_t WS_USC = 640 * 1024, WS_VSC = 704 * 1024;
constexpr size_t WS_XN2 = 48 * MiB;
constexpr size_t WS_XN = 80 * MiB;
constexpr size_t WS_PB = 112 * MiB;
constexpr size_t WS_QM = 120 * MiB, WS_KM = 136 * MiB, WS_VTM = 152 * MiB, WS_QS = 168 * MiB, WS_KS = 184 * MiB, WS_VTS = 200 * MiB;
constexpr size_t WS_ORAW = 216 * MiB;
constexpr size_t WS_A2 = 80 * MiB;
constexpr size_t WS_A3 = 120 * MiB;
constexpr size_t WS_SC = 152 * MiB;
constexpr size_t WS_EIDX = 80 * MiB, WS_GATE = 88 * MiB, WS_CJ = 96 * MiB, WS_RS2 = 104 * MiB, WS_SSQ = 105 * MiB;
constexpr size_t WS_PDOT = 120 * MiB;
constexpr size_t WS_A4 = 184 * MiB;
constexpr size_t WS_END = 248 * MiB;

constexpr int CW_XC = 8192;
constexpr int CW_BAR = 4096;

constexpr int LDS_BYTES = 147456;

#define XB_TMO      128
#define XB_XCNT(j)  (256  + 64 * (j))
#define XB_XSUB(j)  (1280 + 64 * (j))
#define XB_XGEN(j)  (2304 + 64 * (j))
#define XB_TOP      3328
#define XB_TOPGEN   3392
#define XCD_BAR_WORDS 3456
#define XB_SPIN_CAP (1u << 18)

__device__ __forceinline__ unsigned xb_ld(unsigned* p)              { return __hip_atomic_load(p, __ATOMIC_RELAXED, __HIP_MEMORY_SCOPE_AGENT); }
__device__ __forceinline__ unsigned xb_add(unsigned* p, unsigned v) { return __hip_atomic_fetch_add(p, v, __ATOMIC_RELAXED, __HIP_MEMORY_SCOPE_AGENT); }
__device__ __forceinline__ unsigned xb_xcc_id() { return (unsigned)__builtin_amdgcn_s_getreg((3 << 11) | 20) & 0xFu; }
#define XB_SPIN(cond, bar) do { unsigned _sp = 0; while (cond) { __builtin_amdgcn_s_sleep(1); \
    if ((++_sp & 255u) == 0u) { if (xb_ld(&(bar)[XB_TMO])) break; if (_sp > XB_SPIN_CAP) { atomicAdd(&(bar)[XB_TMO], 1u); break; } } } } while (0)

struct XcdBarrier { unsigned* bar; unsigned x; volatile LAS unsigned* st; };

__device__ __forceinline__ XcdBarrier xcd_barrier_post(unsigned* bar, volatile LAS unsigned* st) {
    XcdBarrier b; b.bar = bar; b.x = xb_xcc_id(); b.st = st;
    if (threadIdx.x == 0) (void)xb_add(&bar[XB_XCNT(b.x)], 1u);
    return b;
}
__device__ __forceinline__ void xcd_barrier_complete(unsigned* bar, unsigned x, unsigned& nloc, unsigned& nx) {
    const unsigned G = gridDim.x * gridDim.y * gridDim.z;
    unsigned sum, cnt, mine, sp = 0u;
    for (;;) {
        sum = 0u; cnt = 0u; mine = 0u;
#pragma unroll
        for (unsigned j = 0; j < 16; ++j) { const unsigned c = xb_ld(&bar[XB_XCNT(j)]); sum += c; cnt += (c > 0u) ? 1u : 0u; mine = (j == x) ? c : mine; }
        if (sum == G) break;
        __builtin_amdgcn_s_sleep(1);
        if ((++sp & 255u) == 0u) { if (xb_ld(&bar[XB_TMO])) break; if (sp > XB_SPIN_CAP) { atomicAdd(&bar[XB_TMO], 1u); break; } }
    }
    nloc = mine > 0u ? mine : 1u; nx = cnt > 0u ? cnt : 1u;
}
__device__ __forceinline__ void xcd_barrier(const XcdBarrier& b) {
    asm volatile("s_waitcnt vmcnt(0)" ::: "memory");
    __syncthreads();
    if (threadIdx.x == 0) {
        unsigned* bar = b.bar;
        __builtin_amdgcn_s_waitcnt(0);
        unsigned nloc = b.st[0], nx = b.st[1];
        if (nloc == 0u) { xcd_barrier_complete(bar, b.x, nloc, nx); b.st[0] = nloc; b.st[1] = nx; }
        const unsigned old = xb_add(&bar[XB_XSUB(b.x)], 1u);
        const unsigned gen = old / nloc;
        if (old + 1u == (gen + 1u) * nloc) {
            __builtin_amdgcn_fence(__ATOMIC_RELEASE, "agent");
            asm volatile("s_waitcnt vmcnt(0)" ::: "memory");
            const unsigned og = xb_add(&bar[XB_TOP], 1u);
            const unsigned tg = og / nx;
            if (og + 1u == (tg + 1u) * nx) xb_add(&bar[XB_TOPGEN], 1u);
            else XB_SPIN(xb_ld(&bar[XB_TOPGEN]) == tg, bar);
            __builtin_amdgcn_fence(__ATOMIC_ACQUIRE, "agent");
            xb_add(&bar[XB_XGEN(b.x)], 1u);
            asm volatile("s_waitcnt vmcnt(0)" ::: "memory");
        } else {
            XB_SPIN(xb_ld(&bar[XB_XGEN(b.x)]) == gen, bar);
            __builtin_amdgcn_fence(__ATOMIC_ACQUIRE, "agent");
            asm volatile("s_waitcnt vmcnt(0)" ::: "memory");
        }
    }
    __syncthreads();
}

DI float bf2f(short v) { return __builtin_bit_cast(float, ((unsigned)(unsigned short)v) << 16); }
DI unsigned cvtpk(float lo, float hi) { f32x2 v = {lo, hi}; bf16x2_t b = __builtin_convertvector(v, bf16x2_t); return __builtin_bit_cast(unsigned, b); }
DI bf16_t f2bf(float f) { return (bf16_t)(cvtpk(f, 0.f) & 0xffffu); }
DI float wave_sum(float v) {
#pragma unroll
    for (int o = 1; o < 64; o <<= 1) v += __shfl_xor(v, o);
    return v;
}
DI int crow(int r, int hi) { return (r & 3) + 8 * (r >> 2) + 4 * hi; }
#define MFMA32(a, b, c) __builtin_amdgcn_mfma_f32_32x32x16_bf16((a), (b), (c), 0, 0, 0)
DI f32x16 zero16() { f32x16 z; for (int i = 0; i < 16; ++i) z[i] = 0.f; return z; }

struct Params {
    const float* in[18];
    float* out;
    unsigned char* ws;
    int ph_lo, ph_hi;
};

enum { IN_X = 0, IN_P, IN_RELB, IN_ATTN_NORM, IN_WIN, IN_QNORM, IN_KNORM, IN_ONM, IN_ONS, IN_WOUT, IN_FFN_NORM, IN_PQ, IN_SUBK, IN_PU, IN_PV, IN_PLE_NORM, IN_WPG, IN_WPLE };

template <bool HEADPERM> DI void p0_transpose(const float* W, int K, int N, bf16_t* Wt, LAS float* scr, int tid, int wg, int nwg, const float* kgain = nullptr) {
    const int tn = N / 64, ntile = (K / 64) * tn;
    for (int tile = wg; tile < ntile; tile += nwg) {
        const int k0 = (tile / tn) * 64, n0 = (tile % tn) * 64;
#pragma unroll
        for (int i = 0; i < 8; ++i) { const int kk = (tid >> 6) + 8 * i, nn = tid & 63; scr[kk * 65 + nn] = W[(size_t)(k0 + kk) * N + n0 + nn]; }
        __syncthreads();
#pragma unroll
        for (int i = 0; i < 8; ++i) { const int nn = (tid >> 6) + 8 * i, kk = tid & 63; int n = n0 + nn; if (HEADPERM) { const int w = n & 255; n = (n & ~255) + 128 * ((w >> 5) & 1) + 32 * (w >> 6) + (w & 31); }
            Wt[(size_t)n * K + k0 + kk] = f2bf(scr[kk * 65 + nn] * (kgain ? kgain[k0 + kk] : 1.f)); }
        __syncthreads();
    }
}

DI void p0_fold(const float* wq, const float* sub, const float* gffn, bf16_t* WqT, LAS float* lds, int tid, int wg, int nwg) {
    LAS float* wqs = lds;
    LAS float* subs = lds + 128 * 65;
    for (int item = wg; item < 256; item += nwg) {
        const int dt = item & 15, hh = item >> 4, d0 = dt * 64, h = hh >> 1, half = hh & 1;
#pragma unroll
        for (int i = 0; i < 16; ++i) { const int k = tid & 127, dd = (tid >> 7) + 4 * i; wqs[k * 65 + dd] = wq[(size_t)(d0 + dd) * 2048 + h * 256 + half * 128 + k]; }
#pragma unroll
        for (int i = 0; i < 32; ++i) { const int idx = i * 512 + tid; subs[idx] = sub[half * 16384 + idx]; }
        __syncthreads();
        const int d = tid & 63, ng = tid >> 6;
        float acc[16];
#pragma unroll
        for (int i = 0; i < 16; ++i) acc[i] = 0.f;
        for (int k = 0; k < 128; k += 4) {
            const float a0 = wqs[(k + 0) * 65 + d], a1 = wqs[(k + 1) * 65 + d], a2 = wqs[(k + 2) * 65 + d], a3 = wqs[(k + 3) * 65 + d];
#pragma unroll
            for (int i = 0; i < 16; ++i) { const f32x4 s = *(const LAS f32x4*)(subs + (16 * ng + i) * 128 + k); acc[i] += a0 * s.x + a1 * s.y + a2 * s.z + a3 * s.w; }
        }
        const float g = gffn[d0 + d];
#pragma unroll
        for (int i = 0; i < 16; ++i) WqT[(size_t)(hh * 128 + 16 * ng + i) * 1024 + d0 + d] = f2bf(acc[i] * g);
        __syncthreads();
    }
}

DI void p0_convert(const float* src, bf16_t* dst, size_t n, size_t gtid, size_t nthreads) {
    for (size_t i = gtid * 8; i < n; i += nthreads * 8) {
        const f32x4 a = *(const f32x4*)(src + i), b = *(const f32x4*)(src + i + 4);
        u32x4 o; o.x = cvtpk(a.x, a.y); o.y = cvtpk(a.z, a.w); o.z = cvtpk(b.x, b.y); o.w = cvtpk(b.z, b.w);
        *(u32x4*)(dst + i) = o;
    }
}


DI void p0_quant_finish(const f32x4 (&a)[4], unsigned char* dst, float* scale, int row, int lane) {
    float m = 0.f;
#pragma unroll
    for (int i = 0; i < 4; ++i) m = fmaxf(fmaxf(m, fmaxf(fabsf(a[i].x), fabsf(a[i].y))), fmaxf(fabsf(a[i].z), fabsf(a[i].w)));
#pragma unroll
    for (int o = 1; o < 64; o <<= 1) m = fmaxf(m, __shfl_xor(m, o));
    const float sc = m > 0.f ? m * (1.f / 440.f) : 1.f, inv = m > 0.f ? 440.f / m : 0.f;
    u32x4 w;
#pragma unroll
    for (int i = 0; i < 4; ++i) {
        const float q0 = fminf(fmaxf(a[i].x * inv, -448.f), 448.f), q1 = fminf(fmaxf(a[i].y * inv, -448.f), 448.f);
        const float q2 = fminf(fmaxf(a[i].z * inv, -448.f), 448.f), q3 = fminf(fmaxf(a[i].w * inv, -448.f), 448.f);
        int p = 0;
        p = __builtin_amdgcn_cvt_pk_fp8_f32(q0, q1, p, false);
        p = __builtin_amdgcn_cvt_pk_fp8_f32(q2, q3, p, true);
        w[i] = (unsigned)p;
    }
    *(u32x4*)(dst + ((size_t)(lane >> 3) * 16384 + row) * 128 + 16 * (lane & 7)) = w;
    if (lane == 0) scale[row] = sc;
}
DI void p0_quant_rows4(const float* pu, const float* pv, unsigned char* u8, unsigned char* v8, float* usc_, float* vsc_, int r0, int r1, int lane) {
    f32x4 a[4][4];
    const int r1c = r1 < 16384 ? r1 : r0;
#pragma unroll
    for (int i = 0; i < 4; ++i) { a[0][i] = *(const f32x4*)(pu + (size_t)r0 * 1024 + 16 * lane + 4 * i); a[1][i] = *(const f32x4*)(pv + (size_t)r0 * 1024 + 16 * lane + 4 * i);
        a[2][i] = *(const f32x4*)(pu + (size_t)r1c * 1024 + 16 * lane + 4 * i); a[3][i] = *(const f32x4*)(pv + (size_t)r1c * 1024 + 16 * lane + 4 * i); }
    p0_quant_finish(a[0], u8, usc_, r0, lane); p0_quant_finish(a[1], v8, vsc_, r0, lane);
    if (r1 < 16384) { p0_quant_finish(a[2], u8, usc_, r1, lane); p0_quant_finish(a[3], v8, vsc_, r1, lane); }
}

DI void rmsnorm_rows2_bf16(const float* x, const float* g, bf16_t* o, int r0, int r1, int lane) {
    f32x4 v[2][4]; float s[2] = {0.f, 0.f};
    const int rr[2] = {r0, r1 < T ? r1 : r0};
#pragma unroll
    for (int q = 0; q < 2; ++q)
#pragma unroll
        for (int j = 0; j < 4; ++j) v[q][j] = ((const f32x4*)(x + (size_t)rr[q] * 1024))[lane + 64 * j];
#pragma unroll
    for (int q = 0; q < 2; ++q) {
#pragma unroll
        for (int j = 0; j < 4; ++j) s[q] += (v[q][j].x * v[q][j].x + v[q][j].y * v[q][j].y) + (v[q][j].z * v[q][j].z + v[q][j].w * v[q][j].w);
        s[q] = wave_sum(s[q]);
    }
#pragma unroll
    for (int q = 0; q < 2; ++q) {
        if (q == 1 && r1 >= T) break;
        const float rs = rsqrtf(s[q] * (1.f / 1024.f) + EPS);
#pragma unroll
        for (int j = 0; j < 4; ++j) { const f32x4 gv = ((const f32x4*)g)[lane + 64 * j];
            u32x2 w; w.x = cvtpk(v[q][j].x * rs * gv.x, v[q][j].y * rs * gv.y); w.y = cvtpk(v[q][j].z * rs * gv.z, v[q][j].w * rs * gv.w);
            ((u32x2*)(o + (size_t)rr[q] * 1024))[lane + 64 * j] = w; }
    }
}

namespace pg8 {
#define PG8_LAS __attribute__((address_space(3)))
typedef unsigned short bf16_t;
typedef short bf16x8 __attribute__((ext_vector_type(8)));
typedef float f32x4 __attribute__((ext_vector_type(4)));
typedef unsigned u32x4 __attribute__((ext_vector_type(4)));
constexpr int BM = 256, BK = 64, HALF = 128, HTB = HALF * BK * 2  , STAGE_BYTES = 8 * HTB, NXCD = 8, WGM = 8;

__host__ __device__ __forceinline__ int lds_byte(int r, int c) { const int st = (r >> 4) * 2 + (c >> 5), rr = r & 15, cc = c & 31, ob = rr * 64 + cc * 2; return st * 1024 + (ob ^ (((ob >> 9) & 1) << 5)); }
__host__ __device__ __forceinline__ void stage_rc(int b, int& R, int& C) { const int st = b / 1024, sb = b % 1024, swz = sb ^ (((sb >> 9) & 1) << 5); R = (st >> 1) * 16 + swz / 64; C = (st & 1) * 32 + (swz % 64) / 2; }
__host__ __device__ __forceinline__ int perm32(int rho) { const int n = rho >> 4, i = rho & 15; return 8 * (i >> 2) + 4 * n + (i & 3); }

struct Unit { int pm, pn; };
struct Gemm { const bf16_t* A; const bf16_t* Bt; int M, N, K; };

struct StaticOrder {
    int nM, nN, nwg, G, c;
    __host__ __device__ void init(int M, int N, int G_, int c_) { nM = M / BM; nN = N / BM; nwg = nM * nN; G = G_; c = c_; }
    __host__ __device__ bool next(int i, Unit& u) const {
        const long L = (long)i * G + c; if (L >= nwg) return false;
        int wgid = (int)L; { const int q = nwg / NXCD, r = nwg % NXCD, xcd = wgid % NXCD, off = wgid / NXCD; wgid = (xcd < r ? xcd * (q + 1) : r * (q + 1) + (xcd - r) * q) + off; }
        const int nig = WGM * nN, gid = wgid / nig, fm = gid * WGM, gsz = (nM - fm) < WGM ? (nM - fm) : WGM;
        u.pm = fm + ((wgid % nig) % gsz); u.pn = (wgid % nig) / gsz; return true;
    }
    __device__ __forceinline__ void a_ready(const Unit&) const {}
    __device__ __forceinline__ void done(const Unit&) const {}
};

template <class Epi, class Sched, bool ALIGN_EPI = false, bool SP2 = false>
__device__ __forceinline__ void gemm_phase(PG8_LAS unsigned char* lds, const Gemm g, const Sched& S, const Epi& E) {
    int tid_ = threadIdx.x; asm volatile("" : "+v"(tid_));
    const int tid = tid_, wid = __builtin_amdgcn_readfirstlane(tid >> 6), lane = tid & 63, wr = wid >> 2, wc = wid & 3, fr = lane & 15, fq = lane >> 4;
    const int K = g.K, nt = K / BK;
    unsigned voffA[2], voffB[2];
#pragma unroll
    for (int i = 0; i < 2; ++i) { int R, C; stage_rc(tid * 16 + i * 8192, R, C); const int Rb = Epi::PERM ? ((R & ~31) + perm32(R & 31)) : R;
        voffA[i] = (unsigned)(R * K + C) * 2u; voffB[i] = (unsigned)(Rb * K + C) * 2u; }
    const size_t kstep = (size_t)(BK * 2);
    const size_t hstep = (size_t)HALF * K * 2;
    const size_t tstep = 2 * hstep;
    const unsigned ldsw = (unsigned)wid * 1024u;
    const int aoff = lds_byte(wr * 64 + fr, fq * 8), boff = lds_byte(wc * 32 + fr, fq * 8);
#define PG8_SA(b, h) (((b) * 2 + (h)) * HTB)
#define PG8_SB(b, h) ((4 + (b) * 2 + (h)) * HTB)
#define PG8_STAGE(bufoff, gbase, voff) do { _Pragma("unroll") for (int _i = 0; _i < 2; ++_i) \
        __builtin_amdgcn_global_load_lds((const unsigned*)((const char*)(gbase) + (voff)[_i]), (PG8_LAS unsigned*)(lds + (bufoff) + ldsw + _i * 8192), 16, 0, 0); } while (0)
#define PG8_LDA(dst, b, h) do { _Pragma("unroll") for (int m = 0; m < 4; ++m) _Pragma("unroll") for (int k = 0; k < 2; ++k) dst[m][k] = *(const PG8_LAS bf16x8*)(lds + PG8_SA(b, h) + aoff + m * 2048 + k * 1024); } while (0)
#define PG8_LDB(dst, b, h) do { _Pragma("unroll") for (int n = 0; n < 2; ++n) _Pragma("unroll") for (int k = 0; k < 2; ++k) dst[n][k] = *(const PG8_LAS bf16x8*)(lds + PG8_SB(b, h) + boff + n * 2048 + k * 1024); } while (0)
#define PG8_MMA(ai, bj, At, Bt) do { __builtin_amdgcn_s_setprio(1); _Pragma("unroll") for (int m = 0; m < 4; ++m) _Pragma("unroll") for (int n = 0; n < 2; ++n) _Pragma("unroll") for (int k = 0; k < 2; ++k) \
        acc[ai][bj][m][n] = __builtin_amdgcn_mfma_f32_16x16x32_bf16(Bt[n][k], At[m][k], acc[ai][bj][m][n], 0, 0, 0); __builtin_amdgcn_s_setprio(0); } while (0)
#define PG8_WAIT_V(n) asm volatile("s_waitcnt vmcnt(" #n ")" ::: "memory")
#define PG8_WAIT_L(n) asm volatile("s_waitcnt lgkmcnt(" #n ")" ::: "memory")
#define PG8_BAR __builtin_amdgcn_s_barrier()
#define PG8_SCHED __builtin_amdgcn_sched_barrier(0)
    Unit cur, nxt; int ui = 0;
    if (!S.next(0, cur)) return;
    f32x4 acc[2][2][4][2];
#pragma unroll
    for (int a = 0; a < 2; ++a)
#pragma unroll
        for (int b = 0; b < 2; ++b)
#pragma unroll
            for (int m = 0; m < 4; ++m)
#pragma unroll
                for (int n = 0; n < 2; ++n) acc[a][b][m][n] = (f32x4){0.f, 0.f, 0.f, 0.f};
    bf16x8 At[4][2], B0[2][2], B1[2][2];
    const char* cA = (const char*)g.A + (size_t)cur.pm * tstep; const char* cB = (const char*)g.Bt + (size_t)cur.pn * tstep;
    S.a_ready(cur);
    if constexpr (SP2) {
        PG8_STAGE(PG8_SB(0, 0), cB, voffB); PG8_STAGE(PG8_SB(0, 1), cB + hstep, voffB); PG8_STAGE(PG8_SA(0, 0), cA, voffA); PG8_STAGE(PG8_SA(0, 1), cA + hstep, voffA);
        if (wr == 1) PG8_BAR;
        PG8_WAIT_V(2); PG8_BAR;
        PG8_STAGE(PG8_SB(1, 0), cB + kstep, voffB); PG8_STAGE(PG8_SA(1, 0), cA + kstep, voffA); PG8_STAGE(PG8_SB(1, 1), cB + hstep + kstep, voffB);
        PG8_WAIT_V(6); PG8_BAR;
    } else {
        PG8_STAGE(PG8_SB(0, 0), cB, voffB); PG8_STAGE(PG8_SA(0, 0), cA, voffA); PG8_STAGE(PG8_SB(0, 1), cB + hstep, voffB); PG8_STAGE(PG8_SA(0, 1), cA + hstep, voffA);
        if (wr == 1) PG8_BAR;
        PG8_WAIT_V(4); PG8_BAR;
        PG8_STAGE(PG8_SB(1, 0), cB + kstep, voffB); PG8_STAGE(PG8_SA(1, 0), cA + kstep, voffA); PG8_STAGE(PG8_SB(1, 1), cB + hstep + kstep, voffB);
        PG8_WAIT_V(6); PG8_BAR;
    }
    for (;;) {
        const bool has_next = S.next(ui + 1, nxt);
        const char* nA = has_next ? (const char*)g.A + (size_t)nxt.pm * tstep : cA; const char* nB = has_next ? (const char*)g.Bt + (size_t)nxt.pn * tstep : cB;
        for (int t = 0; t < nt; t += 2) {
            const bool last = (t == nt - 2);
            const char* a1 = cA + (size_t)(t + 1) * kstep;
            const char* a2 = last ? nA : cA + (size_t)(t + 2) * kstep; const char* b2 = last ? nB : cB + (size_t)(t + 2) * kstep;
            const char* a3 = a2 + kstep; const char* b3 = b2 + kstep;
            if (last && has_next) S.a_ready(nxt);
            if constexpr (SP2) {
            PG8_LDB(B0, 0, 0); PG8_LDB(B1, 0, 1); PG8_SCHED; PG8_LDA(At, 0, 0); PG8_STAGE(PG8_SA(1, 1), a1 + hstep, voffA);
            PG8_WAIT_V(8); PG8_WAIT_L(0); PG8_BAR; PG8_MMA(0, 0, At, B0); PG8_MMA(0, 1, At, B1); PG8_BAR; PG8_SCHED;
            PG8_LDA(At, 0, 1); PG8_STAGE(PG8_SB(0, 0), b2, voffB); PG8_STAGE(PG8_SB(0, 1), b2 + hstep, voffB); PG8_STAGE(PG8_SA(0, 0), a2, voffA);
            PG8_WAIT_V(8); PG8_WAIT_L(0); PG8_BAR; PG8_MMA(1, 0, At, B0); PG8_MMA(1, 1, At, B1); PG8_BAR; PG8_SCHED;
            PG8_LDB(B0, 1, 0); PG8_LDB(B1, 1, 1); PG8_SCHED; PG8_LDA(At, 1, 0); PG8_STAGE(PG8_SA(0, 1), a2 + hstep, voffA);
            PG8_WAIT_V(8); PG8_WAIT_L(0); PG8_BAR; PG8_MMA(0, 0, At, B0); PG8_MMA(0, 1, At, B1); PG8_BAR; PG8_SCHED;
            PG8_LDA(At, 1, 1); PG8_STAGE(PG8_SB(1, 0), b3, voffB); PG8_STAGE(PG8_SB(1, 1), b3 + hstep, voffB); PG8_STAGE(PG8_SA(1, 0), a3, voffA);
            PG8_WAIT_V(8); PG8_WAIT_L(0); PG8_BAR; PG8_MMA(1, 0, At, B0); PG8_MMA(1, 1, At, B1); PG8_BAR; PG8_SCHED;
            } else {
            PG8_LDB(B0, 0, 0); PG8_SCHED; PG8_LDA(At, 0, 0); PG8_STAGE(PG8_SA(1, 1), a1 + hstep, voffA);
            PG8_WAIT_L(8); PG8_BAR; PG8_WAIT_L(0); PG8_MMA(0, 0, At, B0); PG8_BAR; PG8_SCHED;
            PG8_LDB(B1, 0, 1); PG8_STAGE(PG8_SB(0, 0), b2, voffB);
            PG8_BAR; PG8_WAIT_L(0); PG8_MMA(0, 1, At, B1); PG8_BAR;
            PG8_LDA(At, 0, 1); PG8_STAGE(PG8_SA(0, 0), a2, voffA);
            PG8_BAR; PG8_WAIT_L(0); PG8_MMA(1, 0, At, B0); PG8_BAR; PG8_SCHED;
            PG8_STAGE(PG8_SB(0, 1), b2 + hstep, voffB);
            PG8_WAIT_V(6); PG8_BAR; PG8_MMA(1, 1, At, B1); PG8_BAR;
            PG8_LDB(B0, 1, 0); PG8_SCHED; PG8_LDA(At, 1, 0); PG8_STAGE(PG8_SA(0, 1), a2 + hstep, voffA);
            PG8_WAIT_L(8); PG8_BAR; PG8_WAIT_L(0); PG8_MMA(0, 0, At, B0); PG8_BAR; PG8_SCHED;
            PG8_LDB(B1, 1, 1); PG8_STAGE(PG8_SB(1, 0), b3, voffB);
            PG8_BAR; PG8_WAIT_L(0); PG8_MMA(0, 1, At, B1); PG8_BAR;
            PG8_LDA(At, 1, 1); PG8_STAGE(PG8_SA(1, 0), a3, voffA);
            PG8_BAR; PG8_WAIT_L(0); PG8_MMA(1, 0, At, B0); PG8_BAR; PG8_SCHED;
            PG8_STAGE(PG8_SB(1, 1), b3 + hstep, voffB);
            PG8_WAIT_V(6); PG8_BAR; PG8_MMA(1, 1, At, B1); PG8_BAR;
            }
        }
        if constexpr (ALIGN_EPI) { if (wr == 0) PG8_BAR; }
        if constexpr (!Epi::AFTER_DRAIN) { E(acc, cur, wr, wc, fr, fq); S.done(cur); }
        if (!has_next) break;
#pragma unroll
        for (int a = 0; a < 2; ++a)
#pragma unroll
            for (int b = 0; b < 2; ++b)
#pragma unroll
                for (int m = 0; m < 4; ++m)
#pragma unroll
                    for (int n = 0; n < 2; ++n) acc[a][b][m][n] = (f32x4){0.f, 0.f, 0.f, 0.f};
        cur = nxt; cA = nA; cB = nB; ++ui;
        if constexpr (ALIGN_EPI) { if (wr == 1) PG8_BAR; }
    }
    PG8_WAIT_V(0);
    if constexpr (!ALIGN_EPI) { if (wr == 0) PG8_BAR; }
    PG8_BAR;
    if constexpr (Epi::AFTER_DRAIN) { E.fused(acc, cur, wr, wc, fr, fq, lds, wid, lane); S.done(cur); }
#undef PG8_SA
#undef PG8_SB
#undef PG8_STAGE
#undef PG8_LDA
#undef PG8_LDB
#undef PG8_MMA
#undef PG8_WAIT_V
#undef PG8_WAIT_L
#undef PG8_BAR
#undef PG8_SCHED
}
}


struct EpiQKV {
    static constexpr bool PERM = true, AFTER_DRAIN = false;
    bf16_t* base6; const float *qn, *kn;
    DI void operator()(const f32x4 (&acc)[2][2][4][2], const pg8::Unit& u, int wr, int wc, int fr, int fq) const {
        const int typ = u.pn >> 1, h = (u.pn & 1) * 4 + wc;
        bf16_t* reg = base6 + (size_t)typ * (16u << 19);
        const int row0 = u.pm * 256 + wr * 64 + fr;
        if (typ == 2 || typ == 5) {
#pragma unroll
            for (int ai = 0; ai < 2; ++ai)
#pragma unroll
                for (int m = 0; m < 4; ++m) {
                    const int tok = row0 + ai * 128 + m * 16, b = tok >> 11, sq = tok & 2047, tile = sq >> 5, kap = sq & 31;
                    const int s2 = kap >> 4, hh = (kap >> 2) & 1, jj = ((kap >> 3) & 1) * 4 + (kap & 3);
                    bf16_t* bp = reg + ((((size_t)(b * 8 + h) * 64 + tile) * 4 + s2 * 2) * 64 + hh * 32 + 8 * fq) * 8 + jj;
#pragma unroll
                    for (int bj = 0; bj < 2; ++bj)
#pragma unroll
                        for (int n = 0; n < 2; ++n)
#pragma unroll
                            for (int i = 0; i < 4; ++i) bp[(size_t)bj * 512 + (4 * n + i) * 8] = f2bf(acc[ai][bj][m][n][i]);
                }
        } else {
            const bool nrm = typ < 2;
            const float* g = (typ == 0) ? qn : kn;
            f32x4 gv[2][2];
#pragma unroll
            for (int bj = 0; bj < 2; ++bj)
#pragma unroll
                for (int n = 0; n < 2; ++n) gv[bj][n] = nrm ? *(const f32x4*)(g + 32 * bj + 8 * fq + 4 * n) : (f32x4){1.f, 1.f, 1.f, 1.f};
#pragma unroll
            for (int ai = 0; ai < 2; ++ai)
#pragma unroll
                for (int m = 0; m < 4; ++m) {
                    const int tok = row0 + ai * 128 + m * 16, b = tok >> 11, sq = tok & 2047, tile = sq >> 5, kap = sq & 31;
                    float rs = 1.f;
                    if (nrm) {
                        float ss = 0.f;
#pragma unroll
                        for (int bj = 0; bj < 2; ++bj)
#pragma unroll
                            for (int n = 0; n < 2; ++n) { const f32x4 v = acc[ai][bj][m][n]; ss += (v.x * v.x + v.y * v.y) + (v.z * v.z + v.w * v.w); }
                        ss += __shfl_xor(ss, 16); ss += __shfl_xor(ss, 32);
                        rs = rsqrtf(ss * (1.f / 64.f) + EPS);
                    }
                    bf16_t* dst = reg + ((((size_t)(b * 8 + h) * 64 + tile) * 4 + (fq >> 1)) * 64 + (fq & 1) * 32 + kap) * 8;
#pragma unroll
                    for (int bj = 0; bj < 2; ++bj) {
                        const f32x4 v0 = acc[ai][bj][m][0] * rs * gv[bj][0], v1 = acc[ai][bj][m][1] * rs * gv[bj][1];
                        u32x4 w; w.x = cvtpk(v0.x, v0.y); w.y = cvtpk(v0.z, v0.w); w.z = cvtpk(v1.x, v1.y); w.w = cvtpk(v1.z, v1.w);
                        *(u32x4*)(dst + (size_t)bj * 2 * 512) = w;
                    }
                }
        }
    }
};

struct EpiRes {
    static constexpr bool PERM = true, AFTER_DRAIN = false;
    const float* x; float* out; bf16_t* xn;
    DI void operator()(const f32x4 (&acc)[2][2][4][2], const pg8::Unit& u, int wr, int wc, int fr, int fq) const {
        const int row0 = u.pm * 256 + wr * 64 + fr, col0 = u.pn * 256 + wc * 32 + 8 * fq;
#pragma unroll
        for (int ai = 0; ai < 2; ++ai)
#pragma unroll
            for (int m = 0; m < 4; ++m)
#pragma unroll
                for (int bj = 0; bj < 2; ++bj) {
                    const size_t off = (size_t)(row0 + ai * 128 + m * 16) * 1024 + col0 + bj * 128;
                    const f32x4 h0 = *(const f32x4*)(x + off) + acc[ai][bj][m][0], h1 = *(const f32x4*)(x + off + 4) + acc[ai][bj][m][1];
                    *(f32x4*)(out + off) = h0; *(f32x4*)(out + off + 4) = h1;
                    u32x4 w; w.x = cvtpk(h0.x, h0.y); w.y = cvtpk(h0.z, h0.w); w.z = cvtpk(h1.x, h1.y); w.w = cvtpk(h1.z, h1.w);
                    *(u32x4*)(xn + off) = w;
                }
    }
};

struct EpiF32 {
    static constexpr bool PERM = true, AFTER_DRAIN = false;
    float* C; int ldc;
    DI void operator()(const f32x4 (&acc)[2][2][4][2], const pg8::Unit& u, int wr, int wc, int fr, int fq) const {
        const int row0 = u.pm * 256 + wr * 64 + fr, col0 = u.pn * 256 + wc * 32 + 8 * fq;
#pragma unroll
        for (int ai = 0; ai < 2; ++ai)
#pragma unroll
            for (int m = 0; m < 4; ++m)
#pragma unroll
                for (int bj = 0; bj < 2; ++bj) {
                    float* p = C + (size_t)(row0 + ai * 128 + m * 16) * ldc + col0 + bj * 128;
                    *(f32x4*)p = acc[ai][bj][m][0]; *(f32x4*)(p + 4) = acc[ai][bj][m][1];
                }
    }
};

struct EpiBf {
    static constexpr bool PERM = true, AFTER_DRAIN = false;
    bf16_t* C; int ldc;
    DI void operator()(const f32x4 (&acc)[2][2][4][2], const pg8::Unit& u, int wr, int wc, int fr, int fq) const {
        const int row0 = u.pm * 256 + wr * 64 + fr, col0 = u.pn * 256 + wc * 32 + 8 * fq;
#pragma unroll
        for (int ai = 0; ai < 2; ++ai)
#pragma unroll
            for (int m = 0; m < 4; ++m)
#pragma unroll
                for (int bj = 0; bj < 2; ++bj) {
                    const f32x4 v0 = acc[ai][bj][m][0], v1 = acc[ai][bj][m][1];
                    u32x4 w; w.x = cvtpk(v0.x, v0.y); w.y = cvtpk(v0.z, v0.w); w.z = cvtpk(v1.x, v1.y); w.w = cvtpk(v1.z, v1.w);
                    *(u32x4*)(C + (size_t)(row0 + ai * 128 + m * 16) * ldc + col0 + bj * 128) = w;
                }
    }
};

struct EpiGate {
    static constexpr bool PERM = true, AFTER_DRAIN = false;
    float* out; const bf16_t* pw; const float* ssq;
    DI void operator()(const f32x4 (&acc)[2][2][4][2], const pg8::Unit& u, int wr, int wc, int fr, int fq) const {
        const int row0 = u.pm * 256 + wr * 64 + fr, col0 = u.pn * 256 + wc * 32 + 8 * fq;
#pragma unroll
        for (int ai = 0; ai < 2; ++ai)
#pragma unroll
            for (int m = 0; m < 4; ++m) {
                const int row = row0 + ai * 128 + m * 16;
                float sq = 0.f;
#pragma unroll
                for (int x = 0; x < 8; ++x) sq += ssq[(size_t)x * T + row];
                const float rs3 = rsqrtf(sq * (1.f / 1024.f) + EPS);
#pragma unroll
                for (int bj = 0; bj < 2; ++bj) {
                    const size_t off = (size_t)row * 1024 + col0 + bj * 128;
                    const bf16x8 pv = *(const bf16x8*)(pw + off);
                    const f32x4 h0 = *(const f32x4*)(out + off), h1 = *(const f32x4*)(out + off + 4);
                    const f32x4 g0 = acc[ai][bj][m][0] * rs3, g1 = acc[ai][bj][m][1] * rs3;
                    f32x4 o0, o1;
#pragma unroll
                    for (int i = 0; i < 4; ++i) { o0[i] = h0[i] + bf2f(pv[i]) / (1.f + __expf(-g0[i])); o1[i] = h1[i] + bf2f(pv[4 + i]) / (1.f + __expf(-g1[i])); }
                    *(f32x4*)(out + off) = o0; *(f32x4*)(out + off + 4) = o1;
                }
            }
    }
};

template <class Epi>
DI void gemm_simple(const bf16_t* A, const bf16_t* Bt, int M, int N, int K, const Epi& epi, int gwave, int nwaves, int lane) {
    const int r32 = lane & 31, hi = lane >> 5;
    const int nNt = N / 64, total = (M / 32) * nNt;
    for (int tile = gwave; tile < total; tile += nwaves) {
        const int mt = tile / nNt, nt = tile - mt * nNt, m0 = mt * 32, n0 = nt * 64;
        const bf16_t* ap = A + (size_t)(m0 + r32) * K + 8 * hi;
        const bf16_t* b0p = Bt + (size_t)(n0 + r32) * K + 8 * hi;
        const bf16_t* b1p = b0p + (size_t)32 * K;
        f32x16 acc0 = zero16(), acc1 = zero16();
#pragma unroll 4
        for (int k = 0; k < K; k += 16) {
            const bf16x8 xa = *(const bf16x8*)(ap + k);
            const bf16x8 w0 = *(const bf16x8*)(b0p + k);
            const bf16x8 w1 = *(const bf16x8*)(b1p + k);
            acc0 = MFMA32(w0, xa, acc0);
            acc1 = MFMA32(w1, xa, acc1);
        }
        epi(m0 + r32, n0, hi, acc0, acc1);
    }
}

struct Epi1 {
    bf16_t* base6;
    const float *qn, *kn;
    DI void operator()(int tok, int n0, int hi, const f32x16& a0, const f32x16& a1) const {
        const int head48 = n0 >> 6, typ = head48 >> 3, h = head48 & 7;
        bf16_t* reg = base6 + (size_t)typ * (16u << 19);
        if (typ == 2 || typ == 5) {
            const int b = tok >> 11, s = tok & 2047;
            const int pos = (s & ~12) | ((s & 4) << 1) | ((s & 8) >> 1);
            bf16_t* base = reg + ((size_t)(b * 8 + h) * 64) * 2048 + pos;
#pragma unroll
            for (int r = 0; r < 16; ++r) { base[(size_t)crow(r, hi) * 2048] = f2bf(a0[r]); base[(size_t)(32 + crow(r, hi)) * 2048] = f2bf(a1[r]); }
        } else {
            float rs = 1.f;
            const bool nrm = (typ == 0 || typ == 1);
            if (nrm) { float ss = 0.f;
#pragma unroll
                for (int r = 0; r < 16; ++r) ss += a0[r] * a0[r] + a1[r] * a1[r];
                ss += __shfl_xor(ss, 32);
                rs = rsqrtf(ss * (1.f / 64.f) + EPS); }
            const float* g = (typ == 0) ? qn : kn;
            bf16_t* dst = reg + (size_t)tok * 512 + h * 64;
#pragma unroll
            for (int t = 0; t < 2; ++t)
#pragma unroll
                for (int g4 = 0; g4 < 4; ++g4) {
                    const int f0 = 32 * t + 8 * g4 + 4 * hi;
                    float v[4];
#pragma unroll
                    for (int i = 0; i < 4; ++i) { const float a = t ? a1[4 * g4 + i] : a0[4 * g4 + i]; v[i] = nrm ? a * rs * g[f0 + i] : a; }
                    u32x2 w; w.x = cvtpk(v[0], v[1]); w.y = cvtpk(v[2], v[3]);
                    *(u32x2*)(dst + f0) = w;
                }
        }
    }
};

struct Epi2 {
    const float* x; float* out; bf16_t* xn;
    DI void operator()(int tok, int n0, int hi, const f32x16& a0, const f32x16& a1) const {
#pragma unroll
        for (int t = 0; t < 2; ++t)
#pragma unroll
            for (int g4 = 0; g4 < 4; ++g4) {
                const size_t off = (size_t)tok * 1024 + n0 + 32 * t + 8 * g4 + 4 * hi;
                const f32x4 xv = *(const f32x4*)(x + off);
                f32x4 hv;
#pragma unroll
                for (int i = 0; i < 4; ++i) hv[i] = xv[i] + (t ? a1[4 * g4 + i] : a0[4 * g4 + i]);
                *(f32x4*)(out + off) = hv;
                u32x2 w; w.x = cvtpk(hv[0], hv[1]); w.y = cvtpk(hv[2], hv[3]);
                *(u32x2*)(xn + off) = w;
            }
    }
};

struct Epi3 {
    float* sc;
    DI void operator()(int tok, int n0, int hi, const f32x16& a0, const f32x16& a1) const {
#pragma unroll
        for (int t = 0; t < 2; ++t)
#pragma unroll
            for (int g4 = 0; g4 < 4; ++g4) {
                f32x4 v;
#pragma unroll
                for (int i = 0; i < 4; ++i) v[i] = t ? a1[4 * g4 + i] : a0[4 * g4 + i];
                *(f32x4*)(sc + (size_t)tok * 2048 + n0 + 32 * t + 8 * g4 + 4 * hi) = v;
            }
    }
};

DI void pv_accum(f32x16& o0, f32x16& o1, const f32x16& p, const bf16_t* vt_row) {
#pragma unroll
    for (int s = 0; s < 2; ++s) {
        u32x4 pk; pk.x = cvtpk(p[8 * s], p[8 * s + 1]); pk.y = cvtpk(p[8 * s + 2], p[8 * s + 3]); pk.z = cvtpk(p[8 * s + 4], p[8 * s + 5]); pk.w = cvtpk(p[8 * s + 6], p[8 * s + 7]);
        const bf16x8 pb = __builtin_bit_cast(bf16x8, pk);
        const bf16x8 v0 = *(const bf16x8*)(vt_row + 16 * s);
        const bf16x8 v1 = *(const bf16x8*)(vt_row + (size_t)32 * 2048 + 16 * s);
        o0 = MFMA32(v0, pb, o0);
        o1 = MFMA32(v1, pb, o1);
    }
}

DI void store_o(bf16_t* op, const f32x16& o0, const f32x16& o1, float inv, int hi) {
#pragma unroll
    for (int t = 0; t < 2; ++t)
#pragma unroll
        for (int g4 = 0; g4 < 4; ++g4) {
            u32x2 w;
            if (t == 0) { w.x = cvtpk(o0[4 * g4] * inv, o0[4 * g4 + 1] * inv); w.y = cvtpk(o0[4 * g4 + 2] * inv, o0[4 * g4 + 3] * inv); }
            else        { w.x = cvtpk(o1[4 * g4] * inv, o1[4 * g4 + 1] * inv); w.y = cvtpk(o1[4 * g4 + 2] * inv, o1[4 * g4 + 3] * inv); }
            *(u32x2*)(op + 32 * t + 8 * g4 + 4 * hi) = w;
        }
}

constexpr int OT_PITCH = 1040;
DI void store_o_lds(LAS unsigned char* ot, int r32, int h, const f32x16& o0, const f32x16& o1, float inv, int hi) {
    LAS unsigned char* op = ot + r32 * OT_PITCH + h * 128;
#pragma unroll
    for (int t = 0; t < 2; ++t)
#pragma unroll
        for (int g4 = 0; g4 < 4; ++g4) {
            u32x2 w;
            if (t == 0) { w.x = cvtpk(o0[4 * g4] * inv, o0[4 * g4 + 1] * inv); w.y = cvtpk(o0[4 * g4 + 2] * inv, o0[4 * g4 + 3] * inv); }
            else        { w.x = cvtpk(o1[4 * g4] * inv, o1[4 * g4 + 1] * inv); w.y = cvtpk(o1[4 * g4 + 2] * inv, o1[4 * g4 + 3] * inv); }
            *(LAS u32x2*)(op + (32 * t + 8 * g4 + 4 * hi) * 2) = w;
        }
}
DI void load_kfrag(bf16x8 (&kf)[4], const bf16_t* fbase  , int tile) {
    const bf16_t* kp = fbase + (size_t)tile * 2048;
#pragma unroll
    for (int s = 0; s < 4; ++s) kf[s] = *(const bf16x8*)(kp + s * 512);
}
DI void load_vfrag(bf16x8 (&vf)[4], const bf16_t* fbase, int tile) {
    const bf16_t* vp = fbase + (size_t)tile * 2048;
#pragma unroll
    for (int q = 0; q < 4; ++q) vf[q] = *(const bf16x8*)(vp + q * 512);
}
DI void pv_accum2(f32x16& o0, f32x16& o1, const f32x16& p, const bf16x8 (&vf)[4]) {
#pragma unroll
    for (int s = 0; s < 2; ++s) {
        u32x4 pk; pk.x = cvtpk(p[8 * s], p[8 * s + 1]); pk.y = cvtpk(p[8 * s + 2], p[8 * s + 3]); pk.z = cvtpk(p[8 * s + 4], p[8 * s + 5]); pk.w = cvtpk(p[8 * s + 6], p[8 * s + 7]);
        const bf16x8 pb = __builtin_bit_cast(bf16x8, pk);
        o0 = MFMA32(vf[2 * s], pb, o0);
        o1 = MFMA32(vf[2 * s + 1], pb, o1);
    }
}

DI void moba_unit(int b, int h, int qt, const bf16_t* Qm_, const bf16_t* Km_, const bf16_t* VtM_, const float* kmean_, const float* biasTab_, LAS unsigned char* ot, int lane) {
    const int r32 = lane & 31, hi = lane >> 5;
    const int q0 = qt * 32, tq = q0 + r32, blk = q0 >> 8;
    const size_t qrow = (size_t)(b * 2048 + tq);
    const size_t bh = (size_t)(b * 8 + h);
    const bf16_t* qfb = Qm_ + bh * (64 * 2048) + (size_t)qt * 2048;
    bf16x8 qf[4];
#pragma unroll
    for (int s = 0; s < 4; ++s) qf[s] = *(const bf16x8*)(qfb + s * 512 + lane * 8);
    unsigned selmask = 0;
    if (blk > 0) {
        float qv[32];
#pragma unroll
        for (int c = 0; c < 4; ++c) { const bf16x8 t = *(const bf16x8*)(qfb + (2 * hi + (c >> 1)) * 512 + ((c & 1) * 32 + r32) * 8);
#pragma unroll
            for (int j = 0; j < 8; ++j) qv[8 * c + j] = bf2f(t[j]); }
        const float* km = kmean_ + (size_t)((b * 8 + h) * 8) * 64 + 32 * hi;
        float g[8];
#pragma unroll
        for (int n = 0; n < 8; ++n) {
            float a = 0.f;
            if (n < blk) {
#pragma unroll
                for (int d4 = 0; d4 < 8; ++d4) { const f32x4 kv = *(const f32x4*)(km + n * 64 + 4 * d4); a += (qv[4 * d4] * kv.x + qv[4 * d4 + 1] * kv.y) + (qv[4 * d4 + 2] * kv.z + qv[4 * d4 + 3] * kv.w); }
            }
            a += __shfl_xor(a, 32);
            g[n] = (n < blk) ? a : -INFINITY;
        }
#pragma unroll
        for (int n = 0; n < 8; ++n) {
            int rank = 0;
#pragma unroll
            for (int m = 0; m < 8; ++m) if (m != n) rank += ((g[m] > g[n]) || (g[m] == g[n] && m < n)) ? 1 : 0;
            if (n < blk && rank < 3) selmask |= 1u << n;
        }
    }
    unsigned anysel = 0;
#pragma unroll
    for (int n = 0; n < 8; ++n) if (__any((selmask >> n) & 1u)) anysel |= 1u << n;
    anysel = __builtin_amdgcn_readfirstlane(anysel);
    float mrun = -1e30f, lsum = 0.f;
    f32x16 o0 = zero16(), o1 = zero16();
    const bf16_t* kbase = Km_ + bh * (64 * 2048) + lane * 8;
    const bf16_t* vbase = VtM_ + bh * (64 * 2048) + lane * 8;
    const float* bt = biasTab_ + h * 132;
    const float bfar = bt[128];
    int kt = qt;
    bf16x8 kf[4], kfn[4], vf[4];
    load_kfrag(kf, kbase, kt);
    while (kt >= 0) {
        const int n = kt >> 3, key0 = kt * 32;
        load_vfrag(vf, vbase, kt);
        int nkt = kt - 1;
        while (nkt >= 0) { const int nn = nkt >> 3; if (nn == blk || ((anysel >> nn) & 1u)) break; nkt = nn * 8 - 1; }
        if (nkt >= 0) load_kfrag(kfn, kbase, nkt);
        f32x16 st = zero16();
#pragma unroll
        for (int s = 0; s < 4; ++s) st = MFMA32(kf[s], qf[s], st);
        float x[16];
        if (n != blk) {
            const bool selq = (selmask >> n) & 1u;
            if ((q0 - (key0 + 31)) >= 128) {
                const float addend = selq ? bfar : -1e30f;
#pragma unroll
                for (int r = 0; r < 16; ++r) x[r] = st[r] * SCL2 + addend;
            } else {
#pragma unroll
                for (int r = 0; r < 16; ++r) { const int dist = tq - (key0 + crow(r, hi)); const float v = st[r] * SCL2 + bt[dist > 128 ? 128 : dist]; x[r] = selq ? v : -1e30f; }
            }
        } else {
#pragma unroll
            for (int r = 0; r < 16; ++r) { const int dist = tq - (key0 + crow(r, hi)); const float v = st[r] * SCL2 + bt[dist < 0 ? 0 : (dist > 128 ? 128 : dist)]; x[r] = (dist >= 0) ? v : -1e30f; }
        }
        float mx = x[0];
#pragma unroll
        for (int r = 1; r < 16; ++r) mx = fmaxf(mx, x[r]);
        mx = fmaxf(mx, __shfl_xor(mx, 32));
        const float mnew = fmaxf(mrun, mx);
        if (!__all(mnew == mrun)) {
            const float alpha = __builtin_amdgcn_exp2f(mrun - mnew);
            lsum *= alpha;
#pragma unroll
            for (int r = 0; r < 16; ++r) { o0[r] *= alpha; o1[r] *= alpha; }
            mrun = mnew;
        }
        f32x16 pr; float ps = 0.f;
#pragma unroll
        for (int r = 0; r < 16; ++r) { const float e = __builtin_amdgcn_exp2f(x[r] - mrun); pr[r] = e; ps += e; }
        lsum += ps;
        pv_accum2(o0, o1, pr, vf);
#pragma unroll
        for (int s = 0; s < 4; ++s) kf[s] = kfn[s];
        kt = nkt;
    }
    lsum += __shfl_xor(lsum, 32);
    const float inv = 1.f / lsum;
    store_o_lds(ot, r32, h, o0, o1, inv, hi);
}

DI void sb_unit(int b, int h, int qt, const bf16_t* Qs_, const bf16_t* Ks_, const bf16_t* VtS_, LAS unsigned char* ot, int lane) {
    const int r32 = lane & 31, hi = lane >> 5;
    const int q0 = qt * 32, tq = q0 + r32;
    const size_t qrow = (size_t)(b * 2048 + tq);
    const size_t bh = (size_t)(b * 8 + h);
    const bf16_t* qfb = Qs_ + bh * (64 * 2048) + (size_t)qt * 2048;
    bf16x8 qf[4];
#pragma unroll
    for (int s = 0; s < 4; ++s) qf[s] = *(const bf16x8*)(qfb + s * 512 + lane * 8);
    f32x16 o0 = zero16(), o1 = zero16();
    const bf16_t* kbase = Ks_ + bh * (64 * 2048) + lane * 8;
    const bf16_t* vbase = VtS_ + bh * (64 * 2048) + lane * 8;
    float C = 1.f;
    bf16x8 kf[4], kfn[4], vf[4];
    load_kfrag(kf, kbase, qt);
    for (int kt = qt; kt >= 0; --kt) {
        const int key0 = kt * 32;
        load_vfrag(vf, vbase, kt);
        if (kt > 0) load_kfrag(kfn, kbase, kt - 1);
        f32x16 st = zero16();
#pragma unroll
        for (int s = 0; s < 4; ++s) st = MFMA32(kf[s], qf[s], st);
        float rr[16], be[16];
#pragma unroll
        for (int r = 0; r < 16; ++r) {
            const int key = key0 + crow(r, hi);
            const float y = fminf(st[r] * SCL2, 100.f);
            const float e = __builtin_amdgcn_exp2f(y);
            const float ri = __builtin_amdgcn_rcpf(1.f + e);
            const bool ok = key < tq;
            rr[r] = ok ? ri : 1.f;
            be[r] = ok ? e * ri : 0.f;
        }
        float G[4], ex[16], Gp[4], Tt[4], Suf[4];
#pragma unroll
        for (int a = 0; a < 4; ++a) {
            ex[4 * a + 3] = 1.f; ex[4 * a + 2] = rr[4 * a + 3]; ex[4 * a + 1] = ex[4 * a + 2] * rr[4 * a + 2]; ex[4 * a] = ex[4 * a + 1] * rr[4 * a + 1];
            G[a] = ex[4 * a] * rr[4 * a];
        }
#pragma unroll
        for (int a = 0; a < 4; ++a) { Gp[a] = __shfl_xor(G[a], 32); Tt[a] = G[a] * Gp[a]; }
        Suf[3] = 1.f; Suf[2] = Tt[3]; Suf[1] = Tt[3] * Tt[2]; Suf[0] = Suf[1] * Tt[1];
        f32x16 pr;
#pragma unroll
        for (int a = 0; a < 4; ++a) {
            const float after = Suf[a] * (hi == 0 ? Gp[a] : 1.f) * C;
#pragma unroll
            for (int i = 0; i < 4; ++i) pr[4 * a + i] = be[4 * a + i] * ex[4 * a + i] * after;
        }
        C = C * (Suf[0] * Tt[0]);
        pv_accum2(o0, o1, pr, vf);
        if (__all(C == 0.f ? 1 : 0)) break;
#pragma unroll
        for (int s = 0; s < 4; ++s) kf[s] = kfn[s];
    }
    store_o_lds(ot, r32, h, o0, o1, 1.f, hi);
}

DI void ce_desc(unsigned& a, unsigned& b) { const unsigned hi = a > b ? a : b, lo = a > b ? b : a; a = hi; b = lo; }
DI void bitonic_clean_desc(unsigned (&v)[16]) {
#pragma unroll
    for (int s = 8; s >= 1; s >>= 1)
#pragma unroll
        for (int i = 0; i < 16; ++i) if ((i & s) == 0) ce_desc(v[i], v[i + s]);
}
DI void sort16_desc(unsigned (&v)[16]) {
#pragma unroll
    for (int k = 2; k <= 16; k <<= 1)
#pragma unroll
        for (int j = k >> 1; j >= 1; j >>= 1)
#pragma unroll
            for (int i = 0; i < 16; ++i) { const int l = i ^ j; if (l > i) { if ((i & k) == 0) ce_desc(v[i], v[l]); else ce_desc(v[l], v[i]); } }
}
DI float key_value(unsigned key) { const unsigned kk = key & ~127u; const unsigned u = (kk & 0x80000000u) ? (kk & 0x7fffffffu) : ~kk; return __builtin_bit_cast(float, u); }

DI float reduce16(const float (&p)[16], int lane) {
    const bool b3 = lane & 8, b2 = lane & 4, b1 = lane & 2, b0 = lane & 1;
    float q[8], r[4], s[2];
#pragma unroll
    for (int i = 0; i < 8; ++i) { const float mine = b3 ? p[i + 8] : p[i], send = b3 ? p[i] : p[i + 8]; q[i] = mine + __shfl_xor(send, 8); }
#pragma unroll
    for (int i = 0; i < 4; ++i) { const float mine = b2 ? q[i + 4] : q[i], send = b2 ? q[i] : q[i + 4]; r[i] = mine + __shfl_xor(send, 4); }
#pragma unroll
    for (int i = 0; i < 2; ++i) { const float mine = b1 ? r[i + 2] : r[i], send = b1 ? r[i] : r[i + 2]; s[i] = mine + __shfl_xor(send, 2); }
    const float mine = b0 ? s[1] : s[0], send = b0 ? s[0] : s[1];
    float t = mine + __shfl_xor(send, 1);
    t += __shfl_xor(t, 16);
    t += __shfl_xor(t, 32);
    return t;
}

#ifndef PEER_REP_TOPK
#define PEER_REP_TOPK 1
#endif
#ifndef PEER_REP_U
#define PEER_REP_U 1
#endif
#ifndef PEER_REP_V
#define PEER_REP_V 1
#endif
struct TopkIn { f32x4 hv[4]; bf16x8 sv[4]; };
DI void peer_topk_load(TopkIn& in, int tok, const float* out, const bf16_t* scores, int lane) {
    const int tc = tok < T ? tok : T - 1;
    const float* hrow = out + (size_t)tc * 1024 + 16 * lane;
    const bf16_t* sp = scores + (size_t)tc * 2048 + (lane >> 2) * 128 + (lane & 3) * 8;
#pragma unroll
    for (int i = 0; i < 4; ++i) { in.hv[i] = *(const f32x4*)(hrow + 4 * i); in.sv[i] = *(const bf16x8*)(sp + 32 * i); }
}
DI void peer_topk_token(int tok, const TopkIn& in, const float* gffn, int* EIDXg, float* GATEg, unsigned char* XN2g, LAS float* wl, int lane) {
    LAS unsigned* kbuf = (LAS unsigned*)wl; LAS unsigned* cand = (LAS unsigned*)(wl + 256); const LAS unsigned* ctab = (const LAS unsigned*)(wl + 768);
    f32x4 hv[4];
    float ss = 0.f;
#pragma unroll
    for (int i = 0; i < 4; ++i) { hv[i] = in.hv[i]; ss += (hv[i].x * hv[i].x + hv[i].y * hv[i].y) + (hv[i].z * hv[i].z + hv[i].w * hv[i].w); }
    ss = wave_sum(ss);
    const float rs2 = rsqrtf(ss * (1.f / 1024.f) + EPS);
    {
        u32x4 w;
#pragma unroll
        for (int i = 0; i < 4; ++i) { const f32x4 gv = *(const f32x4*)(gffn + 16 * lane + 4 * i);
            const float y0 = fminf(fmaxf(hv[i][0] * rs2 * gv[0] * 64.f, -448.f), 448.f), y1 = fminf(fmaxf(hv[i][1] * rs2 * gv[1] * 64.f, -448.f), 448.f);
            const float y2 = fminf(fmaxf(hv[i][2] * rs2 * gv[2] * 64.f, -448.f), 448.f), y3 = fminf(fmaxf(hv[i][3] * rs2 * gv[3] * 64.f, -448.f), 448.f);
            int p = 0;
            p = __builtin_amdgcn_cvt_pk_fp8_f32(y0, y1, p, false);
            p = __builtin_amdgcn_cvt_pk_fp8_f32(y2, y3, p, true);
            w[i] = (unsigned)p; }
        *(u32x4*)(XN2g + (size_t)tok * 1024 + 16 * lane) = w;
    }
    {
        const int L = lane >> 2, q = lane & 3;
        unsigned k0[16], k1[16];
#pragma unroll
        for (int i = 0; i < 4; ++i) {
            const bf16x8 v = in.sv[i];
#pragma unroll
            for (int cI = 0; cI < 8; ++cI) {
                const unsigned u = ((unsigned)(unsigned short)v[cI]) << 16;
                const unsigned mono = (u & 0x80000000u) ? ~u : (u | 0x80000000u);
                const unsigned key = (mono & ~127u) | (unsigned)(127 - (32 * i + 8 * q + cI));
                if (i < 2) k0[8 * i + cI] = key; else k1[8 * (i - 2) + cI] = key;
            }
        }
        sort16_desc(k0); sort16_desc(k1);
        unsigned t[16];
#pragma unroll
        for (int i = 0; i < 16; ++i) t[i] = k0[i] > k1[15 - i] ? k0[i] : k1[15 - i];
        bitonic_clean_desc(t);
#pragma unroll
        for (int i = 0; i < 16; ++i) k0[i] = (unsigned)__builtin_amdgcn_update_dpp(0, (int)t[15 - i], 0xB1, 0xF, 0xF, true);
#pragma unroll
        for (int i = 0; i < 16; ++i) t[i] = t[i] > k0[i] ? t[i] : k0[i];
        bitonic_clean_desc(t);
#pragma unroll
        for (int i = 0; i < 16; ++i) k0[i] = (unsigned)__builtin_amdgcn_update_dpp(0, (int)t[15 - i], 0x4E, 0xF, 0xF, true);
#pragma unroll
        for (int i = 0; i < 16; ++i) t[i] = t[i] > k0[i] ? t[i] : k0[i];
        bitonic_clean_desc(t);
        if (q == 0) {
#pragma unroll
            for (int i = 0; i < 4; ++i) { u32x4 w; w.x = t[4 * i]; w.y = t[4 * i + 1]; w.z = t[4 * i + 2]; w.w = t[4 * i + 3]; *(LAS u32x4*)(kbuf + L * 16 + 4 * i) = w; }
        }
        asm volatile("s_waitcnt lgkmcnt(0)" ::: "memory");
    }
    {
        const int hd = lane >> 3, sub = lane & 7;
        unsigned ck[7]; int ce[7]; float cv[7];
#pragma unroll
        for (int k = 0; k < 7; ++k) {
            const int cidx = 7 * sub + k;
            const unsigned tab = ctab[cidx];
            const unsigned ka = kbuf[hd * 32 + (tab & 15u)], kb = kbuf[hd * 32 + 16 + ((tab >> 8) & 15u)];
            const float v = key_value(ka) + key_value(kb);
            cv[k] = v;
            ce[k] = (127 - (int)(ka & 127u)) * 128 + (127 - (int)(kb & 127u));
            const unsigned u = __float_as_uint(v);
            const unsigned mono = (u & 0x80000000u) ? ~u : (u | 0x80000000u);
            ck[k] = (cidx < 50) ? ((mono & ~63u) | (unsigned)(63 - cidx)) : 0u;
            cand[hd * 64 + cidx] = ck[k];
        }
        asm volatile("s_waitcnt lgkmcnt(0)" ::: "memory");
        int rank[7];
#pragma unroll
        for (int k = 0; k < 7; ++k) rank[k] = 0;
#pragma unroll
        for (int c4 = 0; c4 < 13; ++c4) {
            const u32x4 o4 = *(const LAS u32x4*)(cand + hd * 64 + 4 * c4);
#pragma unroll
            for (int i = 0; i < 4; ++i) if (4 * c4 + i < 50) {
#pragma unroll
                for (int k = 0; k < 7; ++k) rank[k] += (o4[i] > ck[k]) ? 1 : 0;
            }
        }
        float mx = -INFINITY;
#pragma unroll
        for (int k = 0; k < 7; ++k) mx = fmaxf(mx, (7 * sub + k < 50) ? cv[k] : -INFINITY);
        mx = fmaxf(mx, __shfl_xor(mx, 1)); mx = fmaxf(mx, __shfl_xor(mx, 2)); mx = fmaxf(mx, __shfl_xor(mx, 4));
        float ev[7], es = 0.f;
#pragma unroll
        for (int k = 0; k < 7; ++k) { const bool selk = (7 * sub + k < 50) && rank[k] < 16; ev[k] = selk ? __expf((cv[k] - mx) * rs2) : 0.f; es += ev[k]; }
        es += __shfl_xor(es, 1); es += __shfl_xor(es, 2); es += __shfl_xor(es, 4);
        const float inv = 1.f / es;
#pragma unroll
        for (int k = 0; k < 7; ++k) if ((7 * sub + k < 50) && rank[k] < 16) { EIDXg[(size_t)tok * 128 + hd * 16 + rank[k]] = ce[k]; GATEg[(size_t)tok * 128 + hd * 16 + rank[k]] = ev[k] * inv; }
    }
}

DI float dot16_fp8(const u32x4& row, const float (&x)[16]) {
    float sacc = 0.f;
#pragma unroll
    for (int w = 0; w < 4; ++w) { const f32x2 lo = __builtin_amdgcn_cvt_pk_f32_fp8((int)row[w], false), hi2 = __builtin_amdgcn_cvt_pk_f32_fp8((int)row[w], true);
        sacc += lo.x * x[4 * w] + lo.y * x[4 * w + 1] + hi2.x * x[4 * w + 2] + hi2.y * x[4 * w + 3]; }
    return sacc;
}
template <class TT> DI TT ldu(const void* ubase, unsigned off) { return *(const TT*)((const char*)ubase + off); }
typedef _Float16 h2_t __attribute__((ext_vector_type(2)));
DI void peer_u_slice(int sl, int tk_first, int tk_step, const unsigned char* XN8g, const int* EIDXg, const unsigned char* U8s, float* PDOT, int lane) {
    const int es = lane >> 3, c = lane & 7;
    const unsigned char* tb = U8s + (size_t)sl * 16384 * 128;
    const unsigned c16 = 16u * c, eoff = 64u * es, xoff = 128u * sl + 16u * c, poff = (16u * es + c) * 4u;
    const bool b2 = c & 4, b1 = c & 2, b0 = c & 1;
    u32x4 I0[2], I1[2], I2[2], rowsA[8], rowsB[8], rowsC[8], x0, x1, x2;
#define LD_E8(ib, tk, h) do { const int _t = (tk) < T ? (tk) : T - 1; const int* _eb = EIDXg + (size_t)_t * 128 + 8 * (h); ib[0] = ldu<u32x4>(_eb, eoff); ib[1] = ldu<u32x4>(_eb, eoff + 16u); } while (0)
#define LD_R8(rows, ib, tbl) do { _Pragma("unroll") for (int _q = 0; _q < 2; ++_q) _Pragma("unroll") for (int _r = 0; _r < 4; ++_r) rows[4 * _q + _r] = ldu<u32x4>(tbl, ib[_q][_r] * 128u + c16); } while (0)
#define LD_X(xx, tk) do { const int _t = (tk) < T ? (tk) : T - 1; xx = ldu<u32x4>(XN8g + (size_t)_t * 1024, xoff); } while (0)
#define U_COMPUTE8(rows, xx, tk, h) do { h2_t _x[8]; _Pragma("unroll") for (int _w = 0; _w < 4; ++_w) { _x[2 * _w] = __builtin_amdgcn_cvt_scalef32_pk_f16_fp8(xx[_w], 1.0f, false); _x[2 * _w + 1] = __builtin_amdgcn_cvt_scalef32_pk_f16_fp8(xx[_w], 1.0f, true); } \
        float _p[8]; _Pragma("unroll") for (int _i = 0; _i < 8; ++_i) { if (_i > 0) asm volatile("" : "+v"(rows[_i]) : "v"(_p[_i - 1])); float _s = 0.f; \
            _Pragma("unroll") for (int _w = 0; _w < 4; ++_w) { _s = __builtin_amdgcn_fdot2(__builtin_amdgcn_cvt_scalef32_pk_f16_fp8(rows[_i][_w], 1.0f, false), _x[2 * _w], _s, false); \
                _s = __builtin_amdgcn_fdot2(__builtin_amdgcn_cvt_scalef32_pk_f16_fp8(rows[_i][_w], 1.0f, true), _x[2 * _w + 1], _s, false); } _p[_i] = _s; } \
        float _q4[4], _q2[2]; \
        _Pragma("unroll") for (int _k = 0; _k < 4; ++_k) { const float _m = b2 ? _p[_k + 4] : _p[_k], _s = b2 ? _p[_k] : _p[_k + 4]; _q4[_k] = _m + __shfl_xor(_s, 4); } \
        _Pragma("unroll") for (int _k = 0; _k < 2; ++_k) { const float _m = b1 ? _q4[_k + 2] : _q4[_k], _s = b1 ? _q4[_k] : _q4[_k + 2]; _q2[_k] = _m + __shfl_xor(_s, 2); } \
        const float _m = b0 ? _q2[1] : _q2[0], _s = b0 ? _q2[0] : _q2[1]; const float _r1 = _m + __shfl_xor(_s, 1); \
        if ((tk) < T) { float* _pb = PDOT + ((size_t)sl * T + (tk)) * 128 + 8 * (h); *(float*)((char*)_pb + poff) = _r1; } } while (0)
    int t0 = tk_first;
    LD_E8(I0, t0, 0); LD_E8(I1, t0, 1); LD_E8(I2, t0 + tk_step, 0); LD_X(x0, t0); LD_R8(rowsA, I0, tb); LD_R8(rowsB, I1, tb);
#pragma unroll 1
    for (; t0 < T; t0 += 3 * tk_step) {
        const int t1 = t0 + tk_step, t2 = t1 + tk_step, t3 = t2 + tk_step;
        LD_E8(I0, t1, 1);           LD_R8(rowsC, I2, tb); LD_X(x1, t1); U_COMPUTE8(rowsA, x0, t0, 0);
        LD_E8(I1, t2, 0);           LD_R8(rowsA, I0, tb);               U_COMPUTE8(rowsB, x0, t0, 1);
        LD_E8(I2, t2, 1);           LD_R8(rowsB, I1, tb); LD_X(x2, t2); U_COMPUTE8(rowsC, x1, t1, 0);
        LD_E8(I0, t3, 0);           LD_R8(rowsC, I2, tb);               U_COMPUTE8(rowsA, x1, t1, 1);
        LD_E8(I1, t3, 1);           LD_R8(rowsA, I0, tb); LD_X(x0, t3); U_COMPUTE8(rowsB, x2, t2, 0);
        LD_E8(I2, t3 + tk_step, 0); LD_R8(rowsB, I1, tb);               U_COMPUTE8(rowsC, x2, t2, 1);
    }
#undef U_COMPUTE8
#undef LD_X
}
template <int NT> DI void peer_cj_tokens(int tok0, int tstride, const int* EIDXg, const float* GATEg, const float* PDOT, const float* usc, const float* vsc, float* CJg, float* CMAXg, int lane) {
    int e[NT][2]; float d[NT][2], g[NT][2];
#pragma unroll
    for (int i = 0; i < NT; ++i) { const int tok = tok0 + i * tstride, tc = tok < T ? tok : T - 1;
#pragma unroll
        for (int hh = 0; hh < 2; ++hh) { const int j = lane + 64 * hh; e[i][hh] = EIDXg[(size_t)tc * 128 + j]; g[i][hh] = GATEg[(size_t)tc * 128 + j]; float a = 0.f;
#pragma unroll
            for (int x = 0; x < 8; ++x) a += PDOT[((size_t)x * T + tc) * 128 + j];
            d[i][hh] = a; } }
    float us[NT][2], vs[NT][2];
#pragma unroll
    for (int i = 0; i < NT; ++i)
#pragma unroll
        for (int hh = 0; hh < 2; ++hh) { us[i][hh] = usc[e[i][hh]]; vs[i][hh] = vsc[e[i][hh]]; }
#pragma unroll
    for (int i = 0; i < NT; ++i) { const int tok = tok0 + i * tstride;
        float cv[2], cm = 0.f;
#pragma unroll
        for (int hh = 0; hh < 2; ++hh) {
            const float hraw = d[i][hh] * us[i][hh] * (1.f / 64.f);
            const float hid = 0.5f * hraw * (1.f + erff(hraw * 0.70710678118654752f));
            cv[hh] = hid * g[i][hh] * vs[i][hh];
            cm = fmaxf(cm, fabsf(cv[hh]));
        }
#pragma unroll
        for (int o = 1; o < 64; o <<= 1) cm = fmaxf(cm, __shfl_xor(cm, o));
        const float inv = cm > 0.f ? 1.f / cm : 0.f;
        if (tok < T) { CJg[(size_t)tok * 128 + lane] = cv[0] * inv; CJg[(size_t)tok * 128 + 64 + lane] = cv[1] * inv; if (lane == 0) CMAXg[tok] = cm; }
    }
}
DI void peer_v_slice(int sl, int tk_first, int tk_step, float* out, const int* EIDXg, const float* CJg, const float* CMAXg, const unsigned char* V8s, bf16_t* A4g, float* SSQg, int lane) {
    const int es = lane >> 3, c = lane & 7;
    const unsigned char* tb = V8s + (size_t)sl * 16384 * 128;
    const unsigned c16 = 16u * c, eoff = 64u * es, ob = 128u * sl + 16u * c + 2u * es;
    const bool b5 = lane & 32, b4 = lane & 16, b3 = lane & 8;
    u32x4 I0[2], I1[2], I2[2], rowsA[8], rowsB[8], rowsC[8]; f32x4 cA[2], cB[2], cC[2]; f32x2 h0, h1, h2;
#define LD_C8(cc, tk, h) do { const int _t = (tk) < T ? (tk) : T - 1; const float* _cb = CJg + (size_t)_t * 128 + 8 * (h); cc[0] = ldu<f32x4>(_cb, eoff); cc[1] = ldu<f32x4>(_cb, eoff + 16u); } while (0)
#define V_AXPY8(rows, cc) do { _Pragma("unroll") for (int _q = 0; _q < 2; ++_q) _Pragma("unroll") for (int _r = 0; _r < 4; ++_r) { const _Float16 _ch = (_Float16)cc[_q][_r]; const h2_t _c2 = {_ch, _ch}; \
            _Pragma("unroll") for (int _w = 0; _w < 4; ++_w) { acch[2 * _w] = __builtin_amdgcn_cvt_scalef32_pk_f16_fp8(rows[4 * _q + _r][_w], 1.0f, false) * _c2 + acch[2 * _w]; \
                acch[2 * _w + 1] = __builtin_amdgcn_cvt_scalef32_pk_f16_fp8(rows[4 * _q + _r][_w], 1.0f, true) * _c2 + acch[2 * _w + 1]; } \
              \
            if (4 * _q + _r < 7) asm volatile("" : "+v"(acch[0]), "+v"(acch[1]), "+v"(acch[2]), "+v"(acch[3]), "+v"(acch[4]), "+v"(acch[5]), "+v"(acch[6]), "+v"(acch[7]), "+v"(rows[(4 * _q + _r + 1) & 7])); \
            else asm volatile("" : "+v"(acch[0]), "+v"(acch[1]), "+v"(acch[2]), "+v"(acch[3]), "+v"(acch[4]), "+v"(acch[5]), "+v"(acch[6]), "+v"(acch[7])); } } while (0)
#define LD_H(hh, tk) do { const int _t = (tk) < T ? (tk) : T - 1; hh = ldu<f32x2>(out + (size_t)_t * 1024, ob * 4u); } while (0)
#define V_ZERO() do { _Pragma("unroll") for (int _i = 0; _i < 8; ++_i) acch[_i] = (h2_t){(_Float16)0.f, (_Float16)0.f}; } while (0)
#define V_FINAL(hh, tk) do { float _a[16]; _Pragma("unroll") for (int _i = 0; _i < 8; ++_i) { _a[2 * _i] = (float)acch[_i].x; _a[2 * _i + 1] = (float)acch[_i].y; } \
        const float _cm = CMAXg[(tk) < T ? (tk) : T - 1]; \
        float _q8[8], _q4[4], _q2[2]; \
        _Pragma("unroll") for (int _k = 0; _k < 8; ++_k) { const float _m = b5 ? _a[_k + 8] : _a[_k], _s = b5 ? _a[_k] : _a[_k + 8]; _q8[_k] = _m + __shfl_xor(_s, 32); } \
        _Pragma("unroll") for (int _k = 0; _k < 4; ++_k) { const float _m = b4 ? _q8[_k + 4] : _q8[_k], _s = b4 ? _q8[_k] : _q8[_k + 4]; _q4[_k] = _m + __shfl_xor(_s, 16); } \
        _Pragma("unroll") for (int _k = 0; _k < 2; ++_k) { const float _m = b3 ? _q4[_k + 2] : _q4[_k], _s = b3 ? _q4[_k] : _q4[_k + 2]; _q2[_k] = _m + __shfl_xor(_s, 8); } \
        const float _ha = hh.x + _q2[0] * _cm, _hb = hh.y + _q2[1] * _cm; const float _ssq = wave_sum(_ha * _ha + _hb * _hb); \
        if ((tk) < T) { *(f32x2*)((char*)(out + (size_t)(tk) * 1024) + ob * 4u) = (f32x2){_ha, _hb}; *(unsigned*)((char*)(A4g + (size_t)(tk) * 1024) + ob * 2u) = cvtpk(_ha, _hb); \
            if (lane == 0) SSQg[(size_t)sl * T + (tk)] = _ssq; } } while (0)
    h2_t acch[8];
    int t0 = tk_first;
    LD_E8(I0, t0, 0); LD_E8(I1, t0, 1); LD_E8(I2, t0 + tk_step, 0); LD_H(h0, t0); LD_R8(rowsA, I0, tb); LD_C8(cA, t0, 0); LD_R8(rowsB, I1, tb); LD_C8(cB, t0, 1);
#pragma unroll 1
    for (; t0 < T; t0 += 3 * tk_step) {
        const int t1 = t0 + tk_step, t2 = t1 + tk_step, t3 = t2 + tk_step;
        LD_E8(I0, t1, 1);           LD_R8(rowsC, I2, tb); LD_C8(cC, t1, 0); LD_H(h1, t1); V_ZERO(); V_AXPY8(rowsA, cA);
        LD_E8(I1, t2, 0);           LD_R8(rowsA, I0, tb); LD_C8(cA, t1, 1);                          V_AXPY8(rowsB, cB); V_FINAL(h0, t0);
        LD_E8(I2, t2, 1);           LD_R8(rowsB, I1, tb); LD_C8(cB, t2, 0); LD_H(h2, t2); V_ZERO(); V_AXPY8(rowsC, cC);
        LD_E8(I0, t3, 0);           LD_R8(rowsC, I2, tb); LD_C8(cC, t2, 1);                          V_AXPY8(rowsA, cA); V_FINAL(h1, t1);
        LD_E8(I1, t3, 1);           LD_R8(rowsA, I0, tb); LD_C8(cA, t3, 0); LD_H(h0, t3); V_ZERO(); V_AXPY8(rowsB, cB);
        LD_E8(I2, t3 + tk_step, 0); LD_R8(rowsB, I1, tb); LD_C8(cB, t3, 1);                          V_AXPY8(rowsC, cC); V_FINAL(h2, t2);
    }
#undef V_FINAL
#undef V_ZERO
#undef LD_H
#undef V_AXPY8
#undef LD_C8
#undef LD_R8
#undef LD_E8
}

typedef const __attribute__((address_space(4))) unsigned long long* karg_ptr_t;
DI karg_ptr_t kargs() { karg_ptr_t p = (karg_ptr_t)__builtin_amdgcn_kernarg_segment_ptr(); asm volatile("" : "+s"(p)); return p; }
#define GAS1 __attribute__((address_space(1)))
#define KIN(k) ((const float*)(const GAS1 float*)kargs()[k])
#define KOUT() ((float*)(GAS1 float*)kargs()[18])
#define KWS() ((unsigned char*)(GAS1 unsigned char*)kargs()[19])

__global__ void __launch_bounds__(512, 2) fwd_kernel(Params P) {
    extern __shared__ __attribute__((aligned(16))) unsigned char lds_raw[];
    LAS unsigned char* lds = (LAS unsigned char*)lds_raw;
    const int tid = threadIdx.x, lane = tid & 63, wid = __builtin_amdgcn_readfirstlane(tid >> 6);
    const int wg = blockIdx.x, nwg = gridDim.x;
    const int gwave = wg * 8 + wid, nwaves = nwg * 8;
    const int lo = P.ph_lo, hi = P.ph_hi;

    volatile LAS unsigned* misc = (volatile LAS unsigned*)(lds + LDS_BYTES - 64);
    if (tid < 16) misc[tid] = 0u;
    __syncthreads();
    { unsigned* xcw = (unsigned*)(KWS() + WS_CTL) + CW_XC;
      if (tid == 0) { const unsigned xcc = xb_xcc_id(); misc[5] = xcc; misc[4] = xb_add(xcw + 64 * xcc, 1u); } }
    XcdBarrier bar; bar.bar = (unsigned*)(KWS() + WS_CTL) + CW_BAR; bar.x = 0; bar.st = misc;
    if (hi - lo > 1) bar = xcd_barrier_post((unsigned*)(KWS() + WS_CTL) + CW_BAR, misc);

#define kmean   ((float*)(KWS() + WS_KMEAN))
#define biasTab ((float*)(KWS() + WS_BIAS))
#define WinT    ((bf16_t*)(KWS() + WS_WIN))
#define WoutT   ((bf16_t*)(KWS() + WS_WOUT))
#define WqT     ((bf16_t*)(KWS() + WS_WQ))
#define WgT     ((bf16_t*)(KWS() + WS_WG))
#define WpleT   ((bf16_t*)(KWS() + WS_WPLE))
#define U8      ((unsigned char*)(KWS() + WS_U))
#define V8      ((unsigned char*)(KWS() + WS_V))
#define USC     ((float*)(KWS() + WS_USC))
#define VSC     ((float*)(KWS() + WS_VSC))
#define XN      ((bf16_t*)(KWS() + WS_XN))
#define PB      ((bf16_t*)(KWS() + WS_PB))
#define Qm      ((bf16_t*)(KWS() + WS_QM))
#define Km      ((bf16_t*)(KWS() + WS_KM))
#define VtM     ((bf16_t*)(KWS() + WS_VTM))
#define Qs      ((bf16_t*)(KWS() + WS_QS))
#define Ks      ((bf16_t*)(KWS() + WS_KS))
#define VtS     ((bf16_t*)(KWS() + WS_VTS))
#define Oraw    ((bf16_t*)(KWS() + WS_ORAW))
#define A2      ((bf16_t*)(KWS() + WS_A2))
#define A3      ((bf16_t*)(KWS() + WS_A3))
#define SC      ((float*)(KWS() + WS_SC))
#define EIDXG   ((int*)(KWS() + WS_EIDX))
#define GATEG   ((float*)(KWS() + WS_GATE))
#define CJG     ((float*)(KWS() + WS_CJ))
#define RS2G    ((float*)(KWS() + WS_RS2))
#define SSQG    ((float*)(KWS() + WS_SSQ))
#define PDOTG   ((float*)(KWS() + WS_PDOT))
#define A4G     ((bf16_t*)(KWS() + WS_A4))
#define XN2G    ((unsigned char*)(KWS() + WS_XN2))

#define IN(k) (lo <= (k) && (k) < hi)
#ifndef PROBE_PHASE
#define PROBE_PHASE -1
#endif
#ifndef PROBE_REPS
#define PROBE_REPS 1
#endif
#define REP(k) for (int _rep = 0; _rep < ((k) == PROBE_PHASE ? PROBE_REPS : 1); ++_rep)
#define SEAM(k) do { if (IN(k) && IN((k) + 1)) xcd_barrier(bar); } while (0)

    if (IN(0)) REP(0) {
        LAS float* scr = (LAS float*)lds;
        p0_transpose<true>(KIN(IN_WIN), 1024, 3072, WinT, scr, tid, wg, nwg);
        p0_transpose<false>(KIN(IN_WOUT), 1024, 1024, WoutT, scr, tid, wg, nwg);
        p0_transpose<false>(KIN(IN_WPG), 1024, 1024, WgT, scr, tid, wg, nwg, KIN(IN_PLE_NORM));
        p0_transpose<false>(KIN(IN_WPLE), 256, 1024, WpleT, scr, tid, wg, nwg);
        p0_fold(KIN(IN_PQ), KIN(IN_SUBK), KIN(IN_FFN_NORM), WqT, scr, tid, wg, nwg);
        const size_t gtid = (size_t)wg * 512 + tid, nthr = (size_t)nwg * 512;
        p0_convert(KIN(IN_P), PB, (size_t)T * 256, gtid, nthr);
        { const float* xp = KIN(IN_X); const float* gp = KIN(IN_ATTN_NORM); bf16_t* xo = XN;
          for (int row = gwave; row < T; row += 2 * nwaves) rmsnorm_rows2_bf16(xp, gp, xo, row, row + nwaves, lane); }
        if (wg == 0) {
            for (int idx = tid; idx < 8 * 129; idx += 512) {
                const int h = idx / 129, dist = idx % 129;
                int bk;
                if (dist < 16) bk = dist;
                else { const float v = logf((float)dist / 16.f) / 2.0794415416798357f * 16.f; bk = 16 + (int)v; bk = bk > 31 ? 31 : bk; }
                biasTab[h * 132 + dist] = KIN(IN_RELB)[bk * 8 + h] * LOG2E;
            }
        }
    }
    SEAM(0);
    if (IN(1)) REP(1) {
        pg8::Gemm g{XN, WinT, T, NPROJ, 1024}; pg8::StaticOrder S; S.init(T, NPROJ, nwg, wg);
        EpiQKV E{Qm, KIN(IN_QNORM), KIN(IN_KNORM)};
        pg8::gemm_phase<EpiQKV, pg8::StaticOrder, true, true>(lds, g, S, E);
    }
    SEAM(1);
    if (IN(2)) REP(2) {
        for (int item = gwave; item < 512; item += nwaves) {
            const int bhh = item >> 3, blk = item & 7;
            float sacc[4][8];
#pragma unroll
            for (int q = 0; q < 4; ++q)
#pragma unroll
                for (int j = 0; j < 8; ++j) sacc[q][j] = 0.f;
            const bf16_t* base = Km + ((size_t)bhh * 64 + blk * 8) * 2048 + lane * 8;
#pragma unroll 2
            for (int t8 = 0; t8 < 8; ++t8)
#pragma unroll
                for (int q = 0; q < 4; ++q) { const bf16x8 v = *(const bf16x8*)(base + (size_t)t8 * 2048 + q * 512);
#pragma unroll
                    for (int j = 0; j < 8; ++j) sacc[q][j] += bf2f(v[j]); }
#pragma unroll
            for (int q = 0; q < 4; ++q)
#pragma unroll
                for (int j = 0; j < 8; ++j) { float v = sacc[q][j];
#pragma unroll
                    for (int o = 1; o < 32; o <<= 1) v += __shfl_xor(v, o);
                    sacc[q][j] = v; }
            if ((lane & 31) == 0) {
                const int hh = lane >> 5;
#pragma unroll
                for (int q = 0; q < 4; ++q)
#pragma unroll
                    for (int j = 0; j < 8; ++j) kmean[(size_t)item * 64 + 16 * q + 8 * hh + j] = sacc[q][j] * (1.f / 256.f);
            }
        }
    }
    SEAM(2);
    if (IN(3)) REP(3) {
        const float* pu = KIN(IN_PU); const float* pv = KIN(IN_PV); unsigned char* u8 = U8; unsigned char* v8 = V8; float* usc_ = USC; float* vsc_ = VSC;
        const bf16_t* qm_ = Qm; const bf16_t* km_ = Km; const bf16_t* vtm_ = VtM; const bf16_t* qs_ = Qs; const bf16_t* ks_ = Ks; const bf16_t* vts_ = VtS;
        const float* kmn_ = kmean; const float* bt_ = biasTab; bf16_t* a2_ = A2;
        const float* gm_ = KIN(IN_ONM); const float* gs_ = KIN(IN_ONS);
        LAS unsigned char* ot = lds;
        int qrow = gwave;
        for (int u = gwave; u < 8192; u += nwaves) {
            const int grp = u >> 12, i = u & 4095;
            const int half = i >> 11, j = i & 2047;
            const int qt = half ? (j >> 6) : 63 - (j >> 6), bh = j & 63;
            const int b = bh >> 3, h = bh & 7;
            if (grp == 0) moba_unit(b, h, qt, qm_, km_, vtm_, kmn_, bt_, ot, lane);
            else sb_unit(b, h, qt, qs_, ks_, vts_, ot, lane);
            __syncthreads();
            {
                const float* gg = grp ? gs_ : gm_;
                const f32x4 g0 = *(const f32x4*)(gg + 8 * lane), g1 = *(const f32x4*)(gg + 8 * lane + 4);
#pragma unroll
                for (int rr = 0; rr < 4; ++rr) {
                    const int row = 4 * wid + rr;
                    const bf16x8 v = *(const LAS bf16x8*)(ot + row * OT_PITCH + lane * 16);
                    float f[8], sq = 0.f;
#pragma unroll
                    for (int e = 0; e < 8; ++e) { f[e] = bf2f(v[e]); sq += f[e] * f[e]; }
                    sq = wave_sum(sq);
                    const float rs = rsqrtf(sq * (1.f / 512.f) + EPS);
                    u32x4 w; w.x = cvtpk(f[0] * rs * g0.x, f[1] * rs * g0.y); w.y = cvtpk(f[2] * rs * g0.z, f[3] * rs * g0.w);
                    w.z = cvtpk(f[4] * rs * g1.x, f[5] * rs * g1.y); w.w = cvtpk(f[6] * rs * g1.z, f[7] * rs * g1.w);
                    *(u32x4*)(a2_ + (size_t)(b * 2048 + qt * 32 + row) * 1024 + grp * 512 + 8 * lane) = w;
                }
            }
            __syncthreads();
            for (int k = 0; k < 1 && qrow < 16384; ++k, qrow += 2 * nwaves) p0_quant_rows4(pu, pv, u8, v8, usc_, vsc_, qrow, qrow + nwaves, lane);
        }
        for (; qrow < 16384; qrow += 2 * nwaves) p0_quant_rows4(pu, pv, u8, v8, usc_, vsc_, qrow, qrow + nwaves, lane);
    }
    SEAM(3);
    if (IN(5)) REP(5) {
        pg8::Gemm g{A2, WoutT, T, 1024, 1024}; pg8::StaticOrder S; S.init(T, 1024, nwg, wg);
        EpiRes E{KIN(IN_X), KOUT(), A3};
        pg8::gemm_phase<EpiRes, pg8::StaticOrder, true, true>(lds, g, S, E);
    }
    SEAM(5);
    if (IN(6)) REP(6) {
        pg8::Gemm g{A3, WqT, T, 2048, 1024}; pg8::StaticOrder S; S.init(T, 2048, nwg, wg);
        EpiBf E{(bf16_t*)SC, 2048};
        pg8::gemm_phase<EpiBf, pg8::StaticOrder, true, true>(lds, g, S, E);
    }
    SEAM(6);
    if (IN(7)) REP(7) {
        LAS float* wl = (LAS float*)(lds + wid * 4096);
        {
            const int c = lane; int ca, cb;
            if (c < 16) { ca = 0; cb = c; } else if (c < 24) { ca = 1; cb = c - 16; } else if (c < 29) { ca = 2; cb = c - 24; } else if (c < 33) { ca = 3; cb = c - 29; }
            else if (c < 36) { ca = 4; cb = c - 33; } else if (c < 42) { ca = 5 + ((c - 36) >> 1); cb = (c - 36) & 1; } else { ca = (c - 34) & 15; cb = 0; }
            ((LAS unsigned*)(wl + 768))[lane] = (unsigned)ca | ((unsigned)cb << 8);
            asm volatile("s_waitcnt lgkmcnt(0)" ::: "memory");
        }
        const float* h1p = KOUT(); const bf16_t* scp = (const bf16_t*)SC; const float* gfp = KIN(IN_FFN_NORM); int* eip = EIDXG; float* gtp = GATEG; unsigned char* xnp = XN2G;
        TopkIn inA, inB;
        peer_topk_load(inA, gwave, h1p, scp, lane);
        for (int tok = gwave; tok < T; tok += 2 * nwaves) {
            peer_topk_load(inB, tok + nwaves, h1p, scp, lane);
            peer_topk_token(tok, inA, gfp, eip, gtp, xnp, wl, lane);
            peer_topk_load(inA, tok + 2 * nwaves, h1p, scp, lane);
            if (tok + nwaves < T) peer_topk_token(tok + nwaves, inB, gfp, eip, gtp, xnp, wl, lane);
        }
    }
    SEAM(7);
    int sl_first = 0, sl_step = 1, tk_first = 0, tk_step = 8;
    if (IN(8) || IN(10)) {
        __syncthreads();
        const unsigned myx = misc[5], myrank = misc[4];
        unsigned nx = 0, myidx = 0, nloc = 1;
        unsigned* xc = (unsigned*)(KWS() + WS_CTL) + CW_XC;
#pragma unroll
        for (unsigned j = 0; j < 16; ++j) { const unsigned cj = xb_ld(xc + 64 * j); if (cj > 0u) { if (j < myx) ++myidx; ++nx; } if (j == myx) nloc = cj; }
        sl_first = __builtin_amdgcn_readfirstlane((int)myidx); sl_step = __builtin_amdgcn_readfirstlane((int)(nx > 0u ? nx : 1u));
        tk_first = __builtin_amdgcn_readfirstlane((int)myrank * 8 + wid); tk_step = __builtin_amdgcn_readfirstlane((int)(nloc > 0u ? nloc : 1u) * 8);
    }
    if (IN(8)) REP(8) {
        const unsigned char* xnp = XN2G; const int* eip = EIDXG; const unsigned char* u8p = U8; float* pdp = PDOTG;
        for (int sl = sl_first; sl < 8; sl += sl_step) peer_u_slice(sl, tk_first, tk_step, xnp, eip, u8p, pdp, lane);
    }
    SEAM(8);
    if (IN(9)) REP(9) {
        const int* eip = EIDXG; const float* gtp = GATEG; const float* pdp = PDOTG; const float* usp = USC; const float* vsp = VSC; float* cjp = CJG; float* cmp_ = RS2G;
        for (int tok = gwave; tok < T; tok += 4 * nwaves) peer_cj_tokens<4>(tok, nwaves, eip, gtp, pdp, usp, vsp, cjp, cmp_, lane);
    }
    SEAM(9);
    if (IN(10)) REP(10) {
        float* outp = KOUT(); const int* eip = EIDXG; const float* cjp = CJG; const float* cmp_ = RS2G; const unsigned char* v8p = V8; bf16_t* a4p = A4G; float* sqp = SSQG;
        for (int sl = sl_first; sl < 8; sl += sl_step) peer_v_slice(sl, tk_first, tk_step, outp, eip, cjp, cmp_, v8p, a4p, sqp, lane);
    }
    SEAM(10);
    if (IN(11)) REP(11) {
        bf16_t* PW = Oraw;
        { int kple = 256; asm volatile("" : "+s"(kple));
          pg8::Gemm g{PB, WpleT, T, 1024, kple}; pg8::StaticOrder S; S.init(T, 1024, nwg, wg);
          EpiBf E{PW, 1024};
          pg8::gemm_phase<EpiBf, pg8::StaticOrder, true, true>(lds, g, S, E); }
        asm volatile("s_waitcnt vmcnt(0)" ::: "memory");
        __syncthreads();
        { pg8::Gemm g{A4G, WgT, T, 1024, 1024}; pg8::StaticOrder S; S.init(T, 1024, nwg, wg);
          EpiGate E{KOUT(), PW, SSQG};
          pg8::gemm_phase<EpiGate, pg8::StaticOrder, true, true>(lds, g, S, E); }
    }
#undef IN
#undef SEAM
}

extern "C" void kernel_launch(void* const* d_in, const int* in_sizes, int n_in, void* d_out, int out_size, void* d_ws, size_t ws_size, hipStream_t stream) {
    static int grid = 0;
    if (grid == 0) {
        if (n_in != 18 || out_size != T * DM || ws_size < WS_END) { fprintf(stderr, "kernel_launch: unexpected shapes (n_in %d out %d ws %zu)\n", n_in, out_size, ws_size); grid = -1; return; }
        int dev = 0, cus = 0, per_cu = 0;
        if (hipGetDevice(&dev) != hipSuccess || hipDeviceGetAttribute(&cus, hipDeviceAttributeMultiprocessorCount, dev) != hipSuccess) { grid = -1; return; }
        if (hipFuncSetAttribute((const void*)fwd_kernel, hipFuncAttributeMaxDynamicSharedMemorySize, LDS_BYTES) != hipSuccess) { fprintf(stderr, "kernel_launch: hipFuncSetAttribute failed\n"); grid = -1; return; }
        if (hipOccupancyMaxActiveBlocksPerMultiprocessor(&per_cu, (const void*)fwd_kernel, 512, LDS_BYTES) != hipSuccess || per_cu < 1)
            fprintf(stderr, "kernel_launch: note: occupancy query reports %d\n", per_cu);
        (void)hipGetLastError();
        grid = cus - (cus % 8);
    }
    if (grid < 0) return;
    if (hipMemsetAsync((char*)d_ws + WS_CTL, 0, CTL_ZERO_BYTES, stream) != hipSuccess) return;
    Params p{};
    for (int i = 0; i < 18; ++i) p.in[i] = (const float*)d_in[i];
    p.out = (float*)d_out; p.ws = (unsigned char*)d_ws;
    p.ph_lo = 0; p.ph_hi = NPHASE;
    hipLaunchKernelGGL(fwd_kernel, dim3(grid), dim3(512), LDS_BYTES, stream, p);
}
```

```cpp
#include <hip/hip_runtime.h>
#include <stdint.h>
#include <stdio.h>

#ifndef N_LAUNCHES
#define N_LAUNCHES 1
#endif

#define DI __device__ __forceinline__
#define LAS __attribute__((address_space(3)))

typedef unsigned short bf16_t;
typedef short bf16x8 __attribute__((ext_vector_type(8)));
typedef float f32x16 __attribute__((ext_vector_type(16)));
typedef float f32x4 __attribute__((ext_vector_type(4)));
typedef float f32x2 __attribute__((ext_vector_type(2)));
typedef unsigned u32x4 __attribute__((ext_vector_type(4)));
typedef unsigned u32x2 __attribute__((ext_vector_type(2)));
typedef __bf16 bf16x2_t __attribute__((ext_vector_type(2)));

constexpr int BATCH = 8, SEQ = 2048, DM = 1024, T = BATCH * SEQ;
constexpr int NPROJ = 3072;
constexpr float EPS = 1e-6f;
constexpr float LOG2E = 1.4426950408889634f;
constexpr float SCL2 = 0.125f * LOG2E;
constexpr int NPHASE = 12;

constexpr size_t MiB = 1u << 20;
constexpr size_t WS_CTL = 0, CTL_ZERO_BYTES = 65536;
constexpr size_t WS_KMEAN = 256 * 1024;
constexpr size_t WS_BIAS = 512 * 1024;
constexpr size_t WS_WIN = 1 * MiB, WS_WOUT = 7 * MiB, WS_WQ = 9 * MiB, WS_WG = 13 * MiB, WS_WPLE = 15 * MiB;
constexpr size_t WS_U = 16 * MiB, WS_V = 32 * MiB;
constexpr size_t WS_USC = 640 * 1024, WS_VSC = 704 * 1024;
constexpr size_t WS_XN2 = 48 * MiB;
constexpr size_t WS_XN = 80 * MiB;
constexpr size_t WS_PB = 112 * MiB;
constexpr size_t WS_QM = 120 * MiB, WS_KM = 136 * MiB, WS_VTM = 152 * MiB, WS_QS = 168 * MiB, WS_KS = 184 * MiB, WS_VTS = 200 * MiB;
constexpr size_t WS_ORAW = 216 * MiB;
constexpr size_t WS_A2 = 80 * MiB;
constexpr size_t WS_A3 = 120 * MiB;
constexpr size_t WS_SC = 152 * MiB;
constexpr size_t WS_EIDX = 80 * MiB, WS_GATE = 88 * MiB, WS_CJ = 96 * MiB, WS_RS2 = 104 * MiB, WS_SSQ = 105 * MiB;
constexpr size_t WS_PDOT = 120 * MiB;
constexpr size_t WS_A4 = 184 * MiB;
constexpr size_t WS_END = 248 * MiB;

constexpr int CW_XC = 8192;
constexpr int CW_BAR = 4096;

constexpr int LDS_BYTES = 147456;

#define XB_TMO      128
#define XB_XCNT(j)  (256  + 64 * (j))
#define XB_XSUB(j)  (1280 + 64 * (j))
#define XB_XGEN(j)  (2304 + 64 * (j))
#define XB_TOP      3328
#define XB_TOPGEN   3392
#define XCD_BAR_WORDS 3456
#define XB_SPIN_CAP (1u << 18)

__device__ __forceinline__ unsigned xb_ld(unsigned* p)              { return __hip_atomic_load(p, __ATOMIC_RELAXED, __HIP_MEMORY_SCOPE_AGENT); }
__device__ __forceinline__ unsigned xb_add(unsigned* p, unsigned v) { return __hip_atomic_fetch_add(p, v, __ATOMIC_RELAXED, __HIP_MEMORY_SCOPE_AGENT); }
__device__ __forceinline__ unsigned xb_xcc_id() { return (unsigned)__builtin_amdgcn_s_getreg((3 << 11) | 20) & 0xFu; }
#define XB_SPIN(cond, bar) do { unsigned _sp = 0; while (cond) { __builtin_amdgcn_s_sleep(1); \
    if ((++_sp & 255u) == 0u) { if (xb_ld(&(bar)[XB_TMO])) break; if (_sp > XB_SPIN_CAP) { atomicAdd(&(bar)[XB_TMO], 1u); break; } } } } while (0)

struct XcdBarrier { unsigned* bar; unsigned x; volatile LAS unsigned* st; };

__device__ __forceinline__ XcdBarrier xcd_barrier_post(unsigned* bar, volatile LAS unsigned* st) {
    XcdBarrier b; b.bar = bar; b.x = xb_xcc_id(); b.st = st;
    if (threadIdx.x == 0) (void)xb_add(&bar[XB_XCNT(b.x)], 1u);
    return b;
}
__device__ __forceinline__ void xcd_barrier_complete(unsigned* bar, unsigned x, unsigned& nloc, unsigned& nx) {
    const unsigned G = gridDim.x * gridDim.y * gridDim.z;
    unsigned sum, cnt, mine, sp = 0u;
    for (;;) {
        sum = 0u; cnt = 0u; mine = 0u;
#pragma unroll
        for (unsigned j = 0; j < 16; ++j) { const unsigned c = xb_ld(&bar[XB_XCNT(j)]); sum += c; cnt += (c > 0u) ? 1u : 0u; mine = (j == x) ? c : mine; }
        if (sum == G) break;
        __builtin_amdgcn_s_sleep(1);
        if ((++sp & 255u) == 0u) { if (xb_ld(&bar[XB_TMO])) break; if (sp > XB_SPIN_CAP) { atomicAdd(&bar[XB_TMO], 1u); break; } }
    }
    nloc = mine > 0u ? mine : 1u; nx = cnt > 0u ? cnt : 1u;
}
__device__ __forceinline__ void xcd_barrier(const XcdBarrier& b) {
    asm volatile("s_waitcnt vmcnt(0)" ::: "memory");
    __syncthreads();
    if (threadIdx.x == 0) {
        unsigned* bar = b.bar;
        __builtin_amdgcn_s_waitcnt(0);
        unsigned nloc = b.st[0], nx = b.st[1];
        if (nloc == 0u) { xcd_barrier_complete(bar, b.x, nloc, nx); b.st[0] = nloc; b.st[1] = nx; }
        const unsigned old = xb_add(&bar[XB_XSUB(b.x)], 1u);
        const unsigned gen = old / nloc;
        if (old + 1u == (gen + 1u) * nloc) {
            __builtin_amdgcn_fence(__ATOMIC_RELEASE, "agent");
            asm volatile("s_waitcnt vmcnt(0)" ::: "memory");
            const unsigned og = xb_add(&bar[XB_TOP], 1u);
            const unsigned tg = og / nx;
            if (og + 1u == (tg + 1u) * nx) xb_add(&bar[XB_TOPGEN], 1u);
            else XB_SPIN(xb_ld(&bar[XB_TOPGEN]) == tg, bar);
            __builtin_amdgcn_fence(__ATOMIC_ACQUIRE, "agent");
            xb_add(&bar[XB_XGEN(b.x)], 1u);
            asm volatile("s_waitcnt vmcnt(0)" ::: "memory");
        } else {
            XB_SPIN(xb_ld(&bar[XB_XGEN(b.x)]) == gen, bar);
            __builtin_amdgcn_fence(__ATOMIC_ACQUIRE, "agent");
            asm volatile("s_waitcnt vmcnt(0)" ::: "memory");
        }
    }
    __syncthreads();
}

DI float bf2f(short v) { return __builtin_bit_cast(float, ((unsigned)(unsigned short)v) << 16); }
DI unsigned cvtpk(float lo, float hi) { f32x2 v = {lo, hi}; bf16x2_t b = __builtin_convertvector(v, bf16x2_t); return __builtin_bit_cast(unsigned, b); }
DI bf16_t f2bf(float f) { return (bf16_t)(cvtpk(f, 0.f) & 0xffffu); }
DI float wave_sum(float v) {
#pragma unroll
    for (int o = 1; o < 64; o <<= 1) v += __shfl_xor(v, o);
    return v;
}
DI int crow(int r, int hi) { return (r & 3) + 8 * (r >> 2) + 4 * hi; }
#define MFMA32(a, b, c) __builtin_amdgcn_mfma_f32_32x32x16_bf16((a), (b), (c), 0, 0, 0)
DI f32x16 zero16() { f32x16 z; for (int i = 0; i < 16; ++i) z[i] = 0.f; return z; }

struct Params {
    const float* in[18];
    float* out;
    unsigned char* ws;
    int ph_lo, ph_hi;
};

enum { IN_X = 0, IN_P, IN_RELB, IN_ATTN_NORM, IN_WIN, IN_QNORM, IN_KNORM, IN_ONM, IN_ONS, IN_WOUT, IN_FFN_NORM, IN_PQ, IN_SUBK, IN_PU, IN_PV, IN_PLE_NORM, IN_WPG, IN_WPLE };

template <bool HEADPERM> DI void p0_transpose(const float* W, int K, int N, bf16_t* Wt, LAS float* scr, int tid, int wg, int nwg, const float* kgain = nullptr) {
    const int tn = N / 64, ntile = (K / 64) * tn;
    for (int tile = wg; tile < ntile; tile += nwg) {
        const int k0 = (tile / tn) * 64, n0 = (tile % tn) * 64;
#pragma unroll
        for (int i = 0; i < 8; ++i) { const int kk = (tid >> 6) + 8 * i, nn = tid & 63; scr[kk * 65 + nn] = W[(size_t)(k0 + kk) * N + n0 + nn]; }
        __syncthreads();
#pragma unroll
        for (int i = 0; i < 8; ++i) { const int nn = (tid >> 6) + 8 * i, kk = tid & 63; int n = n0 + nn; if (HEADPERM) { const int w = n & 255; n = (n & ~255) + 128 * ((w >> 5) & 1) + 32 * (w >> 6) + (w & 31); }
            Wt[(size_t)n * K + k0 + kk] = f2bf(scr[kk * 65 + nn] * (kgain ? kgain[k0 + kk] : 1.f)); }
        __syncthreads();
    }
}

DI void p0_fold(const float* wq, const float* sub, const float* gffn, bf16_t* WqT, LAS float* lds, int tid, int wg, int nwg) {
    LAS float* wqs = lds;
    LAS float* subs = lds + 128 * 65;
    for (int item = wg; item < 256; item += nwg) {
        const int dt = item & 15, hh = item >> 4, d0 = dt * 64, h = hh >> 1, half = hh & 1;
#pragma unroll
        for (int i = 0; i < 16; ++i) { const int k = tid & 127, dd = (tid >> 7) + 4 * i; wqs[k * 65 + dd] = wq[(size_t)(d0 + dd) * 2048 + h * 256 + half * 128 + k]; }
#pragma unroll
        for (int i = 0; i < 32; ++i) { const int idx = i * 512 + tid; subs[idx] = sub[half * 16384 + idx]; }
        __syncthreads();
        const int d = tid & 63, ng = tid >> 6;
        float acc[16];
#pragma unroll
        for (int i = 0; i < 16; ++i) acc[i] = 0.f;
        for (int k = 0; k < 128; k += 4) {
            const float a0 = wqs[(k + 0) * 65 + d], a1 = wqs[(k + 1) * 65 + d], a2 = wqs[(k + 2) * 65 + d], a3 = wqs[(k + 3) * 65 + d];
#pragma unroll
            for (int i = 0; i < 16; ++i) { const f32x4 s = *(const LAS f32x4*)(subs + (16 * ng + i) * 128 + k); acc[i] += a0 * s.x + a1 * s.y + a2 * s.z + a3 * s.w; }
        }
        const float g = gffn[d0 + d];
#pragma unroll
        for (int i = 0; i < 16; ++i) WqT[(size_t)(hh * 128 + 16 * ng + i) * 1024 + d0 + d] = f2bf(acc[i] * g);
        __syncthreads();
    }
}

DI void p0_convert(const float* src, bf16_t* dst, size_t n, size_t gtid, size_t nthreads) {
    for (size_t i = gtid * 8; i < n; i += nthreads * 8) {
        const f32x4 a = *(const f32x4*)(src + i), b = *(const f32x4*)(src + i + 4);
        u32x4 o; o.x = cvtpk(a.x, a.y); o.y = cvtpk(a.z, a.w); o.z = cvtpk(b.x, b.y); o.w = cvtpk(b.z, b.w);
        *(u32x4*)(dst + i) = o;
    }
}


DI void p0_quant_finish(const f32x4 (&a)[4], unsigned char* dst, float* scale, int row, int lane) {
    float m = 0.f;
#pragma unroll
    for (int i = 0; i < 4; ++i) m = fmaxf(fmaxf(m, fmaxf(fabsf(a[i].x), fabsf(a[i].y))), fmaxf(fabsf(a[i].z), fabsf(a[i].w)));
#pragma unroll
    for (int o = 1; o < 64; o <<= 1) m = fmaxf(m, __shfl_xor(m, o));
    const float sc = m > 0.f ? m * (1.f / 440.f) : 1.f, inv = m > 0.f ? 440.f / m : 0.f;
    u32x4 w;
#pragma unroll
    for (int i = 0; i < 4; ++i) {
        const float q0 = fminf(fmaxf(a[i].x * inv, -448.f), 448.f), q1 = fminf(fmaxf(a[i].y * inv, -448.f), 448.f);
        const float q2 = fminf(fmaxf(a[i].z * inv, -448.f), 448.f), q3 = fminf(fmaxf(a[i].w * inv, -448.f), 448.f);
        int p = 0;
        p = __builtin_amdgcn_cvt_pk_fp8_f32(q0, q1, p, false);
        p = __builtin_amdgcn_cvt_pk_fp8_f32(q2, q3, p, true);
        w[i] = (unsigned)p;
    }
    *(u32x4*)(dst + ((size_t)(lane >> 3) * 16384 + row) * 128 + 16 * (lane & 7)) = w;
    if (lane == 0) scale[row] = sc;
}
DI void p0_quant_rows4(const float* pu, const float* pv, unsigned char* u8, unsigned char* v8, float* usc_, float* vsc_, int r0, int r1, int lane) {
    f32x4 a[4][4];
    const int r1c = r1 < 16384 ? r1 : r0;
#pragma unroll
    for (int i = 0; i < 4; ++i) { a[0][i] = *(const f32x4*)(pu + (size_t)r0 * 1024 + 16 * lane + 4 * i); a[1][i] = *(const f32x4*)(pv + (size_t)r0 * 1024 + 16 * lane + 4 * i);
        a[2][i] = *(const f32x4*)(pu + (size_t)r1c * 1024 + 16 * lane + 4 * i); a[3][i] = *(const f32x4*)(pv + (size_t)r1c * 1024 + 16 * lane + 4 * i); }
    p0_quant_finish(a[0], u8, usc_, r0, lane); p0_quant_finish(a[1], v8, vsc_, r0, lane);
    if (r1 < 16384) { p0_quant_finish(a[2], u8, usc_, r1, lane); p0_quant_finish(a[3], v8, vsc_, r1, lane); }
}

DI void rmsnorm_rows2_bf16(const float* x, const float* g, bf16_t* o, int r0, int r1, int lane) {
    f32x4 v[2][4]; float s[2] = {0.f, 0.f};
    const int rr[2] = {r0, r1 < T ? r1 : r0};
#pragma unroll
    for (int q = 0; q < 2; ++q)
#pragma unroll
        for (int j = 0; j < 4; ++j) v[q][j] = ((const f32x4*)(x + (size_t)rr[q] * 1024))[lane + 64 * j];
#pragma unroll
    for (int q = 0; q < 2; ++q) {
#pragma unroll
        for (int j = 0; j < 4; ++j) s[q] += (v[q][j].x * v[q][j].x + v[q][j].y * v[q][j].y) + (v[q][j].z * v[q][j].z + v[q][j].w * v[q][j].w);
        s[q] = wave_sum(s[q]);
    }
#pragma unroll
    for (int q = 0; q < 2; ++q) {
        if (q == 1 && r1 >= T) break;
        const float rs = rsqrtf(s[q] * (1.f / 1024.f) + EPS);
#pragma unroll
        for (int j = 0; j < 4; ++j) { const f32x4 gv = ((const f32x4*)g)[lane + 64 * j];
            u32x2 w; w.x = cvtpk(v[q][j].x * rs * gv.x, v[q][j].y * rs * gv.y); w.y = cvtpk(v[q][j].z * rs * gv.z, v[q][j].w * rs * gv.w);
            ((u32x2*)(o + (size_t)rr[q] * 1024))[lane + 64 * j] = w; }
    }
}

namespace pg8 {
#define PG8_LAS __attribute__((address_space(3)))
typedef unsigned short bf16_t;
typedef short bf16x8 __attribute__((ext_vector_type(8)));
typedef float f32x4 __attribute__((ext_vector_type(4)));
typedef unsigned u32x4 __attribute__((ext_vector_type(4)));
constexpr int BM = 256, BK = 64, HALF = 128, HTB = HALF * BK * 2  , STAGE_BYTES = 8 * HTB, NXCD = 8, WGM = 8;

__host__ __device__ __forceinline__ int lds_byte(int r, int c) { const int st = (r >> 4) * 2 + (c >> 5), rr = r & 15, cc = c & 31, ob = rr * 64 + cc * 2; return st * 1024 + (ob ^ (((ob >> 9) & 1) << 5)); }
__host__ __device__ __forceinline__ void stage_rc(int b, int& R, int& C) { const int st = b / 1024, sb = b % 1024, swz = sb ^ (((sb >> 9) & 1) << 5); R = (st >> 1) * 16 + swz / 64; C = (st & 1) * 32 + (swz % 64) / 2; }
__host__ __device__ __forceinline__ int perm32(int rho) { const int n = rho >> 4, i = rho & 15; return 8 * (i >> 2) + 4 * n + (i & 3); }

struct Unit { int pm, pn; };
struct Gemm { const bf16_t* A; const bf16_t* Bt; int M, N, K; };

struct StaticOrder {
    int nM, nN, nwg, G, c;
    __host__ __device__ void init(int M, int N, int G_, int c_) { nM = M / BM; nN = N / BM; nwg = nM * nN; G = G_; c = c_; }
    __host__ __device__ bool next(int i, Unit& u) const {
        const long L = (long)i * G + c; if (L >= nwg) return false;
        int wgid = (int)L; { const int q = nwg / NXCD, r = nwg % NXCD, xcd = wgid % NXCD, off = wgid / NXCD; wgid = (xcd < r ? xcd * (q + 1) : r * (q + 1) + (xcd - r) * q) + off; }
        const int nig = WGM * nN, gid = wgid / nig, fm = gid * WGM, gsz = (nM - fm) < WGM ? (nM - fm) : WGM;
        u.pm = fm + ((wgid % nig) % gsz); u.pn = (wgid % nig) / gsz; return true;
    }
    __device__ __forceinline__ void a_ready(const Unit&) const {}
    __device__ __forceinline__ void done(const Unit&) const {}
};

template <class Epi, class Sched, bool ALIGN_EPI = false, bool SP2 = false>
__device__ __forceinline__ void gemm_phase(PG8_LAS unsigned char* lds, const Gemm g, const Sched& S, const Epi& E) {
    int tid_ = threadIdx.x; asm volatile("" : "+v"(tid_));
    const int tid = tid_, wid = __builtin_amdgcn_readfirstlane(tid >> 6), lane = tid & 63, wr = wid >> 2, wc = wid & 3, fr = lane & 15, fq = lane >> 4;
    const int K = g.K, nt = K / BK;
    unsigned voffA[2], voffB[2];
#pragma unroll
    for (int i = 0; i < 2; ++i) { int R, C; stage_rc(tid * 16 + i * 8192, R, C); const int Rb = Epi::PERM ? ((R & ~31) + perm32(R & 31)) : R;
        voffA[i] = (unsigned)(R * K + C) * 2u; voffB[i] = (unsigned)(Rb * K + C) * 2u; }
    const size_t kstep = (size_t)(BK * 2);
    const size_t hstep = (size_t)HALF * K * 2;
    const size_t tstep = 2 * hstep;
    const unsigned ldsw = (unsigned)wid * 1024u;
    const int aoff = lds_byte(wr * 64 + fr, fq * 8), boff = lds_byte(wc * 32 + fr, fq * 8);
#define PG8_SA(b, h) (((b) * 2 + (h)) * HTB)
#define PG8_SB(b, h) ((4 + (b) * 2 + (h)) * HTB)
#define PG8_STAGE(bufoff, gbase, voff) do { _Pragma("unroll") for (int _i = 0; _i < 2; ++_i) \
        __builtin_amdgcn_global_load_lds((const unsigned*)((const char*)(gbase) + (voff)[_i]), (PG8_LAS unsigned*)(lds + (bufoff) + ldsw + _i * 8192), 16, 0, 0); } while (0)
#define PG8_LDA(dst, b, h) do { _Pragma("unroll") for (int m = 0; m < 4; ++m) _Pragma("unroll") for (int k = 0; k < 2; ++k) dst[m][k] = *(const PG8_LAS bf16x8*)(lds + PG8_SA(b, h) + aoff + m * 2048 + k * 1024); } while (0)
#define PG8_LDB(dst, b, h) do { _Pragma("unroll") for (int n = 0; n < 2; ++n) _Pragma("unroll") for (int k = 0; k < 2; ++k) dst[n][k] = *(const PG8_LAS bf16x8*)(lds + PG8_SB(b, h) + boff + n * 2048 + k * 1024); } while (0)
#define PG8_MMA(ai, bj, At, Bt) do { __builtin_amdgcn_s_setprio(1); _Pragma("unroll") for (int m = 0; m < 4; ++m) _Pragma("unroll") for (int n = 0; n < 2; ++n) _Pragma("unroll") for (int k = 0; k < 2; ++k) \
        acc[ai][bj][m][n] = __builtin_amdgcn_mfma_f32_16x16x32_bf16(Bt[n][k], At[m][k], acc[ai][bj][m][n], 0, 0, 0); __builtin_amdgcn_s_setprio(0); } while (0)
#define PG8_WAIT_V(n) asm volatile("s_waitcnt vmcnt(" #n ")" ::: "memory")
#define PG8_WAIT_L(n) asm volatile("s_waitcnt lgkmcnt(" #n ")" ::: "memory")
#define PG8_BAR __builtin_amdgcn_s_barrier()
#define PG8_SCHED __builtin_amdgcn_sched_barrier(0)
    Unit cur, nxt; int ui = 0;
    if (!S.next(0, cur)) return;
    f32x4 acc[2][2][4][2];
#pragma unroll
    for (int a = 0; a < 2; ++a)
#pragma unroll
        for (int b = 0; b < 2; ++b)
#pragma unroll
            for (int m = 0; m < 4; ++m)
#pragma unroll
                for (int n = 0; n < 2; ++n) acc[a][b][m][n] = (f32x4){0.f, 0.f, 0.f, 0.f};
    bf16x8 At[4][2], B0[2][2], B1[2][2];
    const char* cA = (const char*)g.A + (size_t)cur.pm * tstep; const char* cB = (const char*)g.Bt + (size_t)cur.pn * tstep;
    S.a_ready(cur);
    if constexpr (SP2) {
        PG8_STAGE(PG8_SB(0, 0), cB, voffB); PG8_STAGE(PG8_SB(0, 1), cB + hstep, voffB); PG8_STAGE(PG8_SA(0, 0), cA, voffA); PG8_STAGE(PG8_SA(0, 1), cA + hstep, voffA);
        if (wr == 1) PG8_BAR;
        PG8_WAIT_V(2); PG8_BAR;
        PG8_STAGE(PG8_SB(1, 0), cB + kstep, voffB); PG8_STAGE(PG8_SA(1, 0), cA + kstep, voffA); PG8_STAGE(PG8_SB(1, 1), cB + hstep + kstep, voffB);
        PG8_WAIT_V(6); PG8_BAR;
    } else {
        PG8_STAGE(PG8_SB(0, 0), cB, voffB); PG8_STAGE(PG8_SA(0, 0), cA, voffA); PG8_STAGE(PG8_SB(0, 1), cB + hstep, voffB); PG8_STAGE(PG8_SA(0, 1), cA + hstep, voffA);
        if (wr == 1) PG8_BAR;
        PG8_WAIT_V(4); PG8_BAR;
        PG8_STAGE(PG8_SB(1, 0), cB + kstep, voffB); PG8_STAGE(PG8_SA(1, 0), cA + kstep, voffA); PG8_STAGE(PG8_SB(1, 1), cB + hstep + kstep, voffB);
        PG8_WAIT_V(6); PG8_BAR;
    }
    for (;;) {
        const bool has_next = S.next(ui + 1, nxt);
        const char* nA = has_next ? (const char*)g.A + (size_t)nxt.pm * tstep : cA; const char* nB = has_next ? (const char*)g.Bt + (size_t)nxt.pn * tstep : cB;
        for (int t = 0; t < nt; t += 2) {
            const bool last = (t == nt - 2);
            const char* a1 = cA + (size_t)(t + 1) * kstep;
            const char* a2 = last ? nA : cA + (size_t)(t + 2) * kstep; const char* b2 = last ? nB : cB + (size_t)(t + 2) * kstep;
            const char* a3 = a2 + kstep; const char* b3 = b2 + kstep;
            if (last && has_next) S.a_ready(nxt);
            if constexpr (SP2) {
            PG8_LDB(B0, 0, 0); PG8_LDB(B1, 0, 1); PG8_SCHED; PG8_LDA(At, 0, 0); PG8_STAGE(PG8_SA(1, 1), a1 + hstep, voffA);
            PG8_WAIT_V(8); PG8_WAIT_L(0); PG8_BAR; PG8_MMA(0, 0, At, B0); PG8_MMA(0, 1, At, B1); PG8_BAR; PG8_SCHED;
            PG8_LDA(At, 0, 1); PG8_STAGE(PG8_SB(0, 0), b2, voffB); PG8_STAGE(PG8_SB(0, 1), b2 + hstep, voffB); PG8_STAGE(PG8_SA(0, 0), a2, voffA);
            PG8_WAIT_V(8); PG8_WAIT_L(0); PG8_BAR; PG8_MMA(1, 0, At, B0); PG8_MMA(1, 1, At, B1); PG8_BAR; PG8_SCHED;
            PG8_LDB(B0, 1, 0); PG8_LDB(B1, 1, 1); PG8_SCHED; PG8_LDA(At, 1, 0); PG8_STAGE(PG8_SA(0, 1), a2 + hstep, voffA);
            PG8_WAIT_V(8); PG8_WAIT_L(0); PG8_BAR; PG8_MMA(0, 0, At, B0); PG8_MMA(0, 1, At, B1); PG8_BAR; PG8_SCHED;
            PG8_LDA(At, 1, 1); PG8_STAGE(PG8_SB(1, 0), b3, voffB); PG8_STAGE(PG8_SB(1, 1), b3 + hstep, voffB); PG8_STAGE(PG8_SA(1, 0), a3, voffA);
            PG8_WAIT_V(8); PG8_WAIT_L(0); PG8_BAR; PG8_MMA(1, 0, At, B0); PG8_MMA(1, 1, At, B1); PG8_BAR; PG8_SCHED;
            } else {
            PG8_LDB(B0, 0, 0); PG8_SCHED; PG8_LDA(At, 0, 0); PG8_STAGE(PG8_SA(1, 1), a1 + hstep, voffA);
            PG8_WAIT_L(8); PG8_BAR; PG8_WAIT_L(0); PG8_MMA(0, 0, At, B0); PG8_BAR; PG8_SCHED;
            PG8_LDB(B1, 0, 1); PG8_STAGE(PG8_SB(0, 0), b2, voffB);
            PG8_BAR; PG8_WAIT_L(0); PG8_MMA(0, 1, At, B1); PG8_BAR;
            PG8_LDA(At, 0, 1); PG8_STAGE(PG8_SA(0, 0), a2, voffA);
            PG8_BAR; PG8_WAIT_L(0); PG8_MMA(1, 0, At, B0); PG8_BAR; PG8_SCHED;
            PG8_STAGE(PG8_SB(0, 1), b2 + hstep, voffB);
            PG8_WAIT_V(6); PG8_BAR; PG8_MMA(1, 1, At, B1); PG8_BAR;
            PG8_LDB(B0, 1, 0); PG8_SCHED; PG8_LDA(At, 1, 0); PG8_STAGE(PG8_SA(0, 1), a2 + hstep, voffA);
            PG8_WAIT_L(8); PG8_BAR; PG8_WAIT_L(0); PG8_MMA(0, 0, At, B0); PG8_BAR; PG8_SCHED;
            PG8_LDB(B1, 1, 1); PG8_STAGE(PG8_SB(1, 0), b3, voffB);
            PG8_BAR; PG8_WAIT_L(0); PG8_MMA(0, 1, At, B1); PG8_BAR;
            PG8_LDA(At, 1, 1); PG8_STAGE(PG8_SA(1, 0), a3, voffA);
            PG8_BAR; PG8_WAIT_L(0); PG8_MMA(1, 0, At, B0); PG8_BAR; PG8_SCHED;
            PG8_STAGE(PG8_SB(1, 1), b3 + hstep, voffB);
            PG8_WAIT_V(6); PG8_BAR; PG8_MMA(1, 1, At, B1); PG8_BAR;
            }
        }
        if constexpr (ALIGN_EPI) { if (wr == 0) PG8_BAR; }
        if constexpr (!Epi::AFTER_DRAIN) { E(acc, cur, wr, wc, fr, fq); S.done(cur); }
        if (!has_next) break;
#pragma unroll
        for (int a = 0; a < 2; ++a)
#pragma unroll
            for (int b = 0; b < 2; ++b)
#pragma unroll
                for (int m = 0; m < 4; ++m)
#pragma unroll
                    for (int n = 0; n < 2; ++n) acc[a][b][m][n] = (f32x4){0.f, 0.f, 0.f, 0.f};
        cur = nxt; cA = nA; cB = nB; ++ui;
        if constexpr (ALIGN_EPI) { if (wr == 1) PG8_BAR; }
    }
    PG8_WAIT_V(0);
    if constexpr (!ALIGN_EPI) { if (wr == 0) PG8_BAR; }
    PG8_BAR;
    if constexpr (Epi::AFTER_DRAIN) { E.fused(acc, cur, wr, wc, fr, fq, lds, wid, lane); S.done(cur); }
#undef PG8_SA
#undef PG8_SB
#undef PG8_STAGE
#undef PG8_LDA
#undef PG8_LDB
#undef PG8_MMA
#undef PG8_WAIT_V
#undef PG8_WAIT_L
#undef PG8_BAR
#undef PG8_SCHED
}
}


struct EpiQKV {
    static constexpr bool PERM = true, AFTER_DRAIN = false;
    bf16_t* base6; const float *qn, *kn;
    DI void operator()(const f32x4 (&acc)[2][2][4][2], const pg8::Unit& u, int wr, int wc, int fr, int fq) const {
        const int typ = u.pn >> 1, h = (u.pn & 1) * 4 + wc;
        bf16_t* reg = base6 + (size_t)typ * (16u << 19);
        const int row0 = u.pm * 256 + wr * 64 + fr;
        if (typ == 2 || typ == 5) {
#pragma unroll
            for (int ai = 0; ai < 2; ++ai)
#pragma unroll
                for (int m = 0; m < 4; ++m) {
                    const int tok = row0 + ai * 128 + m * 16, b = tok >> 11, sq = tok & 2047, tile = sq >> 5, kap = sq & 31;
                    const int s2 = kap >> 4, hh = (kap >> 2) & 1, jj = ((kap >> 3) & 1) * 4 + (kap & 3);
                    bf16_t* bp = reg + ((((size_t)(b * 8 + h) * 64 + tile) * 4 + s2 * 2) * 64 + hh * 32 + 8 * fq) * 8 + jj;
#pragma unroll
                    for (int bj = 0; bj < 2; ++bj)
#pragma unroll
                        for (int n = 0; n < 2; ++n)
#pragma unroll
                            for (int i = 0; i < 4; ++i) bp[(size_t)bj * 512 + (4 * n + i) * 8] = f2bf(acc[ai][bj][m][n][i]);
                }
        } else {
            const bool nrm = typ < 2;
            const float* g = (typ == 0) ? qn : kn;
            f32x4 gv[2][2];
#pragma unroll
            for (int bj = 0; bj < 2; ++bj)
#pragma unroll
                for (int n = 0; n < 2; ++n) gv[bj][n] = nrm ? *(const f32x4*)(g + 32 * bj + 8 * fq + 4 * n) : (f32x4){1.f, 1.f, 1.f, 1.f};
#pragma unroll
            for (int ai = 0; ai < 2; ++ai)
#pragma unroll
                for (int m = 0; m < 4; ++m) {
                    const int tok = row0 + ai * 128 + m * 16, b = tok >> 11, sq = tok & 2047, tile = sq >> 5, kap = sq & 31;
                    float rs = 1.f;
                    if (nrm) {
                        float ss = 0.f;
#pragma unroll
                        for (int bj = 0; bj < 2; ++bj)
#pragma unroll
                            for (int n = 0; n < 2; ++n) { const f32x4 v = acc[ai][bj][m][n]; ss += (v.x * v.x + v.y * v.y) + (v.z * v.z + v.w * v.w); }
                        ss += __shfl_xor(ss, 16); ss += __shfl_xor(ss, 32);
                        rs = rsqrtf(ss * (1.f / 64.f) + EPS);
                    }
                    bf16_t* dst = reg + ((((size_t)(b * 8 + h) * 64 + tile) * 4 + (fq >> 1)) * 64 + (fq & 1) * 32 + kap) * 8;
#pragma unroll
                    for (int bj = 0; bj < 2; ++bj) {
                        const f32x4 v0 = acc[ai][bj][m][0] * rs * gv[bj][0], v1 = acc[ai][bj][m][1] * rs * gv[bj][1];
                        u32x4 w; w.x = cvtpk(v0.x, v0.y); w.y = cvtpk(v0.z, v0.w); w.z = cvtpk(v1.x, v1.y); w.w = cvtpk(v1.z, v1.w);
                        *(u32x4*)(dst + (size_t)bj * 2 * 512) = w;
                    }
                }
        }
    }
};

struct EpiRes {
    static constexpr bool PERM = true, AFTER_DRAIN = false;
    const float* x; float* out; bf16_t* xn;
    DI void operator()(const f32x4 (&acc)[2][2][4][2], const pg8::Unit& u, int wr, int wc, int fr, int fq) const {
        const int row0 = u.pm * 256 + wr * 64 + fr, col0 = u.pn * 256 + wc * 32 + 8 * fq;
#pragma unroll
        for (int ai = 0; ai < 2; ++ai)
#pragma unroll
            for (int m = 0; m < 4; ++m)
#pragma unroll
                for (int bj = 0; bj < 2; ++bj) {
                    const size_t off = (size_t)(row0 + ai * 128 + m * 16) * 1024 + col0 + bj * 128;
                    const f32x4 h0 = *(const f32x4*)(x + off) + acc[ai][bj][m][0], h1 = *(const f32x4*)(x + off + 4) + acc[ai][bj][m][1];
                    *(f32x4*)(out + off) = h0; *(f32x4*)(out + off + 4) = h1;
                    u32x4 w; w.x = cvtpk(h0.x, h0.y); w.y = cvtpk(h0.z, h0.w); w.z = cvtpk(h1.x, h1.y); w.w = cvtpk(h1.z, h1.w);
                    *(u32x4*)(xn + off) = w;
                }
    }
};

struct EpiF32 {
    static constexpr bool PERM = true, AFTER_DRAIN = false;
    float* C; int ldc;
    DI void operator()(const f32x4 (&acc)[2][2][4][2], const pg8::Unit& u, int wr, int wc, int fr, int fq) const {
        const int row0 = u.pm * 256 + wr * 64 + fr, col0 = u.pn * 256 + wc * 32 + 8 * fq;
#pragma unroll
        for (int ai = 0; ai < 2; ++ai)
#pragma unroll
            for (int m = 0; m < 4; ++m)
#pragma unroll
                for (int bj = 0; bj < 2; ++bj) {
                    float* p = C + (size_t)(row0 + ai * 128 + m * 16) * ldc + col0 + bj * 128;
                    *(f32x4*)p = acc[ai][bj][m][0]; *(f32x4*)(p + 4) = acc[ai][bj][m][1];
                }
    }
};

struct EpiBf {
    static constexpr bool PERM = true, AFTER_DRAIN = false;
    bf16_t* C; int ldc;
    DI void operator()(const f32x4 (&acc)[2][2][4][2], const pg8::Unit& u, int wr, int wc, int fr, int fq) const {
        const int row0 = u.pm * 256 + wr * 64 + fr, col0 = u.pn * 256 + wc * 32 + 8 * fq;
#pragma unroll
        for (int ai = 0; ai < 2; ++ai)
#pragma unroll
            for (int m = 0; m < 4; ++m)
#pragma unroll
                for (int bj = 0; bj < 2; ++bj) {
                    const f32x4 v0 = acc[ai][bj][m][0], v1 = acc[ai][bj][m][1];
                    u32x4 w; w.x = cvtpk(v0.x, v0.y); w.y = cvtpk(v0.z, v0.w); w.z = cvtpk(v1.x, v1.y); w.w = cvtpk(v1.z, v1.w);
                    *(u32x4*)(C + (size_t)(row0 + ai * 128 + m * 16) * ldc + col0 + bj * 128) = w;
                }
    }
};

struct EpiGate {
    static constexpr bool PERM = true, AFTER_DRAIN = false;
    float* out; const bf16_t* pw; const float* ssq;
    DI void operator()(const f32x4 (&acc)[2][2][4][2], const pg8::Unit& u, int wr, int wc, int fr, int fq) const {
        const int row0 = u.pm * 256 + wr * 64 + fr, col0 = u.pn * 256 + wc * 32 + 8 * fq;
#pragma unroll
        for (int ai = 0; ai < 2; ++ai)
#pragma unroll
            for (int m = 0; m < 4; ++m) {
                const int row = row0 + ai * 128 + m * 16;
                float sq = 0.f;
#pragma unroll
                for (int x = 0; x < 8; ++x) sq += ssq[(size_t)x * T + row];
                const float rs3 = rsqrtf(sq * (1.f / 1024.f) + EPS);
#pragma unroll
                for (int bj = 0; bj < 2; ++bj) {
                    const size_t off = (size_t)row * 1024 + col0 + bj * 128;
                    const bf16x8 pv = *(const bf16x8*)(pw + off);
                    const f32x4 h0 = *(const f32x4*)(out + off), h1 = *(const f32x4*)(out + off + 4);
                    const f32x4 g0 = acc[ai][bj][m][0] * rs3, g1 = acc[ai][bj][m][1] * rs3;
                    f32x4 o0, o1;
#pragma unroll
                    for (int i = 0; i < 4; ++i) { o0[i] = h0[i] + bf2f(pv[i]) / (1.f + __expf(-g0[i])); o1[i] = h1[i] + bf2f(pv[4 + i]) / (1.f + __expf(-g1[i])); }
                    *(f32x4*)(out + off) = o0; *(f32x4*)(out + off + 4) = o1;
                }
            }
    }
};

template <class Epi>
DI void gemm_simple(const bf16_t* A, const bf16_t* Bt, int M, int N, int K, const Epi& epi, int gwave, int nwaves, int lane) {
    const int r32 = lane & 31, hi = lane >> 5;
    const int nNt = N / 64, total = (M / 32) * nNt;
    for (int tile = gwave; tile < total; tile += nwaves) {
        const int mt = tile / nNt, nt = tile - mt * nNt, m0 = mt * 32, n0 = nt * 64;
        const bf16_t* ap = A + (size_t)(m0 + r32) * K + 8 * hi;
        const bf16_t* b0p = Bt + (size_t)(n0 + r32) * K + 8 * hi;
        const bf16_t* b1p = b0p + (size_t)32 * K;
        f32x16 acc0 = zero16(), acc1 = zero16();
#pragma unroll 4
        for (int k = 0; k < K; k += 16) {
            const bf16x8 xa = *(const bf16x8*)(ap + k);
            const bf16x8 w0 = *(const bf16x8*)(b0p + k);
            const bf16x8 w1 = *(const bf16x8*)(b1p + k);
            acc0 = MFMA32(w0, xa, acc0);
            acc1 = MFMA32(w1, xa, acc1);
        }
        epi(m0 + r32, n0, hi, acc0, acc1);
    }
}

struct Epi1 {
    bf16_t* base6;
    const float *qn, *kn;
    DI void operator()(int tok, int n0, int hi, const f32x16& a0, const f32x16& a1) const {
        const int head48 = n0 >> 6, typ = head48 >> 3, h = head48 & 7;
        bf16_t* reg = base6 + (size_t)typ * (16u << 19);
        if (typ == 2 || typ == 5) {
            const int b = tok >> 11, s = tok & 2047;
            const int pos = (s & ~12) | ((s & 4) << 1) | ((s & 8) >> 1);
            bf16_t* base = reg + ((size_t)(b * 8 + h) * 64) * 2048 + pos;
#pragma unroll
            for (int r = 0; r < 16; ++r) { base[(size_t)crow(r, hi) * 2048] = f2bf(a0[r]); base[(size_t)(32 + crow(r, hi)) * 2048] = f2bf(a1[r]); }
        } else {
            float rs = 1.f;
            const bool nrm = (typ == 0 || typ == 1);
            if (nrm) { float ss = 0.f;
#pragma unroll
                for (int r = 0; r < 16; ++r) ss += a0[r] * a0[r] + a1[r] * a1[r];
                ss += __shfl_xor(ss, 32);
                rs = rsqrtf(ss * (1.f / 64.f) + EPS); }
            const float* g = (typ == 0) ? qn : kn;
            bf16_t* dst = reg + (size_t)tok * 512 + h * 64;
#pragma unroll
            for (int t = 0; t < 2; ++t)
#pragma unroll
                for (int g4 = 0; g4 < 4; ++g4) {
                    const int f0 = 32 * t + 8 * g4 + 4 * hi;
                    float v[4];
#pragma unroll
                    for (int i = 0; i < 4; ++i) { const float a = t ? a1[4 * g4 + i] : a0[4 * g4 + i]; v[i] = nrm ? a * rs * g[f0 + i] : a; }
                    u32x2 w; w.x = cvtpk(v[0], v[1]); w.y = cvtpk(v[2], v[3]);
                    *(u32x2*)(dst + f0) = w;
                }
        }
    }
};

struct Epi2 {
    const float* x; float* out; bf16_t* xn;
    DI void operator()(int tok, int n0, int hi, const f32x16& a0, const f32x16& a1) const {
#pragma unroll
        for (int t = 0; t < 2; ++t)
#pragma unroll
            for (int g4 = 0; g4 < 4; ++g4) {
                const size_t off = (size_t)tok * 1024 + n0 + 32 * t + 8 * g4 + 4 * hi;
                const f32x4 xv = *(const f32x4*)(x + off);
                f32x4 hv;
#pragma unroll
                for (int i = 0; i < 4; ++i) hv[i] = xv[i] + (t ? a1[4 * g4 + i] : a0[4 * g4 + i]);
                *(f32x4*)(out + off) = hv;
                u32x2 w; w.x = cvtpk(hv[0], hv[1]); w.y = cvtpk(hv[2], hv[3]);
                *(u32x2*)(xn + off) = w;
            }
    }
};

struct Epi3 {
    float* sc;
    DI void operator()(int tok, int n0, int hi, const f32x16& a0, const f32x16& a1) const {
#pragma unroll
        for (int t = 0; t < 2; ++t)
#pragma unroll
            for (int g4 = 0; g4 < 4; ++g4) {
                f32x4 v;
#pragma unroll
                for (int i = 0; i < 4; ++i) v[i] = t ? a1[4 * g4 + i] : a0[4 * g4 + i];
                *(f32x4*)(sc + (size_t)tok * 2048 + n0 + 32 * t + 8 * g4 + 4 * hi) = v;
            }
    }
};

DI void pv_accum(f32x16& o0, f32x16& o1, const f32x16& p, const bf16_t* vt_row) {
#pragma unroll
    for (int s = 0; s < 2; ++s) {
        u32x4 pk; pk.x = cvtpk(p[8 * s], p[8 * s + 1]); pk.y = cvtpk(p[8 * s + 2], p[8 * s + 3]); pk.z = cvtpk(p[8 * s + 4], p[8 * s + 5]); pk.w = cvtpk(p[8 * s + 6], p[8 * s + 7]);
        const bf16x8 pb = __builtin_bit_cast(bf16x8, pk);
        const bf16x8 v0 = *(const bf16x8*)(vt_row + 16 * s);
        const bf16x8 v1 = *(const bf16x8*)(vt_row + (size_t)32 * 2048 + 16 * s);
        o0 = MFMA32(v0, pb, o0);
        o1 = MFMA32(v1, pb, o1);
    }
}

DI void store_o(bf16_t* op, const f32x16& o0, const f32x16& o1, float inv, int hi) {
#pragma unroll
    for (int t = 0; t < 2; ++t)
#pragma unroll
        for (int g4 = 0; g4 < 4; ++g4) {
            u32x2 w;
            if (t == 0) { w.x = cvtpk(o0[4 * g4] * inv, o0[4 * g4 + 1] * inv); w.y = cvtpk(o0[4 * g4 + 2] * inv, o0[4 * g4 + 3] * inv); }
            else        { w.x = cvtpk(o1[4 * g4] * inv, o1[4 * g4 + 1] * inv); w.y = cvtpk(o1[4 * g4 + 2] * inv, o1[4 * g4 + 3] * inv); }
            *(u32x2*)(op + 32 * t + 8 * g4 + 4 * hi) = w;
        }
}

constexpr int OT_PITCH = 1040;
DI void store_o_lds(LAS unsigned char* ot, int r32, int h, const f32x16& o0, const f32x16& o1, float inv, int hi) {
    LAS unsigned char* op = ot + r32 * OT_PITCH + h * 128;
#pragma unroll
    for (int t = 0; t < 2; ++t)
#pragma unroll
        for (int g4 = 0; g4 < 4; ++g4) {
            u32x2 w;
            if (t == 0) { w.x = cvtpk(o0[4 * g4] * inv, o0[4 * g4 + 1] * inv); w.y = cvtpk(o0[4 * g4 + 2] * inv, o0[4 * g4 + 3] * inv); }
            else        { w.x = cvtpk(o1[4 * g4] * inv, o1[4 * g4 + 1] * inv); w.y = cvtpk(o1[4 * g4 + 2] * inv, o1[4 * g4 + 3] * inv); }
            *(LAS u32x2*)(op + (32 * t + 8 * g4 + 4 * hi) * 2) = w;
        }
}
DI void load_kfrag(bf16x8 (&kf)[4], const bf16_t* fbase  , int tile) {
    const bf16_t* kp = fbase + (size_t)tile * 2048;
#pragma unroll
    for (int s = 0; s < 4; ++s) kf[s] = *(const bf16x8*)(kp + s * 512);
}
DI void load_vfrag(bf16x8 (&vf)[4], const bf16_t* fbase, int tile) {
    const bf16_t* vp = fbase + (size_t)tile * 2048;
#pragma unroll
    for (int q = 0; q < 4; ++q) vf[q] = *(const bf16x8*)(vp + q * 512);
}
DI void pv_accum2(f32x16& o0, f32x16& o1, const f32x16& p, const bf16x8 (&vf)[4]) {
#pragma unroll
    for (int s = 0; s < 2; ++s) {
        u32x4 pk; pk.x = cvtpk(p[8 * s], p[8 * s + 1]); pk.y = cvtpk(p[8 * s + 2], p[8 * s + 3]); pk.z = cvtpk(p[8 * s + 4], p[8 * s + 5]); pk.w = cvtpk(p[8 * s + 6], p[8 * s + 7]);
        const bf16x8 pb = __builtin_bit_cast(bf16x8, pk);
        o0 = MFMA32(vf[2 * s], pb, o0);
        o1 = MFMA32(vf[2 * s + 1], pb, o1);
    }
}

#define MEM_FENCE() asm volatile("" ::: "memory")
#define PIN1(a) asm volatile("" : "+v"(a) :: "memory")
#define PIN2(a, b) asm volatile("" : "+v"(a), "+v"(b) :: "memory")
DI void vm_drain() { __builtin_amdgcn_s_waitcnt(0x0F70); }
struct KvStream { const bf16_t* kbase; const bf16_t* vbase; };

struct MobaCtx { int q0, tq, blk, hi; unsigned selmask; float bfar; const LAS float* bt; };
DI void moba_tile(bf16x8 (&kf)[4], bf16x8 (&vf)[4], const bf16x8 (&qf)[4], int kt, int next, const KvStream& kv, const MobaCtx& c, float& mrun, float& lsum, f32x16& o0, f32x16& o1) {
    const int n = kt >> 3, key0 = kt * 32;
    f32x16 st = zero16();
#pragma unroll
    for (int s = 0; s < 4; ++s) st = MFMA32(kf[s], qf[s], st);
    PIN1(st); load_kfrag(kf, kv.kbase, next); PIN1(st);
    float x[16];
    if (n != c.blk) {
        const bool selq = (c.selmask >> n) & 1u;
        if ((c.q0 - (key0 + 31)) >= 128) {
            const float addend = selq ? c.bfar : -1e30f;
#pragma unroll
            for (int r = 0; r < 16; ++r) x[r] = st[r] * SCL2 + addend;
        } else {
#pragma unroll
            for (int r = 0; r < 16; ++r) { const int dist = c.tq - (key0 + crow(r, c.hi)); const float v = st[r] * SCL2 + c.bt[dist > 128 ? 128 : dist]; x[r] = selq ? v : -1e30f; }
        }
    } else {
#pragma unroll
        for (int r = 0; r < 16; ++r) { const int dist = c.tq - (key0 + crow(r, c.hi)); const float v = st[r] * SCL2 + c.bt[dist < 0 ? 0 : (dist > 128 ? 128 : dist)]; x[r] = (dist >= 0) ? v : -1e30f; }
    }
    float mx = x[0];
#pragma unroll
    for (int r = 1; r < 16; ++r) mx = fmaxf(mx, x[r]);
    mx = fmaxf(mx, __shfl_xor(mx, 32));
    const float mnew = fmaxf(mrun, mx);
    if (!__all(mnew == mrun)) {
        const float alpha = __builtin_amdgcn_exp2f(mrun - mnew);
        lsum *= alpha;
#pragma unroll
        for (int r = 0; r < 16; ++r) { o0[r] *= alpha; o1[r] *= alpha; }
        mrun = mnew;
    }
    f32x16 pr; float ps = 0.f;
#pragma unroll
    for (int r = 0; r < 16; ++r) { const float e = __builtin_amdgcn_exp2f(x[r] - mrun); pr[r] = e; ps += e; }
    lsum += ps;
    pv_accum2(o0, o1, pr, vf);
    PIN2(o0, o1); load_vfrag(vf, kv.vbase, next); MEM_FENCE();
}
DI int moba_next(int kt, int blk, unsigned anysel) {
    int nkt = kt - 1;
    while (nkt >= 0) { const int nn = nkt >> 3; if (nn == blk || ((anysel >> nn) & 1u)) break; nkt = nn * 8 - 1; }
    return nkt;
}

DI void moba_unit(int b, int h, int qt, const bf16_t* Qm_, const bf16_t* Km_, const bf16_t* VtM_, const float* kmean_, const LAS float* biasLds, LAS unsigned char* ot, int lane) {
    const int r32 = lane & 31, hi = lane >> 5;
    const int q0 = qt * 32, tq = q0 + r32, blk = q0 >> 8;
    const size_t bh = (size_t)(b * 8 + h);
    const bf16_t* qfb = Qm_ + bh * (64 * 2048) + (size_t)qt * 2048;
    KvStream kv; kv.kbase = Km_ + bh * (64 * 2048) + lane * 8; kv.vbase = VtM_ + bh * (64 * 2048) + lane * 8;
    bf16x8 kf[4], vf[4];
    load_kfrag(kf, kv.kbase, qt); load_vfrag(vf, kv.vbase, qt);
    bf16x8 qf[4];
#pragma unroll
    for (int s = 0; s < 4; ++s) qf[s] = *(const bf16x8*)(qfb + s * 512 + lane * 8);
    unsigned selmask = 0;
    if (blk > 0) {
        float qv[32];
#pragma unroll
        for (int c = 0; c < 4; ++c) { const bf16x8 t = *(const bf16x8*)(qfb + (2 * hi + (c >> 1)) * 512 + ((c & 1) * 32 + r32) * 8);
#pragma unroll
            for (int j = 0; j < 8; ++j) qv[8 * c + j] = bf2f(t[j]); }
        const float* km = kmean_ + (size_t)((b * 8 + h) * 8) * 64 + 32 * hi;
        float g[8];
#pragma unroll
        for (int n = 0; n < 8; ++n) {
            float a = 0.f;
            if (n < blk) {
#pragma unroll
                for (int d4 = 0; d4 < 8; ++d4) { const f32x4 kv4 = *(const f32x4*)(km + n * 64 + 4 * d4); a += (qv[4 * d4] * kv4.x + qv[4 * d4 + 1] * kv4.y) + (qv[4 * d4 + 2] * kv4.z + qv[4 * d4 + 3] * kv4.w); }
            }
            a += __shfl_xor(a, 32);
            g[n] = (n < blk) ? a : -INFINITY;
        }
#pragma unroll
        for (int n = 0; n < 8; ++n) {
            int rank = 0;
#pragma unroll
            for (int m = 0; m < 8; ++m) if (m != n) rank += ((g[m] > g[n]) || (g[m] == g[n] && m < n)) ? 1 : 0;
            if (n < blk && rank < 3) selmask |= 1u << n;
        }
    }
    unsigned anysel = 0;
#pragma unroll
    for (int n = 0; n < 8; ++n) if (__any((selmask >> n) & 1u)) anysel |= 1u << n;
    anysel = __builtin_amdgcn_readfirstlane(anysel);
    float mrun = -1e30f, lsum = 0.f;
    f32x16 o0 = zero16(), o1 = zero16();
    MobaCtx c; c.q0 = q0; c.tq = tq; c.blk = blk; c.hi = hi; c.selmask = selmask; c.bt = biasLds + h * 132; c.bfar = c.bt[128];
    vm_drain();
    int kt = qt;
    for (;;) {
        const int nx = moba_next(kt, blk, anysel);
        moba_tile(kf, vf, qf, kt, nx < 0 ? 0 : nx, kv, c, mrun, lsum, o0, o1);
        if (nx < 0) break;
        kt = nx;
    }
    lsum += __shfl_xor(lsum, 32);
    const float inv = 1.f / lsum;
    store_o_lds(ot, r32, h, o0, o1, inv, hi);
}

DI void sb_tile(bf16x8 (&kf)[4], bf16x8 (&vf)[4], const bf16x8 (&qf)[4], int kt, int next, const KvStream& kv, int tq, int hi, float& C, f32x16& o0, f32x16& o1) {
    const int key0 = kt * 32;
    f32x16 st = zero16();
#pragma unroll
    for (int s = 0; s < 4; ++s) st = MFMA32(kf[s], qf[s], st);
    PIN1(st); load_kfrag(kf, kv.kbase, next); PIN1(st);
    float rr[16], be[16];
#pragma unroll
    for (int r = 0; r < 16; ++r) {
        const int key = key0 + crow(r, hi);
        const float y = fminf(st[r] * SCL2, 100.f);
        const float e = __builtin_amdgcn_exp2f(y);
        const float ri = __builtin_amdgcn_rcpf(1.f + e);
        const bool ok = key < tq;
        rr[r] = ok ? ri : 1.f;
        be[r] = ok ? e * ri : 0.f;
    }
    float G[4], ex[16], Gp[4], Tt[4], Suf[4];
#pragma unroll
    for (int a = 0; a < 4; ++a) {
        ex[4 * a + 3] = 1.f; ex[4 * a + 2] = rr[4 * a + 3]; ex[4 * a + 1] = ex[4 * a + 2] * rr[4 * a + 2]; ex[4 * a] = ex[4 * a + 1] * rr[4 * a + 1];
        G[a] = ex[4 * a] * rr[4 * a];
    }
#pragma unroll
    for (int a = 0; a < 4; ++a) { Gp[a] = __shfl_xor(G[a], 32); Tt[a] = G[a] * Gp[a]; }
    Suf[3] = 1.f; Suf[2] = Tt[3]; Suf[1] = Tt[3] * Tt[2]; Suf[0] = Suf[1] * Tt[1];
    f32x16 pr;
#pragma unroll
    for (int a = 0; a < 4; ++a) {
        const float after = Suf[a] * (hi == 0 ? Gp[a] : 1.f) * C;
#pragma unroll
        for (int i = 0; i < 4; ++i) pr[4 * a + i] = be[4 * a + i] * ex[4 * a + i] * after;
    }
    C = C * (Suf[0] * Tt[0]);
    pv_accum2(o0, o1, pr, vf);
    PIN2(o0, o1); load_vfrag(vf, kv.vbase, next); MEM_FENCE();
}

DI void sb_unit(int b, int h, int qt, const bf16_t* Qs_, const bf16_t* Ks_, const bf16_t* VtS_, LAS unsigned char* ot, int lane) {
    const int r32 = lane & 31, hi = lane >> 5;
    const int q0 = qt * 32, tq = q0 + r32;
    const size_t bh = (size_t)(b * 8 + h);
    const bf16_t* qfb = Qs_ + bh * (64 * 2048) + (size_t)qt * 2048;
    KvStream kv; kv.kbase = Ks_ + bh * (64 * 2048) + lane * 8; kv.vbase = VtS_ + bh * (64 * 2048) + lane * 8;
    bf16x8 kf[4], vf[4];
    load_kfrag(kf, kv.kbase, qt); load_vfrag(vf, kv.vbase, qt);
    bf16x8 qf[4];
#pragma unroll
    for (int s = 0; s < 4; ++s) qf[s] = *(const bf16x8*)(qfb + s * 512 + lane * 8);
    f32x16 o0 = zero16(), o1 = zero16();
    float C = 1.f;
    vm_drain();
    for (int kt = qt; kt >= 0; --kt) {
        sb_tile(kf, vf, qf, kt, kt > 0 ? kt - 1 : 0, kv, tq, hi, C, o0, o1);
        if (__all(C == 0.f ? 1 : 0)) break;
    }
    store_o_lds(ot, r32, h, o0, o1, 1.f, hi);
}

DI void ce_desc(unsigned& a, unsigned& b) { const unsigned hi = a > b ? a : b, lo = a > b ? b : a; a = hi; b = lo; }
DI void bitonic_clean_desc(unsigned (&v)[16]) {
#pragma unroll
    for (int s = 8; s >= 1; s >>= 1)
#pragma unroll
        for (int i = 0; i < 16; ++i) if ((i & s) == 0) ce_desc(v[i], v[i + s]);
}
DI void sort16_desc(unsigned (&v)[16]) {
#pragma unroll
    for (int k = 2; k <= 16; k <<= 1)
#pragma unroll
        for (int j = k >> 1; j >= 1; j >>= 1)
#pragma unroll
            for (int i = 0; i < 16; ++i) { const int l = i ^ j; if (l > i) { if ((i & k) == 0) ce_desc(v[i], v[l]); else ce_desc(v[l], v[i]); } }
}
DI float key_value(unsigned key) { const unsigned kk = key & ~127u; const unsigned u = (kk & 0x80000000u) ? (kk & 0x7fffffffu) : ~kk; return __builtin_bit_cast(float, u); }

DI float reduce16(const float (&p)[16], int lane) {
    const bool b3 = lane & 8, b2 = lane & 4, b1 = lane & 2, b0 = lane & 1;
    float q[8], r[4], s[2];
#pragma unroll
    for (int i = 0; i < 8; ++i) { const float mine = b3 ? p[i + 8] : p[i], send = b3 ? p[i] : p[i + 8]; q[i] = mine + __shfl_xor(send, 8); }
#pragma unroll
    for (int i = 0; i < 4; ++i) { const float mine = b2 ? q[i + 4] : q[i], send = b2 ? q[i] : q[i + 4]; r[i] = mine + __shfl_xor(send, 4); }
#pragma unroll
    for (int i = 0; i < 2; ++i) { const float mine = b1 ? r[i + 2] : r[i], send = b1 ? r[i] : r[i + 2]; s[i] = mine + __shfl_xor(send, 2); }
    const float mine = b0 ? s[1] : s[0], send = b0 ? s[0] : s[1];
    float t = mine + __shfl_xor(send, 1);
    t += __shfl_xor(t, 16);
    t += __shfl_xor(t, 32);
    return t;
}

#ifndef PEER_REP_TOPK
#define PEER_REP_TOPK 1
#endif
#ifndef PEER_REP_U
#define PEER_REP_U 1
#endif
#ifndef PEER_REP_V
#define PEER_REP_V 1
#endif
struct TopkIn { f32x4 hv[4]; bf16x8 sv[4]; };
DI void peer_topk_load(TopkIn& in, int tok, const float* out, const bf16_t* scores, int lane) {
    const int tc = tok < T ? tok : T - 1;
    const float* hrow = out + (size_t)tc * 1024 + 16 * lane;
    const bf16_t* sp = scores + (size_t)tc * 2048 + (lane >> 2) * 128 + (lane & 3) * 8;
#pragma unroll
    for (int i = 0; i < 4; ++i) { in.hv[i] = *(const f32x4*)(hrow + 4 * i); in.sv[i] = *(const bf16x8*)(sp + 32 * i); }
}
DI void peer_topk_token(int tok, const TopkIn& in, const float* gffn, int* EIDXg, float* GATEg, unsigned char* XN2g, LAS float* wl, int lane) {
    LAS unsigned* kbuf = (LAS unsigned*)wl; LAS unsigned* cand = (LAS unsigned*)(wl + 256); const LAS unsigned* ctab = (const LAS unsigned*)(wl + 768);
    f32x4 hv[4];
    float ss = 0.f;
#pragma unroll
    for (int i = 0; i < 4; ++i) { hv[i] = in.hv[i]; ss += (hv[i].x * hv[i].x + hv[i].y * hv[i].y) + (hv[i].z * hv[i].z + hv[i].w * hv[i].w); }
    ss = wave_sum(ss);
    const float rs2 = rsqrtf(ss * (1.f / 1024.f) + EPS);
    {
        u32x4 w;
#pragma unroll
        for (int i = 0; i < 4; ++i) { const f32x4 gv = *(const f32x4*)(gffn + 16 * lane + 4 * i);
            const float y0 = fminf(fmaxf(hv[i][0] * rs2 * gv[0] * 64.f, -448.f), 448.f), y1 = fminf(fmaxf(hv[i][1] * rs2 * gv[1] * 64.f, -448.f), 448.f);
            const float y2 = fminf(fmaxf(hv[i][2] * rs2 * gv[2] * 64.f, -448.f), 448.f), y3 = fminf(fmaxf(hv[i][3] * rs2 * gv[3] * 64.f, -448.f), 448.f);
            int p = 0;
            p = __builtin_amdgcn_cvt_pk_fp8_f32(y0, y1, p, false);
            p = __builtin_amdgcn_cvt_pk_fp8_f32(y2, y3, p, true);
            w[i] = (unsigned)p; }
        *(u32x4*)(XN2g + (size_t)tok * 1024 + 16 * lane) = w;
    }
    {
        const int L = lane >> 2, q = lane & 3;
        unsigned k0[16], k1[16];
#pragma unroll
        for (int i = 0; i < 4; ++i) {
            const bf16x8 v = in.sv[i];
#pragma unroll
            for (int cI = 0; cI < 8; ++cI) {
                const unsigned u = ((unsigned)(unsigned short)v[cI]) << 16;
                const unsigned mono = (u & 0x80000000u) ? ~u : (u | 0x80000000u);
                const unsigned key = (mono & ~127u) | (unsigned)(127 - (32 * i + 8 * q + cI));
                if (i < 2) k0[8 * i + cI] = key; else k1[8 * (i - 2) + cI] = key;
            }
        }
        sort16_desc(k0); sort16_desc(k1);
        unsigned t[16];
#pragma unroll
        for (int i = 0; i < 16; ++i) t[i] = k0[i] > k1[15 - i] ? k0[i] : k1[15 - i];
        bitonic_clean_desc(t);
#pragma unroll
        for (int i = 0; i < 16; ++i) k0[i] = (unsigned)__builtin_amdgcn_update_dpp(0, (int)t[15 - i], 0xB1, 0xF, 0xF, true);
#pragma unroll
        for (int i = 0; i < 16; ++i) t[i] = t[i] > k0[i] ? t[i] : k0[i];
        bitonic_clean_desc(t);
#pragma unroll
        for (int i = 0; i < 16; ++i) k0[i] = (unsigned)__builtin_amdgcn_update_dpp(0, (int)t[15 - i], 0x4E, 0xF, 0xF, true);
#pragma unroll
        for (int i = 0; i < 16; ++i) t[i] = t[i] > k0[i] ? t[i] : k0[i];
        bitonic_clean_desc(t);
        if (q == 0) {
#pragma unroll
            for (int i = 0; i < 4; ++i) { u32x4 w; w.x = t[4 * i]; w.y = t[4 * i + 1]; w.z = t[4 * i + 2]; w.w = t[4 * i + 3]; *(LAS u32x4*)(kbuf + L * 16 + 4 * i) = w; }
        }
        asm volatile("s_waitcnt lgkmcnt(0)" ::: "memory");
    }
    {
        const int hd = lane >> 3, sub = lane & 7;
        unsigned ck[7]; int ce[7]; float cv[7];
#pragma unroll
        for (int k = 0; k < 7; ++k) {
            const int cidx = 7 * sub + k;
            const unsigned tab = ctab[cidx];
            const unsigned ka = kbuf[hd * 32 + (tab & 15u)], kb = kbuf[hd * 32 + 16 + ((tab >> 8) & 15u)];
            const float v = key_value(ka) + key_value(kb);
            cv[k] = v;
            ce[k] = (127 - (int)(ka & 127u)) * 128 + (127 - (int)(kb & 127u));
            const unsigned u = __float_as_uint(v);
            const unsigned mono = (u & 0x80000000u) ? ~u : (u | 0x80000000u);
            ck[k] = (cidx < 50) ? ((mono & ~63u) | (unsigned)(63 - cidx)) : 0u;
            cand[hd * 64 + cidx] = ck[k];
        }
        asm volatile("s_waitcnt lgkmcnt(0)" ::: "memory");
        int rank[7];
#pragma unroll
        for (int k = 0; k < 7; ++k) rank[k] = 0;
#pragma unroll
        for (int c4 = 0; c4 < 13; ++c4) {
            const u32x4 o4 = *(const LAS u32x4*)(cand + hd * 64 + 4 * c4);
#pragma unroll
            for (int i = 0; i < 4; ++i) if (4 * c4 + i < 50) {
#pragma unroll
                for (int k = 0; k < 7; ++k) rank[k] += (o4[i] > ck[k]) ? 1 : 0;
            }
        }
        float mx = -INFINITY;
#pragma unroll
        for (int k = 0; k < 7; ++k) mx = fmaxf(mx, (7 * sub + k < 50) ? cv[k] : -INFINITY);
        mx = fmaxf(mx, __shfl_xor(mx, 1)); mx = fmaxf(mx, __shfl_xor(mx, 2)); mx = fmaxf(mx, __shfl_xor(mx, 4));
        float ev[7], es = 0.f;
#pragma unroll
        for (int k = 0; k < 7; ++k) { const bool selk = (7 * sub + k < 50) && rank[k] < 16; ev[k] = selk ? __expf((cv[k] - mx) * rs2) : 0.f; es += ev[k]; }
        es += __shfl_xor(es, 1); es += __shfl_xor(es, 2); es += __shfl_xor(es, 4);
        const float inv = 1.f / es;
#pragma unroll
        for (int k = 0; k < 7; ++k) if ((7 * sub + k < 50) && rank[k] < 16) { EIDXg[(size_t)tok * 128 + hd * 16 + rank[k]] = ce[k]; GATEg[(size_t)tok * 128 + hd * 16 + rank[k]] = ev[k] * inv; }
    }
}

DI float dot16_fp8(const u32x4& row, const float (&x)[16]) {
    float sacc = 0.f;
#pragma unroll
    for (int w = 0; w < 4; ++w) { const f32x2 lo = __builtin_amdgcn_cvt_pk_f32_fp8((int)row[w], false), hi2 = __builtin_amdgcn_cvt_pk_f32_fp8((int)row[w], true);
        sacc += lo.x * x[4 * w] + lo.y * x[4 * w + 1] + hi2.x * x[4 * w + 2] + hi2.y * x[4 * w + 3]; }
    return sacc;
}
template <class TT> DI TT ldu(const void* ubase, unsigned off) { return *(const TT*)((const char*)ubase + off); }
typedef _Float16 h2_t __attribute__((ext_vector_type(2)));
DI void peer_u_slice(int sl, int tk_first, int tk_step, const unsigned char* XN8g, const int* EIDXg, const unsigned char* U8s, float* PDOT, int lane) {
    const int es = lane >> 3, c = lane & 7;
    const unsigned char* tb = U8s + (size_t)sl * 16384 * 128;
    const unsigned c16 = 16u * c, eoff = 64u * es, xoff = 128u * sl + 16u * c, poff = (16u * es + c) * 4u;
    const bool b2 = c & 4, b1 = c & 2, b0 = c & 1;
    u32x4 I0[2], I1[2], I2[2], rowsA[8], rowsB[8], rowsC[8], x0, x1, x2;
#define LD_E8(ib, tk, h) do { const int _t = (tk) < T ? (tk) : T - 1; const int* _eb = EIDXg + (size_t)_t * 128 + 8 * (h); ib[0] = ldu<u32x4>(_eb, eoff); ib[1] = ldu<u32x4>(_eb, eoff + 16u); } while (0)
#define LD_R8(rows, ib, tbl) do { _Pragma("unroll") for (int _q = 0; _q < 2; ++_q) _Pragma("unroll") for (int _r = 0; _r < 4; ++_r) rows[4 * _q + _r] = ldu<u32x4>(tbl, ib[_q][_r] * 128u + c16); } while (0)
#define LD_X(xx, tk) do { const int _t = (tk) < T ? (tk) : T - 1; xx = ldu<u32x4>(XN8g + (size_t)_t * 1024, xoff); } while (0)
#define U_COMPUTE8(rows, xx, tk, h) do { h2_t _x[8]; _Pragma("unroll") for (int _w = 0; _w < 4; ++_w) { _x[2 * _w] = __builtin_amdgcn_cvt_scalef32_pk_f16_fp8(xx[_w], 1.0f, false); _x[2 * _w + 1] = __builtin_amdgcn_cvt_scalef32_pk_f16_fp8(xx[_w], 1.0f, true); } \
        float _p[8]; _Pragma("unroll") for (int _i = 0; _i < 8; ++_i) { if (_i > 0) asm volatile("" : "+v"(rows[_i]) : "v"(_p[_i - 1])); float _s = 0.f; \
            _Pragma("unroll") for (int _w = 0; _w < 4; ++_w) { _s = __builtin_amdgcn_fdot2(__builtin_amdgcn_cvt_scalef32_pk_f16_fp8(rows[_i][_w], 1.0f, false), _x[2 * _w], _s, false); \
                _s = __builtin_amdgcn_fdot2(__builtin_amdgcn_cvt_scalef32_pk_f16_fp8(rows[_i][_w], 1.0f, true), _x[2 * _w + 1], _s, false); } _p[_i] = _s; } \
        float _q4[4], _q2[2]; \
        _Pragma("unroll") for (int _k = 0; _k < 4; ++_k) { const float _m = b2 ? _p[_k + 4] : _p[_k], _s = b2 ? _p[_k] : _p[_k + 4]; _q4[_k] = _m + __shfl_xor(_s, 4); } \
        _Pragma("unroll") for (int _k = 0; _k < 2; ++_k) { const float _m = b1 ? _q4[_k + 2] : _q4[_k], _s = b1 ? _q4[_k] : _q4[_k + 2]; _q2[_k] = _m + __shfl_xor(_s, 2); } \
        const float _m = b0 ? _q2[1] : _q2[0], _s = b0 ? _q2[0] : _q2[1]; const float _r1 = _m + __shfl_xor(_s, 1); \
        if ((tk) < T) { float* _pb = PDOT + ((size_t)sl * T + (tk)) * 128 + 8 * (h); *(float*)((char*)_pb + poff) = _r1; } } while (0)
    int t0 = tk_first;
    LD_E8(I0, t0, 0); LD_E8(I1, t0, 1); LD_E8(I2, t0 + tk_step, 0); LD_X(x0, t0); LD_R8(rowsA, I0, tb); LD_R8(rowsB, I1, tb);
#pragma unroll 1
    for (; t0 < T; t0 += 3 * tk_step) {
        const int t1 = t0 + tk_step, t2 = t1 + tk_step, t3 = t2 + tk_step;
        LD_E8(I0, t1, 1);           LD_R8(rowsC, I2, tb); LD_X(x1, t1); U_COMPUTE8(rowsA, x0, t0, 0);
        LD_E8(I1, t2, 0);           LD_R8(rowsA, I0, tb);               U_COMPUTE8(rowsB, x0, t0, 1);
        LD_E8(I2, t2, 1);           LD_R8(rowsB, I1, tb); LD_X(x2, t2); U_COMPUTE8(rowsC, x1, t1, 0);
        LD_E8(I0, t3, 0);           LD_R8(rowsC, I2, tb);               U_COMPUTE8(rowsA, x1, t1, 1);
        LD_E8(I1, t3, 1);           LD_R8(rowsA, I0, tb); LD_X(x0, t3); U_COMPUTE8(rowsB, x2, t2, 0);
        LD_E8(I2, t3 + tk_step, 0); LD_R8(rowsB, I1, tb);               U_COMPUTE8(rowsC, x2, t2, 1);
    }
#undef U_COMPUTE8
#undef LD_X
}
template <int NT> DI void peer_cj_tokens(int tok0, int tstride, const int* EIDXg, const float* GATEg, const float* PDOT, const float* usc, const float* vsc, float* CJg, float* CMAXg, int lane) {
    int e[NT][2]; float d[NT][2], g[NT][2];
#pragma unroll
    for (int i = 0; i < NT; ++i) { const int tok = tok0 + i * tstride, tc = tok < T ? tok : T - 1;
#pragma unroll
        for (int hh = 0; hh < 2; ++hh) { const int j = lane + 64 * hh; e[i][hh] = EIDXg[(size_t)tc * 128 + j]; g[i][hh] = GATEg[(size_t)tc * 128 + j]; float a = 0.f;
#pragma unroll
            for (int x = 0; x < 8; ++x) a += PDOT[((size_t)x * T + tc) * 128 + j];
            d[i][hh] = a; } }
    float us[NT][2], vs[NT][2];
#pragma unroll
    for (int i = 0; i < NT; ++i)
#pragma unroll
        for (int hh = 0; hh < 2; ++hh) { us[i][hh] = usc[e[i][hh]]; vs[i][hh] = vsc[e[i][hh]]; }
#pragma unroll
    for (int i = 0; i < NT; ++i) { const int tok = tok0 + i * tstride;
        float cv[2], cm = 0.f;
#pragma unroll
        for (int hh = 0; hh < 2; ++hh) {
            const float hraw = d[i][hh] * us[i][hh] * (1.f / 64.f);
            const float hid = 0.5f * hraw * (1.f + erff(hraw * 0.70710678118654752f));
            cv[hh] = hid * g[i][hh] * vs[i][hh];
            cm = fmaxf(cm, fabsf(cv[hh]));
        }
#pragma unroll
        for (int o = 1; o < 64; o <<= 1) cm = fmaxf(cm, __shfl_xor(cm, o));
        const float inv = cm > 0.f ? 1.f / cm : 0.f;
        if (tok < T) { CJg[(size_t)tok * 128 + lane] = cv[0] * inv; CJg[(size_t)tok * 128 + 64 + lane] = cv[1] * inv; if (lane == 0) CMAXg[tok] = cm; }
    }
}
DI void peer_v_slice(int sl, int tk_first, int tk_step, float* out, const int* EIDXg, const float* CJg, const float* CMAXg, const unsigned char* V8s, bf16_t* A4g, float* SSQg, int lane) {
    const int es = lane >> 3, c = lane & 7;
    const unsigned char* tb = V8s + (size_t)sl * 16384 * 128;
    const unsigned c16 = 16u * c, eoff = 64u * es, ob = 128u * sl + 16u * c + 2u * es;
    const bool b5 = lane & 32, b4 = lane & 16, b3 = lane & 8;
    u32x4 I0[2], I1[2], I2[2], rowsA[8], rowsB[8], rowsC[8]; f32x4 cA[2], cB[2], cC[2]; f32x2 h0, h1, h2;
#define LD_C8(cc, tk, h) do { const int _t = (tk) < T ? (tk) : T - 1; const float* _cb = CJg + (size_t)_t * 128 + 8 * (h); cc[0] = ldu<f32x4>(_cb, eoff); cc[1] = ldu<f32x4>(_cb, eoff + 16u); } while (0)
#define V_AXPY8(rows, cc) do { _Pragma("unroll") for (int _q = 0; _q < 2; ++_q) _Pragma("unroll") for (int _r = 0; _r < 4; ++_r) { const _Float16 _ch = (_Float16)cc[_q][_r]; const h2_t _c2 = {_ch, _ch}; \
            _Pragma("unroll") for (int _w = 0; _w < 4; ++_w) { acch[2 * _w] = __builtin_amdgcn_cvt_scalef32_pk_f16_fp8(rows[4 * _q + _r][_w], 1.0f, false) * _c2 + acch[2 * _w]; \
                acch[2 * _w + 1] = __builtin_amdgcn_cvt_scalef32_pk_f16_fp8(rows[4 * _q + _r][_w], 1.0f, true) * _c2 + acch[2 * _w + 1]; } \
              \
            if (4 * _q + _r < 7) asm volatile("" : "+v"(acch[0]), "+v"(acch[1]), "+v"(acch[2]), "+v"(acch[3]), "+v"(acch[4]), "+v"(acch[5]), "+v"(acch[6]), "+v"(acch[7]), "+v"(rows[(4 * _q + _r + 1) & 7])); \
            else asm volatile("" : "+v"(acch[0]), "+v"(acch[1]), "+v"(acch[2]), "+v"(acch[3]), "+v"(acch[4]), "+v"(acch[5]), "+v"(acch[6]), "+v"(acch[7])); } } while (0)
#define LD_H(hh, tk) do { const int _t = (tk) < T ? (tk) : T - 1; hh = ldu<f32x2>(out + (size_t)_t * 1024, ob * 4u); } while (0)
#define V_ZERO() do { _Pragma("unroll") for (int _i = 0; _i < 8; ++_i) acch[_i] = (h2_t){(_Float16)0.f, (_Float16)0.f}; } while (0)
#define V_FINAL(hh, tk) do { float _a[16]; _Pragma("unroll") for (int _i = 0; _i < 8; ++_i) { _a[2 * _i] = (float)acch[_i].x; _a[2 * _i + 1] = (float)acch[_i].y; } \
        const float _cm = CMAXg[(tk) < T ? (tk) : T - 1]; \
        float _q8[8], _q4[4], _q2[2]; \
        _Pragma("unroll") for (int _k = 0; _k < 8; ++_k) { const float _m = b5 ? _a[_k + 8] : _a[_k], _s = b5 ? _a[_k] : _a[_k + 8]; _q8[_k] = _m + __shfl_xor(_s, 32); } \
        _Pragma("unroll") for (int _k = 0; _k < 4; ++_k) { const float _m = b4 ? _q8[_k + 4] : _q8[_k], _s = b4 ? _q8[_k] : _q8[_k + 4]; _q4[_k] = _m + __shfl_xor(_s, 16); } \
        _Pragma("unroll") for (int _k = 0; _k < 2; ++_k) { const float _m = b3 ? _q4[_k + 2] : _q4[_k], _s = b3 ? _q4[_k] : _q4[_k + 2]; _q2[_k] = _m + __shfl_xor(_s, 8); } \
        const float _ha = hh.x + _q2[0] * _cm, _hb = hh.y + _q2[1] * _cm; const float _ssq = wave_sum(_ha * _ha + _hb * _hb); \
        if ((tk) < T) { *(f32x2*)((char*)(out + (size_t)(tk) * 1024) + ob * 4u) = (f32x2){_ha, _hb}; *(unsigned*)((char*)(A4g + (size_t)(tk) * 1024) + ob * 2u) = cvtpk(_ha, _hb); \
            if (lane == 0) SSQg[(size_t)sl * T + (tk)] = _ssq; } } while (0)
    h2_t acch[8];
    int t0 = tk_first;
    LD_E8(I0, t0, 0); LD_E8(I1, t0, 1); LD_E8(I2, t0 + tk_step, 0); LD_H(h0, t0); LD_R8(rowsA, I0, tb); LD_C8(cA, t0, 0); LD_R8(rowsB, I1, tb); LD_C8(cB, t0, 1);
#pragma unroll 1
    for (; t0 < T; t0 += 3 * tk_step) {
        const int t1 = t0 + tk_step, t2 = t1 + tk_step, t3 = t2 + tk_step;
        LD_E8(I0, t1, 1);           LD_R8(rowsC, I2, tb); LD_C8(cC, t1, 0); LD_H(h1, t1); V_ZERO(); V_AXPY8(rowsA, cA);
        LD_E8(I1, t2, 0);           LD_R8(rowsA, I0, tb); LD_C8(cA, t1, 1);                          V_AXPY8(rowsB, cB); V_FINAL(h0, t0);
        LD_E8(I2, t2, 1);           LD_R8(rowsB, I1, tb); LD_C8(cB, t2, 0); LD_H(h2, t2); V_ZERO(); V_AXPY8(rowsC, cC);
        LD_E8(I0, t3, 0);           LD_R8(rowsC, I2, tb); LD_C8(cC, t2, 1);                          V_AXPY8(rowsA, cA); V_FINAL(h1, t1);
        LD_E8(I1, t3, 1);           LD_R8(rowsA, I0, tb); LD_C8(cA, t3, 0); LD_H(h0, t3); V_ZERO(); V_AXPY8(rowsB, cB);
        LD_E8(I2, t3 + tk_step, 0); LD_R8(rowsB, I1, tb); LD_C8(cB, t3, 1);                          V_AXPY8(rowsC, cC); V_FINAL(h2, t2);
    }
#undef V_FINAL
#undef V_ZERO
#undef LD_H
#undef V_AXPY8
#undef LD_C8
#undef LD_R8
#undef LD_E8
}

typedef const __attribute__((address_space(4))) unsigned long long* karg_ptr_t;
DI karg_ptr_t kargs() { karg_ptr_t p = (karg_ptr_t)__builtin_amdgcn_kernarg_segment_ptr(); asm volatile("" : "+s"(p)); return p; }
#define GAS1 __attribute__((address_space(1)))
#define KIN(k) ((const float*)(const GAS1 float*)kargs()[k])
#define KOUT() ((float*)(GAS1 float*)kargs()[18])
#define KWS() ((unsigned char*)(GAS1 unsigned char*)kargs()[19])

__global__ void __launch_bounds__(512, 2) fwd_kernel(Params P) {
    extern __shared__ __attribute__((aligned(16))) unsigned char lds_raw[];
    LAS unsigned char* lds = (LAS unsigned char*)lds_raw;
    const int tid = threadIdx.x, lane = tid & 63, wid = __builtin_amdgcn_readfirstlane(tid >> 6);
    const int wg = blockIdx.x, nwg = gridDim.x;
    const int gwave = wg * 8 + wid, nwaves = nwg * 8;
    const int lo = P.ph_lo, hi = P.ph_hi;

    volatile LAS unsigned* misc = (volatile LAS unsigned*)(lds + LDS_BYTES - 64);
    if (tid < 16) misc[tid] = 0u;
    __syncthreads();
    { unsigned* xcw = (unsigned*)(KWS() + WS_CTL) + CW_XC;
      if (tid == 0) { const unsigned xcc = xb_xcc_id(); misc[5] = xcc; misc[4] = xb_add(xcw + 64 * xcc, 1u); } }
    XcdBarrier bar; bar.bar = (unsigned*)(KWS() + WS_CTL) + CW_BAR; bar.x = 0; bar.st = misc;
    if (hi - lo > 1) bar = xcd_barrier_post((unsigned*)(KWS() + WS_CTL) + CW_BAR, misc);

#define kmean   ((float*)(KWS() + WS_KMEAN))
#define biasTab ((float*)(KWS() + WS_BIAS))
#define WinT    ((bf16_t*)(KWS() + WS_WIN))
#define WoutT   ((bf16_t*)(KWS() + WS_WOUT))
#define WqT     ((bf16_t*)(KWS() + WS_WQ))
#define WgT     ((bf16_t*)(KWS() + WS_WG))
#define WpleT   ((bf16_t*)(KWS() + WS_WPLE))
#define U8      ((unsigned char*)(KWS() + WS_U))
#define V8      ((unsigned char*)(KWS() + WS_V))
#define USC     ((float*)(KWS() + WS_USC))
#define VSC     ((float*)(KWS() + WS_VSC))
#define XN      ((bf16_t*)(KWS() + WS_XN))
#define PB      ((bf16_t*)(KWS() + WS_PB))
#define Qm      ((bf16_t*)(KWS() + WS_QM))
#define Km      ((bf16_t*)(KWS() + WS_KM))
#define VtM     ((bf16_t*)(KWS() + WS_VTM))
#define Qs      ((bf16_t*)(KWS() + WS_QS))
#define Ks      ((bf16_t*)(KWS() + WS_KS))
#define VtS     ((bf16_t*)(KWS() + WS_VTS))
#define Oraw    ((bf16_t*)(KWS() + WS_ORAW))
#define A2      ((bf16_t*)(KWS() + WS_A2))
#define A3      ((bf16_t*)(KWS() + WS_A3))
#define SC      ((float*)(KWS() + WS_SC))
#define EIDXG   ((int*)(KWS() + WS_EIDX))
#define GATEG   ((float*)(KWS() + WS_GATE))
#define CJG     ((float*)(KWS() + WS_CJ))
#define RS2G    ((float*)(KWS() + WS_RS2))
#define SSQG    ((float*)(KWS() + WS_SSQ))
#define PDOTG   ((float*)(KWS() + WS_PDOT))
#define A4G     ((bf16_t*)(KWS() + WS_A4))
#define XN2G    ((unsigned char*)(KWS() + WS_XN2))

#define IN(k) (lo <= (k) && (k) < hi)
#ifndef PROBE_PHASE
#define PROBE_PHASE -1
#endif
#ifndef PROBE_REPS
#define PROBE_REPS 1
#endif
#define REP(k) for (int _rep = 0; _rep < ((k) == PROBE_PHASE ? PROBE_REPS : 1); ++_rep)
#define SEAM(k) do { if (IN(k) && IN((k) + 1)) xcd_barrier(bar); } while (0)

    if (IN(0)) REP(0) {
        LAS float* scr = (LAS float*)lds;
        p0_transpose<true>(KIN(IN_WIN), 1024, 3072, WinT, scr, tid, wg, nwg);
        p0_transpose<false>(KIN(IN_WOUT), 1024, 1024, WoutT, scr, tid, wg, nwg);
        p0_transpose<false>(KIN(IN_WPG), 1024, 1024, WgT, scr, tid, wg, nwg, KIN(IN_PLE_NORM));
        p0_transpose<false>(KIN(IN_WPLE), 256, 1024, WpleT, scr, tid, wg, nwg);
        p0_fold(KIN(IN_PQ), KIN(IN_SUBK), KIN(IN_FFN_NORM), WqT, scr, tid, wg, nwg);
        const size_t gtid = (size_t)wg * 512 + tid, nthr = (size_t)nwg * 512;
        p0_convert(KIN(IN_P), PB, (size_t)T * 256, gtid, nthr);
        { const float* xp = KIN(IN_X); const float* gp = KIN(IN_ATTN_NORM); bf16_t* xo = XN;
          for (int row = gwave; row < T; row += 2 * nwaves) rmsnorm_rows2_bf16(xp, gp, xo, row, row + nwaves, lane); }
        if (wg == 0) {
            for (int idx = tid; idx < 8 * 129; idx += 512) {
                const int h = idx / 129, dist = idx % 129;
                int bk;
                if (dist < 16) bk = dist;
                else { const float v = logf((float)dist / 16.f) / 2.0794415416798357f * 16.f; bk = 16 + (int)v; bk = bk > 31 ? 31 : bk; }
                biasTab[h * 132 + dist] = KIN(IN_RELB)[bk * 8 + h] * LOG2E;
            }
        }
    }
    SEAM(0);
    if (IN(1)) REP(1) {
        pg8::Gemm g{XN, WinT, T, NPROJ, 1024}; pg8::StaticOrder S; S.init(T, NPROJ, nwg, wg);
        EpiQKV E{Qm, KIN(IN_QNORM), KIN(IN_KNORM)};
        pg8::gemm_phase<EpiQKV, pg8::StaticOrder, true, true>(lds, g, S, E);
    }
    SEAM(1);
    if (IN(2)) REP(2) {
        for (int item = gwave; item < 512; item += nwaves) {
            const int bhh = item >> 3, blk = item & 7;
            float sacc[4][8];
#pragma unroll
            for (int q = 0; q < 4; ++q)
#pragma unroll
                for (int j = 0; j < 8; ++j) sacc[q][j] = 0.f;
            const bf16_t* base = Km + ((size_t)bhh * 64 + blk * 8) * 2048 + lane * 8;
#pragma unroll 2
            for (int t8 = 0; t8 < 8; ++t8)
#pragma unroll
                for (int q = 0; q < 4; ++q) { const bf16x8 v = *(const bf16x8*)(base + (size_t)t8 * 2048 + q * 512);
#pragma unroll
                    for (int j = 0; j < 8; ++j) sacc[q][j] += bf2f(v[j]); }
#pragma unroll
            for (int q = 0; q < 4; ++q)
#pragma unroll
                for (int j = 0; j < 8; ++j) { float v = sacc[q][j];
#pragma unroll
                    for (int o = 1; o < 32; o <<= 1) v += __shfl_xor(v, o);
                    sacc[q][j] = v; }
            if ((lane & 31) == 0) {
                const int hh = lane >> 5;
#pragma unroll
                for (int q = 0; q < 4; ++q)
#pragma unroll
                    for (int j = 0; j < 8; ++j) kmean[(size_t)item * 64 + 16 * q + 8 * hh + j] = sacc[q][j] * (1.f / 256.f);
            }
        }
    }
    SEAM(2);
    if (IN(3)) REP(3) {
        const float* pu = KIN(IN_PU); const float* pv = KIN(IN_PV); unsigned char* u8 = U8; unsigned char* v8 = V8; float* usc_ = USC; float* vsc_ = VSC;
        const bf16_t* qm_ = Qm; const bf16_t* km_ = Km; const bf16_t* vtm_ = VtM; const bf16_t* qs_ = Qs; const bf16_t* ks_ = Ks; const bf16_t* vts_ = VtS;
        const float* kmn_ = kmean; const float* bt_ = biasTab; bf16_t* a2_ = A2;
        const float* gm_ = KIN(IN_ONM); const float* gs_ = KIN(IN_ONS);
        LAS unsigned char* ot = lds;
        LAS float* biasLds = (LAS float*)(lds + 34816);
        for (int i = tid; i < 8 * 132; i += 512) biasLds[i] = bt_[i];
        __syncthreads();
        int qrow = gwave;
        for (int u = gwave; u < 8192; u += nwaves) {
            const int grp = u >> 12, i = u & 4095;
            const int half = i >> 11, j = i & 2047;
            const int qt = half ? (j >> 6) : 63 - (j >> 6), bh = j & 63;
            const int b = bh >> 3, h = bh & 7;
            if (grp == 0) moba_unit(b, h, qt, qm_, km_, vtm_, kmn_, biasLds, ot, lane);
            else sb_unit(b, h, qt, qs_, ks_, vts_, ot, lane);
            __syncthreads();
            {
                const float* gg = grp ? gs_ : gm_;
                const f32x4 g0 = *(const f32x4*)(gg + 8 * lane), g1 = *(const f32x4*)(gg + 8 * lane + 4);
#pragma unroll
                for (int rr = 0; rr < 4; ++rr) {
                    const int row = 4 * wid + rr;
                    const bf16x8 v = *(const LAS bf16x8*)(ot + row * OT_PITCH + lane * 16);
                    float f[8], sq = 0.f;
#pragma unroll
                    for (int e = 0; e < 8; ++e) { f[e] = bf2f(v[e]); sq += f[e] * f[e]; }
                    sq = wave_sum(sq);
                    const float rs = rsqrtf(sq * (1.f / 512.f) + EPS);
                    u32x4 w; w.x = cvtpk(f[0] * rs * g0.x, f[1] * rs * g0.y); w.y = cvtpk(f[2] * rs * g0.z, f[3] * rs * g0.w);
                    w.z = cvtpk(f[4] * rs * g1.x, f[5] * rs * g1.y); w.w = cvtpk(f[6] * rs * g1.z, f[7] * rs * g1.w);
                    *(u32x4*)(a2_ + (size_t)(b * 2048 + qt * 32 + row) * 1024 + grp * 512 + 8 * lane) = w;
                }
            }
            __syncthreads();
            for (int k = 0; k < 1 && qrow < 16384; ++k, qrow += 2 * nwaves) p0_quant_rows4(pu, pv, u8, v8, usc_, vsc_, qrow, qrow + nwaves, lane);
        }
        for (; qrow < 16384; qrow += 2 * nwaves) p0_quant_rows4(pu, pv, u8, v8, usc_, vsc_, qrow, qrow + nwaves, lane);
    }
    SEAM(3);
    if (IN(5)) REP(5) {
        pg8::Gemm g{A2, WoutT, T, 1024, 1024}; pg8::StaticOrder S; S.init(T, 1024, nwg, wg);
        EpiRes E{KIN(IN_X), KOUT(), A3};
        pg8::gemm_phase<EpiRes, pg8::StaticOrder, true, true>(lds, g, S, E);
    }
    SEAM(5);
    if (IN(6)) REP(6) {
        pg8::Gemm g{A3, WqT, T, 2048, 1024}; pg8::StaticOrder S; S.init(T, 2048, nwg, wg);
        EpiBf E{(bf16_t*)SC, 2048};
        pg8::gemm_phase<EpiBf, pg8::StaticOrder, true, true>(lds, g, S, E);
    }
    SEAM(6);
    if (IN(7)) REP(7) {
        LAS float* wl = (LAS float*)(lds + wid * 4096);
        {
            const int c = lane; int ca, cb;
            if (c < 16) { ca = 0; cb = c; } else if (c < 24) { ca = 1; cb = c - 16; } else if (c < 29) { ca = 2; cb = c - 24; } else if (c < 33) { ca = 3; cb = c - 29; }
            else if (c < 36) { ca = 4; cb = c - 33; } else if (c < 42) { ca = 5 + ((c - 36) >> 1); cb = (c - 36) & 1; } else { ca = (c - 34) & 15; cb = 0; }
            ((LAS unsigned*)(wl + 768))[lane] = (unsigned)ca | ((unsigned)cb << 8);
            asm volatile("s_waitcnt lgkmcnt(0)" ::: "memory");
        }
        const float* h1p = KOUT(); const bf16_t* scp = (const bf16_t*)SC; const float* gfp = KIN(IN_FFN_NORM); int* eip = EIDXG; float* gtp = GATEG; unsigned char* xnp = XN2G;
        TopkIn inA, inB;
        peer_topk_load(inA, gwave, h1p, scp, lane);
        for (int tok = gwave; tok < T; tok += 2 * nwaves) {
            peer_topk_load(inB, tok + nwaves, h1p, scp, lane);
            peer_topk_token(tok, inA, gfp, eip, gtp, xnp, wl, lane);
            peer_topk_load(inA, tok + 2 * nwaves, h1p, scp, lane);
            if (tok + nwaves < T) peer_topk_token(tok + nwaves, inB, gfp, eip, gtp, xnp, wl, lane);
        }
    }
    SEAM(7);
    int sl_first = 0, sl_step = 1, tk_first = 0, tk_step = 8;
    if (IN(8) || IN(10)) {
        __syncthreads();
        const unsigned myx = misc[5], myrank = misc[4];
        unsigned nx = 0, myidx = 0, nloc = 1;
        unsigned* xc = (unsigned*)(KWS() + WS_CTL) + CW_XC;
#pragma unroll
        for (unsigned j = 0; j < 16; ++j) { const unsigned cj = xb_ld(xc + 64 * j); if (cj > 0u) { if (j < myx) ++myidx; ++nx; } if (j == myx) nloc = cj; }
        sl_first = __builtin_amdgcn_readfirstlane((int)myidx); sl_step = __builtin_amdgcn_readfirstlane((int)(nx > 0u ? nx : 1u));
        tk_first = __builtin_amdgcn_readfirstlane((int)myrank * 8 + wid); tk_step = __builtin_amdgcn_readfirstlane((int)(nloc > 0u ? nloc : 1u) * 8);
    }
    if (IN(8)) REP(8) {
        const unsigned char* xnp = XN2G; const int* eip = EIDXG; const unsigned char* u8p = U8; float* pdp = PDOTG;
        for (int sl = sl_first; sl < 8; sl += sl_step) peer_u_slice(sl, tk_first, tk_step, xnp, eip, u8p, pdp, lane);
    }
    SEAM(8);
    if (IN(9)) REP(9) {
        const int* eip = EIDXG; const float* gtp = GATEG; const float* pdp = PDOTG; const float* usp = USC; const float* vsp = VSC; float* cjp = CJG; float* cmp_ = RS2G;
        for (int tok = gwave; tok < T; tok += 4 * nwaves) peer_cj_tokens<4>(tok, nwaves, eip, gtp, pdp, usp, vsp, cjp, cmp_, lane);
    }
    SEAM(9);
    if (IN(10)) REP(10) {
        float* outp = KOUT(); const int* eip = EIDXG; const float* cjp = CJG; const float* cmp_ = RS2G; const unsigned char* v8p = V8; bf16_t* a4p = A4G; float* sqp = SSQG;
        for (int sl = sl_first; sl < 8; sl += sl_step) peer_v_slice(sl, tk_first, tk_step, outp, eip, cjp, cmp_, v8p, a4p, sqp, lane);
    }
    SEAM(10);
    if (IN(11)) REP(11) {
        bf16_t* PW = Oraw;
        { int kple = 256; asm volatile("" : "+s"(kple));
          pg8::Gemm g{PB, WpleT, T, 1024, kple}; pg8::StaticOrder S; S.init(T, 1024, nwg, wg);
          EpiBf E{PW, 1024};
          pg8::gemm_phase<EpiBf, pg8::StaticOrder, true, true>(lds, g, S, E); }
        asm volatile("s_waitcnt vmcnt(0)" ::: "memory");
        __syncthreads();
        { pg8::Gemm g{A4G, WgT, T, 1024, 1024}; pg8::StaticOrder S; S.init(T, 1024, nwg, wg);
          EpiGate E{KOUT(), PW, SSQG};
          pg8::gemm_phase<EpiGate, pg8::StaticOrder, true, true>(lds, g, S, E); }
    }
#undef IN
#undef SEAM
}

extern "C" void kernel_launch(void* const* d_in, const int* in_sizes, int n_in, void* d_out, int out_size, void* d_ws, size_t ws_size, hipStream_t stream) {
    static int grid = 0;
    if (grid == 0) {
        if (n_in != 18 || out_size != T * DM || ws_size < WS_END) { fprintf(stderr, "kernel_launch: unexpected shapes (n_in %d out %d ws %zu)\n", n_in, out_size, ws_size); grid = -1; return; }
        int dev = 0, cus = 0, per_cu = 0;
        if (hipGetDevice(&dev) != hipSuccess || hipDeviceGetAttribute(&cus, hipDeviceAttributeMultiprocessorCount, dev) != hipSuccess) { grid = -1; return; }
        if (hipFuncSetAttribute((const void*)fwd_kernel, hipFuncAttributeMaxDynamicSharedMemorySize, LDS_BYTES) != hipSuccess) { fprintf(stderr, "kernel_launch: hipFuncSetAttribute failed\n"); grid = -1; return; }
        if (hipOccupancyMaxActiveBlocksPerMultiprocessor(&per_cu, (const void*)fwd_kernel, 512, LDS_BYTES) != hipSuccess || per_cu < 1)
            fprintf(stderr, "kernel_launch: note: occupancy query reports %d\n", per_cu);
        (void)hipGetLastError();
        grid = cus - (cus % 8);
    }
    if (grid < 0) return;
    if (hipMemsetAsync((char*)d_ws + WS_CTL, 0, CTL_ZERO_BYTES, stream) != hipSuccess) return;
    Params p{};
    for (int i = 0; i < 18; ++i) p.in[i] = (const float*)d_in[i];
    p.out = (float*)d_out; p.ws = (unsigned char*)d_ws;
    p.ph_lo = 0; p.ph_hi = NPHASE;
    hipLaunchKernelGGL(fwd_kernel, dim3(grid), dim3(512), LDS_BYTES, stream, p);
}
```

```cpp
#include <hip/hip_runtime.h>
#include <stdint.h>
#include <stdio.h>

#ifndef N_LAUNCHES
#define N_LAUNCHES 1
#endif

#define DI __device__ __forceinline__
#define LAS __attribute__((address_space(3)))

typedef unsigned short bf16_t;
typedef short bf16x8 __attribute__((ext_vector_type(8)));
typedef float f32x16 __attribute__((ext_vector_type(16)));
typedef float f32x4 __attribute__((ext_vector_type(4)));
typedef float f32x2 __attribute__((ext_vector_type(2)));
typedef unsigned u32x4 __attribute__((ext_vector_type(4)));
typedef unsigned u32x2 __attribute__((ext_vector_type(2)));
typedef __bf16 bf16x2_t __attribute__((ext_vector_type(2)));

constexpr int BATCH = 8, SEQ = 2048, DM = 1024, T = BATCH * SEQ;
constexpr int NPROJ = 3072;
constexpr float EPS = 1e-6f;
constexpr float LOG2E = 1.4426950408889634f;
constexpr float SCL2 = 0.125f * LOG2E;
constexpr int NPHASE = 12;

constexpr size_t MiB = 1u << 20;
constexpr size_t WS_CTL = 0, CTL_ZERO_BYTES = 65536;
constexpr size_t WS_KMEAN = 256 * 1024;
constexpr size_t WS_BIAS = 512 * 1024;
constexpr size_t WS_WIN = 1 * MiB, WS_WOUT = 7 * MiB, WS_WQ = 9 * MiB, WS_WG = 13 * MiB, WS_WPLE = 15 * MiB;
constexpr size_t WS_U = 16 * MiB, WS_V = 32 * MiB;
constexpr size_t WS_USC = 640 * 1024, WS_VSC = 704 * 1024;
constexpr size_t WS_XN2 = 48 * MiB;
constexpr size_t WS_XN = 80 * MiB;
constexpr size_t WS_PB = 112 * MiB;
constexpr size_t WS_QM = 120 * MiB, WS_KM = 136 * MiB, WS_VTM = 152 * MiB, WS_QS = 168 * MiB, WS_KS = 184 * MiB, WS_VTS = 200 * MiB;
constexpr size_t WS_ORAW = 216 * MiB;
constexpr size_t WS_A2 = 80 * MiB;
constexpr size_t WS_A3 = 120 * MiB;
constexpr size_t WS_SC = 152 * MiB;
constexpr size_t WS_EIDX = 80 * MiB, WS_GATE = 88 * MiB, WS_CJ = 96 * MiB, WS_RS2 = 104 * MiB, WS_SSQ = 105 * MiB;
constexpr size_t WS_PDOT = 120 * MiB;
constexpr size_t WS_A4 = 184 * MiB;
constexpr size_t WS_END = 248 * MiB;

constexpr int CW_XC = 8192;
constexpr int CW_BAR = 4096;

constexpr int LDS_BYTES = 147456;

#define XB_TMO      128
#define XB_XCNT(j)  (256  + 64 * (j))
#define XB_XSUB(j)  (1280 + 64 * (j))
#define XB_XGEN(j)  (2304 + 64 * (j))
#define XB_TOP      3328
#define XB_TOPGEN   3392
#define XCD_BAR_WORDS 3456
#define XB_SPIN_CAP (1u << 18)

__device__ __forceinline__ unsigned xb_ld(unsigned* p)              { return __hip_atomic_load(p, __ATOMIC_RELAXED, __HIP_MEMORY_SCOPE_AGENT); }
__device__ __forceinline__ unsigned xb_add(unsigned* p, unsigned v) { return __hip_atomic_fetch_add(p, v, __ATOMIC_RELAXED, __HIP_MEMORY_SCOPE_AGENT); }
__device__ __forceinline__ unsigned xb_xcc_id() { return (unsigned)__builtin_amdgcn_s_getreg((3 << 11) | 20) & 0xFu; }
#define XB_SPIN(cond, bar) do { unsigned _sp = 0; while (cond) { __builtin_amdgcn_s_sleep(1); \
    if ((++_sp & 255u) == 0u) { if (xb_ld(&(bar)[XB_TMO])) break; if (_sp > XB_SPIN_CAP) { atomicAdd(&(bar)[XB_TMO], 1u); break; } } } } while (0)

struct XcdBarrier { unsigned* bar; unsigned x; volatile LAS unsigned* st; };

__device__ __forceinline__ XcdBarrier xcd_barrier_post(unsigned* bar, volatile LAS unsigned* st) {
    XcdBarrier b; b.bar = bar; b.x = xb_xcc_id(); b.st = st;
    if (threadIdx.x == 0) (void)xb_add(&bar[XB_XCNT(b.x)], 1u);
    return b;
}
__device__ __forceinline__ void xcd_barrier_complete(unsigned* bar, unsigned x, unsigned& nloc, unsigned& nx) {
    const unsigned G = gridDim.x * gridDim.y * gridDim.z;
    unsigned sum, cnt, mine, sp = 0u;
    for (;;) {
        sum = 0u; cnt = 0u; mine = 0u;
#pragma unroll
        for (unsigned j = 0; j < 16; ++j) { const unsigned c = xb_ld(&bar[XB_XCNT(j)]); sum += c; cnt += (c > 0u) ? 1u : 0u; mine = (j == x) ? c : mine; }
        if (sum == G) break;
        __builtin_amdgcn_s_sleep(1);
        if ((++sp & 255u) == 0u) { if (xb_ld(&bar[XB_TMO])) break; if (sp > XB_SPIN_CAP) { atomicAdd(&bar[XB_TMO], 1u); break; } }
    }
    nloc = mine > 0u ? mine : 1u; nx = cnt > 0u ? cnt : 1u;
}
__device__ __forceinline__ void xcd_barrier(const XcdBarrier& b) {
    asm volatile("s_waitcnt vmcnt(0)" ::: "memory");
    __syncthreads();
    if (threadIdx.x == 0) {
        unsigned* bar = b.bar;
        __builtin_amdgcn_s_waitcnt(0);
        unsigned nloc = b.st[0], nx = b.st[1];
        if (nloc == 0u) { xcd_barrier_complete(bar, b.x, nloc, nx); b.st[0] = nloc; b.st[1] = nx; }
        const unsigned old = xb_add(&bar[XB_XSUB(b.x)], 1u);
        const unsigned gen = old / nloc;
        if (old + 1u == (gen + 1u) * nloc) {
            __builtin_amdgcn_fence(__ATOMIC_RELEASE, "agent");
            asm volatile("s_waitcnt vmcnt(0)" ::: "memory");
            const unsigned og = xb_add(&bar[XB_TOP], 1u);
            const unsigned tg = og / nx;
            if (og + 1u == (tg + 1u) * nx) xb_add(&bar[XB_TOPGEN], 1u);
            else XB_SPIN(xb_ld(&bar[XB_TOPGEN]) == tg, bar);
            __builtin_amdgcn_fence(__ATOMIC_ACQUIRE, "agent");
            xb_add(&bar[XB_XGEN(b.x)], 1u);
            asm volatile("s_waitcnt vmcnt(0)" ::: "memory");
        } else {
            XB_SPIN(xb_ld(&bar[XB_XGEN(b.x)]) == gen, bar);
            __builtin_amdgcn_fence(__ATOMIC_ACQUIRE, "agent");
            asm volatile("s_waitcnt vmcnt(0)" ::: "memory");
        }
    }
    __syncthreads();
}

DI float bf2f(short v) { return __builtin_bit_cast(float, ((unsigned)(unsigned short)v) << 16); }
DI unsigned cvtpk(float lo, float hi) { f32x2 v = {lo, hi}; bf16x2_t b = __builtin_convertvector(v, bf16x2_t); return __builtin_bit_cast(unsigned, b); }
DI bf16_t f2bf(float f) { return (bf16_t)(cvtpk(f, 0.f) & 0xffffu); }
template <int CTRL> DI float dppf(float v) { return __builtin_bit_cast(float, __builtin_amdgcn_update_dpp(0, __builtin_bit_cast(int, v), CTRL, 0xF, 0xF, true)); }
#define DPP_XOR1 0xB1
#define DPP_XOR2 0x4E
#define DPP_HMIR 0x141
#define DPP_MIR  0x140
DI void swap16(float v, float& a, float& b) { const auto r = __builtin_amdgcn_permlane16_swap(__builtin_bit_cast(unsigned, v), __builtin_bit_cast(unsigned, v), false, false); const unsigned r0 = r[0], r1 = r[1]; a = __builtin_bit_cast(float, r0); b = __builtin_bit_cast(float, r1); }
DI void swap32(float v, float& a, float& b) { const auto r = __builtin_amdgcn_permlane32_swap(__builtin_bit_cast(unsigned, v), __builtin_bit_cast(unsigned, v), false, false); const unsigned r0 = r[0], r1 = r[1]; a = __builtin_bit_cast(float, r0); b = __builtin_bit_cast(float, r1); }
DI float sum_x16(float v) { float a, b; swap16(v, a, b); return a + b; }
DI float sum_x32(float v) { float a, b; swap32(v, a, b); return a + b; }
DI float max_x32(float v) { float a, b; swap32(v, a, b); return fmaxf(a, b); }
DI float sum_row16(float v) { v += dppf<DPP_XOR1>(v); v += dppf<DPP_XOR2>(v); v += dppf<DPP_HMIR>(v); v += dppf<DPP_MIR>(v); return v; }
DI float max_row16(float v) { v = fmaxf(v, dppf<DPP_XOR1>(v)); v = fmaxf(v, dppf<DPP_XOR2>(v)); v = fmaxf(v, dppf<DPP_HMIR>(v)); v = fmaxf(v, dppf<DPP_MIR>(v)); return v; }
DI float sum_oct(float v) { v += dppf<DPP_XOR1>(v); v += dppf<DPP_XOR2>(v); v += dppf<DPP_HMIR>(v); return v; }
DI float max_oct(float v) { v = fmaxf(v, dppf<DPP_XOR1>(v)); v = fmaxf(v, dppf<DPP_XOR2>(v)); v = fmaxf(v, dppf<DPP_HMIR>(v)); return v; }
DI float wave_sum(float v) { return sum_x32(sum_x16(sum_row16(v))); }
DI float wave_max(float v) { v = max_row16(v); float a, b; swap16(v, a, b); return max_x32(fmaxf(a, b)); }
DI int crow(int r, int hi) { return (r & 3) + 8 * (r >> 2) + 4 * hi; }
#define MFMA32(a, b, c) __builtin_amdgcn_mfma_f32_32x32x16_bf16((a), (b), (c), 0, 0, 0)
DI f32x16 zero16() { f32x16 z; for (int i = 0; i < 16; ++i) z[i] = 0.f; return z; }

struct Params {
    const float* in[18];
    float* out;
    unsigned char* ws;
    int ph_lo, ph_hi;
};

enum { IN_X = 0, IN_P, IN_RELB, IN_ATTN_NORM, IN_WIN, IN_QNORM, IN_KNORM, IN_ONM, IN_ONS, IN_WOUT, IN_FFN_NORM, IN_PQ, IN_SUBK, IN_PU, IN_PV, IN_PLE_NORM, IN_WPG, IN_WPLE };

template <bool HEADPERM> DI void p0_transpose(const float* W, int K, int N, bf16_t* Wt, LAS float* scr, int tid, int wg, int nwg, const float* kgain = nullptr) {
    const int tn = N / 64, ntile = (K / 64) * tn;
    for (int tile = wg; tile < ntile; tile += nwg) {
        const int k0 = (tile / tn) * 64, n0 = (tile % tn) * 64;
#pragma unroll
        for (int i = 0; i < 8; ++i) { const int kk = (tid >> 6) + 8 * i, nn = tid & 63; scr[kk * 65 + nn] = W[(size_t)(k0 + kk) * N + n0 + nn]; }
        __syncthreads();
#pragma unroll
        for (int i = 0; i < 8; ++i) { const int nn = (tid >> 6) + 8 * i, kk = tid & 63; int n = n0 + nn; if (HEADPERM) { const int w = n & 255; n = (n & ~255) + 128 * ((w >> 5) & 1) + 32 * (w >> 6) + (w & 31); }
            Wt[(size_t)n * K + k0 + kk] = f2bf(scr[kk * 65 + nn] * (kgain ? kgain[k0 + kk] : 1.f)); }
        __syncthreads();
    }
}

DI void p0_fold(const float* wq, const float* sub, const float* gffn, bf16_t* WqT, LAS float* lds, int tid, int wg, int nwg) {
    LAS float* wqs = lds;
    LAS float* subs = lds + 128 * 65;
    for (int item = wg; item < 256; item += nwg) {
        const int dt = item & 15, hh = item >> 4, d0 = dt * 64, h = hh >> 1, half = hh & 1;
#pragma unroll
        for (int i = 0; i < 16; ++i) { const int k = tid & 127, dd = (tid >> 7) + 4 * i; wqs[k * 65 + dd] = wq[(size_t)(d0 + dd) * 2048 + h * 256 + half * 128 + k]; }
#pragma unroll
        for (int i = 0; i < 32; ++i) { const int idx = i * 512 + tid; subs[idx] = sub[half * 16384 + idx]; }
        __syncthreads();
        const int d = tid & 63, ng = tid >> 6;
        float acc[16];
#pragma unroll
        for (int i = 0; i < 16; ++i) acc[i] = 0.f;
        for (int k = 0; k < 128; k += 4) {
            const float a0 = wqs[(k + 0) * 65 + d], a1 = wqs[(k + 1) * 65 + d], a2 = wqs[(k + 2) * 65 + d], a3 = wqs[(k + 3) * 65 + d];
#pragma unroll
            for (int i = 0; i < 16; ++i) { const f32x4 s = *(const LAS f32x4*)(subs + (16 * ng + i) * 128 + k); acc[i] += a0 * s.x + a1 * s.y + a2 * s.z + a3 * s.w; }
        }
        const float g = gffn[d0 + d];
#pragma unroll
        for (int i = 0; i < 16; ++i) WqT[(size_t)(hh * 128 + 16 * ng + i) * 1024 + d0 + d] = f2bf(acc[i] * g);
        __syncthreads();
    }
}

DI void p0_convert(const float* src, bf16_t* dst, size_t n, size_t gtid, size_t nthreads) {
    for (size_t i = gtid * 8; i < n; i += nthreads * 8) {
        const f32x4 a = *(const f32x4*)(src + i), b = *(const f32x4*)(src + i + 4);
        u32x4 o; o.x = cvtpk(a.x, a.y); o.y = cvtpk(a.z, a.w); o.z = cvtpk(b.x, b.y); o.w = cvtpk(b.z, b.w);
        *(u32x4*)(dst + i) = o;
    }
}


DI void p0_quant_finish(const f32x4 (&a)[4], unsigned char* dst, float* scale, int row, int lane) {
    float m = 0.f;
#pragma unroll
    for (int i = 0; i < 4; ++i) m = fmaxf(fmaxf(m, fmaxf(fabsf(a[i].x), fabsf(a[i].y))), fmaxf(fabsf(a[i].z), fabsf(a[i].w)));
    m = wave_max(m);
    const float sc = m > 0.f ? m * (1.f / 440.f) : 1.f, inv = m > 0.f ? 440.f / m : 0.f;
    u32x4 w;
#pragma unroll
    for (int i = 0; i < 4; ++i) {
        const float q0 = fminf(fmaxf(a[i].x * inv, -448.f), 448.f), q1 = fminf(fmaxf(a[i].y * inv, -448.f), 448.f);
        const float q2 = fminf(fmaxf(a[i].z * inv, -448.f), 448.f), q3 = fminf(fmaxf(a[i].w * inv, -448.f), 448.f);
        int p = 0;
        p = __builtin_amdgcn_cvt_pk_fp8_f32(q0, q1, p, false);
        p = __builtin_amdgcn_cvt_pk_fp8_f32(q2, q3, p, true);
        w[i] = (unsigned)p;
    }
    *(u32x4*)(dst + ((size_t)(lane >> 3) * 16384 + row) * 128 + 16 * (lane & 7)) = w;
    if (lane == 0) scale[row] = sc;
}
DI void p0_quant_rows4(const float* pu, const float* pv, unsigned char* u8, unsigned char* v8, float* usc_, float* vsc_, int r0, int r1, int lane) {
    f32x4 a[4][4];
    const int r1c = r1 < 16384 ? r1 : r0;
#pragma unroll
    for (int i = 0; i < 4; ++i) { a[0][i] = *(const f32x4*)(pu + (size_t)r0 * 1024 + 16 * lane + 4 * i); a[1][i] = *(const f32x4*)(pv + (size_t)r0 * 1024 + 16 * lane + 4 * i);
        a[2][i] = *(const f32x4*)(pu + (size_t)r1c * 1024 + 16 * lane + 4 * i); a[3][i] = *(const f32x4*)(pv + (size_t)r1c * 1024 + 16 * lane + 4 * i); }
    p0_quant_finish(a[0], u8, usc_, r0, lane); p0_quant_finish(a[1], v8, vsc_, r0, lane);
    if (r1 < 16384) { p0_quant_finish(a[2], u8, usc_, r1, lane); p0_quant_finish(a[3], v8, vsc_, r1, lane); }
}

DI void rmsnorm_rows2_bf16(const float* x, const float* g, bf16_t* o, int r0, int r1, int lane) {
    f32x4 v[2][4]; float s[2] = {0.f, 0.f};
    const int rr[2] = {r0, r1 < T ? r1 : r0};
#pragma unroll
    for (int q = 0; q < 2; ++q)
#pragma unroll
        for (int j = 0; j < 4; ++j) v[q][j] = ((const f32x4*)(x + (size_t)rr[q] * 1024))[lane + 64 * j];
#pragma unroll
    for (int q = 0; q < 2; ++q) {
#pragma unroll
        for (int j = 0; j < 4; ++j) s[q] += (v[q][j].x * v[q][j].x + v[q][j].y * v[q][j].y) + (v[q][j].z * v[q][j].z + v[q][j].w * v[q][j].w);
        s[q] = wave_sum(s[q]);
    }
#pragma unroll
    for (int q = 0; q < 2; ++q) {
        if (q == 1 && r1 >= T) break;
        const float rs = rsqrtf(s[q] * (1.f / 1024.f) + EPS);
#pragma unroll
        for (int j = 0; j < 4; ++j) { const f32x4 gv = ((const f32x4*)g)[lane + 64 * j];
            u32x2 w; w.x = cvtpk(v[q][j].x * rs * gv.x, v[q][j].y * rs * gv.y); w.y = cvtpk(v[q][j].z * rs * gv.z, v[q][j].w * rs * gv.w);
            ((u32x2*)(o + (size_t)rr[q] * 1024))[lane + 64 * j] = w; }
    }
}

namespace pg8 {
#define PG8_LAS __attribute__((address_space(3)))
typedef unsigned short bf16_t;
typedef short bf16x8 __attribute__((ext_vector_type(8)));
typedef float f32x4 __attribute__((ext_vector_type(4)));
typedef unsigned u32x4 __attribute__((ext_vector_type(4)));
constexpr int BM = 256, BK = 64, HALF = 128, HTB = HALF * BK * 2  , STAGE_BYTES = 8 * HTB, NXCD = 8, WGM = 8;

__host__ __device__ __forceinline__ int lds_byte(int r, int c) { const int st = (r >> 4) * 2 + (c >> 5), rr = r & 15, cc = c & 31, ob = rr * 64 + cc * 2; return st * 1024 + (ob ^ (((ob >> 9) & 1) << 5)); }
__host__ __device__ __forceinline__ void stage_rc(int b, int& R, int& C) { const int st = b / 1024, sb = b % 1024, swz = sb ^ (((sb >> 9) & 1) << 5); R = (st >> 1) * 16 + swz / 64; C = (st & 1) * 32 + (swz % 64) / 2; }
__host__ __device__ __forceinline__ int perm32(int rho) { const int n = rho >> 4, i = rho & 15; return 8 * (i >> 2) + 4 * n + (i & 3); }

struct Unit { int pm, pn; };
struct Gemm { const bf16_t* A; const bf16_t* Bt; int M, N, K; };

struct StaticOrder {
    int nM, nN, nwg, G, c;
    __host__ __device__ void init(int M, int N, int G_, int c_) { nM = M / BM; nN = N / BM; nwg = nM * nN; G = G_; c = c_; }
    __host__ __device__ bool next(int i, Unit& u) const {
        const long L = (long)i * G + c; if (L >= nwg) return false;
        int wgid = (int)L; { const int q = nwg / NXCD, r = nwg % NXCD, xcd = wgid % NXCD, off = wgid / NXCD; wgid = (xcd < r ? xcd * (q + 1) : r * (q + 1) + (xcd - r) * q) + off; }
        const int nig = WGM * nN, gid = wgid / nig, fm = gid * WGM, gsz = (nM - fm) < WGM ? (nM - fm) : WGM;
        u.pm = fm + ((wgid % nig) % gsz); u.pn = (wgid % nig) / gsz; return true;
    }
    __device__ __forceinline__ void a_ready(const Unit&) const {}
    __device__ __forceinline__ void done(const Unit&) const {}
};

template <class Epi, class Sched, bool ALIGN_EPI = false, bool SP2 = false>
__device__ __forceinline__ void gemm_phase(PG8_LAS unsigned char* lds, const Gemm g, const Sched& S, const Epi& E) {
    int tid_ = threadIdx.x; asm volatile("" : "+v"(tid_));
    const int tid = tid_, wid = __builtin_amdgcn_readfirstlane(tid >> 6), lane = tid & 63, wr = wid >> 2, wc = wid & 3, fr = lane & 15, fq = lane >> 4;
    const int K = g.K, nt = K / BK;
    unsigned voffA[2], voffB[2];
#pragma unroll
    for (int i = 0; i < 2; ++i) { int R, C; stage_rc(tid * 16 + i * 8192, R, C); const int Rb = Epi::PERM ? ((R & ~31) + perm32(R & 31)) : R;
        voffA[i] = (unsigned)(R * K + C) * 2u; voffB[i] = (unsigned)(Rb * K + C) * 2u; }
    const size_t kstep = (size_t)(BK * 2);
    const size_t hstep = (size_t)HALF * K * 2;
    const size_t tstep = 2 * hstep;
    const unsigned ldsw = (unsigned)wid * 1024u;
    const int aoff = lds_byte(wr * 64 + fr, fq * 8), boff = lds_byte(wc * 32 + fr, fq * 8);
#define PG8_SA(b, h) (((b) * 2 + (h)) * HTB)
#define PG8_SB(b, h) ((4 + (b) * 2 + (h)) * HTB)
#define PG8_STAGE(bufoff, gbase, voff) do { _Pragma("unroll") for (int _i = 0; _i < 2; ++_i) \
        __builtin_amdgcn_global_load_lds((const unsigned*)((const char*)(gbase) + (voff)[_i]), (PG8_LAS unsigned*)(lds + (bufoff) + ldsw + _i * 8192), 16, 0, 0); } while (0)
#define PG8_LDA(dst, b, h) do { _Pragma("unroll") for (int m = 0; m < 4; ++m) _Pragma("unroll") for (int k = 0; k < 2; ++k) dst[m][k] = *(const PG8_LAS bf16x8*)(lds + PG8_SA(b, h) + aoff + m * 2048 + k * 1024); } while (0)
#define PG8_LDB(dst, b, h) do { _Pragma("unroll") for (int n = 0; n < 2; ++n) _Pragma("unroll") for (int k = 0; k < 2; ++k) dst[n][k] = *(const PG8_LAS bf16x8*)(lds + PG8_SB(b, h) + boff + n * 2048 + k * 1024); } while (0)
#define PG8_MMA(ai, bj, At, Bt) do { __builtin_amdgcn_s_setprio(1); _Pragma("unroll") for (int m = 0; m < 4; ++m) _Pragma("unroll") for (int n = 0; n < 2; ++n) _Pragma("unroll") for (int k = 0; k < 2; ++k) \
        acc[ai][bj][m][n] = __builtin_amdgcn_mfma_f32_16x16x32_bf16(Bt[n][k], At[m][k], acc[ai][bj][m][n], 0, 0, 0); __builtin_amdgcn_s_setprio(0); } while (0)
#define PG8_WAIT_V(n) asm volatile("s_waitcnt vmcnt(" #n ")" ::: "memory")
#define PG8_WAIT_L(n) asm volatile("s_waitcnt lgkmcnt(" #n ")" ::: "memory")
#define PG8_BAR __builtin_amdgcn_s_barrier()
#define PG8_SCHED __builtin_amdgcn_sched_barrier(0)
    Unit cur, nxt; int ui = 0;
    if (!S.next(0, cur)) return;
    f32x4 acc[2][2][4][2];
#pragma unroll
    for (int a = 0; a < 2; ++a)
#pragma unroll
        for (int b = 0; b < 2; ++b)
#pragma unroll
            for (int m = 0; m < 4; ++m)
#pragma unroll
                for (int n = 0; n < 2; ++n) acc[a][b][m][n] = (f32x4){0.f, 0.f, 0.f, 0.f};
    bf16x8 At[4][2], B0[2][2], B1[2][2];
    const char* cA = (const char*)g.A + (size_t)cur.pm * tstep; const char* cB = (const char*)g.Bt + (size_t)cur.pn * tstep;
    S.a_ready(cur);
    if constexpr (SP2) {
        PG8_STAGE(PG8_SB(0, 0), cB, voffB); PG8_STAGE(PG8_SB(0, 1), cB + hstep, voffB); PG8_STAGE(PG8_SA(0, 0), cA, voffA); PG8_STAGE(PG8_SA(0, 1), cA + hstep, voffA);
        if (wr == 1) PG8_BAR;
        PG8_WAIT_V(2); PG8_BAR;
        PG8_STAGE(PG8_SB(1, 0), cB + kstep, voffB); PG8_STAGE(PG8_SA(1, 0), cA + kstep, voffA); PG8_STAGE(PG8_SB(1, 1), cB + hstep + kstep, voffB);
        PG8_WAIT_V(6); PG8_BAR;
    } else {
        PG8_STAGE(PG8_SB(0, 0), cB, voffB); PG8_STAGE(PG8_SA(0, 0), cA, voffA); PG8_STAGE(PG8_SB(0, 1), cB + hstep, voffB); PG8_STAGE(PG8_SA(0, 1), cA + hstep, voffA);
        if (wr == 1) PG8_BAR;
        PG8_WAIT_V(4); PG8_BAR;
        PG8_STAGE(PG8_SB(1, 0), cB + kstep, voffB); PG8_STAGE(PG8_SA(1, 0), cA + kstep, voffA); PG8_STAGE(PG8_SB(1, 1), cB + hstep + kstep, voffB);
        PG8_WAIT_V(6); PG8_BAR;
    }
    for (;;) {
        const bool has_next = S.next(ui + 1, nxt);
        const char* nA = has_next ? (const char*)g.A + (size_t)nxt.pm * tstep : cA; const char* nB = has_next ? (const char*)g.Bt + (size_t)nxt.pn * tstep : cB;
        for (int t = 0; t < nt; t += 2) {
            const bool last = (t == nt - 2);
            const char* a1 = cA + (size_t)(t + 1) * kstep;
            const char* a2 = last ? nA : cA + (size_t)(t + 2) * kstep; const char* b2 = last ? nB : cB + (size_t)(t + 2) * kstep;
            const char* a3 = a2 + kstep; const char* b3 = b2 + kstep;
            if (last && has_next) S.a_ready(nxt);
            if constexpr (SP2) {
            PG8_LDB(B0, 0, 0); PG8_LDB(B1, 0, 1); PG8_SCHED; PG8_LDA(At, 0, 0); PG8_STAGE(PG8_SA(1, 1), a1 + hstep, voffA);
            PG8_WAIT_V(8); PG8_WAIT_L(0); PG8_BAR; PG8_MMA(0, 0, At, B0); PG8_MMA(0, 1, At, B1); PG8_BAR; PG8_SCHED;
            PG8_LDA(At, 0, 1); PG8_STAGE(PG8_SB(0, 0), b2, voffB); PG8_STAGE(PG8_SB(0, 1), b2 + hstep, voffB); PG8_STAGE(PG8_SA(0, 0), a2, voffA);
            PG8_WAIT_V(8); PG8_WAIT_L(0); PG8_BAR; PG8_MMA(1, 0, At, B0); PG8_MMA(1, 1, At, B1); PG8_BAR; PG8_SCHED;
            PG8_LDB(B0, 1, 0); PG8_LDB(B1, 1, 1); PG8_SCHED; PG8_LDA(At, 1, 0); PG8_STAGE(PG8_SA(0, 1), a2 + hstep, voffA);
            PG8_WAIT_V(8); PG8_WAIT_L(0); PG8_BAR; PG8_MMA(0, 0, At, B0); PG8_MMA(0, 1, At, B1); PG8_BAR; PG8_SCHED;
            PG8_LDA(At, 1, 1); PG8_STAGE(PG8_SB(1, 0), b3, voffB); PG8_STAGE(PG8_SB(1, 1), b3 + hstep, voffB); PG8_STAGE(PG8_SA(1, 0), a3, voffA);
            PG8_WAIT_V(8); PG8_WAIT_L(0); PG8_BAR; PG8_MMA(1, 0, At, B0); PG8_MMA(1, 1, At, B1); PG8_BAR; PG8_SCHED;
            } else {
            PG8_LDB(B0, 0, 0); PG8_SCHED; PG8_LDA(At, 0, 0); PG8_STAGE(PG8_SA(1, 1), a1 + hstep, voffA);
            PG8_WAIT_L(8); PG8_BAR; PG8_WAIT_L(0); PG8_MMA(0, 0, At, B0); PG8_BAR; PG8_SCHED;
            PG8_LDB(B1, 0, 1); PG8_STAGE(PG8_SB(0, 0), b2, voffB);
            PG8_BAR; PG8_WAIT_L(0); PG8_MMA(0, 1, At, B1); PG8_BAR;
            PG8_LDA(At, 0, 1); PG8_STAGE(PG8_SA(0, 0), a2, voffA);
            PG8_BAR; PG8_WAIT_L(0); PG8_MMA(1, 0, At, B0); PG8_BAR; PG8_SCHED;
            PG8_STAGE(PG8_SB(0, 1), b2 + hstep, voffB);
            PG8_WAIT_V(6); PG8_BAR; PG8_MMA(1, 1, At, B1); PG8_BAR;
            PG8_LDB(B0, 1, 0); PG8_SCHED; PG8_LDA(At, 1, 0); PG8_STAGE(PG8_SA(0, 1), a2 + hstep, voffA);
            PG8_WAIT_L(8); PG8_BAR; PG8_WAIT_L(0); PG8_MMA(0, 0, At, B0); PG8_BAR; PG8_SCHED;
            PG8_LDB(B1, 1, 1); PG8_STAGE(PG8_SB(1, 0), b3, voffB);
            PG8_BAR; PG8_WAIT_L(0); PG8_MMA(0, 1, At, B1); PG8_BAR;
            PG8_LDA(At, 1, 1); PG8_STAGE(PG8_SA(1, 0), a3, voffA);
            PG8_BAR; PG8_WAIT_L(0); PG8_MMA(1, 0, At, B0); PG8_BAR; PG8_SCHED;
            PG8_STAGE(PG8_SB(1, 1), b3 + hstep, voffB);
            PG8_WAIT_V(6); PG8_BAR; PG8_MMA(1, 1, At, B1); PG8_BAR;
            }
        }
        if constexpr (ALIGN_EPI) { if (wr == 0) PG8_BAR; }
        if constexpr (!Epi::AFTER_DRAIN) { E(acc, cur, wr, wc, fr, fq); S.done(cur); }
        if (!has_next) break;
#pragma unroll
        for (int a = 0; a < 2; ++a)
#pragma unroll
            for (int b = 0; b < 2; ++b)
#pragma unroll
                for (int m = 0; m < 4; ++m)
#pragma unroll
                    for (int n = 0; n < 2; ++n) acc[a][b][m][n] = (f32x4){0.f, 0.f, 0.f, 0.f};
        cur = nxt; cA = nA; cB = nB; ++ui;
        if constexpr (ALIGN_EPI) { if (wr == 1) PG8_BAR; }
    }
    PG8_WAIT_V(0);
    if constexpr (!ALIGN_EPI) { if (wr == 0) PG8_BAR; }
    PG8_BAR;
    if constexpr (Epi::AFTER_DRAIN) { E.fused(acc, cur, wr, wc, fr, fq, lds, wid, lane); S.done(cur); }
#undef PG8_SA
#undef PG8_SB
#undef PG8_STAGE
#undef PG8_LDA
#undef PG8_LDB
#undef PG8_MMA
#undef PG8_WAIT_V
#undef PG8_WAIT_L
#undef PG8_BAR
#undef PG8_SCHED
}
}


struct EpiQKV {
    static constexpr bool PERM = true, AFTER_DRAIN = false;
    bf16_t* base6; const float *qn, *kn;
    DI void operator()(const f32x4 (&acc)[2][2][4][2], const pg8::Unit& u, int wr, int wc, int fr, int fq) const {
        const int typ = u.pn >> 1, h = (u.pn & 1) * 4 + wc;
        bf16_t* reg = base6 + (size_t)typ * (16u << 19);
        const int row0 = u.pm * 256 + wr * 64 + fr;
        if (typ == 2 || typ == 5) {
#pragma unroll
            for (int ai = 0; ai < 2; ++ai)
#pragma unroll
                for (int m = 0; m < 4; ++m) {
                    const int tok = row0 + ai * 128 + m * 16, b = tok >> 11, sq = tok & 2047, tile = sq >> 5, kap = sq & 31;
                    const int s2 = kap >> 4, hh = (kap >> 2) & 1, jj = ((kap >> 3) & 1) * 4 + (kap & 3);
                    bf16_t* bp = reg + ((((size_t)(b * 8 + h) * 64 + tile) * 4 + s2 * 2) * 64 + hh * 32 + 8 * fq) * 8 + jj;
#pragma unroll
                    for (int bj = 0; bj < 2; ++bj)
#pragma unroll
                        for (int n = 0; n < 2; ++n)
#pragma unroll
                            for (int i = 0; i < 4; ++i) bp[(size_t)bj * 512 + (4 * n + i) * 8] = f2bf(acc[ai][bj][m][n][i]);
                }
        } else {
            const bool nrm = typ < 2;
            const float* g = (typ == 0) ? qn : kn;
            f32x4 gv[2][2];
#pragma unroll
            for (int bj = 0; bj < 2; ++bj)
#pragma unroll
                for (int n = 0; n < 2; ++n) gv[bj][n] = nrm ? *(const f32x4*)(g + 32 * bj + 8 * fq + 4 * n) : (f32x4){1.f, 1.f, 1.f, 1.f};
#pragma unroll
            for (int ai = 0; ai < 2; ++ai)
#pragma unroll
                for (int m = 0; m < 4; ++m) {
                    const int tok = row0 + ai * 128 + m * 16, b = tok >> 11, sq = tok & 2047, tile = sq >> 5, kap = sq & 31;
                    float rs = 1.f;
                    if (nrm) {
                        float ss = 0.f;
#pragma unroll
                        for (int bj = 0; bj < 2; ++bj)
#pragma unroll
                            for (int n = 0; n < 2; ++n) { const f32x4 v = acc[ai][bj][m][n]; ss += (v.x * v.x + v.y * v.y) + (v.z * v.z + v.w * v.w); }
                        ss = sum_x32(sum_x16(ss));
                        rs = rsqrtf(ss * (1.f / 64.f) + EPS);
                    }
                    bf16_t* dst = reg + ((((size_t)(b * 8 + h) * 64 + tile) * 4 + (fq >> 1)) * 64 + (fq & 1) * 32 + kap) * 8;
#pragma unroll
                    for (int bj = 0; bj < 2; ++bj) {
                        const f32x4 v0 = acc[ai][bj][m][0] * rs * gv[bj][0], v1 = acc[ai][bj][m][1] * rs * gv[bj][1];
                        u32x4 w; w.x = cvtpk(v0.x, v0.y); w.y = cvtpk(v0.z, v0.w); w.z = cvtpk(v1.x, v1.y); w.w = cvtpk(v1.z, v1.w);
                        *(u32x4*)(dst + (size_t)bj * 2 * 512) = w;
                    }
                }
        }
    }
};

struct EpiRes {
    static constexpr bool PERM = true, AFTER_DRAIN = false;
    const float* x; float* out; bf16_t* xn;
    DI void operator()(const f32x4 (&acc)[2][2][4][2], const pg8::Unit& u, int wr, int wc, int fr, int fq) const {
        const int row0 = u.pm * 256 + wr * 64 + fr, col0 = u.pn * 256 + wc * 32 + 8 * fq;
#pragma unroll
        for (int ai = 0; ai < 2; ++ai)
#pragma unroll
            for (int m = 0; m < 4; ++m)
#pragma unroll
                for (int bj = 0; bj < 2; ++bj) {
                    const size_t off = (size_t)(row0 + ai * 128 + m * 16) * 1024 + col0 + bj * 128;
                    const f32x4 h0 = *(const f32x4*)(x + off) + acc[ai][bj][m][0], h1 = *(const f32x4*)(x + off + 4) + acc[ai][bj][m][1];
                    *(f32x4*)(out + off) = h0; *(f32x4*)(out + off + 4) = h1;
                    u32x4 w; w.x = cvtpk(h0.x, h0.y); w.y = cvtpk(h0.z, h0.w); w.z = cvtpk(h1.x, h1.y); w.w = cvtpk(h1.z, h1.w);
                    *(u32x4*)(xn + off) = w;
                }
    }
};

struct EpiF32 {
    static constexpr bool PERM = true, AFTER_DRAIN = false;
    float* C; int ldc;
    DI void operator()(const f32x4 (&acc)[2][2][4][2], const pg8::Unit& u, int wr, int wc, int fr, int fq) const {
        const int row0 = u.pm * 256 + wr * 64 + fr, col0 = u.pn * 256 + wc * 32 + 8 * fq;
#pragma unroll
        for (int ai = 0; ai < 2; ++ai)
#pragma unroll
            for (int m = 0; m < 4; ++m)
#pragma unroll
                for (int bj = 0; bj < 2; ++bj) {
                    float* p = C + (size_t)(row0 + ai * 128 + m * 16) * ldc + col0 + bj * 128;
                    *(f32x4*)p = acc[ai][bj][m][0]; *(f32x4*)(p + 4) = acc[ai][bj][m][1];
                }
    }
};

struct EpiBf {
    static constexpr bool PERM = true, AFTER_DRAIN = false;
    bf16_t* C; int ldc;
    DI void operator()(const f32x4 (&acc)[2][2][4][2], const pg8::Unit& u, int wr, int wc, int fr, int fq) const {
        const int row0 = u.pm * 256 + wr * 64 + fr, col0 = u.pn * 256 + wc * 32 + 8 * fq;
#pragma unroll
        for (int ai = 0; ai < 2; ++ai)
#pragma unroll
            for (int m = 0; m < 4; ++m)
#pragma unroll
                for (int bj = 0; bj < 2; ++bj) {
                    const f32x4 v0 = acc[ai][bj][m][0], v1 = acc[ai][bj][m][1];
                    u32x4 w; w.x = cvtpk(v0.x, v0.y); w.y = cvtpk(v0.z, v0.w); w.z = cvtpk(v1.x, v1.y); w.w = cvtpk(v1.z, v1.w);
                    *(u32x4*)(C + (size_t)(row0 + ai * 128 + m * 16) * ldc + col0 + bj * 128) = w;
                }
    }
};

struct EpiGate {
    static constexpr bool PERM = true, AFTER_DRAIN = false;
    float* out; const bf16_t* pw; const float* ssq;
    DI void operator()(const f32x4 (&acc)[2][2][4][2], const pg8::Unit& u, int wr, int wc, int fr, int fq) const {
        const int row0 = u.pm * 256 + wr * 64 + fr, col0 = u.pn * 256 + wc * 32 + 8 * fq;
#pragma unroll
        for (int ai = 0; ai < 2; ++ai)
#pragma unroll
            for (int m = 0; m < 4; ++m) {
                const int row = row0 + ai * 128 + m * 16;
                float sq = 0.f;
#pragma unroll
                for (int x = 0; x < 8; ++x) sq += ssq[(size_t)x * T + row];
                const float rs3 = rsqrtf(sq * (1.f / 1024.f) + EPS);
#pragma unroll
                for (int bj = 0; bj < 2; ++bj) {
                    const size_t off = (size_t)row * 1024 + col0 + bj * 128;
                    const bf16x8 pv = *(const bf16x8*)(pw + off);
                    const f32x4 h0 = *(const f32x4*)(out + off), h1 = *(const f32x4*)(out + off + 4);
                    const f32x4 g0 = acc[ai][bj][m][0] * rs3, g1 = acc[ai][bj][m][1] * rs3;
                    f32x4 o0, o1;
#pragma unroll
                    for (int i = 0; i < 4; ++i) { o0[i] = h0[i] + bf2f(pv[i]) / (1.f + __expf(-g0[i])); o1[i] = h1[i] + bf2f(pv[4 + i]) / (1.f + __expf(-g1[i])); }
                    *(f32x4*)(out + off) = o0; *(f32x4*)(out + off + 4) = o1;
                }
            }
    }
};

template <class Epi>
DI void gemm_simple(const bf16_t* A, const bf16_t* Bt, int M, int N, int K, const Epi& epi, int gwave, int nwaves, int lane) {
    const int r32 = lane & 31, hi = lane >> 5;
    const int nNt = N / 64, total = (M / 32) * nNt;
    for (int tile = gwave; tile < total; tile += nwaves) {
        const int mt = tile / nNt, nt = tile - mt * nNt, m0 = mt * 32, n0 = nt * 64;
        const bf16_t* ap = A + (size_t)(m0 + r32) * K + 8 * hi;
        const bf16_t* b0p = Bt + (size_t)(n0 + r32) * K + 8 * hi;
        const bf16_t* b1p = b0p + (size_t)32 * K;
        f32x16 acc0 = zero16(), acc1 = zero16();
#pragma unroll 4
        for (int k = 0; k < K; k += 16) {
            const bf16x8 xa = *(const bf16x8*)(ap + k);
            const bf16x8 w0 = *(const bf16x8*)(b0p + k);
            const bf16x8 w1 = *(const bf16x8*)(b1p + k);
            acc0 = MFMA32(w0, xa, acc0);
            acc1 = MFMA32(w1, xa, acc1);
        }
        epi(m0 + r32, n0, hi, acc0, acc1);
    }
}

struct Epi1 {
    bf16_t* base6;
    const float *qn, *kn;
    DI void operator()(int tok, int n0, int hi, const f32x16& a0, const f32x16& a1) const {
        const int head48 = n0 >> 6, typ = head48 >> 3, h = head48 & 7;
        bf16_t* reg = base6 + (size_t)typ * (16u << 19);
        if (typ == 2 || typ == 5) {
            const int b = tok >> 11, s = tok & 2047;
            const int pos = (s & ~12) | ((s & 4) << 1) | ((s & 8) >> 1);
            bf16_t* base = reg + ((size_t)(b * 8 + h) * 64) * 2048 + pos;
#pragma unroll
            for (int r = 0; r < 16; ++r) { base[(size_t)crow(r, hi) * 2048] = f2bf(a0[r]); base[(size_t)(32 + crow(r, hi)) * 2048] = f2bf(a1[r]); }
        } else {
            float rs = 1.f;
            const bool nrm = (typ == 0 || typ == 1);
            if (nrm) { float ss = 0.f;
#pragma unroll
                for (int r = 0; r < 16; ++r) ss += a0[r] * a0[r] + a1[r] * a1[r];
                ss = sum_x32(ss);
                rs = rsqrtf(ss * (1.f / 64.f) + EPS); }
            const float* g = (typ == 0) ? qn : kn;
            bf16_t* dst = reg + (size_t)tok * 512 + h * 64;
#pragma unroll
            for (int t = 0; t < 2; ++t)
#pragma unroll
                for (int g4 = 0; g4 < 4; ++g4) {
                    const int f0 = 32 * t + 8 * g4 + 4 * hi;
                    float v[4];
#pragma unroll
                    for (int i = 0; i < 4; ++i) { const float a = t ? a1[4 * g4 + i] : a0[4 * g4 + i]; v[i] = nrm ? a * rs * g[f0 + i] : a; }
                    u32x2 w; w.x = cvtpk(v[0], v[1]); w.y = cvtpk(v[2], v[3]);
                    *(u32x2*)(dst + f0) = w;
                }
        }
    }
};

struct Epi2 {
    const float* x; float* out; bf16_t* xn;
    DI void operator()(int tok, int n0, int hi, const f32x16& a0, const f32x16& a1) const {
#pragma unroll
        for (int t = 0; t < 2; ++t)
#pragma unroll
            for (int g4 = 0; g4 < 4; ++g4) {
                const size_t off = (size_t)tok * 1024 + n0 + 32 * t + 8 * g4 + 4 * hi;
                const f32x4 xv = *(const f32x4*)(x + off);
                f32x4 hv;
#pragma unroll
                for (int i = 0; i < 4; ++i) hv[i] = xv[i] + (t ? a1[4 * g4 + i] : a0[4 * g4 + i]);
                *(f32x4*)(out + off) = hv;
                u32x2 w; w.x = cvtpk(hv[0], hv[1]); w.y = cvtpk(hv[2], hv[3]);
                *(u32x2*)(xn + off) = w;
            }
    }
};

struct Epi3 {
    float* sc;
    DI void operator()(int tok, int n0, int hi, const f32x16& a0, const f32x16& a1) const {
#pragma unroll
        for (int t = 0; t < 2; ++t)
#pragma unroll
            for (int g4 = 0; g4 < 4; ++g4) {
                f32x4 v;
#pragma unroll
                for (int i = 0; i < 4; ++i) v[i] = t ? a1[4 * g4 + i] : a0[4 * g4 + i];
                *(f32x4*)(sc + (size_t)tok * 2048 + n0 + 32 * t + 8 * g4 + 4 * hi) = v;
            }
    }
};

DI void pv_accum(f32x16& o0, f32x16& o1, const f32x16& p, const bf16_t* vt_row) {
#pragma unroll
    for (int s = 0; s < 2; ++s) {
        u32x4 pk; pk.x = cvtpk(p[8 * s], p[8 * s + 1]); pk.y = cvtpk(p[8 * s + 2], p[8 * s + 3]); pk.z = cvtpk(p[8 * s + 4], p[8 * s + 5]); pk.w = cvtpk(p[8 * s + 6], p[8 * s + 7]);
        const bf16x8 pb = __builtin_bit_cast(bf16x8, pk);
        const bf16x8 v0 = *(const bf16x8*)(vt_row + 16 * s);
        const bf16x8 v1 = *(const bf16x8*)(vt_row + (size_t)32 * 2048 + 16 * s);
        o0 = MFMA32(v0, pb, o0);
        o1 = MFMA32(v1, pb, o1);
    }
}

DI void store_o(bf16_t* op, const f32x16& o0, const f32x16& o1, float inv, int hi) {
#pragma unroll
    for (int t = 0; t < 2; ++t)
#pragma unroll
        for (int g4 = 0; g4 < 4; ++g4) {
            u32x2 w;
            if (t == 0) { w.x = cvtpk(o0[4 * g4] * inv, o0[4 * g4 + 1] * inv); w.y = cvtpk(o0[4 * g4 + 2] * inv, o0[4 * g4 + 3] * inv); }
            else        { w.x = cvtpk(o1[4 * g4] * inv, o1[4 * g4 + 1] * inv); w.y = cvtpk(o1[4 * g4 + 2] * inv, o1[4 * g4 + 3] * inv); }
            *(u32x2*)(op + 32 * t + 8 * g4 + 4 * hi) = w;
        }
}

constexpr int OT_PITCH = 1040;
DI void store_o_lds(LAS unsigned char* ot, int r32, int h, const f32x16& o0, const f32x16& o1, float inv, int hi) {
    LAS unsigned char* op = ot + r32 * OT_PITCH + h * 128;
#pragma unroll
    for (int t = 0; t < 2; ++t)
#pragma unroll
        for (int g4 = 0; g4 < 4; ++g4) {
            u32x2 w;
            if (t == 0) { w.x = cvtpk(o0[4 * g4] * inv, o0[4 * g4 + 1] * inv); w.y = cvtpk(o0[4 * g4 + 2] * inv, o0[4 * g4 + 3] * inv); }
            else        { w.x = cvtpk(o1[4 * g4] * inv, o1[4 * g4 + 1] * inv); w.y = cvtpk(o1[4 * g4 + 2] * inv, o1[4 * g4 + 3] * inv); }
            *(LAS u32x2*)(op + (32 * t + 8 * g4 + 4 * hi) * 2) = w;
        }
}
DI void load_kfrag(bf16x8 (&kf)[4], const bf16_t* fbase  , int tile) {
    const bf16_t* kp = fbase + (size_t)tile * 2048;
#pragma unroll
    for (int s = 0; s < 4; ++s) kf[s] = *(const bf16x8*)(kp + s * 512);
}
DI void load_vfrag(bf16x8 (&vf)[4], const bf16_t* fbase, int tile) {
    const bf16_t* vp = fbase + (size_t)tile * 2048;
#pragma unroll
    for (int q = 0; q < 4; ++q) vf[q] = *(const bf16x8*)(vp + q * 512);
}
DI void pv_accum2(f32x16& o0, f32x16& o1, const f32x16& p, const bf16x8 (&vf)[4]) {
#pragma unroll
    for (int s = 0; s < 2; ++s) {
        u32x4 pk; pk.x = cvtpk(p[8 * s], p[8 * s + 1]); pk.y = cvtpk(p[8 * s + 2], p[8 * s + 3]); pk.z = cvtpk(p[8 * s + 4], p[8 * s + 5]); pk.w = cvtpk(p[8 * s + 6], p[8 * s + 7]);
        const bf16x8 pb = __builtin_bit_cast(bf16x8, pk);
        o0 = MFMA32(vf[2 * s], pb, o0);
        o1 = MFMA32(vf[2 * s + 1], pb, o1);
    }
}

#define MEM_FENCE() asm volatile("" ::: "memory")
#define PIN1(a) asm volatile("" : "+v"(a) :: "memory")
#define PIN2(a, b) asm volatile("" : "+v"(a), "+v"(b) :: "memory")
DI void vm_drain() { __builtin_amdgcn_s_waitcnt(0x0F70); }
struct KvStream { const bf16_t* kbase; const bf16_t* vbase; };

struct MobaCtx { int q0, tq, blk, hi; unsigned selmask; float bfar; const LAS float* bt; };
DI void moba_tile(bf16x8 (&kf)[4], bf16x8 (&vf)[4], const bf16x8 (&qf)[4], int kt, int next, const KvStream& kv, const MobaCtx& c, float& mrun, float& lsum, f32x16& o0, f32x16& o1) {
    const int n = kt >> 3, key0 = kt * 32;
    f32x16 st = zero16();
#pragma unroll
    for (int s = 0; s < 4; ++s) st = MFMA32(kf[s], qf[s], st);
    PIN1(st); load_kfrag(kf, kv.kbase, next); PIN1(st);
    float x[16];
    if (n != c.blk) {
        const bool selq = (c.selmask >> n) & 1u;
        if ((c.q0 - (key0 + 31)) >= 128) {
            const float addend = selq ? c.bfar : -1e30f;
#pragma unroll
            for (int r = 0; r < 16; ++r) x[r] = st[r] * SCL2 + addend;
        } else {
#pragma unroll
            for (int r = 0; r < 16; ++r) { const int dist = c.tq - (key0 + crow(r, c.hi)); const float v = st[r] * SCL2 + c.bt[dist > 128 ? 128 : dist]; x[r] = selq ? v : -1e30f; }
        }
    } else {
#pragma unroll
        for (int r = 0; r < 16; ++r) { const int dist = c.tq - (key0 + crow(r, c.hi)); const float v = st[r] * SCL2 + c.bt[dist < 0 ? 0 : (dist > 128 ? 128 : dist)]; x[r] = (dist >= 0) ? v : -1e30f; }
    }
    float mx = x[0];
#pragma unroll
    for (int r = 1; r < 16; ++r) mx = fmaxf(mx, x[r]);
    mx = max_x32(mx);
    const float mnew = fmaxf(mrun, mx);
    if (!__all(mnew == mrun)) {
        const float alpha = __builtin_amdgcn_exp2f(mrun - mnew);
        lsum *= alpha;
#pragma unroll
        for (int r = 0; r < 16; ++r) { o0[r] *= alpha; o1[r] *= alpha; }
        mrun = mnew;
    }
    f32x16 pr; float ps = 0.f;
#pragma unroll
    for (int r = 0; r < 16; ++r) { const float e = __builtin_amdgcn_exp2f(x[r] - mrun); pr[r] = e; ps += e; }
    lsum += ps;
    pv_accum2(o0, o1, pr, vf);
    PIN2(o0, o1); load_vfrag(vf, kv.vbase, next); MEM_FENCE();
}
DI int moba_next(int kt, int blk, unsigned anysel) {
    int nkt = kt - 1;
    while (nkt >= 0) { const int nn = nkt >> 3; if (nn == blk || ((anysel >> nn) & 1u)) break; nkt = nn * 8 - 1; }
    return nkt;
}

DI void moba_unit(int b, int h, int qt, const bf16_t* Qm_, const bf16_t* Km_, const bf16_t* VtM_, const float* kmean_, const LAS float* biasLds, LAS unsigned char* ot, int lane) {
    const int r32 = lane & 31, hi = lane >> 5;
    const int q0 = qt * 32, tq = q0 + r32, blk = q0 >> 8;
    const size_t bh = (size_t)(b * 8 + h);
    const bf16_t* qfb = Qm_ + bh * (64 * 2048) + (size_t)qt * 2048;
    KvStream kv; kv.kbase = Km_ + bh * (64 * 2048) + lane * 8; kv.vbase = VtM_ + bh * (64 * 2048) + lane * 8;
    bf16x8 kf[4], vf[4];
    load_kfrag(kf, kv.kbase, qt); load_vfrag(vf, kv.vbase, qt);
    bf16x8 qf[4];
#pragma unroll
    for (int s = 0; s < 4; ++s) qf[s] = *(const bf16x8*)(qfb + s * 512 + lane * 8);
    unsigned selmask = 0;
    if (blk > 0) {
        float qv[32];
#pragma unroll
        for (int c = 0; c < 4; ++c) { const bf16x8 t = *(const bf16x8*)(qfb + (2 * hi + (c >> 1)) * 512 + ((c & 1) * 32 + r32) * 8);
#pragma unroll
            for (int j = 0; j < 8; ++j) qv[8 * c + j] = bf2f(t[j]); }
        const float* km = kmean_ + (size_t)((b * 8 + h) * 8) * 64 + 32 * hi;
        float g[8];
#pragma unroll
        for (int n = 0; n < 8; ++n) {
            float a = 0.f;
            if (n < blk) {
#pragma unroll
                for (int d4 = 0; d4 < 8; ++d4) { const f32x4 kv4 = *(const f32x4*)(km + n * 64 + 4 * d4); a += (qv[4 * d4] * kv4.x + qv[4 * d4 + 1] * kv4.y) + (qv[4 * d4 + 2] * kv4.z + qv[4 * d4 + 3] * kv4.w); }
            }
            a = sum_x32(a);
            g[n] = (n < blk) ? a : -INFINITY;
        }
#pragma unroll
        for (int n = 0; n < 8; ++n) {
            int rank = 0;
#pragma unroll
            for (int m = 0; m < 8; ++m) if (m != n) rank += ((g[m] > g[n]) || (g[m] == g[n] && m < n)) ? 1 : 0;
            if (n < blk && rank < 3) selmask |= 1u << n;
        }
    }
    unsigned anysel = 0;
#pragma unroll
    for (int n = 0; n < 8; ++n) if (__any((selmask >> n) & 1u)) anysel |= 1u << n;
    anysel = __builtin_amdgcn_readfirstlane(anysel);
    float mrun = -1e30f, lsum = 0.f;
    f32x16 o0 = zero16(), o1 = zero16();
    MobaCtx c; c.q0 = q0; c.tq = tq; c.blk = blk; c.hi = hi; c.selmask = selmask; c.bt = biasLds + h * 132; c.bfar = c.bt[128];
    vm_drain();
    int kt = qt;
    for (;;) {
        const int nx = moba_next(kt, blk, anysel);
        moba_tile(kf, vf, qf, kt, nx < 0 ? 0 : nx, kv, c, mrun, lsum, o0, o1);
        if (nx < 0) break;
        kt = nx;
    }
    lsum = sum_x32(lsum);
    const float inv = 1.f / lsum;
    store_o_lds(ot, r32, h, o0, o1, inv, hi);
}

DI void sb_tile(bf16x8 (&kf)[4], bf16x8 (&vf)[4], const bf16x8 (&qf)[4], int kt, int next, const KvStream& kv, int tq, int hi, float& C, f32x16& o0, f32x16& o1) {
    const int key0 = kt * 32;
    f32x16 st = zero16();
#pragma unroll
    for (int s = 0; s < 4; ++s) st = MFMA32(kf[s], qf[s], st);
    PIN1(st); load_kfrag(kf, kv.kbase, next); PIN1(st);
    float rr[16], be[16];
#pragma unroll
    for (int r = 0; r < 16; ++r) {
        const int key = key0 + crow(r, hi);
        const float y = fminf(st[r] * SCL2, 100.f);
        const float e = __builtin_amdgcn_exp2f(y);
        const float ri = __builtin_amdgcn_rcpf(1.f + e);
        const bool ok = key < tq;
        rr[r] = ok ? ri : 1.f;
        be[r] = ok ? e * ri : 0.f;
    }
    float G[4], ex[16], Gp[4], Tt[4], Suf[4];
#pragma unroll
    for (int a = 0; a < 4; ++a) {
        ex[4 * a + 3] = 1.f; ex[4 * a + 2] = rr[4 * a + 3]; ex[4 * a + 1] = ex[4 * a + 2] * rr[4 * a + 2]; ex[4 * a] = ex[4 * a + 1] * rr[4 * a + 1];
        G[a] = ex[4 * a] * rr[4 * a];
    }
#pragma unroll
    for (int a = 0; a < 4; ++a) { float lo_, hi_; swap32(G[a], lo_, hi_); Gp[a] = hi_; Tt[a] = lo_ * hi_; }
    Suf[3] = 1.f; Suf[2] = Tt[3]; Suf[1] = Tt[3] * Tt[2]; Suf[0] = Suf[1] * Tt[1];
    f32x16 pr;
#pragma unroll
    for (int a = 0; a < 4; ++a) {
        const float after = Suf[a] * (hi == 0 ? Gp[a] : 1.f) * C;
#pragma unroll
        for (int i = 0; i < 4; ++i) pr[4 * a + i] = be[4 * a + i] * ex[4 * a + i] * after;
    }
    C = C * (Suf[0] * Tt[0]);
    pv_accum2(o0, o1, pr, vf);
    PIN2(o0, o1); load_vfrag(vf, kv.vbase, next); MEM_FENCE();
}

DI void sb_unit(int b, int h, int qt, const bf16_t* Qs_, const bf16_t* Ks_, const bf16_t* VtS_, LAS unsigned char* ot, int lane) {
    const int r32 = lane & 31, hi = lane >> 5;
    const int q0 = qt * 32, tq = q0 + r32;
    const size_t bh = (size_t)(b * 8 + h);
    const bf16_t* qfb = Qs_ + bh * (64 * 2048) + (size_t)qt * 2048;
    KvStream kv; kv.kbase = Ks_ + bh * (64 * 2048) + lane * 8; kv.vbase = VtS_ + bh * (64 * 2048) + lane * 8;
    bf16x8 kf[4], vf[4];
    load_kfrag(kf, kv.kbase, qt); load_vfrag(vf, kv.vbase, qt);
    bf16x8 qf[4];
#pragma unroll
    for (int s = 0; s < 4; ++s) qf[s] = *(const bf16x8*)(qfb + s * 512 + lane * 8);
    f32x16 o0 = zero16(), o1 = zero16();
    float C = 1.f;
    vm_drain();
    for (int kt = qt; kt >= 0; --kt) {
        sb_tile(kf, vf, qf, kt, kt > 0 ? kt - 1 : 0, kv, tq, hi, C, o0, o1);
        if (__all(C == 0.f ? 1 : 0)) break;
    }
    store_o_lds(ot, r32, h, o0, o1, 1.f, hi);
}

DI void ce_desc(unsigned& a, unsigned& b) { const unsigned hi = a > b ? a : b, lo = a > b ? b : a; a = hi; b = lo; }
DI void bitonic_clean_desc(unsigned (&v)[16]) {
#pragma unroll
    for (int s = 8; s >= 1; s >>= 1)
#pragma unroll
        for (int i = 0; i < 16; ++i) if ((i & s) == 0) ce_desc(v[i], v[i + s]);
}
DI void sort16_desc(unsigned (&v)[16]) {
#pragma unroll
    for (int k = 2; k <= 16; k <<= 1)
#pragma unroll
        for (int j = k >> 1; j >= 1; j >>= 1)
#pragma unroll
            for (int i = 0; i < 16; ++i) { const int l = i ^ j; if (l > i) { if ((i & k) == 0) ce_desc(v[i], v[l]); else ce_desc(v[l], v[i]); } }
}
DI float key_value(unsigned key) { const unsigned kk = key & ~127u; const unsigned u = (kk & 0x80000000u) ? (kk & 0x7fffffffu) : ~kk; return __builtin_bit_cast(float, u); }

DI float reduce16(const float (&p)[16], int lane) {
    const bool b3 = lane & 8, b2 = lane & 4, b1 = lane & 2, b0 = lane & 1;
    float q[8], r[4], s[2];
#pragma unroll
    for (int i = 0; i < 8; ++i) { const float mine = b3 ? p[i + 8] : p[i], send = b3 ? p[i] : p[i + 8]; q[i] = mine + __shfl_xor(send, 8); }
#pragma unroll
    for (int i = 0; i < 4; ++i) { const float mine = b2 ? q[i + 4] : q[i], send = b2 ? q[i] : q[i + 4]; r[i] = mine + __shfl_xor(send, 4); }
#pragma unroll
    for (int i = 0; i < 2; ++i) { const float mine = b1 ? r[i + 2] : r[i], send = b1 ? r[i] : r[i + 2]; s[i] = mine + __shfl_xor(send, 2); }
    const float mine = b0 ? s[1] : s[0], send = b0 ? s[0] : s[1];
    float t = mine + __shfl_xor(send, 1);
    t = sum_x32(sum_x16(t));
    return t;
}

#ifndef PEER_REP_TOPK
#define PEER_REP_TOPK 1
#endif
#ifndef PEER_REP_U
#define PEER_REP_U 1
#endif
#ifndef PEER_REP_V
#define PEER_REP_V 1
#endif
struct TopkIn { f32x4 hv[4]; bf16x8 sv[4]; };
DI void peer_topk_load(TopkIn& in, int tok, const float* out, const bf16_t* scores, int lane) {
    const int tc = tok < T ? tok : T - 1;
    const float* hrow = out + (size_t)tc * 1024 + 16 * lane;
    const bf16_t* sp = scores + (size_t)tc * 2048 + (lane >> 2) * 128 + (lane & 3) * 8;
#pragma unroll
    for (int i = 0; i < 4; ++i) { in.hv[i] = *(const f32x4*)(hrow + 4 * i); in.sv[i] = *(const bf16x8*)(sp + 32 * i); }
}
DI void peer_topk_token(int tok, const TopkIn& in, const float* gffn, int* EIDXg, float* GATEg, unsigned char* XN2g, LAS float* wl, int lane) {
    LAS unsigned* kbuf = (LAS unsigned*)wl; LAS unsigned* cand = (LAS unsigned*)(wl + 256); const LAS unsigned* ctab = (const LAS unsigned*)(wl + 768);
    f32x4 hv[4];
    float ss = 0.f;
#pragma unroll
    for (int i = 0; i < 4; ++i) { hv[i] = in.hv[i]; ss += (hv[i].x * hv[i].x + hv[i].y * hv[i].y) + (hv[i].z * hv[i].z + hv[i].w * hv[i].w); }
    ss = wave_sum(ss);
    const float rs2 = rsqrtf(ss * (1.f / 1024.f) + EPS);
    {
        u32x4 w;
#pragma unroll
        for (int i = 0; i < 4; ++i) { const f32x4 gv = *(const f32x4*)(gffn + 16 * lane + 4 * i);
            const float y0 = fminf(fmaxf(hv[i][0] * rs2 * gv[0] * 64.f, -448.f), 448.f), y1 = fminf(fmaxf(hv[i][1] * rs2 * gv[1] * 64.f, -448.f), 448.f);
            const float y2 = fminf(fmaxf(hv[i][2] * rs2 * gv[2] * 64.f, -448.f), 448.f), y3 = fminf(fmaxf(hv[i][3] * rs2 * gv[3] * 64.f, -448.f), 448.f);
            int p = 0;
            p = __builtin_amdgcn_cvt_pk_fp8_f32(y0, y1, p, false);
            p = __builtin_amdgcn_cvt_pk_fp8_f32(y2, y3, p, true);
            w[i] = (unsigned)p; }
        *(u32x4*)(XN2g + (size_t)tok * 1024 + 16 * lane) = w;
    }
    {
        const int L = lane >> 2, q = lane & 3;
        unsigned k0[16], k1[16];
#pragma unroll
        for (int i = 0; i < 4; ++i) {
            const bf16x8 v = in.sv[i];
#pragma unroll
            for (int cI = 0; cI < 8; ++cI) {
                const unsigned u = ((unsigned)(unsigned short)v[cI]) << 16;
                const unsigned mono = (u & 0x80000000u) ? ~u : (u | 0x80000000u);
                const unsigned key = (mono & ~127u) | (unsigned)(127 - (32 * i + 8 * q + cI));
                if (i < 2) k0[8 * i + cI] = key; else k1[8 * (i - 2) + cI] = key;
            }
        }
        sort16_desc(k0); sort16_desc(k1);
        unsigned t[16];
#pragma unroll
        for (int i = 0; i < 16; ++i) t[i] = k0[i] > k1[15 - i] ? k0[i] : k1[15 - i];
        bitonic_clean_desc(t);
#pragma unroll
        for (int i = 0; i < 16; ++i) k0[i] = (unsigned)__builtin_amdgcn_update_dpp(0, (int)t[15 - i], 0xB1, 0xF, 0xF, true);
#pragma unroll
        for (int i = 0; i < 16; ++i) t[i] = t[i] > k0[i] ? t[i] : k0[i];
        bitonic_clean_desc(t);
#pragma unroll
        for (int i = 0; i < 16; ++i) k0[i] = (unsigned)__builtin_amdgcn_update_dpp(0, (int)t[15 - i], 0x4E, 0xF, 0xF, true);
#pragma unroll
        for (int i = 0; i < 16; ++i) t[i] = t[i] > k0[i] ? t[i] : k0[i];
        bitonic_clean_desc(t);
        if (q == 0) {
#pragma unroll
            for (int i = 0; i < 4; ++i) { u32x4 w; w.x = t[4 * i]; w.y = t[4 * i + 1]; w.z = t[4 * i + 2]; w.w = t[4 * i + 3]; *(LAS u32x4*)(kbuf + L * 16 + 4 * i) = w; }
        }
        asm volatile("s_waitcnt lgkmcnt(0)" ::: "memory");
    }
    {
        const int hd = lane >> 3, sub = lane & 7;
        unsigned ck[7]; int ce[7]; float cv[7];
#pragma unroll
        for (int k = 0; k < 7; ++k) {
            const int cidx = 7 * sub + k;
            const unsigned tab = ctab[cidx];
            const unsigned ka = kbuf[hd * 32 + (tab & 15u)], kb = kbuf[hd * 32 + 16 + ((tab >> 8) & 15u)];
            const float v = key_value(ka) + key_value(kb);
            cv[k] = v;
            ce[k] = (127 - (int)(ka & 127u)) * 128 + (127 - (int)(kb & 127u));
            const unsigned u = __float_as_uint(v);
            const unsigned mono = (u & 0x80000000u) ? ~u : (u | 0x80000000u);
            ck[k] = (cidx < 50) ? ((mono & ~63u) | (unsigned)(63 - cidx)) : 0u;
            cand[hd * 64 + cidx] = ck[k];
        }
        asm volatile("s_waitcnt lgkmcnt(0)" ::: "memory");
        int rank[7];
#pragma unroll
        for (int k = 0; k < 7; ++k) rank[k] = 0;
#pragma unroll
        for (int c4 = 0; c4 < 13; ++c4) {
            const u32x4 o4 = *(const LAS u32x4*)(cand + hd * 64 + 4 * c4);
#pragma unroll
            for (int i = 0; i < 4; ++i) if (4 * c4 + i < 50) {
#pragma unroll
                for (int k = 0; k < 7; ++k) rank[k] += (o4[i] > ck[k]) ? 1 : 0;
            }
        }
        float mx = -INFINITY;
#pragma unroll
        for (int k = 0; k < 7; ++k) mx = fmaxf(mx, (7 * sub + k < 50) ? cv[k] : -INFINITY);
        mx = max_oct(mx);
        float ev[7], es = 0.f;
#pragma unroll
        for (int k = 0; k < 7; ++k) { const bool selk = (7 * sub + k < 50) && rank[k] < 16; ev[k] = selk ? __expf((cv[k] - mx) * rs2) : 0.f; es += ev[k]; }
        es = sum_oct(es);
        const float inv = 1.f / es;
#pragma unroll
        for (int k = 0; k < 7; ++k) if ((7 * sub + k < 50) && rank[k] < 16) { EIDXg[(size_t)tok * 128 + hd * 16 + rank[k]] = ce[k]; GATEg[(size_t)tok * 128 + hd * 16 + rank[k]] = ev[k] * inv; }
    }
}

DI float dot16_fp8(const u32x4& row, const float (&x)[16]) {
    float sacc = 0.f;
#pragma unroll
    for (int w = 0; w < 4; ++w) { const f32x2 lo = __builtin_amdgcn_cvt_pk_f32_fp8((int)row[w], false), hi2 = __builtin_amdgcn_cvt_pk_f32_fp8((int)row[w], true);
        sacc += lo.x * x[4 * w] + lo.y * x[4 * w + 1] + hi2.x * x[4 * w + 2] + hi2.y * x[4 * w + 3]; }
    return sacc;
}
template <class TT> DI TT ldu(const void* ubase, unsigned off) { return *(const TT*)((const char*)ubase + off); }
typedef _Float16 h2_t __attribute__((ext_vector_type(2)));
DI void peer_u_slice(int sl, int tk_first, int tk_step, const unsigned char* XN8g, const int* EIDXg, const unsigned char* U8s, float* PDOT, int lane) {
    const int es = lane >> 3, c = lane & 7;
    const unsigned char* tb = U8s + (size_t)sl * 16384 * 128;
    const unsigned c16 = 16u * c, eoff = 64u * es, xoff = 128u * sl + 16u * c, poff = (16u * es + c) * 4u;
    const bool b2 = c & 4, b1 = c & 2, b0 = c & 1;
    u32x4 I0[2], I1[2], I2[2], rowsA[8], rowsB[8], rowsC[8], x0, x1, x2;
#define LD_E8(ib, tk, h) do { const int _t = (tk) < T ? (tk) : T - 1; const int* _eb = EIDXg + (size_t)_t * 128 + 8 * (h); ib[0] = ldu<u32x4>(_eb, eoff); ib[1] = ldu<u32x4>(_eb, eoff + 16u); } while (0)
#define LD_R8(rows, ib, tbl) do { _Pragma("unroll") for (int _q = 0; _q < 2; ++_q) _Pragma("unroll") for (int _r = 0; _r < 4; ++_r) rows[4 * _q + _r] = ldu<u32x4>(tbl, ib[_q][_r] * 128u + c16); } while (0)
#define LD_X(xx, tk) do { const int _t = (tk) < T ? (tk) : T - 1; xx = ldu<u32x4>(XN8g + (size_t)_t * 1024, xoff); } while (0)
#define U_COMPUTE8(rows, xx, tk, h) do { h2_t _x[8]; _Pragma("unroll") for (int _w = 0; _w < 4; ++_w) { _x[2 * _w] = __builtin_amdgcn_cvt_scalef32_pk_f16_fp8(xx[_w], 1.0f, false); _x[2 * _w + 1] = __builtin_amdgcn_cvt_scalef32_pk_f16_fp8(xx[_w], 1.0f, true); } \
        float _p[8]; _Pragma("unroll") for (int _i = 0; _i < 8; ++_i) { if (_i > 0) asm volatile("" : "+v"(rows[_i]) : "v"(_p[_i - 1])); float _s = 0.f; \
            _Pragma("unroll") for (int _w = 0; _w < 4; ++_w) { _s = __builtin_amdgcn_fdot2(__builtin_amdgcn_cvt_scalef32_pk_f16_fp8(rows[_i][_w], 1.0f, false), _x[2 * _w], _s, false); \
                _s = __builtin_amdgcn_fdot2(__builtin_amdgcn_cvt_scalef32_pk_f16_fp8(rows[_i][_w], 1.0f, true), _x[2 * _w + 1], _s, false); } _p[_i] = _s; } \
        float _q4[4], _q2[2]; \
        _Pragma("unroll") for (int _k = 0; _k < 4; ++_k) { const float _m = b2 ? _p[_k + 4] : _p[_k], _s = b2 ? _p[_k] : _p[_k + 4]; _q4[_k] = _m + __shfl_xor(_s, 4); } \
        _Pragma("unroll") for (int _k = 0; _k < 2; ++_k) { const float _m = b1 ? _q4[_k + 2] : _q4[_k], _s = b1 ? _q4[_k] : _q4[_k + 2]; _q2[_k] = _m + __shfl_xor(_s, 2); } \
        const float _m = b0 ? _q2[1] : _q2[0], _s = b0 ? _q2[0] : _q2[1]; const float _r1 = _m + __shfl_xor(_s, 1); \
        if ((tk) < T) { float* _pb = PDOT + ((size_t)sl * T + (tk)) * 128 + 8 * (h); *(float*)((char*)_pb + poff) = _r1; } } while (0)
    int t0 = tk_first;
    LD_E8(I0, t0, 0); LD_E8(I1, t0, 1); LD_E8(I2, t0 + tk_step, 0); LD_X(x0, t0); LD_R8(rowsA, I0, tb); LD_R8(rowsB, I1, tb);
#pragma unroll 1
    for (; t0 < T; t0 += 3 * tk_step) {
        const int t1 = t0 + tk_step, t2 = t1 + tk_step, t3 = t2 + tk_step;
        LD_E8(I0, t1, 1);           LD_R8(rowsC, I2, tb); LD_X(x1, t1); U_COMPUTE8(rowsA, x0, t0, 0);
        LD_E8(I1, t2, 0);           LD_R8(rowsA, I0, tb);               U_COMPUTE8(rowsB, x0, t0, 1);
        LD_E8(I2, t2, 1);           LD_R8(rowsB, I1, tb); LD_X(x2, t2); U_COMPUTE8(rowsC, x1, t1, 0);
        LD_E8(I0, t3, 0);           LD_R8(rowsC, I2, tb);               U_COMPUTE8(rowsA, x1, t1, 1);
        LD_E8(I1, t3, 1);           LD_R8(rowsA, I0, tb); LD_X(x0, t3); U_COMPUTE8(rowsB, x2, t2, 0);
        LD_E8(I2, t3 + tk_step, 0); LD_R8(rowsB, I1, tb);               U_COMPUTE8(rowsC, x2, t2, 1);
    }
#undef U_COMPUTE8
#undef LD_X
}
template <int NT> DI void peer_cj_tokens(int tok0, int tstride, const int* EIDXg, const float* GATEg, const float* PDOT, const float* usc, const float* vsc, float* CJg, float* CMAXg, int lane) {
    int e[NT][2]; float d[NT][2], g[NT][2];
#pragma unroll
    for (int i = 0; i < NT; ++i) { const int tok = tok0 + i * tstride, tc = tok < T ? tok : T - 1;
#pragma unroll
        for (int hh = 0; hh < 2; ++hh) { const int j = lane + 64 * hh; e[i][hh] = EIDXg[(size_t)tc * 128 + j]; g[i][hh] = GATEg[(size_t)tc * 128 + j]; float a = 0.f;
#pragma unroll
            for (int x = 0; x < 8; ++x) a += PDOT[((size_t)x * T + tc) * 128 + j];
            d[i][hh] = a; } }
    float us[NT][2], vs[NT][2];
#pragma unroll
    for (int i = 0; i < NT; ++i)
#pragma unroll
        for (int hh = 0; hh < 2; ++hh) { us[i][hh] = usc[e[i][hh]]; vs[i][hh] = vsc[e[i][hh]]; }
#pragma unroll
    for (int i = 0; i < NT; ++i) { const int tok = tok0 + i * tstride;
        float cv[2], cm = 0.f;
#pragma unroll
        for (int hh = 0; hh < 2; ++hh) {
            const float hraw = d[i][hh] * us[i][hh] * (1.f / 64.f);
            const float hid = 0.5f * hraw * (1.f + erff(hraw * 0.70710678118654752f));
            cv[hh] = hid * g[i][hh] * vs[i][hh];
            cm = fmaxf(cm, fabsf(cv[hh]));
        }
        cm = wave_max(cm);
        const float inv = cm > 0.f ? 1.f / cm : 0.f;
        if (tok < T) { CJg[(size_t)tok * 128 + lane] = cv[0] * inv; CJg[(size_t)tok * 128 + 64 + lane] = cv[1] * inv; if (lane == 0) CMAXg[tok] = cm; }
    }
}
DI void peer_v_slice(int sl, int tk_first, int tk_step, float* out, const int* EIDXg, const float* CJg, const float* CMAXg, const unsigned char* V8s, bf16_t* A4g, float* SSQg, int lane) {
    const int es = lane >> 3, c = lane & 7;
    const unsigned char* tb = V8s + (size_t)sl * 16384 * 128;
    const unsigned c16 = 16u * c, eoff = 64u * es, ob = 128u * sl + 16u * c + 2u * es;
    const bool b5 = lane & 32, b4 = lane & 16, b3 = lane & 8;
    u32x4 I0[2], I1[2], I2[2], rowsA[8], rowsB[8], rowsC[8]; f32x4 cA[2], cB[2], cC[2]; f32x2 h0, h1, h2;
#define LD_C8(cc, tk, h) do { const int _t = (tk) < T ? (tk) : T - 1; const float* _cb = CJg + (size_t)_t * 128 + 8 * (h); cc[0] = ldu<f32x4>(_cb, eoff); cc[1] = ldu<f32x4>(_cb, eoff + 16u); } while (0)
#define V_AXPY8(rows, cc) do { _Pragma("unroll") for (int _q = 0; _q < 2; ++_q) _Pragma("unroll") for (int _r = 0; _r < 4; ++_r) { const _Float16 _ch = (_Float16)cc[_q][_r]; const h2_t _c2 = {_ch, _ch}; \
            _Pragma("unroll") for (int _w = 0; _w < 4; ++_w) { acch[2 * _w] = __builtin_amdgcn_cvt_scalef32_pk_f16_fp8(rows[4 * _q + _r][_w], 1.0f, false) * _c2 + acch[2 * _w]; \
                acch[2 * _w + 1] = __builtin_amdgcn_cvt_scalef32_pk_f16_fp8(rows[4 * _q + _r][_w], 1.0f, true) * _c2 + acch[2 * _w + 1]; } \
              \
            if (4 * _q + _r < 7) asm volatile("" : "+v"(acch[0]), "+v"(acch[1]), "+v"(acch[2]), "+v"(acch[3]), "+v"(acch[4]), "+v"(acch[5]), "+v"(acch[6]), "+v"(acch[7]), "+v"(rows[(4 * _q + _r + 1) & 7])); \
            else asm volatile("" : "+v"(acch[0]), "+v"(acch[1]), "+v"(acch[2]), "+v"(acch[3]), "+v"(acch[4]), "+v"(acch[5]), "+v"(acch[6]), "+v"(acch[7])); } } while (0)
#define LD_H(hh, tk) do { const int _t = (tk) < T ? (tk) : T - 1; hh = ldu<f32x2>(out + (size_t)_t * 1024, ob * 4u); } while (0)
#define V_ZERO() do { _Pragma("unroll") for (int _i = 0; _i < 8; ++_i) acch[_i] = (h2_t){(_Float16)0.f, (_Float16)0.f}; } while (0)
#define V_FINAL(hh, tk) do { float _a[16]; _Pragma("unroll") for (int _i = 0; _i < 8; ++_i) { _a[2 * _i] = (float)acch[_i].x; _a[2 * _i + 1] = (float)acch[_i].y; } \
        const float _cm = CMAXg[(tk) < T ? (tk) : T - 1]; \
        float _q8[8], _q4[4], _q2[2]; \
        _Pragma("unroll") for (int _k = 0; _k < 8; ++_k) { const float _m = b5 ? _a[_k + 8] : _a[_k], _s = b5 ? _a[_k] : _a[_k + 8]; _q8[_k] = _m + __shfl_xor(_s, 32); } \
        _Pragma("unroll") for (int _k = 0; _k < 4; ++_k) { const float _m = b4 ? _q8[_k + 4] : _q8[_k], _s = b4 ? _q8[_k] : _q8[_k + 4]; _q4[_k] = _m + __shfl_xor(_s, 16); } \
        _Pragma("unroll") for (int _k = 0; _k < 2; ++_k) { const float _m = b3 ? _q4[_k + 2] : _q4[_k], _s = b3 ? _q4[_k] : _q4[_k + 2]; _q2[_k] = _m + __shfl_xor(_s, 8); } \
        const float _ha = hh.x + _q2[0] * _cm, _hb = hh.y + _q2[1] * _cm; const float _ssq = wave_sum(_ha * _ha + _hb * _hb); \
        if ((tk) < T) { *(f32x2*)((char*)(out + (size_t)(tk) * 1024) + ob * 4u) = (f32x2){_ha, _hb}; *(unsigned*)((char*)(A4g + (size_t)(tk) * 1024) + ob * 2u) = cvtpk(_ha, _hb); \
            if (lane == 0) SSQg[(size_t)sl * T + (tk)] = _ssq; } } while (0)
    h2_t acch[8];
    int t0 = tk_first;
    LD_E8(I0, t0, 0); LD_E8(I1, t0, 1); LD_E8(I2, t0 + tk_step, 0); LD_H(h0, t0); LD_R8(rowsA, I0, tb); LD_C8(cA, t0, 0); LD_R8(rowsB, I1, tb); LD_C8(cB, t0, 1);
#pragma unroll 1
    for (; t0 < T; t0 += 3 * tk_step) {
        const int t1 = t0 + tk_step, t2 = t1 + tk_step, t3 = t2 + tk_step;
        LD_E8(I0, t1, 1);           LD_R8(rowsC, I2, tb); LD_C8(cC, t1, 0); LD_H(h1, t1); V_ZERO(); V_AXPY8(rowsA, cA);
        LD_E8(I1, t2, 0);           LD_R8(rowsA, I0, tb); LD_C8(cA, t1, 1);                          V_AXPY8(rowsB, cB); V_FINAL(h0, t0);
        LD_E8(I2, t2, 1);           LD_R8(rowsB, I1, tb); LD_C8(cB, t2, 0); LD_H(h2, t2); V_ZERO(); V_AXPY8(rowsC, cC);
        LD_E8(I0, t3, 0);           LD_R8(rowsC, I2, tb); LD_C8(cC, t2, 1);                          V_AXPY8(rowsA, cA); V_FINAL(h1, t1);
        LD_E8(I1, t3, 1);           LD_R8(rowsA, I0, tb); LD_C8(cA, t3, 0); LD_H(h0, t3); V_ZERO(); V_AXPY8(rowsB, cB);
        LD_E8(I2, t3 + tk_step, 0); LD_R8(rowsB, I1, tb); LD_C8(cB, t3, 1);                          V_AXPY8(rowsC, cC); V_FINAL(h2, t2);
    }
#undef V_FINAL
#undef V_ZERO
#undef LD_H
#undef V_AXPY8
#undef LD_C8
#undef LD_R8
#undef LD_E8
}

typedef const __attribute__((address_space(4))) unsigned long long* karg_ptr_t;
DI karg_ptr_t kargs() { karg_ptr_t p = (karg_ptr_t)__builtin_amdgcn_kernarg_segment_ptr(); asm volatile("" : "+s"(p)); return p; }
#define GAS1 __attribute__((address_space(1)))
#define KIN(k) ((const float*)(const GAS1 float*)kargs()[k])
#define KOUT() ((float*)(GAS1 float*)kargs()[18])
#define KWS() ((unsigned char*)(GAS1 unsigned char*)kargs()[19])

__global__ void __launch_bounds__(512, 2) fwd_kernel(Params P) {
    extern __shared__ __attribute__((aligned(16))) unsigned char lds_raw[];
    LAS unsigned char* lds = (LAS unsigned char*)lds_raw;
    const int tid = threadIdx.x, lane = tid & 63, wid = __builtin_amdgcn_readfirstlane(tid >> 6);
    const int wg = blockIdx.x, nwg = gridDim.x;
    const int gwave = wg * 8 + wid, nwaves = nwg * 8;
    const int lo = P.ph_lo, hi = P.ph_hi;

    volatile LAS unsigned* misc = (volatile LAS unsigned*)(lds + LDS_BYTES - 64);
    if (tid < 16) misc[tid] = 0u;
    __syncthreads();
    { unsigned* xcw = (unsigned*)(KWS() + WS_CTL) + CW_XC;
      if (tid == 0) { const unsigned xcc = xb_xcc_id(); misc[5] = xcc; misc[4] = xb_add(xcw + 64 * xcc, 1u); } }
    XcdBarrier bar; bar.bar = (unsigned*)(KWS() + WS_CTL) + CW_BAR; bar.x = 0; bar.st = misc;
    if (hi - lo > 1) bar = xcd_barrier_post((unsigned*)(KWS() + WS_CTL) + CW_BAR, misc);

#define kmean   ((float*)(KWS() + WS_KMEAN))
#define biasTab ((float*)(KWS() + WS_BIAS))
#define WinT    ((bf16_t*)(KWS() + WS_WIN))
#define WoutT   ((bf16_t*)(KWS() + WS_WOUT))
#define WqT     ((bf16_t*)(KWS() + WS_WQ))
#define WgT     ((bf16_t*)(KWS() + WS_WG))
#define WpleT   ((bf16_t*)(KWS() + WS_WPLE))
#define U8      ((unsigned char*)(KWS() + WS_U))
#define V8      ((unsigned char*)(KWS() + WS_V))
#define USC     ((float*)(KWS() + WS_USC))
#define VSC     ((float*)(KWS() + WS_VSC))
#define XN      ((bf16_t*)(KWS() + WS_XN))
#define PB      ((bf16_t*)(KWS() + WS_PB))
#define Qm      ((bf16_t*)(KWS() + WS_QM))
#define Km      ((bf16_t*)(KWS() + WS_KM))
#define VtM     ((bf16_t*)(KWS() + WS_VTM))
#define Qs      ((bf16_t*)(KWS() + WS_QS))
#define Ks      ((bf16_t*)(KWS() + WS_KS))
#define VtS     ((bf16_t*)(KWS() + WS_VTS))
#define Oraw    ((bf16_t*)(KWS() + WS_ORAW))
#define A2      ((bf16_t*)(KWS() + WS_A2))
#define A3      ((bf16_t*)(KWS() + WS_A3))
#define SC      ((float*)(KWS() + WS_SC))
#define EIDXG   ((int*)(KWS() + WS_EIDX))
#define GATEG   ((float*)(KWS() + WS_GATE))
#define CJG     ((float*)(KWS() + WS_CJ))
#define RS2G    ((float*)(KWS() + WS_RS2))
#define SSQG    ((float*)(KWS() + WS_SSQ))
#define PDOTG   ((float*)(KWS() + WS_PDOT))
#define A4G     ((bf16_t*)(KWS() + WS_A4))
#define XN2G    ((unsigned char*)(KWS() + WS_XN2))

#define IN(k) (lo <= (k) && (k) < hi)
#ifndef PROBE_PHASE
#define PROBE_PHASE -1
#endif
#ifndef PROBE_REPS
#define PROBE_REPS 1
#endif
#define REP(k) for (int _rep = 0; _rep < ((k) == PROBE_PHASE ? PROBE_REPS : 1); ++_rep)
#define SEAM(k) do { if (IN(k) && IN((k) + 1)) xcd_barrier(bar); } while (0)

    if (IN(0)) REP(0) {
        LAS float* scr = (LAS float*)lds;
        p0_transpose<true>(KIN(IN_WIN), 1024, 3072, WinT, scr, tid, wg, nwg);
        p0_transpose<false>(KIN(IN_WOUT), 1024, 1024, WoutT, scr, tid, wg, nwg);
        p0_transpose<false>(KIN(IN_WPG), 1024, 1024, WgT, scr, tid, wg, nwg, KIN(IN_PLE_NORM));
        p0_transpose<false>(KIN(IN_WPLE), 256, 1024, WpleT, scr, tid, wg, nwg);
        p0_fold(KIN(IN_PQ), KIN(IN_SUBK), KIN(IN_FFN_NORM), WqT, scr, tid, wg, nwg);
        const size_t gtid = (size_t)wg * 512 + tid, nthr = (size_t)nwg * 512;
        p0_convert(KIN(IN_P), PB, (size_t)T * 256, gtid, nthr);
        { const float* xp = KIN(IN_X); const float* gp = KIN(IN_ATTN_NORM); bf16_t* xo = XN;
          for (int row = gwave; row < T; row += 2 * nwaves) rmsnorm_rows2_bf16(xp, gp, xo, row, row + nwaves, lane); }
        if (wg == 0) {
            for (int idx = tid; idx < 8 * 129; idx += 512) {
                const int h = idx / 129, dist = idx % 129;
                int bk;
                if (dist < 16) bk = dist;
                else { const float v = logf((float)dist / 16.f) / 2.0794415416798357f * 16.f; bk = 16 + (int)v; bk = bk > 31 ? 31 : bk; }
                biasTab[h * 132 + dist] = KIN(IN_RELB)[bk * 8 + h] * LOG2E;
            }
        }
    }
    SEAM(0);
    if (IN(1)) REP(1) {
        pg8::Gemm g{XN, WinT, T, NPROJ, 1024}; pg8::StaticOrder S; S.init(T, NPROJ, nwg, wg);
        EpiQKV E{Qm, KIN(IN_QNORM), KIN(IN_KNORM)};
        pg8::gemm_phase<EpiQKV, pg8::StaticOrder, true, true>(lds, g, S, E);
    }
    SEAM(1);
    if (IN(2)) REP(2) {
        for (int item = gwave; item < 512; item += nwaves) {
            const int bhh = item >> 3, blk = item & 7;
            float sacc[4][8];
#pragma unroll
            for (int q = 0; q < 4; ++q)
#pragma unroll
                for (int j = 0; j < 8; ++j) sacc[q][j] = 0.f;
            const bf16_t* base = Km + ((size_t)bhh * 64 + blk * 8) * 2048 + lane * 8;
#pragma unroll 2
            for (int t8 = 0; t8 < 8; ++t8)
#pragma unroll
                for (int q = 0; q < 4; ++q) { const bf16x8 v = *(const bf16x8*)(base + (size_t)t8 * 2048 + q * 512);
#pragma unroll
                    for (int j = 0; j < 8; ++j) sacc[q][j] += bf2f(v[j]); }
#pragma unroll
            for (int q = 0; q < 4; ++q)
#pragma unroll
                for (int j = 0; j < 8; ++j) { float v = sacc[q][j];
                    sacc[q][j] = sum_x16(sum_row16(v)); }
            if ((lane & 31) == 0) {
                const int hh = lane >> 5;
#pragma unroll
                for (int q = 0; q < 4; ++q)
#pragma unroll
                    for (int j = 0; j < 8; ++j) kmean[(size_t)item * 64 + 16 * q + 8 * hh + j] = sacc[q][j] * (1.f / 256.f);
            }
        }
    }
    SEAM(2);
    if (IN(3)) REP(3) {
        const float* pu = KIN(IN_PU); const float* pv = KIN(IN_PV); unsigned char* u8 = U8; unsigned char* v8 = V8; float* usc_ = USC; float* vsc_ = VSC;
        const bf16_t* qm_ = Qm; const bf16_t* km_ = Km; const bf16_t* vtm_ = VtM; const bf16_t* qs_ = Qs; const bf16_t* ks_ = Ks; const bf16_t* vts_ = VtS;
        const float* kmn_ = kmean; const float* bt_ = biasTab; bf16_t* a2_ = A2;
        const float* gm_ = KIN(IN_ONM); const float* gs_ = KIN(IN_ONS);
        LAS unsigned char* ot = lds;
        LAS float* biasLds = (LAS float*)(lds + 34816);
        for (int i = tid; i < 8 * 132; i += 512) biasLds[i] = bt_[i];
        __syncthreads();
        int qrow = gwave;
        for (int u = gwave; u < 8192; u += nwaves) {
            const int grp = u >> 12, i = u & 4095;
            const int half = i >> 11, j = i & 2047;
            const int qt = half ? (j >> 6) : 63 - (j >> 6), bh = j & 63;
            const int b = bh >> 3, h = bh & 7;
            if (grp == 0) moba_unit(b, h, qt, qm_, km_, vtm_, kmn_, biasLds, ot, lane);
            else sb_unit(b, h, qt, qs_, ks_, vts_, ot, lane);
            __syncthreads();
            {
                const float* gg = grp ? gs_ : gm_;
                const f32x4 g0 = *(const f32x4*)(gg + 8 * lane), g1 = *(const f32x4*)(gg + 8 * lane + 4);
#pragma unroll
                for (int rr = 0; rr < 4; ++rr) {
                    const int row = 4 * wid + rr;
                    const bf16x8 v = *(const LAS bf16x8*)(ot + row * OT_PITCH + lane * 16);
                    float f[8], sq = 0.f;
#pragma unroll
                    for (int e = 0; e < 8; ++e) { f[e] = bf2f(v[e]); sq += f[e] * f[e]; }
                    sq = wave_sum(sq);
                    const float rs = rsqrtf(sq * (1.f / 512.f) + EPS);
                    u32x4 w; w.x = cvtpk(f[0] * rs * g0.x, f[1] * rs * g0.y); w.y = cvtpk(f[2] * rs * g0.z, f[3] * rs * g0.w);
                    w.z = cvtpk(f[4] * rs * g1.x, f[5] * rs * g1.y); w.w = cvtpk(f[6] * rs * g1.z, f[7] * rs * g1.w);
                    *(u32x4*)(a2_ + (size_t)(b * 2048 + qt * 32 + row) * 1024 + grp * 512 + 8 * lane) = w;
                }
            }
            __syncthreads();
            for (int k = 0; k < 1 && qrow < 16384; ++k, qrow += 2 * nwaves) p0_quant_rows4(pu, pv, u8, v8, usc_, vsc_, qrow, qrow + nwaves, lane);
        }
        for (; qrow < 16384; qrow += 2 * nwaves) p0_quant_rows4(pu, pv, u8, v8, usc_, vsc_, qrow, qrow + nwaves, lane);
    }
    SEAM(3);
    if (IN(5)) REP(5) {
        pg8::Gemm g{A2, WoutT, T, 1024, 1024}; pg8::StaticOrder S; S.init(T, 1024, nwg, wg);
        EpiRes E{KIN(IN_X), KOUT(), A3};
        pg8::gemm_phase<EpiRes, pg8::StaticOrder, true, true>(lds, g, S, E);
    }
    SEAM(5);
    if (IN(6)) REP(6) {
        pg8::Gemm g{A3, WqT, T, 2048, 1024}; pg8::StaticOrder S; S.init(T, 2048, nwg, wg);
        EpiBf E{(bf16_t*)SC, 2048};
        pg8::gemm_phase<EpiBf, pg8::StaticOrder, true, true>(lds, g, S, E);
    }
    SEAM(6);
    if (IN(7)) REP(7) {
        LAS float* wl = (LAS float*)(lds + wid * 4096);
        {
            const int c = lane; int ca, cb;
            if (c < 16) { ca = 0; cb = c; } else if (c < 24) { ca = 1; cb = c - 16; } else if (c < 29) { ca = 2; cb = c - 24; } else if (c < 33) { ca = 3; cb = c - 29; }
            else if (c < 36) { ca = 4; cb = c - 33; } else if (c < 42) { ca = 5 + ((c - 36) >> 1); cb = (c - 36) & 1; } else { ca = (c - 34) & 15; cb = 0; }
            ((LAS unsigned*)(wl + 768))[lane] = (unsigned)ca | ((unsigned)cb << 8);
            asm volatile("s_waitcnt lgkmcnt(0)" ::: "memory");
        }
        const float* h1p = KOUT(); const bf16_t* scp = (const bf16_t*)SC; const float* gfp = KIN(IN_FFN_NORM); int* eip = EIDXG; float* gtp = GATEG; unsigned char* xnp = XN2G;
        TopkIn inA, inB;
        peer_topk_load(inA, gwave, h1p, scp, lane);
        for (int tok = gwave; tok < T; tok += 2 * nwaves) {
            peer_topk_load(inB, tok + nwaves, h1p, scp, lane);
            peer_topk_token(tok, inA, gfp, eip, gtp, xnp, wl, lane);
            peer_topk_load(inA, tok + 2 * nwaves, h1p, scp, lane);
            if (tok + nwaves < T) peer_topk_token(tok + nwaves, inB, gfp, eip, gtp, xnp, wl, lane);
        }
    }
    SEAM(7);
    int sl_first = 0, sl_step = 1, tk_first = 0, tk_step = 8;
    if (IN(8) || IN(10)) {
        __syncthreads();
        const unsigned myx = misc[5], myrank = misc[4];
        unsigned nx = 0, myidx = 0, nloc = 1;
        unsigned* xc = (unsigned*)(KWS() + WS_CTL) + CW_XC;
#pragma unroll
        for (unsigned j = 0; j < 16; ++j) { const unsigned cj = xb_ld(xc + 64 * j); if (cj > 0u) { if (j < myx) ++myidx; ++nx; } if (j == myx) nloc = cj; }
        sl_first = __builtin_amdgcn_readfirstlane((int)myidx); sl_step = __builtin_amdgcn_readfirstlane((int)(nx > 0u ? nx : 1u));
        tk_first = __builtin_amdgcn_readfirstlane((int)myrank * 8 + wid); tk_step = __builtin_amdgcn_readfirstlane((int)(nloc > 0u ? nloc : 1u) * 8);
    }
    if (IN(8)) REP(8) {
        const unsigned char* xnp = XN2G; const int* eip = EIDXG; const unsigned char* u8p = U8; float* pdp = PDOTG;
        for (int sl = sl_first; sl < 8; sl += sl_step) peer_u_slice(sl, tk_first, tk_step, xnp, eip, u8p, pdp, lane);
    }
    SEAM(8);
    if (IN(9)) REP(9) {
        const int* eip = EIDXG; const float* gtp = GATEG; const float* pdp = PDOTG; const float* usp = USC; const float* vsp = VSC; float* cjp = CJG; float* cmp_ = RS2G;
        for (int tok = gwave; tok < T; tok += 4 * nwaves) peer_cj_tokens<4>(tok, nwaves, eip, gtp, pdp, usp, vsp, cjp, cmp_, lane);
    }
    SEAM(9);
    if (IN(10)) REP(10) {
        float* outp = KOUT(); const int* eip = EIDXG; const float* cjp = CJG; const float* cmp_ = RS2G; const unsigned char* v8p = V8; bf16_t* a4p = A4G; float* sqp = SSQG;
        for (int sl = sl_first; sl < 8; sl += sl_step) peer_v_slice(sl, tk_first, tk_step, outp, eip, cjp, cmp_, v8p, a4p, sqp, lane);
    }
    SEAM(10);
    if (IN(11)) REP(11) {
        bf16_t* PW = Oraw;
        { int kple = 256; asm volatile("" : "+s"(kple));
          pg8::Gemm g{PB, WpleT, T, 1024, kple}; pg8::StaticOrder S; S.init(T, 1024, nwg, wg);
          EpiBf E{PW, 1024};
          pg8::gemm_phase<EpiBf, pg8::StaticOrder, true, true>(lds, g, S, E); }
        asm volatile("s_waitcnt vmcnt(0)" ::: "memory");
        __syncthreads();
        { pg8::Gemm g{A4G, WgT, T, 1024, 1024}; pg8::StaticOrder S; S.init(T, 1024, nwg, wg);
          EpiGate E{KOUT(), PW, SSQG};
          pg8::gemm_phase<EpiGate, pg8::StaticOrder, true, true>(lds, g, S, E); }
    }
#undef IN
#undef SEAM
}

extern "C" void kernel_launch(void* const* d_in, const int* in_sizes, int n_in, void* d_out, int out_size, void* d_ws, size_t ws_size, hipStream_t stream) {
    static int grid = 0;
    if (grid == 0) {
        if (n_in != 18 || out_size != T * DM || ws_size < WS_END) { fprintf(stderr, "kernel_launch: unexpected shapes (n_in %d out %d ws %zu)\n", n_in, out_size, ws_size); grid = -1; return; }
        int dev = 0, cus = 0, per_cu = 0;
        if (hipGetDevice(&dev) != hipSuccess || hipDeviceGetAttribute(&cus, hipDeviceAttributeMultiprocessorCount, dev) != hipSuccess) { grid = -1; return; }
        if (hipFuncSetAttribute((const void*)fwd_kernel, hipFuncAttributeMaxDynamicSharedMemorySize, LDS_BYTES) != hipSuccess) { fprintf(stderr, "kernel_launch: hipFuncSetAttribute failed\n"); grid = -1; return; }
        if (hipOccupancyMaxActiveBlocksPerMultiprocessor(&per_cu, (const void*)fwd_kernel, 512, LDS_BYTES) != hipSuccess || per_cu < 1)
            fprintf(stderr, "kernel_launch: note: occupancy query reports %d\n", per_cu);
        (void)hipGetLastError();
        grid = cus - (cus % 8);
    }
    if (grid < 0) return;
    if (hipMemsetAsync((char*)d_ws + WS_CTL, 0, CTL_ZERO_BYTES, stream) != hipSuccess) return;
    Params p{};
    for (int i = 0; i < 18; ++i) p.in[i] = (const float*)d_in[i];
    p.out = (float*)d_out; p.ws = (unsigned char*)d_ws;
    p.ph_lo = 0; p.ph_hi = NPHASE;
    hipLaunchKernelGGL(fwd_kernel, dim3(grid), dim3(512), LDS_BYTES, stream, p);
}
```

```cpp
#include <hip/hip_runtime.h>
#include <stdint.h>
#include <stdio.h>

#ifndef N_LAUNCHES
#define N_LAUNCHES 1
#endif

#define DI __device__ __forceinline__
#define LAS __attribute__((address_space(3)))

typedef unsigned short bf16_t;
typedef short bf16x8 __attribute__((ext_vector_type(8)));
typedef float f32x16 __attribute__((ext_vector_type(16)));
typedef float f32x4 __attribute__((ext_vector_type(4)));
typedef float f32x2 __attribute__((ext_vector_type(2)));
typedef unsigned u32x4 __attribute__((ext_vector_type(4)));
typedef unsigned u32x2 __attribute__((ext_vector_type(2)));
typedef __bf16 bf16x2_t __attribute__((ext_vector_type(2)));

constexpr int BATCH = 8, SEQ = 2048, DM = 1024, T = BATCH * SEQ;
constexpr int NPROJ = 3072;
constexpr float EPS = 1e-6f;
constexpr float LOG2E = 1.4426950408889634f;
constexpr float SCL2 = 0.125f * LOG2E;
constexpr int NPHASE = 12;

constexpr size_t MiB = 1u << 20;
constexpr size_t WS_CTL = 0, CTL_ZERO_BYTES = 65536;
constexpr size_t WS_KMEAN = 256 * 1024;
constexpr size_t WS_BIAS = 512 * 1024;
constexpr size_t WS_WIN = 1 * MiB, WS_WOUT = 7 * MiB, WS_WQ = 9 * MiB, WS_WG = 13 * MiB, WS_WPLE = 15 * MiB;
constexpr size_t WS_U = 16 * MiB, WS_V = 32 * MiB;
constexpr size_t WS_USC = 640 * 1024, WS_VSC = 704 * 1024;
constexpr size_t WS_XN2 = 48 * MiB;
constexpr size_t WS_XN = 80 * MiB;
constexpr size_t WS_PB = 112 * MiB;
constexpr size_t WS_QM = 120 * MiB, WS_KM = 136 * MiB, WS_VTM = 152 * MiB, WS_QS = 168 * MiB, WS_KS = 184 * MiB, WS_VTS = 200 * MiB;
constexpr size_t WS_ORAW = 216 * MiB;
constexpr size_t WS_A2 = 80 * MiB;
constexpr size_t WS_A3 = 120 * MiB;
constexpr size_t WS_SC = 152 * MiB;
constexpr size_t WS_EIDX = 80 * MiB, WS_GATE = 88 * MiB, WS_CJ = 96 * MiB, WS_RS2 = 104 * MiB, WS_SSQ = 105 * MiB;
constexpr size_t WS_PDOT = 120 * MiB;
constexpr size_t WS_A4 = 184 * MiB;
constexpr size_t WS_END = 248 * MiB;

constexpr int CW_XC = 8192;
constexpr int CW_BAR = 4096;

constexpr int LDS_BYTES = 147456;

#define XB_TMO      128
#define XB_XCNT(j)  (256  + 64 * (j))
#define XB_XSUB(j)  (1280 + 64 * (j))
#define XB_XGEN(j)  (2304 + 64 * (j))
#define XB_TOP      3328
#define XB_TOPGEN   3392
#define XCD_BAR_WORDS 3456
#define XB_SPIN_CAP (1u << 18)

__device__ __forceinline__ unsigned xb_ld(unsigned* p)              { return __hip_atomic_load(p, __ATOMIC_RELAXED, __HIP_MEMORY_SCOPE_AGENT); }
__device__ __forceinline__ unsigned xb_add(unsigned* p, unsigned v) { return __hip_atomic_fetch_add(p, v, __ATOMIC_RELAXED, __HIP_MEMORY_SCOPE_AGENT); }
__device__ __forceinline__ unsigned xb_xcc_id() { return (unsigned)__builtin_amdgcn_s_getreg((3 << 11) | 20) & 0xFu; }
#define XB_SPIN(cond, bar) do { unsigned _sp = 0; while (cond) { __builtin_amdgcn_s_sleep(1); \
    if ((++_sp & 255u) == 0u) { if (xb_ld(&(bar)[XB_TMO])) break; if (_sp > XB_SPIN_CAP) { atomicAdd(&(bar)[XB_TMO], 1u); break; } } } } while (0)

struct XcdBarrier { unsigned* bar; unsigned x; volatile LAS unsigned* st; };

__device__ __forceinline__ XcdBarrier xcd_barrier_post(unsigned* bar, volatile LAS unsigned* st) {
    XcdBarrier b; b.bar = bar; b.x = xb_xcc_id(); b.st = st;
    if (threadIdx.x == 0) (void)xb_add(&bar[XB_XCNT(b.x)], 1u);
    return b;
}
__device__ __forceinline__ void xcd_barrier_complete(unsigned* bar, unsigned x, unsigned& nloc, unsigned& nx) {
    const unsigned G = gridDim.x * gridDim.y * gridDim.z;
    unsigned sum, cnt, mine, sp = 0u;
    for (;;) {
        sum = 0u; cnt = 0u; mine = 0u;
#pragma unroll
        for (unsigned j = 0; j < 16; ++j) { const unsigned c = xb_ld(&bar[XB_XCNT(j)]); sum += c; cnt += (c > 0u) ? 1u : 0u; mine = (j == x) ? c : mine; }
        if (sum == G) break;
        __builtin_amdgcn_s_sleep(1);
        if ((++sp & 255u) == 0u) { if (xb_ld(&bar[XB_TMO])) break; if (sp > XB_SPIN_CAP) { atomicAdd(&bar[XB_TMO], 1u); break; } }
    }
    nloc = mine > 0u ? mine : 1u; nx = cnt > 0u ? cnt : 1u;
}
__device__ __forceinline__ void xcd_barrier(const XcdBarrier& b) {
    asm volatile("s_waitcnt vmcnt(0)" ::: "memory");
    __syncthreads();
    if (threadIdx.x == 0) {
        unsigned* bar = b.bar;
        __builtin_amdgcn_s_waitcnt(0);
        unsigned nloc = b.st[0], nx = b.st[1];
        if (nloc == 0u) { xcd_barrier_complete(bar, b.x, nloc, nx); b.st[0] = nloc; b.st[1] = nx; }
        const unsigned old = xb_add(&bar[XB_XSUB(b.x)], 1u);
        const unsigned gen = old / nloc;
        if (old + 1u == (gen + 1u) * nloc) {
            __builtin_amdgcn_fence(__ATOMIC_RELEASE, "agent");
            asm volatile("s_waitcnt vmcnt(0)" ::: "memory");
            const unsigned og = xb_add(&bar[XB_TOP], 1u);
            const unsigned tg = og / nx;
            if (og + 1u == (tg + 1u) * nx) xb_add(&bar[XB_TOPGEN], 1u);
            else XB_SPIN(xb_ld(&bar[XB_TOPGEN]) == tg, bar);
            __builtin_amdgcn_fence(__ATOMIC_ACQUIRE, "agent");
            xb_add(&bar[XB_XGEN(b.x)], 1u);
            asm volatile("s_waitcnt vmcnt(0)" ::: "memory");
        } else {
            XB_SPIN(xb_ld(&bar[XB_XGEN(b.x)]) == gen, bar);
            __builtin_amdgcn_fence(__ATOMIC_ACQUIRE, "agent");
            asm volatile("s_waitcnt vmcnt(0)" ::: "memory");
        }
    }
    __syncthreads();
}

DI float bf2f(short v) { return __builtin_bit_cast(float, ((unsigned)(unsigned short)v) << 16); }
DI unsigned cvtpk(float lo, float hi) { f32x2 v = {lo, hi}; bf16x2_t b = __builtin_convertvector(v, bf16x2_t); return __builtin_bit_cast(unsigned, b); }
DI bf16_t f2bf(float f) { return (bf16_t)(cvtpk(f, 0.f) & 0xffffu); }
template <int CTRL> DI float dppf(float v) { return __builtin_bit_cast(float, __builtin_amdgcn_update_dpp(0, __builtin_bit_cast(int, v), CTRL, 0xF, 0xF, true)); }
#define DPP_XOR1 0xB1
#define DPP_XOR2 0x4E
#define DPP_HMIR 0x141
#define DPP_MIR  0x140
DI void swap16(float v, float& a, float& b) { const auto r = __builtin_amdgcn_permlane16_swap(__builtin_bit_cast(unsigned, v), __builtin_bit_cast(unsigned, v), false, false); const unsigned r0 = r[0], r1 = r[1]; a = __builtin_bit_cast(float, r0); b = __builtin_bit_cast(float, r1); }
DI void swap32(float v, float& a, float& b) { const auto r = __builtin_amdgcn_permlane32_swap(__builtin_bit_cast(unsigned, v), __builtin_bit_cast(unsigned, v), false, false); const unsigned r0 = r[0], r1 = r[1]; a = __builtin_bit_cast(float, r0); b = __builtin_bit_cast(float, r1); }
DI float sum_x16(float v) { float a, b; swap16(v, a, b); return a + b; }
DI float sum_x32(float v) { float a, b; swap32(v, a, b); return a + b; }
DI float max_x32(float v) { float a, b; swap32(v, a, b); return fmaxf(a, b); }
DI float sum_row16(float v) { v += dppf<DPP_XOR1>(v); v += dppf<DPP_XOR2>(v); v += dppf<DPP_HMIR>(v); v += dppf<DPP_MIR>(v); return v; }
DI float max_row16(float v) { v = fmaxf(v, dppf<DPP_XOR1>(v)); v = fmaxf(v, dppf<DPP_XOR2>(v)); v = fmaxf(v, dppf<DPP_HMIR>(v)); v = fmaxf(v, dppf<DPP_MIR>(v)); return v; }
DI float sum_oct(float v) { v += dppf<DPP_XOR1>(v); v += dppf<DPP_XOR2>(v); v += dppf<DPP_HMIR>(v); return v; }
DI float max_oct(float v) { v = fmaxf(v, dppf<DPP_XOR1>(v)); v = fmaxf(v, dppf<DPP_XOR2>(v)); v = fmaxf(v, dppf<DPP_HMIR>(v)); return v; }
DI float wave_sum(float v) { return sum_x32(sum_x16(sum_row16(v))); }
DI float wave_max(float v) { v = max_row16(v); float a, b; swap16(v, a, b); return max_x32(fmaxf(a, b)); }
DI float tr_x32(float lo, float hi) { const auto r = __builtin_amdgcn_permlane32_swap(__builtin_bit_cast(unsigned, lo), __builtin_bit_cast(unsigned, hi), false, false); const unsigned r0 = r[0], r1 = r[1]; return __builtin_bit_cast(float, r0) + __builtin_bit_cast(float, r1); }
DI float tr_x16(float lo, float hi) { const auto r = __builtin_amdgcn_permlane16_swap(__builtin_bit_cast(unsigned, lo), __builtin_bit_cast(unsigned, hi), false, false); const unsigned r0 = r[0], r1 = r[1]; return __builtin_bit_cast(float, r0) + __builtin_bit_cast(float, r1); }
DI float tr_x8(float lo, float hi, bool bit) { const float mine = bit ? hi : lo, send = bit ? lo : hi; return mine + dppf<0x128>(send); }
DI float tr_x4(float lo, float hi, bool bit) {
    const int a = __builtin_amdgcn_update_dpp(0, __builtin_bit_cast(int, hi), 0x114, 0xF, 0xA, false);
    const int b = __builtin_amdgcn_update_dpp(a, __builtin_bit_cast(int, lo), 0x104, 0xF, 0x5, false);
    return (bit ? hi : lo) + __builtin_bit_cast(float, b);
}
DI float tr_x2(float lo, float hi, bool bit) { const float mine = bit ? hi : lo, send = bit ? lo : hi; return mine + dppf<DPP_XOR2>(send); }
DI float tr_x1(float lo, float hi, bool bit) { const float mine = bit ? hi : lo, send = bit ? lo : hi; return mine + dppf<DPP_XOR1>(send); }
DI int crow(int r, int hi) { return (r & 3) + 8 * (r >> 2) + 4 * hi; }
#define MFMA32(a, b, c) __builtin_amdgcn_mfma_f32_32x32x16_bf16((a), (b), (c), 0, 0, 0)
DI f32x16 zero16() { f32x16 z; for (int i = 0; i < 16; ++i) z[i] = 0.f; return z; }

struct Params {
    const float* in[18];
    float* out;
    unsigned char* ws;
    int ph_lo, ph_hi;
};

enum { IN_X = 0, IN_P, IN_RELB, IN_ATTN_NORM, IN_WIN, IN_QNORM, IN_KNORM, IN_ONM, IN_ONS, IN_WOUT, IN_FFN_NORM, IN_PQ, IN_SUBK, IN_PU, IN_PV, IN_PLE_NORM, IN_WPG, IN_WPLE };

template <bool HEADPERM> DI void p0_transpose(const float* W, int K, int N, bf16_t* Wt, LAS float* scr, int tid, int wg, int nwg, const float* kgain = nullptr) {
    const int tn = N / 64, ntile = (K / 64) * tn;
    for (int tile = wg; tile < ntile; tile += nwg) {
        const int k0 = (tile / tn) * 64, n0 = (tile % tn) * 64;
#pragma unroll
        for (int i = 0; i < 8; ++i) { const int kk = (tid >> 6) + 8 * i, nn = tid & 63; scr[kk * 65 + nn] = W[(size_t)(k0 + kk) * N + n0 + nn]; }
        __syncthreads();
#pragma unroll
        for (int i = 0; i < 8; ++i) { const int nn = (tid >> 6) + 8 * i, kk = tid & 63; int n = n0 + nn; if (HEADPERM) { const int w = n & 255; n = (n & ~255) + 128 * ((w >> 5) & 1) + 32 * (w >> 6) + (w & 31); }
            Wt[(size_t)n * K + k0 + kk] = f2bf(scr[kk * 65 + nn] * (kgain ? kgain[k0 + kk] : 1.f)); }
        __syncthreads();
    }
}

DI void p0_fold(const float* wq, const float* sub, const float* gffn, bf16_t* WqT, LAS float* lds, int tid, int wg, int nwg) {
    LAS float* wqs = lds;
    LAS float* subs = lds + 128 * 65;
    for (int item = wg; item < 256; item += nwg) {
        const int dt = item & 15, hh = item >> 4, d0 = dt * 64, h = hh >> 1, half = hh & 1;
#pragma unroll
        for (int i = 0; i < 16; ++i) { const int k = tid & 127, dd = (tid >> 7) + 4 * i; wqs[k * 65 + dd] = wq[(size_t)(d0 + dd) * 2048 + h * 256 + half * 128 + k]; }
#pragma unroll
        for (int i = 0; i < 32; ++i) { const int idx = i * 512 + tid; subs[idx] = sub[half * 16384 + idx]; }
        __syncthreads();
        const int d = tid & 63, ng = tid >> 6;
        float acc[16];
#pragma unroll
        for (int i = 0; i < 16; ++i) acc[i] = 0.f;
        for (int k = 0; k < 128; k += 4) {
            const float a0 = wqs[(k + 0) * 65 + d], a1 = wqs[(k + 1) * 65 + d], a2 = wqs[(k + 2) * 65 + d], a3 = wqs[(k + 3) * 65 + d];
#pragma unroll
            for (int i = 0; i < 16; ++i) { const f32x4 s = *(const LAS f32x4*)(subs + (16 * ng + i) * 128 + k); acc[i] += a0 * s.x + a1 * s.y + a2 * s.z + a3 * s.w; }
        }
        const float g = gffn[d0 + d];
#pragma unroll
        for (int i = 0; i < 16; ++i) WqT[(size_t)(hh * 128 + 16 * ng + i) * 1024 + d0 + d] = f2bf(acc[i] * g);
        __syncthreads();
    }
}

DI void p0_convert(const float* src, bf16_t* dst, size_t n, size_t gtid, size_t nthreads) {
    for (size_t i = gtid * 8; i < n; i += nthreads * 8) {
        const f32x4 a = *(const f32x4*)(src + i), b = *(const f32x4*)(src + i + 4);
        u32x4 o; o.x = cvtpk(a.x, a.y); o.y = cvtpk(a.z, a.w); o.z = cvtpk(b.x, b.y); o.w = cvtpk(b.z, b.w);
        *(u32x4*)(dst + i) = o;
    }
}


DI void p0_quant_finish(const f32x4 (&a)[4], unsigned char* dst, float* scale, int row, int lane) {
    float m = 0.f;
#pragma unroll
    for (int i = 0; i < 4; ++i) m = fmaxf(fmaxf(m, fmaxf(fabsf(a[i].x), fabsf(a[i].y))), fmaxf(fabsf(a[i].z), fabsf(a[i].w)));
    m = wave_max(m);
    const float sc = m > 0.f ? m * (1.f / 440.f) : 1.f, inv = m > 0.f ? 440.f / m : 0.f;
    u32x4 w;
#pragma unroll
    for (int i = 0; i < 4; ++i) {
        const float q0 = fminf(fmaxf(a[i].x * inv, -448.f), 448.f), q1 = fminf(fmaxf(a[i].y * inv, -448.f), 448.f);
        const float q2 = fminf(fmaxf(a[i].z * inv, -448.f), 448.f), q3 = fminf(fmaxf(a[i].w * inv, -448.f), 448.f);
        int p = 0;
        p = __builtin_amdgcn_cvt_pk_fp8_f32(q0, q1, p, false);
        p = __builtin_amdgcn_cvt_pk_fp8_f32(q2, q3, p, true);
        w[i] = (unsigned)p;
    }
    *(u32x4*)(dst + ((size_t)(lane >> 3) * 16384 + row) * 128 + 16 * (lane & 7)) = w;
    if (lane == 0) scale[row] = sc;
}
DI void p0_quant_rows4(const float* pu, const float* pv, unsigned char* u8, unsigned char* v8, float* usc_, float* vsc_, int r0, int r1, int lane) {
    f32x4 a[4][4];
    const int r1c = r1 < 16384 ? r1 : r0;
#pragma unroll
    for (int i = 0; i < 4; ++i) { a[0][i] = *(const f32x4*)(pu + (size_t)r0 * 1024 + 16 * lane + 4 * i); a[1][i] = *(const f32x4*)(pv + (size_t)r0 * 1024 + 16 * lane + 4 * i);
        a[2][i] = *(const f32x4*)(pu + (size_t)r1c * 1024 + 16 * lane + 4 * i); a[3][i] = *(const f32x4*)(pv + (size_t)r1c * 1024 + 16 * lane + 4 * i); }
    p0_quant_finish(a[0], u8, usc_, r0, lane); p0_quant_finish(a[1], v8, vsc_, r0, lane);
    if (r1 < 16384) { p0_quant_finish(a[2], u8, usc_, r1, lane); p0_quant_finish(a[3], v8, vsc_, r1, lane); }
}

DI void rmsnorm_rows2_bf16(const float* x, const float* g, bf16_t* o, int r0, int r1, int lane) {
    f32x4 v[2][4]; float s[2] = {0.f, 0.f};
    const int rr[2] = {r0, r1 < T ? r1 : r0};
#pragma unroll
    for (int q = 0; q < 2; ++q)
#pragma unroll
        for (int j = 0; j < 4; ++j) v[q][j] = ((const f32x4*)(x + (size_t)rr[q] * 1024))[lane + 64 * j];
#pragma unroll
    for (int q = 0; q < 2; ++q) {
#pragma unroll
        for (int j = 0; j < 4; ++j) s[q] += (v[q][j].x * v[q][j].x + v[q][j].y * v[q][j].y) + (v[q][j].z * v[q][j].z + v[q][j].w * v[q][j].w);
        s[q] = wave_sum(s[q]);
    }
#pragma unroll
    for (int q = 0; q < 2; ++q) {
        if (q == 1 && r1 >= T) break;
        const float rs = rsqrtf(s[q] * (1.f / 1024.f) + EPS);
#pragma unroll
        for (int j = 0; j < 4; ++j) { const f32x4 gv = ((const f32x4*)g)[lane + 64 * j];
            u32x2 w; w.x = cvtpk(v[q][j].x * rs * gv.x, v[q][j].y * rs * gv.y); w.y = cvtpk(v[q][j].z * rs * gv.z, v[q][j].w * rs * gv.w);
            ((u32x2*)(o + (size_t)rr[q] * 1024))[lane + 64 * j] = w; }
    }
}

namespace pg8 {
#define PG8_LAS __attribute__((address_space(3)))
typedef unsigned short bf16_t;
typedef short bf16x8 __attribute__((ext_vector_type(8)));
typedef float f32x4 __attribute__((ext_vector_type(4)));
typedef unsigned u32x4 __attribute__((ext_vector_type(4)));
constexpr int BM = 256, BK = 64, HALF = 128, HTB = HALF * BK * 2  , STAGE_BYTES = 8 * HTB, NXCD = 8, WGM = 8;

__host__ __device__ __forceinline__ int lds_byte(int r, int c) { const int st = (r >> 4) * 2 + (c >> 5), rr = r & 15, cc = c & 31, ob = rr * 64 + cc * 2; return st * 1024 + (ob ^ (((ob >> 9) & 1) << 5)); }
__host__ __device__ __forceinline__ void stage_rc(int b, int& R, int& C) { const int st = b / 1024, sb = b % 1024, swz = sb ^ (((sb >> 9) & 1) << 5); R = (st >> 1) * 16 + swz / 64; C = (st & 1) * 32 + (swz % 64) / 2; }
__host__ __device__ __forceinline__ int perm32(int rho) { const int n = rho >> 4, i = rho & 15; return 8 * (i >> 2) + 4 * n + (i & 3); }

struct Unit { int pm, pn; };
struct Gemm { const bf16_t* A; const bf16_t* Bt; int M, N, K; };

struct StaticOrder {
    int nM, nN, nwg, G, c;
    __host__ __device__ void init(int M, int N, int G_, int c_) { nM = M / BM; nN = N / BM; nwg = nM * nN; G = G_; c = c_; }
    __host__ __device__ bool next(int i, Unit& u) const {
        const long L = (long)i * G + c; if (L >= nwg) return false;
        int wgid = (int)L; { const int q = nwg / NXCD, r = nwg % NXCD, xcd = wgid % NXCD, off = wgid / NXCD; wgid = (xcd < r ? xcd * (q + 1) : r * (q + 1) + (xcd - r) * q) + off; }
        const int nig = WGM * nN, gid = wgid / nig, fm = gid * WGM, gsz = (nM - fm) < WGM ? (nM - fm) : WGM;
        u.pm = fm + ((wgid % nig) % gsz); u.pn = (wgid % nig) / gsz; return true;
    }
    __device__ __forceinline__ void a_ready(const Unit&) const {}
    __device__ __forceinline__ void done(const Unit&) const {}
};

template <class Epi, class Sched, bool ALIGN_EPI = false, bool SP2 = false>
__device__ __forceinline__ void gemm_phase(PG8_LAS unsigned char* lds, const Gemm g, const Sched& S, const Epi& E) {
    int tid_ = threadIdx.x; asm volatile("" : "+v"(tid_));
    const int tid = tid_, wid = __builtin_amdgcn_readfirstlane(tid >> 6), lane = tid & 63, wr = wid >> 2, wc = wid & 3, fr = lane & 15, fq = lane >> 4;
    const int K = g.K, nt = K / BK;
    unsigned voffA[2], voffB[2];
#pragma unroll
    for (int i = 0; i < 2; ++i) { int R, C; stage_rc(tid * 16 + i * 8192, R, C); const int Rb = Epi::PERM ? ((R & ~31) + perm32(R & 31)) : R;
        voffA[i] = (unsigned)(R * K + C) * 2u; voffB[i] = (unsigned)(Rb * K + C) * 2u; }
    const size_t kstep = (size_t)(BK * 2);
    const size_t hstep = (size_t)HALF * K * 2;
    const size_t tstep = 2 * hstep;
    const unsigned ldsw = (unsigned)wid * 1024u;
    const int aoff = lds_byte(wr * 64 + fr, fq * 8), boff = lds_byte(wc * 32 + fr, fq * 8);
#define PG8_SA(b, h) (((b) * 2 + (h)) * HTB)
#define PG8_SB(b, h) ((4 + (b) * 2 + (h)) * HTB)
#define PG8_STAGE(bufoff, gbase, voff) do { _Pragma("unroll") for (int _i = 0; _i < 2; ++_i) \
        __builtin_amdgcn_global_load_lds((const unsigned*)((const char*)(gbase) + (voff)[_i]), (PG8_LAS unsigned*)(lds + (bufoff) + ldsw + _i * 8192), 16, 0, 0); } while (0)
#define PG8_LDA(dst, b, h) do { _Pragma("unroll") for (int m = 0; m < 4; ++m) _Pragma("unroll") for (int k = 0; k < 2; ++k) dst[m][k] = *(const PG8_LAS bf16x8*)(lds + PG8_SA(b, h) + aoff + m * 2048 + k * 1024); } while (0)
#define PG8_LDB(dst, b, h) do { _Pragma("unroll") for (int n = 0; n < 2; ++n) _Pragma("unroll") for (int k = 0; k < 2; ++k) dst[n][k] = *(const PG8_LAS bf16x8*)(lds + PG8_SB(b, h) + boff + n * 2048 + k * 1024); } while (0)
#define PG8_MMA(ai, bj, At, Bt) do { __builtin_amdgcn_s_setprio(1); _Pragma("unroll") for (int m = 0; m < 4; ++m) _Pragma("unroll") for (int n = 0; n < 2; ++n) _Pragma("unroll") for (int k = 0; k < 2; ++k) \
        acc[ai][bj][m][n] = __builtin_amdgcn_mfma_f32_16x16x32_bf16(Bt[n][k], At[m][k], acc[ai][bj][m][n], 0, 0, 0); __builtin_amdgcn_s_setprio(0); } while (0)
#define PG8_WAIT_V(n) asm volatile("s_waitcnt vmcnt(" #n ")" ::: "memory")
#define PG8_WAIT_L(n) asm volatile("s_waitcnt lgkmcnt(" #n ")" ::: "memory")
#define PG8_BAR __builtin_amdgcn_s_barrier()
#define PG8_SCHED __builtin_amdgcn_sched_barrier(0)
    Unit cur, nxt; int ui = 0;
    if (!S.next(0, cur)) return;
    f32x4 acc[2][2][4][2];
#pragma unroll
    for (int a = 0; a < 2; ++a)
#pragma unroll
        for (int b = 0; b < 2; ++b)
#pragma unroll
            for (int m = 0; m < 4; ++m)
#pragma unroll
                for (int n = 0; n < 2; ++n) acc[a][b][m][n] = (f32x4){0.f, 0.f, 0.f, 0.f};
    bf16x8 At[4][2], B0[2][2], B1[2][2];
    const char* cA = (const char*)g.A + (size_t)cur.pm * tstep; const char* cB = (const char*)g.Bt + (size_t)cur.pn * tstep;
    S.a_ready(cur);
    if constexpr (SP2) {
        PG8_STAGE(PG8_SB(0, 0), cB, voffB); PG8_STAGE(PG8_SB(0, 1), cB + hstep, voffB); PG8_STAGE(PG8_SA(0, 0), cA, voffA); PG8_STAGE(PG8_SA(0, 1), cA + hstep, voffA);
        if (wr == 1) PG8_BAR;
        PG8_WAIT_V(2); PG8_BAR;
        PG8_STAGE(PG8_SB(1, 0), cB + kstep, voffB); PG8_STAGE(PG8_SA(1, 0), cA + kstep, voffA); PG8_STAGE(PG8_SB(1, 1), cB + hstep + kstep, voffB);
        PG8_WAIT_V(6); PG8_BAR;
    } else {
        PG8_STAGE(PG8_SB(0, 0), cB, voffB); PG8_STAGE(PG8_SA(0, 0), cA, voffA); PG8_STAGE(PG8_SB(0, 1), cB + hstep, voffB); PG8_STAGE(PG8_SA(0, 1), cA + hstep, voffA);
        if (wr == 1) PG8_BAR;
        PG8_WAIT_V(4); PG8_BAR;
        PG8_STAGE(PG8_SB(1, 0), cB + kstep, voffB); PG8_STAGE(PG8_SA(1, 0), cA + kstep, voffA); PG8_STAGE(PG8_SB(1, 1), cB + hstep + kstep, voffB);
        PG8_WAIT_V(6); PG8_BAR;
    }
    for (;;) {
        const bool has_next = S.next(ui + 1, nxt);
        const char* nA = has_next ? (const char*)g.A + (size_t)nxt.pm * tstep : cA; const char* nB = has_next ? (const char*)g.Bt + (size_t)nxt.pn * tstep : cB;
        for (int t = 0; t < nt; t += 2) {
            const bool last = (t == nt - 2);
            const char* a1 = cA + (size_t)(t + 1) * kstep;
            const char* a2 = last ? nA : cA + (size_t)(t + 2) * kstep; const char* b2 = last ? nB : cB + (size_t)(t + 2) * kstep;
            const char* a3 = a2 + kstep; const char* b3 = b2 + kstep;
            if (last && has_next) S.a_ready(nxt);
            if constexpr (SP2) {
            PG8_LDB(B0, 0, 0); PG8_LDB(B1, 0, 1); PG8_SCHED; PG8_LDA(At, 0, 0); PG8_STAGE(PG8_SA(1, 1), a1 + hstep, voffA);
            PG8_WAIT_V(8); PG8_WAIT_L(0); PG8_BAR; PG8_MMA(0, 0, At, B0); PG8_MMA(0, 1, At, B1); PG8_BAR; PG8_SCHED;
            PG8_LDA(At, 0, 1); PG8_STAGE(PG8_SB(0, 0), b2, voffB); PG8_STAGE(PG8_SB(0, 1), b2 + hstep, voffB); PG8_STAGE(PG8_SA(0, 0), a2, voffA);
            PG8_WAIT_V(8); PG8_WAIT_L(0); PG8_BAR; PG8_MMA(1, 0, At, B0); PG8_MMA(1, 1, At, B1); PG8_BAR; PG8_SCHED;
            PG8_LDB(B0, 1, 0); PG8_LDB(B1, 1, 1); PG8_SCHED; PG8_LDA(At, 1, 0); PG8_STAGE(PG8_SA(0, 1), a2 + hstep, voffA);
            PG8_WAIT_V(8); PG8_WAIT_L(0); PG8_BAR; PG8_MMA(0, 0, At, B0); PG8_MMA(0, 1, At, B1); PG8_BAR; PG8_SCHED;
            PG8_LDA(At, 1, 1); PG8_STAGE(PG8_SB(1, 0), b3, voffB); PG8_STAGE(PG8_SB(1, 1), b3 + hstep, voffB); PG8_STAGE(PG8_SA(1, 0), a3, voffA);
            PG8_WAIT_V(8); PG8_WAIT_L(0); PG8_BAR; PG8_MMA(1, 0, At, B0); PG8_MMA(1, 1, At, B1); PG8_BAR; PG8_SCHED;
            } else {
            PG8_LDB(B0, 0, 0); PG8_SCHED; PG8_LDA(At, 0, 0); PG8_STAGE(PG8_SA(1, 1), a1 + hstep, voffA);
            PG8_WAIT_L(8); PG8_BAR; PG8_WAIT_L(0); PG8_MMA(0, 0, At, B0); PG8_BAR; PG8_SCHED;
            PG8_LDB(B1, 0, 1); PG8_STAGE(PG8_SB(0, 0), b2, voffB);
            PG8_BAR; PG8_WAIT_L(0); PG8_MMA(0, 1, At, B1); PG8_BAR;
            PG8_LDA(At, 0, 1); PG8_STAGE(PG8_SA(0, 0), a2, voffA);
            PG8_BAR; PG8_WAIT_L(0); PG8_MMA(1, 0, At, B0); PG8_BAR; PG8_SCHED;
            PG8_STAGE(PG8_SB(0, 1), b2 + hstep, voffB);
            PG8_WAIT_V(6); PG8_BAR; PG8_MMA(1, 1, At, B1); PG8_BAR;
            PG8_LDB(B0, 1, 0); PG8_SCHED; PG8_LDA(At, 1, 0); PG8_STAGE(PG8_SA(0, 1), a2 + hstep, voffA);
            PG8_WAIT_L(8); PG8_BAR; PG8_WAIT_L(0); PG8_MMA(0, 0, At, B0); PG8_BAR; PG8_SCHED;
            PG8_LDB(B1, 1, 1); PG8_STAGE(PG8_SB(1, 0), b3, voffB);
            PG8_BAR; PG8_WAIT_L(0); PG8_MMA(0, 1, At, B1); PG8_BAR;
            PG8_LDA(At, 1, 1); PG8_STAGE(PG8_SA(1, 0), a3, voffA);
            PG8_BAR; PG8_WAIT_L(0); PG8_MMA(1, 0, At, B0); PG8_BAR; PG8_SCHED;
            PG8_STAGE(PG8_SB(1, 1), b3 + hstep, voffB);
            PG8_WAIT_V(6); PG8_BAR; PG8_MMA(1, 1, At, B1); PG8_BAR;
            }
        }
        if constexpr (ALIGN_EPI) { if (wr == 0) PG8_BAR; }
        if constexpr (!Epi::AFTER_DRAIN) { E(acc, cur, wr, wc, fr, fq); S.done(cur); }
        if (!has_next) break;
#pragma unroll
        for (int a = 0; a < 2; ++a)
#pragma unroll
            for (int b = 0; b < 2; ++b)
#pragma unroll
                for (int m = 0; m < 4; ++m)
#pragma unroll
                    for (int n = 0; n < 2; ++n) acc[a][b][m][n] = (f32x4){0.f, 0.f, 0.f, 0.f};
        cur = nxt; cA = nA; cB = nB; ++ui;
        if constexpr (ALIGN_EPI) { if (wr == 1) PG8_BAR; }
    }
    PG8_WAIT_V(0);
    if constexpr (!ALIGN_EPI) { if (wr == 0) PG8_BAR; }
    PG8_BAR;
    if constexpr (Epi::AFTER_DRAIN) { E.fused(acc, cur, wr, wc, fr, fq, lds, wid, lane); S.done(cur); }
#undef PG8_SA
#undef PG8_SB
#undef PG8_STAGE
#undef PG8_LDA
#undef PG8_LDB
#undef PG8_MMA
#undef PG8_WAIT_V
#undef PG8_WAIT_L
#undef PG8_BAR
#undef PG8_SCHED
}
}


struct EpiQKV {
    static constexpr bool PERM = true, AFTER_DRAIN = false;
    bf16_t* base6; const float *qn, *kn;
    DI void operator()(const f32x4 (&acc)[2][2][4][2], const pg8::Unit& u, int wr, int wc, int fr, int fq) const {
        const int typ = u.pn >> 1, h = (u.pn & 1) * 4 + wc;
        bf16_t* reg = base6 + (size_t)typ * (16u << 19);
        const int row0 = u.pm * 256 + wr * 64 + fr;
        if (typ == 2 || typ == 5) {
#pragma unroll
            for (int ai = 0; ai < 2; ++ai)
#pragma unroll
                for (int m = 0; m < 4; ++m) {
                    const int tok = row0 + ai * 128 + m * 16, b = tok >> 11, sq = tok & 2047, tile = sq >> 5, kap = sq & 31;
                    const int s2 = kap >> 4, hh = (kap >> 2) & 1, jj = ((kap >> 3) & 1) * 4 + (kap & 3);
                    bf16_t* bp = reg + ((((size_t)(b * 8 + h) * 64 + tile) * 4 + s2 * 2) * 64 + hh * 32 + 8 * fq) * 8 + jj;
#pragma unroll
                    for (int bj = 0; bj < 2; ++bj)
#pragma unroll
                        for (int n = 0; n < 2; ++n)
#pragma unroll
                            for (int i = 0; i < 4; ++i) bp[(size_t)bj * 512 + (4 * n + i) * 8] = f2bf(acc[ai][bj][m][n][i]);
                }
        } else {
            const bool nrm = typ < 2;
            const float* g = (typ == 0) ? qn : kn;
            f32x4 gv[2][2];
#pragma unroll
            for (int bj = 0; bj < 2; ++bj)
#pragma unroll
                for (int n = 0; n < 2; ++n) gv[bj][n] = nrm ? *(const f32x4*)(g + 32 * bj + 8 * fq + 4 * n) : (f32x4){1.f, 1.f, 1.f, 1.f};
#pragma unroll
            for (int ai = 0; ai < 2; ++ai)
#pragma unroll
                for (int m = 0; m < 4; ++m) {
                    const int tok = row0 + ai * 128 + m * 16, b = tok >> 11, sq = tok & 2047, tile = sq >> 5, kap = sq & 31;
                    float rs = 1.f;
                    if (nrm) {
                        float ss = 0.f;
#pragma unroll
                        for (int bj = 0; bj < 2; ++bj)
#pragma unroll
                            for (int n = 0; n < 2; ++n) { const f32x4 v = acc[ai][bj][m][n]; ss += (v.x * v.x + v.y * v.y) + (v.z * v.z + v.w * v.w); }
                        ss = sum_x32(sum_x16(ss));
                        rs = rsqrtf(ss * (1.f / 64.f) + EPS);
                    }
                    bf16_t* dst = reg + ((((size_t)(b * 8 + h) * 64 + tile) * 4 + (fq >> 1)) * 64 + (fq & 1) * 32 + kap) * 8;
#pragma unroll
                    for (int bj = 0; bj < 2; ++bj) {
                        const f32x4 v0 = acc[ai][bj][m][0] * rs * gv[bj][0], v1 = acc[ai][bj][m][1] * rs * gv[bj][1];
                        u32x4 w; w.x = cvtpk(v0.x, v0.y); w.y = cvtpk(v0.z, v0.w); w.z = cvtpk(v1.x, v1.y); w.w = cvtpk(v1.z, v1.w);
                        *(u32x4*)(dst + (size_t)bj * 2 * 512) = w;
                    }
                }
        }
    }
};

struct EpiRes {
    static constexpr bool PERM = true, AFTER_DRAIN = false;
    const float* x; float* out; bf16_t* xn;
    DI void operator()(const f32x4 (&acc)[2][2][4][2], const pg8::Unit& u, int wr, int wc, int fr, int fq) const {
        const int row0 = u.pm * 256 + wr * 64 + fr, col0 = u.pn * 256 + wc * 32 + 8 * fq;
#pragma unroll
        for (int ai = 0; ai < 2; ++ai)
#pragma unroll
            for (int m = 0; m < 4; ++m)
#pragma unroll
                for (int bj = 0; bj < 2; ++bj) {
                    const size_t off = (size_t)(row0 + ai * 128 + m * 16) * 1024 + col0 + bj * 128;
                    const f32x4 h0 = *(const f32x4*)(x + off) + acc[ai][bj][m][0], h1 = *(const f32x4*)(x + off + 4) + acc[ai][bj][m][1];
                    *(f32x4*)(out + off) = h0; *(f32x4*)(out + off + 4) = h1;
                    u32x4 w; w.x = cvtpk(h0.x, h0.y); w.y = cvtpk(h0.z, h0.w); w.z = cvtpk(h1.x, h1.y); w.w = cvtpk(h1.z, h1.w);
                    *(u32x4*)(xn + off) = w;
                }
    }
};

struct EpiF32 {
    static constexpr bool PERM = true, AFTER_DRAIN = false;
    float* C; int ldc;
    DI void operator()(const f32x4 (&acc)[2][2][4][2], const pg8::Unit& u, int wr, int wc, int fr, int fq) const {
        const int row0 = u.pm * 256 + wr * 64 + fr, col0 = u.pn * 256 + wc * 32 + 8 * fq;
#pragma unroll
        for (int ai = 0; ai < 2; ++ai)
#pragma unroll
            for (int m = 0; m < 4; ++m)
#pragma unroll
                for (int bj = 0; bj < 2; ++bj) {
                    float* p = C + (size_t)(row0 + ai * 128 + m * 16) * ldc + col0 + bj * 128;
                    *(f32x4*)p = acc[ai][bj][m][0]; *(f32x4*)(p + 4) = acc[ai][bj][m][1];
                }
    }
};

struct EpiBf {
    static constexpr bool PERM = true, AFTER_DRAIN = false;
    bf16_t* C; int ldc;
    DI void operator()(const f32x4 (&acc)[2][2][4][2], const pg8::Unit& u, int wr, int wc, int fr, int fq) const {
        const int row0 = u.pm * 256 + wr * 64 + fr, col0 = u.pn * 256 + wc * 32 + 8 * fq;
#pragma unroll
        for (int ai = 0; ai < 2; ++ai)
#pragma unroll
            for (int m = 0; m < 4; ++m)
#pragma unroll
                for (int bj = 0; bj < 2; ++bj) {
                    const f32x4 v0 = acc[ai][bj][m][0], v1 = acc[ai][bj][m][1];
                    u32x4 w; w.x = cvtpk(v0.x, v0.y); w.y = cvtpk(v0.z, v0.w); w.z = cvtpk(v1.x, v1.y); w.w = cvtpk(v1.z, v1.w);
                    *(u32x4*)(C + (size_t)(row0 + ai * 128 + m * 16) * ldc + col0 + bj * 128) = w;
                }
    }
};

struct EpiGate {
    static constexpr bool PERM = true, AFTER_DRAIN = false;
    float* out; const bf16_t* pw; const float* ssq;
    DI void operator()(const f32x4 (&acc)[2][2][4][2], const pg8::Unit& u, int wr, int wc, int fr, int fq) const {
        const int row0 = u.pm * 256 + wr * 64 + fr, col0 = u.pn * 256 + wc * 32 + 8 * fq;
#pragma unroll
        for (int ai = 0; ai < 2; ++ai)
#pragma unroll
            for (int m = 0; m < 4; ++m) {
                const int row = row0 + ai * 128 + m * 16;
                float sq = 0.f;
#pragma unroll
                for (int x = 0; x < 8; ++x) sq += ssq[(size_t)x * T + row];
                const float rs3 = rsqrtf(sq * (1.f / 1024.f) + EPS);
#pragma unroll
                for (int bj = 0; bj < 2; ++bj) {
                    const size_t off = (size_t)row * 1024 + col0 + bj * 128;
                    const bf16x8 pv = *(const bf16x8*)(pw + off);
                    const f32x4 h0 = *(const f32x4*)(out + off), h1 = *(const f32x4*)(out + off + 4);
                    const f32x4 g0 = acc[ai][bj][m][0] * rs3, g1 = acc[ai][bj][m][1] * rs3;
                    f32x4 o0, o1;
#pragma unroll
                    for (int i = 0; i < 4; ++i) { o0[i] = h0[i] + bf2f(pv[i]) / (1.f + __expf(-g0[i])); o1[i] = h1[i] + bf2f(pv[4 + i]) / (1.f + __expf(-g1[i])); }
                    *(f32x4*)(out + off) = o0; *(f32x4*)(out + off + 4) = o1;
                }
            }
    }
};

template <class Epi>
DI void gemm_simple(const bf16_t* A, const bf16_t* Bt, int M, int N, int K, const Epi& epi, int gwave, int nwaves, int lane) {
    const int r32 = lane & 31, hi = lane >> 5;
    const int nNt = N / 64, total = (M / 32) * nNt;
    for (int tile = gwave; tile < total; tile += nwaves) {
        const int mt = tile / nNt, nt = tile - mt * nNt, m0 = mt * 32, n0 = nt * 64;
        const bf16_t* ap = A + (size_t)(m0 + r32) * K + 8 * hi;
        const bf16_t* b0p = Bt + (size_t)(n0 + r32) * K + 8 * hi;
        const bf16_t* b1p = b0p + (size_t)32 * K;
        f32x16 acc0 = zero16(), acc1 = zero16();
#pragma unroll 4
        for (int k = 0; k < K; k += 16) {
            const bf16x8 xa = *(const bf16x8*)(ap + k);
            const bf16x8 w0 = *(const bf16x8*)(b0p + k);
            const bf16x8 w1 = *(const bf16x8*)(b1p + k);
            acc0 = MFMA32(w0, xa, acc0);
            acc1 = MFMA32(w1, xa, acc1);
        }
        epi(m0 + r32, n0, hi, acc0, acc1);
    }
}

struct Epi1 {
    bf16_t* base6;
    const float *qn, *kn;
    DI void operator()(int tok, int n0, int hi, const f32x16& a0, const f32x16& a1) const {
        const int head48 = n0 >> 6, typ = head48 >> 3, h = head48 & 7;
        bf16_t* reg = base6 + (size_t)typ * (16u << 19);
        if (typ == 2 || typ == 5) {
            const int b = tok >> 11, s = tok & 2047;
            const int pos = (s & ~12) | ((s & 4) << 1) | ((s & 8) >> 1);
            bf16_t* base = reg + ((size_t)(b * 8 + h) * 64) * 2048 + pos;
#pragma unroll
            for (int r = 0; r < 16; ++r) { base[(size_t)crow(r, hi) * 2048] = f2bf(a0[r]); base[(size_t)(32 + crow(r, hi)) * 2048] = f2bf(a1[r]); }
        } else {
            float rs = 1.f;
            const bool nrm = (typ == 0 || typ == 1);
            if (nrm) { float ss = 0.f;
#pragma unroll
                for (int r = 0; r < 16; ++r) ss += a0[r] * a0[r] + a1[r] * a1[r];
                ss = sum_x32(ss);
                rs = rsqrtf(ss * (1.f / 64.f) + EPS); }
            const float* g = (typ == 0) ? qn : kn;
            bf16_t* dst = reg + (size_t)tok * 512 + h * 64;
#pragma unroll
            for (int t = 0; t < 2; ++t)
#pragma unroll
                for (int g4 = 0; g4 < 4; ++g4) {
                    const int f0 = 32 * t + 8 * g4 + 4 * hi;
                    float v[4];
#pragma unroll
                    for (int i = 0; i < 4; ++i) { const float a = t ? a1[4 * g4 + i] : a0[4 * g4 + i]; v[i] = nrm ? a * rs * g[f0 + i] : a; }
                    u32x2 w; w.x = cvtpk(v[0], v[1]); w.y = cvtpk(v[2], v[3]);
                    *(u32x2*)(dst + f0) = w;
                }
        }
    }
};

struct Epi2 {
    const float* x; float* out; bf16_t* xn;
    DI void operator()(int tok, int n0, int hi, const f32x16& a0, const f32x16& a1) const {
#pragma unroll
        for (int t = 0; t < 2; ++t)
#pragma unroll
            for (int g4 = 0; g4 < 4; ++g4) {
                const size_t off = (size_t)tok * 1024 + n0 + 32 * t + 8 * g4 + 4 * hi;
                const f32x4 xv = *(const f32x4*)(x + off);
                f32x4 hv;
#pragma unroll
                for (int i = 0; i < 4; ++i) hv[i] = xv[i] + (t ? a1[4 * g4 + i] : a0[4 * g4 + i]);
                *(f32x4*)(out + off) = hv;
                u32x2 w; w.x = cvtpk(hv[0], hv[1]); w.y = cvtpk(hv[2], hv[3]);
                *(u32x2*)(xn + off) = w;
            }
    }
};

struct Epi3 {
    float* sc;
    DI void operator()(int tok, int n0, int hi, const f32x16& a0, const f32x16& a1) const {
#pragma unroll
        for (int t = 0; t < 2; ++t)
#pragma unroll
            for (int g4 = 0; g4 < 4; ++g4) {
                f32x4 v;
#pragma unroll
                for (int i = 0; i < 4; ++i) v[i] = t ? a1[4 * g4 + i] : a0[4 * g4 + i];
                *(f32x4*)(sc + (size_t)tok * 2048 + n0 + 32 * t + 8 * g4 + 4 * hi) = v;
            }
    }
};

DI void pv_accum(f32x16& o0, f32x16& o1, const f32x16& p, const bf16_t* vt_row) {
#pragma unroll
    for (int s = 0; s < 2; ++s) {
        u32x4 pk; pk.x = cvtpk(p[8 * s], p[8 * s + 1]); pk.y = cvtpk(p[8 * s + 2], p[8 * s + 3]); pk.z = cvtpk(p[8 * s + 4], p[8 * s + 5]); pk.w = cvtpk(p[8 * s + 6], p[8 * s + 7]);
        const bf16x8 pb = __builtin_bit_cast(bf16x8, pk);
        const bf16x8 v0 = *(const bf16x8*)(vt_row + 16 * s);
        const bf16x8 v1 = *(const bf16x8*)(vt_row + (size_t)32 * 2048 + 16 * s);
        o0 = MFMA32(v0, pb, o0);
        o1 = MFMA32(v1, pb, o1);
    }
}

DI void store_o(bf16_t* op, const f32x16& o0, const f32x16& o1, float inv, int hi) {
#pragma unroll
    for (int t = 0; t < 2; ++t)
#pragma unroll
        for (int g4 = 0; g4 < 4; ++g4) {
            u32x2 w;
            if (t == 0) { w.x = cvtpk(o0[4 * g4] * inv, o0[4 * g4 + 1] * inv); w.y = cvtpk(o0[4 * g4 + 2] * inv, o0[4 * g4 + 3] * inv); }
            else        { w.x = cvtpk(o1[4 * g4] * inv, o1[4 * g4 + 1] * inv); w.y = cvtpk(o1[4 * g4 + 2] * inv, o1[4 * g4 + 3] * inv); }
            *(u32x2*)(op + 32 * t + 8 * g4 + 4 * hi) = w;
        }
}

constexpr int OT_PITCH = 1040;
DI void store_o_lds(LAS unsigned char* ot, int r32, int h, const f32x16& o0, const f32x16& o1, float inv, int hi) {
    LAS unsigned char* op = ot + r32 * OT_PITCH + h * 128;
#pragma unroll
    for (int t = 0; t < 2; ++t)
#pragma unroll
        for (int g4 = 0; g4 < 4; ++g4) {
            u32x2 w;
            if (t == 0) { w.x = cvtpk(o0[4 * g4] * inv, o0[4 * g4 + 1] * inv); w.y = cvtpk(o0[4 * g4 + 2] * inv, o0[4 * g4 + 3] * inv); }
            else        { w.x = cvtpk(o1[4 * g4] * inv, o1[4 * g4 + 1] * inv); w.y = cvtpk(o1[4 * g4 + 2] * inv, o1[4 * g4 + 3] * inv); }
            *(LAS u32x2*)(op + (32 * t + 8 * g4 + 4 * hi) * 2) = w;
        }
}
DI void load_kfrag(bf16x8 (&kf)[4], const bf16_t* fbase  , int tile) {
    const bf16_t* kp = fbase + (size_t)tile * 2048;
#pragma unroll
    for (int s = 0; s < 4; ++s) kf[s] = *(const bf16x8*)(kp + s * 512);
}
DI void load_vfrag(bf16x8 (&vf)[4], const bf16_t* fbase, int tile) {
    const bf16_t* vp = fbase + (size_t)tile * 2048;
#pragma unroll
    for (int q = 0; q < 4; ++q) vf[q] = *(const bf16x8*)(vp + q * 512);
}
DI void pv_accum2(f32x16& o0, f32x16& o1, const f32x16& p, const bf16x8 (&vf)[4]) {
#pragma unroll
    for (int s = 0; s < 2; ++s) {
        u32x4 pk; pk.x = cvtpk(p[8 * s], p[8 * s + 1]); pk.y = cvtpk(p[8 * s + 2], p[8 * s + 3]); pk.z = cvtpk(p[8 * s + 4], p[8 * s + 5]); pk.w = cvtpk(p[8 * s + 6], p[8 * s + 7]);
        const bf16x8 pb = __builtin_bit_cast(bf16x8, pk);
        o0 = MFMA32(vf[2 * s], pb, o0);
        o1 = MFMA32(vf[2 * s + 1], pb, o1);
    }
}

#define MEM_FENCE() asm volatile("" ::: "memory")
#define PIN1(a) asm volatile("" : "+v"(a) :: "memory")
#define PIN2(a, b) asm volatile("" : "+v"(a), "+v"(b) :: "memory")
DI void vm_drain() { __builtin_amdgcn_s_waitcnt(0x0F70); }
struct KvStream { const bf16_t* kbase; const bf16_t* vbase; };

struct MobaCtx { int q0, tq, blk, hi; unsigned selmask; float bfar; const LAS float* bt; };
DI void moba_tile(bf16x8 (&kf)[4], bf16x8 (&vf)[4], const bf16x8 (&qf)[4], int kt, int next, const KvStream& kv, const MobaCtx& c, float& mrun, float& lsum, f32x16& o0, f32x16& o1) {
    const int n = kt >> 3, key0 = kt * 32;
    f32x16 st = zero16();
#pragma unroll
    for (int s = 0; s < 4; ++s) st = MFMA32(kf[s], qf[s], st);
    PIN1(st); load_kfrag(kf, kv.kbase, next); PIN1(st);
    float x[16];
    if (n != c.blk) {
        const bool selq = (c.selmask >> n) & 1u;
        if ((c.q0 - (key0 + 31)) >= 128) {
            const float addend = selq ? c.bfar : -1e30f;
#pragma unroll
            for (int r = 0; r < 16; ++r) x[r] = st[r] * SCL2 + addend;
        } else {
#pragma unroll
            for (int r = 0; r < 16; ++r) { const int dist = c.tq - (key0 + crow(r, c.hi)); const float v = st[r] * SCL2 + c.bt[dist > 128 ? 128 : dist]; x[r] = selq ? v : -1e30f; }
        }
    } else {
#pragma unroll
        for (int r = 0; r < 16; ++r) { const int dist = c.tq - (key0 + crow(r, c.hi)); const float v = st[r] * SCL2 + c.bt[dist < 0 ? 0 : (dist > 128 ? 128 : dist)]; x[r] = (dist >= 0) ? v : -1e30f; }
    }
    float mx = x[0];
#pragma unroll
    for (int r = 1; r < 16; ++r) mx = fmaxf(mx, x[r]);
    mx = max_x32(mx);
    const float mnew = fmaxf(mrun, mx);
    if (!__all(mnew == mrun)) {
        const float alpha = __builtin_amdgcn_exp2f(mrun - mnew);
        lsum *= alpha;
#pragma unroll
        for (int r = 0; r < 16; ++r) { o0[r] *= alpha; o1[r] *= alpha; }
        mrun = mnew;
    }
    f32x16 pr; float ps = 0.f;
#pragma unroll
    for (int r = 0; r < 16; ++r) { const float e = __builtin_amdgcn_exp2f(x[r] - mrun); pr[r] = e; ps += e; }
    lsum += ps;
    pv_accum2(o0, o1, pr, vf);
    PIN2(o0, o1); load_vfrag(vf, kv.vbase, next); MEM_FENCE();
}
DI int moba_next(int kt, int blk, unsigned anysel) {
    int nkt = kt - 1;
    while (nkt >= 0) { const int nn = nkt >> 3; if (nn == blk || ((anysel >> nn) & 1u)) break; nkt = nn * 8 - 1; }
    return nkt;
}

DI void moba_unit(int b, int h, int qt, const bf16_t* Qm_, const bf16_t* Km_, const bf16_t* VtM_, const float* kmean_, const LAS float* biasLds, LAS unsigned char* ot, int lane) {
    const int r32 = lane & 31, hi = lane >> 5;
    const int q0 = qt * 32, tq = q0 + r32, blk = q0 >> 8;
    const size_t bh = (size_t)(b * 8 + h);
    const bf16_t* qfb = Qm_ + bh * (64 * 2048) + (size_t)qt * 2048;
    KvStream kv; kv.kbase = Km_ + bh * (64 * 2048) + lane * 8; kv.vbase = VtM_ + bh * (64 * 2048) + lane * 8;
    bf16x8 kf[4], vf[4];
    load_kfrag(kf, kv.kbase, qt); load_vfrag(vf, kv.vbase, qt);
    bf16x8 qf[4];
#pragma unroll
    for (int s = 0; s < 4; ++s) qf[s] = *(const bf16x8*)(qfb + s * 512 + lane * 8);
    unsigned selmask = 0;
    if (blk > 0) {
        float qv[32];
#pragma unroll
        for (int c = 0; c < 4; ++c) { const bf16x8 t = *(const bf16x8*)(qfb + (2 * hi + (c >> 1)) * 512 + ((c & 1) * 32 + r32) * 8);
#pragma unroll
            for (int j = 0; j < 8; ++j) qv[8 * c + j] = bf2f(t[j]); }
        const float* km = kmean_ + (size_t)((b * 8 + h) * 8) * 64 + 32 * hi;
        float g[8];
#pragma unroll
        for (int n = 0; n < 8; ++n) {
            float a = 0.f;
            if (n < blk) {
#pragma unroll
                for (int d4 = 0; d4 < 8; ++d4) { const f32x4 kv4 = *(const f32x4*)(km + n * 64 + 4 * d4); a += (qv[4 * d4] * kv4.x + qv[4 * d4 + 1] * kv4.y) + (qv[4 * d4 + 2] * kv4.z + qv[4 * d4 + 3] * kv4.w); }
            }
            a = sum_x32(a);
            g[n] = (n < blk) ? a : -INFINITY;
        }
#pragma unroll
        for (int n = 0; n < 8; ++n) {
            int rank = 0;
#pragma unroll
            for (int m = 0; m < 8; ++m) if (m != n) rank += ((g[m] > g[n]) || (g[m] == g[n] && m < n)) ? 1 : 0;
            if (n < blk && rank < 3) selmask |= 1u << n;
        }
    }
    unsigned anysel = 0;
#pragma unroll
    for (int n = 0; n < 8; ++n) if (__any((selmask >> n) & 1u)) anysel |= 1u << n;
    anysel = __builtin_amdgcn_readfirstlane(anysel);
    float mrun = -1e30f, lsum = 0.f;
    f32x16 o0 = zero16(), o1 = zero16();
    MobaCtx c; c.q0 = q0; c.tq = tq; c.blk = blk; c.hi = hi; c.selmask = selmask; c.bt = biasLds + h * 132; c.bfar = c.bt[128];
    vm_drain();
    int kt = qt;
    for (;;) {
        const int nx = moba_next(kt, blk, anysel);
        moba_tile(kf, vf, qf, kt, nx < 0 ? 0 : nx, kv, c, mrun, lsum, o0, o1);
        if (nx < 0) break;
        kt = nx;
    }
    lsum = sum_x32(lsum);
    const float inv = 1.f / lsum;
    store_o_lds(ot, r32, h, o0, o1, inv, hi);
}

DI void sb_tile(bf16x8 (&kf)[4], bf16x8 (&vf)[4], const bf16x8 (&qf)[4], int kt, int next, const KvStream& kv, int tq, int hi, float& C, f32x16& o0, f32x16& o1) {
    const int key0 = kt * 32;
    f32x16 st = zero16();
#pragma unroll
    for (int s = 0; s < 4; ++s) st = MFMA32(kf[s], qf[s], st);
    PIN1(st); load_kfrag(kf, kv.kbase, next); PIN1(st);
    float rr[16], be[16];
#pragma unroll
    for (int r = 0; r < 16; ++r) {
        const int key = key0 + crow(r, hi);
        const float y = fminf(st[r] * SCL2, 100.f);
        const float e = __builtin_amdgcn_exp2f(y);
        const float ri = __builtin_amdgcn_rcpf(1.f + e);
        const bool ok = key < tq;
        rr[r] = ok ? ri : 1.f;
        be[r] = ok ? e * ri : 0.f;
    }
    float G[4], ex[16], Gp[4], Tt[4], Suf[4];
#pragma unroll
    for (int a = 0; a < 4; ++a) {
        ex[4 * a + 3] = 1.f; ex[4 * a + 2] = rr[4 * a + 3]; ex[4 * a + 1] = ex[4 * a + 2] * rr[4 * a + 2]; ex[4 * a] = ex[4 * a + 1] * rr[4 * a + 1];
        G[a] = ex[4 * a] * rr[4 * a];
    }
#pragma unroll
    for (int a = 0; a < 4; ++a) { float lo_, hi_; swap32(G[a], lo_, hi_); Gp[a] = hi_; Tt[a] = lo_ * hi_; }
    Suf[3] = 1.f; Suf[2] = Tt[3]; Suf[1] = Tt[3] * Tt[2]; Suf[0] = Suf[1] * Tt[1];
    f32x16 pr;
#pragma unroll
    for (int a = 0; a < 4; ++a) {
        const float after = Suf[a] * (hi == 0 ? Gp[a] : 1.f) * C;
#pragma unroll
        for (int i = 0; i < 4; ++i) pr[4 * a + i] = be[4 * a + i] * ex[4 * a + i] * after;
    }
    C = C * (Suf[0] * Tt[0]);
    pv_accum2(o0, o1, pr, vf);
    PIN2(o0, o1); load_vfrag(vf, kv.vbase, next); MEM_FENCE();
}

DI void sb_unit(int b, int h, int qt, const bf16_t* Qs_, const bf16_t* Ks_, const bf16_t* VtS_, LAS unsigned char* ot, int lane) {
    const int r32 = lane & 31, hi = lane >> 5;
    const int q0 = qt * 32, tq = q0 + r32;
    const size_t bh = (size_t)(b * 8 + h);
    const bf16_t* qfb = Qs_ + bh * (64 * 2048) + (size_t)qt * 2048;
    KvStream kv; kv.kbase = Ks_ + bh * (64 * 2048) + lane * 8; kv.vbase = VtS_ + bh * (64 * 2048) + lane * 8;
    bf16x8 kf[4], vf[4];
    load_kfrag(kf, kv.kbase, qt); load_vfrag(vf, kv.vbase, qt);
    bf16x8 qf[4];
#pragma unroll
    for (int s = 0; s < 4; ++s) qf[s] = *(const bf16x8*)(qfb + s * 512 + lane * 8);
    f32x16 o0 = zero16(), o1 = zero16();
    float C = 1.f;
    vm_drain();
    for (int kt = qt; kt >= 0; --kt) {
        sb_tile(kf, vf, qf, kt, kt > 0 ? kt - 1 : 0, kv, tq, hi, C, o0, o1);
        if (__all(C == 0.f ? 1 : 0)) break;
    }
    store_o_lds(ot, r32, h, o0, o1, 1.f, hi);
}

DI void ce_desc(unsigned& a, unsigned& b) { const unsigned hi = a > b ? a : b, lo = a > b ? b : a; a = hi; b = lo; }
DI void bitonic_clean_desc(unsigned (&v)[16]) {
#pragma unroll
    for (int s = 8; s >= 1; s >>= 1)
#pragma unroll
        for (int i = 0; i < 16; ++i) if ((i & s) == 0) ce_desc(v[i], v[i + s]);
}
DI void sort16_desc(unsigned (&v)[16]) {
#pragma unroll
    for (int k = 2; k <= 16; k <<= 1)
#pragma unroll
        for (int j = k >> 1; j >= 1; j >>= 1)
#pragma unroll
            for (int i = 0; i < 16; ++i) { const int l = i ^ j; if (l > i) { if ((i & k) == 0) ce_desc(v[i], v[l]); else ce_desc(v[l], v[i]); } }
}
DI float key_value(unsigned key) { const unsigned kk = key & ~127u; const unsigned u = (kk & 0x80000000u) ? (kk & 0x7fffffffu) : ~kk; return __builtin_bit_cast(float, u); }

DI float reduce16(const float (&p)[16], int lane) {
    const bool b3 = lane & 8, b2 = lane & 4, b1 = lane & 2, b0 = lane & 1;
    float q[8], r[4], s[2];
#pragma unroll
    for (int i = 0; i < 8; ++i) { const float mine = b3 ? p[i + 8] : p[i], send = b3 ? p[i] : p[i + 8]; q[i] = mine + __shfl_xor(send, 8); }
#pragma unroll
    for (int i = 0; i < 4; ++i) { const float mine = b2 ? q[i + 4] : q[i], send = b2 ? q[i] : q[i + 4]; r[i] = mine + __shfl_xor(send, 4); }
#pragma unroll
    for (int i = 0; i < 2; ++i) { const float mine = b1 ? r[i + 2] : r[i], send = b1 ? r[i] : r[i + 2]; s[i] = mine + __shfl_xor(send, 2); }
    const float mine = b0 ? s[1] : s[0], send = b0 ? s[0] : s[1];
    float t = mine + __shfl_xor(send, 1);
    t = sum_x32(sum_x16(t));
    return t;
}

#ifndef PEER_REP_TOPK
#define PEER_REP_TOPK 1
#endif
#ifndef PEER_REP_U
#define PEER_REP_U 1
#endif
#ifndef PEER_REP_V
#define PEER_REP_V 1
#endif
struct TopkIn { f32x4 hv[4]; bf16x8 sv[4]; };
DI void peer_topk_load(TopkIn& in, int tok, const float* out, const bf16_t* scores, int lane) {
    const int tc = tok < T ? tok : T - 1;
    const float* hrow = out + (size_t)tc * 1024 + 16 * lane;
    const bf16_t* sp = scores + (size_t)tc * 2048 + (lane >> 2) * 128 + (lane & 3) * 8;
#pragma unroll
    for (int i = 0; i < 4; ++i) { in.hv[i] = *(const f32x4*)(hrow + 4 * i); in.sv[i] = *(const bf16x8*)(sp + 32 * i); }
}
DI void peer_topk_token(int tok, const TopkIn& in, const float* gffn, int* EIDXg, float* GATEg, unsigned char* XN2g, LAS float* wl, int lane) {
    LAS unsigned* kbuf = (LAS unsigned*)wl; LAS unsigned* cand = (LAS unsigned*)(wl + 256); const LAS unsigned* ctab = (const LAS unsigned*)(wl + 768);
    f32x4 hv[4];
    float ss = 0.f;
#pragma unroll
    for (int i = 0; i < 4; ++i) { hv[i] = in.hv[i]; ss += (hv[i].x * hv[i].x + hv[i].y * hv[i].y) + (hv[i].z * hv[i].z + hv[i].w * hv[i].w); }
    ss = wave_sum(ss);
    const float rs2 = rsqrtf(ss * (1.f / 1024.f) + EPS);
    {
        u32x4 w;
#pragma unroll
        for (int i = 0; i < 4; ++i) { const f32x4 gv = *(const f32x4*)(gffn + 16 * lane + 4 * i);
            const float y0 = fminf(fmaxf(hv[i][0] * rs2 * gv[0] * 64.f, -448.f), 448.f), y1 = fminf(fmaxf(hv[i][1] * rs2 * gv[1] * 64.f, -448.f), 448.f);
            const float y2 = fminf(fmaxf(hv[i][2] * rs2 * gv[2] * 64.f, -448.f), 448.f), y3 = fminf(fmaxf(hv[i][3] * rs2 * gv[3] * 64.f, -448.f), 448.f);
            int p = 0;
            p = __builtin_amdgcn_cvt_pk_fp8_f32(y0, y1, p, false);
            p = __builtin_amdgcn_cvt_pk_fp8_f32(y2, y3, p, true);
            w[i] = (unsigned)p; }
        *(u32x4*)(XN2g + (size_t)tok * 1024 + 16 * lane) = w;
    }
    {
        const int L = lane >> 2, q = lane & 3;
        unsigned k0[16], k1[16];
#pragma unroll
        for (int i = 0; i < 4; ++i) {
            const bf16x8 v = in.sv[i];
#pragma unroll
            for (int cI = 0; cI < 8; ++cI) {
                const unsigned u = ((unsigned)(unsigned short)v[cI]) << 16;
                const unsigned mono = (u & 0x80000000u) ? ~u : (u | 0x80000000u);
                const unsigned key = (mono & ~127u) | (unsigned)(127 - (32 * i + 8 * q + cI));
                if (i < 2) k0[8 * i + cI] = key; else k1[8 * (i - 2) + cI] = key;
            }
        }
        sort16_desc(k0); sort16_desc(k1);
        unsigned t[16];
#pragma unroll
        for (int i = 0; i < 16; ++i) t[i] = k0[i] > k1[15 - i] ? k0[i] : k1[15 - i];
        bitonic_clean_desc(t);
#pragma unroll
        for (int i = 0; i < 16; ++i) k0[i] = (unsigned)__builtin_amdgcn_update_dpp(0, (int)t[15 - i], 0xB1, 0xF, 0xF, true);
#pragma unroll
        for (int i = 0; i < 16; ++i) t[i] = t[i] > k0[i] ? t[i] : k0[i];
        bitonic_clean_desc(t);
#pragma unroll
        for (int i = 0; i < 16; ++i) k0[i] = (unsigned)__builtin_amdgcn_update_dpp(0, (int)t[15 - i], 0x4E, 0xF, 0xF, true);
#pragma unroll
        for (int i = 0; i < 16; ++i) t[i] = t[i] > k0[i] ? t[i] : k0[i];
        bitonic_clean_desc(t);
        if (q == 0) {
#pragma unroll
            for (int i = 0; i < 4; ++i) { u32x4 w; w.x = t[4 * i]; w.y = t[4 * i + 1]; w.z = t[4 * i + 2]; w.w = t[4 * i + 3]; *(LAS u32x4*)(kbuf + L * 16 + 4 * i) = w; }
        }
        asm volatile("s_waitcnt lgkmcnt(0)" ::: "memory");
    }
    {
        const int hd = lane >> 3, sub = lane & 7;
        unsigned ck[7]; int ce[7]; float cv[7];
#pragma unroll
        for (int k = 0; k < 7; ++k) {
            const int cidx = 7 * sub + k;
            const unsigned tab = ctab[cidx];
            const unsigned ka = kbuf[hd * 32 + (tab & 15u)], kb = kbuf[hd * 32 + 16 + ((tab >> 8) & 15u)];
            const float v = key_value(ka) + key_value(kb);
            cv[k] = v;
            ce[k] = (127 - (int)(ka & 127u)) * 128 + (127 - (int)(kb & 127u));
            const unsigned u = __float_as_uint(v);
            const unsigned mono = (u & 0x80000000u) ? ~u : (u | 0x80000000u);
            ck[k] = (cidx < 50) ? ((mono & ~63u) | (unsigned)(63 - cidx)) : 0u;
            cand[hd * 64 + cidx] = ck[k];
        }
        asm volatile("s_waitcnt lgkmcnt(0)" ::: "memory");
        int rank[7];
#pragma unroll
        for (int k = 0; k < 7; ++k) rank[k] = 0;
#pragma unroll
        for (int c4 = 0; c4 < 13; ++c4) {
            const u32x4 o4 = *(const LAS u32x4*)(cand + hd * 64 + 4 * c4);
#pragma unroll
            for (int i = 0; i < 4; ++i) if (4 * c4 + i < 50) {
#pragma unroll
                for (int k = 0; k < 7; ++k) rank[k] += (o4[i] > ck[k]) ? 1 : 0;
            }
        }
        float mx = -INFINITY;
#pragma unroll
        for (int k = 0; k < 7; ++k) mx = fmaxf(mx, (7 * sub + k < 50) ? cv[k] : -INFINITY);
        mx = max_oct(mx);
        float ev[7], es = 0.f;
#pragma unroll
        for (int k = 0; k < 7; ++k) { const bool selk = (7 * sub + k < 50) && rank[k] < 16; ev[k] = selk ? __expf((cv[k] - mx) * rs2) : 0.f; es += ev[k]; }
        es = sum_oct(es);
        const float inv = 1.f / es;
#pragma unroll
        for (int k = 0; k < 7; ++k) if ((7 * sub + k < 50) && rank[k] < 16) { EIDXg[(size_t)tok * 128 + hd * 16 + rank[k]] = ce[k]; GATEg[(size_t)tok * 128 + hd * 16 + rank[k]] = ev[k] * inv; }
    }
}

DI float dot16_fp8(const u32x4& row, const float (&x)[16]) {
    float sacc = 0.f;
#pragma unroll
    for (int w = 0; w < 4; ++w) { const f32x2 lo = __builtin_amdgcn_cvt_pk_f32_fp8((int)row[w], false), hi2 = __builtin_amdgcn_cvt_pk_f32_fp8((int)row[w], true);
        sacc += lo.x * x[4 * w] + lo.y * x[4 * w + 1] + hi2.x * x[4 * w + 2] + hi2.y * x[4 * w + 3]; }
    return sacc;
}
template <class TT> DI TT ldu(const void* ubase, unsigned off) { return *(const TT*)((const char*)ubase + off); }
typedef _Float16 h2_t __attribute__((ext_vector_type(2)));
DI void peer_u_slice(int sl, int tk_first, int tk_step, const unsigned char* XN8g, const int* EIDXg, const unsigned char* U8s, float* PDOT, int lane) {
    const int es = lane >> 3, c = lane & 7;
    const unsigned char* tb = U8s + (size_t)sl * 16384 * 128;
    const unsigned c16 = 16u * c, eoff = 64u * es, xoff = 128u * sl + 16u * c, poff = (16u * es + c) * 4u;
    const bool b2 = c & 4, b1 = c & 2, b0 = c & 1;
    u32x4 I0[2], I1[2], I2[2], rowsA[8], rowsB[8], rowsC[8], x0, x1, x2;
#define LD_E8(ib, tk, h) do { const int _t = (tk) < T ? (tk) : T - 1; const int* _eb = EIDXg + (size_t)_t * 128 + 8 * (h); ib[0] = ldu<u32x4>(_eb, eoff); ib[1] = ldu<u32x4>(_eb, eoff + 16u); } while (0)
#define LD_R8(rows, ib, tbl) do { _Pragma("unroll") for (int _q = 0; _q < 2; ++_q) _Pragma("unroll") for (int _r = 0; _r < 4; ++_r) rows[4 * _q + _r] = ldu<u32x4>(tbl, ib[_q][_r] * 128u + c16); } while (0)
#define LD_X(xx, tk) do { const int _t = (tk) < T ? (tk) : T - 1; xx = ldu<u32x4>(XN8g + (size_t)_t * 1024, xoff); } while (0)
#define U_COMPUTE8(rows, xx, tk, h) do { h2_t _x[8]; _Pragma("unroll") for (int _w = 0; _w < 4; ++_w) { _x[2 * _w] = __builtin_amdgcn_cvt_scalef32_pk_f16_fp8(xx[_w], 1.0f, false); _x[2 * _w + 1] = __builtin_amdgcn_cvt_scalef32_pk_f16_fp8(xx[_w], 1.0f, true); } \
        float _p[8]; _Pragma("unroll") for (int _i = 0; _i < 8; ++_i) { if (_i > 0) asm volatile("" : "+v"(rows[_i]) : "v"(_p[_i - 1])); float _s = 0.f; \
            _Pragma("unroll") for (int _w = 0; _w < 4; ++_w) { _s = __builtin_amdgcn_fdot2(__builtin_amdgcn_cvt_scalef32_pk_f16_fp8(rows[_i][_w], 1.0f, false), _x[2 * _w], _s, false); \
                _s = __builtin_amdgcn_fdot2(__builtin_amdgcn_cvt_scalef32_pk_f16_fp8(rows[_i][_w], 1.0f, true), _x[2 * _w + 1], _s, false); } _p[_i] = _s; } \
        float _q4[4], _q2[2]; \
        _Pragma("unroll") for (int _k = 0; _k < 4; ++_k) _q4[_k] = tr_x4(_p[_k], _p[_k + 4], b2); \
        _Pragma("unroll") for (int _k = 0; _k < 2; ++_k) _q2[_k] = tr_x2(_q4[_k], _q4[_k + 2], b1); \
        const float _r1 = tr_x1(_q2[0], _q2[1], b0); \
        if ((tk) < T) { float* _pb = PDOT + ((size_t)sl * T + (tk)) * 128 + 8 * (h); *(float*)((char*)_pb + poff) = _r1; } } while (0)
    int t0 = tk_first;
    LD_E8(I0, t0, 0); LD_E8(I1, t0, 1); LD_E8(I2, t0 + tk_step, 0); LD_X(x0, t0); LD_R8(rowsA, I0, tb); LD_R8(rowsB, I1, tb);
#pragma unroll 1
    for (; t0 < T; t0 += 3 * tk_step) {
        const int t1 = t0 + tk_step, t2 = t1 + tk_step, t3 = t2 + tk_step;
        LD_E8(I0, t1, 1);           LD_R8(rowsC, I2, tb); LD_X(x1, t1); U_COMPUTE8(rowsA, x0, t0, 0);
        LD_E8(I1, t2, 0);           LD_R8(rowsA, I0, tb);               U_COMPUTE8(rowsB, x0, t0, 1);
        LD_E8(I2, t2, 1);           LD_R8(rowsB, I1, tb); LD_X(x2, t2); U_COMPUTE8(rowsC, x1, t1, 0);
        LD_E8(I0, t3, 0);           LD_R8(rowsC, I2, tb);               U_COMPUTE8(rowsA, x1, t1, 1);
        LD_E8(I1, t3, 1);           LD_R8(rowsA, I0, tb); LD_X(x0, t3); U_COMPUTE8(rowsB, x2, t2, 0);
        LD_E8(I2, t3 + tk_step, 0); LD_R8(rowsB, I1, tb);               U_COMPUTE8(rowsC, x2, t2, 1);
    }
#undef U_COMPUTE8
#undef LD_X
}
template <int NT> DI void peer_cj_tokens(int tok0, int tstride, const int* EIDXg, const float* GATEg, const float* PDOT, const float* usc, const float* vsc, float* CJg, float* CMAXg, int lane) {
    int e[NT][2]; float d[NT][2], g[NT][2];
#pragma unroll
    for (int i = 0; i < NT; ++i) { const int tok = tok0 + i * tstride, tc = tok < T ? tok : T - 1;
#pragma unroll
        for (int hh = 0; hh < 2; ++hh) { const int j = lane + 64 * hh; e[i][hh] = EIDXg[(size_t)tc * 128 + j]; g[i][hh] = GATEg[(size_t)tc * 128 + j]; float a = 0.f;
#pragma unroll
            for (int x = 0; x < 8; ++x) a += PDOT[((size_t)x * T + tc) * 128 + j];
            d[i][hh] = a; } }
    float us[NT][2], vs[NT][2];
#pragma unroll
    for (int i = 0; i < NT; ++i)
#pragma unroll
        for (int hh = 0; hh < 2; ++hh) { us[i][hh] = usc[e[i][hh]]; vs[i][hh] = vsc[e[i][hh]]; }
#pragma unroll
    for (int i = 0; i < NT; ++i) { const int tok = tok0 + i * tstride;
        float cv[2], cm = 0.f;
#pragma unroll
        for (int hh = 0; hh < 2; ++hh) {
            const float hraw = d[i][hh] * us[i][hh] * (1.f / 64.f);
            const float hid = 0.5f * hraw * (1.f + erff(hraw * 0.70710678118654752f));
            cv[hh] = hid * g[i][hh] * vs[i][hh];
            cm = fmaxf(cm, fabsf(cv[hh]));
        }
        cm = wave_max(cm);
        const float inv = cm > 0.f ? 1.f / cm : 0.f;
        if (tok < T) { CJg[(size_t)tok * 128 + lane] = cv[0] * inv; CJg[(size_t)tok * 128 + 64 + lane] = cv[1] * inv; if (lane == 0) CMAXg[tok] = cm; }
    }
}
DI void peer_v_slice(int sl, int tk_first, int tk_step, float* out, const int* EIDXg, const float* CJg, const float* CMAXg, const unsigned char* V8s, bf16_t* A4g, float* SSQg, int lane) {
    const int es = lane >> 3, c = lane & 7;
    const unsigned char* tb = V8s + (size_t)sl * 16384 * 128;
    const unsigned c16 = 16u * c, eoff = 64u * es, ob = 128u * sl + 16u * c + 2u * es;
    const bool b5 = lane & 32, b4 = lane & 16, b3 = lane & 8;
    u32x4 I0[2], I1[2], I2[2], rowsA[8], rowsB[8], rowsC[8]; f32x4 cA[2], cB[2], cC[2]; f32x2 h0, h1, h2;
#define LD_C8(cc, tk, h) do { const int _t = (tk) < T ? (tk) : T - 1; const float* _cb = CJg + (size_t)_t * 128 + 8 * (h); cc[0] = ldu<f32x4>(_cb, eoff); cc[1] = ldu<f32x4>(_cb, eoff + 16u); } while (0)
#define V_AXPY8(rows, cc) do { _Pragma("unroll") for (int _q = 0; _q < 2; ++_q) _Pragma("unroll") for (int _r = 0; _r < 4; ++_r) { const _Float16 _ch = (_Float16)cc[_q][_r]; const h2_t _c2 = {_ch, _ch}; \
            _Pragma("unroll") for (int _w = 0; _w < 4; ++_w) { acch[2 * _w] = __builtin_amdgcn_cvt_scalef32_pk_f16_fp8(rows[4 * _q + _r][_w], 1.0f, false) * _c2 + acch[2 * _w]; \
                acch[2 * _w + 1] = __builtin_amdgcn_cvt_scalef32_pk_f16_fp8(rows[4 * _q + _r][_w], 1.0f, true) * _c2 + acch[2 * _w + 1]; } \
              \
            if (4 * _q + _r < 7) asm volatile("" : "+v"(acch[0]), "+v"(acch[1]), "+v"(acch[2]), "+v"(acch[3]), "+v"(acch[4]), "+v"(acch[5]), "+v"(acch[6]), "+v"(acch[7]), "+v"(rows[(4 * _q + _r + 1) & 7])); \
            else asm volatile("" : "+v"(acch[0]), "+v"(acch[1]), "+v"(acch[2]), "+v"(acch[3]), "+v"(acch[4]), "+v"(acch[5]), "+v"(acch[6]), "+v"(acch[7])); } } while (0)
#define LD_H(hh, tk) do { const int _t = (tk) < T ? (tk) : T - 1; hh = ldu<f32x2>(out + (size_t)_t * 1024, ob * 4u); } while (0)
#define V_ZERO() do { _Pragma("unroll") for (int _i = 0; _i < 8; ++_i) acch[_i] = (h2_t){(_Float16)0.f, (_Float16)0.f}; } while (0)
#define V_FINAL(hh, tk) do { float _a[16]; _Pragma("unroll") for (int _i = 0; _i < 8; ++_i) { _a[2 * _i] = (float)acch[_i].x; _a[2 * _i + 1] = (float)acch[_i].y; } \
        const float _cm = CMAXg[(tk) < T ? (tk) : T - 1]; \
        float _q8[8], _q4[4], _q2[2]; \
        _Pragma("unroll") for (int _k = 0; _k < 8; ++_k) _q8[_k] = tr_x32(_a[_k], _a[_k + 8]); \
        _Pragma("unroll") for (int _k = 0; _k < 4; ++_k) _q4[_k] = tr_x16(_q8[_k], _q8[_k + 4]); \
        _Pragma("unroll") for (int _k = 0; _k < 2; ++_k) _q2[_k] = tr_x8(_q4[_k], _q4[_k + 2], b3); \
        const float _ha = hh.x + _q2[0] * _cm, _hb = hh.y + _q2[1] * _cm; const float _ssq = wave_sum(_ha * _ha + _hb * _hb); \
        if ((tk) < T) { *(f32x2*)((char*)(out + (size_t)(tk) * 1024) + ob * 4u) = (f32x2){_ha, _hb}; *(unsigned*)((char*)(A4g + (size_t)(tk) * 1024) + ob * 2u) = cvtpk(_ha, _hb); \
            if (lane == 0) SSQg[(size_t)sl * T + (tk)] = _ssq; } } while (0)
    h2_t acch[8];
    int t0 = tk_first;
    LD_E8(I0, t0, 0); LD_E8(I1, t0, 1); LD_E8(I2, t0 + tk_step, 0); LD_H(h0, t0); LD_R8(rowsA, I0, tb); LD_C8(cA, t0, 0); LD_R8(rowsB, I1, tb); LD_C8(cB, t0, 1);
#pragma unroll 1
    for (; t0 < T; t0 += 3 * tk_step) {
        const int t1 = t0 + tk_step, t2 = t1 + tk_step, t3 = t2 + tk_step;
        LD_E8(I0, t1, 1);           LD_R8(rowsC, I2, tb); LD_C8(cC, t1, 0); LD_H(h1, t1); V_ZERO(); V_AXPY8(rowsA, cA);
        LD_E8(I1, t2, 0);           LD_R8(rowsA, I0, tb); LD_C8(cA, t1, 1);                          V_AXPY8(rowsB, cB); V_FINAL(h0, t0);
        LD_E8(I2, t2, 1);           LD_R8(rowsB, I1, tb); LD_C8(cB, t2, 0); LD_H(h2, t2); V_ZERO(); V_AXPY8(rowsC, cC);
        LD_E8(I0, t3, 0);           LD_R8(rowsC, I2, tb); LD_C8(cC, t2, 1);                          V_AXPY8(rowsA, cA); V_FINAL(h1, t1);
        LD_E8(I1, t3, 1);           LD_R8(rowsA, I0, tb); LD_C8(cA, t3, 0); LD_H(h0, t3); V_ZERO(); V_AXPY8(rowsB, cB);
        LD_E8(I2, t3 + tk_step, 0); LD_R8(rowsB, I1, tb); LD_C8(cB, t3, 1);                          V_AXPY8(rowsC, cC); V_FINAL(h2, t2);
    }
#undef V_FINAL
#undef V_ZERO
#undef LD_H
#undef V_AXPY8
#undef LD_C8
#undef LD_R8
#undef LD_E8
}

typedef const __attribute__((address_space(4))) unsigned long long* karg_ptr_t;
DI karg_ptr_t kargs() { karg_ptr_t p = (karg_ptr_t)__builtin_amdgcn_kernarg_segment_ptr(); asm volatile("" : "+s"(p)); return p; }
#define GAS1 __attribute__((address_space(1)))
#define KIN(k) ((const float*)(const GAS1 float*)kargs()[k])
#define KOUT() ((float*)(GAS1 float*)kargs()[18])
#define KWS() ((unsigned char*)(GAS1 unsigned char*)kargs()[19])

__global__ void __launch_bounds__(512, 2) fwd_kernel(Params P) {
    extern __shared__ __attribute__((aligned(16))) unsigned char lds_raw[];
    LAS unsigned char* lds = (LAS unsigned char*)lds_raw;
    const int tid = threadIdx.x, lane = tid & 63, wid = __builtin_amdgcn_readfirstlane(tid >> 6);
    const int wg = blockIdx.x, nwg = gridDim.x;
    const int gwave = wg * 8 + wid, nwaves = nwg * 8;
    const int lo = P.ph_lo, hi = P.ph_hi;

    volatile LAS unsigned* misc = (volatile LAS unsigned*)(lds + LDS_BYTES - 64);
    if (tid < 16) misc[tid] = 0u;
    __syncthreads();
    { unsigned* xcw = (unsigned*)(KWS() + WS_CTL) + CW_XC;
      if (tid == 0) { const unsigned xcc = xb_xcc_id(); misc[5] = xcc; misc[4] = xb_add(xcw + 64 * xcc, 1u); } }
    XcdBarrier bar; bar.bar = (unsigned*)(KWS() + WS_CTL) + CW_BAR; bar.x = 0; bar.st = misc;
    if (hi - lo > 1) bar = xcd_barrier_post((unsigned*)(KWS() + WS_CTL) + CW_BAR, misc);

#define kmean   ((float*)(KWS() + WS_KMEAN))
#define biasTab ((float*)(KWS() + WS_BIAS))
#define WinT    ((bf16_t*)(KWS() + WS_WIN))
#define WoutT   ((bf16_t*)(KWS() + WS_WOUT))
#define WqT     ((bf16_t*)(KWS() + WS_WQ))
#define WgT     ((bf16_t*)(KWS() + WS_WG))
#define WpleT   ((bf16_t*)(KWS() + WS_WPLE))
#define U8      ((unsigned char*)(KWS() + WS_U))
#define V8      ((unsigned char*)(KWS() + WS_V))
#define USC     ((float*)(KWS() + WS_USC))
#define VSC     ((float*)(KWS() + WS_VSC))
#define XN      ((bf16_t*)(KWS() + WS_XN))
#define PB      ((bf16_t*)(KWS() + WS_PB))
#define Qm      ((bf16_t*)(KWS() + WS_QM))
#define Km      ((bf16_t*)(KWS() + WS_KM))
#define VtM     ((bf16_t*)(KWS() + WS_VTM))
#define Qs      ((bf16_t*)(KWS() + WS_QS))
#define Ks      ((bf16_t*)(KWS() + WS_KS))
#define VtS     ((bf16_t*)(KWS() + WS_VTS))
#define Oraw    ((bf16_t*)(KWS() + WS_ORAW))
#define A2      ((bf16_t*)(KWS() + WS_A2))
#define A3      ((bf16_t*)(KWS() + WS_A3))
#define SC      ((float*)(KWS() + WS_SC))
#define EIDXG   ((int*)(KWS() + WS_EIDX))
#define GATEG   ((float*)(KWS() + WS_GATE))
#define CJG     ((float*)(KWS() + WS_CJ))
#define RS2G    ((float*)(KWS() + WS_RS2))
#define SSQG    ((float*)(KWS() + WS_SSQ))
#define PDOTG   ((float*)(KWS() + WS_PDOT))
#define A4G     ((bf16_t*)(KWS() + WS_A4))
#define XN2G    ((unsigned char*)(KWS() + WS_XN2))

#define IN(k) (lo <= (k) && (k) < hi)
#ifndef PROBE_PHASE
#define PROBE_PHASE -1
#endif
#ifndef PROBE_REPS
#define PROBE_REPS 1
#endif
#define REP(k) for (int _rep = 0; _rep < ((k) == PROBE_PHASE ? PROBE_REPS : 1); ++_rep)
#define SEAM(k) do { if (IN(k) && IN((k) + 1)) xcd_barrier(bar); } while (0)

    if (IN(0)) REP(0) {
        LAS float* scr = (LAS float*)lds;
        p0_transpose<true>(KIN(IN_WIN), 1024, 3072, WinT, scr, tid, wg, nwg);
        p0_transpose<false>(KIN(IN_WOUT), 1024, 1024, WoutT, scr, tid, wg, nwg);
        p0_transpose<false>(KIN(IN_WPG), 1024, 1024, WgT, scr, tid, wg, nwg, KIN(IN_PLE_NORM));
        p0_transpose<false>(KIN(IN_WPLE), 256, 1024, WpleT, scr, tid, wg, nwg);
        p0_fold(KIN(IN_PQ), KIN(IN_SUBK), KIN(IN_FFN_NORM), WqT, scr, tid, wg, nwg);
        const size_t gtid = (size_t)wg * 512 + tid, nthr = (size_t)nwg * 512;
        p0_convert(KIN(IN_P), PB, (size_t)T * 256, gtid, nthr);
        { const float* xp = KIN(IN_X); const float* gp = KIN(IN_ATTN_NORM); bf16_t* xo = XN;
          for (int row = gwave; row < T; row += 2 * nwaves) rmsnorm_rows2_bf16(xp, gp, xo, row, row + nwaves, lane); }
        if (wg == 0) {
            for (int idx = tid; idx < 8 * 129; idx += 512) {
                const int h = idx / 129, dist = idx % 129;
                int bk;
                if (dist < 16) bk = dist;
                else { const float v = logf((float)dist / 16.f) / 2.0794415416798357f * 16.f; bk = 16 + (int)v; bk = bk > 31 ? 31 : bk; }
                biasTab[h * 132 + dist] = KIN(IN_RELB)[bk * 8 + h] * LOG2E;
            }
        }
    }
    SEAM(0);
    if (IN(1)) REP(1) {
        pg8::Gemm g{XN, WinT, T, NPROJ, 1024}; pg8::StaticOrder S; S.init(T, NPROJ, nwg, wg);
        EpiQKV E{Qm, KIN(IN_QNORM), KIN(IN_KNORM)};
        pg8::gemm_phase<EpiQKV, pg8::StaticOrder, true, true>(lds, g, S, E);
    }
    SEAM(1);
    if (IN(2)) REP(2) {
        for (int item = gwave; item < 512; item += nwaves) {
            const int bhh = item >> 3, blk = item & 7;
            float sacc[4][8];
#pragma unroll
            for (int q = 0; q < 4; ++q)
#pragma unroll
                for (int j = 0; j < 8; ++j) sacc[q][j] = 0.f;
            const bf16_t* base = Km + ((size_t)bhh * 64 + blk * 8) * 2048 + lane * 8;
#pragma unroll 2
            for (int t8 = 0; t8 < 8; ++t8)
#pragma unroll
                for (int q = 0; q < 4; ++q) { const bf16x8 v = *(const bf16x8*)(base + (size_t)t8 * 2048 + q * 512);
#pragma unroll
                    for (int j = 0; j < 8; ++j) sacc[q][j] += bf2f(v[j]); }
#pragma unroll
            for (int q = 0; q < 4; ++q)
#pragma unroll
                for (int j = 0; j < 8; ++j) { float v = sacc[q][j];
                    sacc[q][j] = sum_x16(sum_row16(v)); }
            if ((lane & 31) == 0) {
                const int hh = lane >> 5;
#pragma unroll
                for (int q = 0; q < 4; ++q)
#pragma unroll
                    for (int j = 0; j < 8; ++j) kmean[(size_t)item * 64 + 16 * q + 8 * hh + j] = sacc[q][j] * (1.f / 256.f);
            }
        }
    }
    SEAM(2);
    if (IN(3)) REP(3) {
        const float* pu = KIN(IN_PU); const float* pv = KIN(IN_PV); unsigned char* u8 = U8; unsigned char* v8 = V8; float* usc_ = USC; float* vsc_ = VSC;
        const bf16_t* qm_ = Qm; const bf16_t* km_ = Km; const bf16_t* vtm_ = VtM; const bf16_t* qs_ = Qs; const bf16_t* ks_ = Ks; const bf16_t* vts_ = VtS;
        const float* kmn_ = kmean; const float* bt_ = biasTab; bf16_t* a2_ = A2;
        const float* gm_ = KIN(IN_ONM); const float* gs_ = KIN(IN_ONS);
        LAS unsigned char* ot = lds;
        LAS float* biasLds = (LAS float*)(lds + 34816);
        for (int i = tid; i < 8 * 132; i += 512) biasLds[i] = bt_[i];
        __syncthreads();
        int qrow = gwave;
        for (int u = gwave; u < 8192; u += nwaves) {
            const int grp = u >> 12, i = u & 4095;
            const int half = i >> 11, j = i & 2047;
            const int qt = half ? (j >> 6) : 63 - (j >> 6), bh = j & 63;
            const int b = bh >> 3, h = bh & 7;
            if (grp == 0) moba_unit(b, h, qt, qm_, km_, vtm_, kmn_, biasLds, ot, lane);
            else sb_unit(b, h, qt, qs_, ks_, vts_, ot, lane);
            __syncthreads();
            {
                const float* gg = grp ? gs_ : gm_;
                const f32x4 g0 = *(const f32x4*)(gg + 8 * lane), g1 = *(const f32x4*)(gg + 8 * lane + 4);
#pragma unroll
                for (int rr = 0; rr < 4; ++rr) {
                    const int row = 4 * wid + rr;
                    const bf16x8 v = *(const LAS bf16x8*)(ot + row * OT_PITCH + lane * 16);
                    float f[8], sq = 0.f;
#pragma unroll
                    for (int e = 0; e < 8; ++e) { f[e] = bf2f(v[e]); sq += f[e] * f[e]; }
                    sq = wave_sum(sq);
                    const float rs = rsqrtf(sq * (1.f / 512.f) + EPS);
                    u32x4 w; w.x = cvtpk(f[0] * rs * g0.x, f[1] * rs * g0.y); w.y = cvtpk(f[2] * rs * g0.z, f[3] * rs * g0.w);
                    w.z = cvtpk(f[4] * rs * g1.x, f[5] * rs * g1.y); w.w = cvtpk(f[6] * rs * g1.z, f[7] * rs * g1.w);
                    *(u32x4*)(a2_ + (size_t)(b * 2048 + qt * 32 + row) * 1024 + grp * 512 + 8 * lane) = w;
                }
            }
            __syncthreads();
            for (int k = 0; k < 1 && qrow < 16384; ++k, qrow += 2 * nwaves) p0_quant_rows4(pu, pv, u8, v8, usc_, vsc_, qrow, qrow + nwaves, lane);
        }
        for (; qrow < 16384; qrow += 2 * nwaves) p0_quant_rows4(pu, pv, u8, v8, usc_, vsc_, qrow, qrow + nwaves, lane);
    }
    SEAM(3);
    if (IN(5)) REP(5) {
        pg8::Gemm g{A2, WoutT, T, 1024, 1024}; pg8::StaticOrder S; S.init(T, 1024, nwg, wg);
        EpiRes E{KIN(IN_X), KOUT(), A3};
        pg8::gemm_phase<EpiRes, pg8::StaticOrder, true, true>(lds, g, S, E);
    }
    SEAM(5);
    if (IN(6)) REP(6) {
        pg8::Gemm g{A3, WqT, T, 2048, 1024}; pg8::StaticOrder S; S.init(T, 2048, nwg, wg);
        EpiBf E{(bf16_t*)SC, 2048};
        pg8::gemm_phase<EpiBf, pg8::StaticOrder, true, true>(lds, g, S, E);
    }
    SEAM(6);
    if (IN(7)) REP(7) {
        LAS float* wl = (LAS float*)(lds + wid * 4096);
        {
            const int c = lane; int ca, cb;
            if (c < 16) { ca = 0; cb = c; } else if (c < 24) { ca = 1; cb = c - 16; } else if (c < 29) { ca = 2; cb = c - 24; } else if (c < 33) { ca = 3; cb = c - 29; }
            else if (c < 36) { ca = 4; cb = c - 33; } else if (c < 42) { ca = 5 + ((c - 36) >> 1); cb = (c - 36) & 1; } else { ca = (c - 34) & 15; cb = 0; }
            ((LAS unsigned*)(wl + 768))[lane] = (unsigned)ca | ((unsigned)cb << 8);
            asm volatile("s_waitcnt lgkmcnt(0)" ::: "memory");
        }
        const float* h1p = KOUT(); const bf16_t* scp = (const bf16_t*)SC; const float* gfp = KIN(IN_FFN_NORM); int* eip = EIDXG; float* gtp = GATEG; unsigned char* xnp = XN2G;
        TopkIn inA, inB;
        peer_topk_load(inA, gwave, h1p, scp, lane);
        for (int tok = gwave; tok < T; tok += 2 * nwaves) {
            peer_topk_load(inB, tok + nwaves, h1p, scp, lane);
            peer_topk_token(tok, inA, gfp, eip, gtp, xnp, wl, lane);
            peer_topk_load(inA, tok + 2 * nwaves, h1p, scp, lane);
            if (tok + nwaves < T) peer_topk_token(tok + nwaves, inB, gfp, eip, gtp, xnp, wl, lane);
        }
    }
    SEAM(7);
    int sl_first = 0, sl_step = 1, tk_first = 0, tk_step = 8;
    if (IN(8) || IN(10)) {
        __syncthreads();
        const unsigned myx = misc[5], myrank = misc[4];
        unsigned nx = 0, myidx = 0, nloc = 1;
        unsigned* xc = (unsigned*)(KWS() + WS_CTL) + CW_XC;
#pragma unroll
        for (unsigned j = 0; j < 16; ++j) { const unsigned cj = xb_ld(xc + 64 * j); if (cj > 0u) { if (j < myx) ++myidx; ++nx; } if (j == myx) nloc = cj; }
        sl_first = __builtin_amdgcn_readfirstlane((int)myidx); sl_step = __builtin_amdgcn_readfirstlane((int)(nx > 0u ? nx : 1u));
        tk_first = __builtin_amdgcn_readfirstlane((int)myrank * 8 + wid); tk_step = __builtin_amdgcn_readfirstlane((int)(nloc > 0u ? nloc : 1u) * 8);
    }
    if (IN(8)) REP(8) {
        const unsigned char* xnp = XN2G; const int* eip = EIDXG; const unsigned char* u8p = U8; float* pdp = PDOTG;
        for (int sl = sl_first; sl < 8; sl += sl_step) peer_u_slice(sl, tk_first, tk_step, xnp, eip, u8p, pdp, lane);
    }
    SEAM(8);
    if (IN(9)) REP(9) {
        const int* eip = EIDXG; const float* gtp = GATEG; const float* pdp = PDOTG; const float* usp = USC; const float* vsp = VSC; float* cjp = CJG; float* cmp_ = RS2G;
        for (int tok = gwave; tok < T; tok += 4 * nwaves) peer_cj_tokens<4>(tok, nwaves, eip, gtp, pdp, usp, vsp, cjp, cmp_, lane);
    }
    SEAM(9);
    if (IN(10)) REP(10) {
        float* outp = KOUT(); const int* eip = EIDXG; const float* cjp = CJG; const float* cmp_ = RS2G; const unsigned char* v8p = V8; bf16_t* a4p = A4G; float* sqp = SSQG;
        for (int sl = sl_first; sl < 8; sl += sl_step) peer_v_slice(sl, tk_first, tk_step, outp, eip, cjp, cmp_, v8p, a4p, sqp, lane);
    }
    SEAM(10);
    if (IN(11)) REP(11) {
        bf16_t* PW = Oraw;
        { int kple = 256; asm volatile("" : "+s"(kple));
          pg8::Gemm g{PB, WpleT, T, 1024, kple}; pg8::StaticOrder S; S.init(T, 1024, nwg, wg);
          EpiBf E{PW, 1024};
          pg8::gemm_phase<EpiBf, pg8::StaticOrder, true, true>(lds, g, S, E); }
        asm volatile("s_waitcnt vmcnt(0)" ::: "memory");
        __syncthreads();
        { pg8::Gemm g{A4G, WgT, T, 1024, 1024}; pg8::StaticOrder S; S.init(T, 1024, nwg, wg);
          EpiGate E{KOUT(), PW, SSQG};
          pg8::gemm_phase<EpiGate, pg8::StaticOrder, true, true>(lds, g, S, E); }
    }
#undef IN
#undef SEAM
}

extern "C" void kernel_launch(void* const* d_in, const int* in_sizes, int n_in, void* d_out, int out_size, void* d_ws, size_t ws_size, hipStream_t stream) {
    static int grid = 0;
    if (grid == 0) {
        if (n_in != 18 || out_size != T * DM || ws_size < WS_END) { fprintf(stderr, "kernel_launch: unexpected shapes (n_in %d out %d ws %zu)\n", n_in, out_size, ws_size); grid = -1; return; }
        int dev = 0, cus = 0, per_cu = 0;
        if (hipGetDevice(&dev) != hipSuccess || hipDeviceGetAttribute(&cus, hipDeviceAttributeMultiprocessorCount, dev) != hipSuccess) { grid = -1; return; }
        if (hipFuncSetAttribute((const void*)fwd_kernel, hipFuncAttributeMaxDynamicSharedMemorySize, LDS_BYTES) != hipSuccess) { fprintf(stderr, "kernel_launch: hipFuncSetAttribute failed\n"); grid = -1; return; }
        if (hipOccupancyMaxActiveBlocksPerMultiprocessor(&per_cu, (const void*)fwd_kernel, 512, LDS_BYTES) != hipSuccess || per_cu < 1)
            fprintf(stderr, "kernel_launch: note: occupancy query reports %d\n", per_cu);
        (void)hipGetLastError();
        grid = cus - (cus % 8);
    }
    if (grid < 0) return;
    if (hipMemsetAsync((char*)d_ws + WS_CTL, 0, CTL_ZERO_BYTES, stream) != hipSuccess) return;
    Params p{};
    for (int i = 0; i < 18; ++i) p.in[i] = (const float*)d_in[i];
    p.out = (float*)d_out; p.ws = (unsigned char*)d_ws;
    p.ph_lo = 0; p.ph_hi = NPHASE;
    hipLaunchKernelGGL(fwd_kernel, dim3(grid), dim3(512), LDS_BYTES, stream, p);
}
```

```cpp
#include <hip/hip_runtime.h>
#include <stdint.h>
#include <stdio.h>

#ifndef N_LAUNCHES
#define N_LAUNCHES 1
#endif

#define DI __device__ __forceinline__
#define LAS __attribute__((address_space(3)))

typedef unsigned short bf16_t;
typedef short bf16x8 __attribute__((ext_vector_type(8)));
typedef float f32x16 __attribute__((ext_vector_type(16)));
typedef float f32x4 __attribute__((ext_vector_type(4)));
typedef float f32x2 __attribute__((ext_vector_type(2)));
typedef unsigned u32x4 __attribute__((ext_vector_type(4)));
typedef unsigned u32x2 __attribute__((ext_vector_type(2)));
typedef __bf16 bf16x2_t __attribute__((ext_vector_type(2)));

constexpr int BATCH = 8, SEQ = 2048, DM = 1024, T = BATCH * SEQ;
constexpr int NPROJ = 3072;
constexpr float EPS = 1e-6f;
constexpr float LOG2E = 1.4426950408889634f;
constexpr float SCL2 = 0.125f * LOG2E;
constexpr int NPHASE = 12;

constexpr size_t MiB = 1u << 20;
constexpr size_t WS_CTL = 0, CTL_ZERO_BYTES = 65536;
constexpr size_t WS_KMEAN = 256 * 1024;
constexpr size_t WS_BIAS = 512 * 1024;
constexpr size_t WS_WIN = 1 * MiB, WS_WOUT = 7 * MiB, WS_WQ = 9 * MiB, WS_WG = 13 * MiB, WS_WPLE = 15 * MiB;
constexpr size_t WS_U = 16 * MiB, WS_V = 32 * MiB;
constexpr size_t WS_USC = 640 * 1024, WS_VSC = 704 * 1024;
constexpr size_t WS_XN2 = 48 * MiB;
constexpr size_t WS_XN = 80 * MiB;
constexpr size_t WS_PB = 112 * MiB;
constexpr size_t WS_QM = 120 * MiB, WS_KM = 136 * MiB, WS_VTM = 152 * MiB, WS_QS = 168 * MiB, WS_KS = 184 * MiB, WS_VTS = 200 * MiB;
constexpr size_t WS_ORAW = 216 * MiB;
constexpr size_t WS_A2 = 80 * MiB;
constexpr size_t WS_A3 = 120 * MiB;
constexpr size_t WS_SC = 152 * MiB;
constexpr size_t WS_EIDX = 80 * MiB, WS_GATE = 88 * MiB, WS_CJ = 96 * MiB, WS_RS2 = 104 * MiB, WS_SSQ = 105 * MiB;
constexpr size_t WS_PDOT = 120 * MiB;
constexpr size_t WS_A4 = 184 * MiB;
constexpr size_t WS_END = 248 * MiB;

constexpr int CW_XC = 8192;
constexpr int CW_BAR = 4096;

constexpr int LDS_BYTES = 147456;

#define XB_TMO      128
#define XB_XCNT(j)  (256  + 64 * (j))
#define XB_XSUB(j)  (1280 + 64 * (j))
#define XB_XGEN(j)  (2304 + 64 * (j))
#define XB_TOP      3328
#define XB_TOPGEN   3392
#define XCD_BAR_WORDS 3456
#define XB_SPIN_CAP (1u << 18)

__device__ __forceinline__ unsigned xb_ld(unsigned* p)              { return __hip_atomic_load(p, __ATOMIC_RELAXED, __HIP_MEMORY_SCOPE_AGENT); }
__device__ __forceinline__ unsigned xb_add(unsigned* p, unsigned v) { return __hip_atomic_fetch_add(p, v, __ATOMIC_RELAXED, __HIP_MEMORY_SCOPE_AGENT); }
__device__ __forceinline__ unsigned xb_xcc_id() { return (unsigned)__builtin_amdgcn_s_getreg((3 << 11) | 20) & 0xFu; }
#define XB_SPIN(cond, bar) do { unsigned _sp = 0; while (cond) { __builtin_amdgcn_s_sleep(1); \
    if ((++_sp & 255u) == 0u) { if (xb_ld(&(bar)[XB_TMO])) break; if (_sp > XB_SPIN_CAP) { atomicAdd(&(bar)[XB_TMO], 1u); break; } } } } while (0)

struct XcdBarrier { unsigned* bar; unsigned x; volatile LAS unsigned* st; };

__device__ __forceinline__ XcdBarrier xcd_barrier_post(unsigned* bar, volatile LAS unsigned* st) {
    XcdBarrier b; b.bar = bar; b.x = xb_xcc_id(); b.st = st;
    if (threadIdx.x == 0) (void)xb_add(&bar[XB_XCNT(b.x)], 1u);
    return b;
}
__device__ __forceinline__ void xcd_barrier_complete(unsigned* bar, unsigned x, unsigned& nloc, unsigned& nx) {
    const unsigned G = gridDim.x * gridDim.y * gridDim.z;
    unsigned sum, cnt, mine, sp = 0u;
    for (;;) {
        sum = 0u; cnt = 0u; mine = 0u;
#pragma unroll
        for (unsigned j = 0; j < 16; ++j) { const unsigned c = xb_ld(&bar[XB_XCNT(j)]); sum += c; cnt += (c > 0u) ? 1u : 0u; mine = (j == x) ? c : mine; }
        if (sum == G) break;
        __builtin_amdgcn_s_sleep(1);
        if ((++sp & 255u) == 0u) { if (xb_ld(&bar[XB_TMO])) break; if (sp > XB_SPIN_CAP) { atomicAdd(&bar[XB_TMO], 1u); break; } }
    }
    nloc = mine > 0u ? mine : 1u; nx = cnt > 0u ? cnt : 1u;
}
__device__ __forceinline__ void xcd_barrier(const XcdBarrier& b) {
    asm volatile("s_waitcnt vmcnt(0)" ::: "memory");
    __syncthreads();
    if (threadIdx.x == 0) {
        unsigned* bar = b.bar;
        __builtin_amdgcn_s_waitcnt(0);
        unsigned nloc = b.st[0], nx = b.st[1];
        if (nloc == 0u) { xcd_barrier_complete(bar, b.x, nloc, nx); b.st[0] = nloc; b.st[1] = nx; }
        const unsigned old = xb_add(&bar[XB_XSUB(b.x)], 1u);
        const unsigned gen = old / nloc;
        if (old + 1u == (gen + 1u) * nloc) {
            __builtin_amdgcn_fence(__ATOMIC_RELEASE, "agent");
            asm volatile("s_waitcnt vmcnt(0)" ::: "memory");
            const unsigned og = xb_add(&bar[XB_TOP], 1u);
            const unsigned tg = og / nx;
            if (og + 1u == (tg + 1u) * nx) xb_add(&bar[XB_TOPGEN], 1u);
            else XB_SPIN(xb_ld(&bar[XB_TOPGEN]) == tg, bar);
            __builtin_amdgcn_fence(__ATOMIC_ACQUIRE, "agent");
            xb_add(&bar[XB_XGEN(b.x)], 1u);
            asm volatile("s_waitcnt vmcnt(0)" ::: "memory");
        } else {
            XB_SPIN(xb_ld(&bar[XB_XGEN(b.x)]) == gen, bar);
            __builtin_amdgcn_fence(__ATOMIC_ACQUIRE, "agent");
            asm volatile("s_waitcnt vmcnt(0)" ::: "memory");
        }
    }
    __syncthreads();
}

DI float bf2f(short v) { return __builtin_bit_cast(float, ((unsigned)(unsigned short)v) << 16); }
DI unsigned cvtpk(float lo, float hi) { f32x2 v = {lo, hi}; bf16x2_t b = __builtin_convertvector(v, bf16x2_t); return __builtin_bit_cast(unsigned, b); }
DI bf16_t f2bf(float f) { return (bf16_t)(cvtpk(f, 0.f) & 0xffffu); }
template <int CTRL> DI float dppf(float v) { return __builtin_bit_cast(float, __builtin_amdgcn_update_dpp(0, __builtin_bit_cast(int, v), CTRL, 0xF, 0xF, true)); }
#define DPP_XOR1 0xB1
#define DPP_XOR2 0x4E
#define DPP_HMIR 0x141
#define DPP_MIR  0x140
DI void swap16(float v, float& a, float& b) { const auto r = __builtin_amdgcn_permlane16_swap(__builtin_bit_cast(unsigned, v), __builtin_bit_cast(unsigned, v), false, false); const unsigned r0 = r[0], r1 = r[1]; a = __builtin_bit_cast(float, r0); b = __builtin_bit_cast(float, r1); }
DI void swap32(float v, float& a, float& b) { const auto r = __builtin_amdgcn_permlane32_swap(__builtin_bit_cast(unsigned, v), __builtin_bit_cast(unsigned, v), false, false); const unsigned r0 = r[0], r1 = r[1]; a = __builtin_bit_cast(float, r0); b = __builtin_bit_cast(float, r1); }
DI float sum_x16(float v) { float a, b; swap16(v, a, b); return a + b; }
DI float sum_x32(float v) { float a, b; swap32(v, a, b); return a + b; }
DI float max_x32(float v) { float a, b; swap32(v, a, b); return fmaxf(a, b); }
DI float sum_row16(float v) { v += dppf<DPP_XOR1>(v); v += dppf<DPP_XOR2>(v); v += dppf<DPP_HMIR>(v); v += dppf<DPP_MIR>(v); return v; }
DI float max_row16(float v) { v = fmaxf(v, dppf<DPP_XOR1>(v)); v = fmaxf(v, dppf<DPP_XOR2>(v)); v = fmaxf(v, dppf<DPP_HMIR>(v)); v = fmaxf(v, dppf<DPP_MIR>(v)); return v; }
DI float sum_oct(float v) { v += dppf<DPP_XOR1>(v); v += dppf<DPP_XOR2>(v); v += dppf<DPP_HMIR>(v); return v; }
DI float max_oct(float v) { v = fmaxf(v, dppf<DPP_XOR1>(v)); v = fmaxf(v, dppf<DPP_XOR2>(v)); v = fmaxf(v, dppf<DPP_HMIR>(v)); return v; }
DI float wave_sum(float v) { return sum_x32(sum_x16(sum_row16(v))); }
DI float wave_max(float v) { v = max_row16(v); float a, b; swap16(v, a, b); return max_x32(fmaxf(a, b)); }
DI float tr_x32(float lo, float hi) { const auto r = __builtin_amdgcn_permlane32_swap(__builtin_bit_cast(unsigned, lo), __builtin_bit_cast(unsigned, hi), false, false); const unsigned r0 = r[0], r1 = r[1]; return __builtin_bit_cast(float, r0) + __builtin_bit_cast(float, r1); }
DI float tr_x16(float lo, float hi) { const auto r = __builtin_amdgcn_permlane16_swap(__builtin_bit_cast(unsigned, lo), __builtin_bit_cast(unsigned, hi), false, false); const unsigned r0 = r[0], r1 = r[1]; return __builtin_bit_cast(float, r0) + __builtin_bit_cast(float, r1); }
DI float tr_x8(float lo, float hi, bool bit) { const float mine = bit ? hi : lo, send = bit ? lo : hi; return mine + dppf<0x128>(send); }
DI float tr_x4(float lo, float hi, bool bit) {
    const int a = __builtin_amdgcn_update_dpp(0, __builtin_bit_cast(int, hi), 0x114, 0xF, 0xA, false);
    const int b = __builtin_amdgcn_update_dpp(a, __builtin_bit_cast(int, lo), 0x104, 0xF, 0x5, false);
    return (bit ? hi : lo) + __builtin_bit_cast(float, b);
}
DI float tr_x2(float lo, float hi, bool bit) { const float mine = bit ? hi : lo, send = bit ? lo : hi; return mine + dppf<DPP_XOR2>(send); }
DI float tr_x1(float lo, float hi, bool bit) { const float mine = bit ? hi : lo, send = bit ? lo : hi; return mine + dppf<DPP_XOR1>(send); }
DI int crow(int r, int hi) { return (r & 3) + 8 * (r >> 2) + 4 * hi; }
#define MFMA32(a, b, c) __builtin_amdgcn_mfma_f32_32x32x16_bf16((a), (b), (c), 0, 0, 0)
DI f32x16 zero16() { f32x16 z; for (int i = 0; i < 16; ++i) z[i] = 0.f; return z; }

struct Params {
    const float* in[18];
    float* out;
    unsigned char* ws;
    int ph_lo, ph_hi;
};

enum { IN_X = 0, IN_P, IN_RELB, IN_ATTN_NORM, IN_WIN, IN_QNORM, IN_KNORM, IN_ONM, IN_ONS, IN_WOUT, IN_FFN_NORM, IN_PQ, IN_SUBK, IN_PU, IN_PV, IN_PLE_NORM, IN_WPG, IN_WPLE };

template <bool HEADPERM> DI void p0_transpose(const float* W, int K, int N, bf16_t* Wt, LAS float* scr, int tid, int wg, int nwg, const float* kgain = nullptr) {
    const int tn = N / 64, ntile = (K / 64) * tn;
    for (int tile = wg; tile < ntile; tile += nwg) {
        const int k0 = (tile / tn) * 64, n0 = (tile % tn) * 64;
#pragma unroll
        for (int i = 0; i < 8; ++i) { const int kk = (tid >> 6) + 8 * i, nn = tid & 63; scr[kk * 65 + nn] = W[(size_t)(k0 + kk) * N + n0 + nn]; }
        __syncthreads();
#pragma unroll
        for (int i = 0; i < 8; ++i) { const int nn = (tid >> 6) + 8 * i, kk = tid & 63; int n = n0 + nn; if (HEADPERM) { const int w = n & 255; n = (n & ~255) + 128 * ((w >> 5) & 1) + 32 * (w >> 6) + (w & 31); }
            Wt[(size_t)n * K + k0 + kk] = f2bf(scr[kk * 65 + nn] * (kgain ? kgain[k0 + kk] : 1.f)); }
        __syncthreads();
    }
}

DI void p0_fold(const float* wq, const float* sub, const float* gffn, bf16_t* WqT, LAS float* lds, int tid, int wg, int nwg) {
    LAS float* wqs = lds;
    LAS float* subs = lds + 128 * 65;
    for (int item = wg; item < 256; item += nwg) {
        const int dt = item & 15, hh = item >> 4, d0 = dt * 64, h = hh >> 1, half = hh & 1;
#pragma unroll
        for (int i = 0; i < 16; ++i) { const int k = tid & 127, dd = (tid >> 7) + 4 * i; wqs[k * 65 + dd] = wq[(size_t)(d0 + dd) * 2048 + h * 256 + half * 128 + k]; }
#pragma unroll
        for (int i = 0; i < 32; ++i) { const int idx = i * 512 + tid; subs[idx] = sub[half * 16384 + idx]; }
        __syncthreads();
        const int d = tid & 63, ng = tid >> 6;
        float acc[16];
#pragma unroll
        for (int i = 0; i < 16; ++i) acc[i] = 0.f;
        for (int k = 0; k < 128; k += 4) {
            const float a0 = wqs[(k + 0) * 65 + d], a1 = wqs[(k + 1) * 65 + d], a2 = wqs[(k + 2) * 65 + d], a3 = wqs[(k + 3) * 65 + d];
#pragma unroll
            for (int i = 0; i < 16; ++i) { const f32x4 s = *(const LAS f32x4*)(subs + (16 * ng + i) * 128 + k); acc[i] += a0 * s.x + a1 * s.y + a2 * s.z + a3 * s.w; }
        }
        const float g = gffn[d0 + d];
#pragma unroll
        for (int i = 0; i < 16; ++i) WqT[(size_t)(hh * 128 + 16 * ng + i) * 1024 + d0 + d] = f2bf(acc[i] * g);
        __syncthreads();
    }
}

DI void p0_convert(const float* src, bf16_t* dst, size_t n, size_t gtid, size_t nthreads) {
    for (size_t i = gtid * 8; i < n; i += nthreads * 8) {
        const f32x4 a = *(const f32x4*)(src + i), b = *(const f32x4*)(src + i + 4);
        u32x4 o; o.x = cvtpk(a.x, a.y); o.y = cvtpk(a.z, a.w); o.z = cvtpk(b.x, b.y); o.w = cvtpk(b.z, b.w);
        *(u32x4*)(dst + i) = o;
    }
}


DI void p0_quant_finish(const f32x4 (&a)[4], unsigned char* dst, float* scale, int row, int lane) {
    float m = 0.f;
#pragma unroll
    for (int i = 0; i < 4; ++i) m = fmaxf(fmaxf(m, fmaxf(fabsf(a[i].x), fabsf(a[i].y))), fmaxf(fabsf(a[i].z), fabsf(a[i].w)));
    m = wave_max(m);
    const float sc = m > 0.f ? m * (1.f / 440.f) : 1.f, inv = m > 0.f ? 440.f / m : 0.f;
    u32x4 w;
#pragma unroll
    for (int i = 0; i < 4; ++i) {
        const float q0 = fminf(fmaxf(a[i].x * inv, -448.f), 448.f), q1 = fminf(fmaxf(a[i].y * inv, -448.f), 448.f);
        const float q2 = fminf(fmaxf(a[i].z * inv, -448.f), 448.f), q3 = fminf(fmaxf(a[i].w * inv, -448.f), 448.f);
        int p = 0;
        p = __builtin_amdgcn_cvt_pk_fp8_f32(q0, q1, p, false);
        p = __builtin_amdgcn_cvt_pk_fp8_f32(q2, q3, p, true);
        w[i] = (unsigned)p;
    }
    *(u32x4*)(dst + ((size_t)(lane >> 3) * 16384 + row) * 128 + 16 * (lane & 7)) = w;
    if (lane == 0) scale[row] = sc;
}
DI void p0_quant_rows4(const float* pu, const float* pv, unsigned char* u8, unsigned char* v8, float* usc_, float* vsc_, int r0, int r1, int lane) {
    f32x4 a[4][4];
    const int r1c = r1 < 16384 ? r1 : r0;
#pragma unroll
    for (int i = 0; i < 4; ++i) { a[0][i] = *(const f32x4*)(pu + (size_t)r0 * 1024 + 16 * lane + 4 * i); a[1][i] = *(const f32x4*)(pv + (size_t)r0 * 1024 + 16 * lane + 4 * i);
        a[2][i] = *(const f32x4*)(pu + (size_t)r1c * 1024 + 16 * lane + 4 * i); a[3][i] = *(const f32x4*)(pv + (size_t)r1c * 1024 + 16 * lane + 4 * i); }
    p0_quant_finish(a[0], u8, usc_, r0, lane); p0_quant_finish(a[1], v8, vsc_, r0, lane);
    if (r1 < 16384) { p0_quant_finish(a[2], u8, usc_, r1, lane); p0_quant_finish(a[3], v8, vsc_, r1, lane); }
}

DI void rmsnorm_rows2_bf16(const float* x, const float* g, bf16_t* o, int r0, int r1, int lane) {
    f32x4 v[2][4]; float s[2] = {0.f, 0.f};
    const int rr[2] = {r0, r1 < T ? r1 : r0};
#pragma unroll
    for (int q = 0; q < 2; ++q)
#pragma unroll
        for (int j = 0; j < 4; ++j) v[q][j] = ((const f32x4*)(x + (size_t)rr[q] * 1024))[lane + 64 * j];
#pragma unroll
    for (int q = 0; q < 2; ++q) {
#pragma unroll
        for (int j = 0; j < 4; ++j) s[q] += (v[q][j].x * v[q][j].x + v[q][j].y * v[q][j].y) + (v[q][j].z * v[q][j].z + v[q][j].w * v[q][j].w);
        s[q] = wave_sum(s[q]);
    }
#pragma unroll
    for (int q = 0; q < 2; ++q) {
        if (q == 1 && r1 >= T) break;
        const float rs = rsqrtf(s[q] * (1.f / 1024.f) + EPS);
#pragma unroll
        for (int j = 0; j < 4; ++j) { const f32x4 gv = ((const f32x4*)g)[lane + 64 * j];
            u32x2 w; w.x = cvtpk(v[q][j].x * rs * gv.x, v[q][j].y * rs * gv.y); w.y = cvtpk(v[q][j].z * rs * gv.z, v[q][j].w * rs * gv.w);
            ((u32x2*)(o + (size_t)rr[q] * 1024))[lane + 64 * j] = w; }
    }
}

namespace pg8 {
#define PG8_LAS __attribute__((address_space(3)))
typedef unsigned short bf16_t;
typedef short bf16x8 __attribute__((ext_vector_type(8)));
typedef float f32x4 __attribute__((ext_vector_type(4)));
typedef unsigned u32x4 __attribute__((ext_vector_type(4)));
constexpr int BM = 256, BK = 64, HALF = 128, HTB = HALF * BK * 2  , STAGE_BYTES = 8 * HTB, NXCD = 8, WGM = 8;

__host__ __device__ __forceinline__ int lds_byte(int r, int c) { const int st = (r >> 4) * 2 + (c >> 5), rr = r & 15, cc = c & 31, ob = rr * 64 + cc * 2; return st * 1024 + (ob ^ (((ob >> 9) & 1) << 5)); }
__host__ __device__ __forceinline__ void stage_rc(int b, int& R, int& C) { const int st = b / 1024, sb = b % 1024, swz = sb ^ (((sb >> 9) & 1) << 5); R = (st >> 1) * 16 + swz / 64; C = (st & 1) * 32 + (swz % 64) / 2; }
__host__ __device__ __forceinline__ int perm32(int rho) { const int n = rho >> 4, i = rho & 15; return 8 * (i >> 2) + 4 * n + (i & 3); }

struct Unit { int pm, pn; };
struct Gemm { const bf16_t* A; const bf16_t* Bt; int M, N, K; };

struct StaticOrder {
    int nM, nN, nwg, G, c;
    __host__ __device__ void init(int M, int N, int G_, int c_) { nM = M / BM; nN = N / BM; nwg = nM * nN; G = G_; c = c_; }
    __host__ __device__ bool next(int i, Unit& u) const {
        const long L = (long)i * G + c; if (L >= nwg) return false;
        int wgid = (int)L; { const int q = nwg / NXCD, r = nwg % NXCD, xcd = wgid % NXCD, off = wgid / NXCD; wgid = (xcd < r ? xcd * (q + 1) : r * (q + 1) + (xcd - r) * q) + off; }
        const int nig = WGM * nN, gid = wgid / nig, fm = gid * WGM, gsz = (nM - fm) < WGM ? (nM - fm) : WGM;
        u.pm = fm + ((wgid % nig) % gsz); u.pn = (wgid % nig) / gsz; return true;
    }
    __device__ __forceinline__ void a_ready(const Unit&) const {}
    __device__ __forceinline__ void done(const Unit&) const {}
};

template <class Epi, class Sched, bool ALIGN_EPI = false, bool SP2 = false>
__device__ __forceinline__ void gemm_phase(PG8_LAS unsigned char* lds, const Gemm g, const Sched& S, const Epi& E) {
    int tid_ = threadIdx.x; asm volatile("" : "+v"(tid_));
    const int tid = tid_, wid = __builtin_amdgcn_readfirstlane(tid >> 6), lane = tid & 63, wr = wid >> 2, wc = wid & 3, fr = lane & 15, fq = lane >> 4;
    const int K = g.K, nt = K / BK;
    unsigned voffA[2], voffB[2];
#pragma unroll
    for (int i = 0; i < 2; ++i) { int R, C; stage_rc(tid * 16 + i * 8192, R, C); const int Rb = Epi::PERM ? ((R & ~31) + perm32(R & 31)) : R;
        voffA[i] = (unsigned)(R * K + C) * 2u; voffB[i] = (unsigned)(Rb * K + C) * 2u; }
    const size_t kstep = (size_t)(BK * 2);
    const size_t hstep = (size_t)HALF * K * 2;
    const size_t tstep = 2 * hstep;
    const unsigned ldsw = (unsigned)wid * 1024u;
    const int aoff = lds_byte(wr * 64 + fr, fq * 8), boff = lds_byte(wc * 32 + fr, fq * 8);
#define PG8_SA(b, h) (((b) * 2 + (h)) * HTB)
#define PG8_SB(b, h) ((4 + (b) * 2 + (h)) * HTB)
#define PG8_STAGE(bufoff, gbase, voff) do { _Pragma("unroll") for (int _i = 0; _i < 2; ++_i) \
        __builtin_amdgcn_global_load_lds((const unsigned*)((const char*)(gbase) + (voff)[_i]), (PG8_LAS unsigned*)(lds + (bufoff) + ldsw + _i * 8192), 16, 0, 0); } while (0)
#define PG8_LDA(dst, b, h) do { _Pragma("unroll") for (int m = 0; m < 4; ++m) _Pragma("unroll") for (int k = 0; k < 2; ++k) dst[m][k] = *(const PG8_LAS bf16x8*)(lds + PG8_SA(b, h) + aoff + m * 2048 + k * 1024); } while (0)
#define PG8_LDB(dst, b, h) do { _Pragma("unroll") for (int n = 0; n < 2; ++n) _Pragma("unroll") for (int k = 0; k < 2; ++k) dst[n][k] = *(const PG8_LAS bf16x8*)(lds + PG8_SB(b, h) + boff + n * 2048 + k * 1024); } while (0)
#define PG8_MMA(ai, bj, At, Bt) do { __builtin_amdgcn_s_setprio(1); _Pragma("unroll") for (int m = 0; m < 4; ++m) _Pragma("unroll") for (int n = 0; n < 2; ++n) _Pragma("unroll") for (int k = 0; k < 2; ++k) \
        acc[ai][bj][m][n] = __builtin_amdgcn_mfma_f32_16x16x32_bf16(Bt[n][k], At[m][k], acc[ai][bj][m][n], 0, 0, 0); __builtin_amdgcn_s_setprio(0); } while (0)
#define PG8_WAIT_V(n) asm volatile("s_waitcnt vmcnt(" #n ")" ::: "memory")
#define PG8_WAIT_L(n) asm volatile("s_waitcnt lgkmcnt(" #n ")" ::: "memory")
#define PG8_BAR __builtin_amdgcn_s_barrier()
#define PG8_SCHED __builtin_amdgcn_sched_barrier(0)
    Unit cur, nxt; int ui = 0;
    if (!S.next(0, cur)) return;
    f32x4 acc[2][2][4][2];
#pragma unroll
    for (int a = 0; a < 2; ++a)
#pragma unroll
        for (int b = 0; b < 2; ++b)
#pragma unroll
            for (int m = 0; m < 4; ++m)
#pragma unroll
                for (int n = 0; n < 2; ++n) acc[a][b][m][n] = (f32x4){0.f, 0.f, 0.f, 0.f};
    bf16x8 At[4][2], B0[2][2], B1[2][2];
    const char* cA = (const char*)g.A + (size_t)cur.pm * tstep; const char* cB = (const char*)g.Bt + (size_t)cur.pn * tstep;
    S.a_ready(cur);
    if constexpr (SP2) {
        PG8_STAGE(PG8_SB(0, 0), cB, voffB); PG8_STAGE(PG8_SB(0, 1), cB + hstep, voffB); PG8_STAGE(PG8_SA(0, 0), cA, voffA); PG8_STAGE(PG8_SA(0, 1), cA + hstep, voffA);
        if (wr == 1) PG8_BAR;
        PG8_WAIT_V(2); PG8_BAR;
        PG8_STAGE(PG8_SB(1, 0), cB + kstep, voffB); PG8_STAGE(PG8_SA(1, 0), cA + kstep, voffA); PG8_STAGE(PG8_SB(1, 1), cB + hstep + kstep, voffB);
        PG8_WAIT_V(6); PG8_BAR;
    } else {
        PG8_STAGE(PG8_SB(0, 0), cB, voffB); PG8_STAGE(PG8_SA(0, 0), cA, voffA); PG8_STAGE(PG8_SB(0, 1), cB + hstep, voffB); PG8_STAGE(PG8_SA(0, 1), cA + hstep, voffA);
        if (wr == 1) PG8_BAR;
        PG8_WAIT_V(4); PG8_BAR;
        PG8_STAGE(PG8_SB(1, 0), cB + kstep, voffB); PG8_STAGE(PG8_SA(1, 0), cA + kstep, voffA); PG8_STAGE(PG8_SB(1, 1), cB + hstep + kstep, voffB);
        PG8_WAIT_V(6); PG8_BAR;
    }
    for (;;) {
        const bool has_next = S.next(ui + 1, nxt);
        const char* nA = has_next ? (const char*)g.A + (size_t)nxt.pm * tstep : cA; const char* nB = has_next ? (const char*)g.Bt + (size_t)nxt.pn * tstep : cB;
        for (int t = 0; t < nt; t += 2) {
            const bool last = (t == nt - 2);
            const char* a1 = cA + (size_t)(t + 1) * kstep;
            const char* a2 = last ? nA : cA + (size_t)(t + 2) * kstep; const char* b2 = last ? nB : cB + (size_t)(t + 2) * kstep;
            const char* a3 = a2 + kstep; const char* b3 = b2 + kstep;
            if (last && has_next) S.a_ready(nxt);
            if constexpr (SP2) {
            PG8_LDB(B0, 0, 0); PG8_LDB(B1, 0, 1); PG8_SCHED; PG8_LDA(At, 0, 0); PG8_STAGE(PG8_SA(1, 1), a1 + hstep, voffA);
            PG8_WAIT_V(8); PG8_WAIT_L(0); PG8_BAR; PG8_MMA(0, 0, At, B0); PG8_MMA(0, 1, At, B1); PG8_BAR; PG8_SCHED;
            PG8_LDA(At, 0, 1); PG8_STAGE(PG8_SB(0, 0), b2, voffB); PG8_STAGE(PG8_SB(0, 1), b2 + hstep, voffB); PG8_STAGE(PG8_SA(0, 0), a2, voffA);
            PG8_WAIT_V(8); PG8_WAIT_L(0); PG8_BAR; PG8_MMA(1, 0, At, B0); PG8_MMA(1, 1, At, B1); PG8_BAR; PG8_SCHED;
            PG8_LDB(B0, 1, 0); PG8_LDB(B1, 1, 1); PG8_SCHED; PG8_LDA(At, 1, 0); PG8_STAGE(PG8_SA(0, 1), a2 + hstep, voffA);
            PG8_WAIT_V(8); PG8_WAIT_L(0); PG8_BAR; PG8_MMA(0, 0, At, B0); PG8_MMA(0, 1, At, B1); PG8_BAR; PG8_SCHED;
            PG8_LDA(At, 1, 1); PG8_STAGE(PG8_SB(1, 0), b3, voffB); PG8_STAGE(PG8_SB(1, 1), b3 + hstep, voffB); PG8_STAGE(PG8_SA(1, 0), a3, voffA);
            PG8_WAIT_V(8); PG8_WAIT_L(0); PG8_BAR; PG8_MMA(1, 0, At, B0); PG8_MMA(1, 1, At, B1); PG8_BAR; PG8_SCHED;
            } else {
            PG8_LDB(B0, 0, 0); PG8_SCHED; PG8_LDA(At, 0, 0); PG8_STAGE(PG8_SA(1, 1), a1 + hstep, voffA);
            PG8_WAIT_L(8); PG8_BAR; PG8_WAIT_L(0); PG8_MMA(0, 0, At, B0); PG8_BAR; PG8_SCHED;
            PG8_LDB(B1, 0, 1); PG8_STAGE(PG8_SB(0, 0), b2, voffB);
            PG8_BAR; PG8_WAIT_L(0); PG8_MMA(0, 1, At, B1); PG8_BAR;
            PG8_LDA(At, 0, 1); PG8_STAGE(PG8_SA(0, 0), a2, voffA);
            PG8_BAR; PG8_WAIT_L(0); PG8_MMA(1, 0, At, B0); PG8_BAR; PG8_SCHED;
            PG8_STAGE(PG8_SB(0, 1), b2 + hstep, voffB);
            PG8_WAIT_V(6); PG8_BAR; PG8_MMA(1, 1, At, B1); PG8_BAR;
            PG8_LDB(B0, 1, 0); PG8_SCHED; PG8_LDA(At, 1, 0); PG8_STAGE(PG8_SA(0, 1), a2 + hstep, voffA);
            PG8_WAIT_L(8); PG8_BAR; PG8_WAIT_L(0); PG8_MMA(0, 0, At, B0); PG8_BAR; PG8_SCHED;
            PG8_LDB(B1, 1, 1); PG8_STAGE(PG8_SB(1, 0), b3, voffB);
            PG8_BAR; PG8_WAIT_L(0); PG8_MMA(0, 1, At, B1); PG8_BAR;
            PG8_LDA(At, 1, 1); PG8_STAGE(PG8_SA(1, 0), a3, voffA);
            PG8_BAR; PG8_WAIT_L(0); PG8_MMA(1, 0, At, B0); PG8_BAR; PG8_SCHED;
            PG8_STAGE(PG8_SB(1, 1), b3 + hstep, voffB);
            PG8_WAIT_V(6); PG8_BAR; PG8_MMA(1, 1, At, B1); PG8_BAR;
            }
        }
        if constexpr (ALIGN_EPI) { if (wr == 0) PG8_BAR; }
        if constexpr (!Epi::AFTER_DRAIN) { E(acc, cur, wr, wc, fr, fq); S.done(cur); }
        if (!has_next) break;
#pragma unroll
        for (int a = 0; a < 2; ++a)
#pragma unroll
            for (int b = 0; b < 2; ++b)
#pragma unroll
                for (int m = 0; m < 4; ++m)
#pragma unroll
                    for (int n = 0; n < 2; ++n) acc[a][b][m][n] = (f32x4){0.f, 0.f, 0.f, 0.f};
        cur = nxt; cA = nA; cB = nB; ++ui;
        if constexpr (ALIGN_EPI) { if (wr == 1) PG8_BAR; }
    }
    PG8_WAIT_V(0);
    if constexpr (!ALIGN_EPI) { if (wr == 0) PG8_BAR; }
    PG8_BAR;
    if constexpr (Epi::AFTER_DRAIN) { E.fused(acc, cur, wr, wc, fr, fq, lds, wid, lane); S.done(cur); }
#undef PG8_SA
#undef PG8_SB
#undef PG8_STAGE
#undef PG8_LDA
#undef PG8_LDB
#undef PG8_MMA
#undef PG8_WAIT_V
#undef PG8_WAIT_L
#undef PG8_BAR
#undef PG8_SCHED
}
}


struct EpiQKV {
    static constexpr bool PERM = true, AFTER_DRAIN = false;
    bf16_t* base6; const float *qn, *kn;
    DI void operator()(const f32x4 (&acc)[2][2][4][2], const pg8::Unit& u, int wr, int wc, int fr, int fq) const {
        const int typ = u.pn >> 1, h = (u.pn & 1) * 4 + wc;
        bf16_t* reg = base6 + (size_t)typ * (16u << 19);
        const int row0 = u.pm * 256 + wr * 64 + fr;
        if (typ == 2 || typ == 5) {
#pragma unroll
            for (int ai = 0; ai < 2; ++ai)
#pragma unroll
                for (int m = 0; m < 4; ++m) {
                    const int tok = row0 + ai * 128 + m * 16, b = tok >> 11, sq = tok & 2047, tile = sq >> 5, kap = sq & 31;
                    const int s2 = kap >> 4, hh = (kap >> 2) & 1, jj = ((kap >> 3) & 1) * 4 + (kap & 3);
                    bf16_t* bp = reg + ((((size_t)(b * 8 + h) * 64 + tile) * 4 + s2 * 2) * 64 + hh * 32 + 8 * fq) * 8 + jj;
#pragma unroll
                    for (int bj = 0; bj < 2; ++bj)
#pragma unroll
                        for (int n = 0; n < 2; ++n)
#pragma unroll
                            for (int i = 0; i < 4; ++i) bp[(size_t)bj * 512 + (4 * n + i) * 8] = f2bf(acc[ai][bj][m][n][i]);
                }
        } else {
            const bool nrm = typ < 2;
            const float* g = (typ == 0) ? qn : kn;
            f32x4 gv[2][2];
#pragma unroll
            for (int bj = 0; bj < 2; ++bj)
#pragma unroll
                for (int n = 0; n < 2; ++n) gv[bj][n] = nrm ? *(const f32x4*)(g + 32 * bj + 8 * fq + 4 * n) : (f32x4){1.f, 1.f, 1.f, 1.f};
#pragma unroll
            for (int ai = 0; ai < 2; ++ai)
#pragma unroll
                for (int m = 0; m < 4; ++m) {
                    const int tok = row0 + ai * 128 + m * 16, b = tok >> 11, sq = tok & 2047, tile = sq >> 5, kap = sq & 31;
                    float rs = 1.f;
                    if (nrm) {
                        float ss = 0.f;
#pragma unroll
                        for (int bj = 0; bj < 2; ++bj)
#pragma unroll
                            for (int n = 0; n < 2; ++n) { const f32x4 v = acc[ai][bj][m][n]; ss += (v.x * v.x + v.y * v.y) + (v.z * v.z + v.w * v.w); }
                        ss = sum_x32(sum_x16(ss));
                        rs = rsqrtf(ss * (1.f / 64.f) + EPS);
                    }
                    bf16_t* dst = reg + ((((size_t)(b * 8 + h) * 64 + tile) * 4 + (fq >> 1)) * 64 + (fq & 1) * 32 + kap) * 8;
#pragma unroll
                    for (int bj = 0; bj < 2; ++bj) {
                        const f32x4 v0 = acc[ai][bj][m][0] * rs * gv[bj][0], v1 = acc[ai][bj][m][1] * rs * gv[bj][1];
                        u32x4 w; w.x = cvtpk(v0.x, v0.y); w.y = cvtpk(v0.z, v0.w); w.z = cvtpk(v1.x, v1.y); w.w = cvtpk(v1.z, v1.w);
                        *(u32x4*)(dst + (size_t)bj * 2 * 512) = w;
                    }
                }
        }
    }
};

struct EpiRes {
    static constexpr bool PERM = true, AFTER_DRAIN = false;
    const float* x; float* out; bf16_t* xn;
    DI void operator()(const f32x4 (&acc)[2][2][4][2], const pg8::Unit& u, int wr, int wc, int fr, int fq) const {
        const int row0 = u.pm * 256 + wr * 64 + fr, col0 = u.pn * 256 + wc * 32 + 8 * fq;
#pragma unroll
        for (int ai = 0; ai < 2; ++ai)
#pragma unroll
            for (int m = 0; m < 4; ++m)
#pragma unroll
                for (int bj = 0; bj < 2; ++bj) {
                    const size_t off = (size_t)(row0 + ai * 128 + m * 16) * 1024 + col0 + bj * 128;
                    const f32x4 h0 = *(const f32x4*)(x + off) + acc[ai][bj][m][0], h1 = *(const f32x4*)(x + off + 4) + acc[ai][bj][m][1];
                    *(f32x4*)(out + off) = h0; *(f32x4*)(out + off + 4) = h1;
                    u32x4 w; w.x = cvtpk(h0.x, h0.y); w.y = cvtpk(h0.z, h0.w); w.z = cvtpk(h1.x, h1.y); w.w = cvtpk(h1.z, h1.w);
                    *(u32x4*)(xn + off) = w;
                }
    }
};

struct EpiF32 {
    static constexpr bool PERM = true, AFTER_DRAIN = false;
    float* C; int ldc;
    DI void operator()(const f32x4 (&acc)[2][2][4][2], const pg8::Unit& u, int wr, int wc, int fr, int fq) const {
        const int row0 = u.pm * 256 + wr * 64 + fr, col0 = u.pn * 256 + wc * 32 + 8 * fq;
#pragma unroll
        for (int ai = 0; ai < 2; ++ai)
#pragma unroll
            for (int m = 0; m < 4; ++m)
#pragma unroll
                for (int bj = 0; bj < 2; ++bj) {
                    float* p = C + (size_t)(row0 + ai * 128 + m * 16) * ldc + col0 + bj * 128;
                    *(f32x4*)p = acc[ai][bj][m][0]; *(f32x4*)(p + 4) = acc[ai][bj][m][1];
                }
    }
};

struct EpiBf {
    static constexpr bool PERM = true, AFTER_DRAIN = false;
    bf16_t* C; int ldc;
    DI void operator()(const f32x4 (&acc)[2][2][4][2], const pg8::Unit& u, int wr, int wc, int fr, int fq) const {
        const int row0 = u.pm * 256 + wr * 64 + fr, col0 = u.pn * 256 + wc * 32 + 8 * fq;
#pragma unroll
        for (int ai = 0; ai < 2; ++ai)
#pragma unroll
            for (int m = 0; m < 4; ++m)
#pragma unroll
                for (int bj = 0; bj < 2; ++bj) {
                    const f32x4 v0 = acc[ai][bj][m][0], v1 = acc[ai][bj][m][1];
                    u32x4 w; w.x = cvtpk(v0.x, v0.y); w.y = cvtpk(v0.z, v0.w); w.z = cvtpk(v1.x, v1.y); w.w = cvtpk(v1.z, v1.w);
                    *(u32x4*)(C + (size_t)(row0 + ai * 128 + m * 16) * ldc + col0 + bj * 128) = w;
                }
    }
};

struct EpiGate {
    static constexpr bool PERM = true, AFTER_DRAIN = false;
    float* out; const bf16_t* pw; const float* ssq;
    DI void operator()(const f32x4 (&acc)[2][2][4][2], const pg8::Unit& u, int wr, int wc, int fr, int fq) const {
        const int row0 = u.pm * 256 + wr * 64 + fr, col0 = u.pn * 256 + wc * 32 + 8 * fq;
#pragma unroll
        for (int ai = 0; ai < 2; ++ai)
#pragma unroll
            for (int m = 0; m < 4; ++m) {
                const int row = row0 + ai * 128 + m * 16;
                float sq = 0.f;
#pragma unroll
                for (int x = 0; x < 8; ++x) sq += ssq[(size_t)x * T + row];
                const float rs3 = rsqrtf(sq * (1.f / 1024.f) + EPS);
#pragma unroll
                for (int bj = 0; bj < 2; ++bj) {
                    const size_t off = (size_t)row * 1024 + col0 + bj * 128;
                    const bf16x8 pv = *(const bf16x8*)(pw + off);
                    const f32x4 h0 = *(const f32x4*)(out + off), h1 = *(const f32x4*)(out + off + 4);
                    const f32x4 g0 = acc[ai][bj][m][0] * rs3, g1 = acc[ai][bj][m][1] * rs3;
                    f32x4 o0, o1;
#pragma unroll
                    for (int i = 0; i < 4; ++i) { o0[i] = h0[i] + bf2f(pv[i]) / (1.f + __expf(-g0[i])); o1[i] = h1[i] + bf2f(pv[4 + i]) / (1.f + __expf(-g1[i])); }
                    *(f32x4*)(out + off) = o0; *(f32x4*)(out + off + 4) = o1;
                }
            }
    }
};

template <class Epi>
DI void gemm_simple(const bf16_t* A, const bf16_t* Bt, int M, int N, int K, const Epi& epi, int gwave, int nwaves, int lane) {
    const int r32 = lane & 31, hi = lane >> 5;
    const int nNt = N / 64, total = (M / 32) * nNt;
    for (int tile = gwave; tile < total; tile += nwaves) {
        const int mt = tile / nNt, nt = tile - mt * nNt, m0 = mt * 32, n0 = nt * 64;
        const bf16_t* ap = A + (size_t)(m0 + r32) * K + 8 * hi;
        const bf16_t* b0p = Bt + (size_t)(n0 + r32) * K + 8 * hi;
        const bf16_t* b1p = b0p + (size_t)32 * K;
        f32x16 acc0 = zero16(), acc1 = zero16();
#pragma unroll 4
        for (int k = 0; k < K; k += 16) {
            const bf16x8 xa = *(const bf16x8*)(ap + k);
            const bf16x8 w0 = *(const bf16x8*)(b0p + k);
            const bf16x8 w1 = *(const bf16x8*)(b1p + k);
            acc0 = MFMA32(w0, xa, acc0);
            acc1 = MFMA32(w1, xa, acc1);
        }
        epi(m0 + r32, n0, hi, acc0, acc1);
    }
}

struct Epi1 {
    bf16_t* base6;
    const float *qn, *kn;
    DI void operator()(int tok, int n0, int hi, const f32x16& a0, const f32x16& a1) const {
        const int head48 = n0 >> 6, typ = head48 >> 3, h = head48 & 7;
        bf16_t* reg = base6 + (size_t)typ * (16u << 19);
        if (typ == 2 || typ == 5) {
            const int b = tok >> 11, s = tok & 2047;
            const int pos = (s & ~12) | ((s & 4) << 1) | ((s & 8) >> 1);
            bf16_t* base = reg + ((size_t)(b * 8 + h) * 64) * 2048 + pos;
#pragma unroll
            for (int r = 0; r < 16; ++r) { base[(size_t)crow(r, hi) * 2048] = f2bf(a0[r]); base[(size_t)(32 + crow(r, hi)) * 2048] = f2bf(a1[r]); }
        } else {
            float rs = 1.f;
            const bool nrm = (typ == 0 || typ == 1);
            if (nrm) { float ss = 0.f;
#pragma unroll
                for (int r = 0; r < 16; ++r) ss += a0[r] * a0[r] + a1[r] * a1[r];
                ss = sum_x32(ss);
                rs = rsqrtf(ss * (1.f / 64.f) + EPS); }
            const float* g = (typ == 0) ? qn : kn;
            bf16_t* dst = reg + (size_t)tok * 512 + h * 64;
#pragma unroll
            for (int t = 0; t < 2; ++t)
#pragma unroll
                for (int g4 = 0; g4 < 4; ++g4) {
                    const int f0 = 32 * t + 8 * g4 + 4 * hi;
                    float v[4];
#pragma unroll
                    for (int i = 0; i < 4; ++i) { const float a = t ? a1[4 * g4 + i] : a0[4 * g4 + i]; v[i] = nrm ? a * rs * g[f0 + i] : a; }
                    u32x2 w; w.x = cvtpk(v[0], v[1]); w.y = cvtpk(v[2], v[3]);
                    *(u32x2*)(dst + f0) = w;
                }
        }
    }
};

struct Epi2 {
    const float* x; float* out; bf16_t* xn;
    DI void operator()(int tok, int n0, int hi, const f32x16& a0, const f32x16& a1) const {
#pragma unroll
        for (int t = 0; t < 2; ++t)
#pragma unroll
            for (int g4 = 0; g4 < 4; ++g4) {
                const size_t off = (size_t)tok * 1024 + n0 + 32 * t + 8 * g4 + 4 * hi;
                const f32x4 xv = *(const f32x4*)(x + off);
                f32x4 hv;
#pragma unroll
                for (int i = 0; i < 4; ++i) hv[i] = xv[i] + (t ? a1[4 * g4 + i] : a0[4 * g4 + i]);
                *(f32x4*)(out + off) = hv;
                u32x2 w; w.x = cvtpk(hv[0], hv[1]); w.y = cvtpk(hv[2], hv[3]);
                *(u32x2*)(xn + off) = w;
            }
    }
};

struct Epi3 {
    float* sc;
    DI void operator()(int tok, int n0, int hi, const f32x16& a0, const f32x16& a1) const {
#pragma unroll
        for (int t = 0; t < 2; ++t)
#pragma unroll
            for (int g4 = 0; g4 < 4; ++g4) {
                f32x4 v;
#pragma unroll
                for (int i = 0; i < 4; ++i) v[i] = t ? a1[4 * g4 + i] : a0[4 * g4 + i];
                *(f32x4*)(sc + (size_t)tok * 2048 + n0 + 32 * t + 8 * g4 + 4 * hi) = v;
            }
    }
};

DI void pv_accum(f32x16& o0, f32x16& o1, const f32x16& p, const bf16_t* vt_row) {
#pragma unroll
    for (int s = 0; s < 2; ++s) {
        u32x4 pk; pk.x = cvtpk(p[8 * s], p[8 * s + 1]); pk.y = cvtpk(p[8 * s + 2], p[8 * s + 3]); pk.z = cvtpk(p[8 * s + 4], p[8 * s + 5]); pk.w = cvtpk(p[8 * s + 6], p[8 * s + 7]);
        const bf16x8 pb = __builtin_bit_cast(bf16x8, pk);
        const bf16x8 v0 = *(const bf16x8*)(vt_row + 16 * s);
        const bf16x8 v1 = *(const bf16x8*)(vt_row + (size_t)32 * 2048 + 16 * s);
        o0 = MFMA32(v0, pb, o0);
        o1 = MFMA32(v1, pb, o1);
    }
}

DI void store_o(bf16_t* op, const f32x16& o0, const f32x16& o1, float inv, int hi) {
#pragma unroll
    for (int t = 0; t < 2; ++t)
#pragma unroll
        for (int g4 = 0; g4 < 4; ++g4) {
            u32x2 w;
            if (t == 0) { w.x = cvtpk(o0[4 * g4] * inv, o0[4 * g4 + 1] * inv); w.y = cvtpk(o0[4 * g4 + 2] * inv, o0[4 * g4 + 3] * inv); }
            else        { w.x = cvtpk(o1[4 * g4] * inv, o1[4 * g4 + 1] * inv); w.y = cvtpk(o1[4 * g4 + 2] * inv, o1[4 * g4 + 3] * inv); }
            *(u32x2*)(op + 32 * t + 8 * g4 + 4 * hi) = w;
        }
}

constexpr int OT_PITCH = 1040;
DI void store_o_lds(LAS unsigned char* ot, int r32, int h, const f32x16& o0, const f32x16& o1, float inv, int hi) {
    LAS unsigned char* op = ot + r32 * OT_PITCH + h * 128;
#pragma unroll
    for (int t = 0; t < 2; ++t)
#pragma unroll
        for (int g4 = 0; g4 < 4; ++g4) {
            u32x2 w;
            if (t == 0) { w.x = cvtpk(o0[4 * g4] * inv, o0[4 * g4 + 1] * inv); w.y = cvtpk(o0[4 * g4 + 2] * inv, o0[4 * g4 + 3] * inv); }
            else        { w.x = cvtpk(o1[4 * g4] * inv, o1[4 * g4 + 1] * inv); w.y = cvtpk(o1[4 * g4 + 2] * inv, o1[4 * g4 + 3] * inv); }
            *(LAS u32x2*)(op + (32 * t + 8 * g4 + 4 * hi) * 2) = w;
        }
}
DI void load_kfrag(bf16x8 (&kf)[4], const bf16_t* fbase  , int tile) {
    const bf16_t* kp = fbase + (size_t)tile * 2048;
#pragma unroll
    for (int s = 0; s < 4; ++s) kf[s] = *(const bf16x8*)(kp + s * 512);
}
DI void load_vfrag(bf16x8 (&vf)[4], const bf16_t* fbase, int tile) {
    const bf16_t* vp = fbase + (size_t)tile * 2048;
#pragma unroll
    for (int q = 0; q < 4; ++q) vf[q] = *(const bf16x8*)(vp + q * 512);
}
DI void pv_accum2(f32x16& o0, f32x16& o1, const f32x16& p, const bf16x8 (&vf)[4]) {
#pragma unroll
    for (int s = 0; s < 2; ++s) {
        u32x4 pk; pk.x = cvtpk(p[8 * s], p[8 * s + 1]); pk.y = cvtpk(p[8 * s + 2], p[8 * s + 3]); pk.z = cvtpk(p[8 * s + 4], p[8 * s + 5]); pk.w = cvtpk(p[8 * s + 6], p[8 * s + 7]);
        const bf16x8 pb = __builtin_bit_cast(bf16x8, pk);
        o0 = MFMA32(vf[2 * s], pb, o0);
        o1 = MFMA32(vf[2 * s + 1], pb, o1);
    }
}

#define MEM_FENCE() asm volatile("" ::: "memory")
#define PIN1(a) asm volatile("" : "+v"(a) :: "memory")
#define PIN2(a, b) asm volatile("" : "+v"(a), "+v"(b) :: "memory")
DI void vm_drain() { __builtin_amdgcn_s_waitcnt(0x0F70); }
struct KvStream { const bf16_t* kbase; const bf16_t* vbase; };

struct MobaCtx { int q0, tq, blk, hi; unsigned selmask; float bfar; const LAS float* bt; };
DI void moba_tile(bf16x8 (&kf)[4], bf16x8 (&vf)[4], const bf16x8 (&qf)[4], int kt, int next, const KvStream& kv, const MobaCtx& c, float& mrun, float& lsum, f32x16& o0, f32x16& o1) {
    const int n = kt >> 3, key0 = kt * 32;
    f32x16 st = zero16();
#pragma unroll
    for (int s = 0; s < 4; ++s) st = MFMA32(kf[s], qf[s], st);
    PIN1(st); load_kfrag(kf, kv.kbase, next); PIN1(st);
    float x[16];
    if (n != c.blk) {
        const bool selq = (c.selmask >> n) & 1u;
        if ((c.q0 - (key0 + 31)) >= 128) {
            const float addend = selq ? c.bfar : -1e30f;
#pragma unroll
            for (int r = 0; r < 16; ++r) x[r] = st[r] * SCL2 + addend;
        } else {
#pragma unroll
            for (int r = 0; r < 16; ++r) { const int dist = c.tq - (key0 + crow(r, c.hi)); const float v = st[r] * SCL2 + c.bt[dist > 128 ? 128 : dist]; x[r] = selq ? v : -1e30f; }
        }
    } else {
#pragma unroll
        for (int r = 0; r < 16; ++r) { const int dist = c.tq - (key0 + crow(r, c.hi)); const float v = st[r] * SCL2 + c.bt[dist < 0 ? 0 : (dist > 128 ? 128 : dist)]; x[r] = (dist >= 0) ? v : -1e30f; }
    }
    float mx = x[0];
#pragma unroll
    for (int r = 1; r < 16; ++r) mx = fmaxf(mx, x[r]);
    mx = max_x32(mx);
    const float mnew = fmaxf(mrun, mx);
    if (!__all(mnew == mrun)) {
        const float alpha = __builtin_amdgcn_exp2f(mrun - mnew);
        lsum *= alpha;
#pragma unroll
        for (int r = 0; r < 16; ++r) { o0[r] *= alpha; o1[r] *= alpha; }
        mrun = mnew;
    }
    f32x16 pr; float ps = 0.f;
#pragma unroll
    for (int r = 0; r < 16; ++r) { const float e = __builtin_amdgcn_exp2f(x[r] - mrun); pr[r] = e; ps += e; }
    lsum += ps;
    pv_accum2(o0, o1, pr, vf);
    PIN2(o0, o1); load_vfrag(vf, kv.vbase, next); MEM_FENCE();
}
DI int moba_next(int kt, int blk, unsigned anysel) {
    int nkt = kt - 1;
    while (nkt >= 0) { const int nn = nkt >> 3; if (nn == blk || ((anysel >> nn) & 1u)) break; nkt = nn * 8 - 1; }
    return nkt;
}

DI void moba_unit(int b, int h, int qt, const bf16_t* Qm_, const bf16_t* Km_, const bf16_t* VtM_, const float* kmean_, const LAS float* biasLds, LAS unsigned char* ot, int lane) {
    const int r32 = lane & 31, hi = lane >> 5;
    const int q0 = qt * 32, tq = q0 + r32, blk = q0 >> 8;
    const size_t bh = (size_t)(b * 8 + h);
    const bf16_t* qfb = Qm_ + bh * (64 * 2048) + (size_t)qt * 2048;
    KvStream kv; kv.kbase = Km_ + bh * (64 * 2048) + lane * 8; kv.vbase = VtM_ + bh * (64 * 2048) + lane * 8;
    bf16x8 kf[4], vf[4];
    load_kfrag(kf, kv.kbase, qt); load_vfrag(vf, kv.vbase, qt);
    bf16x8 qf[4];
#pragma unroll
    for (int s = 0; s < 4; ++s) qf[s] = *(const bf16x8*)(qfb + s * 512 + lane * 8);
    unsigned selmask = 0;
    if (blk > 0) {
        float qv[32];
#pragma unroll
        for (int c = 0; c < 4; ++c) { const bf16x8 t = *(const bf16x8*)(qfb + (2 * hi + (c >> 1)) * 512 + ((c & 1) * 32 + r32) * 8);
#pragma unroll
            for (int j = 0; j < 8; ++j) qv[8 * c + j] = bf2f(t[j]); }
        const float* km = kmean_ + (size_t)((b * 8 + h) * 8) * 64 + 32 * hi;
        float g[8];
#pragma unroll
        for (int n = 0; n < 8; ++n) {
            float a = 0.f;
            if (n < blk) {
#pragma unroll
                for (int d4 = 0; d4 < 8; ++d4) { const f32x4 kv4 = *(const f32x4*)(km + n * 64 + 4 * d4); a += (qv[4 * d4] * kv4.x + qv[4 * d4 + 1] * kv4.y) + (qv[4 * d4 + 2] * kv4.z + qv[4 * d4 + 3] * kv4.w); }
            }
            a = sum_x32(a);
            g[n] = (n < blk) ? a : -INFINITY;
        }
#pragma unroll
        for (int n = 0; n < 8; ++n) {
            int rank = 0;
#pragma unroll
            for (int m = 0; m < 8; ++m) if (m != n) rank += ((g[m] > g[n]) || (g[m] == g[n] && m < n)) ? 1 : 0;
            if (n < blk && rank < 3) selmask |= 1u << n;
        }
    }
    unsigned anysel = 0;
#pragma unroll
    for (int n = 0; n < 8; ++n) if (__any((selmask >> n) & 1u)) anysel |= 1u << n;
    anysel = __builtin_amdgcn_readfirstlane(anysel);
    float mrun = -1e30f, lsum = 0.f;
    f32x16 o0 = zero16(), o1 = zero16();
    MobaCtx c; c.q0 = q0; c.tq = tq; c.blk = blk; c.hi = hi; c.selmask = selmask; c.bt = biasLds + h * 132; c.bfar = c.bt[128];
    vm_drain();
    int kt = qt;
    for (;;) {
        const int nx = moba_next(kt, blk, anysel);
        moba_tile(kf, vf, qf, kt, nx < 0 ? 0 : nx, kv, c, mrun, lsum, o0, o1);
        if (nx < 0) break;
        kt = nx;
    }
    lsum = sum_x32(lsum);
    const float inv = 1.f / lsum;
    store_o_lds(ot, r32, h, o0, o1, inv, hi);
}

DI void sb_tile(bf16x8 (&kf)[4], bf16x8 (&vf)[4], const bf16x8 (&qf)[4], int kt, int next, const KvStream& kv, int tq, int hi, float& C, f32x16& o0, f32x16& o1) {
    const int key0 = kt * 32;
    f32x16 st = zero16();
#pragma unroll
    for (int s = 0; s < 4; ++s) st = MFMA32(kf[s], qf[s], st);
    PIN1(st); load_kfrag(kf, kv.kbase, next); PIN1(st);
    float rr[16], be[16];
#pragma unroll
    for (int r = 0; r < 16; ++r) {
        const int key = key0 + crow(r, hi);
        const float y = fminf(st[r] * SCL2, 100.f);
        const float e = __builtin_amdgcn_exp2f(y);
        const float ri = __builtin_amdgcn_rcpf(1.f + e);
        const bool ok = key < tq;
        rr[r] = ok ? ri : 1.f;
        be[r] = ok ? e * ri : 0.f;
    }
    float G[4], ex[16], Gp[4], Tt[4], Suf[4];
#pragma unroll
    for (int a = 0; a < 4; ++a) {
        ex[4 * a + 3] = 1.f; ex[4 * a + 2] = rr[4 * a + 3]; ex[4 * a + 1] = ex[4 * a + 2] * rr[4 * a + 2]; ex[4 * a] = ex[4 * a + 1] * rr[4 * a + 1];
        G[a] = ex[4 * a] * rr[4 * a];
    }
#pragma unroll
    for (int a = 0; a < 4; ++a) { float lo_, hi_; swap32(G[a], lo_, hi_); Gp[a] = hi_; Tt[a] = lo_ * hi_; }
    Suf[3] = 1.f; Suf[2] = Tt[3]; Suf[1] = Tt[3] * Tt[2]; Suf[0] = Suf[1] * Tt[1];
    f32x16 pr;
#pragma unroll
    for (int a = 0; a < 4; ++a) {
        const float after = Suf[a] * (hi == 0 ? Gp[a] : 1.f) * C;
#pragma unroll
        for (int i = 0; i < 4; ++i) pr[4 * a + i] = be[4 * a + i] * ex[4 * a + i] * after;
    }
    C = C * (Suf[0] * Tt[0]);
    pv_accum2(o0, o1, pr, vf);
    PIN2(o0, o1); load_vfrag(vf, kv.vbase, next); MEM_FENCE();
}

DI void sb_unit(int b, int h, int qt, const bf16_t* Qs_, const bf16_t* Ks_, const bf16_t* VtS_, LAS unsigned char* ot, int lane) {
    const int r32 = lane & 31, hi = lane >> 5;
    const int q0 = qt * 32, tq = q0 + r32;
    const size_t bh = (size_t)(b * 8 + h);
    const bf16_t* qfb = Qs_ + bh * (64 * 2048) + (size_t)qt * 2048;
    KvStream kv; kv.kbase = Ks_ + bh * (64 * 2048) + lane * 8; kv.vbase = VtS_ + bh * (64 * 2048) + lane * 8;
    bf16x8 kf[4], vf[4];
    load_kfrag(kf, kv.kbase, qt); load_vfrag(vf, kv.vbase, qt);
    bf16x8 qf[4];
#pragma unroll
    for (int s = 0; s < 4; ++s) qf[s] = *(const bf16x8*)(qfb + s * 512 + lane * 8);
    f32x16 o0 = zero16(), o1 = zero16();
    float C = 1.f;
    vm_drain();
    for (int kt = qt; kt >= 0; --kt) {
        sb_tile(kf, vf, qf, kt, kt > 0 ? kt - 1 : 0, kv, tq, hi, C, o0, o1);
        if (__all(C == 0.f ? 1 : 0)) break;
    }
    store_o_lds(ot, r32, h, o0, o1, 1.f, hi);
}

DI void ce_desc(unsigned& a, unsigned& b) { const unsigned hi = a > b ? a : b, lo = a > b ? b : a; a = hi; b = lo; }
DI void bitonic_clean_desc(unsigned (&v)[16]) {
#pragma unroll
    for (int s = 8; s >= 1; s >>= 1)
#pragma unroll
        for (int i = 0; i < 16; ++i) if ((i & s) == 0) ce_desc(v[i], v[i + s]);
}
DI void sort16_desc(unsigned (&v)[16]) {
#pragma unroll
    for (int k = 2; k <= 16; k <<= 1)
#pragma unroll
        for (int j = k >> 1; j >= 1; j >>= 1)
#pragma unroll
            for (int i = 0; i < 16; ++i) { const int l = i ^ j; if (l > i) { if ((i & k) == 0) ce_desc(v[i], v[l]); else ce_desc(v[l], v[i]); } }
}
DI float key_value(unsigned key) { const unsigned kk = key & ~127u; const unsigned u = (kk & 0x80000000u) ? (kk & 0x7fffffffu) : ~kk; return __builtin_bit_cast(float, u); }
DI float key_value8(unsigned key) { const unsigned kk = key & ~255u; const unsigned u = (kk & 0x80000000u) ? (kk & 0x7fffffffu) : ~kk; return __builtin_bit_cast(float, u); }
template <int CTRL> DI unsigned dppu(unsigned v) { return (unsigned)__builtin_amdgcn_update_dpp(0, (int)v, CTRL, 0xF, 0xF, true); }
DI void sort8_desc(unsigned (&v)[8]) {
    ce_desc(v[0], v[2]); ce_desc(v[1], v[3]); ce_desc(v[4], v[6]); ce_desc(v[5], v[7]);
    ce_desc(v[0], v[4]); ce_desc(v[1], v[5]); ce_desc(v[2], v[6]); ce_desc(v[3], v[7]);
    ce_desc(v[0], v[1]); ce_desc(v[2], v[3]); ce_desc(v[4], v[5]); ce_desc(v[6], v[7]);
    ce_desc(v[2], v[4]); ce_desc(v[3], v[5]);
    ce_desc(v[1], v[4]); ce_desc(v[3], v[6]);
    ce_desc(v[1], v[2]); ce_desc(v[3], v[4]); ce_desc(v[5], v[6]);
}
DI void clean8_desc(unsigned (&v)[8]) {
#pragma unroll
    for (int s = 4; s >= 1; s >>= 1)
#pragma unroll
        for (int i = 0; i < 8; ++i) if ((i & s) == 0) ce_desc(v[i], v[i + s]);
}
template <int CTRL> DI void cross_rev_max(unsigned (&v)[8]) {
    unsigned t[8];
#pragma unroll
    for (int i = 0; i < 8; ++i) t[i] = dppu<CTRL>(v[7 - i]);
#pragma unroll
    for (int i = 0; i < 8; ++i) v[i] = v[i] > t[i] ? v[i] : t[i];
}
template <bool REV> DI void cross_minmax_x1(unsigned (&v)[8], bool odd) {
    unsigned t[8];
#pragma unroll
    for (int i = 0; i < 8; ++i) t[i] = dppu<DPP_XOR1>(v[REV ? 7 - i : i]);
#pragma unroll
    for (int i = 0; i < 8; ++i) { const unsigned hi = v[i] > t[i] ? v[i] : t[i], lo = v[i] > t[i] ? t[i] : v[i]; v[i] = odd ? lo : hi; }
}

DI float reduce16(const float (&p)[16], int lane) {
    const bool b3 = lane & 8, b2 = lane & 4, b1 = lane & 2, b0 = lane & 1;
    float q[8], r[4], s[2];
#pragma unroll
    for (int i = 0; i < 8; ++i) { const float mine = b3 ? p[i + 8] : p[i], send = b3 ? p[i] : p[i + 8]; q[i] = mine + __shfl_xor(send, 8); }
#pragma unroll
    for (int i = 0; i < 4; ++i) { const float mine = b2 ? q[i + 4] : q[i], send = b2 ? q[i] : q[i + 4]; r[i] = mine + __shfl_xor(send, 4); }
#pragma unroll
    for (int i = 0; i < 2; ++i) { const float mine = b1 ? r[i + 2] : r[i], send = b1 ? r[i] : r[i + 2]; s[i] = mine + __shfl_xor(send, 2); }
    const float mine = b0 ? s[1] : s[0], send = b0 ? s[0] : s[1];
    float t = mine + __shfl_xor(send, 1);
    t = sum_x32(sum_x16(t));
    return t;
}

#ifndef PEER_REP_TOPK
#define PEER_REP_TOPK 1
#endif
#ifndef PEER_REP_U
#define PEER_REP_U 1
#endif
#ifndef PEER_REP_V
#define PEER_REP_V 1
#endif
struct TopkIn { f32x4 hv[4]; bf16x8 sv[4]; };
DI void peer_topk_load(TopkIn& in, int tok, const float* out, const bf16_t* scores, int lane) {
    const int tc = tok < T ? tok : T - 1;
    const float* hrow = out + (size_t)tc * 1024 + 16 * lane;
    const bf16_t* sp = scores + (size_t)tc * 2048 + (lane >> 2) * 128 + (lane & 3) * 8;
#pragma unroll
    for (int i = 0; i < 4; ++i) { in.hv[i] = *(const f32x4*)(hrow + 4 * i); in.sv[i] = *(const bf16x8*)(sp + 32 * i); }
}
DI void peer_topk_token(int tok, const TopkIn& in, const float* gffn, int* EIDXg, float* GATEg, unsigned char* XN2g, LAS float* wl, int lane) {
    LAS unsigned* kbuf = (LAS unsigned*)wl; const LAS unsigned* ctab = (const LAS unsigned*)(wl + 768);
    f32x4 hv[4];
    float ss = 0.f;
#pragma unroll
    for (int i = 0; i < 4; ++i) { hv[i] = in.hv[i]; ss += (hv[i].x * hv[i].x + hv[i].y * hv[i].y) + (hv[i].z * hv[i].z + hv[i].w * hv[i].w); }
    ss = wave_sum(ss);
    const float rs2 = rsqrtf(ss * (1.f / 1024.f) + EPS);
    {
        u32x4 w;
#pragma unroll
        for (int i = 0; i < 4; ++i) { const f32x4 gv = *(const f32x4*)(gffn + 16 * lane + 4 * i);
            const float y0 = fminf(fmaxf(hv[i][0] * rs2 * gv[0] * 64.f, -448.f), 448.f), y1 = fminf(fmaxf(hv[i][1] * rs2 * gv[1] * 64.f, -448.f), 448.f);
            const float y2 = fminf(fmaxf(hv[i][2] * rs2 * gv[2] * 64.f, -448.f), 448.f), y3 = fminf(fmaxf(hv[i][3] * rs2 * gv[3] * 64.f, -448.f), 448.f);
            int p = 0;
            p = __builtin_amdgcn_cvt_pk_fp8_f32(y0, y1, p, false);
            p = __builtin_amdgcn_cvt_pk_fp8_f32(y2, y3, p, true);
            w[i] = (unsigned)p; }
        *(u32x4*)(XN2g + (size_t)tok * 1024 + 16 * lane) = w;
    }
    {
        const int L = lane >> 2, q = lane & 3;
        unsigned k0[16], k1[16];
#pragma unroll
        for (int i = 0; i < 4; ++i) {
            const bf16x8 v = in.sv[i];
#pragma unroll
            for (int cI = 0; cI < 8; ++cI) {
                const unsigned u = ((unsigned)(unsigned short)v[cI]) << 16;
                const unsigned mono = (u & 0x80000000u) ? ~u : (u | 0x80000000u);
                const unsigned key = (mono & ~127u) | (unsigned)(127 - (32 * i + 8 * q + cI));
                if (i < 2) k0[8 * i + cI] = key; else k1[8 * (i - 2) + cI] = key;
            }
        }
        sort16_desc(k0); sort16_desc(k1);
        unsigned t[16];
#pragma unroll
        for (int i = 0; i < 16; ++i) t[i] = k0[i] > k1[15 - i] ? k0[i] : k1[15 - i];
        bitonic_clean_desc(t);
#pragma unroll
        for (int i = 0; i < 16; ++i) k0[i] = (unsigned)__builtin_amdgcn_update_dpp(0, (int)t[15 - i], 0xB1, 0xF, 0xF, true);
#pragma unroll
        for (int i = 0; i < 16; ++i) t[i] = t[i] > k0[i] ? t[i] : k0[i];
        bitonic_clean_desc(t);
#pragma unroll
        for (int i = 0; i < 16; ++i) k0[i] = (unsigned)__builtin_amdgcn_update_dpp(0, (int)t[15 - i], 0x4E, 0xF, 0xF, true);
#pragma unroll
        for (int i = 0; i < 16; ++i) t[i] = t[i] > k0[i] ? t[i] : k0[i];
        bitonic_clean_desc(t);
        if (q == 0) {
#pragma unroll
            for (int i = 0; i < 4; ++i) { u32x4 w; w.x = t[4 * i]; w.y = t[4 * i + 1]; w.z = t[4 * i + 2]; w.w = t[4 * i + 3]; *(LAS u32x4*)(kbuf + L * 16 + 4 * i) = w; }
        }
        asm volatile("s_waitcnt lgkmcnt(0)" ::: "memory");
    }
    {
        const int hd = lane >> 3, sub = lane & 7; const bool odd = sub & 1;
        unsigned ck[8];
#pragma unroll
        for (int k = 0; k < 7; ++k) {
            const int cidx = 7 * sub + k;
            const unsigned tab = ctab[cidx];
            const unsigned ia = tab & 15u, ib = (tab >> 8) & 15u;
            const unsigned ka = kbuf[hd * 32 + ia], kb = kbuf[hd * 32 + 16 + ib];
            const float v = key_value(ka) + key_value(kb);
            const unsigned u = __float_as_uint(v);
            const unsigned mono = (u & 0x80000000u) ? ~u : (u | 0x80000000u);
            ck[k] = (cidx < 50) ? ((mono & ~255u) | (255u - (16u * ia + ib))) : 0u;
        }
        ck[7] = 0u;
        sort8_desc(ck);
        cross_minmax_x1<true>(ck, odd); clean8_desc(ck);
        cross_rev_max<0x1B>(ck); cross_minmax_x1<false>(ck, odd); clean8_desc(ck);
        cross_rev_max<DPP_HMIR>(ck); cross_minmax_x1<false>(ck, odd); clean8_desc(ck);
        const int pr = sub >> 1;
        const unsigned e0 = pr == 0 ? ck[0] : pr == 1 ? ck[2] : pr == 2 ? ck[4] : ck[6];
        const unsigned e1 = pr == 0 ? ck[1] : pr == 1 ? ck[3] : pr == 2 ? ck[5] : ck[7];
        const unsigned id0 = 255u - (e0 & 255u), id1 = 255u - (e1 & 255u);
        const unsigned ka0 = kbuf[hd * 32 + (id0 >> 4)], kb0 = kbuf[hd * 32 + 16 + (id0 & 15u)];
        const unsigned ka1 = kbuf[hd * 32 + (id1 >> 4)], kb1 = kbuf[hd * 32 + 16 + (id1 & 15u)];
        const float v0 = key_value8(e0), v1 = key_value8(e1);
        const float mx = max_oct(fmaxf(v0, v1));
        const float ev0 = __expf((v0 - mx) * rs2), ev1 = __expf((v1 - mx) * rs2);
        const float inv = 1.f / sum_oct(ev0 + ev1);
        const int rank0 = (odd ? 8 : 0) + 2 * pr;
        u32x2 ew; ew.x = (127u - (ka0 & 127u)) * 128u + (127u - (kb0 & 127u)); ew.y = (127u - (ka1 & 127u)) * 128u + (127u - (kb1 & 127u));
        f32x2 gw; gw.x = ev0 * inv; gw.y = ev1 * inv;
        *(u32x2*)(EIDXg + (size_t)tok * 128 + hd * 16 + rank0) = ew;
        *(f32x2*)(GATEg + (size_t)tok * 128 + hd * 16 + rank0) = gw;
    }
}

DI float dot16_fp8(const u32x4& row, const float (&x)[16]) {
    float sacc = 0.f;
#pragma unroll
    for (int w = 0; w < 4; ++w) { const f32x2 lo = __builtin_amdgcn_cvt_pk_f32_fp8((int)row[w], false), hi2 = __builtin_amdgcn_cvt_pk_f32_fp8((int)row[w], true);
        sacc += lo.x * x[4 * w] + lo.y * x[4 * w + 1] + hi2.x * x[4 * w + 2] + hi2.y * x[4 * w + 3]; }
    return sacc;
}
template <class TT> DI TT ldu(const void* ubase, unsigned off) { return *(const TT*)((const char*)ubase + off); }
typedef _Float16 h2_t __attribute__((ext_vector_type(2)));
DI void peer_u_slice(int sl, int tk_first, int tk_step, const unsigned char* XN8g, const int* EIDXg, const unsigned char* U8s, float* PDOT, int lane) {
    const int es = lane >> 3, c = lane & 7;
    const unsigned char* tb = U8s + (size_t)sl * 16384 * 128;
    const unsigned c16 = 16u * c, eoff = 64u * es, xoff = 128u * sl + 16u * c, poff = (16u * es + c) * 4u;
    const bool b2 = c & 4, b1 = c & 2, b0 = c & 1;
    u32x4 I0[2], I1[2], I2[2], rowsA[8], rowsB[8], rowsC[8], x0, x1, x2;
#define LD_E8(ib, tk, h) do { const int _t = (tk) < T ? (tk) : T - 1; const int* _eb = EIDXg + (size_t)_t * 128 + 8 * (h); ib[0] = ldu<u32x4>(_eb, eoff); ib[1] = ldu<u32x4>(_eb, eoff + 16u); } while (0)
#define LD_R8(rows, ib, tbl) do { _Pragma("unroll") for (int _q = 0; _q < 2; ++_q) _Pragma("unroll") for (int _r = 0; _r < 4; ++_r) rows[4 * _q + _r] = ldu<u32x4>(tbl, ib[_q][_r] * 128u + c16); } while (0)
#define LD_X(xx, tk) do { const int _t = (tk) < T ? (tk) : T - 1; xx = ldu<u32x4>(XN8g + (size_t)_t * 1024, xoff); } while (0)
#define U_COMPUTE8(rows, xx, tk, h) do { h2_t _x[8]; _Pragma("unroll") for (int _w = 0; _w < 4; ++_w) { _x[2 * _w] = __builtin_amdgcn_cvt_scalef32_pk_f16_fp8(xx[_w], 1.0f, false); _x[2 * _w + 1] = __builtin_amdgcn_cvt_scalef32_pk_f16_fp8(xx[_w], 1.0f, true); } \
        float _p[8]; _Pragma("unroll") for (int _i = 0; _i < 8; ++_i) { if (_i > 0) asm volatile("" : "+v"(rows[_i]) : "v"(_p[_i - 1])); float _s = 0.f; \
            _Pragma("unroll") for (int _w = 0; _w < 4; ++_w) { _s = __builtin_amdgcn_fdot2(__builtin_amdgcn_cvt_scalef32_pk_f16_fp8(rows[_i][_w], 1.0f, false), _x[2 * _w], _s, false); \
                _s = __builtin_amdgcn_fdot2(__builtin_amdgcn_cvt_scalef32_pk_f16_fp8(rows[_i][_w], 1.0f, true), _x[2 * _w + 1], _s, false); } _p[_i] = _s; } \
        float _q4[4], _q2[2]; \
        _Pragma("unroll") for (int _k = 0; _k < 4; ++_k) _q4[_k] = tr_x4(_p[_k], _p[_k + 4], b2); \
        _Pragma("unroll") for (int _k = 0; _k < 2; ++_k) _q2[_k] = tr_x2(_q4[_k], _q4[_k + 2], b1); \
        const float _r1 = tr_x1(_q2[0], _q2[1], b0); \
        if ((tk) < T) { float* _pb = PDOT + ((size_t)sl * T + (tk)) * 128 + 8 * (h); *(float*)((char*)_pb + poff) = _r1; } } while (0)
    int t0 = tk_first;
    LD_E8(I0, t0, 0); LD_E8(I1, t0, 1); LD_E8(I2, t0 + tk_step, 0); LD_X(x0, t0); LD_R8(rowsA, I0, tb); LD_R8(rowsB, I1, tb);
#pragma unroll 1
    for (; t0 < T; t0 += 3 * tk_step) {
        const int t1 = t0 + tk_step, t2 = t1 + tk_step, t3 = t2 + tk_step;
        LD_E8(I0, t1, 1);           LD_R8(rowsC, I2, tb); LD_X(x1, t1); U_COMPUTE8(rowsA, x0, t0, 0);
        LD_E8(I1, t2, 0);           LD_R8(rowsA, I0, tb);               U_COMPUTE8(rowsB, x0, t0, 1);
        LD_E8(I2, t2, 1);           LD_R8(rowsB, I1, tb); LD_X(x2, t2); U_COMPUTE8(rowsC, x1, t1, 0);
        LD_E8(I0, t3, 0);           LD_R8(rowsC, I2, tb);               U_COMPUTE8(rowsA, x1, t1, 1);
        LD_E8(I1, t3, 1);           LD_R8(rowsA, I0, tb); LD_X(x0, t3); U_COMPUTE8(rowsB, x2, t2, 0);
        LD_E8(I2, t3 + tk_step, 0); LD_R8(rowsB, I1, tb);               U_COMPUTE8(rowsC, x2, t2, 1);
    }
#undef U_COMPUTE8
#undef LD_X
}
template <int NT> DI void peer_cj_tokens(int tok0, int tstride, const int* EIDXg, const float* GATEg, const float* PDOT, const float* usc, const float* vsc, float* CJg, float* CMAXg, int lane) {
    int e[NT][2]; float d[NT][2], g[NT][2];
#pragma unroll
    for (int i = 0; i < NT; ++i) { const int tok = tok0 + i * tstride, tc = tok < T ? tok : T - 1;
#pragma unroll
        for (int hh = 0; hh < 2; ++hh) { const int j = lane + 64 * hh; e[i][hh] = EIDXg[(size_t)tc * 128 + j]; g[i][hh] = GATEg[(size_t)tc * 128 + j]; float a = 0.f;
#pragma unroll
            for (int x = 0; x < 8; ++x) a += PDOT[((size_t)x * T + tc) * 128 + j];
            d[i][hh] = a; } }
    float us[NT][2], vs[NT][2];
#pragma unroll
    for (int i = 0; i < NT; ++i)
#pragma unroll
        for (int hh = 0; hh < 2; ++hh) { us[i][hh] = usc[e[i][hh]]; vs[i][hh] = vsc[e[i][hh]]; }
#pragma unroll
    for (int i = 0; i < NT; ++i) { const int tok = tok0 + i * tstride;
        float cv[2], cm = 0.f;
#pragma unroll
        for (int hh = 0; hh < 2; ++hh) {
            const float hraw = d[i][hh] * us[i][hh] * (1.f / 64.f);
            const float hid = 0.5f * hraw * (1.f + erff(hraw * 0.70710678118654752f));
            cv[hh] = hid * g[i][hh] * vs[i][hh];
            cm = fmaxf(cm, fabsf(cv[hh]));
        }
        cm = wave_max(cm);
        const float inv = cm > 0.f ? 1.f / cm : 0.f;
        if (tok < T) { CJg[(size_t)tok * 128 + lane] = cv[0] * inv; CJg[(size_t)tok * 128 + 64 + lane] = cv[1] * inv; if (lane == 0) CMAXg[tok] = cm; }
    }
}
DI void peer_v_slice(int sl, int tk_first, int tk_step, float* out, const int* EIDXg, const float* CJg, const float* CMAXg, const unsigned char* V8s, bf16_t* A4g, float* SSQg, int lane) {
    const int es = lane >> 3, c = lane & 7;
    const unsigned char* tb = V8s + (size_t)sl * 16384 * 128;
    const unsigned c16 = 16u * c, eoff = 64u * es, ob = 128u * sl + 16u * c + 2u * es;
    const bool b5 = lane & 32, b4 = lane & 16, b3 = lane & 8;
    u32x4 I0[2], I1[2], I2[2], rowsA[8], rowsB[8], rowsC[8]; f32x4 cA[2], cB[2], cC[2]; f32x2 h0, h1, h2;
#define LD_C8(cc, tk, h) do { const int _t = (tk) < T ? (tk) : T - 1; const float* _cb = CJg + (size_t)_t * 128 + 8 * (h); cc[0] = ldu<f32x4>(_cb, eoff); cc[1] = ldu<f32x4>(_cb, eoff + 16u); } while (0)
#define V_AXPY8(rows, cc) do { _Pragma("unroll") for (int _q = 0; _q < 2; ++_q) _Pragma("unroll") for (int _r = 0; _r < 4; ++_r) { const _Float16 _ch = (_Float16)cc[_q][_r]; const h2_t _c2 = {_ch, _ch}; \
            _Pragma("unroll") for (int _w = 0; _w < 4; ++_w) { acch[2 * _w] = __builtin_amdgcn_cvt_scalef32_pk_f16_fp8(rows[4 * _q + _r][_w], 1.0f, false) * _c2 + acch[2 * _w]; \
                acch[2 * _w + 1] = __builtin_amdgcn_cvt_scalef32_pk_f16_fp8(rows[4 * _q + _r][_w], 1.0f, true) * _c2 + acch[2 * _w + 1]; } \
              \
            if (4 * _q + _r < 7) asm volatile("" : "+v"(acch[0]), "+v"(acch[1]), "+v"(acch[2]), "+v"(acch[3]), "+v"(acch[4]), "+v"(acch[5]), "+v"(acch[6]), "+v"(acch[7]), "+v"(rows[(4 * _q + _r + 1) & 7])); \
            else asm volatile("" : "+v"(acch[0]), "+v"(acch[1]), "+v"(acch[2]), "+v"(acch[3]), "+v"(acch[4]), "+v"(acch[5]), "+v"(acch[6]), "+v"(acch[7])); } } while (0)
#define LD_H(hh, tk) do { const int _t = (tk) < T ? (tk) : T - 1; hh = ldu<f32x2>(out + (size_t)_t * 1024, ob * 4u); } while (0)
#define V_ZERO() do { _Pragma("unroll") for (int _i = 0; _i < 8; ++_i) acch[_i] = (h2_t){(_Float16)0.f, (_Float16)0.f}; } while (0)
#define V_FINAL(hh, tk) do { float _a[16]; _Pragma("unroll") for (int _i = 0; _i < 8; ++_i) { _a[2 * _i] = (float)acch[_i].x; _a[2 * _i + 1] = (float)acch[_i].y; } \
        const float _cm = CMAXg[(tk) < T ? (tk) : T - 1]; \
        float _q8[8], _q4[4], _q2[2]; \
        _Pragma("unroll") for (int _k = 0; _k < 8; ++_k) _q8[_k] = tr_x32(_a[_k], _a[_k + 8]); \
        _Pragma("unroll") for (int _k = 0; _k < 4; ++_k) _q4[_k] = tr_x16(_q8[_k], _q8[_k + 4]); \
        _Pragma("unroll") for (int _k = 0; _k < 2; ++_k) _q2[_k] = tr_x8(_q4[_k], _q4[_k + 2], b3); \
        const float _ha = hh.x + _q2[0] * _cm, _hb = hh.y + _q2[1] * _cm; const float _ssq = wave_sum(_ha * _ha + _hb * _hb); \
        if ((tk) < T) { *(f32x2*)((char*)(out + (size_t)(tk) * 1024) + ob * 4u) = (f32x2){_ha, _hb}; *(unsigned*)((char*)(A4g + (size_t)(tk) * 1024) + ob * 2u) = cvtpk(_ha, _hb); \
            if (lane == 0) SSQg[(size_t)sl * T + (tk)] = _ssq; } } while (0)
    h2_t acch[8];
    int t0 = tk_first;
    LD_E8(I0, t0, 0); LD_E8(I1, t0, 1); LD_E8(I2, t0 + tk_step, 0); LD_H(h0, t0); LD_R8(rowsA, I0, tb); LD_C8(cA, t0, 0); LD_R8(rowsB, I1, tb); LD_C8(cB, t0, 1);
#pragma unroll 1
    for (; t0 < T; t0 += 3 * tk_step) {
        const int t1 = t0 + tk_step, t2 = t1 + tk_step, t3 = t2 + tk_step;
        LD_E8(I0, t1, 1);           LD_R8(rowsC, I2, tb); LD_C8(cC, t1, 0); LD_H(h1, t1); V_ZERO(); V_AXPY8(rowsA, cA);
        LD_E8(I1, t2, 0);           LD_R8(rowsA, I0, tb); LD_C8(cA, t1, 1);                          V_AXPY8(rowsB, cB); V_FINAL(h0, t0);
        LD_E8(I2, t2, 1);           LD_R8(rowsB, I1, tb); LD_C8(cB, t2, 0); LD_H(h2, t2); V_ZERO(); V_AXPY8(rowsC, cC);
        LD_E8(I0, t3, 0);           LD_R8(rowsC, I2, tb); LD_C8(cC, t2, 1);                          V_AXPY8(rowsA, cA); V_FINAL(h1, t1);
        LD_E8(I1, t3, 1);           LD_R8(rowsA, I0, tb); LD_C8(cA, t3, 0); LD_H(h0, t3); V_ZERO(); V_AXPY8(rowsB, cB);
        LD_E8(I2, t3 + tk_step, 0); LD_R8(rowsB, I1, tb); LD_C8(cB, t3, 1);                          V_AXPY8(rowsC, cC); V_FINAL(h2, t2);
    }
#undef V_FINAL
#undef V_ZERO
#undef LD_H
#undef V_AXPY8
#undef LD_C8
#undef LD_R8
#undef LD_E8
}

typedef const __attribute__((address_space(4))) unsigned long long* karg_ptr_t;
DI karg_ptr_t kargs() { karg_ptr_t p = (karg_ptr_t)__builtin_amdgcn_kernarg_segment_ptr(); asm volatile("" : "+s"(p)); return p; }
#define GAS1 __attribute__((address_space(1)))
#define KIN(k) ((const float*)(const GAS1 float*)kargs()[k])
#define KOUT() ((float*)(GAS1 float*)kargs()[18])
#define KWS() ((unsigned char*)(GAS1 unsigned char*)kargs()[19])

__global__ void __launch_bounds__(512, 2) fwd_kernel(Params P) {
    extern __shared__ __attribute__((aligned(16))) unsigned char lds_raw[];
    LAS unsigned char* lds = (LAS unsigned char*)lds_raw;
    const int tid = threadIdx.x, lane = tid & 63, wid = __builtin_amdgcn_readfirstlane(tid >> 6);
    const int wg = blockIdx.x, nwg = gridDim.x;
    const int gwave = wg * 8 + wid, nwaves = nwg * 8;
    const int lo = P.ph_lo, hi = P.ph_hi;

    volatile LAS unsigned* misc = (volatile LAS unsigned*)(lds + LDS_BYTES - 64);
    if (tid < 16) misc[tid] = 0u;
    __syncthreads();
    { unsigned* xcw = (unsigned*)(KWS() + WS_CTL) + CW_XC;
      if (tid == 0) { const unsigned xcc = xb_xcc_id(); misc[5] = xcc; misc[4] = xb_add(xcw + 64 * xcc, 1u); } }
    XcdBarrier bar; bar.bar = (unsigned*)(KWS() + WS_CTL) + CW_BAR; bar.x = 0; bar.st = misc;
    if (hi - lo > 1) bar = xcd_barrier_post((unsigned*)(KWS() + WS_CTL) + CW_BAR, misc);

#define kmean   ((float*)(KWS() + WS_KMEAN))
#define biasTab ((float*)(KWS() + WS_BIAS))
#define WinT    ((bf16_t*)(KWS() + WS_WIN))
#define WoutT   ((bf16_t*)(KWS() + WS_WOUT))
#define WqT     ((bf16_t*)(KWS() + WS_WQ))
#define WgT     ((bf16_t*)(KWS() + WS_WG))
#define WpleT   ((bf16_t*)(KWS() + WS_WPLE))
#define U8      ((unsigned char*)(KWS() + WS_U))
#define V8      ((unsigned char*)(KWS() + WS_V))
#define USC     ((float*)(KWS() + WS_USC))
#define VSC     ((float*)(KWS() + WS_VSC))
#define XN      ((bf16_t*)(KWS() + WS_XN))
#define PB      ((bf16_t*)(KWS() + WS_PB))
#define Qm      ((bf16_t*)(KWS() + WS_QM))
#define Km      ((bf16_t*)(KWS() + WS_KM))
#define VtM     ((bf16_t*)(KWS() + WS_VTM))
#define Qs      ((bf16_t*)(KWS() + WS_QS))
#define Ks      ((bf16_t*)(KWS() + WS_KS))
#define VtS     ((bf16_t*)(KWS() + WS_VTS))
#define Oraw    ((bf16_t*)(KWS() + WS_ORAW))
#define A2      ((bf16_t*)(KWS() + WS_A2))
#define A3      ((bf16_t*)(KWS() + WS_A3))
#define SC      ((float*)(KWS() + WS_SC))
#define EIDXG   ((int*)(KWS() + WS_EIDX))
#define GATEG   ((float*)(KWS() + WS_GATE))
#define CJG     ((float*)(KWS() + WS_CJ))
#define RS2G    ((float*)(KWS() + WS_RS2))
#define SSQG    ((float*)(KWS() + WS_SSQ))
#define PDOTG   ((float*)(KWS() + WS_PDOT))
#define A4G     ((bf16_t*)(KWS() + WS_A4))
#define XN2G    ((unsigned char*)(KWS() + WS_XN2))

#define IN(k) (lo <= (k) && (k) < hi)
#ifndef PROBE_PHASE
#define PROBE_PHASE -1
#endif
#ifndef PROBE_REPS
#define PROBE_REPS 1
#endif
#define REP(k) for (int _rep = 0; _rep < ((k) == PROBE_PHASE ? PROBE_REPS : 1); ++_rep)
#define SEAM(k) do { if (IN(k) && IN((k) + 1)) xcd_barrier(bar); } while (0)

    if (IN(0)) REP(0) {
        LAS float* scr = (LAS float*)lds;
        p0_transpose<true>(KIN(IN_WIN), 1024, 3072, WinT, scr, tid, wg, nwg);
        p0_transpose<false>(KIN(IN_WOUT), 1024, 1024, WoutT, scr, tid, wg, nwg);
        p0_transpose<false>(KIN(IN_WPG), 1024, 1024, WgT, scr, tid, wg, nwg, KIN(IN_PLE_NORM));
        p0_transpose<false>(KIN(IN_WPLE), 256, 1024, WpleT, scr, tid, wg, nwg);
        p0_fold(KIN(IN_PQ), KIN(IN_SUBK), KIN(IN_FFN_NORM), WqT, scr, tid, wg, nwg);
        const size_t gtid = (size_t)wg * 512 + tid, nthr = (size_t)nwg * 512;
        p0_convert(KIN(IN_P), PB, (size_t)T * 256, gtid, nthr);
        { const float* xp = KIN(IN_X); const float* gp = KIN(IN_ATTN_NORM); bf16_t* xo = XN;
          for (int row = gwave; row < T; row += 2 * nwaves) rmsnorm_rows2_bf16(xp, gp, xo, row, row + nwaves, lane); }
        if (wg == 0) {
            for (int idx = tid; idx < 8 * 129; idx += 512) {
                const int h = idx / 129, dist = idx % 129;
                int bk;
                if (dist < 16) bk = dist;
                else { const float v = logf((float)dist / 16.f) / 2.0794415416798357f * 16.f; bk = 16 + (int)v; bk = bk > 31 ? 31 : bk; }
                biasTab[h * 132 + dist] = KIN(IN_RELB)[bk * 8 + h] * LOG2E;
            }
        }
    }
    SEAM(0);
    if (IN(1)) REP(1) {
        pg8::Gemm g{XN, WinT, T, NPROJ, 1024}; pg8::StaticOrder S; S.init(T, NPROJ, nwg, wg);
        EpiQKV E{Qm, KIN(IN_QNORM), KIN(IN_KNORM)};
        pg8::gemm_phase<EpiQKV, pg8::StaticOrder, true, true>(lds, g, S, E);
    }
    SEAM(1);
    if (IN(2)) REP(2) {
        for (int item = gwave; item < 512; item += nwaves) {
            const int bhh = item >> 3, blk = item & 7;
            float sacc[4][8];
#pragma unroll
            for (int q = 0; q < 4; ++q)
#pragma unroll
                for (int j = 0; j < 8; ++j) sacc[q][j] = 0.f;
            const bf16_t* base = Km + ((size_t)bhh * 64 + blk * 8) * 2048 + lane * 8;
#pragma unroll 2
            for (int t8 = 0; t8 < 8; ++t8)
#pragma unroll
                for (int q = 0; q < 4; ++q) { const bf16x8 v = *(const bf16x8*)(base + (size_t)t8 * 2048 + q * 512);
#pragma unroll
                    for (int j = 0; j < 8; ++j) sacc[q][j] += bf2f(v[j]); }
#pragma unroll
            for (int q = 0; q < 4; ++q)
#pragma unroll
                for (int j = 0; j < 8; ++j) { float v = sacc[q][j];
                    sacc[q][j] = sum_x16(sum_row16(v)); }
            if ((lane & 31) == 0) {
                const int hh = lane >> 5;
#pragma unroll
                for (int q = 0; q < 4; ++q)
#pragma unroll
                    for (int j = 0; j < 8; ++j) kmean[(size_t)item * 64 + 16 * q + 8 * hh + j] = sacc[q][j] * (1.f / 256.f);
            }
        }
    }
    SEAM(2);
    if (IN(3)) REP(3) {
        const float* pu = KIN(IN_PU); const float* pv = KIN(IN_PV); unsigned char* u8 = U8; unsigned char* v8 = V8; float* usc_ = USC; float* vsc_ = VSC;
        const bf16_t* qm_ = Qm; const bf16_t* km_ = Km; const bf16_t* vtm_ = VtM; const bf16_t* qs_ = Qs; const bf16_t* ks_ = Ks; const bf16_t* vts_ = VtS;
        const float* kmn_ = kmean; const float* bt_ = biasTab; bf16_t* a2_ = A2;
        const float* gm_ = KIN(IN_ONM); const float* gs_ = KIN(IN_ONS);
        LAS unsigned char* ot = lds;
        LAS float* biasLds = (LAS float*)(lds + 34816);
        for (int i = tid; i < 8 * 132; i += 512) biasLds[i] = bt_[i];
        __syncthreads();
        int qrow = gwave;
        for (int u = gwave; u < 8192; u += nwaves) {
            const int grp = u >> 12, i = u & 4095;
            const int half = i >> 11, j = i & 2047;
            const int qt = half ? (j >> 6) : 63 - (j >> 6), bh = j & 63;
            const int b = bh >> 3, h = bh & 7;
            if (grp == 0) moba_unit(b, h, qt, qm_, km_, vtm_, kmn_, biasLds, ot, lane);
            else sb_unit(b, h, qt, qs_, ks_, vts_, ot, lane);
            __syncthreads();
            {
                const float* gg = grp ? gs_ : gm_;
                const f32x4 g0 = *(const f32x4*)(gg + 8 * lane), g1 = *(const f32x4*)(gg + 8 * lane + 4);
#pragma unroll
                for (int rr = 0; rr < 4; ++rr) {
                    const int row = 4 * wid + rr;
                    const bf16x8 v = *(const LAS bf16x8*)(ot + row * OT_PITCH + lane * 16);
                    float f[8], sq = 0.f;
#pragma unroll
                    for (int e = 0; e < 8; ++e) { f[e] = bf2f(v[e]); sq += f[e] * f[e]; }
                    sq = wave_sum(sq);
                    const float rs = rsqrtf(sq * (1.f / 512.f) + EPS);
                    u32x4 w; w.x = cvtpk(f[0] * rs * g0.x, f[1] * rs * g0.y); w.y = cvtpk(f[2] * rs * g0.z, f[3] * rs * g0.w);
                    w.z = cvtpk(f[4] * rs * g1.x, f[5] * rs * g1.y); w.w = cvtpk(f[6] * rs * g1.z, f[7] * rs * g1.w);
                    *(u32x4*)(a2_ + (size_t)(b * 2048 + qt * 32 + row) * 1024 + grp * 512 + 8 * lane) = w;
                }
            }
            __syncthreads();
            for (int k = 0; k < 1 && qrow < 16384; ++k, qrow += 2 * nwaves) p0_quant_rows4(pu, pv, u8, v8, usc_, vsc_, qrow, qrow + nwaves, lane);
        }
        for (; qrow < 16384; qrow += 2 * nwaves) p0_quant_rows4(pu, pv, u8, v8, usc_, vsc_, qrow, qrow + nwaves, lane);
    }
    SEAM(3);
    if (IN(5)) REP(5) {
        pg8::Gemm g{A2, WoutT, T, 1024, 1024}; pg8::StaticOrder S; S.init(T, 1024, nwg, wg);
        EpiRes E{KIN(IN_X), KOUT(), A3};
        pg8::gemm_phase<EpiRes, pg8::StaticOrder, true, true>(lds, g, S, E);
    }
    SEAM(5);
    if (IN(6)) REP(6) {
        pg8::Gemm g{A3, WqT, T, 2048, 1024}; pg8::StaticOrder S; S.init(T, 2048, nwg, wg);
        EpiBf E{(bf16_t*)SC, 2048};
        pg8::gemm_phase<EpiBf, pg8::StaticOrder, true, true>(lds, g, S, E);
    }
    SEAM(6);
    if (IN(7)) REP(7) {
        LAS float* wl = (LAS float*)(lds + wid * 4096);
        {
            const int c = lane; int ca, cb;
            if (c < 16) { ca = 0; cb = c; } else if (c < 24) { ca = 1; cb = c - 16; } else if (c < 29) { ca = 2; cb = c - 24; } else if (c < 33) { ca = 3; cb = c - 29; }
            else if (c < 36) { ca = 4; cb = c - 33; } else if (c < 42) { ca = 5 + ((c - 36) >> 1); cb = (c - 36) & 1; } else { ca = (c - 34) & 15; cb = 0; }
            ((LAS unsigned*)(wl + 768))[lane] = (unsigned)ca | ((unsigned)cb << 8);
            asm volatile("s_waitcnt lgkmcnt(0)" ::: "memory");
        }
        const float* h1p = KOUT(); const bf16_t* scp = (const bf16_t*)SC; const float* gfp = KIN(IN_FFN_NORM); int* eip = EIDXG; float* gtp = GATEG; unsigned char* xnp = XN2G;
        TopkIn inA, inB;
        peer_topk_load(inA, gwave, h1p, scp, lane);
        for (int tok = gwave; tok < T; tok += 2 * nwaves) {
            peer_topk_load(inB, tok + nwaves, h1p, scp, lane);
            peer_topk_token(tok, inA, gfp, eip, gtp, xnp, wl, lane);
            peer_topk_load(inA, tok + 2 * nwaves, h1p, scp, lane);
            if (tok + nwaves < T) peer_topk_token(tok + nwaves, inB, gfp, eip, gtp, xnp, wl, lane);
        }
    }
    SEAM(7);
    int sl_first = 0, sl_step = 1, tk_first = 0, tk_step = 8;
    if (IN(8) || IN(10)) {
        __syncthreads();
        const unsigned myx = misc[5], myrank = misc[4];
        unsigned nx = 0, myidx = 0, nloc = 1;
        unsigned* xc = (unsigned*)(KWS() + WS_CTL) + CW_XC;
#pragma unroll
        for (unsigned j = 0; j < 16; ++j) { const unsigned cj = xb_ld(xc + 64 * j); if (cj > 0u) { if (j < myx) ++myidx; ++nx; } if (j == myx) nloc = cj; }
        sl_first = __builtin_amdgcn_readfirstlane((int)myidx); sl_step = __builtin_amdgcn_readfirstlane((int)(nx > 0u ? nx : 1u));
        tk_first = __builtin_amdgcn_readfirstlane((int)myrank * 8 + wid); tk_step = __builtin_amdgcn_readfirstlane((int)(nloc > 0u ? nloc : 1u) * 8);
    }
    if (IN(8)) REP(8) {
        const unsigned char* xnp = XN2G; const int* eip = EIDXG; const unsigned char* u8p = U8; float* pdp = PDOTG;
        for (int sl = sl_first; sl < 8; sl += sl_step) peer_u_slice(sl, tk_first, tk_step, xnp, eip, u8p, pdp, lane);
    }
    SEAM(8);
    if (IN(9)) REP(9) {
        const int* eip = EIDXG; const float* gtp = GATEG; const float* pdp = PDOTG; const float* usp = USC; const float* vsp = VSC; float* cjp = CJG; float* cmp_ = RS2G;
        for (int tok = gwave; tok < T; tok += 4 * nwaves) peer_cj_tokens<4>(tok, nwaves, eip, gtp, pdp, usp, vsp, cjp, cmp_, lane);
    }
    SEAM(9);
    if (IN(10)) REP(10) {
        float* outp = KOUT(); const int* eip = EIDXG; const float* cjp = CJG; const float* cmp_ = RS2G; const unsigned char* v8p = V8; bf16_t* a4p = A4G; float* sqp = SSQG;
        for (int sl = sl_first; sl < 8; sl += sl_step) peer_v_slice(sl, tk_first, tk_step, outp, eip, cjp, cmp_, v8p, a4p, sqp, lane);
    }
    SEAM(10);
    if (IN(11)) REP(11) {
        bf16_t* PW = Oraw;
        { int kple = 256; asm volatile("" : "+s"(kple));
          pg8::Gemm g{PB, WpleT, T, 1024, kple}; pg8::StaticOrder S; S.init(T, 1024, nwg, wg);
          EpiBf E{PW, 1024};
          pg8::gemm_phase<EpiBf, pg8::StaticOrder, true, true>(lds, g, S, E); }
        asm volatile("s_waitcnt vmcnt(0)" ::: "memory");
        __syncthreads();
        { pg8::Gemm g{A4G, WgT, T, 1024, 1024}; pg8::StaticOrder S; S.init(T, 1024, nwg, wg);
          EpiGate E{KOUT(), PW, SSQG};
          pg8::gemm_phase<EpiGate, pg8::StaticOrder, true, true>(lds, g, S, E); }
    }
#undef IN
#undef SEAM
}

extern "C" void kernel_launch(void* const* d_in, const int* in_sizes, int n_in, void* d_out, int out_size, void* d_ws, size_t ws_size, hipStream_t stream) {
    static int grid = 0;
    if (grid == 0) {
        if (n_in != 18 || out_size != T * DM || ws_size < WS_END) { fprintf(stderr, "kernel_launch: unexpected shapes (n_in %d out %d ws %zu)\n", n_in, out_size, ws_size); grid = -1; return; }
        int dev = 0, cus = 0, per_cu = 0;
        if (hipGetDevice(&dev) != hipSuccess || hipDeviceGetAttribute(&cus, hipDeviceAttributeMultiprocessorCount, dev) != hipSuccess) { grid = -1; return; }
        if (hipFuncSetAttribute((const void*)fwd_kernel, hipFuncAttributeMaxDynamicSharedMemorySize, LDS_BYTES) != hipSuccess) { fprintf(stderr, "kernel_launch: hipFuncSetAttribute failed\n"); grid = -1; return; }
        if (hipOccupancyMaxActiveBlocksPerMultiprocessor(&per_cu, (const void*)fwd_kernel, 512, LDS_BYTES) != hipSuccess || per_cu < 1)
            fprintf(stderr, "kernel_launch: note: occupancy query reports %d\n", per_cu);
        (void)hipGetLastError();
        grid = cus - (cus % 8);
    }
    if (grid < 0) return;
    if (hipMemsetAsync((char*)d_ws + WS_CTL, 0, CTL_ZERO_BYTES, stream) != hipSuccess) return;
    Params p{};
    for (int i = 0; i < 18; ++i) p.in[i] = (const float*)d_in[i];
    p.out = (float*)d_out; p.ws = (unsigned char*)d_ws;
    p.ph_lo = 0; p.ph_hi = NPHASE;
    hipLaunchKernelGGL(fwd_kernel, dim3(grid), dim3(512), LDS_BYTES, stream, p);
}
```

```cpp
#include <hip/hip_runtime.h>
#include <stdint.h>
#include <stdio.h>

#ifndef N_LAUNCHES
#define N_LAUNCHES 1
#endif

#define DI __device__ __forceinline__
#define LAS __attribute__((address_space(3)))

typedef unsigned short bf16_t;
typedef short bf16x8 __attribute__((ext_vector_type(8)));
typedef float f32x16 __attribute__((ext_vector_type(16)));
typedef float f32x4 __attribute__((ext_vector_type(4)));
typedef float f32x2 __attribute__((ext_vector_type(2)));
typedef unsigned u32x4 __attribute__((ext_vector_type(4)));
typedef unsigned u32x2 __attribute__((ext_vector_type(2)));
typedef __bf16 bf16x2_t __attribute__((ext_vector_type(2)));

constexpr int BATCH = 8, SEQ = 2048, DM = 1024, T = BATCH * SEQ;
constexpr int NPROJ = 3072;
constexpr float EPS = 1e-6f;
constexpr float LOG2E = 1.4426950408889634f;
constexpr float SCL2 = 0.125f * LOG2E;
constexpr int NPHASE = 12;

constexpr size_t MiB = 1u << 20;
constexpr size_t WS_CTL = 0, CTL_ZERO_BYTES = 65536;
constexpr size_t WS_KMEAN = 256 * 1024;
constexpr size_t WS_BIAS = 512 * 1024;
constexpr size_t WS_WIN = 1 * MiB, WS_WOUT = 7 * MiB, WS_WQ = 9 * MiB, WS_WG = 13 * MiB, WS_WPLE = 15 * MiB;
constexpr size_t WS_U = 16 * MiB, WS_V = 32 * MiB;
constexpr size_t WS_USC = 640 * 1024, WS_VSC = 704 * 1024;
constexpr size_t WS_XN2 = 48 * MiB;
constexpr size_t WS_XN = 80 * MiB;
constexpr size_t WS_PB = 112 * MiB;
constexpr size_t WS_QM = 120 * MiB, WS_KM = 136 * MiB, WS_VTM = 152 * MiB, WS_QS = 168 * MiB, WS_KS = 184 * MiB, WS_VTS = 200 * MiB;
constexpr size_t WS_ORAW = 216 * MiB;
constexpr size_t WS_A2 = 80 * MiB;
constexpr size_t WS_A3 = 120 * MiB;
constexpr size_t WS_SC = 152 * MiB;
constexpr size_t WS_EIDX = 80 * MiB, WS_GATE = 88 * MiB, WS_CJ = 96 * MiB, WS_RS2 = 104 * MiB, WS_SSQ = 105 * MiB;
constexpr size_t WS_PDOT = 120 * MiB;
constexpr size_t WS_A4 = 184 * MiB;
constexpr size_t WS_END = 248 * MiB;

constexpr int CW_XC = 8192;
constexpr int CW_BAR = 4096;

constexpr int LDS_BYTES = 147456;

#define XB_TMO      128
#define XB_XCNT(j)  (256  + 64 * (j))
#define XB_XSUB(j)  (1280 + 64 * (j))
#define XB_XGEN(j)  (2304 + 64 * (j))
#define XB_TOP      3328
#define XB_TOPGEN   3392
#define XCD_BAR_WORDS 3456
#define XB_SPIN_CAP (1u << 18)

__device__ __forceinline__ unsigned xb_ld(unsigned* p)              { return __hip_atomic_load(p, __ATOMIC_RELAXED, __HIP_MEMORY_SCOPE_AGENT); }
__device__ __forceinline__ unsigned xb_add(unsigned* p, unsigned v) { return __hip_atomic_fetch_add(p, v, __ATOMIC_RELAXED, __HIP_MEMORY_SCOPE_AGENT); }
__device__ __forceinline__ unsigned xb_xcc_id() { return (unsigned)__builtin_amdgcn_s_getreg((3 << 11) | 20) & 0xFu; }
#define XB_SPIN(cond, bar) do { unsigned _sp = 0; while (cond) { __builtin_amdgcn_s_sleep(1); \
    if ((++_sp & 255u) == 0u) { if (xb_ld(&(bar)[XB_TMO])) break; if (_sp > XB_SPIN_CAP) { atomicAdd(&(bar)[XB_TMO], 1u); break; } } } } while (0)

struct XcdBarrier { unsigned* bar; unsigned x; volatile LAS unsigned* st; };

__device__ __forceinline__ XcdBarrier xcd_barrier_post(unsigned* bar, volatile LAS unsigned* st) {
    XcdBarrier b; b.bar = bar; b.x = xb_xcc_id(); b.st = st;
    if (threadIdx.x == 0) (void)xb_add(&bar[XB_XCNT(b.x)], 1u);
    return b;
}
__device__ __forceinline__ void xcd_barrier_complete(unsigned* bar, unsigned x, unsigned& nloc, unsigned& nx) {
    const unsigned G = gridDim.x * gridDim.y * gridDim.z;
    unsigned sum, cnt, mine, sp = 0u;
    for (;;) {
        sum = 0u; cnt = 0u; mine = 0u;
#pragma unroll
        for (unsigned j = 0; j < 16; ++j) { const unsigned c = xb_ld(&bar[XB_XCNT(j)]); sum += c; cnt += (c > 0u) ? 1u : 0u; mine = (j == x) ? c : mine; }
        if (sum == G) break;
        __builtin_amdgcn_s_sleep(1);
        if ((++sp & 255u) == 0u) { if (xb_ld(&bar[XB_TMO])) break; if (sp > XB_SPIN_CAP) { atomicAdd(&bar[XB_TMO], 1u); break; } }
    }
    nloc = mine > 0u ? mine : 1u; nx = cnt > 0u ? cnt : 1u;
}
__device__ __forceinline__ void xcd_barrier(const XcdBarrier& b) {
    asm volatile("s_waitcnt vmcnt(0)" ::: "memory");
    __syncthreads();
    if (threadIdx.x == 0) {
        unsigned* bar = b.bar;
        __builtin_amdgcn_s_waitcnt(0);
        unsigned nloc = b.st[0], nx = b.st[1];
        if (nloc == 0u) { xcd_barrier_complete(bar, b.x, nloc, nx); b.st[0] = nloc; b.st[1] = nx; }
        const unsigned old = xb_add(&bar[XB_XSUB(b.x)], 1u);
        const unsigned gen = old / nloc;
        if (old + 1u == (gen + 1u) * nloc) {
            __builtin_amdgcn_fence(__ATOMIC_RELEASE, "agent");
            asm volatile("s_waitcnt vmcnt(0)" ::: "memory");
            const unsigned og = xb_add(&bar[XB_TOP], 1u);
            const unsigned tg = og / nx;
            if (og + 1u == (tg + 1u) * nx) xb_add(&bar[XB_TOPGEN], 1u);
            else XB_SPIN(xb_ld(&bar[XB_TOPGEN]) == tg, bar);
            __builtin_amdgcn_fence(__ATOMIC_ACQUIRE, "agent");
            xb_add(&bar[XB_XGEN(b.x)], 1u);
            asm volatile("s_waitcnt vmcnt(0)" ::: "memory");
        } else {
            XB_SPIN(xb_ld(&bar[XB_XGEN(b.x)]) == gen, bar);
            __builtin_amdgcn_fence(__ATOMIC_ACQUIRE, "agent");
            asm volatile("s_waitcnt vmcnt(0)" ::: "memory");
        }
    }
    __syncthreads();
}

DI float bf2f(short v) { return __builtin_bit_cast(float, ((unsigned)(unsigned short)v) << 16); }
DI unsigned cvtpk(float lo, float hi) { f32x2 v = {lo, hi}; bf16x2_t b = __builtin_convertvector(v, bf16x2_t); return __builtin_bit_cast(unsigned, b); }
DI bf16_t f2bf(float f) { return (bf16_t)(cvtpk(f, 0.f) & 0xffffu); }
template <int CTRL> DI float dppf(float v) { return __builtin_bit_cast(float, __builtin_amdgcn_update_dpp(0, __builtin_bit_cast(int, v), CTRL, 0xF, 0xF, true)); }
#define DPP_XOR1 0xB1
#define DPP_XOR2 0x4E
#define DPP_HMIR 0x141
#define DPP_MIR  0x140
DI void swap16(float v, float& a, float& b) { const auto r = __builtin_amdgcn_permlane16_swap(__builtin_bit_cast(unsigned, v), __builtin_bit_cast(unsigned, v), false, false); const unsigned r0 = r[0], r1 = r[1]; a = __builtin_bit_cast(float, r0); b = __builtin_bit_cast(float, r1); }
DI void swap32(float v, float& a, float& b) { const auto r = __builtin_amdgcn_permlane32_swap(__builtin_bit_cast(unsigned, v), __builtin_bit_cast(unsigned, v), false, false); const unsigned r0 = r[0], r1 = r[1]; a = __builtin_bit_cast(float, r0); b = __builtin_bit_cast(float, r1); }
DI float sum_x16(float v) { float a, b; swap16(v, a, b); return a + b; }
DI float sum_x32(float v) { float a, b; swap32(v, a, b); return a + b; }
DI float max_x32(float v) { float a, b; swap32(v, a, b); return fmaxf(a, b); }
DI float sum_row16(float v) { v += dppf<DPP_XOR1>(v); v += dppf<DPP_XOR2>(v); v += dppf<DPP_HMIR>(v); v += dppf<DPP_MIR>(v); return v; }
DI float max_row16(float v) { v = fmaxf(v, dppf<DPP_XOR1>(v)); v = fmaxf(v, dppf<DPP_XOR2>(v)); v = fmaxf(v, dppf<DPP_HMIR>(v)); v = fmaxf(v, dppf<DPP_MIR>(v)); return v; }
DI float sum_oct(float v) { v += dppf<DPP_XOR1>(v); v += dppf<DPP_XOR2>(v); v += dppf<DPP_HMIR>(v); return v; }
DI float max_oct(float v) { v = fmaxf(v, dppf<DPP_XOR1>(v)); v = fmaxf(v, dppf<DPP_XOR2>(v)); v = fmaxf(v, dppf<DPP_HMIR>(v)); return v; }
DI float wave_sum(float v) { return sum_x32(sum_x16(sum_row16(v))); }
DI float wave_max(float v) { v = max_row16(v); float a, b; swap16(v, a, b); return max_x32(fmaxf(a, b)); }
DI float tr_x32(float lo, float hi) { const auto r = __builtin_amdgcn_permlane32_swap(__builtin_bit_cast(unsigned, lo), __builtin_bit_cast(unsigned, hi), false, false); const unsigned r0 = r[0], r1 = r[1]; return __builtin_bit_cast(float, r0) + __builtin_bit_cast(float, r1); }
DI float tr_x16(float lo, float hi) { const auto r = __builtin_amdgcn_permlane16_swap(__builtin_bit_cast(unsigned, lo), __builtin_bit_cast(unsigned, hi), false, false); const unsigned r0 = r[0], r1 = r[1]; return __builtin_bit_cast(float, r0) + __builtin_bit_cast(float, r1); }
DI float tr_x8(float lo, float hi, bool bit) { const float mine = bit ? hi : lo, send = bit ? lo : hi; return mine + dppf<0x128>(send); }
DI float tr_x4(float lo, float hi, bool bit) {
    const int a = __builtin_amdgcn_update_dpp(0, __builtin_bit_cast(int, hi), 0x114, 0xF, 0xA, false);
    const int b = __builtin_amdgcn_update_dpp(a, __builtin_bit_cast(int, lo), 0x104, 0xF, 0x5, false);
    return (bit ? hi : lo) + __builtin_bit_cast(float, b);
}
DI float tr_x2(float lo, float hi, bool bit) { const float mine = bit ? hi : lo, send = bit ? lo : hi; return mine + dppf<DPP_XOR2>(send); }
DI float tr_x1(float lo, float hi, bool bit) { const float mine = bit ? hi : lo, send = bit ? lo : hi; return mine + dppf<DPP_XOR1>(send); }
DI int crow(int r, int hi) { return (r & 3) + 8 * (r >> 2) + 4 * hi; }
#define MFMA32(a, b, c) __builtin_amdgcn_mfma_f32_32x32x16_bf16((a), (b), (c), 0, 0, 0)
DI f32x16 zero16() { f32x16 z; for (int i = 0; i < 16; ++i) z[i] = 0.f; return z; }

struct Params {
    const float* in[18];
    float* out;
    unsigned char* ws;
    int ph_lo, ph_hi;
};

enum { IN_X = 0, IN_P, IN_RELB, IN_ATTN_NORM, IN_WIN, IN_QNORM, IN_KNORM, IN_ONM, IN_ONS, IN_WOUT, IN_FFN_NORM, IN_PQ, IN_SUBK, IN_PU, IN_PV, IN_PLE_NORM, IN_WPG, IN_WPLE };

template <bool HEADPERM> DI void p0_transpose(const float* W, int K, int N, bf16_t* Wt, LAS float* scr, int tid, int wg, int nwg, const float* kgain = nullptr) {
    const int tn = N / 64, ntile = (K / 64) * tn;
    for (int tile = wg; tile < ntile; tile += nwg) {
        const int k0 = (tile / tn) * 64, n0 = (tile % tn) * 64;
#pragma unroll
        for (int i = 0; i < 8; ++i) { const int kk = (tid >> 6) + 8 * i, nn = tid & 63; scr[kk * 65 + nn] = W[(size_t)(k0 + kk) * N + n0 + nn]; }
        __syncthreads();
#pragma unroll
        for (int i = 0; i < 8; ++i) { const int nn = (tid >> 6) + 8 * i, kk = tid & 63; int n = n0 + nn; if (HEADPERM) { const int w = n & 255; n = (n & ~255) + 128 * ((w >> 5) & 1) + 32 * (w >> 6) + (w & 31); }
            Wt[(size_t)n * K + k0 + kk] = f2bf(scr[kk * 65 + nn] * (kgain ? kgain[k0 + kk] : 1.f)); }
        __syncthreads();
    }
}

DI void split_bf16x8(const f32x4& p, const f32x4& q, bf16x8& hi, bf16x8& lo) {
    u32x4 h, l;
    h.x = cvtpk(p.x, p.y); h.y = cvtpk(p.z, p.w); h.z = cvtpk(q.x, q.y); h.w = cvtpk(q.z, q.w);
    const float r0 = p.x - __builtin_bit_cast(float, h.x << 16), r1 = p.y - __builtin_bit_cast(float, h.x & 0xffff0000u), r2 = p.z - __builtin_bit_cast(float, h.y << 16), r3 = p.w - __builtin_bit_cast(float, h.y & 0xffff0000u);
    const float r4 = q.x - __builtin_bit_cast(float, h.z << 16), r5 = q.y - __builtin_bit_cast(float, h.z & 0xffff0000u), r6 = q.z - __builtin_bit_cast(float, h.w << 16), r7 = q.w - __builtin_bit_cast(float, h.w & 0xffff0000u);
    l.x = cvtpk(r0, r1); l.y = cvtpk(r2, r3); l.z = cvtpk(r4, r5); l.w = cvtpk(r6, r7);
    hi = __builtin_bit_cast(bf16x8, h); lo = __builtin_bit_cast(bf16x8, l);
}
DI void p0_fold(const float* wq, const float* sub, const float* gffn, bf16_t* WqT, int wid, int lane, int wg, int nwg) {
    const int r = lane & 31, hi = lane >> 5, dq = wid & 1, nq = wid >> 1;
    for (int item = wg; item < 256; item += nwg) {
        const int dt = item & 15, hh = item >> 4, d0 = dt * 64 + 32 * dq, h = hh >> 1, half = hh & 1;
        const float* ap = wq + (size_t)(d0 + r) * 2048 + h * 256 + half * 128 + 8 * hi;
        const float* bp = sub + half * 16384 + (size_t)(32 * nq + r) * 128 + 8 * hi;
        f32x16 acc = zero16();
#pragma unroll
        for (int st = 0; st < 8; ++st) {
            const f32x4 a0 = *(const f32x4*)(ap + 16 * st), a1 = *(const f32x4*)(ap + 16 * st + 4), b0 = *(const f32x4*)(bp + 16 * st), b1 = *(const f32x4*)(bp + 16 * st + 4);
            bf16x8 ah, al, bh, bl;
            split_bf16x8(a0, a1, ah, al); split_bf16x8(b0, b1, bh, bl);
            acc = MFMA32(ah, bh, acc); acc = MFMA32(ah, bl, acc); acc = MFMA32(al, bh, acc);
        }
        bf16_t* op = WqT + (size_t)(hh * 128 + 32 * nq + r) * 1024 + d0 + 4 * hi;
#pragma unroll
        for (int g4 = 0; g4 < 4; ++g4) {
            const f32x4 gv = *(const f32x4*)(gffn + d0 + 8 * g4 + 4 * hi);
            u32x2 w; w.x = cvtpk(acc[4 * g4] * gv.x, acc[4 * g4 + 1] * gv.y); w.y = cvtpk(acc[4 * g4 + 2] * gv.z, acc[4 * g4 + 3] * gv.w);
            *(u32x2*)(op + 8 * g4) = w;
        }
    }
}

DI void p0_convert(const float* src, bf16_t* dst, size_t n, size_t gtid, size_t nthreads) {
    for (size_t i = gtid * 8; i < n; i += nthreads * 8) {
        const f32x4 a = *(const f32x4*)(src + i), b = *(const f32x4*)(src + i + 4);
        u32x4 o; o.x = cvtpk(a.x, a.y); o.y = cvtpk(a.z, a.w); o.z = cvtpk(b.x, b.y); o.w = cvtpk(b.z, b.w);
        *(u32x4*)(dst + i) = o;
    }
}


DI void p0_quant_finish(const f32x4 (&a)[4], unsigned char* dst, float* scale, int row, int lane) {
    float m = 0.f;
#pragma unroll
    for (int i = 0; i < 4; ++i) m = fmaxf(fmaxf(m, fmaxf(fabsf(a[i].x), fabsf(a[i].y))), fmaxf(fabsf(a[i].z), fabsf(a[i].w)));
    m = wave_max(m);
    const float sc = m > 0.f ? m * (1.f / 440.f) : 1.f, inv = m > 0.f ? 440.f / m : 0.f;
    u32x4 w;
#pragma unroll
    for (int i = 0; i < 4; ++i) {
        const float q0 = fminf(fmaxf(a[i].x * inv, -448.f), 448.f), q1 = fminf(fmaxf(a[i].y * inv, -448.f), 448.f);
        const float q2 = fminf(fmaxf(a[i].z * inv, -448.f), 448.f), q3 = fminf(fmaxf(a[i].w * inv, -448.f), 448.f);
        int p = 0;
        p = __builtin_amdgcn_cvt_pk_fp8_f32(q0, q1, p, false);
        p = __builtin_amdgcn_cvt_pk_fp8_f32(q2, q3, p, true);
        w[i] = (unsigned)p;
    }
    *(u32x4*)(dst + ((size_t)(lane >> 3) * 16384 + row) * 128 + 16 * (lane & 7)) = w;
    if (lane == 0) scale[row] = sc;
}
DI void p0_quant_rows4(const float* pu, const float* pv, unsigned char* u8, unsigned char* v8, float* usc_, float* vsc_, int r0, int r1, int lane) {
    f32x4 a[4][4];
    const int r1c = r1 < 16384 ? r1 : r0;
#pragma unroll
    for (int i = 0; i < 4; ++i) { a[0][i] = *(const f32x4*)(pu + (size_t)r0 * 1024 + 16 * lane + 4 * i); a[1][i] = *(const f32x4*)(pv + (size_t)r0 * 1024 + 16 * lane + 4 * i);
        a[2][i] = *(const f32x4*)(pu + (size_t)r1c * 1024 + 16 * lane + 4 * i); a[3][i] = *(const f32x4*)(pv + (size_t)r1c * 1024 + 16 * lane + 4 * i); }
    p0_quant_finish(a[0], u8, usc_, r0, lane); p0_quant_finish(a[1], v8, vsc_, r0, lane);
    if (r1 < 16384) { p0_quant_finish(a[2], u8, usc_, r1, lane); p0_quant_finish(a[3], v8, vsc_, r1, lane); }
}

DI void rmsnorm_rows2_bf16(const float* x, const float* g, bf16_t* o, int r0, int r1, int lane) {
    f32x4 v[2][4]; float s[2] = {0.f, 0.f};
    const int rr[2] = {r0, r1 < T ? r1 : r0};
#pragma unroll
    for (int q = 0; q < 2; ++q)
#pragma unroll
        for (int j = 0; j < 4; ++j) v[q][j] = ((const f32x4*)(x + (size_t)rr[q] * 1024))[lane + 64 * j];
#pragma unroll
    for (int q = 0; q < 2; ++q) {
#pragma unroll
        for (int j = 0; j < 4; ++j) s[q] += (v[q][j].x * v[q][j].x + v[q][j].y * v[q][j].y) + (v[q][j].z * v[q][j].z + v[q][j].w * v[q][j].w);
        s[q] = wave_sum(s[q]);
    }
#pragma unroll
    for (int q = 0; q < 2; ++q) {
        if (q == 1 && r1 >= T) break;
        const float rs = rsqrtf(s[q] * (1.f / 1024.f) + EPS);
#pragma unroll
        for (int j = 0; j < 4; ++j) { const f32x4 gv = ((const f32x4*)g)[lane + 64 * j];
            u32x2 w; w.x = cvtpk(v[q][j].x * rs * gv.x, v[q][j].y * rs * gv.y); w.y = cvtpk(v[q][j].z * rs * gv.z, v[q][j].w * rs * gv.w);
            ((u32x2*)(o + (size_t)rr[q] * 1024))[lane + 64 * j] = w; }
    }
}

namespace pg8 {
#define PG8_LAS __attribute__((address_space(3)))
typedef unsigned short bf16_t;
typedef short bf16x8 __attribute__((ext_vector_type(8)));
typedef float f32x4 __attribute__((ext_vector_type(4)));
typedef unsigned u32x4 __attribute__((ext_vector_type(4)));
constexpr int BM = 256, BK = 64, HALF = 128, HTB = HALF * BK * 2  , STAGE_BYTES = 8 * HTB, NXCD = 8, WGM = 8;

__host__ __device__ __forceinline__ int lds_byte(int r, int c) { const int st = (r >> 4) * 2 + (c >> 5), rr = r & 15, cc = c & 31, ob = rr * 64 + cc * 2; return st * 1024 + (ob ^ (((ob >> 9) & 1) << 5)); }
__host__ __device__ __forceinline__ void stage_rc(int b, int& R, int& C) { const int st = b / 1024, sb = b % 1024, swz = sb ^ (((sb >> 9) & 1) << 5); R = (st >> 1) * 16 + swz / 64; C = (st & 1) * 32 + (swz % 64) / 2; }
__host__ __device__ __forceinline__ int perm32(int rho) { const int n = rho >> 4, i = rho & 15; return 8 * (i >> 2) + 4 * n + (i & 3); }

struct Unit { int pm, pn; };
struct Gemm { const bf16_t* A; const bf16_t* Bt; int M, N, K; };

struct StaticOrder {
    int nM, nN, nwg, G, c;
    __host__ __device__ void init(int M, int N, int G_, int c_) { nM = M / BM; nN = N / BM; nwg = nM * nN; G = G_; c = c_; }
    __host__ __device__ bool next(int i, Unit& u) const {
        const long L = (long)i * G + c; if (L >= nwg) return false;
        int wgid = (int)L; { const int q = nwg / NXCD, r = nwg % NXCD, xcd = wgid % NXCD, off = wgid / NXCD; wgid = (xcd < r ? xcd * (q + 1) : r * (q + 1) + (xcd - r) * q) + off; }
        const int nig = WGM * nN, gid = wgid / nig, fm = gid * WGM, gsz = (nM - fm) < WGM ? (nM - fm) : WGM;
        u.pm = fm + ((wgid % nig) % gsz); u.pn = (wgid % nig) / gsz; return true;
    }
    __device__ __forceinline__ void a_ready(const Unit&) const {}
    __device__ __forceinline__ void done(const Unit&) const {}
};

template <class Epi, class Sched, bool ALIGN_EPI = false, bool SP2 = false>
__device__ __forceinline__ void gemm_phase(PG8_LAS unsigned char* lds, const Gemm g, const Sched& S, const Epi& E) {
    int tid_ = threadIdx.x; asm volatile("" : "+v"(tid_));
    const int tid = tid_, wid = __builtin_amdgcn_readfirstlane(tid >> 6), lane = tid & 63, wr = wid >> 2, wc = wid & 3, fr = lane & 15, fq = lane >> 4;
    const int K = g.K, nt = K / BK;
    unsigned voffA[2], voffB[2];
#pragma unroll
    for (int i = 0; i < 2; ++i) { int R, C; stage_rc(tid * 16 + i * 8192, R, C); const int Rb = Epi::PERM ? ((R & ~31) + perm32(R & 31)) : R;
        voffA[i] = (unsigned)(R * K + C) * 2u; voffB[i] = (unsigned)(Rb * K + C) * 2u; }
    const size_t kstep = (size_t)(BK * 2);
    const size_t hstep = (size_t)HALF * K * 2;
    const size_t tstep = 2 * hstep;
    const unsigned ldsw = (unsigned)wid * 1024u;
    const int aoff = lds_byte(wr * 64 + fr, fq * 8), boff = lds_byte(wc * 32 + fr, fq * 8);
#define PG8_SA(b, h) (((b) * 2 + (h)) * HTB)
#define PG8_SB(b, h) ((4 + (b) * 2 + (h)) * HTB)
#define PG8_STAGE(bufoff, gbase, voff) do { _Pragma("unroll") for (int _i = 0; _i < 2; ++_i) \
        __builtin_amdgcn_global_load_lds((const unsigned*)((const char*)(gbase) + (voff)[_i]), (PG8_LAS unsigned*)(lds + (bufoff) + ldsw + _i * 8192), 16, 0, 0); } while (0)
#define PG8_LDA(dst, b, h) do { _Pragma("unroll") for (int m = 0; m < 4; ++m) _Pragma("unroll") for (int k = 0; k < 2; ++k) dst[m][k] = *(const PG8_LAS bf16x8*)(lds + PG8_SA(b, h) + aoff + m * 2048 + k * 1024); } while (0)
#define PG8_LDB(dst, b, h) do { _Pragma("unroll") for (int n = 0; n < 2; ++n) _Pragma("unroll") for (int k = 0; k < 2; ++k) dst[n][k] = *(const PG8_LAS bf16x8*)(lds + PG8_SB(b, h) + boff + n * 2048 + k * 1024); } while (0)
#define PG8_MMA(ai, bj, At, Bt) do { __builtin_amdgcn_s_setprio(1); _Pragma("unroll") for (int m = 0; m < 4; ++m) _Pragma("unroll") for (int n = 0; n < 2; ++n) _Pragma("unroll") for (int k = 0; k < 2; ++k) \
        acc[ai][bj][m][n] = __builtin_amdgcn_mfma_f32_16x16x32_bf16(Bt[n][k], At[m][k], acc[ai][bj][m][n], 0, 0, 0); __builtin_amdgcn_s_setprio(0); } while (0)
#define PG8_WAIT_V(n) asm volatile("s_waitcnt vmcnt(" #n ")" ::: "memory")
#define PG8_WAIT_L(n) asm volatile("s_waitcnt lgkmcnt(" #n ")" ::: "memory")
#define PG8_BAR __builtin_amdgcn_s_barrier()
#define PG8_SCHED __builtin_amdgcn_sched_barrier(0)
    Unit cur, nxt; int ui = 0;
    if (!S.next(0, cur)) return;
    f32x4 acc[2][2][4][2];
#pragma unroll
    for (int a = 0; a < 2; ++a)
#pragma unroll
        for (int b = 0; b < 2; ++b)
#pragma unroll
            for (int m = 0; m < 4; ++m)
#pragma unroll
                for (int n = 0; n < 2; ++n) acc[a][b][m][n] = (f32x4){0.f, 0.f, 0.f, 0.f};
    bf16x8 At[4][2], B0[2][2], B1[2][2];
    const char* cA = (const char*)g.A + (size_t)cur.pm * tstep; const char* cB = (const char*)g.Bt + (size_t)cur.pn * tstep;
    S.a_ready(cur);
    if constexpr (SP2) {
        PG8_STAGE(PG8_SB(0, 0), cB, voffB); PG8_STAGE(PG8_SB(0, 1), cB + hstep, voffB); PG8_STAGE(PG8_SA(0, 0), cA, voffA); PG8_STAGE(PG8_SA(0, 1), cA + hstep, voffA);
        if (wr == 1) PG8_BAR;
        PG8_WAIT_V(2); PG8_BAR;
        PG8_STAGE(PG8_SB(1, 0), cB + kstep, voffB); PG8_STAGE(PG8_SA(1, 0), cA + kstep, voffA); PG8_STAGE(PG8_SB(1, 1), cB + hstep + kstep, voffB);
        PG8_WAIT_V(6); PG8_BAR;
    } else {
        PG8_STAGE(PG8_SB(0, 0), cB, voffB); PG8_STAGE(PG8_SA(0, 0), cA, voffA); PG8_STAGE(PG8_SB(0, 1), cB + hstep, voffB); PG8_STAGE(PG8_SA(0, 1), cA + hstep, voffA);
        if (wr == 1) PG8_BAR;
        PG8_WAIT_V(4); PG8_BAR;
        PG8_STAGE(PG8_SB(1, 0), cB + kstep, voffB); PG8_STAGE(PG8_SA(1, 0), cA + kstep, voffA); PG8_STAGE(PG8_SB(1, 1), cB + hstep + kstep, voffB);
        PG8_WAIT_V(6); PG8_BAR;
    }
    for (;;) {
        const bool has_next = S.next(ui + 1, nxt);
        const char* nA = has_next ? (const char*)g.A + (size_t)nxt.pm * tstep : cA; const char* nB = has_next ? (const char*)g.Bt + (size_t)nxt.pn * tstep : cB;
        for (int t = 0; t < nt; t += 2) {
            const bool last = (t == nt - 2);
            const char* a1 = cA + (size_t)(t + 1) * kstep;
            const char* a2 = last ? nA : cA + (size_t)(t + 2) * kstep; const char* b2 = last ? nB : cB + (size_t)(t + 2) * kstep;
            const char* a3 = a2 + kstep; const char* b3 = b2 + kstep;
            if (last && has_next) S.a_ready(nxt);
            if constexpr (SP2) {
            PG8_LDB(B0, 0, 0); PG8_LDB(B1, 0, 1); PG8_SCHED; PG8_LDA(At, 0, 0); PG8_STAGE(PG8_SA(1, 1), a1 + hstep, voffA);
            PG8_WAIT_V(8); PG8_WAIT_L(0); PG8_BAR; PG8_MMA(0, 0, At, B0); PG8_MMA(0, 1, At, B1); PG8_BAR; PG8_SCHED;
            PG8_LDA(At, 0, 1); PG8_STAGE(PG8_SB(0, 0), b2, voffB); PG8_STAGE(PG8_SB(0, 1), b2 + hstep, voffB); PG8_STAGE(PG8_SA(0, 0), a2, voffA);
            PG8_WAIT_V(8); PG8_WAIT_L(0); PG8_BAR; PG8_MMA(1, 0, At, B0); PG8_MMA(1, 1, At, B1); PG8_BAR; PG8_SCHED;
            PG8_LDB(B0, 1, 0); PG8_LDB(B1, 1, 1); PG8_SCHED; PG8_LDA(At, 1, 0); PG8_STAGE(PG8_SA(0, 1), a2 + hstep, voffA);
            PG8_WAIT_V(8); PG8_WAIT_L(0); PG8_BAR; PG8_MMA(0, 0, At, B0); PG8_MMA(0, 1, At, B1); PG8_BAR; PG8_SCHED;
            PG8_LDA(At, 1, 1); PG8_STAGE(PG8_SB(1, 0), b3, voffB); PG8_STAGE(PG8_SB(1, 1), b3 + hstep, voffB); PG8_STAGE(PG8_SA(1, 0), a3, voffA);
            PG8_WAIT_V(8); PG8_WAIT_L(0); PG8_BAR; PG8_MMA(1, 0, At, B0); PG8_MMA(1, 1, At, B1); PG8_BAR; PG8_SCHED;
            } else {
            PG8_LDB(B0, 0, 0); PG8_SCHED; PG8_LDA(At, 0, 0); PG8_STAGE(PG8_SA(1, 1), a1 + hstep, voffA);
            PG8_WAIT_L(8); PG8_BAR; PG8_WAIT_L(0); PG8_MMA(0, 0, At, B0); PG8_BAR; PG8_SCHED;
            PG8_LDB(B1, 0, 1); PG8_STAGE(PG8_SB(0, 0), b2, voffB);
            PG8_BAR; PG8_WAIT_L(0); PG8_MMA(0, 1, At, B1); PG8_BAR;
            PG8_LDA(At, 0, 1); PG8_STAGE(PG8_SA(0, 0), a2, voffA);
            PG8_BAR; PG8_WAIT_L(0); PG8_MMA(1, 0, At, B0); PG8_BAR; PG8_SCHED;
            PG8_STAGE(PG8_SB(0, 1), b2 + hstep, voffB);
            PG8_WAIT_V(6); PG8_BAR; PG8_MMA(1, 1, At, B1); PG8_BAR;
            PG8_LDB(B0, 1, 0); PG8_SCHED; PG8_LDA(At, 1, 0); PG8_STAGE(PG8_SA(0, 1), a2 + hstep, voffA);
            PG8_WAIT_L(8); PG8_BAR; PG8_WAIT_L(0); PG8_MMA(0, 0, At, B0); PG8_BAR; PG8_SCHED;
            PG8_LDB(B1, 1, 1); PG8_STAGE(PG8_SB(1, 0), b3, voffB);
            PG8_BAR; PG8_WAIT_L(0); PG8_MMA(0, 1, At, B1); PG8_BAR;
            PG8_LDA(At, 1, 1); PG8_STAGE(PG8_SA(1, 0), a3, voffA);
            PG8_BAR; PG8_WAIT_L(0); PG8_MMA(1, 0, At, B0); PG8_BAR; PG8_SCHED;
            PG8_STAGE(PG8_SB(1, 1), b3 + hstep, voffB);
            PG8_WAIT_V(6); PG8_BAR; PG8_MMA(1, 1, At, B1); PG8_BAR;
            }
        }
        if constexpr (ALIGN_EPI) { if (wr == 0) PG8_BAR; }
        if constexpr (!Epi::AFTER_DRAIN) { E(acc, cur, wr, wc, fr, fq); S.done(cur); }
        if (!has_next) break;
#pragma unroll
        for (int a = 0; a < 2; ++a)
#pragma unroll
            for (int b = 0; b < 2; ++b)
#pragma unroll
                for (int m = 0; m < 4; ++m)
#pragma unroll
                    for (int n = 0; n < 2; ++n) acc[a][b][m][n] = (f32x4){0.f, 0.f, 0.f, 0.f};
        cur = nxt; cA = nA; cB = nB; ++ui;
        if constexpr (ALIGN_EPI) { if (wr == 1) PG8_BAR; }
    }
    PG8_WAIT_V(0);
    if constexpr (!ALIGN_EPI) { if (wr == 0) PG8_BAR; }
    PG8_BAR;
    if constexpr (Epi::AFTER_DRAIN) { E.fused(acc, cur, wr, wc, fr, fq, lds, wid, lane); S.done(cur); }
#undef PG8_SA
#undef PG8_SB
#undef PG8_STAGE
#undef PG8_LDA
#undef PG8_LDB
#undef PG8_MMA
#undef PG8_WAIT_V
#undef PG8_WAIT_L
#undef PG8_BAR
#undef PG8_SCHED
}
}


struct EpiQKV {
    static constexpr bool PERM = true, AFTER_DRAIN = false;
    bf16_t* base6; const float *qn, *kn;
    DI void operator()(const f32x4 (&acc)[2][2][4][2], const pg8::Unit& u, int wr, int wc, int fr, int fq) const {
        const int typ = u.pn >> 1, h = (u.pn & 1) * 4 + wc;
        bf16_t* reg = base6 + (size_t)typ * (16u << 19);
        const int row0 = u.pm * 256 + wr * 64 + fr;
        if (typ == 2 || typ == 5) {
#pragma unroll
            for (int ai = 0; ai < 2; ++ai)
#pragma unroll
                for (int m = 0; m < 4; ++m) {
                    const int tok = row0 + ai * 128 + m * 16, b = tok >> 11, sq = tok & 2047, tile = sq >> 5, kap = sq & 31;
                    const int s2 = kap >> 4, hh = (kap >> 2) & 1, jj = ((kap >> 3) & 1) * 4 + (kap & 3);
                    bf16_t* bp = reg + ((((size_t)(b * 8 + h) * 64 + tile) * 4 + s2 * 2) * 64 + hh * 32 + 8 * fq) * 8 + jj;
#pragma unroll
                    for (int bj = 0; bj < 2; ++bj)
#pragma unroll
                        for (int n = 0; n < 2; ++n)
#pragma unroll
                            for (int i = 0; i < 4; ++i) bp[(size_t)bj * 512 + (4 * n + i) * 8] = f2bf(acc[ai][bj][m][n][i]);
                }
        } else {
            const bool nrm = typ < 2;
            const float* g = (typ == 0) ? qn : kn;
            f32x4 gv[2][2];
#pragma unroll
            for (int bj = 0; bj < 2; ++bj)
#pragma unroll
                for (int n = 0; n < 2; ++n) gv[bj][n] = nrm ? *(const f32x4*)(g + 32 * bj + 8 * fq + 4 * n) : (f32x4){1.f, 1.f, 1.f, 1.f};
#pragma unroll
            for (int ai = 0; ai < 2; ++ai)
#pragma unroll
                for (int m = 0; m < 4; ++m) {
                    const int tok = row0 + ai * 128 + m * 16, b = tok >> 11, sq = tok & 2047, tile = sq >> 5, kap = sq & 31;
                    float rs = 1.f;
                    if (nrm) {
                        float ss = 0.f;
#pragma unroll
                        for (int bj = 0; bj < 2; ++bj)
#pragma unroll
                            for (int n = 0; n < 2; ++n) { const f32x4 v = acc[ai][bj][m][n]; ss += (v.x * v.x + v.y * v.y) + (v.z * v.z + v.w * v.w); }
                        ss = sum_x32(sum_x16(ss));
                        rs = rsqrtf(ss * (1.f / 64.f) + EPS);
                    }
                    bf16_t* dst = reg + ((((size_t)(b * 8 + h) * 64 + tile) * 4 + (fq >> 1)) * 64 + (fq & 1) * 32 + kap) * 8;
#pragma unroll
                    for (int bj = 0; bj < 2; ++bj) {
                        const f32x4 v0 = acc[ai][bj][m][0] * rs * gv[bj][0], v1 = acc[ai][bj][m][1] * rs * gv[bj][1];
                        u32x4 w; w.x = cvtpk(v0.x, v0.y); w.y = cvtpk(v0.z, v0.w); w.z = cvtpk(v1.x, v1.y); w.w = cvtpk(v1.z, v1.w);
                        *(u32x4*)(dst + (size_t)bj * 2 * 512) = w;
                    }
                }
        }
    }
};

struct EpiRes {
    static constexpr bool PERM = true, AFTER_DRAIN = false;
    const float* x; float* out; bf16_t* xn;
    DI void operator()(const f32x4 (&acc)[2][2][4][2], const pg8::Unit& u, int wr, int wc, int fr, int fq) const {
        const int row0 = u.pm * 256 + wr * 64 + fr, col0 = u.pn * 256 + wc * 32 + 8 * fq;
#pragma unroll
        for (int ai = 0; ai < 2; ++ai)
#pragma unroll
            for (int m = 0; m < 4; ++m)
#pragma unroll
                for (int bj = 0; bj < 2; ++bj) {
                    const size_t off = (size_t)(row0 + ai * 128 + m * 16) * 1024 + col0 + bj * 128;
                    const f32x4 h0 = *(const f32x4*)(x + off) + acc[ai][bj][m][0], h1 = *(const f32x4*)(x + off + 4) + acc[ai][bj][m][1];
                    *(f32x4*)(out + off) = h0; *(f32x4*)(out + off + 4) = h1;
                    u32x4 w; w.x = cvtpk(h0.x, h0.y); w.y = cvtpk(h0.z, h0.w); w.z = cvtpk(h1.x, h1.y); w.w = cvtpk(h1.z, h1.w);
                    *(u32x4*)(xn + off) = w;
                }
    }
};

struct EpiF32 {
    static constexpr bool PERM = true, AFTER_DRAIN = false;
    float* C; int ldc;
    DI void operator()(const f32x4 (&acc)[2][2][4][2], const pg8::Unit& u, int wr, int wc, int fr, int fq) const {
        const int row0 = u.pm * 256 + wr * 64 + fr, col0 = u.pn * 256 + wc * 32 + 8 * fq;
#pragma unroll
        for (int ai = 0; ai < 2; ++ai)
#pragma unroll
            for (int m = 0; m < 4; ++m)
#pragma unroll
                for (int bj = 0; bj < 2; ++bj) {
                    float* p = C + (size_t)(row0 + ai * 128 + m * 16) * ldc + col0 + bj * 128;
                    *(f32x4*)p = acc[ai][bj][m][0]; *(f32x4*)(p + 4) = acc[ai][bj][m][1];
                }
    }
};

struct EpiBf {
    static constexpr bool PERM = true, AFTER_DRAIN = false;
    bf16_t* C; int ldc;
    DI void operator()(const f32x4 (&acc)[2][2][4][2], const pg8::Unit& u, int wr, int wc, int fr, int fq) const {
        const int row0 = u.pm * 256 + wr * 64 + fr, col0 = u.pn * 256 + wc * 32 + 8 * fq;
#pragma unroll
        for (int ai = 0; ai < 2; ++ai)
#pragma unroll
            for (int m = 0; m < 4; ++m)
#pragma unroll
                for (int bj = 0; bj < 2; ++bj) {
                    const f32x4 v0 = acc[ai][bj][m][0], v1 = acc[ai][bj][m][1];
                    u32x4 w; w.x = cvtpk(v0.x, v0.y); w.y = cvtpk(v0.z, v0.w); w.z = cvtpk(v1.x, v1.y); w.w = cvtpk(v1.z, v1.w);
                    *(u32x4*)(C + (size_t)(row0 + ai * 128 + m * 16) * ldc + col0 + bj * 128) = w;
                }
    }
};

struct EpiGate {
    static constexpr bool PERM = true, AFTER_DRAIN = false;
    float* out; const bf16_t* pw; const float* ssq;
    DI void operator()(const f32x4 (&acc)[2][2][4][2], const pg8::Unit& u, int wr, int wc, int fr, int fq) const {
        const int row0 = u.pm * 256 + wr * 64 + fr, col0 = u.pn * 256 + wc * 32 + 8 * fq;
#pragma unroll
        for (int ai = 0; ai < 2; ++ai)
#pragma unroll
            for (int m = 0; m < 4; ++m) {
                const int row = row0 + ai * 128 + m * 16;
                float sq = 0.f;
#pragma unroll
                for (int x = 0; x < 8; ++x) sq += ssq[(size_t)x * T + row];
                const float rs3 = rsqrtf(sq * (1.f / 1024.f) + EPS);
#pragma unroll
                for (int bj = 0; bj < 2; ++bj) {
                    const size_t off = (size_t)row * 1024 + col0 + bj * 128;
                    const bf16x8 pv = *(const bf16x8*)(pw + off);
                    const f32x4 h0 = *(const f32x4*)(out + off), h1 = *(const f32x4*)(out + off + 4);
                    const f32x4 g0 = acc[ai][bj][m][0] * rs3, g1 = acc[ai][bj][m][1] * rs3;
                    f32x4 o0, o1;
#pragma unroll
                    for (int i = 0; i < 4; ++i) { o0[i] = h0[i] + bf2f(pv[i]) / (1.f + __expf(-g0[i])); o1[i] = h1[i] + bf2f(pv[4 + i]) / (1.f + __expf(-g1[i])); }
                    *(f32x4*)(out + off) = o0; *(f32x4*)(out + off + 4) = o1;
                }
            }
    }
};

template <class Epi>
DI void gemm_simple(const bf16_t* A, const bf16_t* Bt, int M, int N, int K, const Epi& epi, int gwave, int nwaves, int lane) {
    const int r32 = lane & 31, hi = lane >> 5;
    const int nNt = N / 64, total = (M / 32) * nNt;
    for (int tile = gwave; tile < total; tile += nwaves) {
        const int mt = tile / nNt, nt = tile - mt * nNt, m0 = mt * 32, n0 = nt * 64;
        const bf16_t* ap = A + (size_t)(m0 + r32) * K + 8 * hi;
        const bf16_t* b0p = Bt + (size_t)(n0 + r32) * K + 8 * hi;
        const bf16_t* b1p = b0p + (size_t)32 * K;
        f32x16 acc0 = zero16(), acc1 = zero16();
#pragma unroll 4
        for (int k = 0; k < K; k += 16) {
            const bf16x8 xa = *(const bf16x8*)(ap + k);
            const bf16x8 w0 = *(const bf16x8*)(b0p + k);
            const bf16x8 w1 = *(const bf16x8*)(b1p + k);
            acc0 = MFMA32(w0, xa, acc0);
            acc1 = MFMA32(w1, xa, acc1);
        }
        epi(m0 + r32, n0, hi, acc0, acc1);
    }
}

struct Epi1 {
    bf16_t* base6;
    const float *qn, *kn;
    DI void operator()(int tok, int n0, int hi, const f32x16& a0, const f32x16& a1) const {
        const int head48 = n0 >> 6, typ = head48 >> 3, h = head48 & 7;
        bf16_t* reg = base6 + (size_t)typ * (16u << 19);
        if (typ == 2 || typ == 5) {
            const int b = tok >> 11, s = tok & 2047;
            const int pos = (s & ~12) | ((s & 4) << 1) | ((s & 8) >> 1);
            bf16_t* base = reg + ((size_t)(b * 8 + h) * 64) * 2048 + pos;
#pragma unroll
            for (int r = 0; r < 16; ++r) { base[(size_t)crow(r, hi) * 2048] = f2bf(a0[r]); base[(size_t)(32 + crow(r, hi)) * 2048] = f2bf(a1[r]); }
        } else {
            float rs = 1.f;
            const bool nrm = (typ == 0 || typ == 1);
            if (nrm) { float ss = 0.f;
#pragma unroll
                for (int r = 0; r < 16; ++r) ss += a0[r] * a0[r] + a1[r] * a1[r];
                ss = sum_x32(ss);
                rs = rsqrtf(ss * (1.f / 64.f) + EPS); }
            const float* g = (typ == 0) ? qn : kn;
            bf16_t* dst = reg + (size_t)tok * 512 + h * 64;
#pragma unroll
            for (int t = 0; t < 2; ++t)
#pragma unroll
                for (int g4 = 0; g4 < 4; ++g4) {
                    const int f0 = 32 * t + 8 * g4 + 4 * hi;
                    float v[4];
#pragma unroll
                    for (int i = 0; i < 4; ++i) { const float a = t ? a1[4 * g4 + i] : a0[4 * g4 + i]; v[i] = nrm ? a * rs * g[f0 + i] : a; }
                    u32x2 w; w.x = cvtpk(v[0], v[1]); w.y = cvtpk(v[2], v[3]);
                    *(u32x2*)(dst + f0) = w;
                }
        }
    }
};

struct Epi2 {
    const float* x; float* out; bf16_t* xn;
    DI void operator()(int tok, int n0, int hi, const f32x16& a0, const f32x16& a1) const {
#pragma unroll
        for (int t = 0; t < 2; ++t)
#pragma unroll
            for (int g4 = 0; g4 < 4; ++g4) {
                const size_t off = (size_t)tok * 1024 + n0 + 32 * t + 8 * g4 + 4 * hi;
                const f32x4 xv = *(const f32x4*)(x + off);
                f32x4 hv;
#pragma unroll
                for (int i = 0; i < 4; ++i) hv[i] = xv[i] + (t ? a1[4 * g4 + i] : a0[4 * g4 + i]);
                *(f32x4*)(out + off) = hv;
                u32x2 w; w.x = cvtpk(hv[0], hv[1]); w.y = cvtpk(hv[2], hv[3]);
                *(u32x2*)(xn + off) = w;
            }
    }
};

struct Epi3 {
    float* sc;
    DI void operator()(int tok, int n0, int hi, const f32x16& a0, const f32x16& a1) const {
#pragma unroll
        for (int t = 0; t < 2; ++t)
#pragma unroll
            for (int g4 = 0; g4 < 4; ++g4) {
                f32x4 v;
#pragma unroll
                for (int i = 0; i < 4; ++i) v[i] = t ? a1[4 * g4 + i] : a0[4 * g4 + i];
                *(f32x4*)(sc + (size_t)tok * 2048 + n0 + 32 * t + 8 * g4 + 4 * hi) = v;
            }
    }
};

DI void pv_accum(f32x16& o0, f32x16& o1, const f32x16& p, const bf16_t* vt_row) {
#pragma unroll
    for (int s = 0; s < 2; ++s) {
        u32x4 pk; pk.x = cvtpk(p[8 * s], p[8 * s + 1]); pk.y = cvtpk(p[8 * s + 2], p[8 * s + 3]); pk.z = cvtpk(p[8 * s + 4], p[8 * s + 5]); pk.w = cvtpk(p[8 * s + 6], p[8 * s + 7]);
        const bf16x8 pb = __builtin_bit_cast(bf16x8, pk);
        const bf16x8 v0 = *(const bf16x8*)(vt_row + 16 * s);
        const bf16x8 v1 = *(const bf16x8*)(vt_row + (size_t)32 * 2048 + 16 * s);
        o0 = MFMA32(v0, pb, o0);
        o1 = MFMA32(v1, pb, o1);
    }
}

DI void store_o(bf16_t* op, const f32x16& o0, const f32x16& o1, float inv, int hi) {
#pragma unroll
    for (int t = 0; t < 2; ++t)
#pragma unroll
        for (int g4 = 0; g4 < 4; ++g4) {
            u32x2 w;
            if (t == 0) { w.x = cvtpk(o0[4 * g4] * inv, o0[4 * g4 + 1] * inv); w.y = cvtpk(o0[4 * g4 + 2] * inv, o0[4 * g4 + 3] * inv); }
            else        { w.x = cvtpk(o1[4 * g4] * inv, o1[4 * g4 + 1] * inv); w.y = cvtpk(o1[4 * g4 + 2] * inv, o1[4 * g4 + 3] * inv); }
            *(u32x2*)(op + 32 * t + 8 * g4 + 4 * hi) = w;
        }
}

constexpr int OT_PITCH = 1040;
DI void store_o_lds(LAS unsigned char* ot, int r32, int h, const f32x16& o0, const f32x16& o1, float inv, int hi) {
    LAS unsigned char* op = ot + r32 * OT_PITCH + h * 128;
#pragma unroll
    for (int t = 0; t < 2; ++t)
#pragma unroll
        for (int g4 = 0; g4 < 4; ++g4) {
            u32x2 w;
            if (t == 0) { w.x = cvtpk(o0[4 * g4] * inv, o0[4 * g4 + 1] * inv); w.y = cvtpk(o0[4 * g4 + 2] * inv, o0[4 * g4 + 3] * inv); }
            else        { w.x = cvtpk(o1[4 * g4] * inv, o1[4 * g4 + 1] * inv); w.y = cvtpk(o1[4 * g4 + 2] * inv, o1[4 * g4 + 3] * inv); }
            *(LAS u32x2*)(op + (32 * t + 8 * g4 + 4 * hi) * 2) = w;
        }
}
DI void load_kfrag(bf16x8 (&kf)[4], const bf16_t* fbase  , int tile) {
    const bf16_t* kp = fbase + (size_t)tile * 2048;
#pragma unroll
    for (int s = 0; s < 4; ++s) kf[s] = *(const bf16x8*)(kp + s * 512);
}
DI void load_vfrag(bf16x8 (&vf)[4], const bf16_t* fbase, int tile) {
    const bf16_t* vp = fbase + (size_t)tile * 2048;
#pragma unroll
    for (int q = 0; q < 4; ++q) vf[q] = *(const bf16x8*)(vp + q * 512);
}
DI void pv_accum2(f32x16& o0, f32x16& o1, const f32x16& p, const bf16x8 (&vf)[4]) {
#pragma unroll
    for (int s = 0; s < 2; ++s) {
        u32x4 pk; pk.x = cvtpk(p[8 * s], p[8 * s + 1]); pk.y = cvtpk(p[8 * s + 2], p[8 * s + 3]); pk.z = cvtpk(p[8 * s + 4], p[8 * s + 5]); pk.w = cvtpk(p[8 * s + 6], p[8 * s + 7]);
        const bf16x8 pb = __builtin_bit_cast(bf16x8, pk);
        o0 = MFMA32(vf[2 * s], pb, o0);
        o1 = MFMA32(vf[2 * s + 1], pb, o1);
    }
}

#define MEM_FENCE() asm volatile("" ::: "memory")
#define PIN1(a) asm volatile("" : "+v"(a) :: "memory")
#define PIN2(a, b) asm volatile("" : "+v"(a), "+v"(b) :: "memory")
DI void vm_drain() { __builtin_amdgcn_s_waitcnt(0x0F70); }
struct KvStream { const bf16_t* kbase; const bf16_t* vbase; };

struct MobaCtx { int q0, tq, blk, hi; unsigned selmask; float bfar; const LAS float* bt; };
DI void moba_tile(bf16x8 (&kf)[4], bf16x8 (&vf)[4], const bf16x8 (&qf)[4], int kt, int next, const KvStream& kv, const MobaCtx& c, float& mrun, float& lsum, f32x16& o0, f32x16& o1) {
    const int n = kt >> 3, key0 = kt * 32;
    f32x16 st = zero16();
#pragma unroll
    for (int s = 0; s < 4; ++s) st = MFMA32(kf[s], qf[s], st);
    PIN1(st); load_kfrag(kf, kv.kbase, next); PIN1(st);
    float x[16];
    if (n != c.blk) {
        const bool selq = (c.selmask >> n) & 1u;
        if ((c.q0 - (key0 + 31)) >= 128) {
            const float addend = selq ? c.bfar : -1e30f;
#pragma unroll
            for (int r = 0; r < 16; ++r) x[r] = st[r] * SCL2 + addend;
        } else {
#pragma unroll
            for (int r = 0; r < 16; ++r) { const int dist = c.tq - (key0 + crow(r, c.hi)); const float v = st[r] * SCL2 + c.bt[dist > 128 ? 128 : dist]; x[r] = selq ? v : -1e30f; }
        }
    } else {
#pragma unroll
        for (int r = 0; r < 16; ++r) { const int dist = c.tq - (key0 + crow(r, c.hi)); const float v = st[r] * SCL2 + c.bt[dist < 0 ? 0 : (dist > 128 ? 128 : dist)]; x[r] = (dist >= 0) ? v : -1e30f; }
    }
    float mx = x[0];
#pragma unroll
    for (int r = 1; r < 16; ++r) mx = fmaxf(mx, x[r]);
    mx = max_x32(mx);
    const float mnew = fmaxf(mrun, mx);
    if (!__all(mnew == mrun)) {
        const float alpha = __builtin_amdgcn_exp2f(mrun - mnew);
        lsum *= alpha;
#pragma unroll
        for (int r = 0; r < 16; ++r) { o0[r] *= alpha; o1[r] *= alpha; }
        mrun = mnew;
    }
    f32x16 pr; float ps = 0.f;
#pragma unroll
    for (int r = 0; r < 16; ++r) { const float e = __builtin_amdgcn_exp2f(x[r] - mrun); pr[r] = e; ps += e; }
    lsum += ps;
    pv_accum2(o0, o1, pr, vf);
    PIN2(o0, o1); load_vfrag(vf, kv.vbase, next); MEM_FENCE();
}
DI int moba_next(int kt, int blk, unsigned anysel) {
    int nkt = kt - 1;
    while (nkt >= 0) { const int nn = nkt >> 3; if (nn == blk || ((anysel >> nn) & 1u)) break; nkt = nn * 8 - 1; }
    return nkt;
}

DI void moba_unit(int b, int h, int qt, const bf16_t* Qm_, const bf16_t* Km_, const bf16_t* VtM_, const float* kmean_, const LAS float* biasLds, LAS unsigned char* ot, int lane) {
    const int r32 = lane & 31, hi = lane >> 5;
    const int q0 = qt * 32, tq = q0 + r32, blk = q0 >> 8;
    const size_t bh = (size_t)(b * 8 + h);
    const bf16_t* qfb = Qm_ + bh * (64 * 2048) + (size_t)qt * 2048;
    KvStream kv; kv.kbase = Km_ + bh * (64 * 2048) + lane * 8; kv.vbase = VtM_ + bh * (64 * 2048) + lane * 8;
    bf16x8 kf[4], vf[4];
    load_kfrag(kf, kv.kbase, qt); load_vfrag(vf, kv.vbase, qt);
    bf16x8 qf[4];
#pragma unroll
    for (int s = 0; s < 4; ++s) qf[s] = *(const bf16x8*)(qfb + s * 512 + lane * 8);
    unsigned selmask = 0;
    if (blk > 0) {
        float qv[32];
#pragma unroll
        for (int c = 0; c < 4; ++c) { const bf16x8 t = *(const bf16x8*)(qfb + (2 * hi + (c >> 1)) * 512 + ((c & 1) * 32 + r32) * 8);
#pragma unroll
            for (int j = 0; j < 8; ++j) qv[8 * c + j] = bf2f(t[j]); }
        const float* km = kmean_ + (size_t)((b * 8 + h) * 8) * 64 + 32 * hi;
        float g[8];
#pragma unroll
        for (int n = 0; n < 8; ++n) {
            float a = 0.f;
            if (n < blk) {
#pragma unroll
                for (int d4 = 0; d4 < 8; ++d4) { const f32x4 kv4 = *(const f32x4*)(km + n * 64 + 4 * d4); a += (qv[4 * d4] * kv4.x + qv[4 * d4 + 1] * kv4.y) + (qv[4 * d4 + 2] * kv4.z + qv[4 * d4 + 3] * kv4.w); }
            }
            a = sum_x32(a);
            g[n] = (n < blk) ? a : -INFINITY;
        }
#pragma unroll
        for (int n = 0; n < 8; ++n) {
            int rank = 0;
#pragma unroll
            for (int m = 0; m < 8; ++m) if (m != n) rank += ((g[m] > g[n]) || (g[m] == g[n] && m < n)) ? 1 : 0;
            if (n < blk && rank < 3) selmask |= 1u << n;
        }
    }
    unsigned anysel = 0;
#pragma unroll
    for (int n = 0; n < 8; ++n) if (__any((selmask >> n) & 1u)) anysel |= 1u << n;
    anysel = __builtin_amdgcn_readfirstlane(anysel);
    float mrun = -1e30f, lsum = 0.f;
    f32x16 o0 = zero16(), o1 = zero16();
    MobaCtx c; c.q0 = q0; c.tq = tq; c.blk = blk; c.hi = hi; c.selmask = selmask; c.bt = biasLds + h * 132; c.bfar = c.bt[128];
    vm_drain();
    int kt = qt;
    for (;;) {
        const int nx = moba_next(kt, blk, anysel);
        moba_tile(kf, vf, qf, kt, nx < 0 ? 0 : nx, kv, c, mrun, lsum, o0, o1);
        if (nx < 0) break;
        kt = nx;
    }
    lsum = sum_x32(lsum);
    const float inv = 1.f / lsum;
    store_o_lds(ot, r32, h, o0, o1, inv, hi);
}

DI void sb_tile(bf16x8 (&kf)[4], bf16x8 (&vf)[4], const bf16x8 (&qf)[4], int kt, int next, const KvStream& kv, int tq, int hi, float& C, f32x16& o0, f32x16& o1) {
    const int key0 = kt * 32;
    f32x16 st = zero16();
#pragma unroll
    for (int s = 0; s < 4; ++s) st = MFMA32(kf[s], qf[s], st);
    PIN1(st); load_kfrag(kf, kv.kbase, next); PIN1(st);
    float rr[16], be[16];
#pragma unroll
    for (int r = 0; r < 16; ++r) {
        const int key = key0 + crow(r, hi);
        const float y = fminf(st[r] * SCL2, 100.f);
        const float e = __builtin_amdgcn_exp2f(y);
        const float ri = __builtin_amdgcn_rcpf(1.f + e);
        const bool ok = key < tq;
        rr[r] = ok ? ri : 1.f;
        be[r] = ok ? e * ri : 0.f;
    }
    float G[4], ex[16], Gp[4], Tt[4], Suf[4];
#pragma unroll
    for (int a = 0; a < 4; ++a) {
        ex[4 * a + 3] = 1.f; ex[4 * a + 2] = rr[4 * a + 3]; ex[4 * a + 1] = ex[4 * a + 2] * rr[4 * a + 2]; ex[4 * a] = ex[4 * a + 1] * rr[4 * a + 1];
        G[a] = ex[4 * a] * rr[4 * a];
    }
#pragma unroll
    for (int a = 0; a < 4; ++a) { float lo_, hi_; swap32(G[a], lo_, hi_); Gp[a] = hi_; Tt[a] = lo_ * hi_; }
    Suf[3] = 1.f; Suf[2] = Tt[3]; Suf[1] = Tt[3] * Tt[2]; Suf[0] = Suf[1] * Tt[1];
    f32x16 pr;
#pragma unroll
    for (int a = 0; a < 4; ++a) {
        const float after = Suf[a] * (hi == 0 ? Gp[a] : 1.f) * C;
#pragma unroll
        for (int i = 0; i < 4; ++i) pr[4 * a + i] = be[4 * a + i] * ex[4 * a + i] * after;
    }
    C = C * (Suf[0] * Tt[0]);
    pv_accum2(o0, o1, pr, vf);
    PIN2(o0, o1); load_vfrag(vf, kv.vbase, next); MEM_FENCE();
}

DI void sb_unit(int b, int h, int qt, const bf16_t* Qs_, const bf16_t* Ks_, const bf16_t* VtS_, LAS unsigned char* ot, int lane) {
    const int r32 = lane & 31, hi = lane >> 5;
    const int q0 = qt * 32, tq = q0 + r32;
    const size_t bh = (size_t)(b * 8 + h);
    const bf16_t* qfb = Qs_ + bh * (64 * 2048) + (size_t)qt * 2048;
    KvStream kv; kv.kbase = Ks_ + bh * (64 * 2048) + lane * 8; kv.vbase = VtS_ + bh * (64 * 2048) + lane * 8;
    bf16x8 kf[4], vf[4];
    load_kfrag(kf, kv.kbase, qt); load_vfrag(vf, kv.vbase, qt);
    bf16x8 qf[4];
#pragma unroll
    for (int s = 0; s < 4; ++s) qf[s] = *(const bf16x8*)(qfb + s * 512 + lane * 8);
    f32x16 o0 = zero16(), o1 = zero16();
    float C = 1.f;
    vm_drain();
    for (int kt = qt; kt >= 0; --kt) {
        sb_tile(kf, vf, qf, kt, kt > 0 ? kt - 1 : 0, kv, tq, hi, C, o0, o1);
        if (__all(C == 0.f ? 1 : 0)) break;
    }
    store_o_lds(ot, r32, h, o0, o1, 1.f, hi);
}

DI void ce_desc(unsigned& a, unsigned& b) { const unsigned hi = a > b ? a : b, lo = a > b ? b : a; a = hi; b = lo; }
DI void bitonic_clean_desc(unsigned (&v)[16]) {
#pragma unroll
    for (int s = 8; s >= 1; s >>= 1)
#pragma unroll
        for (int i = 0; i < 16; ++i) if ((i & s) == 0) ce_desc(v[i], v[i + s]);
}
DI void sort16_desc(unsigned (&v)[16]) {
#pragma unroll
    for (int k = 2; k <= 16; k <<= 1)
#pragma unroll
        for (int j = k >> 1; j >= 1; j >>= 1)
#pragma unroll
            for (int i = 0; i < 16; ++i) { const int l = i ^ j; if (l > i) { if ((i & k) == 0) ce_desc(v[i], v[l]); else ce_desc(v[l], v[i]); } }
}
DI float key_value(unsigned key) { const unsigned kk = key & ~127u; const unsigned u = (kk & 0x80000000u) ? (kk & 0x7fffffffu) : ~kk; return __builtin_bit_cast(float, u); }
DI float key_value8(unsigned key) { const unsigned kk = key & ~255u; const unsigned u = (kk & 0x80000000u) ? (kk & 0x7fffffffu) : ~kk; return __builtin_bit_cast(float, u); }
template <int CTRL> DI unsigned dppu(unsigned v) { return (unsigned)__builtin_amdgcn_update_dpp(0, (int)v, CTRL, 0xF, 0xF, true); }
DI void sort8_desc(unsigned (&v)[8]) {
    ce_desc(v[0], v[2]); ce_desc(v[1], v[3]); ce_desc(v[4], v[6]); ce_desc(v[5], v[7]);
    ce_desc(v[0], v[4]); ce_desc(v[1], v[5]); ce_desc(v[2], v[6]); ce_desc(v[3], v[7]);
    ce_desc(v[0], v[1]); ce_desc(v[2], v[3]); ce_desc(v[4], v[5]); ce_desc(v[6], v[7]);
    ce_desc(v[2], v[4]); ce_desc(v[3], v[5]);
    ce_desc(v[1], v[4]); ce_desc(v[3], v[6]);
    ce_desc(v[1], v[2]); ce_desc(v[3], v[4]); ce_desc(v[5], v[6]);
}
DI void clean8_desc(unsigned (&v)[8]) {
#pragma unroll
    for (int s = 4; s >= 1; s >>= 1)
#pragma unroll
        for (int i = 0; i < 8; ++i) if ((i & s) == 0) ce_desc(v[i], v[i + s]);
}
template <int CTRL> DI void cross_rev_max(unsigned (&v)[8]) {
    unsigned t[8];
#pragma unroll
    for (int i = 0; i < 8; ++i) t[i] = dppu<CTRL>(v[7 - i]);
#pragma unroll
    for (int i = 0; i < 8; ++i) v[i] = v[i] > t[i] ? v[i] : t[i];
}
template <bool REV> DI void cross_minmax_x1(unsigned (&v)[8], bool odd) {
    unsigned t[8];
#pragma unroll
    for (int i = 0; i < 8; ++i) t[i] = dppu<DPP_XOR1>(v[REV ? 7 - i : i]);
#pragma unroll
    for (int i = 0; i < 8; ++i) { const unsigned hi = v[i] > t[i] ? v[i] : t[i], lo = v[i] > t[i] ? t[i] : v[i]; v[i] = odd ? lo : hi; }
}

DI float reduce16(const float (&p)[16], int lane) {
    const bool b3 = lane & 8, b2 = lane & 4, b1 = lane & 2, b0 = lane & 1;
    float q[8], r[4], s[2];
#pragma unroll
    for (int i = 0; i < 8; ++i) { const float mine = b3 ? p[i + 8] : p[i], send = b3 ? p[i] : p[i + 8]; q[i] = mine + __shfl_xor(send, 8); }
#pragma unroll
    for (int i = 0; i < 4; ++i) { const float mine = b2 ? q[i + 4] : q[i], send = b2 ? q[i] : q[i + 4]; r[i] = mine + __shfl_xor(send, 4); }
#pragma unroll
    for (int i = 0; i < 2; ++i) { const float mine = b1 ? r[i + 2] : r[i], send = b1 ? r[i] : r[i + 2]; s[i] = mine + __shfl_xor(send, 2); }
    const float mine = b0 ? s[1] : s[0], send = b0 ? s[0] : s[1];
    float t = mine + __shfl_xor(send, 1);
    t = sum_x32(sum_x16(t));
    return t;
}

#ifndef PEER_REP_TOPK
#define PEER_REP_TOPK 1
#endif
#ifndef PEER_REP_U
#define PEER_REP_U 1
#endif
#ifndef PEER_REP_V
#define PEER_REP_V 1
#endif
struct TopkIn { f32x4 hv[4]; bf16x8 sv[4]; };
DI void peer_topk_load(TopkIn& in, int tok, const float* out, const bf16_t* scores, int lane) {
    const int tc = tok < T ? tok : T - 1;
    const float* hrow = out + (size_t)tc * 1024 + 16 * lane;
    const bf16_t* sp = scores + (size_t)tc * 2048 + (lane >> 2) * 128 + (lane & 3) * 8;
#pragma unroll
    for (int i = 0; i < 4; ++i) { in.hv[i] = *(const f32x4*)(hrow + 4 * i); in.sv[i] = *(const bf16x8*)(sp + 32 * i); }
}
DI void peer_topk_token(int tok, const TopkIn& in, const float* gffn, int* EIDXg, float* GATEg, unsigned char* XN2g, LAS float* wl, int lane) {
    LAS unsigned* kbuf = (LAS unsigned*)wl; const LAS unsigned* ctab = (const LAS unsigned*)(wl + 768);
    f32x4 hv[4];
    float ss = 0.f;
#pragma unroll
    for (int i = 0; i < 4; ++i) { hv[i] = in.hv[i]; ss += (hv[i].x * hv[i].x + hv[i].y * hv[i].y) + (hv[i].z * hv[i].z + hv[i].w * hv[i].w); }
    ss = wave_sum(ss);
    const float rs2 = rsqrtf(ss * (1.f / 1024.f) + EPS);
    {
        u32x4 w;
#pragma unroll
        for (int i = 0; i < 4; ++i) { const f32x4 gv = *(const f32x4*)(gffn + 16 * lane + 4 * i);
            const float y0 = fminf(fmaxf(hv[i][0] * rs2 * gv[0] * 64.f, -448.f), 448.f), y1 = fminf(fmaxf(hv[i][1] * rs2 * gv[1] * 64.f, -448.f), 448.f);
            const float y2 = fminf(fmaxf(hv[i][2] * rs2 * gv[2] * 64.f, -448.f), 448.f), y3 = fminf(fmaxf(hv[i][3] * rs2 * gv[3] * 64.f, -448.f), 448.f);
            int p = 0;
            p = __builtin_amdgcn_cvt_pk_fp8_f32(y0, y1, p, false);
            p = __builtin_amdgcn_cvt_pk_fp8_f32(y2, y3, p, true);
            w[i] = (unsigned)p; }
        *(u32x4*)(XN2g + (size_t)tok * 1024 + 16 * lane) = w;
    }
    {
        const int L = lane >> 2, q = lane & 3;
        unsigned k0[16], k1[16];
#pragma unroll
        for (int i = 0; i < 4; ++i) {
            const bf16x8 v = in.sv[i];
#pragma unroll
            for (int cI = 0; cI < 8; ++cI) {
                const unsigned u = ((unsigned)(unsigned short)v[cI]) << 16;
                const unsigned mono = (u & 0x80000000u) ? ~u : (u | 0x80000000u);
                const unsigned key = (mono & ~127u) | (unsigned)(127 - (32 * i + 8 * q + cI));
                if (i < 2) k0[8 * i + cI] = key; else k1[8 * (i - 2) + cI] = key;
            }
        }
        sort16_desc(k0); sort16_desc(k1);
        unsigned t[16];
#pragma unroll
        for (int i = 0; i < 16; ++i) t[i] = k0[i] > k1[15 - i] ? k0[i] : k1[15 - i];
        bitonic_clean_desc(t);
#pragma unroll
        for (int i = 0; i < 16; ++i) k0[i] = (unsigned)__builtin_amdgcn_update_dpp(0, (int)t[15 - i], 0xB1, 0xF, 0xF, true);
#pragma unroll
        for (int i = 0; i < 16; ++i) t[i] = t[i] > k0[i] ? t[i] : k0[i];
        bitonic_clean_desc(t);
#pragma unroll
        for (int i = 0; i < 16; ++i) k0[i] = (unsigned)__builtin_amdgcn_update_dpp(0, (int)t[15 - i], 0x4E, 0xF, 0xF, true);
#pragma unroll
        for (int i = 0; i < 16; ++i) t[i] = t[i] > k0[i] ? t[i] : k0[i];
        bitonic_clean_desc(t);
        if (q == 0) {
#pragma unroll
            for (int i = 0; i < 4; ++i) { u32x4 w; w.x = t[4 * i]; w.y = t[4 * i + 1]; w.z = t[4 * i + 2]; w.w = t[4 * i + 3]; *(LAS u32x4*)(kbuf + L * 16 + 4 * i) = w; }
        }
        asm volatile("s_waitcnt lgkmcnt(0)" ::: "memory");
    }
    {
        const int hd = lane >> 3, sub = lane & 7; const bool odd = sub & 1;
        unsigned ck[8];
#pragma unroll
        for (int k = 0; k < 7; ++k) {
            const int cidx = 7 * sub + k;
            const unsigned tab = ctab[cidx];
            const unsigned ia = tab & 15u, ib = (tab >> 8) & 15u;
            const unsigned ka = kbuf[hd * 32 + ia], kb = kbuf[hd * 32 + 16 + ib];
            const float v = key_value(ka) + key_value(kb);
            const unsigned u = __float_as_uint(v);
            const unsigned mono = (u & 0x80000000u) ? ~u : (u | 0x80000000u);
            ck[k] = (cidx < 50) ? ((mono & ~255u) | (255u - (16u * ia + ib))) : 0u;
        }
        ck[7] = 0u;
        sort8_desc(ck);
        cross_minmax_x1<true>(ck, odd); clean8_desc(ck);
        cross_rev_max<0x1B>(ck); cross_minmax_x1<false>(ck, odd); clean8_desc(ck);
        cross_rev_max<DPP_HMIR>(ck); cross_minmax_x1<false>(ck, odd); clean8_desc(ck);
        const int pr = sub >> 1;
        const unsigned e0 = pr == 0 ? ck[0] : pr == 1 ? ck[2] : pr == 2 ? ck[4] : ck[6];
        const unsigned e1 = pr == 0 ? ck[1] : pr == 1 ? ck[3] : pr == 2 ? ck[5] : ck[7];
        const unsigned id0 = 255u - (e0 & 255u), id1 = 255u - (e1 & 255u);
        const unsigned ka0 = kbuf[hd * 32 + (id0 >> 4)], kb0 = kbuf[hd * 32 + 16 + (id0 & 15u)];
        const unsigned ka1 = kbuf[hd * 32 + (id1 >> 4)], kb1 = kbuf[hd * 32 + 16 + (id1 & 15u)];
        const float v0 = key_value8(e0), v1 = key_value8(e1);
        const float mx = max_oct(fmaxf(v0, v1));
        const float ev0 = __expf((v0 - mx) * rs2), ev1 = __expf((v1 - mx) * rs2);
        const float inv = 1.f / sum_oct(ev0 + ev1);
        const int rank0 = (odd ? 8 : 0) + 2 * pr;
        u32x2 ew; ew.x = (127u - (ka0 & 127u)) * 128u + (127u - (kb0 & 127u)); ew.y = (127u - (ka1 & 127u)) * 128u + (127u - (kb1 & 127u));
        f32x2 gw; gw.x = ev0 * inv; gw.y = ev1 * inv;
        *(u32x2*)(EIDXg + (size_t)tok * 128 + hd * 16 + rank0) = ew;
        *(f32x2*)(GATEg + (size_t)tok * 128 + hd * 16 + rank0) = gw;
    }
}

DI float dot16_fp8(const u32x4& row, const float (&x)[16]) {
    float sacc = 0.f;
#pragma unroll
    for (int w = 0; w < 4; ++w) { const f32x2 lo = __builtin_amdgcn_cvt_pk_f32_fp8((int)row[w], false), hi2 = __builtin_amdgcn_cvt_pk_f32_fp8((int)row[w], true);
        sacc += lo.x * x[4 * w] + lo.y * x[4 * w + 1] + hi2.x * x[4 * w + 2] + hi2.y * x[4 * w + 3]; }
    return sacc;
}
template <class TT> DI TT ldu(const void* ubase, unsigned off) { return *(const TT*)((const char*)ubase + off); }
typedef _Float16 h2_t __attribute__((ext_vector_type(2)));
DI void peer_u_slice(int sl, int tk_first, int tk_step, const unsigned char* XN8g, const int* EIDXg, const unsigned char* U8s, float* PDOT, int lane) {
    const int es = lane >> 3, c = lane & 7;
    const unsigned char* tb = U8s + (size_t)sl * 16384 * 128;
    const unsigned c16 = 16u * c, eoff = 64u * es, xoff = 128u * sl + 16u * c, poff = (16u * es + c) * 4u;
    const bool b2 = c & 4, b1 = c & 2, b0 = c & 1;
    u32x4 I0[2], I1[2], I2[2], rowsA[8], rowsB[8], rowsC[8], x0, x1, x2;
#define LD_E8(ib, tk, h) do { const int _t = (tk) < T ? (tk) : T - 1; const int* _eb = EIDXg + (size_t)_t * 128 + 8 * (h); ib[0] = ldu<u32x4>(_eb, eoff); ib[1] = ldu<u32x4>(_eb, eoff + 16u); } while (0)
#define LD_R8(rows, ib, tbl) do { _Pragma("unroll") for (int _q = 0; _q < 2; ++_q) _Pragma("unroll") for (int _r = 0; _r < 4; ++_r) rows[4 * _q + _r] = ldu<u32x4>(tbl, ib[_q][_r] * 128u + c16); } while (0)
#define LD_X(xx, tk) do { const int _t = (tk) < T ? (tk) : T - 1; xx = ldu<u32x4>(XN8g + (size_t)_t * 1024, xoff); } while (0)
#define U_COMPUTE8(rows, xx, tk, h) do { h2_t _x[8]; _Pragma("unroll") for (int _w = 0; _w < 4; ++_w) { _x[2 * _w] = __builtin_amdgcn_cvt_scalef32_pk_f16_fp8(xx[_w], 1.0f, false); _x[2 * _w + 1] = __builtin_amdgcn_cvt_scalef32_pk_f16_fp8(xx[_w], 1.0f, true); } \
        float _p[8]; _Pragma("unroll") for (int _i = 0; _i < 8; ++_i) { if (_i > 0) asm volatile("" : "+v"(rows[_i]) : "v"(_p[_i - 1])); float _s = 0.f; \
            _Pragma("unroll") for (int _w = 0; _w < 4; ++_w) { _s = __builtin_amdgcn_fdot2(__builtin_amdgcn_cvt_scalef32_pk_f16_fp8(rows[_i][_w], 1.0f, false), _x[2 * _w], _s, false); \
                _s = __builtin_amdgcn_fdot2(__builtin_amdgcn_cvt_scalef32_pk_f16_fp8(rows[_i][_w], 1.0f, true), _x[2 * _w + 1], _s, false); } _p[_i] = _s; } \
        float _q4[4], _q2[2]; \
        _Pragma("unroll") for (int _k = 0; _k < 4; ++_k) _q4[_k] = tr_x4(_p[_k], _p[_k + 4], b2); \
        _Pragma("unroll") for (int _k = 0; _k < 2; ++_k) _q2[_k] = tr_x2(_q4[_k], _q4[_k + 2], b1); \
        const float _r1 = tr_x1(_q2[0], _q2[1], b0); \
        if ((tk) < T) { float* _pb = PDOT + ((size_t)sl * T + (tk)) * 128 + 8 * (h); *(float*)((char*)_pb + poff) = _r1; } } while (0)
    int t0 = tk_first;
    LD_E8(I0, t0, 0); LD_E8(I1, t0, 1); LD_E8(I2, t0 + tk_step, 0); LD_X(x0, t0); LD_R8(rowsA, I0, tb); LD_R8(rowsB, I1, tb);
#pragma unroll 1
    for (; t0 < T; t0 += 3 * tk_step) {
        const int t1 = t0 + tk_step, t2 = t1 + tk_step, t3 = t2 + tk_step;
        LD_E8(I0, t1, 1);           LD_R8(rowsC, I2, tb); LD_X(x1, t1); U_COMPUTE8(rowsA, x0, t0, 0);
        LD_E8(I1, t2, 0);           LD_R8(rowsA, I0, tb);               U_COMPUTE8(rowsB, x0, t0, 1);
        LD_E8(I2, t2, 1);           LD_R8(rowsB, I1, tb); LD_X(x2, t2); U_COMPUTE8(rowsC, x1, t1, 0);
        LD_E8(I0, t3, 0);           LD_R8(rowsC, I2, tb);               U_COMPUTE8(rowsA, x1, t1, 1);
        LD_E8(I1, t3, 1);           LD_R8(rowsA, I0, tb); LD_X(x0, t3); U_COMPUTE8(rowsB, x2, t2, 0);
        LD_E8(I2, t3 + tk_step, 0); LD_R8(rowsB, I1, tb);               U_COMPUTE8(rowsC, x2, t2, 1);
    }
#undef U_COMPUTE8
#undef LD_X
}
template <int NT> DI void peer_cj_tokens(int tok0, int tstride, const int* EIDXg, const float* GATEg, const float* PDOT, const float* usc, const float* vsc, float* CJg, float* CMAXg, int lane) {
    int e[NT][2]; float d[NT][2], g[NT][2];
#pragma unroll
    for (int i = 0; i < NT; ++i) { const int tok = tok0 + i * tstride, tc = tok < T ? tok : T - 1;
#pragma unroll
        for (int hh = 0; hh < 2; ++hh) { const int j = lane + 64 * hh; e[i][hh] = EIDXg[(size_t)tc * 128 + j]; g[i][hh] = GATEg[(size_t)tc * 128 + j]; float a = 0.f;
#pragma unroll
            for (int x = 0; x < 8; ++x) a += PDOT[((size_t)x * T + tc) * 128 + j];
            d[i][hh] = a; } }
    float us[NT][2], vs[NT][2];
#pragma unroll
    for (int i = 0; i < NT; ++i)
#pragma unroll
        for (int hh = 0; hh < 2; ++hh) { us[i][hh] = usc[e[i][hh]]; vs[i][hh] = vsc[e[i][hh]]; }
#pragma unroll
    for (int i = 0; i < NT; ++i) { const int tok = tok0 + i * tstride;
        float cv[2], cm = 0.f;
#pragma unroll
        for (int hh = 0; hh < 2; ++hh) {
            const float hraw = d[i][hh] * us[i][hh] * (1.f / 64.f);
            const float hid = 0.5f * hraw * (1.f + erff(hraw * 0.70710678118654752f));
            cv[hh] = hid * g[i][hh] * vs[i][hh];
            cm = fmaxf(cm, fabsf(cv[hh]));
        }
        cm = wave_max(cm);
        const float inv = cm > 0.f ? 1.f / cm : 0.f;
        if (tok < T) { CJg[(size_t)tok * 128 + lane] = cv[0] * inv; CJg[(size_t)tok * 128 + 64 + lane] = cv[1] * inv; if (lane == 0) CMAXg[tok] = cm; }
    }
}
DI void peer_v_slice(int sl, int tk_first, int tk_step, float* out, const int* EIDXg, const float* CJg, const float* CMAXg, const unsigned char* V8s, bf16_t* A4g, float* SSQg, int lane) {
    const int es = lane >> 3, c = lane & 7;
    const unsigned char* tb = V8s + (size_t)sl * 16384 * 128;
    const unsigned c16 = 16u * c, eoff = 64u * es, ob = 128u * sl + 16u * c + 2u * es;
    const bool b5 = lane & 32, b4 = lane & 16, b3 = lane & 8;
    u32x4 I0[2], I1[2], I2[2], rowsA[8], rowsB[8], rowsC[8]; f32x4 cA[2], cB[2], cC[2]; f32x2 h0, h1, h2;
#define LD_C8(cc, tk, h) do { const int _t = (tk) < T ? (tk) : T - 1; const float* _cb = CJg + (size_t)_t * 128 + 8 * (h); cc[0] = ldu<f32x4>(_cb, eoff); cc[1] = ldu<f32x4>(_cb, eoff + 16u); } while (0)
#define V_AXPY8(rows, cc) do { _Pragma("unroll") for (int _q = 0; _q < 2; ++_q) _Pragma("unroll") for (int _r = 0; _r < 4; ++_r) { const _Float16 _ch = (_Float16)cc[_q][_r]; const h2_t _c2 = {_ch, _ch}; \
            _Pragma("unroll") for (int _w = 0; _w < 4; ++_w) { acch[2 * _w] = __builtin_amdgcn_cvt_scalef32_pk_f16_fp8(rows[4 * _q + _r][_w], 1.0f, false) * _c2 + acch[2 * _w]; \
                acch[2 * _w + 1] = __builtin_amdgcn_cvt_scalef32_pk_f16_fp8(rows[4 * _q + _r][_w], 1.0f, true) * _c2 + acch[2 * _w + 1]; } \
              \
            if (4 * _q + _r < 7) asm volatile("" : "+v"(acch[0]), "+v"(acch[1]), "+v"(acch[2]), "+v"(acch[3]), "+v"(acch[4]), "+v"(acch[5]), "+v"(acch[6]), "+v"(acch[7]), "+v"(rows[(4 * _q + _r + 1) & 7])); \
            else asm volatile("" : "+v"(acch[0]), "+v"(acch[1]), "+v"(acch[2]), "+v"(acch[3]), "+v"(acch[4]), "+v"(acch[5]), "+v"(acch[6]), "+v"(acch[7])); } } while (0)
#define LD_H(hh, tk) do { const int _t = (tk) < T ? (tk) : T - 1; hh = ldu<f32x2>(out + (size_t)_t * 1024, ob * 4u); } while (0)
#define V_ZERO() do { _Pragma("unroll") for (int _i = 0; _i < 8; ++_i) acch[_i] = (h2_t){(_Float16)0.f, (_Float16)0.f}; } while (0)
#define V_FINAL(hh, tk) do { float _a[16]; _Pragma("unroll") for (int _i = 0; _i < 8; ++_i) { _a[2 * _i] = (float)acch[_i].x; _a[2 * _i + 1] = (float)acch[_i].y; } \
        const float _cm = CMAXg[(tk) < T ? (tk) : T - 1]; \
        float _q8[8], _q4[4], _q2[2]; \
        _Pragma("unroll") for (int _k = 0; _k < 8; ++_k) _q8[_k] = tr_x32(_a[_k], _a[_k + 8]); \
        _Pragma("unroll") for (int _k = 0; _k < 4; ++_k) _q4[_k] = tr_x16(_q8[_k], _q8[_k + 4]); \
        _Pragma("unroll") for (int _k = 0; _k < 2; ++_k) _q2[_k] = tr_x8(_q4[_k], _q4[_k + 2], b3); \
        const float _ha = hh.x + _q2[0] * _cm, _hb = hh.y + _q2[1] * _cm; const float _ssq = wave_sum(_ha * _ha + _hb * _hb); \
        if ((tk) < T) { *(f32x2*)((char*)(out + (size_t)(tk) * 1024) + ob * 4u) = (f32x2){_ha, _hb}; *(unsigned*)((char*)(A4g + (size_t)(tk) * 1024) + ob * 2u) = cvtpk(_ha, _hb); \
            if (lane == 0) SSQg[(size_t)sl * T + (tk)] = _ssq; } } while (0)
    h2_t acch[8];
    int t0 = tk_first;
    LD_E8(I0, t0, 0); LD_E8(I1, t0, 1); LD_E8(I2, t0 + tk_step, 0); LD_H(h0, t0); LD_R8(rowsA, I0, tb); LD_C8(cA, t0, 0); LD_R8(rowsB, I1, tb); LD_C8(cB, t0, 1);
#pragma unroll 1
    for (; t0 < T; t0 += 3 * tk_step) {
        const int t1 = t0 + tk_step, t2 = t1 + tk_step, t3 = t2 + tk_step;
        LD_E8(I0, t1, 1);           LD_R8(rowsC, I2, tb); LD_C8(cC, t1, 0); LD_H(h1, t1); V_ZERO(); V_AXPY8(rowsA, cA);
        LD_E8(I1, t2, 0);           LD_R8(rowsA, I0, tb); LD_C8(cA, t1, 1);                          V_AXPY8(rowsB, cB); V_FINAL(h0, t0);
        LD_E8(I2, t2, 1);           LD_R8(rowsB, I1, tb); LD_C8(cB, t2, 0); LD_H(h2, t2); V_ZERO(); V_AXPY8(rowsC, cC);
        LD_E8(I0, t3, 0);           LD_R8(rowsC, I2, tb); LD_C8(cC, t2, 1);                          V_AXPY8(rowsA, cA); V_FINAL(h1, t1);
        LD_E8(I1, t3, 1);           LD_R8(rowsA, I0, tb); LD_C8(cA, t3, 0); LD_H(h0, t3); V_ZERO(); V_AXPY8(rowsB, cB);
        LD_E8(I2, t3 + tk_step, 0); LD_R8(rowsB, I1, tb); LD_C8(cB, t3, 1);                          V_AXPY8(rowsC, cC); V_FINAL(h2, t2);
    }
#undef V_FINAL
#undef V_ZERO
#undef LD_H
#undef V_AXPY8
#undef LD_C8
#undef LD_R8
#undef LD_E8
}

typedef const __attribute__((address_space(4))) unsigned long long* karg_ptr_t;
DI karg_ptr_t kargs() { karg_ptr_t p = (karg_ptr_t)__builtin_amdgcn_kernarg_segment_ptr(); asm volatile("" : "+s"(p)); return p; }
#define GAS1 __attribute__((address_space(1)))
#define KIN(k) ((const float*)(const GAS1 float*)kargs()[k])
#define KOUT() ((float*)(GAS1 float*)kargs()[18])
#define KWS() ((unsigned char*)(GAS1 unsigned char*)kargs()[19])

__global__ void __launch_bounds__(512, 2) fwd_kernel(Params P) {
    extern __shared__ __attribute__((aligned(16))) unsigned char lds_raw[];
    LAS unsigned char* lds = (LAS unsigned char*)lds_raw;
    const int tid = threadIdx.x, lane = tid & 63, wid = __builtin_amdgcn_readfirstlane(tid >> 6);
    const int wg = blockIdx.x, nwg = gridDim.x;
    const int gwave = wg * 8 + wid, nwaves = nwg * 8;
    const int lo = P.ph_lo, hi = P.ph_hi;

    volatile LAS unsigned* misc = (volatile LAS unsigned*)(lds + LDS_BYTES - 64);
    if (tid < 16) misc[tid] = 0u;
    __syncthreads();
    { unsigned* xcw = (unsigned*)(KWS() + WS_CTL) + CW_XC;
      if (tid == 0) { const unsigned xcc = xb_xcc_id(); misc[5] = xcc; misc[4] = xb_add(xcw + 64 * xcc, 1u); } }
    XcdBarrier bar; bar.bar = (unsigned*)(KWS() + WS_CTL) + CW_BAR; bar.x = 0; bar.st = misc;
    if (hi - lo > 1) bar = xcd_barrier_post((unsigned*)(KWS() + WS_CTL) + CW_BAR, misc);

#define kmean   ((float*)(KWS() + WS_KMEAN))
#define biasTab ((float*)(KWS() + WS_BIAS))
#define WinT    ((bf16_t*)(KWS() + WS_WIN))
#define WoutT   ((bf16_t*)(KWS() + WS_WOUT))
#define WqT     ((bf16_t*)(KWS() + WS_WQ))
#define WgT     ((bf16_t*)(KWS() + WS_WG))
#define WpleT   ((bf16_t*)(KWS() + WS_WPLE))
#define U8      ((unsigned char*)(KWS() + WS_U))
#define V8      ((unsigned char*)(KWS() + WS_V))
#define USC     ((float*)(KWS() + WS_USC))
#define VSC     ((float*)(KWS() + WS_VSC))
#define XN      ((bf16_t*)(KWS() + WS_XN))
#define PB      ((bf16_t*)(KWS() + WS_PB))
#define Qm      ((bf16_t*)(KWS() + WS_QM))
#define Km      ((bf16_t*)(KWS() + WS_KM))
#define VtM     ((bf16_t*)(KWS() + WS_VTM))
#define Qs      ((bf16_t*)(KWS() + WS_QS))
#define Ks      ((bf16_t*)(KWS() + WS_KS))
#define VtS     ((bf16_t*)(KWS() + WS_VTS))
#define Oraw    ((bf16_t*)(KWS() + WS_ORAW))
#define A2      ((bf16_t*)(KWS() + WS_A2))
#define A3      ((bf16_t*)(KWS() + WS_A3))
#define SC      ((float*)(KWS() + WS_SC))
#define EIDXG   ((int*)(KWS() + WS_EIDX))
#define GATEG   ((float*)(KWS() + WS_GATE))
#define CJG     ((float*)(KWS() + WS_CJ))
#define RS2G    ((float*)(KWS() + WS_RS2))
#define SSQG    ((float*)(KWS() + WS_SSQ))
#define PDOTG   ((float*)(KWS() + WS_PDOT))
#define A4G     ((bf16_t*)(KWS() + WS_A4))
#define XN2G    ((unsigned char*)(KWS() + WS_XN2))

#define IN(k) (lo <= (k) && (k) < hi)
#ifndef PROBE_PHASE
#define PROBE_PHASE -1
#endif
#ifndef PROBE_REPS
#define PROBE_REPS 1
#endif
#define REP(k) for (int _rep = 0; _rep < ((k) == PROBE_PHASE ? PROBE_REPS : 1); ++_rep)
#define SEAM(k) do { if (IN(k) && IN((k) + 1)) xcd_barrier(bar); } while (0)

    if (IN(0)) REP(0) {
        LAS float* scr = (LAS float*)lds;
        p0_transpose<true>(KIN(IN_WIN), 1024, 3072, WinT, scr, tid, wg, nwg);
        p0_transpose<false>(KIN(IN_WOUT), 1024, 1024, WoutT, scr, tid, wg, nwg);
        p0_transpose<false>(KIN(IN_WPG), 1024, 1024, WgT, scr, tid, wg, nwg, KIN(IN_PLE_NORM));
        p0_transpose<false>(KIN(IN_WPLE), 256, 1024, WpleT, scr, tid, wg, nwg);
        p0_fold(KIN(IN_PQ), KIN(IN_SUBK), KIN(IN_FFN_NORM), WqT, wid, lane, wg, nwg);
        const size_t gtid = (size_t)wg * 512 + tid, nthr = (size_t)nwg * 512;
        p0_convert(KIN(IN_P), PB, (size_t)T * 256, gtid, nthr);
        { const float* xp = KIN(IN_X); const float* gp = KIN(IN_ATTN_NORM); bf16_t* xo = XN;
          for (int row = gwave; row < T; row += 2 * nwaves) rmsnorm_rows2_bf16(xp, gp, xo, row, row + nwaves, lane); }
        if (wg == 0) {
            for (int idx = tid; idx < 8 * 129; idx += 512) {
                const int h = idx / 129, dist = idx % 129;
                int bk;
                if (dist < 16) bk = dist;
                else { const float v = logf((float)dist / 16.f) / 2.0794415416798357f * 16.f; bk = 16 + (int)v; bk = bk > 31 ? 31 : bk; }
                biasTab[h * 132 + dist] = KIN(IN_RELB)[bk * 8 + h] * LOG2E;
            }
        }
    }
    SEAM(0);
    if (IN(1)) REP(1) {
        pg8::Gemm g{XN, WinT, T, NPROJ, 1024}; pg8::StaticOrder S; S.init(T, NPROJ, nwg, wg);
        EpiQKV E{Qm, KIN(IN_QNORM), KIN(IN_KNORM)};
        pg8::gemm_phase<EpiQKV, pg8::StaticOrder, true, true>(lds, g, S, E);
    }
    SEAM(1);
    if (IN(2)) REP(2) {
        for (int item = gwave; item < 512; item += nwaves) {
            const int bhh = item >> 3, blk = item & 7;
            float sacc[4][8];
#pragma unroll
            for (int q = 0; q < 4; ++q)
#pragma unroll
                for (int j = 0; j < 8; ++j) sacc[q][j] = 0.f;
            const bf16_t* base = Km + ((size_t)bhh * 64 + blk * 8) * 2048 + lane * 8;
#pragma unroll 2
            for (int t8 = 0; t8 < 8; ++t8)
#pragma unroll
                for (int q = 0; q < 4; ++q) { const bf16x8 v = *(const bf16x8*)(base + (size_t)t8 * 2048 + q * 512);
#pragma unroll
                    for (int j = 0; j < 8; ++j) sacc[q][j] += bf2f(v[j]); }
#pragma unroll
            for (int q = 0; q < 4; ++q)
#pragma unroll
                for (int j = 0; j < 8; ++j) { float v = sacc[q][j];
                    sacc[q][j] = sum_x16(sum_row16(v)); }
            if ((lane & 31) == 0) {
                const int hh = lane >> 5;
#pragma unroll
                for (int q = 0; q < 4; ++q)
#pragma unroll
                    for (int j = 0; j < 8; ++j) kmean[(size_t)item * 64 + 16 * q + 8 * hh + j] = sacc[q][j] * (1.f / 256.f);
            }
        }
    }
    SEAM(2);
    if (IN(3)) REP(3) {
        const float* pu = KIN(IN_PU); const float* pv = KIN(IN_PV); unsigned char* u8 = U8; unsigned char* v8 = V8; float* usc_ = USC; float* vsc_ = VSC;
        const bf16_t* qm_ = Qm; const bf16_t* km_ = Km; const bf16_t* vtm_ = VtM; const bf16_t* qs_ = Qs; const bf16_t* ks_ = Ks; const bf16_t* vts_ = VtS;
        const float* kmn_ = kmean; const float* bt_ = biasTab; bf16_t* a2_ = A2;
        const float* gm_ = KIN(IN_ONM); const float* gs_ = KIN(IN_ONS);
        LAS unsigned char* ot = lds;
        LAS float* biasLds = (LAS float*)(lds + 34816);
        for (int i = tid; i < 8 * 132; i += 512) biasLds[i] = bt_[i];
        __syncthreads();
        int qrow = gwave;
        for (int u = gwave; u < 8192; u += nwaves) {
            const int grp = u >> 12, i = u & 4095;
            const int half = i >> 11, j = i & 2047;
            const int qt = half ? (j >> 6) : 63 - (j >> 6), bh = j & 63;
            const int b = bh >> 3, h = bh & 7;
            if (grp == 0) moba_unit(b, h, qt, qm_, km_, vtm_, kmn_, biasLds, ot, lane);
            else sb_unit(b, h, qt, qs_, ks_, vts_, ot, lane);
            __syncthreads();
            {
                const float* gg = grp ? gs_ : gm_;
                const f32x4 g0 = *(const f32x4*)(gg + 8 * lane), g1 = *(const f32x4*)(gg + 8 * lane + 4);
#pragma unroll
                for (int rr = 0; rr < 4; ++rr) {
                    const int row = 4 * wid + rr;
                    const bf16x8 v = *(const LAS bf16x8*)(ot + row * OT_PITCH + lane * 16);
                    float f[8], sq = 0.f;
#pragma unroll
                    for (int e = 0; e < 8; ++e) { f[e] = bf2f(v[e]); sq += f[e] * f[e]; }
                    sq = wave_sum(sq);
                    const float rs = rsqrtf(sq * (1.f / 512.f) + EPS);
                    u32x4 w; w.x = cvtpk(f[0] * rs * g0.x, f[1] * rs * g0.y); w.y = cvtpk(f[2] * rs * g0.z, f[3] * rs * g0.w);
                    w.z = cvtpk(f[4] * rs * g1.x, f[5] * rs * g1.y); w.w = cvtpk(f[6] * rs * g1.z, f[7] * rs * g1.w);
                    *(u32x4*)(a2_ + (size_t)(b * 2048 + qt * 32 + row) * 1024 + grp * 512 + 8 * lane) = w;
                }
            }
            __syncthreads();
            for (int k = 0; k < 1 && qrow < 16384; ++k, qrow += 2 * nwaves) p0_quant_rows4(pu, pv, u8, v8, usc_, vsc_, qrow, qrow + nwaves, lane);
        }
        for (; qrow < 16384; qrow += 2 * nwaves) p0_quant_rows4(pu, pv, u8, v8, usc_, vsc_, qrow, qrow + nwaves, lane);
    }
    SEAM(3);
    if (IN(5)) REP(5) {
        pg8::Gemm g{A2, WoutT, T, 1024, 1024}; pg8::StaticOrder S; S.init(T, 1024, nwg, wg);
        EpiRes E{KIN(IN_X), KOUT(), A3};
        pg8::gemm_phase<EpiRes, pg8::StaticOrder, true, true>(lds, g, S, E);
    }
    SEAM(5);
    if (IN(6)) REP(6) {
        pg8::Gemm g{A3, WqT, T, 2048, 1024}; pg8::StaticOrder S; S.init(T, 2048, nwg, wg);
        EpiBf E{(bf16_t*)SC, 2048};
        pg8::gemm_phase<EpiBf, pg8::StaticOrder, true, true>(lds, g, S, E);
    }
    SEAM(6);
    if (IN(7)) REP(7) {
        LAS float* wl = (LAS float*)(lds + wid * 4096);
        {
            const int c = lane; int ca, cb;
            if (c < 16) { ca = 0; cb = c; } else if (c < 24) { ca = 1; cb = c - 16; } else if (c < 29) { ca = 2; cb = c - 24; } else if (c < 33) { ca = 3; cb = c - 29; }
            else if (c < 36) { ca = 4; cb = c - 33; } else if (c < 42) { ca = 5 + ((c - 36) >> 1); cb = (c - 36) & 1; } else { ca = (c - 34) & 15; cb = 0; }
            ((LAS unsigned*)(wl + 768))[lane] = (unsigned)ca | ((unsigned)cb << 8);
            asm volatile("s_waitcnt lgkmcnt(0)" ::: "memory");
        }
        const float* h1p = KOUT(); const bf16_t* scp = (const bf16_t*)SC; const float* gfp = KIN(IN_FFN_NORM); int* eip = EIDXG; float* gtp = GATEG; unsigned char* xnp = XN2G;
        TopkIn inA, inB;
        peer_topk_load(inA, gwave, h1p, scp, lane);
        for (int tok = gwave; tok < T; tok += 2 * nwaves) {
            peer_topk_load(inB, tok + nwaves, h1p, scp, lane);
            peer_topk_token(tok, inA, gfp, eip, gtp, xnp, wl, lane);
            peer_topk_load(inA, tok + 2 * nwaves, h1p, scp, lane);
            if (tok + nwaves < T) peer_topk_token(tok + nwaves, inB, gfp, eip, gtp, xnp, wl, lane);
        }
    }
    SEAM(7);
    int sl_first = 0, sl_step = 1, tk_first = 0, tk_step = 8;
    if (IN(8) || IN(10)) {
        __syncthreads();
        const unsigned myx = misc[5], myrank = misc[4];
        unsigned nx = 0, myidx = 0, nloc = 1;
        unsigned* xc = (unsigned*)(KWS() + WS_CTL) + CW_XC;
#pragma unroll
        for (unsigned j = 0; j < 16; ++j) { const unsigned cj = xb_ld(xc + 64 * j); if (cj > 0u) { if (j < myx) ++myidx; ++nx; } if (j == myx) nloc = cj; }
        sl_first = __builtin_amdgcn_readfirstlane((int)myidx); sl_step = __builtin_amdgcn_readfirstlane((int)(nx > 0u ? nx : 1u));
        tk_first = __builtin_amdgcn_readfirstlane((int)myrank * 8 + wid); tk_step = __builtin_amdgcn_readfirstlane((int)(nloc > 0u ? nloc : 1u) * 8);
    }
    if (IN(8)) REP(8) {
        const unsigned char* xnp = XN2G; const int* eip = EIDXG; const unsigned char* u8p = U8; float* pdp = PDOTG;
        for (int sl = sl_first; sl < 8; sl += sl_step) peer_u_slice(sl, tk_first, tk_step, xnp, eip, u8p, pdp, lane);
    }
    SEAM(8);
    if (IN(9)) REP(9) {
        const int* eip = EIDXG; const float* gtp = GATEG; const float* pdp = PDOTG; const float* usp = USC; const float* vsp = VSC; float* cjp = CJG; float* cmp_ = RS2G;
        for (int tok = gwave; tok < T; tok += 4 * nwaves) peer_cj_tokens<4>(tok, nwaves, eip, gtp, pdp, usp, vsp, cjp, cmp_, lane);
    }
    SEAM(9);
    if (IN(10)) REP(10) {
        float* outp = KOUT(); const int* eip = EIDXG; const float* cjp = CJG; const float* cmp_ = RS2G; const unsigned char* v8p = V8; bf16_t* a4p = A4G; float* sqp = SSQG;
        for (int sl = sl_first; sl < 8; sl += sl_step) peer_v_slice(sl, tk_first, tk_step, outp, eip, cjp, cmp_, v8p, a4p, sqp, lane);
    }
    SEAM(10);
    if (IN(11)) REP(11) {
        bf16_t* PW = Oraw;
        { int kple = 256; asm volatile("" : "+s"(kple));
          pg8::Gemm g{PB, WpleT, T, 1024, kple}; pg8::StaticOrder S; S.init(T, 1024, nwg, wg);
          EpiBf E{PW, 1024};
          pg8::gemm_phase<EpiBf, pg8::StaticOrder, true, true>(lds, g, S, E); }
        asm volatile("s_waitcnt vmcnt(0)" ::: "memory");
        __syncthreads();
        { pg8::Gemm g{A4G, WgT, T, 1024, 1024}; pg8::StaticOrder S; S.init(T, 1024, nwg, wg);
          EpiGate E{KOUT(), PW, SSQG};
          pg8::gemm_phase<EpiGate, pg8::StaticOrder, true, true>(lds, g, S, E); }
    }
#undef IN
#undef SEAM
}

extern "C" void kernel_launch(void* const* d_in, const int* in_sizes, int n_in, void* d_out, int out_size, void* d_ws, size_t ws_size, hipStream_t stream) {
    static int grid = 0;
    if (grid == 0) {
        if (n_in != 18 || out_size != T * DM || ws_size < WS_END) { fprintf(stderr, "kernel_launch: unexpected shapes (n_in %d out %d ws %zu)\n", n_in, out_size, ws_size); grid = -1; return; }
        int dev = 0, cus = 0, per_cu = 0;
        if (hipGetDevice(&dev) != hipSuccess || hipDeviceGetAttribute(&cus, hipDeviceAttributeMultiprocessorCount, dev) != hipSuccess) { grid = -1; return; }
        if (hipFuncSetAttribute((const void*)fwd_kernel, hipFuncAttributeMaxDynamicSharedMemorySize, LDS_BYTES) != hipSuccess) { fprintf(stderr, "kernel_launch: hipFuncSetAttribute failed\n"); grid = -1; return; }
        if (hipOccupancyMaxActiveBlocksPerMultiprocessor(&per_cu, (const void*)fwd_kernel, 512, LDS_BYTES) != hipSuccess || per_cu < 1)
            fprintf(stderr, "kernel_launch: note: occupancy query reports %d\n", per_cu);
        (void)hipGetLastError();
        grid = cus - (cus % 8);
    }
    if (grid < 0) return;
    if (hipMemsetAsync((char*)d_ws + WS_CTL, 0, CTL_ZERO_BYTES, stream) != hipSuccess) return;
    Params p{};
    for (int i = 0; i < 18; ++i) p.in[i] = (const float*)d_in[i];
    p.out = (float*)d_out; p.ws = (unsigned char*)d_ws;
    p.ph_lo = 0; p.ph_hi = NPHASE;
    hipLaunchKernelGGL(fwd_kernel, dim3(grid), dim3(512), LDS_BYTES, stream, p);
}
```

```cpp
#include <hip/hip_runtime.h>
#include <stdint.h>
#include <stdio.h>

#ifndef N_LAUNCHES
#define N_LAUNCHES 1
#endif

#define DI __device__ __forceinline__
#define LAS __attribute__((address_space(3)))

typedef unsigned short bf16_t;
typedef short bf16x8 __attribute__((ext_vector_type(8)));
typedef float f32x16 __attribute__((ext_vector_type(16)));
typedef float f32x4 __attribute__((ext_vector_type(4)));
typedef float f32x2 __attribute__((ext_vector_type(2)));
typedef unsigned u32x4 __attribute__((ext_vector_type(4)));
typedef unsigned u32x2 __attribute__((ext_vector_type(2)));
typedef __bf16 bf16x2_t __attribute__((ext_vector_type(2)));

constexpr int BATCH = 8, SEQ = 2048, DM = 1024, T = BATCH * SEQ;
constexpr int NPROJ = 3072;
constexpr float EPS = 1e-6f;
constexpr float LOG2E = 1.4426950408889634f;
constexpr float SCL2 = 0.125f * LOG2E;
constexpr int NPHASE = 12;

constexpr size_t MiB = 1u << 20;
constexpr size_t WS_CTL = 0, CTL_ZERO_BYTES = 256 * 1024 + 128 * 1024;
constexpr size_t WS_KMEAN = 256 * 1024;
constexpr size_t WS_BIAS = 512 * 1024;
constexpr size_t WS_WIN = 1 * MiB, WS_WOUT = 7 * MiB, WS_WQ = 9 * MiB, WS_WG = 13 * MiB, WS_WPLE = 15 * MiB;
constexpr size_t WS_U = 16 * MiB, WS_V = 32 * MiB;
constexpr size_t WS_USC = 640 * 1024, WS_VSC = 704 * 1024;
constexpr size_t WS_XN2 = 48 * MiB;
constexpr size_t WS_XN = 80 * MiB;
constexpr size_t WS_PB = 112 * MiB;
constexpr size_t WS_QM = 120 * MiB, WS_KM = 136 * MiB, WS_VTM = 152 * MiB, WS_QS = 168 * MiB, WS_KS = 184 * MiB, WS_VTS = 200 * MiB;
constexpr size_t WS_ORAW = 216 * MiB;
constexpr size_t WS_A2 = 80 * MiB;
constexpr size_t WS_A3 = 120 * MiB;
constexpr size_t WS_SC = 152 * MiB;
constexpr size_t WS_EIDX = 80 * MiB, WS_GATE = 88 * MiB, WS_CJ = 96 * MiB, WS_RS2 = 104 * MiB, WS_SSQ = 105 * MiB;
constexpr size_t WS_PDOT = 120 * MiB;
constexpr size_t WS_A4 = 184 * MiB;
constexpr size_t WS_END = 248 * MiB;

constexpr int CW_XC = 8192;
constexpr int CW_BAR = 4096;

constexpr int LDS_BYTES = 147456;

#define XB_TMO      128
#define XB_XCNT(j)  (256  + 64 * (j))
#define XB_XSUB(j)  (1280 + 64 * (j))
#define XB_XGEN(j)  (2304 + 64 * (j))
#define XB_TOP      3328
#define XB_TOPGEN   3392
#define XCD_BAR_WORDS 3456
#define XB_SPIN_CAP (1u << 18)

__device__ __forceinline__ unsigned xb_ld(unsigned* p)              { return __hip_atomic_load(p, __ATOMIC_RELAXED, __HIP_MEMORY_SCOPE_AGENT); }
__device__ __forceinline__ unsigned xb_add(unsigned* p, unsigned v) { return __hip_atomic_fetch_add(p, v, __ATOMIC_RELAXED, __HIP_MEMORY_SCOPE_AGENT); }
__device__ __forceinline__ unsigned xb_xcc_id() { return (unsigned)__builtin_amdgcn_s_getreg((3 << 11) | 20) & 0xFu; }
#define XB_SPIN(cond, bar) do { unsigned _sp = 0; while (cond) { __builtin_amdgcn_s_sleep(1); \
    if ((++_sp & 255u) == 0u) { if (xb_ld(&(bar)[XB_TMO])) break; if (_sp > XB_SPIN_CAP) { atomicAdd(&(bar)[XB_TMO], 1u); break; } } } } while (0)

struct XcdBarrier { unsigned* bar; unsigned x; volatile LAS unsigned* st; };

__device__ __forceinline__ XcdBarrier xcd_barrier_post(unsigned* bar, volatile LAS unsigned* st) {
    XcdBarrier b; b.bar = bar; b.x = xb_xcc_id(); b.st = st;
    if (threadIdx.x == 0) (void)xb_add(&bar[XB_XCNT(b.x)], 1u);
    return b;
}
__device__ __forceinline__ void xcd_barrier_complete(unsigned* bar, unsigned x, unsigned& nloc, unsigned& nx) {
    const unsigned G = gridDim.x * gridDim.y * gridDim.z;
    unsigned sum, cnt, mine, sp = 0u;
    for (;;) {
        sum = 0u; cnt = 0u; mine = 0u;
#pragma unroll
        for (unsigned j = 0; j < 16; ++j) { const unsigned c = xb_ld(&bar[XB_XCNT(j)]); sum += c; cnt += (c > 0u) ? 1u : 0u; mine = (j == x) ? c : mine; }
        if (sum == G) break;
        __builtin_amdgcn_s_sleep(1);
        if ((++sp & 255u) == 0u) { if (xb_ld(&bar[XB_TMO])) break; if (sp > XB_SPIN_CAP) { atomicAdd(&bar[XB_TMO], 1u); break; } }
    }
    nloc = mine > 0u ? mine : 1u; nx = cnt > 0u ? cnt : 1u;
}
__device__ __forceinline__ void xcd_barrier(const XcdBarrier& b) {
    asm volatile("s_waitcnt vmcnt(0)" ::: "memory");
    __syncthreads();
    if (threadIdx.x == 0) {
        unsigned* bar = b.bar;
        __builtin_amdgcn_s_waitcnt(0);
        unsigned nloc = b.st[0], nx = b.st[1];
        if (nloc == 0u) { xcd_barrier_complete(bar, b.x, nloc, nx); b.st[0] = nloc; b.st[1] = nx; }
        const unsigned old = xb_add(&bar[XB_XSUB(b.x)], 1u);
        const unsigned gen = old / nloc;
        if (old + 1u == (gen + 1u) * nloc) {
            __builtin_amdgcn_fence(__ATOMIC_RELEASE, "agent");
            asm volatile("s_waitcnt vmcnt(0)" ::: "memory");
            const unsigned og = xb_add(&bar[XB_TOP], 1u);
            const unsigned tg = og / nx;
            if (og + 1u == (tg + 1u) * nx) xb_add(&bar[XB_TOPGEN], 1u);
            else XB_SPIN(xb_ld(&bar[XB_TOPGEN]) == tg, bar);
            __builtin_amdgcn_fence(__ATOMIC_ACQUIRE, "agent");
            xb_add(&bar[XB_XGEN(b.x)], 1u);
            asm volatile("s_waitcnt vmcnt(0)" ::: "memory");
        } else {
            XB_SPIN(xb_ld(&bar[XB_XGEN(b.x)]) == gen, bar);
            __builtin_amdgcn_fence(__ATOMIC_ACQUIRE, "agent");
            asm volatile("s_waitcnt vmcnt(0)" ::: "memory");
        }
    }
    __syncthreads();
}

DI float bf2f(short v) { return __builtin_bit_cast(float, ((unsigned)(unsigned short)v) << 16); }
DI unsigned cvtpk(float lo, float hi) { f32x2 v = {lo, hi}; bf16x2_t b = __builtin_convertvector(v, bf16x2_t); return __builtin_bit_cast(unsigned, b); }
DI bf16_t f2bf(float f) { return (bf16_t)(cvtpk(f, 0.f) & 0xffffu); }
template <int CTRL> DI float dppf(float v) { return __builtin_bit_cast(float, __builtin_amdgcn_update_dpp(0, __builtin_bit_cast(int, v), CTRL, 0xF, 0xF, true)); }
#define DPP_XOR1 0xB1
#define DPP_XOR2 0x4E
#define DPP_HMIR 0x141
#define DPP_MIR  0x140
DI void swap16(float v, float& a, float& b) { const auto r = __builtin_amdgcn_permlane16_swap(__builtin_bit_cast(unsigned, v), __builtin_bit_cast(unsigned, v), false, false); const unsigned r0 = r[0], r1 = r[1]; a = __builtin_bit_cast(float, r0); b = __builtin_bit_cast(float, r1); }
DI void swap32(float v, float& a, float& b) { const auto r = __builtin_amdgcn_permlane32_swap(__builtin_bit_cast(unsigned, v), __builtin_bit_cast(unsigned, v), false, false); const unsigned r0 = r[0], r1 = r[1]; a = __builtin_bit_cast(float, r0); b = __builtin_bit_cast(float, r1); }
DI float sum_x16(float v) { float a, b; swap16(v, a, b); return a + b; }
DI float sum_x32(float v) { float a, b; swap32(v, a, b); return a + b; }
DI float max_x32(float v) { float a, b; swap32(v, a, b); return fmaxf(a, b); }
DI float sum_row16(float v) { v += dppf<DPP_XOR1>(v); v += dppf<DPP_XOR2>(v); v += dppf<DPP_HMIR>(v); v += dppf<DPP_MIR>(v); return v; }
DI float max_row16(float v) { v = fmaxf(v, dppf<DPP_XOR1>(v)); v = fmaxf(v, dppf<DPP_XOR2>(v)); v = fmaxf(v, dppf<DPP_HMIR>(v)); v = fmaxf(v, dppf<DPP_MIR>(v)); return v; }
DI float sum_oct(float v) { v += dppf<DPP_XOR1>(v); v += dppf<DPP_XOR2>(v); v += dppf<DPP_HMIR>(v); return v; }
DI float max_oct(float v) { v = fmaxf(v, dppf<DPP_XOR1>(v)); v = fmaxf(v, dppf<DPP_XOR2>(v)); v = fmaxf(v, dppf<DPP_HMIR>(v)); return v; }
DI float wave_sum(float v) { return sum_x32(sum_x16(sum_row16(v))); }
DI float wave_max(float v) { v = max_row16(v); float a, b; swap16(v, a, b); return max_x32(fmaxf(a, b)); }
DI float tr_x32(float lo, float hi) { const auto r = __builtin_amdgcn_permlane32_swap(__builtin_bit_cast(unsigned, lo), __builtin_bit_cast(unsigned, hi), false, false); const unsigned r0 = r[0], r1 = r[1]; return __builtin_bit_cast(float, r0) + __builtin_bit_cast(float, r1); }
DI float tr_x16(float lo, float hi) { const auto r = __builtin_amdgcn_permlane16_swap(__builtin_bit_cast(unsigned, lo), __builtin_bit_cast(unsigned, hi), false, false); const unsigned r0 = r[0], r1 = r[1]; return __builtin_bit_cast(float, r0) + __builtin_bit_cast(float, r1); }
DI float tr_x8(float lo, float hi, bool bit) { const float mine = bit ? hi : lo, send = bit ? lo : hi; return mine + dppf<0x128>(send); }
DI float tr_x4(float lo, float hi, bool bit) {
    const int a = __builtin_amdgcn_update_dpp(0, __builtin_bit_cast(int, hi), 0x114, 0xF, 0xA, false);
    const int b = __builtin_amdgcn_update_dpp(a, __builtin_bit_cast(int, lo), 0x104, 0xF, 0x5, false);
    return (bit ? hi : lo) + __builtin_bit_cast(float, b);
}
DI float tr_x2(float lo, float hi, bool bit) { const float mine = bit ? hi : lo, send = bit ? lo : hi; return mine + dppf<DPP_XOR2>(send); }
DI float tr_x1(float lo, float hi, bool bit) { const float mine = bit ? hi : lo, send = bit ? lo : hi; return mine + dppf<DPP_XOR1>(send); }
DI int crow(int r, int hi) { return (r & 3) + 8 * (r >> 2) + 4 * hi; }
#define MFMA32(a, b, c) __builtin_amdgcn_mfma_f32_32x32x16_bf16((a), (b), (c), 0, 0, 0)
DI f32x16 zero16() { f32x16 z; for (int i = 0; i < 16; ++i) z[i] = 0.f; return z; }

struct Params {
    const float* in[18];
    float* out;
    unsigned char* ws;
    int ph_lo, ph_hi;
};

enum { IN_X = 0, IN_P, IN_RELB, IN_ATTN_NORM, IN_WIN, IN_QNORM, IN_KNORM, IN_ONM, IN_ONS, IN_WOUT, IN_FFN_NORM, IN_PQ, IN_SUBK, IN_PU, IN_PV, IN_PLE_NORM, IN_WPG, IN_WPLE };

DI void p0_transpose_wave(const float* W, int K, int N, bf16_t* Wt, LAS float* scr  , int lane, int k0, int n0, bool headperm, const float* kgain) {
    f32x4 v[16];
    const int lr = lane >> 4, lc = 4 * (lane & 15);
#pragma unroll
    for (int i = 0; i < 16; ++i) v[i] = *(const f32x4*)(W + (size_t)(k0 + 4 * i + lr) * N + n0 + lc);
#pragma unroll
    for (int i = 0; i < 16; ++i) { LAS float* d = scr + (4 * i + lr) * 65 + lc; d[0] = v[i].x; d[1] = v[i].y; d[2] = v[i].z; d[3] = v[i].w; }
    __builtin_amdgcn_wave_barrier();
    const int j = lane & 7, nl = lane >> 3;
    f32x4 g0 = {1.f, 1.f, 1.f, 1.f}, g1 = g0;
    if (kgain) { g0 = *(const f32x4*)(kgain + k0 + 8 * j); g1 = *(const f32x4*)(kgain + k0 + 8 * j + 4); }
#pragma unroll
    for (int q = 0; q < 8; ++q) {
        const int nn = 8 * q + nl;
        int n = n0 + nn;
        if (headperm) { const int w = n & 255; n = (n & ~255) + 128 * ((w >> 5) & 1) + 32 * (w >> 6) + (w & 31); }
        const LAS float* sp = scr + (8 * j) * 65 + nn;
        u32x4 w;
        w.x = cvtpk(sp[0] * g0.x, sp[65] * g0.y); w.y = cvtpk(sp[130] * g0.z, sp[195] * g0.w);
        w.z = cvtpk(sp[260] * g1.x, sp[325] * g1.y); w.w = cvtpk(sp[390] * g1.z, sp[455] * g1.w);
        *(u32x4*)(Wt + (size_t)n * K + k0 + 8 * j) = w;
    }
    __builtin_amdgcn_wave_barrier();
}

DI void split_bf16x8(const f32x4& p, const f32x4& q, bf16x8& hi, bf16x8& lo) {
    u32x4 h, l;
    h.x = cvtpk(p.x, p.y); h.y = cvtpk(p.z, p.w); h.z = cvtpk(q.x, q.y); h.w = cvtpk(q.z, q.w);
    const float r0 = p.x - __builtin_bit_cast(float, h.x << 16), r1 = p.y - __builtin_bit_cast(float, h.x & 0xffff0000u), r2 = p.z - __builtin_bit_cast(float, h.y << 16), r3 = p.w - __builtin_bit_cast(float, h.y & 0xffff0000u);
    const float r4 = q.x - __builtin_bit_cast(float, h.z << 16), r5 = q.y - __builtin_bit_cast(float, h.z & 0xffff0000u), r6 = q.z - __builtin_bit_cast(float, h.w << 16), r7 = q.w - __builtin_bit_cast(float, h.w & 0xffff0000u);
    l.x = cvtpk(r0, r1); l.y = cvtpk(r2, r3); l.z = cvtpk(r4, r5); l.w = cvtpk(r6, r7);
    hi = __builtin_bit_cast(bf16x8, h); lo = __builtin_bit_cast(bf16x8, l);
}
DI void p0_fold(const float* wq, const float* sub, const float* gffn, bf16_t* WqT, int wid, int lane, int wg, int nwg) {
    const int r = lane & 31, hi = lane >> 5, dq = wid & 1, nq = wid >> 1;
    for (int item = wg; item < 256; item += nwg) {
        const int dt = item & 15, hh = item >> 4, d0 = dt * 64 + 32 * dq, h = hh >> 1, half = hh & 1;
        const float* ap = wq + (size_t)(d0 + r) * 2048 + h * 256 + half * 128 + 8 * hi;
        const float* bp = sub + half * 16384 + (size_t)(32 * nq + r) * 128 + 8 * hi;
        f32x16 acc = zero16();
#pragma unroll
        for (int st = 0; st < 8; ++st) {
            const f32x4 a0 = *(const f32x4*)(ap + 16 * st), a1 = *(const f32x4*)(ap + 16 * st + 4), b0 = *(const f32x4*)(bp + 16 * st), b1 = *(const f32x4*)(bp + 16 * st + 4);
            bf16x8 ah, al, bh, bl;
            split_bf16x8(a0, a1, ah, al); split_bf16x8(b0, b1, bh, bl);
            acc = MFMA32(ah, bh, acc); acc = MFMA32(ah, bl, acc); acc = MFMA32(al, bh, acc);
        }
        bf16_t* op = WqT + (size_t)(hh * 128 + 32 * nq + r) * 1024 + d0 + 4 * hi;
#pragma unroll
        for (int g4 = 0; g4 < 4; ++g4) {
            const f32x4 gv = *(const f32x4*)(gffn + d0 + 8 * g4 + 4 * hi);
            u32x2 w; w.x = cvtpk(acc[4 * g4] * gv.x, acc[4 * g4 + 1] * gv.y); w.y = cvtpk(acc[4 * g4 + 2] * gv.z, acc[4 * g4 + 3] * gv.w);
            *(u32x2*)(op + 8 * g4) = w;
        }
    }
}

DI void p0_convert(const float* src, bf16_t* dst, size_t n, size_t gtid, size_t nthreads) {
    for (size_t i = gtid * 8; i < n; i += nthreads * 8) {
        const f32x4 a = *(const f32x4*)(src + i), b = *(const f32x4*)(src + i + 4);
        u32x4 o; o.x = cvtpk(a.x, a.y); o.y = cvtpk(a.z, a.w); o.z = cvtpk(b.x, b.y); o.w = cvtpk(b.z, b.w);
        *(u32x4*)(dst + i) = o;
    }
}


DI void p0_quant_finish(const f32x4 (&a)[4], unsigned char* dst, float* scale, int row, int lane) {
    float m = 0.f;
#pragma unroll
    for (int i = 0; i < 4; ++i) m = fmaxf(fmaxf(m, fmaxf(fabsf(a[i].x), fabsf(a[i].y))), fmaxf(fabsf(a[i].z), fabsf(a[i].w)));
    m = wave_max(m);
    const float sc = m > 0.f ? m * (1.f / 440.f) : 1.f, inv = m > 0.f ? 440.f / m : 0.f;
    u32x4 w;
#pragma unroll
    for (int i = 0; i < 4; ++i) {
        const float q0 = fminf(fmaxf(a[i].x * inv, -448.f), 448.f), q1 = fminf(fmaxf(a[i].y * inv, -448.f), 448.f);
        const float q2 = fminf(fmaxf(a[i].z * inv, -448.f), 448.f), q3 = fminf(fmaxf(a[i].w * inv, -448.f), 448.f);
        int p = 0;
        p = __builtin_amdgcn_cvt_pk_fp8_f32(q0, q1, p, false);
        p = __builtin_amdgcn_cvt_pk_fp8_f32(q2, q3, p, true);
        w[i] = (unsigned)p;
    }
    *(u32x4*)(dst + ((size_t)(lane >> 3) * 16384 + row) * 128 + 16 * (lane & 7)) = w;
    if (lane == 0) scale[row] = sc;
}
DI void p0_quant_rows4(const float* pu, const float* pv, unsigned char* u8, unsigned char* v8, float* usc_, float* vsc_, int r0, int r1, int lane) {
    f32x4 a[4][4];
    const int r1c = r1 < 16384 ? r1 : r0;
#pragma unroll
    for (int i = 0; i < 4; ++i) { a[0][i] = *(const f32x4*)(pu + (size_t)r0 * 1024 + 16 * lane + 4 * i); a[1][i] = *(const f32x4*)(pv + (size_t)r0 * 1024 + 16 * lane + 4 * i);
        a[2][i] = *(const f32x4*)(pu + (size_t)r1c * 1024 + 16 * lane + 4 * i); a[3][i] = *(const f32x4*)(pv + (size_t)r1c * 1024 + 16 * lane + 4 * i); }
    p0_quant_finish(a[0], u8, usc_, r0, lane); p0_quant_finish(a[1], v8, vsc_, r0, lane);
    if (r1 < 16384) { p0_quant_finish(a[2], u8, usc_, r1, lane); p0_quant_finish(a[3], v8, vsc_, r1, lane); }
}

DI void rmsnorm_rows2_bf16(const float* x, const float* g, bf16_t* o, int r0, int r1, int lane) {
    f32x4 v[2][4]; float s[2] = {0.f, 0.f};
    const int rr[2] = {r0, r1 < T ? r1 : r0};
#pragma unroll
    for (int q = 0; q < 2; ++q)
#pragma unroll
        for (int j = 0; j < 4; ++j) v[q][j] = ((const f32x4*)(x + (size_t)rr[q] * 1024))[lane + 64 * j];
#pragma unroll
    for (int q = 0; q < 2; ++q) {
#pragma unroll
        for (int j = 0; j < 4; ++j) s[q] += (v[q][j].x * v[q][j].x + v[q][j].y * v[q][j].y) + (v[q][j].z * v[q][j].z + v[q][j].w * v[q][j].w);
        s[q] = wave_sum(s[q]);
    }
#pragma unroll
    for (int q = 0; q < 2; ++q) {
        if (q == 1 && r1 >= T) break;
        const float rs = rsqrtf(s[q] * (1.f / 1024.f) + EPS);
#pragma unroll
        for (int j = 0; j < 4; ++j) { const f32x4 gv = ((const f32x4*)g)[lane + 64 * j];
            u32x2 w; w.x = cvtpk(v[q][j].x * rs * gv.x, v[q][j].y * rs * gv.y); w.y = cvtpk(v[q][j].z * rs * gv.z, v[q][j].w * rs * gv.w);
            ((u32x2*)(o + (size_t)rr[q] * 1024))[lane + 64 * j] = w; }
    }
}

namespace pg8 {
#define PG8_LAS __attribute__((address_space(3)))
typedef unsigned short bf16_t;
typedef short bf16x8 __attribute__((ext_vector_type(8)));
typedef float f32x4 __attribute__((ext_vector_type(4)));
typedef unsigned u32x4 __attribute__((ext_vector_type(4)));
constexpr int BM = 256, BK = 64, HALF = 128, HTB = HALF * BK * 2  , STAGE_BYTES = 8 * HTB, NXCD = 8, WGM = 8;

__host__ __device__ __forceinline__ int lds_byte(int r, int c) { const int st = (r >> 4) * 2 + (c >> 5), rr = r & 15, cc = c & 31, ob = rr * 64 + cc * 2; return st * 1024 + (ob ^ (((ob >> 9) & 1) << 5)); }
__host__ __device__ __forceinline__ void stage_rc(int b, int& R, int& C) { const int st = b / 1024, sb = b % 1024, swz = sb ^ (((sb >> 9) & 1) << 5); R = (st >> 1) * 16 + swz / 64; C = (st & 1) * 32 + (swz % 64) / 2; }
__host__ __device__ __forceinline__ int perm32(int rho) { const int n = rho >> 4, i = rho & 15; return 8 * (i >> 2) + 4 * n + (i & 3); }

struct Unit { int pm, pn; };
struct Gemm { const bf16_t* A; const bf16_t* Bt; int M, N, K; };

struct StaticOrder {
    int nM, nN, nwg, G, c;
    __host__ __device__ void init(int M, int N, int G_, int c_) { nM = M / BM; nN = N / BM; nwg = nM * nN; G = G_; c = c_; }
    __host__ __device__ bool next(int i, Unit& u) const {
        const long L = (long)i * G + c; if (L >= nwg) return false;
        int wgid = (int)L; { const int q = nwg / NXCD, r = nwg % NXCD, xcd = wgid % NXCD, off = wgid / NXCD; wgid = (xcd < r ? xcd * (q + 1) : r * (q + 1) + (xcd - r) * q) + off; }
        const int nig = WGM * nN, gid = wgid / nig, fm = gid * WGM, gsz = (nM - fm) < WGM ? (nM - fm) : WGM;
        u.pm = fm + ((wgid % nig) % gsz); u.pn = (wgid % nig) / gsz; return true;
    }
    __device__ __forceinline__ void a_ready(const Unit&) const {}
    __device__ __forceinline__ void done(const Unit&) const {}
};

template <class Epi, class Sched, bool ALIGN_EPI = false, bool SP2 = false>
__device__ __forceinline__ void gemm_phase(PG8_LAS unsigned char* lds, const Gemm g, const Sched& S, const Epi& E) {
    int tid_ = threadIdx.x; asm volatile("" : "+v"(tid_));
    const int tid = tid_, wid = __builtin_amdgcn_readfirstlane(tid >> 6), lane = tid & 63, wr = wid >> 2, wc = wid & 3, fr = lane & 15, fq = lane >> 4;
    const int K = g.K, nt = K / BK;
    unsigned voffA[2], voffB[2];
#pragma unroll
    for (int i = 0; i < 2; ++i) { int R, C; stage_rc(tid * 16 + i * 8192, R, C); const int Rb = Epi::PERM ? ((R & ~31) + perm32(R & 31)) : R;
        voffA[i] = (unsigned)(R * K + C) * 2u; voffB[i] = (unsigned)(Rb * K + C) * 2u; }
    const size_t kstep = (size_t)(BK * 2);
    const size_t hstep = (size_t)HALF * K * 2;
    const size_t tstep = 2 * hstep;
    const unsigned ldsw = (unsigned)wid * 1024u;
    const int aoff = lds_byte(wr * 64 + fr, fq * 8), boff = lds_byte(wc * 32 + fr, fq * 8);
#define PG8_SA(b, h) (((b) * 2 + (h)) * HTB)
#define PG8_SB(b, h) ((4 + (b) * 2 + (h)) * HTB)
#define PG8_STAGE(bufoff, gbase, voff) do { _Pragma("unroll") for (int _i = 0; _i < 2; ++_i) \
        __builtin_amdgcn_global_load_lds((const unsigned*)((const char*)(gbase) + (voff)[_i]), (PG8_LAS unsigned*)(lds + (bufoff) + ldsw + _i * 8192), 16, 0, 0); } while (0)
#define PG8_LDA(dst, b, h) do { _Pragma("unroll") for (int m = 0; m < 4; ++m) _Pragma("unroll") for (int k = 0; k < 2; ++k) dst[m][k] = *(const PG8_LAS bf16x8*)(lds + PG8_SA(b, h) + aoff + m * 2048 + k * 1024); } while (0)
#define PG8_LDB(dst, b, h) do { _Pragma("unroll") for (int n = 0; n < 2; ++n) _Pragma("unroll") for (int k = 0; k < 2; ++k) dst[n][k] = *(const PG8_LAS bf16x8*)(lds + PG8_SB(b, h) + boff + n * 2048 + k * 1024); } while (0)
#define PG8_MMA(ai, bj, At, Bt) do { __builtin_amdgcn_s_setprio(1); _Pragma("unroll") for (int m = 0; m < 4; ++m) _Pragma("unroll") for (int n = 0; n < 2; ++n) _Pragma("unroll") for (int k = 0; k < 2; ++k) \
        acc[ai][bj][m][n] = __builtin_amdgcn_mfma_f32_16x16x32_bf16(Bt[n][k], At[m][k], acc[ai][bj][m][n], 0, 0, 0); __builtin_amdgcn_s_setprio(0); } while (0)
#define PG8_WAIT_V(n) asm volatile("s_waitcnt vmcnt(" #n ")" ::: "memory")
#define PG8_WAIT_L(n) asm volatile("s_waitcnt lgkmcnt(" #n ")" ::: "memory")
#define PG8_BAR __builtin_amdgcn_s_barrier()
#define PG8_SCHED __builtin_amdgcn_sched_barrier(0)
    Unit cur, nxt; int ui = 0;
    if (!S.next(0, cur)) return;
    f32x4 acc[2][2][4][2];
#pragma unroll
    for (int a = 0; a < 2; ++a)
#pragma unroll
        for (int b = 0; b < 2; ++b)
#pragma unroll
            for (int m = 0; m < 4; ++m)
#pragma unroll
                for (int n = 0; n < 2; ++n) acc[a][b][m][n] = (f32x4){0.f, 0.f, 0.f, 0.f};
    bf16x8 At[4][2], B0[2][2], B1[2][2];
    const char* cA = (const char*)g.A + (size_t)cur.pm * tstep; const char* cB = (const char*)g.Bt + (size_t)cur.pn * tstep;
    S.a_ready(cur);
    if constexpr (SP2) {
        PG8_STAGE(PG8_SB(0, 0), cB, voffB); PG8_STAGE(PG8_SB(0, 1), cB + hstep, voffB); PG8_STAGE(PG8_SA(0, 0), cA, voffA); PG8_STAGE(PG8_SA(0, 1), cA + hstep, voffA);
        if (wr == 1) PG8_BAR;
        PG8_WAIT_V(2); PG8_BAR;
        PG8_STAGE(PG8_SB(1, 0), cB + kstep, voffB); PG8_STAGE(PG8_SA(1, 0), cA + kstep, voffA); PG8_STAGE(PG8_SB(1, 1), cB + hstep + kstep, voffB);
        PG8_WAIT_V(6); PG8_BAR;
    } else {
        PG8_STAGE(PG8_SB(0, 0), cB, voffB); PG8_STAGE(PG8_SA(0, 0), cA, voffA); PG8_STAGE(PG8_SB(0, 1), cB + hstep, voffB); PG8_STAGE(PG8_SA(0, 1), cA + hstep, voffA);
        if (wr == 1) PG8_BAR;
        PG8_WAIT_V(4); PG8_BAR;
        PG8_STAGE(PG8_SB(1, 0), cB + kstep, voffB); PG8_STAGE(PG8_SA(1, 0), cA + kstep, voffA); PG8_STAGE(PG8_SB(1, 1), cB + hstep + kstep, voffB);
        PG8_WAIT_V(6); PG8_BAR;
    }
    for (;;) {
        const bool has_next = S.next(ui + 1, nxt);
        const char* nA = has_next ? (const char*)g.A + (size_t)nxt.pm * tstep : cA; const char* nB = has_next ? (const char*)g.Bt + (size_t)nxt.pn * tstep : cB;
        for (int t = 0; t < nt; t += 2) {
            const bool last = (t == nt - 2);
            const char* a1 = cA + (size_t)(t + 1) * kstep;
            const char* a2 = last ? nA : cA + (size_t)(t + 2) * kstep; const char* b2 = last ? nB : cB + (size_t)(t + 2) * kstep;
            const char* a3 = a2 + kstep; const char* b3 = b2 + kstep;
            if (last && has_next) S.a_ready(nxt);
            if constexpr (SP2) {
            PG8_LDB(B0, 0, 0); PG8_LDB(B1, 0, 1); PG8_SCHED; PG8_LDA(At, 0, 0); PG8_STAGE(PG8_SA(1, 1), a1 + hstep, voffA);
            PG8_WAIT_V(8); PG8_WAIT_L(0); PG8_BAR; PG8_MMA(0, 0, At, B0); PG8_MMA(0, 1, At, B1); PG8_BAR; PG8_SCHED;
            PG8_LDA(At, 0, 1); PG8_STAGE(PG8_SB(0, 0), b2, voffB); PG8_STAGE(PG8_SB(0, 1), b2 + hstep, voffB); PG8_STAGE(PG8_SA(0, 0), a2, voffA);
            PG8_WAIT_V(8); PG8_WAIT_L(0); PG8_BAR; PG8_MMA(1, 0, At, B0); PG8_MMA(1, 1, At, B1); PG8_BAR; PG8_SCHED;
            PG8_LDB(B0, 1, 0); PG8_LDB(B1, 1, 1); PG8_SCHED; PG8_LDA(At, 1, 0); PG8_STAGE(PG8_SA(0, 1), a2 + hstep, voffA);
            PG8_WAIT_V(8); PG8_WAIT_L(0); PG8_BAR; PG8_MMA(0, 0, At, B0); PG8_MMA(0, 1, At, B1); PG8_BAR; PG8_SCHED;
            PG8_LDA(At, 1, 1); PG8_STAGE(PG8_SB(1, 0), b3, voffB); PG8_STAGE(PG8_SB(1, 1), b3 + hstep, voffB); PG8_STAGE(PG8_SA(1, 0), a3, voffA);
            PG8_WAIT_V(8); PG8_WAIT_L(0); PG8_BAR; PG8_MMA(1, 0, At, B0); PG8_MMA(1, 1, At, B1); PG8_BAR; PG8_SCHED;
            } else {
            PG8_LDB(B0, 0, 0); PG8_SCHED; PG8_LDA(At, 0, 0); PG8_STAGE(PG8_SA(1, 1), a1 + hstep, voffA);
            PG8_WAIT_L(8); PG8_BAR; PG8_WAIT_L(0); PG8_MMA(0, 0, At, B0); PG8_BAR; PG8_SCHED;
            PG8_LDB(B1, 0, 1); PG8_STAGE(PG8_SB(0, 0), b2, voffB);
            PG8_BAR; PG8_WAIT_L(0); PG8_MMA(0, 1, At, B1); PG8_BAR;
            PG8_LDA(At, 0, 1); PG8_STAGE(PG8_SA(0, 0), a2, voffA);
            PG8_BAR; PG8_WAIT_L(0); PG8_MMA(1, 0, At, B0); PG8_BAR; PG8_SCHED;
            PG8_STAGE(PG8_SB(0, 1), b2 + hstep, voffB);
            PG8_WAIT_V(6); PG8_BAR; PG8_MMA(1, 1, At, B1); PG8_BAR;
            PG8_LDB(B0, 1, 0); PG8_SCHED; PG8_LDA(At, 1, 0); PG8_STAGE(PG8_SA(0, 1), a2 + hstep, voffA);
            PG8_WAIT_L(8); PG8_BAR; PG8_WAIT_L(0); PG8_MMA(0, 0, At, B0); PG8_BAR; PG8_SCHED;
            PG8_LDB(B1, 1, 1); PG8_STAGE(PG8_SB(1, 0), b3, voffB);
            PG8_BAR; PG8_WAIT_L(0); PG8_MMA(0, 1, At, B1); PG8_BAR;
            PG8_LDA(At, 1, 1); PG8_STAGE(PG8_SA(1, 0), a3, voffA);
            PG8_BAR; PG8_WAIT_L(0); PG8_MMA(1, 0, At, B0); PG8_BAR; PG8_SCHED;
            PG8_STAGE(PG8_SB(1, 1), b3 + hstep, voffB);
            PG8_WAIT_V(6); PG8_BAR; PG8_MMA(1, 1, At, B1); PG8_BAR;
            }
        }
        if constexpr (ALIGN_EPI) { if (wr == 0) PG8_BAR; }
        if constexpr (!Epi::AFTER_DRAIN) { E(acc, cur, wr, wc, fr, fq); S.done(cur); }
        if (!has_next) break;
#pragma unroll
        for (int a = 0; a < 2; ++a)
#pragma unroll
            for (int b = 0; b < 2; ++b)
#pragma unroll
                for (int m = 0; m < 4; ++m)
#pragma unroll
                    for (int n = 0; n < 2; ++n) acc[a][b][m][n] = (f32x4){0.f, 0.f, 0.f, 0.f};
        cur = nxt; cA = nA; cB = nB; ++ui;
        if constexpr (ALIGN_EPI) { if (wr == 1) PG8_BAR; }
    }
    PG8_WAIT_V(0);
    if constexpr (!ALIGN_EPI) { if (wr == 0) PG8_BAR; }
    PG8_BAR;
    if constexpr (Epi::AFTER_DRAIN) { E.fused(acc, cur, wr, wc, fr, fq, lds, wid, lane); S.done(cur); }
#undef PG8_SA
#undef PG8_SB
#undef PG8_STAGE
#undef PG8_LDA
#undef PG8_LDB
#undef PG8_MMA
#undef PG8_WAIT_V
#undef PG8_WAIT_L
#undef PG8_BAR
#undef PG8_SCHED
}
}


struct EpiQKV {
    static constexpr bool PERM = true, AFTER_DRAIN = false;
    bf16_t* base6; const float *qn, *kn; float* kmean_acc;
    DI void operator()(const f32x4 (&acc)[2][2][4][2], const pg8::Unit& u, int wr, int wc, int fr, int fq) const {
        const int typ = u.pn >> 1, h = (u.pn & 1) * 4 + wc;
        bf16_t* reg = base6 + (size_t)typ * (16u << 19);
        const int row0 = u.pm * 256 + wr * 64 + fr;
        if (typ == 2 || typ == 5) {
#pragma unroll
            for (int ai = 0; ai < 2; ++ai)
#pragma unroll
                for (int m = 0; m < 4; ++m) {
                    const int tok = row0 + ai * 128 + m * 16, b = tok >> 11, sq = tok & 2047, tile = sq >> 5, kap = sq & 31;
                    const int s2 = kap >> 4, hh = (kap >> 2) & 1, jj = ((kap >> 3) & 1) * 4 + (kap & 3);
                    bf16_t* bp = reg + ((((size_t)(b * 8 + h) * 64 + tile) * 4 + s2 * 2) * 64 + hh * 32 + 8 * fq) * 8 + jj;
#pragma unroll
                    for (int bj = 0; bj < 2; ++bj)
#pragma unroll
                        for (int n = 0; n < 2; ++n)
#pragma unroll
                            for (int i = 0; i < 4; ++i) bp[(size_t)bj * 512 + (4 * n + i) * 8] = f2bf(acc[ai][bj][m][n][i]);
                }
        } else {
            const bool nrm = typ < 2;
            const float* g = (typ == 0) ? qn : kn;
            f32x4 gv[2][2];
#pragma unroll
            for (int bj = 0; bj < 2; ++bj)
#pragma unroll
                for (int n = 0; n < 2; ++n) gv[bj][n] = nrm ? *(const f32x4*)(g + 32 * bj + 8 * fq + 4 * n) : (f32x4){1.f, 1.f, 1.f, 1.f};
#pragma unroll
            for (int ai = 0; ai < 2; ++ai)
#pragma unroll
                for (int m = 0; m < 4; ++m) {
                    const int tok = row0 + ai * 128 + m * 16, b = tok >> 11, sq = tok & 2047, tile = sq >> 5, kap = sq & 31;
                    float rs = 1.f;
                    if (nrm) {
                        float ss = 0.f;
#pragma unroll
                        for (int bj = 0; bj < 2; ++bj)
#pragma unroll
                            for (int n = 0; n < 2; ++n) { const f32x4 v = acc[ai][bj][m][n]; ss += (v.x * v.x + v.y * v.y) + (v.z * v.z + v.w * v.w); }
                        ss = sum_x32(sum_x16(ss));
                        rs = rsqrtf(ss * (1.f / 64.f) + EPS);
                    }
                    bf16_t* dst = reg + ((((size_t)(b * 8 + h) * 64 + tile) * 4 + (fq >> 1)) * 64 + (fq & 1) * 32 + kap) * 8;
#pragma unroll
                    for (int bj = 0; bj < 2; ++bj) {
                        const f32x4 v0 = acc[ai][bj][m][0] * rs * gv[bj][0], v1 = acc[ai][bj][m][1] * rs * gv[bj][1];
                        u32x4 w; w.x = cvtpk(v0.x, v0.y); w.y = cvtpk(v0.z, v0.w); w.z = cvtpk(v1.x, v1.y); w.w = cvtpk(v1.z, v1.w);
                        *(u32x4*)(dst + (size_t)bj * 2 * 512) = w;
                    }
                }
            if (typ == 1) {
                asm volatile("" ::: "memory");
                f32x4 ks[2][2];
#pragma unroll
                for (int bj = 0; bj < 2; ++bj)
#pragma unroll
                    for (int n = 0; n < 2; ++n) ks[bj][n] = (f32x4){0.f, 0.f, 0.f, 0.f};
#pragma unroll
                for (int ai = 0; ai < 2; ++ai)
#pragma unroll
                    for (int m = 0; m < 4; ++m) {
                        float ss = 0.f;
#pragma unroll
                        for (int bj = 0; bj < 2; ++bj)
#pragma unroll
                            for (int n = 0; n < 2; ++n) { const f32x4 v = acc[ai][bj][m][n]; ss += (v.x * v.x + v.y * v.y) + (v.z * v.z + v.w * v.w); }
                        ss = sum_x32(sum_x16(ss));
                        const float rs = rsqrtf(ss * (1.f / 64.f) + EPS);
#pragma unroll
                        for (int bj = 0; bj < 2; ++bj)
#pragma unroll
                            for (int n = 0; n < 2; ++n) ks[bj][n] += acc[ai][bj][m][n] * rs * gv[bj][n];
                    }
                const int tok0 = u.pm * 256;
                float* kd = kmean_acc + ((size_t)((tok0 >> 11) * 8 + h) * 8 + ((tok0 & 2047) >> 8)) * 64 + 8 * fq;
#pragma unroll
                for (int bj = 0; bj < 2; ++bj)
#pragma unroll
                    for (int n = 0; n < 2; ++n)
#pragma unroll
                        for (int i = 0; i < 4; ++i) { const float t = sum_row16(ks[bj][n][i]) * (1.f / 256.f); if (fr == 0) atomicAdd(kd + 32 * bj + 4 * n + i, t); }
            }
        }
    }
};

struct EpiRes {
    static constexpr bool PERM = true, AFTER_DRAIN = false;
    const float* x; float* out; bf16_t* xn;
    DI void operator()(const f32x4 (&acc)[2][2][4][2], const pg8::Unit& u, int wr, int wc, int fr, int fq) const {
        const int row0 = u.pm * 256 + wr * 64 + fr, col0 = u.pn * 256 + wc * 32 + 8 * fq;
#pragma unroll
        for (int ai = 0; ai < 2; ++ai)
#pragma unroll
            for (int m = 0; m < 4; ++m)
#pragma unroll
                for (int bj = 0; bj < 2; ++bj) {
                    const size_t off = (size_t)(row0 + ai * 128 + m * 16) * 1024 + col0 + bj * 128;
                    const f32x4 h0 = *(const f32x4*)(x + off) + acc[ai][bj][m][0], h1 = *(const f32x4*)(x + off + 4) + acc[ai][bj][m][1];
                    *(f32x4*)(out + off) = h0; *(f32x4*)(out + off + 4) = h1;
                    u32x4 w; w.x = cvtpk(h0.x, h0.y); w.y = cvtpk(h0.z, h0.w); w.z = cvtpk(h1.x, h1.y); w.w = cvtpk(h1.z, h1.w);
                    *(u32x4*)(xn + off) = w;
                }
    }
};

struct EpiF32 {
    static constexpr bool PERM = true, AFTER_DRAIN = false;
    float* C; int ldc;
    DI void operator()(const f32x4 (&acc)[2][2][4][2], const pg8::Unit& u, int wr, int wc, int fr, int fq) const {
        const int row0 = u.pm * 256 + wr * 64 + fr, col0 = u.pn * 256 + wc * 32 + 8 * fq;
#pragma unroll
        for (int ai = 0; ai < 2; ++ai)
#pragma unroll
            for (int m = 0; m < 4; ++m)
#pragma unroll
                for (int bj = 0; bj < 2; ++bj) {
                    float* p = C + (size_t)(row0 + ai * 128 + m * 16) * ldc + col0 + bj * 128;
                    *(f32x4*)p = acc[ai][bj][m][0]; *(f32x4*)(p + 4) = acc[ai][bj][m][1];
                }
    }
};

struct EpiBf {
    static constexpr bool PERM = true, AFTER_DRAIN = false;
    bf16_t* C; int ldc;
    DI void operator()(const f32x4 (&acc)[2][2][4][2], const pg8::Unit& u, int wr, int wc, int fr, int fq) const {
        const int row0 = u.pm * 256 + wr * 64 + fr, col0 = u.pn * 256 + wc * 32 + 8 * fq;
#pragma unroll
        for (int ai = 0; ai < 2; ++ai)
#pragma unroll
            for (int m = 0; m < 4; ++m)
#pragma unroll
                for (int bj = 0; bj < 2; ++bj) {
                    const f32x4 v0 = acc[ai][bj][m][0], v1 = acc[ai][bj][m][1];
                    u32x4 w; w.x = cvtpk(v0.x, v0.y); w.y = cvtpk(v0.z, v0.w); w.z = cvtpk(v1.x, v1.y); w.w = cvtpk(v1.z, v1.w);
                    *(u32x4*)(C + (size_t)(row0 + ai * 128 + m * 16) * ldc + col0 + bj * 128) = w;
                }
    }
};

struct EpiGate {
    static constexpr bool PERM = true, AFTER_DRAIN = false;
    float* out; const bf16_t* pw; const float* ssq;
    DI void operator()(const f32x4 (&acc)[2][2][4][2], const pg8::Unit& u, int wr, int wc, int fr, int fq) const {
        const int row0 = u.pm * 256 + wr * 64 + fr, col0 = u.pn * 256 + wc * 32 + 8 * fq;
#pragma unroll
        for (int ai = 0; ai < 2; ++ai)
#pragma unroll
            for (int m = 0; m < 4; ++m) {
                const int row = row0 + ai * 128 + m * 16;
                float sq = 0.f;
#pragma unroll
                for (int x = 0; x < 8; ++x) sq += ssq[(size_t)x * T + row];
                const float rs3 = rsqrtf(sq * (1.f / 1024.f) + EPS);
#pragma unroll
                for (int bj = 0; bj < 2; ++bj) {
                    const size_t off = (size_t)row * 1024 + col0 + bj * 128;
                    const bf16x8 pv = *(const bf16x8*)(pw + off);
                    const f32x4 h0 = *(const f32x4*)(out + off), h1 = *(const f32x4*)(out + off + 4);
                    const f32x4 g0 = acc[ai][bj][m][0] * rs3, g1 = acc[ai][bj][m][1] * rs3;
                    f32x4 o0, o1;
#pragma unroll
                    for (int i = 0; i < 4; ++i) { o0[i] = h0[i] + bf2f(pv[i]) / (1.f + __expf(-g0[i])); o1[i] = h1[i] + bf2f(pv[4 + i]) / (1.f + __expf(-g1[i])); }
                    *(f32x4*)(out + off) = o0; *(f32x4*)(out + off + 4) = o1;
                }
            }
    }
};

template <class Epi>
DI void gemm_simple(const bf16_t* A, const bf16_t* Bt, int M, int N, int K, const Epi& epi, int gwave, int nwaves, int lane) {
    const int r32 = lane & 31, hi = lane >> 5;
    const int nNt = N / 64, total = (M / 32) * nNt;
    for (int tile = gwave; tile < total; tile += nwaves) {
        const int mt = tile / nNt, nt = tile - mt * nNt, m0 = mt * 32, n0 = nt * 64;
        const bf16_t* ap = A + (size_t)(m0 + r32) * K + 8 * hi;
        const bf16_t* b0p = Bt + (size_t)(n0 + r32) * K + 8 * hi;
        const bf16_t* b1p = b0p + (size_t)32 * K;
        f32x16 acc0 = zero16(), acc1 = zero16();
#pragma unroll 4
        for (int k = 0; k < K; k += 16) {
            const bf16x8 xa = *(const bf16x8*)(ap + k);
            const bf16x8 w0 = *(const bf16x8*)(b0p + k);
            const bf16x8 w1 = *(const bf16x8*)(b1p + k);
            acc0 = MFMA32(w0, xa, acc0);
            acc1 = MFMA32(w1, xa, acc1);
        }
        epi(m0 + r32, n0, hi, acc0, acc1);
    }
}

struct Epi1 {
    bf16_t* base6;
    const float *qn, *kn;
    DI void operator()(int tok, int n0, int hi, const f32x16& a0, const f32x16& a1) const {
        const int head48 = n0 >> 6, typ = head48 >> 3, h = head48 & 7;
        bf16_t* reg = base6 + (size_t)typ * (16u << 19);
        if (typ == 2 || typ == 5) {
            const int b = tok >> 11, s = tok & 2047;
            const int pos = (s & ~12) | ((s & 4) << 1) | ((s & 8) >> 1);
            bf16_t* base = reg + ((size_t)(b * 8 + h) * 64) * 2048 + pos;
#pragma unroll
            for (int r = 0; r < 16; ++r) { base[(size_t)crow(r, hi) * 2048] = f2bf(a0[r]); base[(size_t)(32 + crow(r, hi)) * 2048] = f2bf(a1[r]); }
        } else {
            float rs = 1.f;
            const bool nrm = (typ == 0 || typ == 1);
            if (nrm) { float ss = 0.f;
#pragma unroll
                for (int r = 0; r < 16; ++r) ss += a0[r] * a0[r] + a1[r] * a1[r];
                ss = sum_x32(ss);
                rs = rsqrtf(ss * (1.f / 64.f) + EPS); }
            const float* g = (typ == 0) ? qn : kn;
            bf16_t* dst = reg + (size_t)tok * 512 + h * 64;
#pragma unroll
            for (int t = 0; t < 2; ++t)
#pragma unroll
                for (int g4 = 0; g4 < 4; ++g4) {
                    const int f0 = 32 * t + 8 * g4 + 4 * hi;
                    float v[4];
#pragma unroll
                    for (int i = 0; i < 4; ++i) { const float a = t ? a1[4 * g4 + i] : a0[4 * g4 + i]; v[i] = nrm ? a * rs * g[f0 + i] : a; }
                    u32x2 w; w.x = cvtpk(v[0], v[1]); w.y = cvtpk(v[2], v[3]);
                    *(u32x2*)(dst + f0) = w;
                }
        }
    }
};

struct Epi2 {
    const float* x; float* out; bf16_t* xn;
    DI void operator()(int tok, int n0, int hi, const f32x16& a0, const f32x16& a1) const {
#pragma unroll
        for (int t = 0; t < 2; ++t)
#pragma unroll
            for (int g4 = 0; g4 < 4; ++g4) {
                const size_t off = (size_t)tok * 1024 + n0 + 32 * t + 8 * g4 + 4 * hi;
                const f32x4 xv = *(const f32x4*)(x + off);
                f32x4 hv;
#pragma unroll
                for (int i = 0; i < 4; ++i) hv[i] = xv[i] + (t ? a1[4 * g4 + i] : a0[4 * g4 + i]);
                *(f32x4*)(out + off) = hv;
                u32x2 w; w.x = cvtpk(hv[0], hv[1]); w.y = cvtpk(hv[2], hv[3]);
                *(u32x2*)(xn + off) = w;
            }
    }
};

struct Epi3 {
    float* sc;
    DI void operator()(int tok, int n0, int hi, const f32x16& a0, const f32x16& a1) const {
#pragma unroll
        for (int t = 0; t < 2; ++t)
#pragma unroll
            for (int g4 = 0; g4 < 4; ++g4) {
                f32x4 v;
#pragma unroll
                for (int i = 0; i < 4; ++i) v[i] = t ? a1[4 * g4 + i] : a0[4 * g4 + i];
                *(f32x4*)(sc + (size_t)tok * 2048 + n0 + 32 * t + 8 * g4 + 4 * hi) = v;
            }
    }
};

DI void pv_accum(f32x16& o0, f32x16& o1, const f32x16& p, const bf16_t* vt_row) {
#pragma unroll
    for (int s = 0; s < 2; ++s) {
        u32x4 pk; pk.x = cvtpk(p[8 * s], p[8 * s + 1]); pk.y = cvtpk(p[8 * s + 2], p[8 * s + 3]); pk.z = cvtpk(p[8 * s + 4], p[8 * s + 5]); pk.w = cvtpk(p[8 * s + 6], p[8 * s + 7]);
        const bf16x8 pb = __builtin_bit_cast(bf16x8, pk);
        const bf16x8 v0 = *(const bf16x8*)(vt_row + 16 * s);
        const bf16x8 v1 = *(const bf16x8*)(vt_row + (size_t)32 * 2048 + 16 * s);
        o0 = MFMA32(v0, pb, o0);
        o1 = MFMA32(v1, pb, o1);
    }
}

DI void store_o(bf16_t* op, const f32x16& o0, const f32x16& o1, float inv, int hi) {
#pragma unroll
    for (int t = 0; t < 2; ++t)
#pragma unroll
        for (int g4 = 0; g4 < 4; ++g4) {
            u32x2 w;
            if (t == 0) { w.x = cvtpk(o0[4 * g4] * inv, o0[4 * g4 + 1] * inv); w.y = cvtpk(o0[4 * g4 + 2] * inv, o0[4 * g4 + 3] * inv); }
            else        { w.x = cvtpk(o1[4 * g4] * inv, o1[4 * g4 + 1] * inv); w.y = cvtpk(o1[4 * g4 + 2] * inv, o1[4 * g4 + 3] * inv); }
            *(u32x2*)(op + 32 * t + 8 * g4 + 4 * hi) = w;
        }
}

constexpr int OT_PITCH = 1040;
DI void store_o_lds(LAS unsigned char* ot, int r32, int h, const f32x16& o0, const f32x16& o1, float inv, int hi) {
    LAS unsigned char* op = ot + r32 * OT_PITCH + h * 128;
#pragma unroll
    for (int t = 0; t < 2; ++t)
#pragma unroll
        for (int g4 = 0; g4 < 4; ++g4) {
            u32x2 w;
            if (t == 0) { w.x = cvtpk(o0[4 * g4] * inv, o0[4 * g4 + 1] * inv); w.y = cvtpk(o0[4 * g4 + 2] * inv, o0[4 * g4 + 3] * inv); }
            else        { w.x = cvtpk(o1[4 * g4] * inv, o1[4 * g4 + 1] * inv); w.y = cvtpk(o1[4 * g4 + 2] * inv, o1[4 * g4 + 3] * inv); }
            *(LAS u32x2*)(op + (32 * t + 8 * g4 + 4 * hi) * 2) = w;
        }
}
DI void load_kfrag(bf16x8 (&kf)[4], const bf16_t* fbase  , int tile) {
    const bf16_t* kp = fbase + (size_t)tile * 2048;
#pragma unroll
    for (int s = 0; s < 4; ++s) kf[s] = *(const bf16x8*)(kp + s * 512);
}
DI void load_vfrag(bf16x8 (&vf)[4], const bf16_t* fbase, int tile) {
    const bf16_t* vp = fbase + (size_t)tile * 2048;
#pragma unroll
    for (int q = 0; q < 4; ++q) vf[q] = *(const bf16x8*)(vp + q * 512);
}
DI void pv_accum2(f32x16& o0, f32x16& o1, const f32x16& p, const bf16x8 (&vf)[4]) {
#pragma unroll
    for (int s = 0; s < 2; ++s) {
        u32x4 pk; pk.x = cvtpk(p[8 * s], p[8 * s + 1]); pk.y = cvtpk(p[8 * s + 2], p[8 * s + 3]); pk.z = cvtpk(p[8 * s + 4], p[8 * s + 5]); pk.w = cvtpk(p[8 * s + 6], p[8 * s + 7]);
        const bf16x8 pb = __builtin_bit_cast(bf16x8, pk);
        o0 = MFMA32(vf[2 * s], pb, o0);
        o1 = MFMA32(vf[2 * s + 1], pb, o1);
    }
}

#define MEM_FENCE() asm volatile("" ::: "memory")
#define PIN1(a) asm volatile("" : "+v"(a) :: "memory")
#define PIN2(a, b) asm volatile("" : "+v"(a), "+v"(b) :: "memory")
DI void vm_drain() { __builtin_amdgcn_s_waitcnt(0x0F70); }
struct KvStream { const bf16_t* kbase; const bf16_t* vbase; };

struct MobaCtx { int q0, tq, blk, hi; unsigned selmask; float bfar; const LAS float* bt; };
DI void moba_tile(bf16x8 (&kf)[4], bf16x8 (&vf)[4], const bf16x8 (&qf)[4], int kt, int next, const KvStream& kv, const MobaCtx& c, float& mrun, float& lsum, f32x16& o0, f32x16& o1) {
    const int n = kt >> 3, key0 = kt * 32;
    f32x16 st = zero16();
#pragma unroll
    for (int s = 0; s < 4; ++s) st = MFMA32(kf[s], qf[s], st);
    PIN1(st); load_kfrag(kf, kv.kbase, next); PIN1(st);
    float x[16];
    if (n != c.blk) {
        const bool selq = (c.selmask >> n) & 1u;
        if ((c.q0 - (key0 + 31)) >= 128) {
            const float addend = selq ? c.bfar : -1e30f;
#pragma unroll
            for (int r = 0; r < 16; ++r) x[r] = st[r] * SCL2 + addend;
        } else {
#pragma unroll
            for (int r = 0; r < 16; ++r) { const int dist = c.tq - (key0 + crow(r, c.hi)); const float v = st[r] * SCL2 + c.bt[dist > 128 ? 128 : dist]; x[r] = selq ? v : -1e30f; }
        }
    } else {
#pragma unroll
        for (int r = 0; r < 16; ++r) { const int dist = c.tq - (key0 + crow(r, c.hi)); const float v = st[r] * SCL2 + c.bt[dist < 0 ? 0 : (dist > 128 ? 128 : dist)]; x[r] = (dist >= 0) ? v : -1e30f; }
    }
    float mx = x[0];
#pragma unroll
    for (int r = 1; r < 16; ++r) mx = fmaxf(mx, x[r]);
    mx = max_x32(mx);
    const float mnew = fmaxf(mrun, mx);
    if (!__all(mnew == mrun)) {
        const float alpha = __builtin_amdgcn_exp2f(mrun - mnew);
        lsum *= alpha;
#pragma unroll
        for (int r = 0; r < 16; ++r) { o0[r] *= alpha; o1[r] *= alpha; }
        mrun = mnew;
    }
    f32x16 pr; float ps = 0.f;
#pragma unroll
    for (int r = 0; r < 16; ++r) { const float e = __builtin_amdgcn_exp2f(x[r] - mrun); pr[r] = e; ps += e; }
    lsum += ps;
    pv_accum2(o0, o1, pr, vf);
    PIN2(o0, o1); load_vfrag(vf, kv.vbase, next); MEM_FENCE();
}
DI int moba_next(int kt, int blk, unsigned anysel) {
    int nkt = kt - 1;
    while (nkt >= 0) { const int nn = nkt >> 3; if (nn == blk || ((anysel >> nn) & 1u)) break; nkt = nn * 8 - 1; }
    return nkt;
}

DI void moba_unit(int b, int h, int qt, const bf16_t* Qm_, const bf16_t* Km_, const bf16_t* VtM_, const float* kmean_, const LAS float* biasLds, LAS unsigned char* ot, int lane) {
    const int r32 = lane & 31, hi = lane >> 5;
    const int q0 = qt * 32, tq = q0 + r32, blk = q0 >> 8;
    const size_t bh = (size_t)(b * 8 + h);
    const bf16_t* qfb = Qm_ + bh * (64 * 2048) + (size_t)qt * 2048;
    KvStream kv; kv.kbase = Km_ + bh * (64 * 2048) + lane * 8; kv.vbase = VtM_ + bh * (64 * 2048) + lane * 8;
    bf16x8 kf[4], vf[4];
    load_kfrag(kf, kv.kbase, qt); load_vfrag(vf, kv.vbase, qt);
    bf16x8 qf[4];
#pragma unroll
    for (int s = 0; s < 4; ++s) qf[s] = *(const bf16x8*)(qfb + s * 512 + lane * 8);
    unsigned selmask = 0;
    if (blk > 0) {
        float qv[32];
#pragma unroll
        for (int c = 0; c < 4; ++c) { const bf16x8 t = *(const bf16x8*)(qfb + (2 * hi + (c >> 1)) * 512 + ((c & 1) * 32 + r32) * 8);
#pragma unroll
            for (int j = 0; j < 8; ++j) qv[8 * c + j] = bf2f(t[j]); }
        const float* km = kmean_ + (size_t)((b * 8 + h) * 8) * 64 + 32 * hi;
        float g[8];
#pragma unroll
        for (int n = 0; n < 8; ++n) {
            float a = 0.f;
            if (n < blk) {
#pragma unroll
                for (int d4 = 0; d4 < 8; ++d4) { const f32x4 kv4 = *(const f32x4*)(km + n * 64 + 4 * d4); a += (qv[4 * d4] * kv4.x + qv[4 * d4 + 1] * kv4.y) + (qv[4 * d4 + 2] * kv4.z + qv[4 * d4 + 3] * kv4.w); }
            }
            a = sum_x32(a);
            g[n] = (n < blk) ? a : -INFINITY;
        }
#pragma unroll
        for (int n = 0; n < 8; ++n) {
            int rank = 0;
#pragma unroll
            for (int m = 0; m < 8; ++m) if (m != n) rank += ((g[m] > g[n]) || (g[m] == g[n] && m < n)) ? 1 : 0;
            if (n < blk && rank < 3) selmask |= 1u << n;
        }
    }
    unsigned anysel = 0;
#pragma unroll
    for (int n = 0; n < 8; ++n) if (__any((selmask >> n) & 1u)) anysel |= 1u << n;
    anysel = __builtin_amdgcn_readfirstlane(anysel);
    float mrun = -1e30f, lsum = 0.f;
    f32x16 o0 = zero16(), o1 = zero16();
    MobaCtx c; c.q0 = q0; c.tq = tq; c.blk = blk; c.hi = hi; c.selmask = selmask; c.bt = biasLds + h * 132; c.bfar = c.bt[128];
    vm_drain();
    int kt = qt;
    for (;;) {
        const int nx = moba_next(kt, blk, anysel);
        moba_tile(kf, vf, qf, kt, nx < 0 ? 0 : nx, kv, c, mrun, lsum, o0, o1);
        if (nx < 0) break;
        kt = nx;
    }
    lsum = sum_x32(lsum);
    const float inv = 1.f / lsum;
    store_o_lds(ot, r32, h, o0, o1, inv, hi);
}

DI void sb_tile(bf16x8 (&kf)[4], bf16x8 (&vf)[4], const bf16x8 (&qf)[4], int kt, int next, const KvStream& kv, int tq, int hi, float& C, f32x16& o0, f32x16& o1) {
    const int key0 = kt * 32;
    f32x16 st = zero16();
#pragma unroll
    for (int s = 0; s < 4; ++s) st = MFMA32(kf[s], qf[s], st);
    PIN1(st); load_kfrag(kf, kv.kbase, next); PIN1(st);
    float rr[16], be[16];
#pragma unroll
    for (int r = 0; r < 16; ++r) {
        const int key = key0 + crow(r, hi);
        const float y = fminf(st[r] * SCL2, 100.f);
        const float e = __builtin_amdgcn_exp2f(y);
        const float ri = __builtin_amdgcn_rcpf(1.f + e);
        const bool ok = key < tq;
        rr[r] = ok ? ri : 1.f;
        be[r] = ok ? e * ri : 0.f;
    }
    float G[4], ex[16], Gp[4], Tt[4], Suf[4];
#pragma unroll
    for (int a = 0; a < 4; ++a) {
        ex[4 * a + 3] = 1.f; ex[4 * a + 2] = rr[4 * a + 3]; ex[4 * a + 1] = ex[4 * a + 2] * rr[4 * a + 2]; ex[4 * a] = ex[4 * a + 1] * rr[4 * a + 1];
        G[a] = ex[4 * a] * rr[4 * a];
    }
#pragma unroll
    for (int a = 0; a < 4; ++a) { float lo_, hi_; swap32(G[a], lo_, hi_); Gp[a] = hi_; Tt[a] = lo_ * hi_; }
    Suf[3] = 1.f; Suf[2] = Tt[3]; Suf[1] = Tt[3] * Tt[2]; Suf[0] = Suf[1] * Tt[1];
    f32x16 pr;
#pragma unroll
    for (int a = 0; a < 4; ++a) {
        const float after = Suf[a] * (hi == 0 ? Gp[a] : 1.f) * C;
#pragma unroll
        for (int i = 0; i < 4; ++i) pr[4 * a + i] = be[4 * a + i] * ex[4 * a + i] * after;
    }
    C = C * (Suf[0] * Tt[0]);
    pv_accum2(o0, o1, pr, vf);
    PIN2(o0, o1); load_vfrag(vf, kv.vbase, next); MEM_FENCE();
}

DI void sb_unit(int b, int h, int qt, const bf16_t* Qs_, const bf16_t* Ks_, const bf16_t* VtS_, LAS unsigned char* ot, int lane) {
    const int r32 = lane & 31, hi = lane >> 5;
    const int q0 = qt * 32, tq = q0 + r32;
    const size_t bh = (size_t)(b * 8 + h);
    const bf16_t* qfb = Qs_ + bh * (64 * 2048) + (size_t)qt * 2048;
    KvStream kv; kv.kbase = Ks_ + bh * (64 * 2048) + lane * 8; kv.vbase = VtS_ + bh * (64 * 2048) + lane * 8;
    bf16x8 kf[4], vf[4];
    load_kfrag(kf, kv.kbase, qt); load_vfrag(vf, kv.vbase, qt);
    bf16x8 qf[4];
#pragma unroll
    for (int s = 0; s < 4; ++s) qf[s] = *(const bf16x8*)(qfb + s * 512 + lane * 8);
    f32x16 o0 = zero16(), o1 = zero16();
    float C = 1.f;
    vm_drain();
    for (int kt = qt; kt >= 0; --kt) {
        sb_tile(kf, vf, qf, kt, kt > 0 ? kt - 1 : 0, kv, tq, hi, C, o0, o1);
        if (__all(C == 0.f ? 1 : 0)) break;
    }
    store_o_lds(ot, r32, h, o0, o1, 1.f, hi);
}

DI void ce_desc(unsigned& a, unsigned& b) { const unsigned hi = a > b ? a : b, lo = a > b ? b : a; a = hi; b = lo; }
DI void bitonic_clean_desc(unsigned (&v)[16]) {
#pragma unroll
    for (int s = 8; s >= 1; s >>= 1)
#pragma unroll
        for (int i = 0; i < 16; ++i) if ((i & s) == 0) ce_desc(v[i], v[i + s]);
}
DI void sort16_desc(unsigned (&v)[16]) {
#pragma unroll
    for (int k = 2; k <= 16; k <<= 1)
#pragma unroll
        for (int j = k >> 1; j >= 1; j >>= 1)
#pragma unroll
            for (int i = 0; i < 16; ++i) { const int l = i ^ j; if (l > i) { if ((i & k) == 0) ce_desc(v[i], v[l]); else ce_desc(v[l], v[i]); } }
}
DI float key_value(unsigned key) { const unsigned kk = key & ~127u; const unsigned u = (kk & 0x80000000u) ? (kk & 0x7fffffffu) : ~kk; return __builtin_bit_cast(float, u); }
DI float key_value8(unsigned key) { const unsigned kk = key & ~255u; const unsigned u = (kk & 0x80000000u) ? (kk & 0x7fffffffu) : ~kk; return __builtin_bit_cast(float, u); }
template <int CTRL> DI unsigned dppu(unsigned v) { return (unsigned)__builtin_amdgcn_update_dpp(0, (int)v, CTRL, 0xF, 0xF, true); }
DI void sort8_desc(unsigned (&v)[8]) {
    ce_desc(v[0], v[2]); ce_desc(v[1], v[3]); ce_desc(v[4], v[6]); ce_desc(v[5], v[7]);
    ce_desc(v[0], v[4]); ce_desc(v[1], v[5]); ce_desc(v[2], v[6]); ce_desc(v[3], v[7]);
    ce_desc(v[0], v[1]); ce_desc(v[2], v[3]); ce_desc(v[4], v[5]); ce_desc(v[6], v[7]);
    ce_desc(v[2], v[4]); ce_desc(v[3], v[5]);
    ce_desc(v[1], v[4]); ce_desc(v[3], v[6]);
    ce_desc(v[1], v[2]); ce_desc(v[3], v[4]); ce_desc(v[5], v[6]);
}
DI void clean8_desc(unsigned (&v)[8]) {
#pragma unroll
    for (int s = 4; s >= 1; s >>= 1)
#pragma unroll
        for (int i = 0; i < 8; ++i) if ((i & s) == 0) ce_desc(v[i], v[i + s]);
}
template <int CTRL> DI void cross_rev_max(unsigned (&v)[8]) {
    unsigned t[8];
#pragma unroll
    for (int i = 0; i < 8; ++i) t[i] = dppu<CTRL>(v[7 - i]);
#pragma unroll
    for (int i = 0; i < 8; ++i) v[i] = v[i] > t[i] ? v[i] : t[i];
}
template <bool REV> DI void cross_minmax_x1(unsigned (&v)[8], bool odd) {
    unsigned t[8];
#pragma unroll
    for (int i = 0; i < 8; ++i) t[i] = dppu<DPP_XOR1>(v[REV ? 7 - i : i]);
#pragma unroll
    for (int i = 0; i < 8; ++i) { const unsigned hi = v[i] > t[i] ? v[i] : t[i], lo = v[i] > t[i] ? t[i] : v[i]; v[i] = odd ? lo : hi; }
}

DI float reduce16(const float (&p)[16], int lane) {
    const bool b3 = lane & 8, b2 = lane & 4, b1 = lane & 2, b0 = lane & 1;
    float q[8], r[4], s[2];
#pragma unroll
    for (int i = 0; i < 8; ++i) { const float mine = b3 ? p[i + 8] : p[i], send = b3 ? p[i] : p[i + 8]; q[i] = mine + __shfl_xor(send, 8); }
#pragma unroll
    for (int i = 0; i < 4; ++i) { const float mine = b2 ? q[i + 4] : q[i], send = b2 ? q[i] : q[i + 4]; r[i] = mine + __shfl_xor(send, 4); }
#pragma unroll
    for (int i = 0; i < 2; ++i) { const float mine = b1 ? r[i + 2] : r[i], send = b1 ? r[i] : r[i + 2]; s[i] = mine + __shfl_xor(send, 2); }
    const float mine = b0 ? s[1] : s[0], send = b0 ? s[0] : s[1];
    float t = mine + __shfl_xor(send, 1);
    t = sum_x32(sum_x16(t));
    return t;
}

#ifndef PEER_REP_TOPK
#define PEER_REP_TOPK 1
#endif
#ifndef PEER_REP_U
#define PEER_REP_U 1
#endif
#ifndef PEER_REP_V
#define PEER_REP_V 1
#endif
struct TopkIn { f32x4 hv[4]; bf16x8 sv[4]; };
DI void peer_topk_load(TopkIn& in, int tok, const float* out, const bf16_t* scores, int lane) {
    const int tc = tok < T ? tok : T - 1;
    const float* hrow = out + (size_t)tc * 1024 + 16 * lane;
    const bf16_t* sp = scores + (size_t)tc * 2048 + (lane >> 2) * 128 + (lane & 3) * 8;
#pragma unroll
    for (int i = 0; i < 4; ++i) { in.hv[i] = *(const f32x4*)(hrow + 4 * i); in.sv[i] = *(const bf16x8*)(sp + 32 * i); }
}
DI void peer_topk_token(int tok, const TopkIn& in, const float* gffn, int* EIDXg, float* GATEg, unsigned char* XN2g, LAS float* wl, int lane) {
    LAS unsigned* kbuf = (LAS unsigned*)wl; const LAS unsigned* ctab = (const LAS unsigned*)(wl + 768);
    f32x4 hv[4];
    float ss = 0.f;
#pragma unroll
    for (int i = 0; i < 4; ++i) { hv[i] = in.hv[i]; ss += (hv[i].x * hv[i].x + hv[i].y * hv[i].y) + (hv[i].z * hv[i].z + hv[i].w * hv[i].w); }
    ss = wave_sum(ss);
    const float rs2 = rsqrtf(ss * (1.f / 1024.f) + EPS);
    {
        u32x4 w;
#pragma unroll
        for (int i = 0; i < 4; ++i) { const f32x4 gv = *(const f32x4*)(gffn + 16 * lane + 4 * i);
            const float y0 = fminf(fmaxf(hv[i][0] * rs2 * gv[0] * 64.f, -448.f), 448.f), y1 = fminf(fmaxf(hv[i][1] * rs2 * gv[1] * 64.f, -448.f), 448.f);
            const float y2 = fminf(fmaxf(hv[i][2] * rs2 * gv[2] * 64.f, -448.f), 448.f), y3 = fminf(fmaxf(hv[i][3] * rs2 * gv[3] * 64.f, -448.f), 448.f);
            int p = 0;
            p = __builtin_amdgcn_cvt_pk_fp8_f32(y0, y1, p, false);
            p = __builtin_amdgcn_cvt_pk_fp8_f32(y2, y3, p, true);
            w[i] = (unsigned)p; }
        *(u32x4*)(XN2g + (size_t)tok * 1024 + 16 * lane) = w;
    }
    {
        const int L = lane >> 2, q = lane & 3;
        unsigned k0[16], k1[16];
#pragma unroll
        for (int i = 0; i < 4; ++i) {
            const bf16x8 v = in.sv[i];
#pragma unroll
            for (int cI = 0; cI < 8; ++cI) {
                const unsigned u = ((unsigned)(unsigned short)v[cI]) << 16;
                const unsigned mono = (u & 0x80000000u) ? ~u : (u | 0x80000000u);
                const unsigned key = (mono & ~127u) | (unsigned)(127 - (32 * i + 8 * q + cI));
                if (i < 2) k0[8 * i + cI] = key; else k1[8 * (i - 2) + cI] = key;
            }
        }
        sort16_desc(k0); sort16_desc(k1);
        unsigned t[16];
#pragma unroll
        for (int i = 0; i < 16; ++i) t[i] = k0[i] > k1[15 - i] ? k0[i] : k1[15 - i];
        bitonic_clean_desc(t);
#pragma unroll
        for (int i = 0; i < 16; ++i) k0[i] = (unsigned)__builtin_amdgcn_update_dpp(0, (int)t[15 - i], 0xB1, 0xF, 0xF, true);
#pragma unroll
        for (int i = 0; i < 16; ++i) t[i] = t[i] > k0[i] ? t[i] : k0[i];
        bitonic_clean_desc(t);
#pragma unroll
        for (int i = 0; i < 16; ++i) k0[i] = (unsigned)__builtin_amdgcn_update_dpp(0, (int)t[15 - i], 0x4E, 0xF, 0xF, true);
#pragma unroll
        for (int i = 0; i < 16; ++i) t[i] = t[i] > k0[i] ? t[i] : k0[i];
        bitonic_clean_desc(t);
        if (q == 0) {
#pragma unroll
            for (int i = 0; i < 4; ++i) { u32x4 w; w.x = t[4 * i]; w.y = t[4 * i + 1]; w.z = t[4 * i + 2]; w.w = t[4 * i + 3]; *(LAS u32x4*)(kbuf + L * 16 + 4 * i) = w; }
        }
        asm volatile("s_waitcnt lgkmcnt(0)" ::: "memory");
    }
    {
        const int hd = lane >> 3, sub = lane & 7; const bool odd = sub & 1;
        unsigned ck[8];
#pragma unroll
        for (int k = 0; k < 7; ++k) {
            const int cidx = 7 * sub + k;
            const unsigned tab = ctab[cidx];
            const unsigned ia = tab & 15u, ib = (tab >> 8) & 15u;
            const unsigned ka = kbuf[hd * 32 + ia], kb = kbuf[hd * 32 + 16 + ib];
            const float v = key_value(ka) + key_value(kb);
            const unsigned u = __float_as_uint(v);
            const unsigned mono = (u & 0x80000000u) ? ~u : (u | 0x80000000u);
            ck[k] = (cidx < 50) ? ((mono & ~255u) | (255u - (16u * ia + ib))) : 0u;
        }
        ck[7] = 0u;
        sort8_desc(ck);
        cross_minmax_x1<true>(ck, odd); clean8_desc(ck);
        cross_rev_max<0x1B>(ck); cross_minmax_x1<false>(ck, odd); clean8_desc(ck);
        cross_rev_max<DPP_HMIR>(ck); cross_minmax_x1<false>(ck, odd); clean8_desc(ck);
        const int pr = sub >> 1;
        const unsigned e0 = pr == 0 ? ck[0] : pr == 1 ? ck[2] : pr == 2 ? ck[4] : ck[6];
        const unsigned e1 = pr == 0 ? ck[1] : pr == 1 ? ck[3] : pr == 2 ? ck[5] : ck[7];
        const unsigned id0 = 255u - (e0 & 255u), id1 = 255u - (e1 & 255u);
        const unsigned ka0 = kbuf[hd * 32 + (id0 >> 4)], kb0 = kbuf[hd * 32 + 16 + (id0 & 15u)];
        const unsigned ka1 = kbuf[hd * 32 + (id1 >> 4)], kb1 = kbuf[hd * 32 + 16 + (id1 & 15u)];
        const float v0 = key_value8(e0), v1 = key_value8(e1);
        const float mx = max_oct(fmaxf(v0, v1));
        const float ev0 = __expf((v0 - mx) * rs2), ev1 = __expf((v1 - mx) * rs2);
        const float inv = 1.f / sum_oct(ev0 + ev1);
        const int rank0 = (odd ? 8 : 0) + 2 * pr;
        u32x2 ew; ew.x = (127u - (ka0 & 127u)) * 128u + (127u - (kb0 & 127u)); ew.y = (127u - (ka1 & 127u)) * 128u + (127u - (kb1 & 127u));
        f32x2 gw; gw.x = ev0 * inv; gw.y = ev1 * inv;
        *(u32x2*)(EIDXg + (size_t)tok * 128 + hd * 16 + rank0) = ew;
        *(f32x2*)(GATEg + (size_t)tok * 128 + hd * 16 + rank0) = gw;
    }
}

DI float dot16_fp8(const u32x4& row, const float (&x)[16]) {
    float sacc = 0.f;
#pragma unroll
    for (int w = 0; w < 4; ++w) { const f32x2 lo = __builtin_amdgcn_cvt_pk_f32_fp8((int)row[w], false), hi2 = __builtin_amdgcn_cvt_pk_f32_fp8((int)row[w], true);
        sacc += lo.x * x[4 * w] + lo.y * x[4 * w + 1] + hi2.x * x[4 * w + 2] + hi2.y * x[4 * w + 3]; }
    return sacc;
}
template <class TT> DI TT ldu(const void* ubase, unsigned off) { return *(const TT*)((const char*)ubase + off); }
typedef _Float16 h2_t __attribute__((ext_vector_type(2)));
DI void peer_u_slice(int sl, int tk_first, int tk_step, const unsigned char* XN8g, const int* EIDXg, const unsigned char* U8s, float* PDOT, int lane) {
    const int es = lane >> 3, c = lane & 7;
    const unsigned char* tb = U8s + (size_t)sl * 16384 * 128;
    const unsigned c16 = 16u * c, eoff = 64u * es, xoff = 128u * sl + 16u * c, poff = (16u * es + c) * 4u;
    const bool b2 = c & 4, b1 = c & 2, b0 = c & 1;
    u32x4 I0[2], I1[2], I2[2], rowsA[8], rowsB[8], rowsC[8], x0, x1, x2;
#define LD_E8(ib, tk, h) do { const int _t = (tk) < T ? (tk) : T - 1; const int* _eb = EIDXg + (size_t)_t * 128 + 8 * (h); ib[0] = ldu<u32x4>(_eb, eoff); ib[1] = ldu<u32x4>(_eb, eoff + 16u); } while (0)
#define LD_R8(rows, ib, tbl) do { _Pragma("unroll") for (int _q = 0; _q < 2; ++_q) _Pragma("unroll") for (int _r = 0; _r < 4; ++_r) rows[4 * _q + _r] = ldu<u32x4>(tbl, ib[_q][_r] * 128u + c16); } while (0)
#define LD_X(xx, tk) do { const int _t = (tk) < T ? (tk) : T - 1; xx = ldu<u32x4>(XN8g + (size_t)_t * 1024, xoff); } while (0)
#define U_COMPUTE8(rows, xx, tk, h) do { h2_t _x[8]; _Pragma("unroll") for (int _w = 0; _w < 4; ++_w) { _x[2 * _w] = __builtin_amdgcn_cvt_scalef32_pk_f16_fp8(xx[_w], 1.0f, false); _x[2 * _w + 1] = __builtin_amdgcn_cvt_scalef32_pk_f16_fp8(xx[_w], 1.0f, true); } \
        float _p[8]; _Pragma("unroll") for (int _i = 0; _i < 8; ++_i) { if (_i > 0) asm volatile("" : "+v"(rows[_i]) : "v"(_p[_i - 1])); float _s = 0.f; \
            _Pragma("unroll") for (int _w = 0; _w < 4; ++_w) { _s = __builtin_amdgcn_fdot2(__builtin_amdgcn_cvt_scalef32_pk_f16_fp8(rows[_i][_w], 1.0f, false), _x[2 * _w], _s, false); \
                _s = __builtin_amdgcn_fdot2(__builtin_amdgcn_cvt_scalef32_pk_f16_fp8(rows[_i][_w], 1.0f, true), _x[2 * _w + 1], _s, false); } _p[_i] = _s; } \
        float _q4[4], _q2[2]; \
        _Pragma("unroll") for (int _k = 0; _k < 4; ++_k) _q4[_k] = tr_x4(_p[_k], _p[_k + 4], b2); \
        _Pragma("unroll") for (int _k = 0; _k < 2; ++_k) _q2[_k] = tr_x2(_q4[_k], _q4[_k + 2], b1); \
        const float _r1 = tr_x1(_q2[0], _q2[1], b0); \
        if ((tk) < T) { float* _pb = PDOT + ((size_t)sl * T + (tk)) * 128 + 8 * (h); *(float*)((char*)_pb + poff) = _r1; } } while (0)
    int t0 = tk_first;
    LD_E8(I0, t0, 0); LD_E8(I1, t0, 1); LD_E8(I2, t0 + tk_step, 0); LD_X(x0, t0); LD_R8(rowsA, I0, tb); LD_R8(rowsB, I1, tb);
#pragma unroll 1
    for (; t0 < T; t0 += 3 * tk_step) {
        const int t1 = t0 + tk_step, t2 = t1 + tk_step, t3 = t2 + tk_step;
        LD_E8(I0, t1, 1);           LD_R8(rowsC, I2, tb); LD_X(x1, t1); U_COMPUTE8(rowsA, x0, t0, 0);
        LD_E8(I1, t2, 0);           LD_R8(rowsA, I0, tb);               U_COMPUTE8(rowsB, x0, t0, 1);
        LD_E8(I2, t2, 1);           LD_R8(rowsB, I1, tb); LD_X(x2, t2); U_COMPUTE8(rowsC, x1, t1, 0);
        LD_E8(I0, t3, 0);           LD_R8(rowsC, I2, tb);               U_COMPUTE8(rowsA, x1, t1, 1);
        LD_E8(I1, t3, 1);           LD_R8(rowsA, I0, tb); LD_X(x0, t3); U_COMPUTE8(rowsB, x2, t2, 0);
        LD_E8(I2, t3 + tk_step, 0); LD_R8(rowsB, I1, tb);               U_COMPUTE8(rowsC, x2, t2, 1);
    }
#undef U_COMPUTE8
#undef LD_X
}
template <int NT> DI void peer_cj_tokens(int tok0, int tstride, const int* EIDXg, const float* GATEg, const float* PDOT, const float* usc, const float* vsc, float* CJg, float* CMAXg, int lane) {
    int e[NT][2]; float d[NT][2], g[NT][2];
#pragma unroll
    for (int i = 0; i < NT; ++i) { const int tok = tok0 + i * tstride, tc = tok < T ? tok : T - 1;
#pragma unroll
        for (int hh = 0; hh < 2; ++hh) { const int j = lane + 64 * hh; e[i][hh] = EIDXg[(size_t)tc * 128 + j]; g[i][hh] = GATEg[(size_t)tc * 128 + j]; float a = 0.f;
#pragma unroll
            for (int x = 0; x < 8; ++x) a += PDOT[((size_t)x * T + tc) * 128 + j];
            d[i][hh] = a; } }
    float us[NT][2], vs[NT][2];
#pragma unroll
    for (int i = 0; i < NT; ++i)
#pragma unroll
        for (int hh = 0; hh < 2; ++hh) { us[i][hh] = usc[e[i][hh]]; vs[i][hh] = vsc[e[i][hh]]; }
#pragma unroll
    for (int i = 0; i < NT; ++i) { const int tok = tok0 + i * tstride;
        float cv[2], cm = 0.f;
#pragma unroll
        for (int hh = 0; hh < 2; ++hh) {
            const float hraw = d[i][hh] * us[i][hh] * (1.f / 64.f);
            const float hid = 0.5f * hraw * (1.f + erff(hraw * 0.70710678118654752f));
            cv[hh] = hid * g[i][hh] * vs[i][hh];
            cm = fmaxf(cm, fabsf(cv[hh]));
        }
        cm = wave_max(cm);
        const float inv = cm > 0.f ? 1.f / cm : 0.f;
        if (tok < T) { CJg[(size_t)tok * 128 + lane] = cv[0] * inv; CJg[(size_t)tok * 128 + 64 + lane] = cv[1] * inv; if (lane == 0) CMAXg[tok] = cm; }
    }
}
DI void peer_v_slice(int sl, int tk_first, int tk_step, float* out, const int* EIDXg, const float* CJg, const float* CMAXg, const unsigned char* V8s, bf16_t* A4g, float* SSQg, int lane) {
    const int es = lane >> 3, c = lane & 7;
    const unsigned char* tb = V8s + (size_t)sl * 16384 * 128;
    const unsigned c16 = 16u * c, eoff = 64u * es, ob = 128u * sl + 16u * c + 2u * es;
    const bool b5 = lane & 32, b4 = lane & 16, b3 = lane & 8;
    u32x4 I0[2], I1[2], I2[2], rowsA[8], rowsB[8], rowsC[8]; f32x4 cA[2], cB[2], cC[2]; f32x2 h0, h1, h2;
#define LD_C8(cc, tk, h) do { const int _t = (tk) < T ? (tk) : T - 1; const float* _cb = CJg + (size_t)_t * 128 + 8 * (h); cc[0] = ldu<f32x4>(_cb, eoff); cc[1] = ldu<f32x4>(_cb, eoff + 16u); } while (0)
#define V_AXPY8(rows, cc) do { _Pragma("unroll") for (int _q = 0; _q < 2; ++_q) _Pragma("unroll") for (int _r = 0; _r < 4; ++_r) { const _Float16 _ch = (_Float16)cc[_q][_r]; const h2_t _c2 = {_ch, _ch}; \
            _Pragma("unroll") for (int _w = 0; _w < 4; ++_w) { acch[2 * _w] = __builtin_amdgcn_cvt_scalef32_pk_f16_fp8(rows[4 * _q + _r][_w], 1.0f, false) * _c2 + acch[2 * _w]; \
                acch[2 * _w + 1] = __builtin_amdgcn_cvt_scalef32_pk_f16_fp8(rows[4 * _q + _r][_w], 1.0f, true) * _c2 + acch[2 * _w + 1]; } \
              \
            if (4 * _q + _r < 7) asm volatile("" : "+v"(acch[0]), "+v"(acch[1]), "+v"(acch[2]), "+v"(acch[3]), "+v"(acch[4]), "+v"(acch[5]), "+v"(acch[6]), "+v"(acch[7]), "+v"(rows[(4 * _q + _r + 1) & 7])); \
            else asm volatile("" : "+v"(acch[0]), "+v"(acch[1]), "+v"(acch[2]), "+v"(acch[3]), "+v"(acch[4]), "+v"(acch[5]), "+v"(acch[6]), "+v"(acch[7])); } } while (0)
#define LD_H(hh, tk) do { const int _t = (tk) < T ? (tk) : T - 1; hh = ldu<f32x2>(out + (size_t)_t * 1024, ob * 4u); } while (0)
#define V_ZERO() do { _Pragma("unroll") for (int _i = 0; _i < 8; ++_i) acch[_i] = (h2_t){(_Float16)0.f, (_Float16)0.f}; } while (0)
#define V_FINAL(hh, tk) do { float _a[16]; _Pragma("unroll") for (int _i = 0; _i < 8; ++_i) { _a[2 * _i] = (float)acch[_i].x; _a[2 * _i + 1] = (float)acch[_i].y; } \
        const float _cm = CMAXg[(tk) < T ? (tk) : T - 1]; \
        float _q8[8], _q4[4], _q2[2]; \
        _Pragma("unroll") for (int _k = 0; _k < 8; ++_k) _q8[_k] = tr_x32(_a[_k], _a[_k + 8]); \
        _Pragma("unroll") for (int _k = 0; _k < 4; ++_k) _q4[_k] = tr_x16(_q8[_k], _q8[_k + 4]); \
        _Pragma("unroll") for (int _k = 0; _k < 2; ++_k) _q2[_k] = tr_x8(_q4[_k], _q4[_k + 2], b3); \
        const float _ha = hh.x + _q2[0] * _cm, _hb = hh.y + _q2[1] * _cm; const float _ssq = wave_sum(_ha * _ha + _hb * _hb); \
        if ((tk) < T) { *(f32x2*)((char*)(out + (size_t)(tk) * 1024) + ob * 4u) = (f32x2){_ha, _hb}; *(unsigned*)((char*)(A4g + (size_t)(tk) * 1024) + ob * 2u) = cvtpk(_ha, _hb); \
            if (lane == 0) SSQg[(size_t)sl * T + (tk)] = _ssq; } } while (0)
    h2_t acch[8];
    int t0 = tk_first;
    LD_E8(I0, t0, 0); LD_E8(I1, t0, 1); LD_E8(I2, t0 + tk_step, 0); LD_H(h0, t0); LD_R8(rowsA, I0, tb); LD_C8(cA, t0, 0); LD_R8(rowsB, I1, tb); LD_C8(cB, t0, 1);
#pragma unroll 1
    for (; t0 < T; t0 += 3 * tk_step) {
        const int t1 = t0 + tk_step, t2 = t1 + tk_step, t3 = t2 + tk_step;
        LD_E8(I0, t1, 1);           LD_R8(rowsC, I2, tb); LD_C8(cC, t1, 0); LD_H(h1, t1); V_ZERO(); V_AXPY8(rowsA, cA);
        LD_E8(I1, t2, 0);           LD_R8(rowsA, I0, tb); LD_C8(cA, t1, 1);                          V_AXPY8(rowsB, cB); V_FINAL(h0, t0);
        LD_E8(I2, t2, 1);           LD_R8(rowsB, I1, tb); LD_C8(cB, t2, 0); LD_H(h2, t2); V_ZERO(); V_AXPY8(rowsC, cC);
        LD_E8(I0, t3, 0);           LD_R8(rowsC, I2, tb); LD_C8(cC, t2, 1);                          V_AXPY8(rowsA, cA); V_FINAL(h1, t1);
        LD_E8(I1, t3, 1);           LD_R8(rowsA, I0, tb); LD_C8(cA, t3, 0); LD_H(h0, t3); V_ZERO(); V_AXPY8(rowsB, cB);
        LD_E8(I2, t3 + tk_step, 0); LD_R8(rowsB, I1, tb); LD_C8(cB, t3, 1);                          V_AXPY8(rowsC, cC); V_FINAL(h2, t2);
    }
#undef V_FINAL
#undef V_ZERO
#undef LD_H
#undef V_AXPY8
#undef LD_C8
#undef LD_R8
#undef LD_E8
}

typedef const __attribute__((address_space(4))) unsigned long long* karg_ptr_t;
DI karg_ptr_t kargs() { karg_ptr_t p = (karg_ptr_t)__builtin_amdgcn_kernarg_segment_ptr(); asm volatile("" : "+s"(p)); return p; }
#define GAS1 __attribute__((address_space(1)))
#define KIN(k) ((const float*)(const GAS1 float*)kargs()[k])
#define KOUT() ((float*)(GAS1 float*)kargs()[18])
#define KWS() ((unsigned char*)(GAS1 unsigned char*)kargs()[19])

__global__ void __launch_bounds__(512, 2) fwd_kernel(Params P) {
    extern __shared__ __attribute__((aligned(16))) unsigned char lds_raw[];
    LAS unsigned char* lds = (LAS unsigned char*)lds_raw;
    const int tid = threadIdx.x, lane = tid & 63, wid = __builtin_amdgcn_readfirstlane(tid >> 6);
    const int wg = blockIdx.x, nwg = gridDim.x;
    const int gwave = wg * 8 + wid, nwaves = nwg * 8;
    const int lo = P.ph_lo, hi = P.ph_hi;

    volatile LAS unsigned* misc = (volatile LAS unsigned*)(lds + LDS_BYTES - 64);
    if (tid < 16) misc[tid] = 0u;
    __syncthreads();
    { unsigned* xcw = (unsigned*)(KWS() + WS_CTL) + CW_XC;
      if (tid == 0) { const unsigned xcc = xb_xcc_id(); misc[5] = xcc; misc[4] = xb_add(xcw + 64 * xcc, 1u); } }
    XcdBarrier bar; bar.bar = (unsigned*)(KWS() + WS_CTL) + CW_BAR; bar.x = 0; bar.st = misc;
    if (hi - lo > 1) bar = xcd_barrier_post((unsigned*)(KWS() + WS_CTL) + CW_BAR, misc);

#define kmean   ((float*)(KWS() + WS_KMEAN))
#define biasTab ((float*)(KWS() + WS_BIAS))
#define WinT    ((bf16_t*)(KWS() + WS_WIN))
#define WoutT   ((bf16_t*)(KWS() + WS_WOUT))
#define WqT     ((bf16_t*)(KWS() + WS_WQ))
#define WgT     ((bf16_t*)(KWS() + WS_WG))
#define WpleT   ((bf16_t*)(KWS() + WS_WPLE))
#define U8      ((unsigned char*)(KWS() + WS_U))
#define V8      ((unsigned char*)(KWS() + WS_V))
#define USC     ((float*)(KWS() + WS_USC))
#define VSC     ((float*)(KWS() + WS_VSC))
#define XN      ((bf16_t*)(KWS() + WS_XN))
#define PB      ((bf16_t*)(KWS() + WS_PB))
#define Qm      ((bf16_t*)(KWS() + WS_QM))
#define Km      ((bf16_t*)(KWS() + WS_KM))
#define VtM     ((bf16_t*)(KWS() + WS_VTM))
#define Qs      ((bf16_t*)(KWS() + WS_QS))
#define Ks      ((bf16_t*)(KWS() + WS_KS))
#define VtS     ((bf16_t*)(KWS() + WS_VTS))
#define Oraw    ((bf16_t*)(KWS() + WS_ORAW))
#define A2      ((bf16_t*)(KWS() + WS_A2))
#define A3      ((bf16_t*)(KWS() + WS_A3))
#define SC      ((float*)(KWS() + WS_SC))
#define EIDXG   ((int*)(KWS() + WS_EIDX))
#define GATEG   ((float*)(KWS() + WS_GATE))
#define CJG     ((float*)(KWS() + WS_CJ))
#define RS2G    ((float*)(KWS() + WS_RS2))
#define SSQG    ((float*)(KWS() + WS_SSQ))
#define PDOTG   ((float*)(KWS() + WS_PDOT))
#define A4G     ((bf16_t*)(KWS() + WS_A4))
#define XN2G    ((unsigned char*)(KWS() + WS_XN2))

#define IN(k) (lo <= (k) && (k) < hi)
#ifndef PROBE_PHASE
#define PROBE_PHASE -1
#endif
#ifndef PROBE_REPS
#define PROBE_REPS 1
#endif
#define REP(k) for (int _rep = 0; _rep < ((k) == PROBE_PHASE ? PROBE_REPS : 1); ++_rep)
#define SEAM(k) do { if (IN(k) && IN((k) + 1)) xcd_barrier(bar); } while (0)

    if (IN(0)) REP(0) {
        {
            LAS float* scr = (LAS float*)lds + wid * (64 * 65);
            const float* win = KIN(IN_WIN); const float* wout = KIN(IN_WOUT); const float* wpg = KIN(IN_WPG); const float* wple = KIN(IN_WPLE); const float* pln = KIN(IN_PLE_NORM);
            bf16_t* wint = WinT; bf16_t* woutt = WoutT; bf16_t* wgt = WgT; bf16_t* wplet = WpleT;
            for (int t = gwave; t < 1344; t += nwaves) {
                const int sel = t < 768 ? 0 : t < 1024 ? 1 : t < 1280 ? 2 : 3;
                const int tt = sel == 0 ? t : sel == 1 ? t - 768 : sel == 2 ? t - 1024 : t - 1280;
                const float* W = sel == 0 ? win : sel == 1 ? wout : sel == 2 ? wpg : wple;
                bf16_t* Wt = sel == 0 ? wint : sel == 1 ? woutt : sel == 2 ? wgt : wplet;
                const int K = sel == 3 ? 256 : 1024, N = sel == 0 ? 3072 : 1024, tn = sel == 0 ? 48 : 16;
                p0_transpose_wave(W, K, N, Wt, scr, lane, (tt / tn) * 64, (tt % tn) * 64, sel == 0, sel == 2 ? pln : nullptr);
            }
        }
        p0_fold(KIN(IN_PQ), KIN(IN_SUBK), KIN(IN_FFN_NORM), WqT, wid, lane, wg, nwg);
        const size_t gtid = (size_t)wg * 512 + tid, nthr = (size_t)nwg * 512;
        p0_convert(KIN(IN_P), PB, (size_t)T * 256, gtid, nthr);
        { const float* xp = KIN(IN_X); const float* gp = KIN(IN_ATTN_NORM); bf16_t* xo = XN;
          for (int row = gwave; row < T; row += 2 * nwaves) rmsnorm_rows2_bf16(xp, gp, xo, row, row + nwaves, lane); }
        if (wg == 0) {
            for (int idx = tid; idx < 8 * 129; idx += 512) {
                const int h = idx / 129, dist = idx % 129;
                int bk;
                if (dist < 16) bk = dist;
                else { const float v = logf((float)dist / 16.f) / 2.0794415416798357f * 16.f; bk = 16 + (int)v; bk = bk > 31 ? 31 : bk; }
                biasTab[h * 132 + dist] = KIN(IN_RELB)[bk * 8 + h] * LOG2E;
            }
        }
    }
    SEAM(0);
    if (IN(1)) REP(1) {
        pg8::Gemm g{XN, WinT, T, NPROJ, 1024}; pg8::StaticOrder S; S.init(T, NPROJ, nwg, wg);
        EpiQKV E{Qm, KIN(IN_QNORM), KIN(IN_KNORM), kmean};
        pg8::gemm_phase<EpiQKV, pg8::StaticOrder, true, true>(lds, g, S, E);
    }
    SEAM(1);
    if (IN(3)) REP(3) {
        const float* pu = KIN(IN_PU); const float* pv = KIN(IN_PV); unsigned char* u8 = U8; unsigned char* v8 = V8; float* usc_ = USC; float* vsc_ = VSC;
        const bf16_t* qm_ = Qm; const bf16_t* km_ = Km; const bf16_t* vtm_ = VtM; const bf16_t* qs_ = Qs; const bf16_t* ks_ = Ks; const bf16_t* vts_ = VtS;
        const float* kmn_ = kmean; const float* bt_ = biasTab; bf16_t* a2_ = A2;
        const float* gm_ = KIN(IN_ONM); const float* gs_ = KIN(IN_ONS);
        LAS unsigned char* ot = lds;
        LAS float* biasLds = (LAS float*)(lds + 34816);
        for (int i = tid; i < 8 * 132; i += 512) biasLds[i] = bt_[i];
        __syncthreads();
        int qrow = gwave;
        for (int u = gwave; u < 8192; u += nwaves) {
            const int grp = u >> 12, i = u & 4095;
            const int half = i >> 11, j = i & 2047;
            const int qt = half ? (j >> 6) : 63 - (j >> 6), bh = j & 63;
            const int b = bh >> 3, h = bh & 7;
            if (grp == 0) moba_unit(b, h, qt, qm_, km_, vtm_, kmn_, biasLds, ot, lane);
            else sb_unit(b, h, qt, qs_, ks_, vts_, ot, lane);
            __syncthreads();
            {
                const float* gg = grp ? gs_ : gm_;
                const f32x4 g0 = *(const f32x4*)(gg + 8 * lane), g1 = *(const f32x4*)(gg + 8 * lane + 4);
#pragma unroll
                for (int rr = 0; rr < 4; ++rr) {
                    const int row = 4 * wid + rr;
                    const bf16x8 v = *(const LAS bf16x8*)(ot + row * OT_PITCH + lane * 16);
                    float f[8], sq = 0.f;
#pragma unroll
                    for (int e = 0; e < 8; ++e) { f[e] = bf2f(v[e]); sq += f[e] * f[e]; }
                    sq = wave_sum(sq);
                    const float rs = rsqrtf(sq * (1.f / 512.f) + EPS);
                    u32x4 w; w.x = cvtpk(f[0] * rs * g0.x, f[1] * rs * g0.y); w.y = cvtpk(f[2] * rs * g0.z, f[3] * rs * g0.w);
                    w.z = cvtpk(f[4] * rs * g1.x, f[5] * rs * g1.y); w.w = cvtpk(f[6] * rs * g1.z, f[7] * rs * g1.w);
                    *(u32x4*)(a2_ + (size_t)(b * 2048 + qt * 32 + row) * 1024 + grp * 512 + 8 * lane) = w;
                }
            }
            __syncthreads();
            for (int k = 0; k < 1 && qrow < 16384; ++k, qrow += 2 * nwaves) p0_quant_rows4(pu, pv, u8, v8, usc_, vsc_, qrow, qrow + nwaves, lane);
        }
        for (; qrow < 16384; qrow += 2 * nwaves) p0_quant_rows4(pu, pv, u8, v8, usc_, vsc_, qrow, qrow + nwaves, lane);
    }
    SEAM(3);
    if (IN(5)) REP(5) {
        pg8::Gemm g{A2, WoutT, T, 1024, 1024}; pg8::StaticOrder S; S.init(T, 1024, nwg, wg);
        EpiRes E{KIN(IN_X), KOUT(), A3};
        pg8::gemm_phase<EpiRes, pg8::StaticOrder, true, true>(lds, g, S, E);
    }
    SEAM(5);
    if (IN(6)) REP(6) {
        pg8::Gemm g{A3, WqT, T, 2048, 1024}; pg8::StaticOrder S; S.init(T, 2048, nwg, wg);
        EpiBf E{(bf16_t*)SC, 2048};
        pg8::gemm_phase<EpiBf, pg8::StaticOrder, true, true>(lds, g, S, E);
    }
    SEAM(6);
    if (IN(7)) REP(7) {
        LAS float* wl = (LAS float*)(lds + wid * 4096);
        {
            const int c = lane; int ca, cb;
            if (c < 16) { ca = 0; cb = c; } else if (c < 24) { ca = 1; cb = c - 16; } else if (c < 29) { ca = 2; cb = c - 24; } else if (c < 33) { ca = 3; cb = c - 29; }
            else if (c < 36) { ca = 4; cb = c - 33; } else if (c < 42) { ca = 5 + ((c - 36) >> 1); cb = (c - 36) & 1; } else { ca = (c - 34) & 15; cb = 0; }
            ((LAS unsigned*)(wl + 768))[lane] = (unsigned)ca | ((unsigned)cb << 8);
            asm volatile("s_waitcnt lgkmcnt(0)" ::: "memory");
        }
        const float* h1p = KOUT(); const bf16_t* scp = (const bf16_t*)SC; const float* gfp = KIN(IN_FFN_NORM); int* eip = EIDXG; float* gtp = GATEG; unsigned char* xnp = XN2G;
        TopkIn inA, inB;
        peer_topk_load(inA, gwave, h1p, scp, lane);
        for (int tok = gwave; tok < T; tok += 2 * nwaves) {
            peer_topk_load(inB, tok + nwaves, h1p, scp, lane);
            peer_topk_token(tok, inA, gfp, eip, gtp, xnp, wl, lane);
            peer_topk_load(inA, tok + 2 * nwaves, h1p, scp, lane);
            if (tok + nwaves < T) peer_topk_token(tok + nwaves, inB, gfp, eip, gtp, xnp, wl, lane);
        }
    }
    SEAM(7);
    int sl_first = 0, sl_step = 1, tk_first = 0, tk_step = 8;
    if (IN(8) || IN(10)) {
        __syncthreads();
        const unsigned myx = misc[5], myrank = misc[4];
        unsigned nx = 0, myidx = 0, nloc = 1;
        unsigned* xc = (unsigned*)(KWS() + WS_CTL) + CW_XC;
#pragma unroll
        for (unsigned j = 0; j < 16; ++j) { const unsigned cj = xb_ld(xc + 64 * j); if (cj > 0u) { if (j < myx) ++myidx; ++nx; } if (j == myx) nloc = cj; }
        sl_first = __builtin_amdgcn_readfirstlane((int)myidx); sl_step = __builtin_amdgcn_readfirstlane((int)(nx > 0u ? nx : 1u));
        tk_first = __builtin_amdgcn_readfirstlane((int)myrank * 8 + wid); tk_step = __builtin_amdgcn_readfirstlane((int)(nloc > 0u ? nloc : 1u) * 8);
    }
    if (IN(8)) REP(8) {
        const unsigned char* xnp = XN2G; const int* eip = EIDXG; const unsigned char* u8p = U8; float* pdp = PDOTG;
        for (int sl = sl_first; sl < 8; sl += sl_step) peer_u_slice(sl, tk_first, tk_step, xnp, eip, u8p, pdp, lane);
    }
    SEAM(8);
    if (IN(9)) REP(9) {
        const int* eip = EIDXG; const float* gtp = GATEG; const float* pdp = PDOTG; const float* usp = USC; const float* vsp = VSC; float* cjp = CJG; float* cmp_ = RS2G;
        for (int tok = gwave; tok < T; tok += 4 * nwaves) peer_cj_tokens<4>(tok, nwaves, eip, gtp, pdp, usp, vsp, cjp, cmp_, lane);
    }
    SEAM(9);
    if (IN(10)) REP(10) {
        float* outp = KOUT(); const int* eip = EIDXG; const float* cjp = CJG; const float* cmp_ = RS2G; const unsigned char* v8p = V8; bf16_t* a4p = A4G; float* sqp = SSQG;
        for (int sl = sl_first; sl < 8; sl += sl_step) peer_v_slice(sl, tk_first, tk_step, outp, eip, cjp, cmp_, v8p, a4p, sqp, lane);
    }
    SEAM(10);
    if (IN(11)) REP(11) {
        bf16_t* PW = Oraw;
        { int kple = 256; asm volatile("" : "+s"(kple));
          pg8::Gemm g{PB, WpleT, T, 1024, kple}; pg8::StaticOrder S; S.init(T, 1024, nwg, wg);
          EpiBf E{PW, 1024};
          pg8::gemm_phase<EpiBf, pg8::StaticOrder, true, true>(lds, g, S, E); }
        asm volatile("s_waitcnt vmcnt(0)" ::: "memory");
        __syncthreads();
        { pg8::Gemm g{A4G, WgT, T, 1024, 1024}; pg8::StaticOrder S; S.init(T, 1024, nwg, wg);
          EpiGate E{KOUT(), PW, SSQG};
          pg8::gemm_phase<EpiGate, pg8::StaticOrder, true, true>(lds, g, S, E); }
    }
#undef IN
#undef SEAM
}

extern "C" void kernel_launch(void* const* d_in, const int* in_sizes, int n_in, void* d_out, int out_size, void* d_ws, size_t ws_size, hipStream_t stream) {
    static int grid = 0;
    if (grid == 0) {
        if (n_in != 18 || out_size != T * DM || ws_size < WS_END) { fprintf(stderr, "kernel_launch: unexpected shapes (n_in %d out %d ws %zu)\n", n_in, out_size, ws_size); grid = -1; return; }
        int dev = 0, cus = 0, per_cu = 0;
        if (hipGetDevice(&dev) != hipSuccess || hipDeviceGetAttribute(&cus, hipDeviceAttributeMultiprocessorCount, dev) != hipSuccess) { grid = -1; return; }
        if (hipFuncSetAttribute((const void*)fwd_kernel, hipFuncAttributeMaxDynamicSharedMemorySize, LDS_BYTES) != hipSuccess) { fprintf(stderr, "kernel_launch: hipFuncSetAttribute failed\n"); grid = -1; return; }
        if (hipOccupancyMaxActiveBlocksPerMultiprocessor(&per_cu, (const void*)fwd_kernel, 512, LDS_BYTES) != hipSuccess || per_cu < 1)
            fprintf(stderr, "kernel_launch: note: occupancy query reports %d\n", per_cu);
        (void)hipGetLastError();
        grid = cus - (cus % 8);
    }
    if (grid < 0) return;
    if (hipMemsetAsync((char*)d_ws + WS_CTL, 0, CTL_ZERO_BYTES, stream) != hipSuccess) return;
    Params p{};
    for (int i = 0; i < 18; ++i) p.in[i] = (const float*)d_in[i];
    p.out = (float*)d_out; p.ws = (unsigned char*)d_ws;
    p.ph_lo = 0; p.ph_hi = NPHASE;
    hipLaunchKernelGGL(fwd_kernel, dim3(grid), dim3(512), LDS_BYTES, stream, p);
}
```

```cpp
#include <hip/hip_runtime.h>
#include <stdint.h>
#include <stdio.h>

#ifndef N_LAUNCHES
#define N_LAUNCHES 1
#endif

#define DI __device__ __forceinline__
#define LAS __attribute__((address_space(3)))

typedef unsigned short bf16_t;
typedef short bf16x8 __attribute__((ext_vector_type(8)));
typedef float f32x16 __attribute__((ext_vector_type(16)));
typedef float f32x4 __attribute__((ext_vector_type(4)));
typedef float f32x2 __attribute__((ext_vector_type(2)));
typedef unsigned u32x4 __attribute__((ext_vector_type(4)));
typedef unsigned u32x2 __attribute__((ext_vector_type(2)));
typedef __bf16 bf16x2_t __attribute__((ext_vector_type(2)));

constexpr int BATCH = 8, SEQ = 2048, DM = 1024, T = BATCH * SEQ;
constexpr int NPROJ = 3072;
constexpr float EPS = 1e-6f;
constexpr float LOG2E = 1.4426950408889634f;
constexpr float SCL2 = 0.125f * LOG2E;
constexpr int NPHASE = 12;

constexpr size_t MiB = 1u << 20;
constexpr size_t WS_CTL = 0, CTL_ZERO_BYTES = 256 * 1024 + 128 * 1024;
constexpr size_t WS_KMEAN = 256 * 1024;
constexpr size_t WS_BIAS = 512 * 1024;
constexpr size_t WS_WIN = 1 * MiB, WS_WOUT = 7 * MiB, WS_WQ = 9 * MiB, WS_WG = 13 * MiB, WS_WPLE = 15 * MiB;
constexpr size_t WS_U = 16 * MiB, WS_V = 32 * MiB;
constexpr size_t WS_USC = 640 * 1024, WS_VSC = 704 * 1024;
constexpr size_t WS_XN2 = 48 * MiB;
constexpr size_t WS_XN = 80 * MiB;
constexpr size_t WS_PB = 112 * MiB;
constexpr size_t WS_QM = 120 * MiB, WS_KM = 136 * MiB, WS_VTM = 152 * MiB, WS_QS = 168 * MiB, WS_KS = 184 * MiB, WS_VTS = 200 * MiB;
constexpr size_t WS_ORAW = 216 * MiB;
constexpr size_t WS_A2 = 80 * MiB;
constexpr size_t WS_A3 = 120 * MiB;
constexpr size_t WS_SC = 152 * MiB;
constexpr size_t WS_EIDX = 80 * MiB, WS_GATE = 88 * MiB, WS_CJ = 96 * MiB, WS_RS2 = 104 * MiB, WS_SSQ = 105 * MiB;
constexpr size_t WS_PDOT = 152 * MiB;
constexpr size_t WS_A4 = 184 * MiB;
constexpr size_t WS_END = 248 * MiB;

constexpr int CW_XC = 8192;
constexpr int CW_BAR = 4096;

constexpr int LDS_BYTES = 147456;

#define XB_TMO      128
#define XB_XCNT(j)  (256  + 64 * (j))
#define XB_XSUB(j)  (1280 + 64 * (j))
#define XB_XGEN(j)  (2304 + 64 * (j))
#define XB_TOP      3328
#define XB_TOPGEN   3392
#define XCD_BAR_WORDS 3456
#define XB_SPIN_CAP (1u << 18)

__device__ __forceinline__ unsigned xb_ld(unsigned* p)              { return __hip_atomic_load(p, __ATOMIC_RELAXED, __HIP_MEMORY_SCOPE_AGENT); }
__device__ __forceinline__ unsigned xb_add(unsigned* p, unsigned v) { return __hip_atomic_fetch_add(p, v, __ATOMIC_RELAXED, __HIP_MEMORY_SCOPE_AGENT); }
__device__ __forceinline__ unsigned xb_xcc_id() { return (unsigned)__builtin_amdgcn_s_getreg((3 << 11) | 20) & 0xFu; }
#define XB_SPIN(cond, bar) do { unsigned _sp = 0; while (cond) { __builtin_amdgcn_s_sleep(1); \
    if ((++_sp & 255u) == 0u) { if (xb_ld(&(bar)[XB_TMO])) break; if (_sp > XB_SPIN_CAP) { atomicAdd(&(bar)[XB_TMO], 1u); break; } } } } while (0)

struct XcdBarrier { unsigned* bar; unsigned x; volatile LAS unsigned* st; };

__device__ __forceinline__ XcdBarrier xcd_barrier_post(unsigned* bar, volatile LAS unsigned* st) {
    XcdBarrier b; b.bar = bar; b.x = xb_xcc_id(); b.st = st;
    if (threadIdx.x == 0) (void)xb_add(&bar[XB_XCNT(b.x)], 1u);
    return b;
}
__device__ __forceinline__ void xcd_barrier_complete(unsigned* bar, unsigned x, unsigned& nloc, unsigned& nx) {
    const unsigned G = gridDim.x * gridDim.y * gridDim.z;
    unsigned sum, cnt, mine, sp = 0u;
    for (;;) {
        sum = 0u; cnt = 0u; mine = 0u;
#pragma unroll
        for (unsigned j = 0; j < 16; ++j) { const unsigned c = xb_ld(&bar[XB_XCNT(j)]); sum += c; cnt += (c > 0u) ? 1u : 0u; mine = (j == x) ? c : mine; }
        if (sum == G) break;
        __builtin_amdgcn_s_sleep(1);
        if ((++sp & 255u) == 0u) { if (xb_ld(&bar[XB_TMO])) break; if (sp > XB_SPIN_CAP) { atomicAdd(&bar[XB_TMO], 1u); break; } }
    }
    nloc = mine > 0u ? mine : 1u; nx = cnt > 0u ? cnt : 1u;
}
__device__ __forceinline__ void xcd_barrier(const XcdBarrier& b) {
    asm volatile("s_waitcnt vmcnt(0)" ::: "memory");
    __syncthreads();
    if (threadIdx.x == 0) {
        unsigned* bar = b.bar;
        __builtin_amdgcn_s_waitcnt(0);
        unsigned nloc = b.st[0], nx = b.st[1];
        if (nloc == 0u) { xcd_barrier_complete(bar, b.x, nloc, nx); b.st[0] = nloc; b.st[1] = nx; }
        const unsigned old = xb_add(&bar[XB_XSUB(b.x)], 1u);
        const unsigned gen = old / nloc;
        if (old + 1u == (gen + 1u) * nloc) {
            __builtin_amdgcn_fence(__ATOMIC_RELEASE, "agent");
            asm volatile("s_waitcnt vmcnt(0)" ::: "memory");
            const unsigned og = xb_add(&bar[XB_TOP], 1u);
            const unsigned tg = og / nx;
            if (og + 1u == (tg + 1u) * nx) xb_add(&bar[XB_TOPGEN], 1u);
            else XB_SPIN(xb_ld(&bar[XB_TOPGEN]) == tg, bar);
            __builtin_amdgcn_fence(__ATOMIC_ACQUIRE, "agent");
            xb_add(&bar[XB_XGEN(b.x)], 1u);
            asm volatile("s_waitcnt vmcnt(0)" ::: "memory");
        } else {
            XB_SPIN(xb_ld(&bar[XB_XGEN(b.x)]) == gen, bar);
            __builtin_amdgcn_fence(__ATOMIC_ACQUIRE, "agent");
            asm volatile("s_waitcnt vmcnt(0)" ::: "memory");
        }
    }
    __syncthreads();
}

DI float bf2f(short v) { return __builtin_bit_cast(float, ((unsigned)(unsigned short)v) << 16); }
DI unsigned cvtpk(float lo, float hi) { f32x2 v = {lo, hi}; bf16x2_t b = __builtin_convertvector(v, bf16x2_t); return __builtin_bit_cast(unsigned, b); }
DI bf16_t f2bf(float f) { return (bf16_t)(cvtpk(f, 0.f) & 0xffffu); }
template <int CTRL> DI float dppf(float v) { return __builtin_bit_cast(float, __builtin_amdgcn_update_dpp(0, __builtin_bit_cast(int, v), CTRL, 0xF, 0xF, true)); }
#define DPP_XOR1 0xB1
#define DPP_XOR2 0x4E
#define DPP_HMIR 0x141
#define DPP_MIR  0x140
DI void swap16(float v, float& a, float& b) { const auto r = __builtin_amdgcn_permlane16_swap(__builtin_bit_cast(unsigned, v), __builtin_bit_cast(unsigned, v), false, false); const unsigned r0 = r[0], r1 = r[1]; a = __builtin_bit_cast(float, r0); b = __builtin_bit_cast(float, r1); }
DI void swap32(float v, float& a, float& b) { const auto r = __builtin_amdgcn_permlane32_swap(__builtin_bit_cast(unsigned, v), __builtin_bit_cast(unsigned, v), false, false); const unsigned r0 = r[0], r1 = r[1]; a = __builtin_bit_cast(float, r0); b = __builtin_bit_cast(float, r1); }
DI float sum_x16(float v) { float a, b; swap16(v, a, b); return a + b; }
DI float sum_x32(float v) { float a, b; swap32(v, a, b); return a + b; }
DI float max_x32(float v) { float a, b; swap32(v, a, b); return fmaxf(a, b); }
DI float sum_row16(float v) { v += dppf<DPP_XOR1>(v); v += dppf<DPP_XOR2>(v); v += dppf<DPP_HMIR>(v); v += dppf<DPP_MIR>(v); return v; }
DI float max_row16(float v) { v = fmaxf(v, dppf<DPP_XOR1>(v)); v = fmaxf(v, dppf<DPP_XOR2>(v)); v = fmaxf(v, dppf<DPP_HMIR>(v)); v = fmaxf(v, dppf<DPP_MIR>(v)); return v; }
DI float sum_oct(float v) { v += dppf<DPP_XOR1>(v); v += dppf<DPP_XOR2>(v); v += dppf<DPP_HMIR>(v); return v; }
DI float max_oct(float v) { v = fmaxf(v, dppf<DPP_XOR1>(v)); v = fmaxf(v, dppf<DPP_XOR2>(v)); v = fmaxf(v, dppf<DPP_HMIR>(v)); return v; }
DI float wave_sum(float v) { return sum_x32(sum_x16(sum_row16(v))); }
DI float wave_max(float v) { v = max_row16(v); float a, b; swap16(v, a, b); return max_x32(fmaxf(a, b)); }
DI float tr_x32(float lo, float hi) { const auto r = __builtin_amdgcn_permlane32_swap(__builtin_bit_cast(unsigned, lo), __builtin_bit_cast(unsigned, hi), false, false); const unsigned r0 = r[0], r1 = r[1]; return __builtin_bit_cast(float, r0) + __builtin_bit_cast(float, r1); }
DI float tr_x16(float lo, float hi) { const auto r = __builtin_amdgcn_permlane16_swap(__builtin_bit_cast(unsigned, lo), __builtin_bit_cast(unsigned, hi), false, false); const unsigned r0 = r[0], r1 = r[1]; return __builtin_bit_cast(float, r0) + __builtin_bit_cast(float, r1); }
DI float tr_x8(float lo, float hi, bool bit) { const float mine = bit ? hi : lo, send = bit ? lo : hi; return mine + dppf<0x128>(send); }
DI float tr_x4(float lo, float hi, bool bit) {
    const int a = __builtin_amdgcn_update_dpp(0, __builtin_bit_cast(int, hi), 0x114, 0xF, 0xA, false);
    const int b = __builtin_amdgcn_update_dpp(a, __builtin_bit_cast(int, lo), 0x104, 0xF, 0x5, false);
    return (bit ? hi : lo) + __builtin_bit_cast(float, b);
}
DI float tr_x2(float lo, float hi, bool bit) { const float mine = bit ? hi : lo, send = bit ? lo : hi; return mine + dppf<DPP_XOR2>(send); }
DI float tr_x1(float lo, float hi, bool bit) { const float mine = bit ? hi : lo, send = bit ? lo : hi; return mine + dppf<DPP_XOR1>(send); }
DI int crow(int r, int hi) { return (r & 3) + 8 * (r >> 2) + 4 * hi; }
#define MFMA32(a, b, c) __builtin_amdgcn_mfma_f32_32x32x16_bf16((a), (b), (c), 0, 0, 0)
DI f32x16 zero16() { f32x16 z; for (int i = 0; i < 16; ++i) z[i] = 0.f; return z; }

struct Params {
    const float* in[18];
    float* out;
    unsigned char* ws;
    int ph_lo, ph_hi;
};

enum { IN_X = 0, IN_P, IN_RELB, IN_ATTN_NORM, IN_WIN, IN_QNORM, IN_KNORM, IN_ONM, IN_ONS, IN_WOUT, IN_FFN_NORM, IN_PQ, IN_SUBK, IN_PU, IN_PV, IN_PLE_NORM, IN_WPG, IN_WPLE };

DI void p0_transpose_wave(const float* W, int K, int N, bf16_t* Wt, LAS float* scr  , int lane, int k0, int n0, bool headperm, const float* kgain) {
    f32x4 v[16];
    const int lr = lane >> 4, lc = 4 * (lane & 15);
#pragma unroll
    for (int i = 0; i < 16; ++i) v[i] = *(const f32x4*)(W + (size_t)(k0 + 4 * i + lr) * N + n0 + lc);
#pragma unroll
    for (int i = 0; i < 16; ++i) { LAS float* d = scr + (4 * i + lr) * 65 + lc; d[0] = v[i].x; d[1] = v[i].y; d[2] = v[i].z; d[3] = v[i].w; }
    __builtin_amdgcn_wave_barrier();
    const int j = lane & 7, nl = lane >> 3;
    f32x4 g0 = {1.f, 1.f, 1.f, 1.f}, g1 = g0;
    if (kgain) { g0 = *(const f32x4*)(kgain + k0 + 8 * j); g1 = *(const f32x4*)(kgain + k0 + 8 * j + 4); }
#pragma unroll
    for (int q = 0; q < 8; ++q) {
        const int nn = 8 * q + nl;
        int n = n0 + nn;
        if (headperm) { const int w = n & 255; n = (n & ~255) + 128 * ((w >> 5) & 1) + 32 * (w >> 6) + (w & 31); }
        const LAS float* sp = scr + (8 * j) * 65 + nn;
        u32x4 w;
        w.x = cvtpk(sp[0] * g0.x, sp[65] * g0.y); w.y = cvtpk(sp[130] * g0.z, sp[195] * g0.w);
        w.z = cvtpk(sp[260] * g1.x, sp[325] * g1.y); w.w = cvtpk(sp[390] * g1.z, sp[455] * g1.w);
        *(u32x4*)(Wt + (size_t)n * K + k0 + 8 * j) = w;
    }
    __builtin_amdgcn_wave_barrier();
}

DI void split_bf16x8(const f32x4& p, const f32x4& q, bf16x8& hi, bf16x8& lo) {
    u32x4 h, l;
    h.x = cvtpk(p.x, p.y); h.y = cvtpk(p.z, p.w); h.z = cvtpk(q.x, q.y); h.w = cvtpk(q.z, q.w);
    const float r0 = p.x - __builtin_bit_cast(float, h.x << 16), r1 = p.y - __builtin_bit_cast(float, h.x & 0xffff0000u), r2 = p.z - __builtin_bit_cast(float, h.y << 16), r3 = p.w - __builtin_bit_cast(float, h.y & 0xffff0000u);
    const float r4 = q.x - __builtin_bit_cast(float, h.z << 16), r5 = q.y - __builtin_bit_cast(float, h.z & 0xffff0000u), r6 = q.z - __builtin_bit_cast(float, h.w << 16), r7 = q.w - __builtin_bit_cast(float, h.w & 0xffff0000u);
    l.x = cvtpk(r0, r1); l.y = cvtpk(r2, r3); l.z = cvtpk(r4, r5); l.w = cvtpk(r6, r7);
    hi = __builtin_bit_cast(bf16x8, h); lo = __builtin_bit_cast(bf16x8, l);
}
DI void p0_fold(const float* wq, const float* sub, const float* gffn, bf16_t* WqT, int wid, int lane, int wg, int nwg) {
    const int r = lane & 31, hi = lane >> 5, dq = wid & 1, nq = wid >> 1;
    for (int item = wg; item < 256; item += nwg) {
        const int dt = item & 15, hh = item >> 4, d0 = dt * 64 + 32 * dq, h = hh >> 1, half = hh & 1;
        const float* ap = wq + (size_t)(d0 + r) * 2048 + h * 256 + half * 128 + 8 * hi;
        const float* bp = sub + half * 16384 + (size_t)(32 * nq + r) * 128 + 8 * hi;
        f32x16 acc = zero16();
#pragma unroll
        for (int st = 0; st < 8; ++st) {
            const f32x4 a0 = *(const f32x4*)(ap + 16 * st), a1 = *(const f32x4*)(ap + 16 * st + 4), b0 = *(const f32x4*)(bp + 16 * st), b1 = *(const f32x4*)(bp + 16 * st + 4);
            bf16x8 ah, al, bh, bl;
            split_bf16x8(a0, a1, ah, al); split_bf16x8(b0, b1, bh, bl);
            acc = MFMA32(ah, bh, acc); acc = MFMA32(ah, bl, acc); acc = MFMA32(al, bh, acc);
        }
        bf16_t* op = WqT + (size_t)(hh * 128 + 32 * nq + r) * 1024 + d0 + 4 * hi;
#pragma unroll
        for (int g4 = 0; g4 < 4; ++g4) {
            const f32x4 gv = *(const f32x4*)(gffn + d0 + 8 * g4 + 4 * hi);
            u32x2 w; w.x = cvtpk(acc[4 * g4] * gv.x, acc[4 * g4 + 1] * gv.y); w.y = cvtpk(acc[4 * g4 + 2] * gv.z, acc[4 * g4 + 3] * gv.w);
            *(u32x2*)(op + 8 * g4) = w;
        }
    }
}

DI void p0_convert(const float* src, bf16_t* dst, size_t n, size_t gtid, size_t nthreads) {
    for (size_t i = gtid * 8; i < n; i += nthreads * 8) {
        const f32x4 a = *(const f32x4*)(src + i), b = *(const f32x4*)(src + i + 4);
        u32x4 o; o.x = cvtpk(a.x, a.y); o.y = cvtpk(a.z, a.w); o.z = cvtpk(b.x, b.y); o.w = cvtpk(b.z, b.w);
        *(u32x4*)(dst + i) = o;
    }
}


DI void p0_quant_finish(const f32x4 (&a)[4], unsigned char* dst, float* scale, int row, int lane) {
    float m = 0.f;
#pragma unroll
    for (int i = 0; i < 4; ++i) m = fmaxf(fmaxf(m, fmaxf(fabsf(a[i].x), fabsf(a[i].y))), fmaxf(fabsf(a[i].z), fabsf(a[i].w)));
    m = wave_max(m);
    const float sc = m > 0.f ? m * (1.f / 440.f) : 1.f, inv = m > 0.f ? 440.f / m : 0.f;
    u32x4 w;
#pragma unroll
    for (int i = 0; i < 4; ++i) {
        const float q0 = fminf(fmaxf(a[i].x * inv, -448.f), 448.f), q1 = fminf(fmaxf(a[i].y * inv, -448.f), 448.f);
        const float q2 = fminf(fmaxf(a[i].z * inv, -448.f), 448.f), q3 = fminf(fmaxf(a[i].w * inv, -448.f), 448.f);
        int p = 0;
        p = __builtin_amdgcn_cvt_pk_fp8_f32(q0, q1, p, false);
        p = __builtin_amdgcn_cvt_pk_fp8_f32(q2, q3, p, true);
        w[i] = (unsigned)p;
    }
    *(u32x4*)(dst + ((size_t)(lane >> 3) * 16384 + row) * 128 + 16 * (lane & 7)) = w;
    if (lane == 0) scale[row] = sc;
}
DI void p0_quant_rows4(const float* pu, const float* pv, unsigned char* u8, unsigned char* v8, float* usc_, float* vsc_, int r0, int r1, int lane) {
    f32x4 a[4][4];
    const int r1c = r1 < 16384 ? r1 : r0;
#pragma unroll
    for (int i = 0; i < 4; ++i) { a[0][i] = *(const f32x4*)(pu + (size_t)r0 * 1024 + 16 * lane + 4 * i); a[1][i] = *(const f32x4*)(pv + (size_t)r0 * 1024 + 16 * lane + 4 * i);
        a[2][i] = *(const f32x4*)(pu + (size_t)r1c * 1024 + 16 * lane + 4 * i); a[3][i] = *(const f32x4*)(pv + (size_t)r1c * 1024 + 16 * lane + 4 * i); }
    p0_quant_finish(a[0], u8, usc_, r0, lane); p0_quant_finish(a[1], v8, vsc_, r0, lane);
    if (r1 < 16384) { p0_quant_finish(a[2], u8, usc_, r1, lane); p0_quant_finish(a[3], v8, vsc_, r1, lane); }
}

DI void rmsnorm_rows2_bf16(const float* x, const float* g, bf16_t* o, int r0, int r1, int lane) {
    f32x4 v[2][4]; float s[2] = {0.f, 0.f};
    const int rr[2] = {r0, r1 < T ? r1 : r0};
#pragma unroll
    for (int q = 0; q < 2; ++q)
#pragma unroll
        for (int j = 0; j < 4; ++j) v[q][j] = ((const f32x4*)(x + (size_t)rr[q] * 1024))[lane + 64 * j];
#pragma unroll
    for (int q = 0; q < 2; ++q) {
#pragma unroll
        for (int j = 0; j < 4; ++j) s[q] += (v[q][j].x * v[q][j].x + v[q][j].y * v[q][j].y) + (v[q][j].z * v[q][j].z + v[q][j].w * v[q][j].w);
        s[q] = wave_sum(s[q]);
    }
#pragma unroll
    for (int q = 0; q < 2; ++q) {
        if (q == 1 && r1 >= T) break;
        const float rs = rsqrtf(s[q] * (1.f / 1024.f) + EPS);
#pragma unroll
        for (int j = 0; j < 4; ++j) { const f32x4 gv = ((const f32x4*)g)[lane + 64 * j];
            u32x2 w; w.x = cvtpk(v[q][j].x * rs * gv.x, v[q][j].y * rs * gv.y); w.y = cvtpk(v[q][j].z * rs * gv.z, v[q][j].w * rs * gv.w);
            ((u32x2*)(o + (size_t)rr[q] * 1024))[lane + 64 * j] = w; }
    }
}

namespace pg8 {
#define PG8_LAS __attribute__((address_space(3)))
typedef unsigned short bf16_t;
typedef short bf16x8 __attribute__((ext_vector_type(8)));
typedef float f32x4 __attribute__((ext_vector_type(4)));
typedef unsigned u32x4 __attribute__((ext_vector_type(4)));
constexpr int BM = 256, BK = 64, HALF = 128, HTB = HALF * BK * 2  , STAGE_BYTES = 8 * HTB, NXCD = 8, WGM = 8;

__host__ __device__ __forceinline__ int lds_byte(int r, int c) { const int st = (r >> 4) * 2 + (c >> 5), rr = r & 15, cc = c & 31, ob = rr * 64 + cc * 2; return st * 1024 + (ob ^ (((ob >> 9) & 1) << 5)); }
__host__ __device__ __forceinline__ void stage_rc(int b, int& R, int& C) { const int st = b / 1024, sb = b % 1024, swz = sb ^ (((sb >> 9) & 1) << 5); R = (st >> 1) * 16 + swz / 64; C = (st & 1) * 32 + (swz % 64) / 2; }
__host__ __device__ __forceinline__ int perm32(int rho) { const int n = rho >> 4, i = rho & 15; return 8 * (i >> 2) + 4 * n + (i & 3); }

struct Unit { int pm, pn; };
struct Gemm { const bf16_t* A; const bf16_t* Bt; int M, N, K; };

struct StaticOrder {
    int nM, nN, nwg, G, c;
    __host__ __device__ void init(int M, int N, int G_, int c_) { nM = M / BM; nN = N / BM; nwg = nM * nN; G = G_; c = c_; }
    __host__ __device__ bool next(int i, Unit& u) const {
        const long L = (long)i * G + c; if (L >= nwg) return false;
        int wgid = (int)L; { const int q = nwg / NXCD, r = nwg % NXCD, xcd = wgid % NXCD, off = wgid / NXCD; wgid = (xcd < r ? xcd * (q + 1) : r * (q + 1) + (xcd - r) * q) + off; }
        const int nig = WGM * nN, gid = wgid / nig, fm = gid * WGM, gsz = (nM - fm) < WGM ? (nM - fm) : WGM;
        u.pm = fm + ((wgid % nig) % gsz); u.pn = (wgid % nig) / gsz; return true;
    }
    __device__ __forceinline__ void a_ready(const Unit&) const {}
    __device__ __forceinline__ void done(const Unit&) const {}
};

template <class Epi, class Sched, bool ALIGN_EPI = false, bool SP2 = false>
__device__ __forceinline__ void gemm_phase(PG8_LAS unsigned char* lds, const Gemm g, const Sched& S, const Epi& E) {
    int tid_ = threadIdx.x; asm volatile("" : "+v"(tid_));
    const int tid = tid_, wid = __builtin_amdgcn_readfirstlane(tid >> 6), lane = tid & 63, wr = wid >> 2, wc = wid & 3, fr = lane & 15, fq = lane >> 4;
    const int K = g.K, nt = K / BK;
    unsigned voffA[2], voffB[2];
#pragma unroll
    for (int i = 0; i < 2; ++i) { int R, C; stage_rc(tid * 16 + i * 8192, R, C); const int Rb = Epi::PERM ? ((R & ~31) + perm32(R & 31)) : R;
        voffA[i] = (unsigned)(R * K + C) * 2u; voffB[i] = (unsigned)(Rb * K + C) * 2u; }
    const size_t kstep = (size_t)(BK * 2);
    const size_t hstep = (size_t)HALF * K * 2;
    const size_t tstep = 2 * hstep;
    const unsigned ldsw = (unsigned)wid * 1024u;
    const int aoff = lds_byte(wr * 64 + fr, fq * 8), boff = lds_byte(wc * 32 + fr, fq * 8);
#define PG8_SA(b, h) (((b) * 2 + (h)) * HTB)
#define PG8_SB(b, h) ((4 + (b) * 2 + (h)) * HTB)
#define PG8_STAGE(bufoff, gbase, voff) do { _Pragma("unroll") for (int _i = 0; _i < 2; ++_i) \
        __builtin_amdgcn_global_load_lds((const unsigned*)((const char*)(gbase) + (voff)[_i]), (PG8_LAS unsigned*)(lds + (bufoff) + ldsw + _i * 8192), 16, 0, 0); } while (0)
#define PG8_LDA(dst, b, h) do { _Pragma("unroll") for (int m = 0; m < 4; ++m) _Pragma("unroll") for (int k = 0; k < 2; ++k) dst[m][k] = *(const PG8_LAS bf16x8*)(lds + PG8_SA(b, h) + aoff + m * 2048 + k * 1024); } while (0)
#define PG8_LDB(dst, b, h) do { _Pragma("unroll") for (int n = 0; n < 2; ++n) _Pragma("unroll") for (int k = 0; k < 2; ++k) dst[n][k] = *(const PG8_LAS bf16x8*)(lds + PG8_SB(b, h) + boff + n * 2048 + k * 1024); } while (0)
#define PG8_MMA(ai, bj, At, Bt) do { __builtin_amdgcn_s_setprio(1); _Pragma("unroll") for (int m = 0; m < 4; ++m) _Pragma("unroll") for (int n = 0; n < 2; ++n) _Pragma("unroll") for (int k = 0; k < 2; ++k) \
        acc[ai][bj][m][n] = __builtin_amdgcn_mfma_f32_16x16x32_bf16(Bt[n][k], At[m][k], acc[ai][bj][m][n], 0, 0, 0); __builtin_amdgcn_s_setprio(0); } while (0)
#define PG8_WAIT_V(n) asm volatile("s_waitcnt vmcnt(" #n ")" ::: "memory")
#define PG8_WAIT_L(n) asm volatile("s_waitcnt lgkmcnt(" #n ")" ::: "memory")
#define PG8_BAR __builtin_amdgcn_s_barrier()
#define PG8_SCHED __builtin_amdgcn_sched_barrier(0)
    Unit cur, nxt; int ui = 0;
    if (!S.next(0, cur)) return;
    f32x4 acc[2][2][4][2];
#pragma unroll
    for (int a = 0; a < 2; ++a)
#pragma unroll
        for (int b = 0; b < 2; ++b)
#pragma unroll
            for (int m = 0; m < 4; ++m)
#pragma unroll
                for (int n = 0; n < 2; ++n) acc[a][b][m][n] = (f32x4){0.f, 0.f, 0.f, 0.f};
    bf16x8 At[4][2], B0[2][2], B1[2][2];
    const char* cA = (const char*)g.A + (size_t)cur.pm * tstep; const char* cB = (const char*)g.Bt + (size_t)cur.pn * tstep;
    S.a_ready(cur);
    if constexpr (SP2) {
        PG8_STAGE(PG8_SB(0, 0), cB, voffB); PG8_STAGE(PG8_SB(0, 1), cB + hstep, voffB); PG8_STAGE(PG8_SA(0, 0), cA, voffA); PG8_STAGE(PG8_SA(0, 1), cA + hstep, voffA);
        if (wr == 1) PG8_BAR;
        PG8_WAIT_V(2); PG8_BAR;
        PG8_STAGE(PG8_SB(1, 0), cB + kstep, voffB); PG8_STAGE(PG8_SA(1, 0), cA + kstep, voffA); PG8_STAGE(PG8_SB(1, 1), cB + hstep + kstep, voffB);
        PG8_WAIT_V(6); PG8_BAR;
    } else {
        PG8_STAGE(PG8_SB(0, 0), cB, voffB); PG8_STAGE(PG8_SA(0, 0), cA, voffA); PG8_STAGE(PG8_SB(0, 1), cB + hstep, voffB); PG8_STAGE(PG8_SA(0, 1), cA + hstep, voffA);
        if (wr == 1) PG8_BAR;
        PG8_WAIT_V(4); PG8_BAR;
        PG8_STAGE(PG8_SB(1, 0), cB + kstep, voffB); PG8_STAGE(PG8_SA(1, 0), cA + kstep, voffA); PG8_STAGE(PG8_SB(1, 1), cB + hstep + kstep, voffB);
        PG8_WAIT_V(6); PG8_BAR;
    }
    for (;;) {
        const bool has_next = S.next(ui + 1, nxt);
        const char* nA = has_next ? (const char*)g.A + (size_t)nxt.pm * tstep : cA; const char* nB = has_next ? (const char*)g.Bt + (size_t)nxt.pn * tstep : cB;
        for (int t = 0; t < nt; t += 2) {
            const bool last = (t == nt - 2);
            const char* a1 = cA + (size_t)(t + 1) * kstep;
            const char* a2 = last ? nA : cA + (size_t)(t + 2) * kstep; const char* b2 = last ? nB : cB + (size_t)(t + 2) * kstep;
            const char* a3 = a2 + kstep; const char* b3 = b2 + kstep;
            if (last && has_next) S.a_ready(nxt);
            if constexpr (SP2) {
            PG8_LDB(B0, 0, 0); PG8_LDB(B1, 0, 1); PG8_SCHED; PG8_LDA(At, 0, 0); PG8_STAGE(PG8_SA(1, 1), a1 + hstep, voffA);
            PG8_WAIT_V(8); PG8_WAIT_L(0); PG8_BAR; PG8_MMA(0, 0, At, B0); PG8_MMA(0, 1, At, B1); PG8_BAR; PG8_SCHED;
            PG8_LDA(At, 0, 1); PG8_STAGE(PG8_SB(0, 0), b2, voffB); PG8_STAGE(PG8_SB(0, 1), b2 + hstep, voffB); PG8_STAGE(PG8_SA(0, 0), a2, voffA);
            PG8_WAIT_V(8); PG8_WAIT_L(0); PG8_BAR; PG8_MMA(1, 0, At, B0); PG8_MMA(1, 1, At, B1); PG8_BAR; PG8_SCHED;
            PG8_LDB(B0, 1, 0); PG8_LDB(B1, 1, 1); PG8_SCHED; PG8_LDA(At, 1, 0); PG8_STAGE(PG8_SA(0, 1), a2 + hstep, voffA);
            PG8_WAIT_V(8); PG8_WAIT_L(0); PG8_BAR; PG8_MMA(0, 0, At, B0); PG8_MMA(0, 1, At, B1); PG8_BAR; PG8_SCHED;
            PG8_LDA(At, 1, 1); PG8_STAGE(PG8_SB(1, 0), b3, voffB); PG8_STAGE(PG8_SB(1, 1), b3 + hstep, voffB); PG8_STAGE(PG8_SA(1, 0), a3, voffA);
            PG8_WAIT_V(8); PG8_WAIT_L(0); PG8_BAR; PG8_MMA(1, 0, At, B0); PG8_MMA(1, 1, At, B1); PG8_BAR; PG8_SCHED;
            } else {
            PG8_LDB(B0, 0, 0); PG8_SCHED; PG8_LDA(At, 0, 0); PG8_STAGE(PG8_SA(1, 1), a1 + hstep, voffA);
            PG8_WAIT_L(8); PG8_BAR; PG8_WAIT_L(0); PG8_MMA(0, 0, At, B0); PG8_BAR; PG8_SCHED;
            PG8_LDB(B1, 0, 1); PG8_STAGE(PG8_SB(0, 0), b2, voffB);
            PG8_BAR; PG8_WAIT_L(0); PG8_MMA(0, 1, At, B1); PG8_BAR;
            PG8_LDA(At, 0, 1); PG8_STAGE(PG8_SA(0, 0), a2, voffA);
            PG8_BAR; PG8_WAIT_L(0); PG8_MMA(1, 0, At, B0); PG8_BAR; PG8_SCHED;
            PG8_STAGE(PG8_SB(0, 1), b2 + hstep, voffB);
            PG8_WAIT_V(6); PG8_BAR; PG8_MMA(1, 1, At, B1); PG8_BAR;
            PG8_LDB(B0, 1, 0); PG8_SCHED; PG8_LDA(At, 1, 0); PG8_STAGE(PG8_SA(0, 1), a2 + hstep, voffA);
            PG8_WAIT_L(8); PG8_BAR; PG8_WAIT_L(0); PG8_MMA(0, 0, At, B0); PG8_BAR; PG8_SCHED;
            PG8_LDB(B1, 1, 1); PG8_STAGE(PG8_SB(1, 0), b3, voffB);
            PG8_BAR; PG8_WAIT_L(0); PG8_MMA(0, 1, At, B1); PG8_BAR;
            PG8_LDA(At, 1, 1); PG8_STAGE(PG8_SA(1, 0), a3, voffA);
            PG8_BAR; PG8_WAIT_L(0); PG8_MMA(1, 0, At, B0); PG8_BAR; PG8_SCHED;
            PG8_STAGE(PG8_SB(1, 1), b3 + hstep, voffB);
            PG8_WAIT_V(6); PG8_BAR; PG8_MMA(1, 1, At, B1); PG8_BAR;
            }
        }
        if constexpr (ALIGN_EPI) { if (wr == 0) PG8_BAR; }
        if constexpr (!Epi::AFTER_DRAIN) { E(acc, cur, wr, wc, fr, fq); S.done(cur); }
        if (!has_next) break;
#pragma unroll
        for (int a = 0; a < 2; ++a)
#pragma unroll
            for (int b = 0; b < 2; ++b)
#pragma unroll
                for (int m = 0; m < 4; ++m)
#pragma unroll
                    for (int n = 0; n < 2; ++n) acc[a][b][m][n] = (f32x4){0.f, 0.f, 0.f, 0.f};
        cur = nxt; cA = nA; cB = nB; ++ui;
        if constexpr (ALIGN_EPI) { if (wr == 1) PG8_BAR; }
    }
    PG8_WAIT_V(0);
    if constexpr (!ALIGN_EPI) { if (wr == 0) PG8_BAR; }
    PG8_BAR;
    if constexpr (Epi::AFTER_DRAIN) { E.fused(acc, cur, wr, wc, fr, fq, lds, wid, lane); S.done(cur); }
#undef PG8_SA
#undef PG8_SB
#undef PG8_STAGE
#undef PG8_LDA
#undef PG8_LDB
#undef PG8_MMA
#undef PG8_WAIT_V
#undef PG8_WAIT_L
#undef PG8_BAR
#undef PG8_SCHED
}
}


struct EpiQKV {
    static constexpr bool PERM = true, AFTER_DRAIN = false;
    bf16_t* base6; const float *qn, *kn; float* kmean_acc;
    DI void operator()(const f32x4 (&acc)[2][2][4][2], const pg8::Unit& u, int wr, int wc, int fr, int fq) const {
        const int typ = u.pn >> 1, h = (u.pn & 1) * 4 + wc;
        bf16_t* reg = base6 + (size_t)typ * (16u << 19);
        const int row0 = u.pm * 256 + wr * 64 + fr;
        if (typ == 2 || typ == 5) {
#pragma unroll
            for (int ai = 0; ai < 2; ++ai)
#pragma unroll
                for (int m = 0; m < 4; ++m) {
                    const int tok = row0 + ai * 128 + m * 16, b = tok >> 11, sq = tok & 2047, tile = sq >> 5, kap = sq & 31;
                    const int s2 = kap >> 4, hh = (kap >> 2) & 1, jj = ((kap >> 3) & 1) * 4 + (kap & 3);
                    bf16_t* bp = reg + ((((size_t)(b * 8 + h) * 64 + tile) * 4 + s2 * 2) * 64 + hh * 32 + 8 * fq) * 8 + jj;
#pragma unroll
                    for (int bj = 0; bj < 2; ++bj)
#pragma unroll
                        for (int n = 0; n < 2; ++n)
#pragma unroll
                            for (int i = 0; i < 4; ++i) bp[(size_t)bj * 512 + (4 * n + i) * 8] = f2bf(acc[ai][bj][m][n][i]);
                }
        } else {
            const bool nrm = typ < 2;
            const float* g = (typ == 0) ? qn : kn;
            f32x4 gv[2][2];
#pragma unroll
            for (int bj = 0; bj < 2; ++bj)
#pragma unroll
                for (int n = 0; n < 2; ++n) gv[bj][n] = nrm ? *(const f32x4*)(g + 32 * bj + 8 * fq + 4 * n) : (f32x4){1.f, 1.f, 1.f, 1.f};
#pragma unroll
            for (int ai = 0; ai < 2; ++ai)
#pragma unroll
                for (int m = 0; m < 4; ++m) {
                    const int tok = row0 + ai * 128 + m * 16, b = tok >> 11, sq = tok & 2047, tile = sq >> 5, kap = sq & 31;
                    float rs = 1.f;
                    if (nrm) {
                        float ss = 0.f;
#pragma unroll
                        for (int bj = 0; bj < 2; ++bj)
#pragma unroll
                            for (int n = 0; n < 2; ++n) { const f32x4 v = acc[ai][bj][m][n]; ss += (v.x * v.x + v.y * v.y) + (v.z * v.z + v.w * v.w); }
                        ss = sum_x32(sum_x16(ss));
                        rs = rsqrtf(ss * (1.f / 64.f) + EPS);
                    }
                    bf16_t* dst = reg + ((((size_t)(b * 8 + h) * 64 + tile) * 4 + (fq >> 1)) * 64 + (fq & 1) * 32 + kap) * 8;
#pragma unroll
                    for (int bj = 0; bj < 2; ++bj) {
                        const f32x4 v0 = acc[ai][bj][m][0] * rs * gv[bj][0], v1 = acc[ai][bj][m][1] * rs * gv[bj][1];
                        u32x4 w; w.x = cvtpk(v0.x, v0.y); w.y = cvtpk(v0.z, v0.w); w.z = cvtpk(v1.x, v1.y); w.w = cvtpk(v1.z, v1.w);
                        *(u32x4*)(dst + (size_t)bj * 2 * 512) = w;
                    }
                }
            if (typ == 1) {
                asm volatile("" ::: "memory");
                f32x4 ks[2][2];
#pragma unroll
                for (int bj = 0; bj < 2; ++bj)
#pragma unroll
                    for (int n = 0; n < 2; ++n) ks[bj][n] = (f32x4){0.f, 0.f, 0.f, 0.f};
#pragma unroll
                for (int ai = 0; ai < 2; ++ai)
#pragma unroll
                    for (int m = 0; m < 4; ++m) {
                        float ss = 0.f;
#pragma unroll
                        for (int bj = 0; bj < 2; ++bj)
#pragma unroll
                            for (int n = 0; n < 2; ++n) { const f32x4 v = acc[ai][bj][m][n]; ss += (v.x * v.x + v.y * v.y) + (v.z * v.z + v.w * v.w); }
                        ss = sum_x32(sum_x16(ss));
                        const float rs = rsqrtf(ss * (1.f / 64.f) + EPS);
#pragma unroll
                        for (int bj = 0; bj < 2; ++bj)
#pragma unroll
                            for (int n = 0; n < 2; ++n) ks[bj][n] += acc[ai][bj][m][n] * rs * gv[bj][n];
                    }
                const int tok0 = u.pm * 256;
                float* kd = kmean_acc + ((size_t)((tok0 >> 11) * 8 + h) * 8 + ((tok0 & 2047) >> 8)) * 64 + 8 * fq;
#pragma unroll
                for (int bj = 0; bj < 2; ++bj)
#pragma unroll
                    for (int n = 0; n < 2; ++n)
#pragma unroll
                        for (int i = 0; i < 4; ++i) { const float t = sum_row16(ks[bj][n][i]) * (1.f / 256.f); if (fr == 0) atomicAdd(kd + 32 * bj + 4 * n + i, t); }
            }
        }
    }
};

struct EpiRes {
    static constexpr bool PERM = true, AFTER_DRAIN = false;
    const float* x; bf16_t* xn;
    DI void operator()(const f32x4 (&acc)[2][2][4][2], const pg8::Unit& u, int wr, int wc, int fr, int fq) const {
        const int row0 = u.pm * 256 + wr * 64 + fr, col0 = u.pn * 256 + wc * 32 + 8 * fq;
#pragma unroll
        for (int ai = 0; ai < 2; ++ai)
#pragma unroll
            for (int m = 0; m < 4; ++m)
#pragma unroll
                for (int bj = 0; bj < 2; ++bj) {
                    const size_t off = (size_t)(row0 + ai * 128 + m * 16) * 1024 + col0 + bj * 128;
                    const f32x4 h0 = *(const f32x4*)(x + off) + acc[ai][bj][m][0], h1 = *(const f32x4*)(x + off + 4) + acc[ai][bj][m][1];
                    u32x4 w; w.x = cvtpk(h0.x, h0.y); w.y = cvtpk(h0.z, h0.w); w.z = cvtpk(h1.x, h1.y); w.w = cvtpk(h1.z, h1.w);
                    *(u32x4*)(xn + off) = w;
                }
    }
};

struct EpiF32 {
    static constexpr bool PERM = true, AFTER_DRAIN = false;
    float* C; int ldc;
    DI void operator()(const f32x4 (&acc)[2][2][4][2], const pg8::Unit& u, int wr, int wc, int fr, int fq) const {
        const int row0 = u.pm * 256 + wr * 64 + fr, col0 = u.pn * 256 + wc * 32 + 8 * fq;
#pragma unroll
        for (int ai = 0; ai < 2; ++ai)
#pragma unroll
            for (int m = 0; m < 4; ++m)
#pragma unroll
                for (int bj = 0; bj < 2; ++bj) {
                    float* p = C + (size_t)(row0 + ai * 128 + m * 16) * ldc + col0 + bj * 128;
                    *(f32x4*)p = acc[ai][bj][m][0]; *(f32x4*)(p + 4) = acc[ai][bj][m][1];
                }
    }
};

struct EpiBf {
    static constexpr bool PERM = true, AFTER_DRAIN = false;
    bf16_t* C; int ldc;
    DI void operator()(const f32x4 (&acc)[2][2][4][2], const pg8::Unit& u, int wr, int wc, int fr, int fq) const {
        const int row0 = u.pm * 256 + wr * 64 + fr, col0 = u.pn * 256 + wc * 32 + 8 * fq;
#pragma unroll
        for (int ai = 0; ai < 2; ++ai)
#pragma unroll
            for (int m = 0; m < 4; ++m)
#pragma unroll
                for (int bj = 0; bj < 2; ++bj) {
                    const f32x4 v0 = acc[ai][bj][m][0], v1 = acc[ai][bj][m][1];
                    u32x4 w; w.x = cvtpk(v0.x, v0.y); w.y = cvtpk(v0.z, v0.w); w.z = cvtpk(v1.x, v1.y); w.w = cvtpk(v1.z, v1.w);
                    *(u32x4*)(C + (size_t)(row0 + ai * 128 + m * 16) * ldc + col0 + bj * 128) = w;
                }
    }
};

struct EpiGate {
    static constexpr bool PERM = true, AFTER_DRAIN = false;
    float* out; const bf16_t* pw; const float* ssq; const bf16_t* h2b;
    DI void operator()(const f32x4 (&acc)[2][2][4][2], const pg8::Unit& u, int wr, int wc, int fr, int fq) const {
        const int row0 = u.pm * 256 + wr * 64 + fr, col0 = u.pn * 256 + wc * 32 + 8 * fq;
#pragma unroll
        for (int ai = 0; ai < 2; ++ai)
#pragma unroll
            for (int m = 0; m < 4; ++m) {
                const int row = row0 + ai * 128 + m * 16;
                float sq = 0.f;
#pragma unroll
                for (int x = 0; x < 8; ++x) sq += ssq[(size_t)x * T + row];
                const float rs3 = rsqrtf(sq * (1.f / 1024.f) + EPS);
#pragma unroll
                for (int bj = 0; bj < 2; ++bj) {
                    const size_t off = (size_t)row * 1024 + col0 + bj * 128;
                    const bf16x8 pv = *(const bf16x8*)(pw + off);
                    const bf16x8 hb = *(const bf16x8*)(h2b + off);
                    const f32x4 g0 = acc[ai][bj][m][0] * rs3, g1 = acc[ai][bj][m][1] * rs3;
                    f32x4 o0, o1;
#pragma unroll
                    for (int i = 0; i < 4; ++i) { o0[i] = bf2f(hb[i]) + bf2f(pv[i]) / (1.f + __expf(-g0[i])); o1[i] = bf2f(hb[4 + i]) + bf2f(pv[4 + i]) / (1.f + __expf(-g1[i])); }
                    *(f32x4*)(out + off) = o0; *(f32x4*)(out + off + 4) = o1;
                }
            }
    }
};

template <class Epi>
DI void gemm_simple(const bf16_t* A, const bf16_t* Bt, int M, int N, int K, const Epi& epi, int gwave, int nwaves, int lane) {
    const int r32 = lane & 31, hi = lane >> 5;
    const int nNt = N / 64, total = (M / 32) * nNt;
    for (int tile = gwave; tile < total; tile += nwaves) {
        const int mt = tile / nNt, nt = tile - mt * nNt, m0 = mt * 32, n0 = nt * 64;
        const bf16_t* ap = A + (size_t)(m0 + r32) * K + 8 * hi;
        const bf16_t* b0p = Bt + (size_t)(n0 + r32) * K + 8 * hi;
        const bf16_t* b1p = b0p + (size_t)32 * K;
        f32x16 acc0 = zero16(), acc1 = zero16();
#pragma unroll 4
        for (int k = 0; k < K; k += 16) {
            const bf16x8 xa = *(const bf16x8*)(ap + k);
            const bf16x8 w0 = *(const bf16x8*)(b0p + k);
            const bf16x8 w1 = *(const bf16x8*)(b1p + k);
            acc0 = MFMA32(w0, xa, acc0);
            acc1 = MFMA32(w1, xa, acc1);
        }
        epi(m0 + r32, n0, hi, acc0, acc1);
    }
}

struct Epi1 {
    bf16_t* base6;
    const float *qn, *kn;
    DI void operator()(int tok, int n0, int hi, const f32x16& a0, const f32x16& a1) const {
        const int head48 = n0 >> 6, typ = head48 >> 3, h = head48 & 7;
        bf16_t* reg = base6 + (size_t)typ * (16u << 19);
        if (typ == 2 || typ == 5) {
            const int b = tok >> 11, s = tok & 2047;
            const int pos = (s & ~12) | ((s & 4) << 1) | ((s & 8) >> 1);
            bf16_t* base = reg + ((size_t)(b * 8 + h) * 64) * 2048 + pos;
#pragma unroll
            for (int r = 0; r < 16; ++r) { base[(size_t)crow(r, hi) * 2048] = f2bf(a0[r]); base[(size_t)(32 + crow(r, hi)) * 2048] = f2bf(a1[r]); }
        } else {
            float rs = 1.f;
            const bool nrm = (typ == 0 || typ == 1);
            if (nrm) { float ss = 0.f;
#pragma unroll
                for (int r = 0; r < 16; ++r) ss += a0[r] * a0[r] + a1[r] * a1[r];
                ss = sum_x32(ss);
                rs = rsqrtf(ss * (1.f / 64.f) + EPS); }
            const float* g = (typ == 0) ? qn : kn;
            bf16_t* dst = reg + (size_t)tok * 512 + h * 64;
#pragma unroll
            for (int t = 0; t < 2; ++t)
#pragma unroll
                for (int g4 = 0; g4 < 4; ++g4) {
                    const int f0 = 32 * t + 8 * g4 + 4 * hi;
                    float v[4];
#pragma unroll
                    for (int i = 0; i < 4; ++i) { const float a = t ? a1[4 * g4 + i] : a0[4 * g4 + i]; v[i] = nrm ? a * rs * g[f0 + i] : a; }
                    u32x2 w; w.x = cvtpk(v[0], v[1]); w.y = cvtpk(v[2], v[3]);
                    *(u32x2*)(dst + f0) = w;
                }
        }
    }
};

struct Epi2 {
    const float* x; float* out; bf16_t* xn;
    DI void operator()(int tok, int n0, int hi, const f32x16& a0, const f32x16& a1) const {
#pragma unroll
        for (int t = 0; t < 2; ++t)
#pragma unroll
            for (int g4 = 0; g4 < 4; ++g4) {
                const size_t off = (size_t)tok * 1024 + n0 + 32 * t + 8 * g4 + 4 * hi;
                const f32x4 xv = *(const f32x4*)(x + off);
                f32x4 hv;
#pragma unroll
                for (int i = 0; i < 4; ++i) hv[i] = xv[i] + (t ? a1[4 * g4 + i] : a0[4 * g4 + i]);
                *(f32x4*)(out + off) = hv;
                u32x2 w; w.x = cvtpk(hv[0], hv[1]); w.y = cvtpk(hv[2], hv[3]);
                *(u32x2*)(xn + off) = w;
            }
    }
};

struct Epi3 {
    float* sc;
    DI void operator()(int tok, int n0, int hi, const f32x16& a0, const f32x16& a1) const {
#pragma unroll
        for (int t = 0; t < 2; ++t)
#pragma unroll
            for (int g4 = 0; g4 < 4; ++g4) {
                f32x4 v;
#pragma unroll
                for (int i = 0; i < 4; ++i) v[i] = t ? a1[4 * g4 + i] : a0[4 * g4 + i];
                *(f32x4*)(sc + (size_t)tok * 2048 + n0 + 32 * t + 8 * g4 + 4 * hi) = v;
            }
    }
};

DI void pv_accum(f32x16& o0, f32x16& o1, const f32x16& p, const bf16_t* vt_row) {
#pragma unroll
    for (int s = 0; s < 2; ++s) {
        u32x4 pk; pk.x = cvtpk(p[8 * s], p[8 * s + 1]); pk.y = cvtpk(p[8 * s + 2], p[8 * s + 3]); pk.z = cvtpk(p[8 * s + 4], p[8 * s + 5]); pk.w = cvtpk(p[8 * s + 6], p[8 * s + 7]);
        const bf16x8 pb = __builtin_bit_cast(bf16x8, pk);
        const bf16x8 v0 = *(const bf16x8*)(vt_row + 16 * s);
        const bf16x8 v1 = *(const bf16x8*)(vt_row + (size_t)32 * 2048 + 16 * s);
        o0 = MFMA32(v0, pb, o0);
        o1 = MFMA32(v1, pb, o1);
    }
}

DI void store_o(bf16_t* op, const f32x16& o0, const f32x16& o1, float inv, int hi) {
#pragma unroll
    for (int t = 0; t < 2; ++t)
#pragma unroll
        for (int g4 = 0; g4 < 4; ++g4) {
            u32x2 w;
            if (t == 0) { w.x = cvtpk(o0[4 * g4] * inv, o0[4 * g4 + 1] * inv); w.y = cvtpk(o0[4 * g4 + 2] * inv, o0[4 * g4 + 3] * inv); }
            else        { w.x = cvtpk(o1[4 * g4] * inv, o1[4 * g4 + 1] * inv); w.y = cvtpk(o1[4 * g4 + 2] * inv, o1[4 * g4 + 3] * inv); }
            *(u32x2*)(op + 32 * t + 8 * g4 + 4 * hi) = w;
        }
}

constexpr int OT_PITCH = 1040;
DI void store_o_lds(LAS unsigned char* ot, int r32, int h, const f32x16& o0, const f32x16& o1, float inv, int hi) {
    LAS unsigned char* op = ot + r32 * OT_PITCH + h * 128;
#pragma unroll
    for (int t = 0; t < 2; ++t)
#pragma unroll
        for (int g4 = 0; g4 < 4; ++g4) {
            u32x2 w;
            if (t == 0) { w.x = cvtpk(o0[4 * g4] * inv, o0[4 * g4 + 1] * inv); w.y = cvtpk(o0[4 * g4 + 2] * inv, o0[4 * g4 + 3] * inv); }
            else        { w.x = cvtpk(o1[4 * g4] * inv, o1[4 * g4 + 1] * inv); w.y = cvtpk(o1[4 * g4 + 2] * inv, o1[4 * g4 + 3] * inv); }
            *(LAS u32x2*)(op + (32 * t + 8 * g4 + 4 * hi) * 2) = w;
        }
}
DI void load_kfrag(bf16x8 (&kf)[4], const bf16_t* fbase  , int tile) {
    const bf16_t* kp = fbase + (size_t)tile * 2048;
#pragma unroll
    for (int s = 0; s < 4; ++s) kf[s] = *(const bf16x8*)(kp + s * 512);
}
DI void load_vfrag(bf16x8 (&vf)[4], const bf16_t* fbase, int tile) {
    const bf16_t* vp = fbase + (size_t)tile * 2048;
#pragma unroll
    for (int q = 0; q < 4; ++q) vf[q] = *(const bf16x8*)(vp + q * 512);
}
DI void pv_accum2(f32x16& o0, f32x16& o1, const f32x16& p, const bf16x8 (&vf)[4]) {
#pragma unroll
    for (int s = 0; s < 2; ++s) {
        u32x4 pk; pk.x = cvtpk(p[8 * s], p[8 * s + 1]); pk.y = cvtpk(p[8 * s + 2], p[8 * s + 3]); pk.z = cvtpk(p[8 * s + 4], p[8 * s + 5]); pk.w = cvtpk(p[8 * s + 6], p[8 * s + 7]);
        const bf16x8 pb = __builtin_bit_cast(bf16x8, pk);
        o0 = MFMA32(vf[2 * s], pb, o0);
        o1 = MFMA32(vf[2 * s + 1], pb, o1);
    }
}

#define MEM_FENCE() asm volatile("" ::: "memory")
#define PIN1(a) asm volatile("" : "+v"(a) :: "memory")
#define PIN2(a, b) asm volatile("" : "+v"(a), "+v"(b) :: "memory")
DI void vm_drain() { __builtin_amdgcn_s_waitcnt(0x0F70); }
struct KvStream { const bf16_t* kbase; const bf16_t* vbase; };

struct MobaCtx { int q0, tq, blk, hi; unsigned selmask; float bfar; const LAS float* bt; };
DI void moba_tile(bf16x8 (&kf)[4], bf16x8 (&vf)[4], const bf16x8 (&qf)[4], int kt, int next, const KvStream& kv, const MobaCtx& c, float& mrun, float& lsum, f32x16& o0, f32x16& o1) {
    const int n = kt >> 3, key0 = kt * 32;
    f32x16 st = zero16();
#pragma unroll
    for (int s = 0; s < 4; ++s) st = MFMA32(kf[s], qf[s], st);
    PIN1(st); load_kfrag(kf, kv.kbase, next); PIN1(st);
    float x[16];
    if (n != c.blk) {
        const bool selq = (c.selmask >> n) & 1u;
        if ((c.q0 - (key0 + 31)) >= 128) {
            const float addend = selq ? c.bfar : -1e30f;
#pragma unroll
            for (int r = 0; r < 16; ++r) x[r] = st[r] * SCL2 + addend;
        } else {
#pragma unroll
            for (int r = 0; r < 16; ++r) { const int dist = c.tq - (key0 + crow(r, c.hi)); const float v = st[r] * SCL2 + c.bt[dist > 128 ? 128 : dist]; x[r] = selq ? v : -1e30f; }
        }
    } else {
#pragma unroll
        for (int r = 0; r < 16; ++r) { const int dist = c.tq - (key0 + crow(r, c.hi)); const float v = st[r] * SCL2 + c.bt[dist < 0 ? 0 : (dist > 128 ? 128 : dist)]; x[r] = (dist >= 0) ? v : -1e30f; }
    }
    float mx = x[0];
#pragma unroll
    for (int r = 1; r < 16; ++r) mx = fmaxf(mx, x[r]);
    mx = max_x32(mx);
    const float mnew = fmaxf(mrun, mx);
    if (!__all(mnew == mrun)) {
        const float alpha = __builtin_amdgcn_exp2f(mrun - mnew);
        lsum *= alpha;
#pragma unroll
        for (int r = 0; r < 16; ++r) { o0[r] *= alpha; o1[r] *= alpha; }
        mrun = mnew;
    }
    f32x16 pr; float ps = 0.f;
#pragma unroll
    for (int r = 0; r < 16; ++r) { const float e = __builtin_amdgcn_exp2f(x[r] - mrun); pr[r] = e; ps += e; }
    lsum += ps;
    pv_accum2(o0, o1, pr, vf);
    PIN2(o0, o1); load_vfrag(vf, kv.vbase, next); MEM_FENCE();
}
DI int moba_next(int kt, int blk, unsigned anysel) {
    int nkt = kt - 1;
    while (nkt >= 0) { const int nn = nkt >> 3; if (nn == blk || ((anysel >> nn) & 1u)) break; nkt = nn * 8 - 1; }
    return nkt;
}

DI void moba_unit(int b, int h, int qt, const bf16_t* Qm_, const bf16_t* Km_, const bf16_t* VtM_, const float* kmean_, const LAS float* biasLds, LAS unsigned char* ot, int lane) {
    const int r32 = lane & 31, hi = lane >> 5;
    const int q0 = qt * 32, tq = q0 + r32, blk = q0 >> 8;
    const size_t bh = (size_t)(b * 8 + h);
    const bf16_t* qfb = Qm_ + bh * (64 * 2048) + (size_t)qt * 2048;
    KvStream kv; kv.kbase = Km_ + bh * (64 * 2048) + lane * 8; kv.vbase = VtM_ + bh * (64 * 2048) + lane * 8;
    bf16x8 kf[4], vf[4];
    load_kfrag(kf, kv.kbase, qt); load_vfrag(vf, kv.vbase, qt);
    bf16x8 qf[4];
#pragma unroll
    for (int s = 0; s < 4; ++s) qf[s] = *(const bf16x8*)(qfb + s * 512 + lane * 8);
    unsigned selmask = 0;
    if (blk > 0) {
        float qv[32];
#pragma unroll
        for (int c = 0; c < 4; ++c) { const bf16x8 t = *(const bf16x8*)(qfb + (2 * hi + (c >> 1)) * 512 + ((c & 1) * 32 + r32) * 8);
#pragma unroll
            for (int j = 0; j < 8; ++j) qv[8 * c + j] = bf2f(t[j]); }
        const float* km = kmean_ + (size_t)((b * 8 + h) * 8) * 64 + 32 * hi;
        float g[8];
#pragma unroll
        for (int n = 0; n < 8; ++n) {
            float a = 0.f;
            if (n < blk) {
#pragma unroll
                for (int d4 = 0; d4 < 8; ++d4) { const f32x4 kv4 = *(const f32x4*)(km + n * 64 + 4 * d4); a += (qv[4 * d4] * kv4.x + qv[4 * d4 + 1] * kv4.y) + (qv[4 * d4 + 2] * kv4.z + qv[4 * d4 + 3] * kv4.w); }
            }
            a = sum_x32(a);
            g[n] = (n < blk) ? a : -INFINITY;
        }
#pragma unroll
        for (int n = 0; n < 8; ++n) {
            int rank = 0;
#pragma unroll
            for (int m = 0; m < 8; ++m) if (m != n) rank += ((g[m] > g[n]) || (g[m] == g[n] && m < n)) ? 1 : 0;
            if (n < blk && rank < 3) selmask |= 1u << n;
        }
    }
    unsigned anysel = 0;
#pragma unroll
    for (int n = 0; n < 8; ++n) if (__any((selmask >> n) & 1u)) anysel |= 1u << n;
    anysel = __builtin_amdgcn_readfirstlane(anysel);
    float mrun = -1e30f, lsum = 0.f;
    f32x16 o0 = zero16(), o1 = zero16();
    MobaCtx c; c.q0 = q0; c.tq = tq; c.blk = blk; c.hi = hi; c.selmask = selmask; c.bt = biasLds + h * 132; c.bfar = c.bt[128];
    vm_drain();
    int kt = qt;
    for (;;) {
        const int nx = moba_next(kt, blk, anysel);
        moba_tile(kf, vf, qf, kt, nx < 0 ? 0 : nx, kv, c, mrun, lsum, o0, o1);
        if (nx < 0) break;
        kt = nx;
    }
    lsum = sum_x32(lsum);
    const float inv = 1.f / lsum;
    store_o_lds(ot, r32, h, o0, o1, inv, hi);
}

DI void sb_tile(bf16x8 (&kf)[4], bf16x8 (&vf)[4], const bf16x8 (&qf)[4], int kt, int next, const KvStream& kv, int tq, int hi, float& C, f32x16& o0, f32x16& o1) {
    const int key0 = kt * 32;
    f32x16 st = zero16();
#pragma unroll
    for (int s = 0; s < 4; ++s) st = MFMA32(kf[s], qf[s], st);
    PIN1(st); load_kfrag(kf, kv.kbase, next); PIN1(st);
    float rr[16], be[16];
#pragma unroll
    for (int r = 0; r < 16; ++r) {
        const int key = key0 + crow(r, hi);
        const float y = fminf(st[r] * SCL2, 100.f);
        const float e = __builtin_amdgcn_exp2f(y);
        const float ri = __builtin_amdgcn_rcpf(1.f + e);
        const bool ok = key < tq;
        rr[r] = ok ? ri : 1.f;
        be[r] = ok ? e * ri : 0.f;
    }
    float G[4], ex[16], Gp[4], Tt[4], Suf[4];
#pragma unroll
    for (int a = 0; a < 4; ++a) {
        ex[4 * a + 3] = 1.f; ex[4 * a + 2] = rr[4 * a + 3]; ex[4 * a + 1] = ex[4 * a + 2] * rr[4 * a + 2]; ex[4 * a] = ex[4 * a + 1] * rr[4 * a + 1];
        G[a] = ex[4 * a] * rr[4 * a];
    }
#pragma unroll
    for (int a = 0; a < 4; ++a) { float lo_, hi_; swap32(G[a], lo_, hi_); Gp[a] = hi_; Tt[a] = lo_ * hi_; }
    Suf[3] = 1.f; Suf[2] = Tt[3]; Suf[1] = Tt[3] * Tt[2]; Suf[0] = Suf[1] * Tt[1];
    f32x16 pr;
#pragma unroll
    for (int a = 0; a < 4; ++a) {
        const float after = Suf[a] * (hi == 0 ? Gp[a] : 1.f) * C;
#pragma unroll
        for (int i = 0; i < 4; ++i) pr[4 * a + i] = be[4 * a + i] * ex[4 * a + i] * after;
    }
    C = C * (Suf[0] * Tt[0]);
    pv_accum2(o0, o1, pr, vf);
    PIN2(o0, o1); load_vfrag(vf, kv.vbase, next); MEM_FENCE();
}

DI void sb_unit(int b, int h, int qt, const bf16_t* Qs_, const bf16_t* Ks_, const bf16_t* VtS_, LAS unsigned char* ot, int lane) {
    const int r32 = lane & 31, hi = lane >> 5;
    const int q0 = qt * 32, tq = q0 + r32;
    const size_t bh = (size_t)(b * 8 + h);
    const bf16_t* qfb = Qs_ + bh * (64 * 2048) + (size_t)qt * 2048;
    KvStream kv; kv.kbase = Ks_ + bh * (64 * 2048) + lane * 8; kv.vbase = VtS_ + bh * (64 * 2048) + lane * 8;
    bf16x8 kf[4], vf[4];
    load_kfrag(kf, kv.kbase, qt); load_vfrag(vf, kv.vbase, qt);
    bf16x8 qf[4];
#pragma unroll
    for (int s = 0; s < 4; ++s) qf[s] = *(const bf16x8*)(qfb + s * 512 + lane * 8);
    f32x16 o0 = zero16(), o1 = zero16();
    float C = 1.f;
    vm_drain();
    for (int kt = qt; kt >= 0; --kt) {
        sb_tile(kf, vf, qf, kt, kt > 0 ? kt - 1 : 0, kv, tq, hi, C, o0, o1);
        if (__all(C == 0.f ? 1 : 0)) break;
    }
    store_o_lds(ot, r32, h, o0, o1, 1.f, hi);
}

DI void ce_desc(unsigned& a, unsigned& b) { const unsigned hi = a > b ? a : b, lo = a > b ? b : a; a = hi; b = lo; }
DI void bitonic_clean_desc(unsigned (&v)[16]) {
#pragma unroll
    for (int s = 8; s >= 1; s >>= 1)
#pragma unroll
        for (int i = 0; i < 16; ++i) if ((i & s) == 0) ce_desc(v[i], v[i + s]);
}
DI void sort16_desc(unsigned (&v)[16]) {
#pragma unroll
    for (int k = 2; k <= 16; k <<= 1)
#pragma unroll
        for (int j = k >> 1; j >= 1; j >>= 1)
#pragma unroll
            for (int i = 0; i < 16; ++i) { const int l = i ^ j; if (l > i) { if ((i & k) == 0) ce_desc(v[i], v[l]); else ce_desc(v[l], v[i]); } }
}
DI float key_value(unsigned key) { const unsigned kk = key & ~127u; const unsigned u = (kk & 0x80000000u) ? (kk & 0x7fffffffu) : ~kk; return __builtin_bit_cast(float, u); }
DI float key_value8(unsigned key) { const unsigned kk = key & ~255u; const unsigned u = (kk & 0x80000000u) ? (kk & 0x7fffffffu) : ~kk; return __builtin_bit_cast(float, u); }
template <int CTRL> DI unsigned dppu(unsigned v) { return (unsigned)__builtin_amdgcn_update_dpp(0, (int)v, CTRL, 0xF, 0xF, true); }
DI void sort8_desc(unsigned (&v)[8]) {
    ce_desc(v[0], v[2]); ce_desc(v[1], v[3]); ce_desc(v[4], v[6]); ce_desc(v[5], v[7]);
    ce_desc(v[0], v[4]); ce_desc(v[1], v[5]); ce_desc(v[2], v[6]); ce_desc(v[3], v[7]);
    ce_desc(v[0], v[1]); ce_desc(v[2], v[3]); ce_desc(v[4], v[5]); ce_desc(v[6], v[7]);
    ce_desc(v[2], v[4]); ce_desc(v[3], v[5]);
    ce_desc(v[1], v[4]); ce_desc(v[3], v[6]);
    ce_desc(v[1], v[2]); ce_desc(v[3], v[4]); ce_desc(v[5], v[6]);
}
DI void clean8_desc(unsigned (&v)[8]) {
#pragma unroll
    for (int s = 4; s >= 1; s >>= 1)
#pragma unroll
        for (int i = 0; i < 8; ++i) if ((i & s) == 0) ce_desc(v[i], v[i + s]);
}
template <int CTRL> DI void cross_rev_max(unsigned (&v)[8]) {
    unsigned t[8];
#pragma unroll
    for (int i = 0; i < 8; ++i) t[i] = dppu<CTRL>(v[7 - i]);
#pragma unroll
    for (int i = 0; i < 8; ++i) v[i] = v[i] > t[i] ? v[i] : t[i];
}
template <bool REV> DI void cross_minmax_x1(unsigned (&v)[8], bool odd) {
    unsigned t[8];
#pragma unroll
    for (int i = 0; i < 8; ++i) t[i] = dppu<DPP_XOR1>(v[REV ? 7 - i : i]);
#pragma unroll
    for (int i = 0; i < 8; ++i) { const unsigned hi = v[i] > t[i] ? v[i] : t[i], lo = v[i] > t[i] ? t[i] : v[i]; v[i] = odd ? lo : hi; }
}

DI float reduce16(const float (&p)[16], int lane) {
    const bool b3 = lane & 8, b2 = lane & 4, b1 = lane & 2, b0 = lane & 1;
    float q[8], r[4], s[2];
#pragma unroll
    for (int i = 0; i < 8; ++i) { const float mine = b3 ? p[i + 8] : p[i], send = b3 ? p[i] : p[i + 8]; q[i] = mine + __shfl_xor(send, 8); }
#pragma unroll
    for (int i = 0; i < 4; ++i) { const float mine = b2 ? q[i + 4] : q[i], send = b2 ? q[i] : q[i + 4]; r[i] = mine + __shfl_xor(send, 4); }
#pragma unroll
    for (int i = 0; i < 2; ++i) { const float mine = b1 ? r[i + 2] : r[i], send = b1 ? r[i] : r[i + 2]; s[i] = mine + __shfl_xor(send, 2); }
    const float mine = b0 ? s[1] : s[0], send = b0 ? s[0] : s[1];
    float t = mine + __shfl_xor(send, 1);
    t = sum_x32(sum_x16(t));
    return t;
}

#ifndef PEER_REP_TOPK
#define PEER_REP_TOPK 1
#endif
#ifndef PEER_REP_U
#define PEER_REP_U 1
#endif
#ifndef PEER_REP_V
#define PEER_REP_V 1
#endif
struct TopkIn { bf16x8 hv[2]; bf16x8 sv[4]; };
DI void peer_topk_load(TopkIn& in, int tok, const bf16_t* h1b, const bf16_t* scores, int lane) {
    const int tc = tok < T ? tok : T - 1;
    const bf16_t* hrow = h1b + (size_t)tc * 1024 + 16 * lane;
    const bf16_t* sp = scores + (size_t)tc * 2048 + (lane >> 2) * 128 + (lane & 3) * 8;
#pragma unroll
    for (int i = 0; i < 4; ++i) in.sv[i] = *(const bf16x8*)(sp + 32 * i);
    in.hv[0] = *(const bf16x8*)hrow; in.hv[1] = *(const bf16x8*)(hrow + 8);
}
DI void peer_topk_token(int tok, const TopkIn& in, const float* gffn, int* EIDXg, float* GATEg, unsigned char* XN2g, LAS float* wl, int lane) {
    LAS unsigned* kbuf = (LAS unsigned*)wl; const LAS unsigned* ctab = (const LAS unsigned*)(wl + 768);
    f32x4 hv[4];
    float ss = 0.f;
#pragma unroll
    for (int i = 0; i < 4; ++i) { const bf16x8 hb = in.hv[i >> 1]; const int o4 = 4 * (i & 1); hv[i] = (f32x4){bf2f(hb[o4]), bf2f(hb[o4 + 1]), bf2f(hb[o4 + 2]), bf2f(hb[o4 + 3])}; ss += (hv[i].x * hv[i].x + hv[i].y * hv[i].y) + (hv[i].z * hv[i].z + hv[i].w * hv[i].w); }
    ss = wave_sum(ss);
    const float rs2 = rsqrtf(ss * (1.f / 1024.f) + EPS);
    {
        u32x4 w;
#pragma unroll
        for (int i = 0; i < 4; ++i) { const f32x4 gv = *(const f32x4*)(gffn + 16 * lane + 4 * i);
            const float y0 = fminf(fmaxf(hv[i][0] * rs2 * gv[0] * 64.f, -448.f), 448.f), y1 = fminf(fmaxf(hv[i][1] * rs2 * gv[1] * 64.f, -448.f), 448.f);
            const float y2 = fminf(fmaxf(hv[i][2] * rs2 * gv[2] * 64.f, -448.f), 448.f), y3 = fminf(fmaxf(hv[i][3] * rs2 * gv[3] * 64.f, -448.f), 448.f);
            int p = 0;
            p = __builtin_amdgcn_cvt_pk_fp8_f32(y0, y1, p, false);
            p = __builtin_amdgcn_cvt_pk_fp8_f32(y2, y3, p, true);
            w[i] = (unsigned)p; }
        *(u32x4*)(XN2g + (size_t)tok * 1024 + 16 * lane) = w;
    }
    {
        const int L = lane >> 2, q = lane & 3;
        unsigned k0[16], k1[16];
#pragma unroll
        for (int i = 0; i < 4; ++i) {
            const bf16x8 v = in.sv[i];
#pragma unroll
            for (int cI = 0; cI < 8; ++cI) {
                const unsigned u = ((unsigned)(unsigned short)v[cI]) << 16;
                const unsigned mono = (u & 0x80000000u) ? ~u : (u | 0x80000000u);
                const unsigned key = (mono & ~127u) | (unsigned)(127 - (32 * i + 8 * q + cI));
                if (i < 2) k0[8 * i + cI] = key; else k1[8 * (i - 2) + cI] = key;
            }
        }
        sort16_desc(k0); sort16_desc(k1);
        unsigned t[16];
#pragma unroll
        for (int i = 0; i < 16; ++i) t[i] = k0[i] > k1[15 - i] ? k0[i] : k1[15 - i];
        bitonic_clean_desc(t);
#pragma unroll
        for (int i = 0; i < 16; ++i) k0[i] = (unsigned)__builtin_amdgcn_update_dpp(0, (int)t[15 - i], 0xB1, 0xF, 0xF, true);
#pragma unroll
        for (int i = 0; i < 16; ++i) t[i] = t[i] > k0[i] ? t[i] : k0[i];
        bitonic_clean_desc(t);
#pragma unroll
        for (int i = 0; i < 16; ++i) k0[i] = (unsigned)__builtin_amdgcn_update_dpp(0, (int)t[15 - i], 0x4E, 0xF, 0xF, true);
#pragma unroll
        for (int i = 0; i < 16; ++i) t[i] = t[i] > k0[i] ? t[i] : k0[i];
        bitonic_clean_desc(t);
        if (q == 0) {
#pragma unroll
            for (int i = 0; i < 4; ++i) { u32x4 w; w.x = t[4 * i]; w.y = t[4 * i + 1]; w.z = t[4 * i + 2]; w.w = t[4 * i + 3]; *(LAS u32x4*)(kbuf + L * 16 + 4 * i) = w; }
        }
        asm volatile("s_waitcnt lgkmcnt(0)" ::: "memory");
    }
    {
        const int hd = lane >> 3, sub = lane & 7; const bool odd = sub & 1;
        unsigned ck[8];
#pragma unroll
        for (int k = 0; k < 7; ++k) {
            const int cidx = 7 * sub + k;
            const unsigned tab = ctab[cidx];
            const unsigned ia = tab & 15u, ib = (tab >> 8) & 15u;
            const unsigned ka = kbuf[hd * 32 + ia], kb = kbuf[hd * 32 + 16 + ib];
            const float v = key_value(ka) + key_value(kb);
            const unsigned u = __float_as_uint(v);
            const unsigned mono = (u & 0x80000000u) ? ~u : (u | 0x80000000u);
            ck[k] = (cidx < 50) ? ((mono & ~255u) | (255u - (16u * ia + ib))) : 0u;
        }
        ck[7] = 0u;
        sort8_desc(ck);
        cross_minmax_x1<true>(ck, odd); clean8_desc(ck);
        cross_rev_max<0x1B>(ck); cross_minmax_x1<false>(ck, odd); clean8_desc(ck);
        cross_rev_max<DPP_HMIR>(ck); cross_minmax_x1<false>(ck, odd); clean8_desc(ck);
        const int pr = sub >> 1;
        const unsigned e0 = pr == 0 ? ck[0] : pr == 1 ? ck[2] : pr == 2 ? ck[4] : ck[6];
        const unsigned e1 = pr == 0 ? ck[1] : pr == 1 ? ck[3] : pr == 2 ? ck[5] : ck[7];
        const unsigned id0 = 255u - (e0 & 255u), id1 = 255u - (e1 & 255u);
        const unsigned ka0 = kbuf[hd * 32 + (id0 >> 4)], kb0 = kbuf[hd * 32 + 16 + (id0 & 15u)];
        const unsigned ka1 = kbuf[hd * 32 + (id1 >> 4)], kb1 = kbuf[hd * 32 + 16 + (id1 & 15u)];
        const float v0 = key_value8(e0), v1 = key_value8(e1);
        const float mx = max_oct(fmaxf(v0, v1));
        const float ev0 = __expf((v0 - mx) * rs2), ev1 = __expf((v1 - mx) * rs2);
        const float inv = 1.f / sum_oct(ev0 + ev1);
        const int rank0 = (odd ? 8 : 0) + 2 * pr;
        u32x2 ew; ew.x = (127u - (ka0 & 127u)) * 128u + (127u - (kb0 & 127u)); ew.y = (127u - (ka1 & 127u)) * 128u + (127u - (kb1 & 127u));
        f32x2 gw; gw.x = ev0 * inv; gw.y = ev1 * inv;
        *(u32x2*)(EIDXg + (size_t)tok * 128 + hd * 16 + rank0) = ew;
        *(f32x2*)(GATEg + (size_t)tok * 128 + hd * 16 + rank0) = gw;
    }
}

DI float dot16_fp8(const u32x4& row, const float (&x)[16]) {
    float sacc = 0.f;
#pragma unroll
    for (int w = 0; w < 4; ++w) { const f32x2 lo = __builtin_amdgcn_cvt_pk_f32_fp8((int)row[w], false), hi2 = __builtin_amdgcn_cvt_pk_f32_fp8((int)row[w], true);
        sacc += lo.x * x[4 * w] + lo.y * x[4 * w + 1] + hi2.x * x[4 * w + 2] + hi2.y * x[4 * w + 3]; }
    return sacc;
}
template <class TT> DI TT ldu(const void* ubase, unsigned off) { return *(const TT*)((const char*)ubase + off); }
typedef _Float16 h2_t __attribute__((ext_vector_type(2)));
DI void peer_u_slice(int sl, int tk_first, int tk_step, const unsigned char* XN8g, const int* EIDXg, const unsigned char* U8s, bf16_t* PDOT, int lane) {
    const int es = lane >> 3, c = lane & 7;
    const unsigned char* tb = U8s + (size_t)sl * 16384 * 128;
    const unsigned c16 = 16u * c, eoff = 64u * es, xoff = 128u * sl + 16u * c, poff = (16u * es + c) * 2u;
    const bool b2 = c & 4, b1 = c & 2, b0 = c & 1;
    u32x4 I0[2], I1[2], I2[2], rowsA[8], rowsB[8], rowsC[8], x0, x1, x2;
#define LD_E8(ib, tk, h) do { const int _t = (tk) < T ? (tk) : T - 1; const int* _eb = EIDXg + (size_t)_t * 128 + 8 * (h); ib[0] = ldu<u32x4>(_eb, eoff); ib[1] = ldu<u32x4>(_eb, eoff + 16u); } while (0)
#define LD_R8(rows, ib, tbl) do { _Pragma("unroll") for (int _q = 0; _q < 2; ++_q) _Pragma("unroll") for (int _r = 0; _r < 4; ++_r) rows[4 * _q + _r] = ldu<u32x4>(tbl, ib[_q][_r] * 128u + c16); } while (0)
#define LD_X(xx, tk) do { const int _t = (tk) < T ? (tk) : T - 1; xx = ldu<u32x4>(XN8g + (size_t)_t * 1024, xoff); } while (0)
#define U_COMPUTE8(rows, xx, tk, h) do { h2_t _x[8]; _Pragma("unroll") for (int _w = 0; _w < 4; ++_w) { _x[2 * _w] = __builtin_amdgcn_cvt_scalef32_pk_f16_fp8(xx[_w], 1.0f, false); _x[2 * _w + 1] = __builtin_amdgcn_cvt_scalef32_pk_f16_fp8(xx[_w], 1.0f, true); } \
        float _p[8]; _Pragma("unroll") for (int _i = 0; _i < 8; ++_i) { if (_i > 0) asm volatile("" : "+v"(rows[_i]) : "v"(_p[_i - 1])); float _s = 0.f; \
            _Pragma("unroll") for (int _w = 0; _w < 4; ++_w) { _s = __builtin_amdgcn_fdot2(__builtin_amdgcn_cvt_scalef32_pk_f16_fp8(rows[_i][_w], 1.0f, false), _x[2 * _w], _s, false); \
                _s = __builtin_amdgcn_fdot2(__builtin_amdgcn_cvt_scalef32_pk_f16_fp8(rows[_i][_w], 1.0f, true), _x[2 * _w + 1], _s, false); } _p[_i] = _s; } \
        float _q4[4], _q2[2]; \
        _Pragma("unroll") for (int _k = 0; _k < 4; ++_k) _q4[_k] = tr_x4(_p[_k], _p[_k + 4], b2); \
        _Pragma("unroll") for (int _k = 0; _k < 2; ++_k) _q2[_k] = tr_x2(_q4[_k], _q4[_k + 2], b1); \
        const float _r1 = tr_x1(_q2[0], _q2[1], b0); \
        if ((tk) < T) { bf16_t* _pb = PDOT + ((size_t)sl * T + (tk)) * 128 + 8 * (h); *(bf16_t*)((char*)_pb + poff) = f2bf(_r1); } } while (0)
    int t0 = tk_first;
    LD_E8(I0, t0, 0); LD_E8(I1, t0, 1); LD_E8(I2, t0 + tk_step, 0); LD_X(x0, t0); LD_R8(rowsA, I0, tb); LD_R8(rowsB, I1, tb);
#pragma unroll 1
    for (; t0 < T; t0 += 3 * tk_step) {
        const int t1 = t0 + tk_step, t2 = t1 + tk_step, t3 = t2 + tk_step;
        LD_E8(I0, t1, 1);           LD_R8(rowsC, I2, tb); LD_X(x1, t1); U_COMPUTE8(rowsA, x0, t0, 0);
        LD_E8(I1, t2, 0);           LD_R8(rowsA, I0, tb);               U_COMPUTE8(rowsB, x0, t0, 1);
        LD_E8(I2, t2, 1);           LD_R8(rowsB, I1, tb); LD_X(x2, t2); U_COMPUTE8(rowsC, x1, t1, 0);
        LD_E8(I0, t3, 0);           LD_R8(rowsC, I2, tb);               U_COMPUTE8(rowsA, x1, t1, 1);
        LD_E8(I1, t3, 1);           LD_R8(rowsA, I0, tb); LD_X(x0, t3); U_COMPUTE8(rowsB, x2, t2, 0);
        LD_E8(I2, t3 + tk_step, 0); LD_R8(rowsB, I1, tb);               U_COMPUTE8(rowsC, x2, t2, 1);
    }
#undef U_COMPUTE8
#undef LD_X
}
template <int NT> DI void peer_cj_tokens(int tok0, int tstride, const int* EIDXg, const float* GATEg, const bf16_t* PDOT, const float* usc, const float* vsc, float* CJg, float* CMAXg, int lane) {
    int e[NT][2]; float d[NT][2], g[NT][2];
#pragma unroll
    for (int i = 0; i < NT; ++i) { const int tok = tok0 + i * tstride, tc = tok < T ? tok : T - 1;
#pragma unroll
        for (int hh = 0; hh < 2; ++hh) { const int j = lane + 64 * hh; e[i][hh] = EIDXg[(size_t)tc * 128 + j]; g[i][hh] = GATEg[(size_t)tc * 128 + j]; float a = 0.f;
#pragma unroll
            for (int x = 0; x < 8; ++x) a += bf2f((short)PDOT[((size_t)x * T + tc) * 128 + j]);
            d[i][hh] = a; } }
    float us[NT][2], vs[NT][2];
#pragma unroll
    for (int i = 0; i < NT; ++i)
#pragma unroll
        for (int hh = 0; hh < 2; ++hh) { us[i][hh] = usc[e[i][hh]]; vs[i][hh] = vsc[e[i][hh]]; }
#pragma unroll
    for (int i = 0; i < NT; ++i) { const int tok = tok0 + i * tstride;
        float cv[2], cm = 0.f;
#pragma unroll
        for (int hh = 0; hh < 2; ++hh) {
            const float hraw = d[i][hh] * us[i][hh] * (1.f / 64.f);
            const float hid = 0.5f * hraw * (1.f + erff(hraw * 0.70710678118654752f));
            cv[hh] = hid * g[i][hh] * vs[i][hh];
            cm = fmaxf(cm, fabsf(cv[hh]));
        }
        cm = wave_max(cm);
        const float inv = cm > 0.f ? 1.f / cm : 0.f;
        if (tok < T) { CJg[(size_t)tok * 128 + lane] = cv[0] * inv; CJg[(size_t)tok * 128 + 64 + lane] = cv[1] * inv; if (lane == 0) CMAXg[tok] = cm; }
    }
}
DI void peer_v_slice(int sl, int tk_first, int tk_step, const bf16_t* H1b, const int* EIDXg, const float* CJg, const float* CMAXg, const unsigned char* V8s, bf16_t* A4g, float* SSQg, int lane) {
    const int es = lane >> 3, c = lane & 7;
    const unsigned char* tb = V8s + (size_t)sl * 16384 * 128;
    const unsigned c16 = 16u * c, eoff = 64u * es, ob = 128u * sl + 16u * c + 2u * es;
    const bool b5 = lane & 32, b4 = lane & 16, b3 = lane & 8;
    u32x4 I0[2], I1[2], I2[2], rowsA[8], rowsB[8], rowsC[8]; f32x4 cA[2], cB[2], cC[2]; unsigned h0, h1, h2;
#define LD_C8(cc, tk, h) do { const int _t = (tk) < T ? (tk) : T - 1; const float* _cb = CJg + (size_t)_t * 128 + 8 * (h); cc[0] = ldu<f32x4>(_cb, eoff); cc[1] = ldu<f32x4>(_cb, eoff + 16u); } while (0)
#define V_AXPY8(rows, cc) do { _Pragma("unroll") for (int _q = 0; _q < 2; ++_q) _Pragma("unroll") for (int _r = 0; _r < 4; ++_r) { const _Float16 _ch = (_Float16)cc[_q][_r]; const h2_t _c2 = {_ch, _ch}; \
            _Pragma("unroll") for (int _w = 0; _w < 4; ++_w) { acch[2 * _w] = __builtin_amdgcn_cvt_scalef32_pk_f16_fp8(rows[4 * _q + _r][_w], 1.0f, false) * _c2 + acch[2 * _w]; \
                acch[2 * _w + 1] = __builtin_amdgcn_cvt_scalef32_pk_f16_fp8(rows[4 * _q + _r][_w], 1.0f, true) * _c2 + acch[2 * _w + 1]; } \
              \
            if (4 * _q + _r < 7) asm volatile("" : "+v"(acch[0]), "+v"(acch[1]), "+v"(acch[2]), "+v"(acch[3]), "+v"(acch[4]), "+v"(acch[5]), "+v"(acch[6]), "+v"(acch[7]), "+v"(rows[(4 * _q + _r + 1) & 7])); \
            else asm volatile("" : "+v"(acch[0]), "+v"(acch[1]), "+v"(acch[2]), "+v"(acch[3]), "+v"(acch[4]), "+v"(acch[5]), "+v"(acch[6]), "+v"(acch[7])); } } while (0)
#define LD_H(hh, tk) do { const int _t = (tk) < T ? (tk) : T - 1; hh = ldu<unsigned>(H1b + (size_t)_t * 1024, ob * 2u); } while (0)
#define V_ZERO() do { _Pragma("unroll") for (int _i = 0; _i < 8; ++_i) acch[_i] = (h2_t){(_Float16)0.f, (_Float16)0.f}; } while (0)
#define V_FINAL(hh, tk) do { float _a[16]; _Pragma("unroll") for (int _i = 0; _i < 8; ++_i) { _a[2 * _i] = (float)acch[_i].x; _a[2 * _i + 1] = (float)acch[_i].y; } \
        const float _cm = CMAXg[(tk) < T ? (tk) : T - 1]; \
        float _q8[8], _q4[4], _q2[2]; \
        _Pragma("unroll") for (int _k = 0; _k < 8; ++_k) _q8[_k] = tr_x32(_a[_k], _a[_k + 8]); \
        _Pragma("unroll") for (int _k = 0; _k < 4; ++_k) _q4[_k] = tr_x16(_q8[_k], _q8[_k + 4]); \
        _Pragma("unroll") for (int _k = 0; _k < 2; ++_k) _q2[_k] = tr_x8(_q4[_k], _q4[_k + 2], b3); \
        const float _ha = __builtin_bit_cast(float, hh << 16) + _q2[0] * _cm, _hb = __builtin_bit_cast(float, hh & 0xffff0000u) + _q2[1] * _cm; const float _ssq = wave_sum(_ha * _ha + _hb * _hb); \
        if ((tk) < T) { *(unsigned*)((char*)(A4g + (size_t)(tk) * 1024) + ob * 2u) = cvtpk(_ha, _hb); \
            if (lane == 0) SSQg[(size_t)sl * T + (tk)] = _ssq; } } while (0)
    h2_t acch[8];
    int t0 = tk_first;
    LD_E8(I0, t0, 0); LD_E8(I1, t0, 1); LD_E8(I2, t0 + tk_step, 0); LD_H(h0, t0); LD_R8(rowsA, I0, tb); LD_C8(cA, t0, 0); LD_R8(rowsB, I1, tb); LD_C8(cB, t0, 1);
#pragma unroll 1
    for (; t0 < T; t0 += 3 * tk_step) {
        const int t1 = t0 + tk_step, t2 = t1 + tk_step, t3 = t2 + tk_step;
        LD_E8(I0, t1, 1);           LD_R8(rowsC, I2, tb); LD_C8(cC, t1, 0); LD_H(h1, t1); V_ZERO(); V_AXPY8(rowsA, cA);
        LD_E8(I1, t2, 0);           LD_R8(rowsA, I0, tb); LD_C8(cA, t1, 1);                          V_AXPY8(rowsB, cB); V_FINAL(h0, t0);
        LD_E8(I2, t2, 1);           LD_R8(rowsB, I1, tb); LD_C8(cB, t2, 0); LD_H(h2, t2); V_ZERO(); V_AXPY8(rowsC, cC);
        LD_E8(I0, t3, 0);           LD_R8(rowsC, I2, tb); LD_C8(cC, t2, 1);                          V_AXPY8(rowsA, cA); V_FINAL(h1, t1);
        LD_E8(I1, t3, 1);           LD_R8(rowsA, I0, tb); LD_C8(cA, t3, 0); LD_H(h0, t3); V_ZERO(); V_AXPY8(rowsB, cB);
        LD_E8(I2, t3 + tk_step, 0); LD_R8(rowsB, I1, tb); LD_C8(cB, t3, 1);                          V_AXPY8(rowsC, cC); V_FINAL(h2, t2);
    }
#undef V_FINAL
#undef V_ZERO
#undef LD_H
#undef V_AXPY8
#undef LD_C8
#undef LD_R8
#undef LD_E8
}

typedef const __attribute__((address_space(4))) unsigned long long* karg_ptr_t;
DI karg_ptr_t kargs() { karg_ptr_t p = (karg_ptr_t)__builtin_amdgcn_kernarg_segment_ptr(); asm volatile("" : "+s"(p)); return p; }
#define GAS1 __attribute__((address_space(1)))
#define KIN(k) ((const float*)(const GAS1 float*)kargs()[k])
#define KOUT() ((float*)(GAS1 float*)kargs()[18])
#define KWS() ((unsigned char*)(GAS1 unsigned char*)kargs()[19])

__global__ void __launch_bounds__(512, 2) fwd_kernel(Params P) {
    extern __shared__ __attribute__((aligned(16))) unsigned char lds_raw[];
    LAS unsigned char* lds = (LAS unsigned char*)lds_raw;
    const int tid = threadIdx.x, lane = tid & 63, wid = __builtin_amdgcn_readfirstlane(tid >> 6);
    const int wg = blockIdx.x, nwg = gridDim.x;
    const int gwave = wg * 8 + wid, nwaves = nwg * 8;
    const int lo = P.ph_lo, hi = P.ph_hi;

    volatile LAS unsigned* misc = (volatile LAS unsigned*)(lds + LDS_BYTES - 64);
    if (tid < 16) misc[tid] = 0u;
    __syncthreads();
    { unsigned* xcw = (unsigned*)(KWS() + WS_CTL) + CW_XC;
      if (tid == 0) { const unsigned xcc = xb_xcc_id(); misc[5] = xcc; misc[4] = xb_add(xcw + 64 * xcc, 1u); } }
    XcdBarrier bar; bar.bar = (unsigned*)(KWS() + WS_CTL) + CW_BAR; bar.x = 0; bar.st = misc;
    if (hi - lo > 1) bar = xcd_barrier_post((unsigned*)(KWS() + WS_CTL) + CW_BAR, misc);

#define kmean   ((float*)(KWS() + WS_KMEAN))
#define biasTab ((float*)(KWS() + WS_BIAS))
#define WinT    ((bf16_t*)(KWS() + WS_WIN))
#define WoutT   ((bf16_t*)(KWS() + WS_WOUT))
#define WqT     ((bf16_t*)(KWS() + WS_WQ))
#define WgT     ((bf16_t*)(KWS() + WS_WG))
#define WpleT   ((bf16_t*)(KWS() + WS_WPLE))
#define U8      ((unsigned char*)(KWS() + WS_U))
#define V8      ((unsigned char*)(KWS() + WS_V))
#define USC     ((float*)(KWS() + WS_USC))
#define VSC     ((float*)(KWS() + WS_VSC))
#define XN      ((bf16_t*)(KWS() + WS_XN))
#define PB      ((bf16_t*)(KWS() + WS_PB))
#define Qm      ((bf16_t*)(KWS() + WS_QM))
#define Km      ((bf16_t*)(KWS() + WS_KM))
#define VtM     ((bf16_t*)(KWS() + WS_VTM))
#define Qs      ((bf16_t*)(KWS() + WS_QS))
#define Ks      ((bf16_t*)(KWS() + WS_KS))
#define VtS     ((bf16_t*)(KWS() + WS_VTS))
#define Oraw    ((bf16_t*)(KWS() + WS_ORAW))
#define A2      ((bf16_t*)(KWS() + WS_A2))
#define A3      ((bf16_t*)(KWS() + WS_A3))
#define SC      ((float*)(KWS() + WS_SC))
#define EIDXG   ((int*)(KWS() + WS_EIDX))
#define GATEG   ((float*)(KWS() + WS_GATE))
#define CJG     ((float*)(KWS() + WS_CJ))
#define RS2G    ((float*)(KWS() + WS_RS2))
#define SSQG    ((float*)(KWS() + WS_SSQ))
#define PDOTG   ((bf16_t*)(KWS() + WS_PDOT))
#define A4G     ((bf16_t*)(KWS() + WS_A4))
#define XN2G    ((unsigned char*)(KWS() + WS_XN2))

#define IN(k) (lo <= (k) && (k) < hi)
#ifndef PROBE_PHASE
#define PROBE_PHASE -1
#endif
#ifndef PROBE_REPS
#define PROBE_REPS 1
#endif
#define REP(k) for (int _rep = 0; _rep < ((k) == PROBE_PHASE ? PROBE_REPS : 1); ++_rep)
#define SEAM(k) do { if (IN(k) && IN((k) + 1)) xcd_barrier(bar); } while (0)

    if (IN(0)) REP(0) {
        {
            LAS float* scr = (LAS float*)lds + wid * (64 * 65);
            const float* win = KIN(IN_WIN); const float* wout = KIN(IN_WOUT); const float* wpg = KIN(IN_WPG); const float* wple = KIN(IN_WPLE); const float* pln = KIN(IN_PLE_NORM);
            bf16_t* wint = WinT; bf16_t* woutt = WoutT; bf16_t* wgt = WgT; bf16_t* wplet = WpleT;
            for (int t = gwave; t < 1344; t += nwaves) {
                const int sel = t < 768 ? 0 : t < 1024 ? 1 : t < 1280 ? 2 : 3;
                const int tt = sel == 0 ? t : sel == 1 ? t - 768 : sel == 2 ? t - 1024 : t - 1280;
                const float* W = sel == 0 ? win : sel == 1 ? wout : sel == 2 ? wpg : wple;
                bf16_t* Wt = sel == 0 ? wint : sel == 1 ? woutt : sel == 2 ? wgt : wplet;
                const int K = sel == 3 ? 256 : 1024, N = sel == 0 ? 3072 : 1024, tn = sel == 0 ? 48 : 16;
                p0_transpose_wave(W, K, N, Wt, scr, lane, (tt / tn) * 64, (tt % tn) * 64, sel == 0, sel == 2 ? pln : nullptr);
            }
        }
        p0_fold(KIN(IN_PQ), KIN(IN_SUBK), KIN(IN_FFN_NORM), WqT, wid, lane, wg, nwg);
        const size_t gtid = (size_t)wg * 512 + tid, nthr = (size_t)nwg * 512;
        p0_convert(KIN(IN_P), PB, (size_t)T * 256, gtid, nthr);
        { const float* xp = KIN(IN_X); const float* gp = KIN(IN_ATTN_NORM); bf16_t* xo = XN;
          for (int row = gwave; row < T; row += 2 * nwaves) rmsnorm_rows2_bf16(xp, gp, xo, row, row + nwaves, lane); }
        if (wg == 0) {
            for (int idx = tid; idx < 8 * 129; idx += 512) {
                const int h = idx / 129, dist = idx % 129;
                int bk;
                if (dist < 16) bk = dist;
                else { const float v = logf((float)dist / 16.f) / 2.0794415416798357f * 16.f; bk = 16 + (int)v; bk = bk > 31 ? 31 : bk; }
                biasTab[h * 132 + dist] = KIN(IN_RELB)[bk * 8 + h] * LOG2E;
            }
        }
    }
    SEAM(0);
    if (IN(1)) REP(1) {
        pg8::Gemm g{XN, WinT, T, NPROJ, 1024}; pg8::StaticOrder S; S.init(T, NPROJ, nwg, wg);
        EpiQKV E{Qm, KIN(IN_QNORM), KIN(IN_KNORM), kmean};
        pg8::gemm_phase<EpiQKV, pg8::StaticOrder, true, true>(lds, g, S, E);
    }
    SEAM(1);
    if (IN(3)) REP(3) {
        const float* pu = KIN(IN_PU); const float* pv = KIN(IN_PV); unsigned char* u8 = U8; unsigned char* v8 = V8; float* usc_ = USC; float* vsc_ = VSC;
        const bf16_t* qm_ = Qm; const bf16_t* km_ = Km; const bf16_t* vtm_ = VtM; const bf16_t* qs_ = Qs; const bf16_t* ks_ = Ks; const bf16_t* vts_ = VtS;
        const float* kmn_ = kmean; const float* bt_ = biasTab; bf16_t* a2_ = A2;
        const float* gm_ = KIN(IN_ONM); const float* gs_ = KIN(IN_ONS);
        LAS unsigned char* ot = lds;
        LAS float* biasLds = (LAS float*)(lds + 34816);
        for (int i = tid; i < 8 * 132; i += 512) biasLds[i] = bt_[i];
        __syncthreads();
        int qrow = gwave;
        for (int u = gwave; u < 8192; u += nwaves) {
            const int grp = u >> 12, i = u & 4095;
            const int half = i >> 11, j = i & 2047;
            const int qt = half ? (j >> 6) : 63 - (j >> 6), bh = j & 63;
            const int b = bh >> 3, h = bh & 7;
            if (grp == 0) moba_unit(b, h, qt, qm_, km_, vtm_, kmn_, biasLds, ot, lane);
            else sb_unit(b, h, qt, qs_, ks_, vts_, ot, lane);
            __syncthreads();
            {
                const float* gg = grp ? gs_ : gm_;
                const f32x4 g0 = *(const f32x4*)(gg + 8 * lane), g1 = *(const f32x4*)(gg + 8 * lane + 4);
#pragma unroll
                for (int rr = 0; rr < 4; ++rr) {
                    const int row = 4 * wid + rr;
                    const bf16x8 v = *(const LAS bf16x8*)(ot + row * OT_PITCH + lane * 16);
                    float f[8], sq = 0.f;
#pragma unroll
                    for (int e = 0; e < 8; ++e) { f[e] = bf2f(v[e]); sq += f[e] * f[e]; }
                    sq = wave_sum(sq);
                    const float rs = rsqrtf(sq * (1.f / 512.f) + EPS);
                    u32x4 w; w.x = cvtpk(f[0] * rs * g0.x, f[1] * rs * g0.y); w.y = cvtpk(f[2] * rs * g0.z, f[3] * rs * g0.w);
                    w.z = cvtpk(f[4] * rs * g1.x, f[5] * rs * g1.y); w.w = cvtpk(f[6] * rs * g1.z, f[7] * rs * g1.w);
                    *(u32x4*)(a2_ + (size_t)(b * 2048 + qt * 32 + row) * 1024 + grp * 512 + 8 * lane) = w;
                }
            }
            __syncthreads();
            for (int k = 0; k < 1 && qrow < 16384; ++k, qrow += 2 * nwaves) p0_quant_rows4(pu, pv, u8, v8, usc_, vsc_, qrow, qrow + nwaves, lane);
        }
        for (; qrow < 16384; qrow += 2 * nwaves) p0_quant_rows4(pu, pv, u8, v8, usc_, vsc_, qrow, qrow + nwaves, lane);
    }
    SEAM(3);
    if (IN(5)) REP(5) {
        pg8::Gemm g{A2, WoutT, T, 1024, 1024}; pg8::StaticOrder S; S.init(T, 1024, nwg, wg);
        EpiRes E{KIN(IN_X), A3};
        pg8::gemm_phase<EpiRes, pg8::StaticOrder, true, true>(lds, g, S, E);
    }
    SEAM(5);
    if (IN(6)) REP(6) {
        pg8::Gemm g{A3, WqT, T, 2048, 1024}; pg8::StaticOrder S; S.init(T, 2048, nwg, wg);
        EpiBf E{(bf16_t*)SC, 2048};
        pg8::gemm_phase<EpiBf, pg8::StaticOrder, true, true>(lds, g, S, E);
    }
    SEAM(6);
    if (IN(7)) REP(7) {
        LAS float* wl = (LAS float*)(lds + wid * 4096);
        {
            const int c = lane; int ca, cb;
            if (c < 16) { ca = 0; cb = c; } else if (c < 24) { ca = 1; cb = c - 16; } else if (c < 29) { ca = 2; cb = c - 24; } else if (c < 33) { ca = 3; cb = c - 29; }
            else if (c < 36) { ca = 4; cb = c - 33; } else if (c < 42) { ca = 5 + ((c - 36) >> 1); cb = (c - 36) & 1; } else { ca = (c - 34) & 15; cb = 0; }
            ((LAS unsigned*)(wl + 768))[lane] = (unsigned)ca | ((unsigned)cb << 8);
            asm volatile("s_waitcnt lgkmcnt(0)" ::: "memory");
        }
        const bf16_t* h1p = A3; const bf16_t* scp = (const bf16_t*)SC; const float* gfp = KIN(IN_FFN_NORM); int* eip = EIDXG; float* gtp = GATEG; unsigned char* xnp = XN2G;
        TopkIn inA, inB;
        peer_topk_load(inA, gwave, h1p, scp, lane);
        for (int tok = gwave; tok < T; tok += 2 * nwaves) {
            peer_topk_load(inB, tok + nwaves, h1p, scp, lane);
            peer_topk_token(tok, inA, gfp, eip, gtp, xnp, wl, lane);
            peer_topk_load(inA, tok + 2 * nwaves, h1p, scp, lane);
            if (tok + nwaves < T) peer_topk_token(tok + nwaves, inB, gfp, eip, gtp, xnp, wl, lane);
        }
    }
    SEAM(7);
    int sl_first = 0, sl_step = 1, tk_first = 0, tk_step = 8;
    if (IN(8) || IN(10)) {
        __syncthreads();
        const unsigned myx = misc[5], myrank = misc[4];
        unsigned nx = 0, myidx = 0, nloc = 1;
        unsigned* xc = (unsigned*)(KWS() + WS_CTL) + CW_XC;
#pragma unroll
        for (unsigned j = 0; j < 16; ++j) { const unsigned cj = xb_ld(xc + 64 * j); if (cj > 0u) { if (j < myx) ++myidx; ++nx; } if (j == myx) nloc = cj; }
        sl_first = __builtin_amdgcn_readfirstlane((int)myidx); sl_step = __builtin_amdgcn_readfirstlane((int)(nx > 0u ? nx : 1u));
        tk_first = __builtin_amdgcn_readfirstlane((int)myrank * 8 + wid); tk_step = __builtin_amdgcn_readfirstlane((int)(nloc > 0u ? nloc : 1u) * 8);
    }
    if (IN(8)) REP(8) {
        const unsigned char* xnp = XN2G; const int* eip = EIDXG; const unsigned char* u8p = U8; bf16_t* pdp = PDOTG;
        for (int sl = sl_first; sl < 8; sl += sl_step) peer_u_slice(sl, tk_first, tk_step, xnp, eip, u8p, pdp, lane);
    }
    SEAM(8);
    if (IN(9)) REP(9) {
        const int* eip = EIDXG; const float* gtp = GATEG; const bf16_t* pdp = PDOTG; const float* usp = USC; const float* vsp = VSC; float* cjp = CJG; float* cmp_ = RS2G;
        for (int tok = gwave; tok < T; tok += 8 * nwaves) peer_cj_tokens<8>(tok, nwaves, eip, gtp, pdp, usp, vsp, cjp, cmp_, lane);
    }
    SEAM(9);
    if (IN(10)) REP(10) {
        const bf16_t* outp = A3; const int* eip = EIDXG; const float* cjp = CJG; const float* cmp_ = RS2G; const unsigned char* v8p = V8; bf16_t* a4p = A4G; float* sqp = SSQG;
        for (int sl = sl_first; sl < 8; sl += sl_step) peer_v_slice(sl, tk_first, tk_step, outp, eip, cjp, cmp_, v8p, a4p, sqp, lane);
    }
    SEAM(10);
    if (IN(11)) REP(11) {
        bf16_t* PW = Oraw;
        { int kple = 256; asm volatile("" : "+s"(kple));
          pg8::Gemm g{PB, WpleT, T, 1024, kple}; pg8::StaticOrder S; S.init(T, 1024, nwg, wg);
          EpiBf E{PW, 1024};
          pg8::gemm_phase<EpiBf, pg8::StaticOrder, true, true>(lds, g, S, E); }
        asm volatile("s_waitcnt vmcnt(0)" ::: "memory");
        __syncthreads();
        { pg8::Gemm g{A4G, WgT, T, 1024, 1024}; pg8::StaticOrder S; S.init(T, 1024, nwg, wg);
          EpiGate E{KOUT(), PW, SSQG, A4G};
          pg8::gemm_phase<EpiGate, pg8::StaticOrder, true, true>(lds, g, S, E); }
    }
#undef IN
#undef SEAM
}

extern "C" void kernel_launch(void* const* d_in, const int* in_sizes, int n_in, void* d_out, int out_size, void* d_ws, size_t ws_size, hipStream_t stream) {
    static int grid = 0;
    if (grid == 0) {
        if (n_in != 18 || out_size != T * DM || ws_size < WS_END) { fprintf(stderr, "kernel_launch: unexpected shapes (n_in %d out %d ws %zu)\n", n_in, out_size, ws_size); grid = -1; return; }
        int dev = 0, cus = 0, per_cu = 0;
        if (hipGetDevice(&dev) != hipSuccess || hipDeviceGetAttribute(&cus, hipDeviceAttributeMultiprocessorCount, dev) != hipSuccess) { grid = -1; return; }
        if (hipFuncSetAttribute((const void*)fwd_kernel, hipFuncAttributeMaxDynamicSharedMemorySize, LDS_BYTES) != hipSuccess) { fprintf(stderr, "kernel_launch: hipFuncSetAttribute failed\n"); grid = -1; return; }
        if (hipOccupancyMaxActiveBlocksPerMultiprocessor(&per_cu, (const void*)fwd_kernel, 512, LDS_BYTES) != hipSuccess || per_cu < 1)
            fprintf(stderr, "kernel_launch: note: occupancy query reports %d\n", per_cu);
        (void)hipGetLastError();
        grid = cus - (cus % 8);
    }
    if (grid < 0) return;
    if (hipMemsetAsync((char*)d_ws + WS_CTL, 0, CTL_ZERO_BYTES, stream) != hipSuccess) return;
    Params p{};
    for (int i = 0; i < 18; ++i) p.in[i] = (const float*)d_in[i];
    p.out = (float*)d_out; p.ws = (unsigned char*)d_ws;
    p.ph_lo = 0; p.ph_hi = NPHASE;
    hipLaunchKernelGGL(fwd_kernel, dim3(grid), dim3(512), LDS_BYTES, stream, p);
}
```

```cpp
#include <hip/hip_runtime.h>
#include <stdint.h>
#include <stdio.h>

#ifndef N_LAUNCHES
#define N_LAUNCHES 1
#endif

#define DI __device__ __forceinline__
#define LAS __attribute__((address_space(3)))

typedef unsigned short bf16_t;
typedef short bf16x8 __attribute__((ext_vector_type(8)));
typedef float f32x16 __attribute__((ext_vector_type(16)));
typedef float f32x4 __attribute__((ext_vector_type(4)));
typedef float f32x2 __attribute__((ext_vector_type(2)));
typedef unsigned u32x4 __attribute__((ext_vector_type(4)));
typedef unsigned u32x2 __attribute__((ext_vector_type(2)));
typedef __bf16 bf16x2_t __attribute__((ext_vector_type(2)));

constexpr int BATCH = 8, SEQ = 2048, DM = 1024, T = BATCH * SEQ;
constexpr int NPROJ = 3072;
constexpr float EPS = 1e-6f;
constexpr float LOG2E = 1.4426950408889634f;
constexpr float SCL2 = 0.125f * LOG2E;
constexpr int NPHASE = 12;

constexpr size_t MiB = 1u << 20;
constexpr size_t WS_CTL = 0, CTL_ZERO_BYTES = 256 * 1024 + 128 * 1024;
constexpr size_t WS_KMEAN = 256 * 1024;
constexpr size_t WS_BIAS = 512 * 1024;
constexpr size_t WS_WIN = 1 * MiB, WS_WOUT = 7 * MiB, WS_WQ = 9 * MiB, WS_WG = 13 * MiB, WS_WPLE = 15 * MiB;
constexpr size_t WS_U = 16 * MiB, WS_V = 32 * MiB;
constexpr size_t WS_USC = 640 * 1024, WS_VSC = 704 * 1024;
constexpr size_t WS_XN2 = 48 * MiB;
constexpr size_t WS_XN = 80 * MiB;
constexpr size_t WS_PB = 112 * MiB;
constexpr size_t WS_QM = 120 * MiB, WS_KM = 136 * MiB, WS_VTM = 152 * MiB, WS_QS = 168 * MiB, WS_KS = 184 * MiB, WS_VTS = 200 * MiB;
constexpr size_t WS_ORAW = 216 * MiB;
constexpr size_t WS_A2 = 80 * MiB;
constexpr size_t WS_A3 = 120 * MiB;
constexpr size_t WS_SC = 152 * MiB;
constexpr size_t WS_EIDX = 80 * MiB, WS_GATE = 88 * MiB, WS_CJ = 96 * MiB, WS_RS2 = 104 * MiB, WS_SSQ = 105 * MiB;
constexpr size_t WS_PDOT = 152 * MiB;
constexpr size_t WS_A4 = 184 * MiB;
constexpr size_t WS_END = 248 * MiB;

constexpr int CW_XC = 8192;
constexpr int CW_BAR = 4096;

constexpr int LDS_BYTES = 147456;

#define XB_TMO      128
#define XB_XCNT(j)  (256  + 64 * (j))
#define XB_XSUB(j)  (1280 + 64 * (j))
#define XB_XGEN(j)  (2304 + 64 * (j))
#define XB_TOP      3328
#define XB_TOPGEN   3392
#define XCD_BAR_WORDS 3456
#define XB_SPIN_CAP (1u << 18)

__device__ __forceinline__ unsigned xb_ld(unsigned* p)              { return __hip_atomic_load(p, __ATOMIC_RELAXED, __HIP_MEMORY_SCOPE_AGENT); }
__device__ __forceinline__ unsigned xb_add(unsigned* p, unsigned v) { return __hip_atomic_fetch_add(p, v, __ATOMIC_RELAXED, __HIP_MEMORY_SCOPE_AGENT); }
__device__ __forceinline__ unsigned xb_xcc_id() { return (unsigned)__builtin_amdgcn_s_getreg((3 << 11) | 20) & 0xFu; }
#define XB_SPIN(cond, bar) do { unsigned _sp = 0; while (cond) { __builtin_amdgcn_s_sleep(1); \
    if ((++_sp & 255u) == 0u) { if (xb_ld(&(bar)[XB_TMO])) break; if (_sp > XB_SPIN_CAP) { atomicAdd(&(bar)[XB_TMO], 1u); break; } } } } while (0)

struct XcdBarrier { unsigned* bar; unsigned x; volatile LAS unsigned* st; };

__device__ __forceinline__ XcdBarrier xcd_barrier_post(unsigned* bar, volatile LAS unsigned* st) {
    XcdBarrier b; b.bar = bar; b.x = xb_xcc_id(); b.st = st;
    if (threadIdx.x == 0) (void)xb_add(&bar[XB_XCNT(b.x)], 1u);
    return b;
}
__device__ __forceinline__ void xcd_barrier_complete(unsigned* bar, unsigned x, unsigned& nloc, unsigned& nx) {
    const unsigned G = gridDim.x * gridDim.y * gridDim.z;
    unsigned sum, cnt, mine, sp = 0u;
    for (;;) {
        sum = 0u; cnt = 0u; mine = 0u;
#pragma unroll
        for (unsigned j = 0; j < 16; ++j) { const unsigned c = xb_ld(&bar[XB_XCNT(j)]); sum += c; cnt += (c > 0u) ? 1u : 0u; mine = (j == x) ? c : mine; }
        if (sum == G) break;
        __builtin_amdgcn_s_sleep(1);
        if ((++sp & 255u) == 0u) { if (xb_ld(&bar[XB_TMO])) break; if (sp > XB_SPIN_CAP) { atomicAdd(&bar[XB_TMO], 1u); break; } }
    }
    nloc = mine > 0u ? mine : 1u; nx = cnt > 0u ? cnt : 1u;
}
template <bool CENSUS> __device__ __forceinline__ void xcd_barrier(const XcdBarrier& b) {
    asm volatile("s_waitcnt vmcnt(0)" ::: "memory");
    __syncthreads();
    if (threadIdx.x == 0) {
        unsigned* bar = b.bar;
        __builtin_amdgcn_s_waitcnt(0);
        unsigned nloc = b.st[0], nx = b.st[1];
        if (CENSUS) { if (nloc == 0u) { xcd_barrier_complete(bar, b.x, nloc, nx); b.st[0] = nloc; b.st[1] = nx; } }
        const unsigned old = xb_add(&bar[XB_XSUB(b.x)], 1u);
        const unsigned gen = old / nloc;
        if (old + 1u == (gen + 1u) * nloc) {
            __builtin_amdgcn_fence(__ATOMIC_RELEASE, "agent");
            asm volatile("s_waitcnt vmcnt(0)" ::: "memory");
            const unsigned og = xb_add(&bar[XB_TOP], 1u);
            const unsigned tg = og / nx;
            if (og + 1u == (tg + 1u) * nx) xb_add(&bar[XB_TOPGEN], 1u);
            else XB_SPIN(xb_ld(&bar[XB_TOPGEN]) == tg, bar);
            __builtin_amdgcn_fence(__ATOMIC_ACQUIRE, "agent");
            xb_add(&bar[XB_XGEN(b.x)], 1u);
            asm volatile("s_waitcnt vmcnt(0)" ::: "memory");
        } else {
            XB_SPIN(xb_ld(&bar[XB_XGEN(b.x)]) == gen, bar);
            __builtin_amdgcn_fence(__ATOMIC_ACQUIRE, "agent");
            asm volatile("s_waitcnt vmcnt(0)" ::: "memory");
        }
    }
    __syncthreads();
}

DI float bf2f(short v) { return __builtin_bit_cast(float, ((unsigned)(unsigned short)v) << 16); }
DI unsigned cvtpk(float lo, float hi) { f32x2 v = {lo, hi}; bf16x2_t b = __builtin_convertvector(v, bf16x2_t); return __builtin_bit_cast(unsigned, b); }
DI bf16_t f2bf(float f) { return (bf16_t)(cvtpk(f, 0.f) & 0xffffu); }
template <int CTRL> DI float dppf(float v) { return __builtin_bit_cast(float, __builtin_amdgcn_update_dpp(0, __builtin_bit_cast(int, v), CTRL, 0xF, 0xF, true)); }
#define DPP_XOR1 0xB1
#define DPP_XOR2 0x4E
#define DPP_HMIR 0x141
#define DPP_MIR  0x140
DI void swap16(float v, float& a, float& b) { const auto r = __builtin_amdgcn_permlane16_swap(__builtin_bit_cast(unsigned, v), __builtin_bit_cast(unsigned, v), false, false); const unsigned r0 = r[0], r1 = r[1]; a = __builtin_bit_cast(float, r0); b = __builtin_bit_cast(float, r1); }
DI void swap32(float v, float& a, float& b) { const auto r = __builtin_amdgcn_permlane32_swap(__builtin_bit_cast(unsigned, v), __builtin_bit_cast(unsigned, v), false, false); const unsigned r0 = r[0], r1 = r[1]; a = __builtin_bit_cast(float, r0); b = __builtin_bit_cast(float, r1); }
DI float sum_x16(float v) { float a, b; swap16(v, a, b); return a + b; }
DI float sum_x32(float v) { float a, b; swap32(v, a, b); return a + b; }
DI float max_x32(float v) { float a, b; swap32(v, a, b); return fmaxf(a, b); }
DI float sum_row16(float v) { v += dppf<DPP_XOR1>(v); v += dppf<DPP_XOR2>(v); v += dppf<DPP_HMIR>(v); v += dppf<DPP_MIR>(v); return v; }
DI float max_row16(float v) { v = fmaxf(v, dppf<DPP_XOR1>(v)); v = fmaxf(v, dppf<DPP_XOR2>(v)); v = fmaxf(v, dppf<DPP_HMIR>(v)); v = fmaxf(v, dppf<DPP_MIR>(v)); return v; }
DI float sum_oct(float v) { v += dppf<DPP_XOR1>(v); v += dppf<DPP_XOR2>(v); v += dppf<DPP_HMIR>(v); return v; }
DI float max_oct(float v) { v = fmaxf(v, dppf<DPP_XOR1>(v)); v = fmaxf(v, dppf<DPP_XOR2>(v)); v = fmaxf(v, dppf<DPP_HMIR>(v)); return v; }
DI float wave_sum(float v) { return sum_x32(sum_x16(sum_row16(v))); }
DI float wave_max(float v) { v = max_row16(v); float a, b; swap16(v, a, b); return max_x32(fmaxf(a, b)); }
DI float tr_x32(float lo, float hi) { const auto r = __builtin_amdgcn_permlane32_swap(__builtin_bit_cast(unsigned, lo), __builtin_bit_cast(unsigned, hi), false, false); const unsigned r0 = r[0], r1 = r[1]; return __builtin_bit_cast(float, r0) + __builtin_bit_cast(float, r1); }
DI float tr_x16(float lo, float hi) { const auto r = __builtin_amdgcn_permlane16_swap(__builtin_bit_cast(unsigned, lo), __builtin_bit_cast(unsigned, hi), false, false); const unsigned r0 = r[0], r1 = r[1]; return __builtin_bit_cast(float, r0) + __builtin_bit_cast(float, r1); }
DI float tr_x8(float lo, float hi, bool bit) { const float mine = bit ? hi : lo, send = bit ? lo : hi; return mine + dppf<0x128>(send); }
DI float tr_x4(float lo, float hi, bool bit) {
    const int a = __builtin_amdgcn_update_dpp(0, __builtin_bit_cast(int, hi), 0x114, 0xF, 0xA, false);
    const int b = __builtin_amdgcn_update_dpp(a, __builtin_bit_cast(int, lo), 0x104, 0xF, 0x5, false);
    return (bit ? hi : lo) + __builtin_bit_cast(float, b);
}
DI float tr_x2(float lo, float hi, bool bit) { const float mine = bit ? hi : lo, send = bit ? lo : hi; return mine + dppf<DPP_XOR2>(send); }
DI float tr_x1(float lo, float hi, bool bit) { const float mine = bit ? hi : lo, send = bit ? lo : hi; return mine + dppf<DPP_XOR1>(send); }
DI int crow(int r, int hi) { return (r & 3) + 8 * (r >> 2) + 4 * hi; }
#define MFMA32(a, b, c) __builtin_amdgcn_mfma_f32_32x32x16_bf16((a), (b), (c), 0, 0, 0)
DI f32x16 zero16() { f32x16 z; for (int i = 0; i < 16; ++i) z[i] = 0.f; return z; }

struct Params {
    const float* in[18];
    float* out;
    unsigned char* ws;
    int ph_lo, ph_hi;
};

enum { IN_X = 0, IN_P, IN_RELB, IN_ATTN_NORM, IN_WIN, IN_QNORM, IN_KNORM, IN_ONM, IN_ONS, IN_WOUT, IN_FFN_NORM, IN_PQ, IN_SUBK, IN_PU, IN_PV, IN_PLE_NORM, IN_WPG, IN_WPLE };

DI void p0_transpose_wave(const float* W, int K, int N, bf16_t* Wt, LAS float* scr  , int lane, int k0, int n0, bool headperm, const float* kgain) {
    f32x4 v[16];
    const int lr = lane >> 4, lc = 4 * (lane & 15);
#pragma unroll
    for (int i = 0; i < 16; ++i) v[i] = *(const f32x4*)(W + (size_t)(k0 + 4 * i + lr) * N + n0 + lc);
#pragma unroll
    for (int i = 0; i < 16; ++i) { LAS float* d = scr + (4 * i + lr) * 65 + lc; d[0] = v[i].x; d[1] = v[i].y; d[2] = v[i].z; d[3] = v[i].w; }
    __builtin_amdgcn_wave_barrier();
    const int j = lane & 7, nl = lane >> 3;
    f32x4 g0 = {1.f, 1.f, 1.f, 1.f}, g1 = g0;
    if (kgain) { g0 = *(const f32x4*)(kgain + k0 + 8 * j); g1 = *(const f32x4*)(kgain + k0 + 8 * j + 4); }
#pragma unroll
    for (int q = 0; q < 8; ++q) {
        const int nn = 8 * q + nl;
        int n = n0 + nn;
        if (headperm) { const int w = n & 255; n = (n & ~255) + 128 * ((w >> 5) & 1) + 32 * (w >> 6) + (w & 31); }
        const LAS float* sp = scr + (8 * j) * 65 + nn;
        u32x4 w;
        w.x = cvtpk(sp[0] * g0.x, sp[65] * g0.y); w.y = cvtpk(sp[130] * g0.z, sp[195] * g0.w);
        w.z = cvtpk(sp[260] * g1.x, sp[325] * g1.y); w.w = cvtpk(sp[390] * g1.z, sp[455] * g1.w);
        *(u32x4*)(Wt + (size_t)n * K + k0 + 8 * j) = w;
    }
    __builtin_amdgcn_wave_barrier();
}

DI void split_bf16x8(const f32x4& p, const f32x4& q, bf16x8& hi, bf16x8& lo) {
    u32x4 h, l;
    h.x = cvtpk(p.x, p.y); h.y = cvtpk(p.z, p.w); h.z = cvtpk(q.x, q.y); h.w = cvtpk(q.z, q.w);
    const float r0 = p.x - __builtin_bit_cast(float, h.x << 16), r1 = p.y - __builtin_bit_cast(float, h.x & 0xffff0000u), r2 = p.z - __builtin_bit_cast(float, h.y << 16), r3 = p.w - __builtin_bit_cast(float, h.y & 0xffff0000u);
    const float r4 = q.x - __builtin_bit_cast(float, h.z << 16), r5 = q.y - __builtin_bit_cast(float, h.z & 0xffff0000u), r6 = q.z - __builtin_bit_cast(float, h.w << 16), r7 = q.w - __builtin_bit_cast(float, h.w & 0xffff0000u);
    l.x = cvtpk(r0, r1); l.y = cvtpk(r2, r3); l.z = cvtpk(r4, r5); l.w = cvtpk(r6, r7);
    hi = __builtin_bit_cast(bf16x8, h); lo = __builtin_bit_cast(bf16x8, l);
}
DI void p0_fold(const float* wq, const float* sub, const float* gffn, bf16_t* WqT, int wid, int lane, int wg, int nwg) {
    const int r = lane & 31, hi = lane >> 5, dq = wid & 1, nq = wid >> 1;
    for (int item = wg; item < 256; item += nwg) {
        const int dt = item & 15, hh = item >> 4, d0 = dt * 64 + 32 * dq, h = hh >> 1, half = hh & 1;
        const float* ap = wq + (size_t)(d0 + r) * 2048 + h * 256 + half * 128 + 8 * hi;
        const float* bp = sub + half * 16384 + (size_t)(32 * nq + r) * 128 + 8 * hi;
        f32x16 acc = zero16();
#pragma unroll
        for (int st = 0; st < 8; ++st) {
            const f32x4 a0 = *(const f32x4*)(ap + 16 * st), a1 = *(const f32x4*)(ap + 16 * st + 4), b0 = *(const f32x4*)(bp + 16 * st), b1 = *(const f32x4*)(bp + 16 * st + 4);
            bf16x8 ah, al, bh, bl;
            split_bf16x8(a0, a1, ah, al); split_bf16x8(b0, b1, bh, bl);
            acc = MFMA32(ah, bh, acc); acc = MFMA32(ah, bl, acc); acc = MFMA32(al, bh, acc);
        }
        bf16_t* op = WqT + (size_t)(hh * 128 + 32 * nq + r) * 1024 + d0 + 4 * hi;
#pragma unroll
        for (int g4 = 0; g4 < 4; ++g4) {
            const f32x4 gv = *(const f32x4*)(gffn + d0 + 8 * g4 + 4 * hi);
            u32x2 w; w.x = cvtpk(acc[4 * g4] * gv.x, acc[4 * g4 + 1] * gv.y); w.y = cvtpk(acc[4 * g4 + 2] * gv.z, acc[4 * g4 + 3] * gv.w);
            *(u32x2*)(op + 8 * g4) = w;
        }
    }
}

DI void p0_convert(const float* src, bf16_t* dst, size_t n, size_t gtid, size_t nthreads) {
    for (size_t i = gtid * 8; i < n; i += nthreads * 8) {
        const f32x4 a = *(const f32x4*)(src + i), b = *(const f32x4*)(src + i + 4);
        u32x4 o; o.x = cvtpk(a.x, a.y); o.y = cvtpk(a.z, a.w); o.z = cvtpk(b.x, b.y); o.w = cvtpk(b.z, b.w);
        *(u32x4*)(dst + i) = o;
    }
}


DI void p0_quant_finish(const f32x4 (&a)[4], unsigned char* dst, float* scale, int row, int lane) {
    float m = 0.f;
#pragma unroll
    for (int i = 0; i < 4; ++i) m = fmaxf(fmaxf(m, fmaxf(fabsf(a[i].x), fabsf(a[i].y))), fmaxf(fabsf(a[i].z), fabsf(a[i].w)));
    m = wave_max(m);
    const float sc = m > 0.f ? m * (1.f / 440.f) : 1.f, inv = m > 0.f ? 440.f / m : 0.f;
    u32x4 w;
#pragma unroll
    for (int i = 0; i < 4; ++i) {
        const float q0 = fminf(fmaxf(a[i].x * inv, -448.f), 448.f), q1 = fminf(fmaxf(a[i].y * inv, -448.f), 448.f);
        const float q2 = fminf(fmaxf(a[i].z * inv, -448.f), 448.f), q3 = fminf(fmaxf(a[i].w * inv, -448.f), 448.f);
        int p = 0;
        p = __builtin_amdgcn_cvt_pk_fp8_f32(q0, q1, p, false);
        p = __builtin_amdgcn_cvt_pk_fp8_f32(q2, q3, p, true);
        w[i] = (unsigned)p;
    }
    *(u32x4*)(dst + ((size_t)(lane >> 3) * 16384 + row) * 128 + 16 * (lane & 7)) = w;
    if (lane == 0) scale[row] = sc;
}
DI void p0_quant_issue2(f32x4 (&a)[2][4], const float* pu, const float* pv, int r, int lane) {
#pragma unroll
    for (int i = 0; i < 4; ++i) { a[0][i] = *(const f32x4*)(pu + (size_t)r * 1024 + 16 * lane + 4 * i); a[1][i] = *(const f32x4*)(pv + (size_t)r * 1024 + 16 * lane + 4 * i); }
}
DI void p0_quant_rows4(const float* pu, const float* pv, unsigned char* u8, unsigned char* v8, float* usc_, float* vsc_, int r0, int r1, int lane) {
    f32x4 a[4][4];
    const int r1c = r1 < 16384 ? r1 : r0;
#pragma unroll
    for (int i = 0; i < 4; ++i) { a[0][i] = *(const f32x4*)(pu + (size_t)r0 * 1024 + 16 * lane + 4 * i); a[1][i] = *(const f32x4*)(pv + (size_t)r0 * 1024 + 16 * lane + 4 * i);
        a[2][i] = *(const f32x4*)(pu + (size_t)r1c * 1024 + 16 * lane + 4 * i); a[3][i] = *(const f32x4*)(pv + (size_t)r1c * 1024 + 16 * lane + 4 * i); }
    p0_quant_finish(a[0], u8, usc_, r0, lane); p0_quant_finish(a[1], v8, vsc_, r0, lane);
    if (r1 < 16384) { p0_quant_finish(a[2], u8, usc_, r1, lane); p0_quant_finish(a[3], v8, vsc_, r1, lane); }
}

DI void rmsnorm_rows2_bf16(const float* x, const float* g, bf16_t* o, int r0, int r1, int lane) {
    f32x4 v[2][4]; float s[2] = {0.f, 0.f};
    const int rr[2] = {r0, r1 < T ? r1 : r0};
#pragma unroll
    for (int q = 0; q < 2; ++q)
#pragma unroll
        for (int j = 0; j < 4; ++j) v[q][j] = ((const f32x4*)(x + (size_t)rr[q] * 1024))[lane + 64 * j];
#pragma unroll
    for (int q = 0; q < 2; ++q) {
#pragma unroll
        for (int j = 0; j < 4; ++j) s[q] += (v[q][j].x * v[q][j].x + v[q][j].y * v[q][j].y) + (v[q][j].z * v[q][j].z + v[q][j].w * v[q][j].w);
        s[q] = wave_sum(s[q]);
    }
#pragma unroll
    for (int q = 0; q < 2; ++q) {
        if (q == 1 && r1 >= T) break;
        const float rs = rsqrtf(s[q] * (1.f / 1024.f) + EPS);
#pragma unroll
        for (int j = 0; j < 4; ++j) { const f32x4 gv = ((const f32x4*)g)[lane + 64 * j];
            u32x2 w; w.x = cvtpk(v[q][j].x * rs * gv.x, v[q][j].y * rs * gv.y); w.y = cvtpk(v[q][j].z * rs * gv.z, v[q][j].w * rs * gv.w);
            ((u32x2*)(o + (size_t)rr[q] * 1024))[lane + 64 * j] = w; }
    }
}

namespace pg8 {
#define PG8_LAS __attribute__((address_space(3)))
typedef unsigned short bf16_t;
typedef short bf16x8 __attribute__((ext_vector_type(8)));
typedef float f32x4 __attribute__((ext_vector_type(4)));
typedef unsigned u32x4 __attribute__((ext_vector_type(4)));
constexpr int BM = 256, BK = 64, HALF = 128, HTB = HALF * BK * 2  , STAGE_BYTES = 8 * HTB, NXCD = 8, WGM = 8;

__host__ __device__ __forceinline__ int lds_byte(int r, int c) { const int st = (r >> 4) * 2 + (c >> 5), rr = r & 15, cc = c & 31, ob = rr * 64 + cc * 2; return st * 1024 + (ob ^ (((ob >> 9) & 1) << 5)); }
__host__ __device__ __forceinline__ void stage_rc(int b, int& R, int& C) { const int st = b / 1024, sb = b % 1024, swz = sb ^ (((sb >> 9) & 1) << 5); R = (st >> 1) * 16 + swz / 64; C = (st & 1) * 32 + (swz % 64) / 2; }
__host__ __device__ __forceinline__ int perm32(int rho) { const int n = rho >> 4, i = rho & 15; return 8 * (i >> 2) + 4 * n + (i & 3); }

struct Unit { int pm, pn; };
struct Gemm { const bf16_t* A; const bf16_t* Bt; int M, N, K; };

struct StaticOrder {
    int nM, nN, nwg, G, c;
    __host__ __device__ void init(int M, int N, int G_, int c_) { nM = M / BM; nN = N / BM; nwg = nM * nN; G = G_; c = c_; }
    __host__ __device__ bool next(int i, Unit& u) const {
        const long L = (long)i * G + c; if (L >= nwg) return false;
        int wgid = (int)L; { const int q = nwg / NXCD, r = nwg % NXCD, xcd = wgid % NXCD, off = wgid / NXCD; wgid = (xcd < r ? xcd * (q + 1) : r * (q + 1) + (xcd - r) * q) + off; }
        const int nig = WGM * nN, gid = wgid / nig, fm = gid * WGM, gsz = (nM - fm) < WGM ? (nM - fm) : WGM;
        u.pm = fm + ((wgid % nig) % gsz); u.pn = (wgid % nig) / gsz; return true;
    }
    __device__ __forceinline__ void a_ready(const Unit&) const {}
    __device__ __forceinline__ void done(const Unit&) const {}
};

template <class Epi, class Sched, bool ALIGN_EPI = false, bool SP2 = false>
__device__ __forceinline__ void gemm_phase(PG8_LAS unsigned char* lds, const Gemm g, const Sched& S, const Epi& E) {
    int tid_ = threadIdx.x; asm volatile("" : "+v"(tid_));
    const int tid = tid_, wid = __builtin_amdgcn_readfirstlane(tid >> 6), lane = tid & 63, wr = wid >> 2, wc = wid & 3, fr = lane & 15, fq = lane >> 4;
    const int K = g.K, nt = K / BK;
    unsigned voffA[2], voffB[2];
#pragma unroll
    for (int i = 0; i < 2; ++i) { int R, C; stage_rc(tid * 16 + i * 8192, R, C); const int Rb = Epi::PERM ? ((R & ~31) + perm32(R & 31)) : R;
        voffA[i] = (unsigned)(R * K + C) * 2u; voffB[i] = (unsigned)(Rb * K + C) * 2u; }
    const size_t kstep = (size_t)(BK * 2);
    const size_t hstep = (size_t)HALF * K * 2;
    const size_t tstep = 2 * hstep;
    const unsigned ldsw = (unsigned)wid * 1024u;
    const int aoff = lds_byte(wr * 64 + fr, fq * 8), boff = lds_byte(wc * 32 + fr, fq * 8);
#define PG8_SA(b, h) (((b) * 2 + (h)) * HTB)
#define PG8_SB(b, h) ((4 + (b) * 2 + (h)) * HTB)
#define PG8_STAGE(bufoff, gbase, voff) do { _Pragma("unroll") for (int _i = 0; _i < 2; ++_i) \
        __builtin_amdgcn_global_load_lds((const unsigned*)((const char*)(gbase) + (voff)[_i]), (PG8_LAS unsigned*)(lds + (bufoff) + ldsw + _i * 8192), 16, 0, 0); } while (0)
#define PG8_LDA(dst, b, h) do { _Pragma("unroll") for (int m = 0; m < 4; ++m) _Pragma("unroll") for (int k = 0; k < 2; ++k) dst[m][k] = *(const PG8_LAS bf16x8*)(lds + PG8_SA(b, h) + aoff + m * 2048 + k * 1024); } while (0)
#define PG8_LDB(dst, b, h) do { _Pragma("unroll") for (int n = 0; n < 2; ++n) _Pragma("unroll") for (int k = 0; k < 2; ++k) dst[n][k] = *(const PG8_LAS bf16x8*)(lds + PG8_SB(b, h) + boff + n * 2048 + k * 1024); } while (0)
#define PG8_MMA(ai, bj, At, Bt) do { __builtin_amdgcn_s_setprio(1); _Pragma("unroll") for (int m = 0; m < 4; ++m) _Pragma("unroll") for (int n = 0; n < 2; ++n) _Pragma("unroll") for (int k = 0; k < 2; ++k) \
        acc[ai][bj][m][n] = __builtin_amdgcn_mfma_f32_16x16x32_bf16(Bt[n][k], At[m][k], acc[ai][bj][m][n], 0, 0, 0); __builtin_amdgcn_s_setprio(0); } while (0)
#define PG8_WAIT_V(n) asm volatile("s_waitcnt vmcnt(" #n ")" ::: "memory")
#define PG8_WAIT_L(n) asm volatile("s_waitcnt lgkmcnt(" #n ")" ::: "memory")
#define PG8_BAR __builtin_amdgcn_s_barrier()
#define PG8_SCHED __builtin_amdgcn_sched_barrier(0)
    Unit cur, nxt; int ui = 0;
    if (!S.next(0, cur)) return;
    f32x4 acc[2][2][4][2];
#pragma unroll
    for (int a = 0; a < 2; ++a)
#pragma unroll
        for (int b = 0; b < 2; ++b)
#pragma unroll
            for (int m = 0; m < 4; ++m)
#pragma unroll
                for (int n = 0; n < 2; ++n) acc[a][b][m][n] = (f32x4){0.f, 0.f, 0.f, 0.f};
    bf16x8 At[4][2], B0[2][2], B1[2][2];
    const char* cA = (const char*)g.A + (size_t)cur.pm * tstep; const char* cB = (const char*)g.Bt + (size_t)cur.pn * tstep;
    S.a_ready(cur);
    if constexpr (SP2) {
        PG8_STAGE(PG8_SB(0, 0), cB, voffB); PG8_STAGE(PG8_SB(0, 1), cB + hstep, voffB); PG8_STAGE(PG8_SA(0, 0), cA, voffA); PG8_STAGE(PG8_SA(0, 1), cA + hstep, voffA);
        if (wr == 1) PG8_BAR;
        PG8_WAIT_V(2); PG8_BAR;
        PG8_STAGE(PG8_SB(1, 0), cB + kstep, voffB); PG8_STAGE(PG8_SA(1, 0), cA + kstep, voffA); PG8_STAGE(PG8_SB(1, 1), cB + hstep + kstep, voffB);
        PG8_WAIT_V(6); PG8_BAR;
    } else {
        PG8_STAGE(PG8_SB(0, 0), cB, voffB); PG8_STAGE(PG8_SA(0, 0), cA, voffA); PG8_STAGE(PG8_SB(0, 1), cB + hstep, voffB); PG8_STAGE(PG8_SA(0, 1), cA + hstep, voffA);
        if (wr == 1) PG8_BAR;
        PG8_WAIT_V(4); PG8_BAR;
        PG8_STAGE(PG8_SB(1, 0), cB + kstep, voffB); PG8_STAGE(PG8_SA(1, 0), cA + kstep, voffA); PG8_STAGE(PG8_SB(1, 1), cB + hstep + kstep, voffB);
        PG8_WAIT_V(6); PG8_BAR;
    }
    for (;;) {
        const bool has_next = S.next(ui + 1, nxt);
        const char* nA = has_next ? (const char*)g.A + (size_t)nxt.pm * tstep : cA; const char* nB = has_next ? (const char*)g.Bt + (size_t)nxt.pn * tstep : cB;
        for (int t = 0; t < nt; t += 2) {
            const bool last = (t == nt - 2);
            const char* a1 = cA + (size_t)(t + 1) * kstep;
            const char* a2 = last ? nA : cA + (size_t)(t + 2) * kstep; const char* b2 = last ? nB : cB + (size_t)(t + 2) * kstep;
            const char* a3 = a2 + kstep; const char* b3 = b2 + kstep;
            if (last && has_next) S.a_ready(nxt);
            if constexpr (SP2) {
            PG8_LDB(B0, 0, 0); PG8_LDB(B1, 0, 1); PG8_SCHED; PG8_LDA(At, 0, 0); PG8_STAGE(PG8_SA(1, 1), a1 + hstep, voffA);
            PG8_WAIT_V(8); PG8_WAIT_L(0); PG8_BAR; PG8_MMA(0, 0, At, B0); PG8_MMA(0, 1, At, B1); PG8_BAR; PG8_SCHED;
            PG8_LDA(At, 0, 1); PG8_STAGE(PG8_SB(0, 0), b2, voffB); PG8_STAGE(PG8_SB(0, 1), b2 + hstep, voffB); PG8_STAGE(PG8_SA(0, 0), a2, voffA);
            PG8_WAIT_V(8); PG8_WAIT_L(0); PG8_BAR; PG8_MMA(1, 0, At, B0); PG8_MMA(1, 1, At, B1); PG8_BAR; PG8_SCHED;
            PG8_LDB(B0, 1, 0); PG8_LDB(B1, 1, 1); PG8_SCHED; PG8_LDA(At, 1, 0); PG8_STAGE(PG8_SA(0, 1), a2 + hstep, voffA);
            PG8_WAIT_V(8); PG8_WAIT_L(0); PG8_BAR; PG8_MMA(0, 0, At, B0); PG8_MMA(0, 1, At, B1); PG8_BAR; PG8_SCHED;
            PG8_LDA(At, 1, 1); PG8_STAGE(PG8_SB(1, 0), b3, voffB); PG8_STAGE(PG8_SB(1, 1), b3 + hstep, voffB); PG8_STAGE(PG8_SA(1, 0), a3, voffA);
            PG8_WAIT_V(8); PG8_WAIT_L(0); PG8_BAR; PG8_MMA(1, 0, At, B0); PG8_MMA(1, 1, At, B1); PG8_BAR; PG8_SCHED;
            } else {
            PG8_LDB(B0, 0, 0); PG8_SCHED; PG8_LDA(At, 0, 0); PG8_STAGE(PG8_SA(1, 1), a1 + hstep, voffA);
            PG8_WAIT_L(8); PG8_BAR; PG8_WAIT_L(0); PG8_MMA(0, 0, At, B0); PG8_BAR; PG8_SCHED;
            PG8_LDB(B1, 0, 1); PG8_STAGE(PG8_SB(0, 0), b2, voffB);
            PG8_BAR; PG8_WAIT_L(0); PG8_MMA(0, 1, At, B1); PG8_BAR;
            PG8_LDA(At, 0, 1); PG8_STAGE(PG8_SA(0, 0), a2, voffA);
            PG8_BAR; PG8_WAIT_L(0); PG8_MMA(1, 0, At, B0); PG8_BAR; PG8_SCHED;
            PG8_STAGE(PG8_SB(0, 1), b2 + hstep, voffB);
            PG8_WAIT_V(6); PG8_BAR; PG8_MMA(1, 1, At, B1); PG8_BAR;
            PG8_LDB(B0, 1, 0); PG8_SCHED; PG8_LDA(At, 1, 0); PG8_STAGE(PG8_SA(0, 1), a2 + hstep, voffA);
            PG8_WAIT_L(8); PG8_BAR; PG8_WAIT_L(0); PG8_MMA(0, 0, At, B0); PG8_BAR; PG8_SCHED;
            PG8_LDB(B1, 1, 1); PG8_STAGE(PG8_SB(1, 0), b3, voffB);
            PG8_BAR; PG8_WAIT_L(0); PG8_MMA(0, 1, At, B1); PG8_BAR;
            PG8_LDA(At, 1, 1); PG8_STAGE(PG8_SA(1, 0), a3, voffA);
            PG8_BAR; PG8_WAIT_L(0); PG8_MMA(1, 0, At, B0); PG8_BAR; PG8_SCHED;
            PG8_STAGE(PG8_SB(1, 1), b3 + hstep, voffB);
            PG8_WAIT_V(6); PG8_BAR; PG8_MMA(1, 1, At, B1); PG8_BAR;
            }
        }
        if constexpr (ALIGN_EPI) { if (wr == 0) PG8_BAR; }
        if constexpr (!Epi::AFTER_DRAIN) { E(acc, cur, wr, wc, fr, fq); S.done(cur); }
        if (!has_next) break;
#pragma unroll
        for (int a = 0; a < 2; ++a)
#pragma unroll
            for (int b = 0; b < 2; ++b)
#pragma unroll
                for (int m = 0; m < 4; ++m)
#pragma unroll
                    for (int n = 0; n < 2; ++n) acc[a][b][m][n] = (f32x4){0.f, 0.f, 0.f, 0.f};
        cur = nxt; cA = nA; cB = nB; ++ui;
        if constexpr (ALIGN_EPI) { if (wr == 1) PG8_BAR; }
    }
    PG8_WAIT_V(0);
    if constexpr (!ALIGN_EPI) { if (wr == 0) PG8_BAR; }
    PG8_BAR;
    if constexpr (Epi::AFTER_DRAIN) { E.fused(acc, cur, wr, wc, fr, fq, lds, wid, lane); S.done(cur); }
#undef PG8_SA
#undef PG8_SB
#undef PG8_STAGE
#undef PG8_LDA
#undef PG8_LDB
#undef PG8_MMA
#undef PG8_WAIT_V
#undef PG8_WAIT_L
#undef PG8_BAR
#undef PG8_SCHED
}
}


struct EpiQKV {
    static constexpr bool PERM = true, AFTER_DRAIN = false;
    bf16_t* base6; const float *qn, *kn; float* kmean_acc;
    DI void operator()(const f32x4 (&acc)[2][2][4][2], const pg8::Unit& u, int wr, int wc, int fr, int fq) const {
        const int typ = u.pn >> 1, h = (u.pn & 1) * 4 + wc;
        bf16_t* reg = base6 + (size_t)typ * (16u << 19);
        const int row0 = u.pm * 256 + wr * 64 + fr;
        if (typ == 2 || typ == 5) {
#pragma unroll
            for (int ai = 0; ai < 2; ++ai)
#pragma unroll
                for (int m = 0; m < 4; ++m) {
                    const int tok = row0 + ai * 128 + m * 16, b = tok >> 11, sq = tok & 2047, tile = sq >> 5, kap = sq & 31;
                    const int s2 = kap >> 4, hh = (kap >> 2) & 1, jj = ((kap >> 3) & 1) * 4 + (kap & 3);
                    bf16_t* bp = reg + ((((size_t)(b * 8 + h) * 64 + tile) * 4 + s2 * 2) * 64 + hh * 32 + 8 * fq) * 8 + jj;
#pragma unroll
                    for (int bj = 0; bj < 2; ++bj)
#pragma unroll
                        for (int n = 0; n < 2; ++n)
#pragma unroll
                            for (int i = 0; i < 4; ++i) bp[(size_t)bj * 512 + (4 * n + i) * 8] = f2bf(acc[ai][bj][m][n][i]);
                }
        } else {
            const bool nrm = typ < 2;
            const float* g = (typ == 0) ? qn : kn;
            f32x4 gv[2][2];
#pragma unroll
            for (int bj = 0; bj < 2; ++bj)
#pragma unroll
                for (int n = 0; n < 2; ++n) gv[bj][n] = nrm ? *(const f32x4*)(g + 32 * bj + 8 * fq + 4 * n) : (f32x4){1.f, 1.f, 1.f, 1.f};
#pragma unroll
            for (int ai = 0; ai < 2; ++ai)
#pragma unroll
                for (int m = 0; m < 4; ++m) {
                    const int tok = row0 + ai * 128 + m * 16, b = tok >> 11, sq = tok & 2047, tile = sq >> 5, kap = sq & 31;
                    float rs = 1.f;
                    if (nrm) {
                        float ss = 0.f;
#pragma unroll
                        for (int bj = 0; bj < 2; ++bj)
#pragma unroll
                            for (int n = 0; n < 2; ++n) { const f32x4 v = acc[ai][bj][m][n]; ss += (v.x * v.x + v.y * v.y) + (v.z * v.z + v.w * v.w); }
                        ss = sum_x32(sum_x16(ss));
                        rs = rsqrtf(ss * (1.f / 64.f) + EPS);
                    }
                    bf16_t* dst = reg + ((((size_t)(b * 8 + h) * 64 + tile) * 4 + (fq >> 1)) * 64 + (fq & 1) * 32 + kap) * 8;
#pragma unroll
                    for (int bj = 0; bj < 2; ++bj) {
                        const f32x4 v0 = acc[ai][bj][m][0] * rs * gv[bj][0], v1 = acc[ai][bj][m][1] * rs * gv[bj][1];
                        u32x4 w; w.x = cvtpk(v0.x, v0.y); w.y = cvtpk(v0.z, v0.w); w.z = cvtpk(v1.x, v1.y); w.w = cvtpk(v1.z, v1.w);
                        *(u32x4*)(dst + (size_t)bj * 2 * 512) = w;
                    }
                }
            if (typ == 1) {
                asm volatile("" ::: "memory");
                f32x4 ks[2][2];
#pragma unroll
                for (int bj = 0; bj < 2; ++bj)
#pragma unroll
                    for (int n = 0; n < 2; ++n) ks[bj][n] = (f32x4){0.f, 0.f, 0.f, 0.f};
#pragma unroll
                for (int ai = 0; ai < 2; ++ai)
#pragma unroll
                    for (int m = 0; m < 4; ++m) {
                        float ss = 0.f;
#pragma unroll
                        for (int bj = 0; bj < 2; ++bj)
#pragma unroll
                            for (int n = 0; n < 2; ++n) { const f32x4 v = acc[ai][bj][m][n]; ss += (v.x * v.x + v.y * v.y) + (v.z * v.z + v.w * v.w); }
                        ss = sum_x32(sum_x16(ss));
                        const float rs = rsqrtf(ss * (1.f / 64.f) + EPS);
#pragma unroll
                        for (int bj = 0; bj < 2; ++bj)
#pragma unroll
                            for (int n = 0; n < 2; ++n) ks[bj][n] += acc[ai][bj][m][n] * rs * gv[bj][n];
                    }
                const int tok0 = u.pm * 256;
                float* kd = kmean_acc + ((size_t)((tok0 >> 11) * 8 + h) * 8 + ((tok0 & 2047) >> 8)) * 64 + 8 * fq;
#pragma unroll
                for (int bj = 0; bj < 2; ++bj)
#pragma unroll
                    for (int n = 0; n < 2; ++n)
#pragma unroll
                        for (int i = 0; i < 4; ++i) { const float t = sum_row16(ks[bj][n][i]) * (1.f / 256.f); if (fr == 0) atomicAdd(kd + 32 * bj + 4 * n + i, t); }
            }
        }
    }
};

struct EpiRes {
    static constexpr bool PERM = true, AFTER_DRAIN = false;
    const float* x; bf16_t* xn;
    DI void operator()(const f32x4 (&acc)[2][2][4][2], const pg8::Unit& u, int wr, int wc, int fr, int fq) const {
        const int row0 = u.pm * 256 + wr * 64 + fr, col0 = u.pn * 256 + wc * 32 + 8 * fq;
#pragma unroll
        for (int ai = 0; ai < 2; ++ai)
#pragma unroll
            for (int m = 0; m < 4; ++m)
#pragma unroll
                for (int bj = 0; bj < 2; ++bj) {
                    const size_t off = (size_t)(row0 + ai * 128 + m * 16) * 1024 + col0 + bj * 128;
                    const f32x4 h0 = *(const f32x4*)(x + off) + acc[ai][bj][m][0], h1 = *(const f32x4*)(x + off + 4) + acc[ai][bj][m][1];
                    u32x4 w; w.x = cvtpk(h0.x, h0.y); w.y = cvtpk(h0.z, h0.w); w.z = cvtpk(h1.x, h1.y); w.w = cvtpk(h1.z, h1.w);
                    *(u32x4*)(xn + off) = w;
                }
    }
};

struct EpiF32 {
    static constexpr bool PERM = true, AFTER_DRAIN = false;
    float* C; int ldc;
    DI void operator()(const f32x4 (&acc)[2][2][4][2], const pg8::Unit& u, int wr, int wc, int fr, int fq) const {
        const int row0 = u.pm * 256 + wr * 64 + fr, col0 = u.pn * 256 + wc * 32 + 8 * fq;
#pragma unroll
        for (int ai = 0; ai < 2; ++ai)
#pragma unroll
            for (int m = 0; m < 4; ++m)
#pragma unroll
                for (int bj = 0; bj < 2; ++bj) {
                    float* p = C + (size_t)(row0 + ai * 128 + m * 16) * ldc + col0 + bj * 128;
                    *(f32x4*)p = acc[ai][bj][m][0]; *(f32x4*)(p + 4) = acc[ai][bj][m][1];
                }
    }
};

struct EpiBf {
    static constexpr bool PERM = true, AFTER_DRAIN = false;
    bf16_t* C; int ldc;
    DI void operator()(const f32x4 (&acc)[2][2][4][2], const pg8::Unit& u, int wr, int wc, int fr, int fq) const {
        const int row0 = u.pm * 256 + wr * 64 + fr, col0 = u.pn * 256 + wc * 32 + 8 * fq;
#pragma unroll
        for (int ai = 0; ai < 2; ++ai)
#pragma unroll
            for (int m = 0; m < 4; ++m)
#pragma unroll
                for (int bj = 0; bj < 2; ++bj) {
                    const f32x4 v0 = acc[ai][bj][m][0], v1 = acc[ai][bj][m][1];
                    u32x4 w; w.x = cvtpk(v0.x, v0.y); w.y = cvtpk(v0.z, v0.w); w.z = cvtpk(v1.x, v1.y); w.w = cvtpk(v1.z, v1.w);
                    *(u32x4*)(C + (size_t)(row0 + ai * 128 + m * 16) * ldc + col0 + bj * 128) = w;
                }
    }
};

struct EpiGate {
    static constexpr bool PERM = true, AFTER_DRAIN = false;
    float* out; const bf16_t* pw; const float* ssq; const bf16_t* h2b;
    DI void operator()(const f32x4 (&acc)[2][2][4][2], const pg8::Unit& u, int wr, int wc, int fr, int fq) const {
        const int row0 = u.pm * 256 + wr * 64 + fr, col0 = u.pn * 256 + wc * 32 + 8 * fq;
#pragma unroll
        for (int ai = 0; ai < 2; ++ai)
#pragma unroll
            for (int m = 0; m < 4; ++m) {
                const int row = row0 + ai * 128 + m * 16;
                float sq = 0.f;
#pragma unroll
                for (int x = 0; x < 8; ++x) sq += ssq[(size_t)x * T + row];
                const float rs3 = rsqrtf(sq * (1.f / 1024.f) + EPS);
#pragma unroll
                for (int bj = 0; bj < 2; ++bj) {
                    const size_t off = (size_t)row * 1024 + col0 + bj * 128;
                    const bf16x8 pv = *(const bf16x8*)(pw + off);
                    const bf16x8 hb = *(const bf16x8*)(h2b + off);
                    const f32x4 g0 = acc[ai][bj][m][0] * rs3, g1 = acc[ai][bj][m][1] * rs3;
                    f32x4 o0, o1;
#pragma unroll
                    for (int i = 0; i < 4; ++i) { o0[i] = bf2f(hb[i]) + bf2f(pv[i]) * __builtin_amdgcn_rcpf(1.f + __expf(-g0[i])); o1[i] = bf2f(hb[4 + i]) + bf2f(pv[4 + i]) * __builtin_amdgcn_rcpf(1.f + __expf(-g1[i])); }
                    *(f32x4*)(out + off) = o0; *(f32x4*)(out + off + 4) = o1;
                }
            }
    }
};

template <class Epi>
DI void gemm_simple(const bf16_t* A, const bf16_t* Bt, int M, int N, int K, const Epi& epi, int gwave, int nwaves, int lane) {
    const int r32 = lane & 31, hi = lane >> 5;
    const int nNt = N / 64, total = (M / 32) * nNt;
    for (int tile = gwave; tile < total; tile += nwaves) {
        const int mt = tile / nNt, nt = tile - mt * nNt, m0 = mt * 32, n0 = nt * 64;
        const bf16_t* ap = A + (size_t)(m0 + r32) * K + 8 * hi;
        const bf16_t* b0p = Bt + (size_t)(n0 + r32) * K + 8 * hi;
        const bf16_t* b1p = b0p + (size_t)32 * K;
        f32x16 acc0 = zero16(), acc1 = zero16();
#pragma unroll 4
        for (int k = 0; k < K; k += 16) {
            const bf16x8 xa = *(const bf16x8*)(ap + k);
            const bf16x8 w0 = *(const bf16x8*)(b0p + k);
            const bf16x8 w1 = *(const bf16x8*)(b1p + k);
            acc0 = MFMA32(w0, xa, acc0);
            acc1 = MFMA32(w1, xa, acc1);
        }
        epi(m0 + r32, n0, hi, acc0, acc1);
    }
}

struct Epi1 {
    bf16_t* base6;
    const float *qn, *kn;
    DI void operator()(int tok, int n0, int hi, const f32x16& a0, const f32x16& a1) const {
        const int head48 = n0 >> 6, typ = head48 >> 3, h = head48 & 7;
        bf16_t* reg = base6 + (size_t)typ * (16u << 19);
        if (typ == 2 || typ == 5) {
            const int b = tok >> 11, s = tok & 2047;
            const int pos = (s & ~12) | ((s & 4) << 1) | ((s & 8) >> 1);
            bf16_t* base = reg + ((size_t)(b * 8 + h) * 64) * 2048 + pos;
#pragma unroll
            for (int r = 0; r < 16; ++r) { base[(size_t)crow(r, hi) * 2048] = f2bf(a0[r]); base[(size_t)(32 + crow(r, hi)) * 2048] = f2bf(a1[r]); }
        } else {
            float rs = 1.f;
            const bool nrm = (typ == 0 || typ == 1);
            if (nrm) { float ss = 0.f;
#pragma unroll
                for (int r = 0; r < 16; ++r) ss += a0[r] * a0[r] + a1[r] * a1[r];
                ss = sum_x32(ss);
                rs = rsqrtf(ss * (1.f / 64.f) + EPS); }
            const float* g = (typ == 0) ? qn : kn;
            bf16_t* dst = reg + (size_t)tok * 512 + h * 64;
#pragma unroll
            for (int t = 0; t < 2; ++t)
#pragma unroll
                for (int g4 = 0; g4 < 4; ++g4) {
                    const int f0 = 32 * t + 8 * g4 + 4 * hi;
                    float v[4];
#pragma unroll
                    for (int i = 0; i < 4; ++i) { const float a = t ? a1[4 * g4 + i] : a0[4 * g4 + i]; v[i] = nrm ? a * rs * g[f0 + i] : a; }
                    u32x2 w; w.x = cvtpk(v[0], v[1]); w.y = cvtpk(v[2], v[3]);
                    *(u32x2*)(dst + f0) = w;
                }
        }
    }
};

struct Epi2 {
    const float* x; float* out; bf16_t* xn;
    DI void operator()(int tok, int n0, int hi, const f32x16& a0, const f32x16& a1) const {
#pragma unroll
        for (int t = 0; t < 2; ++t)
#pragma unroll
            for (int g4 = 0; g4 < 4; ++g4) {
                const size_t off = (size_t)tok * 1024 + n0 + 32 * t + 8 * g4 + 4 * hi;
                const f32x4 xv = *(const f32x4*)(x + off);
                f32x4 hv;
#pragma unroll
                for (int i = 0; i < 4; ++i) hv[i] = xv[i] + (t ? a1[4 * g4 + i] : a0[4 * g4 + i]);
                *(f32x4*)(out + off) = hv;
                u32x2 w; w.x = cvtpk(hv[0], hv[1]); w.y = cvtpk(hv[2], hv[3]);
                *(u32x2*)(xn + off) = w;
            }
    }
};

struct Epi3 {
    float* sc;
    DI void operator()(int tok, int n0, int hi, const f32x16& a0, const f32x16& a1) const {
#pragma unroll
        for (int t = 0; t < 2; ++t)
#pragma unroll
            for (int g4 = 0; g4 < 4; ++g4) {
                f32x4 v;
#pragma unroll
                for (int i = 0; i < 4; ++i) v[i] = t ? a1[4 * g4 + i] : a0[4 * g4 + i];
                *(f32x4*)(sc + (size_t)tok * 2048 + n0 + 32 * t + 8 * g4 + 4 * hi) = v;
            }
    }
};

DI void pv_accum(f32x16& o0, f32x16& o1, const f32x16& p, const bf16_t* vt_row) {
#pragma unroll
    for (int s = 0; s < 2; ++s) {
        u32x4 pk; pk.x = cvtpk(p[8 * s], p[8 * s + 1]); pk.y = cvtpk(p[8 * s + 2], p[8 * s + 3]); pk.z = cvtpk(p[8 * s + 4], p[8 * s + 5]); pk.w = cvtpk(p[8 * s + 6], p[8 * s + 7]);
        const bf16x8 pb = __builtin_bit_cast(bf16x8, pk);
        const bf16x8 v0 = *(const bf16x8*)(vt_row + 16 * s);
        const bf16x8 v1 = *(const bf16x8*)(vt_row + (size_t)32 * 2048 + 16 * s);
        o0 = MFMA32(v0, pb, o0);
        o1 = MFMA32(v1, pb, o1);
    }
}

DI void store_o(bf16_t* op, const f32x16& o0, const f32x16& o1, float inv, int hi) {
#pragma unroll
    for (int t = 0; t < 2; ++t)
#pragma unroll
        for (int g4 = 0; g4 < 4; ++g4) {
            u32x2 w;
            if (t == 0) { w.x = cvtpk(o0[4 * g4] * inv, o0[4 * g4 + 1] * inv); w.y = cvtpk(o0[4 * g4 + 2] * inv, o0[4 * g4 + 3] * inv); }
            else        { w.x = cvtpk(o1[4 * g4] * inv, o1[4 * g4 + 1] * inv); w.y = cvtpk(o1[4 * g4 + 2] * inv, o1[4 * g4 + 3] * inv); }
            *(u32x2*)(op + 32 * t + 8 * g4 + 4 * hi) = w;
        }
}

constexpr int OT_PITCH = 1040;
DI void store_o_lds(LAS unsigned char* ot, int r32, int h, const f32x16& o0, const f32x16& o1, float inv, int hi) {
    LAS unsigned char* op = ot + r32 * OT_PITCH + h * 128;
#pragma unroll
    for (int t = 0; t < 2; ++t)
#pragma unroll
        for (int g4 = 0; g4 < 4; ++g4) {
            u32x2 w;
            if (t == 0) { w.x = cvtpk(o0[4 * g4] * inv, o0[4 * g4 + 1] * inv); w.y = cvtpk(o0[4 * g4 + 2] * inv, o0[4 * g4 + 3] * inv); }
            else        { w.x = cvtpk(o1[4 * g4] * inv, o1[4 * g4 + 1] * inv); w.y = cvtpk(o1[4 * g4 + 2] * inv, o1[4 * g4 + 3] * inv); }
            *(LAS u32x2*)(op + (32 * t + 8 * g4 + 4 * hi) * 2) = w;
        }
}
DI void load_kfrag(bf16x8 (&kf)[4], const bf16_t* fbase  , int tile) {
    const bf16_t* kp = fbase + (size_t)tile * 2048;
#pragma unroll
    for (int s = 0; s < 4; ++s) kf[s] = *(const bf16x8*)(kp + s * 512);
}
DI void load_vfrag(bf16x8 (&vf)[4], const bf16_t* fbase, int tile) {
    const bf16_t* vp = fbase + (size_t)tile * 2048;
#pragma unroll
    for (int q = 0; q < 4; ++q) vf[q] = *(const bf16x8*)(vp + q * 512);
}
DI void pv_accum2(f32x16& o0, f32x16& o1, const f32x16& p, const bf16x8 (&vf)[4]) {
#pragma unroll
    for (int s = 0; s < 2; ++s) {
        u32x4 pk; pk.x = cvtpk(p[8 * s], p[8 * s + 1]); pk.y = cvtpk(p[8 * s + 2], p[8 * s + 3]); pk.z = cvtpk(p[8 * s + 4], p[8 * s + 5]); pk.w = cvtpk(p[8 * s + 6], p[8 * s + 7]);
        const bf16x8 pb = __builtin_bit_cast(bf16x8, pk);
        o0 = MFMA32(vf[2 * s], pb, o0);
        o1 = MFMA32(vf[2 * s + 1], pb, o1);
    }
}

#define MEM_FENCE() asm volatile("" ::: "memory")
#define PIN1(a) asm volatile("" : "+v"(a) :: "memory")
#define PIN2(a, b) asm volatile("" : "+v"(a), "+v"(b) :: "memory")
DI void vm_drain() { __builtin_amdgcn_s_waitcnt(0x0F70); }
struct KvStream { const bf16_t* kbase; const bf16_t* vbase; };

struct MobaCtx { int q0, tq, blk, hi; unsigned selmask; float bfar; const LAS float* bt; };
DI void moba_tile(bf16x8 (&kf)[4], bf16x8 (&vf)[4], const bf16x8 (&qf)[4], int kt, int next, const KvStream& kv, const MobaCtx& c, float& mrun, float& lsum, f32x16& o0, f32x16& o1) {
    const int n = kt >> 3, key0 = kt * 32;
    f32x16 st = zero16();
#pragma unroll
    for (int s = 0; s < 4; ++s) st = MFMA32(kf[s], qf[s], st);
    PIN1(st); load_kfrag(kf, kv.kbase, next); PIN1(st);
    float x[16];
    if (n != c.blk) {
        const bool selq = (c.selmask >> n) & 1u;
        if ((c.q0 - (key0 + 31)) >= 128) {
            const float addend = selq ? c.bfar : -1e30f;
#pragma unroll
            for (int r = 0; r < 16; ++r) x[r] = st[r] * SCL2 + addend;
        } else {
#pragma unroll
            for (int r = 0; r < 16; ++r) { const int dist = c.tq - (key0 + crow(r, c.hi)); const float v = st[r] * SCL2 + c.bt[dist > 128 ? 128 : dist]; x[r] = selq ? v : -1e30f; }
        }
    } else {
#pragma unroll
        for (int r = 0; r < 16; ++r) { const int dist = c.tq - (key0 + crow(r, c.hi)); const float v = st[r] * SCL2 + c.bt[dist < 0 ? 0 : (dist > 128 ? 128 : dist)]; x[r] = (dist >= 0) ? v : -1e30f; }
    }
    float mx = x[0];
#pragma unroll
    for (int r = 1; r < 16; ++r) mx = fmaxf(mx, x[r]);
    mx = max_x32(mx);
    const float mnew = fmaxf(mrun, mx);
    if (!__all(mnew == mrun)) {
        const float alpha = __builtin_amdgcn_exp2f(mrun - mnew);
        lsum *= alpha;
#pragma unroll
        for (int r = 0; r < 16; ++r) { o0[r] *= alpha; o1[r] *= alpha; }
        mrun = mnew;
    }
    f32x16 pr; float ps = 0.f;
#pragma unroll
    for (int r = 0; r < 16; ++r) { const float e = __builtin_amdgcn_exp2f(x[r] - mrun); pr[r] = e; ps += e; }
    lsum += ps;
    pv_accum2(o0, o1, pr, vf);
    PIN2(o0, o1); load_vfrag(vf, kv.vbase, next); MEM_FENCE();
}
DI int moba_next(int kt, int blk, unsigned anysel) {
    int nkt = kt - 1;
    while (nkt >= 0) { const int nn = nkt >> 3; if (nn == blk || ((anysel >> nn) & 1u)) break; nkt = nn * 8 - 1; }
    return nkt;
}

DI void moba_unit(int b, int h, int qt, const bf16_t* Qm_, const bf16_t* Km_, const bf16_t* VtM_, const float* kmean_, const LAS float* biasLds, LAS unsigned char* ot, int lane) {
    const int r32 = lane & 31, hi = lane >> 5;
    const int q0 = qt * 32, tq = q0 + r32, blk = q0 >> 8;
    const size_t bh = (size_t)(b * 8 + h);
    const bf16_t* qfb = Qm_ + bh * (64 * 2048) + (size_t)qt * 2048;
    KvStream kv; kv.kbase = Km_ + bh * (64 * 2048) + lane * 8; kv.vbase = VtM_ + bh * (64 * 2048) + lane * 8;
    bf16x8 kf[4], vf[4];
    load_kfrag(kf, kv.kbase, qt); load_vfrag(vf, kv.vbase, qt);
    bf16x8 qf[4];
#pragma unroll
    for (int s = 0; s < 4; ++s) qf[s] = *(const bf16x8*)(qfb + s * 512 + lane * 8);
    unsigned selmask = 0;
    if (blk > 0) {
        float qv[32];
#pragma unroll
        for (int c = 0; c < 4; ++c) { const bf16x8 t = *(const bf16x8*)(qfb + (2 * hi + (c >> 1)) * 512 + ((c & 1) * 32 + r32) * 8);
#pragma unroll
            for (int j = 0; j < 8; ++j) qv[8 * c + j] = bf2f(t[j]); }
        const float* km = kmean_ + (size_t)((b * 8 + h) * 8) * 64 + 32 * hi;
        float g[8];
#pragma unroll
        for (int n = 0; n < 8; ++n) {
            float a = 0.f;
            if (n < blk) {
#pragma unroll
                for (int d4 = 0; d4 < 8; ++d4) { const f32x4 kv4 = *(const f32x4*)(km + n * 64 + 4 * d4); a += (qv[4 * d4] * kv4.x + qv[4 * d4 + 1] * kv4.y) + (qv[4 * d4 + 2] * kv4.z + qv[4 * d4 + 3] * kv4.w); }
            }
            a = sum_x32(a);
            g[n] = (n < blk) ? a : -INFINITY;
        }
#pragma unroll
        for (int n = 0; n < 8; ++n) {
            int rank = 0;
#pragma unroll
            for (int m = 0; m < 8; ++m) if (m != n) rank += ((g[m] > g[n]) || (g[m] == g[n] && m < n)) ? 1 : 0;
            if (n < blk && rank < 3) selmask |= 1u << n;
        }
    }
    unsigned anysel = 0;
#pragma unroll
    for (int n = 0; n < 8; ++n) if (__any((selmask >> n) & 1u)) anysel |= 1u << n;
    anysel = __builtin_amdgcn_readfirstlane(anysel);
    float mrun = -1e30f, lsum = 0.f;
    f32x16 o0 = zero16(), o1 = zero16();
    MobaCtx c; c.q0 = q0; c.tq = tq; c.blk = blk; c.hi = hi; c.selmask = selmask; c.bt = biasLds + h * 132; c.bfar = c.bt[128];
    vm_drain();
    int kt = qt;
    for (;;) {
        const int nx = moba_next(kt, blk, anysel);
        moba_tile(kf, vf, qf, kt, nx < 0 ? 0 : nx, kv, c, mrun, lsum, o0, o1);
        if (nx < 0) break;
        kt = nx;
    }
    lsum = sum_x32(lsum);
    const float inv = 1.f / lsum;
    store_o_lds(ot, r32, h, o0, o1, inv, hi);
}

DI void sb_tile(bf16x8 (&kf)[4], bf16x8 (&vf)[4], const bf16x8 (&qf)[4], int kt, int next, const KvStream& kv, int tq, int hi, float& C, f32x16& o0, f32x16& o1) {
    const int key0 = kt * 32;
    f32x16 st = zero16();
#pragma unroll
    for (int s = 0; s < 4; ++s) st = MFMA32(kf[s], qf[s], st);
    PIN1(st); load_kfrag(kf, kv.kbase, next); PIN1(st);
    float rr[16], be[16];
#pragma unroll
    for (int r = 0; r < 16; ++r) {
        const int key = key0 + crow(r, hi);
        const float y = fminf(st[r] * SCL2, 100.f);
        const float e = __builtin_amdgcn_exp2f(y);
        const float ri = __builtin_amdgcn_rcpf(1.f + e);
        const bool ok = key < tq;
        rr[r] = ok ? ri : 1.f;
        be[r] = ok ? e * ri : 0.f;
    }
    float G[4], ex[16], Gp[4], Tt[4], Suf[4];
#pragma unroll
    for (int a = 0; a < 4; ++a) {
        ex[4 * a + 3] = 1.f; ex[4 * a + 2] = rr[4 * a + 3]; ex[4 * a + 1] = ex[4 * a + 2] * rr[4 * a + 2]; ex[4 * a] = ex[4 * a + 1] * rr[4 * a + 1];
        G[a] = ex[4 * a] * rr[4 * a];
    }
#pragma unroll
    for (int a = 0; a < 4; ++a) { float lo_, hi_; swap32(G[a], lo_, hi_); Gp[a] = hi_; Tt[a] = lo_ * hi_; }
    Suf[3] = 1.f; Suf[2] = Tt[3]; Suf[1] = Tt[3] * Tt[2]; Suf[0] = Suf[1] * Tt[1];
    f32x16 pr;
#pragma unroll
    for (int a = 0; a < 4; ++a) {
        const float after = Suf[a] * (hi == 0 ? Gp[a] : 1.f) * C;
#pragma unroll
        for (int i = 0; i < 4; ++i) pr[4 * a + i] = be[4 * a + i] * ex[4 * a + i] * after;
    }
    C = C * (Suf[0] * Tt[0]);
    pv_accum2(o0, o1, pr, vf);
    PIN2(o0, o1); load_vfrag(vf, kv.vbase, next); MEM_FENCE();
}

DI void sb_unit(int b, int h, int qt, const bf16_t* Qs_, const bf16_t* Ks_, const bf16_t* VtS_, LAS unsigned char* ot, int lane) {
    const int r32 = lane & 31, hi = lane >> 5;
    const int q0 = qt * 32, tq = q0 + r32;
    const size_t bh = (size_t)(b * 8 + h);
    const bf16_t* qfb = Qs_ + bh * (64 * 2048) + (size_t)qt * 2048;
    KvStream kv; kv.kbase = Ks_ + bh * (64 * 2048) + lane * 8; kv.vbase = VtS_ + bh * (64 * 2048) + lane * 8;
    bf16x8 kf[4], vf[4];
    load_kfrag(kf, kv.kbase, qt); load_vfrag(vf, kv.vbase, qt);
    bf16x8 qf[4];
#pragma unroll
    for (int s = 0; s < 4; ++s) qf[s] = *(const bf16x8*)(qfb + s * 512 + lane * 8);
    f32x16 o0 = zero16(), o1 = zero16();
    float C = 1.f;
    vm_drain();
    for (int kt = qt; kt >= 0; --kt) {
        sb_tile(kf, vf, qf, kt, kt > 0 ? kt - 1 : 0, kv, tq, hi, C, o0, o1);
        if (__all(C == 0.f ? 1 : 0)) break;
    }
    store_o_lds(ot, r32, h, o0, o1, 1.f, hi);
}

DI void ce_desc(unsigned& a, unsigned& b) { const unsigned hi = a > b ? a : b, lo = a > b ? b : a; a = hi; b = lo; }
DI void bitonic_clean_desc(unsigned (&v)[16]) {
#pragma unroll
    for (int s = 8; s >= 1; s >>= 1)
#pragma unroll
        for (int i = 0; i < 16; ++i) if ((i & s) == 0) ce_desc(v[i], v[i + s]);
}
DI void sort16_desc(unsigned (&v)[16]) {
#pragma unroll
    for (int k = 2; k <= 16; k <<= 1)
#pragma unroll
        for (int j = k >> 1; j >= 1; j >>= 1)
#pragma unroll
            for (int i = 0; i < 16; ++i) { const int l = i ^ j; if (l > i) { if ((i & k) == 0) ce_desc(v[i], v[l]); else ce_desc(v[l], v[i]); } }
}
DI float key_value(unsigned key) { const unsigned kk = key & ~127u; const unsigned u = (kk & 0x80000000u) ? (kk & 0x7fffffffu) : ~kk; return __builtin_bit_cast(float, u); }
DI float key_value8(unsigned key) { const unsigned kk = key & ~255u; const unsigned u = (kk & 0x80000000u) ? (kk & 0x7fffffffu) : ~kk; return __builtin_bit_cast(float, u); }
template <int CTRL> DI unsigned dppu(unsigned v) { return (unsigned)__builtin_amdgcn_update_dpp(0, (int)v, CTRL, 0xF, 0xF, true); }
DI void sort8_desc(unsigned (&v)[8]) {
    ce_desc(v[0], v[2]); ce_desc(v[1], v[3]); ce_desc(v[4], v[6]); ce_desc(v[5], v[7]);
    ce_desc(v[0], v[4]); ce_desc(v[1], v[5]); ce_desc(v[2], v[6]); ce_desc(v[3], v[7]);
    ce_desc(v[0], v[1]); ce_desc(v[2], v[3]); ce_desc(v[4], v[5]); ce_desc(v[6], v[7]);
    ce_desc(v[2], v[4]); ce_desc(v[3], v[5]);
    ce_desc(v[1], v[4]); ce_desc(v[3], v[6]);
    ce_desc(v[1], v[2]); ce_desc(v[3], v[4]); ce_desc(v[5], v[6]);
}
DI void clean8_desc(unsigned (&v)[8]) {
#pragma unroll
    for (int s = 4; s >= 1; s >>= 1)
#pragma unroll
        for (int i = 0; i < 8; ++i) if ((i & s) == 0) ce_desc(v[i], v[i + s]);
}
template <int CTRL> DI void cross_rev_max(unsigned (&v)[8]) {
    unsigned t[8];
#pragma unroll
    for (int i = 0; i < 8; ++i) t[i] = dppu<CTRL>(v[7 - i]);
#pragma unroll
    for (int i = 0; i < 8; ++i) v[i] = v[i] > t[i] ? v[i] : t[i];
}
template <bool REV> DI void cross_minmax_x1(unsigned (&v)[8], bool odd) {
    unsigned t[8];
#pragma unroll
    for (int i = 0; i < 8; ++i) t[i] = dppu<DPP_XOR1>(v[REV ? 7 - i : i]);
#pragma unroll
    for (int i = 0; i < 8; ++i) { const unsigned hi = v[i] > t[i] ? v[i] : t[i], lo = v[i] > t[i] ? t[i] : v[i]; v[i] = odd ? lo : hi; }
}

DI float reduce16(const float (&p)[16], int lane) {
    const bool b3 = lane & 8, b2 = lane & 4, b1 = lane & 2, b0 = lane & 1;
    float q[8], r[4], s[2];
#pragma unroll
    for (int i = 0; i < 8; ++i) { const float mine = b3 ? p[i + 8] : p[i], send = b3 ? p[i] : p[i + 8]; q[i] = mine + __shfl_xor(send, 8); }
#pragma unroll
    for (int i = 0; i < 4; ++i) { const float mine = b2 ? q[i + 4] : q[i], send = b2 ? q[i] : q[i + 4]; r[i] = mine + __shfl_xor(send, 4); }
#pragma unroll
    for (int i = 0; i < 2; ++i) { const float mine = b1 ? r[i + 2] : r[i], send = b1 ? r[i] : r[i + 2]; s[i] = mine + __shfl_xor(send, 2); }
    const float mine = b0 ? s[1] : s[0], send = b0 ? s[0] : s[1];
    float t = mine + __shfl_xor(send, 1);
    t = sum_x32(sum_x16(t));
    return t;
}

#ifndef PEER_REP_TOPK
#define PEER_REP_TOPK 1
#endif
#ifndef PEER_REP_U
#define PEER_REP_U 1
#endif
#ifndef PEER_REP_V
#define PEER_REP_V 1
#endif
struct TopkIn { bf16x8 hv[2]; bf16x8 sv[4]; };
DI void peer_topk_load(TopkIn& in, int tok, const bf16_t* h1b, const bf16_t* scores, int lane) {
    const int tc = tok < T ? tok : T - 1;
    const bf16_t* hrow = h1b + (size_t)tc * 1024 + 16 * lane;
    const bf16_t* sp = scores + (size_t)tc * 2048 + (lane >> 2) * 128 + (lane & 3) * 8;
#pragma unroll
    for (int i = 0; i < 4; ++i) in.sv[i] = *(const bf16x8*)(sp + 32 * i);
    in.hv[0] = *(const bf16x8*)hrow; in.hv[1] = *(const bf16x8*)(hrow + 8);
}
DI void peer_topk_token(int tok, const TopkIn& in, const float* gffn, int* EIDXg, float* GATEg, unsigned char* XN2g, LAS float* wl, int lane) {
    LAS unsigned* kbuf = (LAS unsigned*)wl; const LAS unsigned* ctab = (const LAS unsigned*)(wl + 768);
    f32x4 hv[4];
    float ss = 0.f;
#pragma unroll
    for (int i = 0; i < 4; ++i) { const bf16x8 hb = in.hv[i >> 1]; const int o4 = 4 * (i & 1); hv[i] = (f32x4){bf2f(hb[o4]), bf2f(hb[o4 + 1]), bf2f(hb[o4 + 2]), bf2f(hb[o4 + 3])}; ss += (hv[i].x * hv[i].x + hv[i].y * hv[i].y) + (hv[i].z * hv[i].z + hv[i].w * hv[i].w); }
    ss = wave_sum(ss);
    const float rs2 = rsqrtf(ss * (1.f / 1024.f) + EPS);
    {
        u32x4 w;
#pragma unroll
        for (int i = 0; i < 4; ++i) { const f32x4 gv = *(const f32x4*)(gffn + 16 * lane + 4 * i);
            const float y0 = fminf(fmaxf(hv[i][0] * rs2 * gv[0] * 64.f, -448.f), 448.f), y1 = fminf(fmaxf(hv[i][1] * rs2 * gv[1] * 64.f, -448.f), 448.f);
            const float y2 = fminf(fmaxf(hv[i][2] * rs2 * gv[2] * 64.f, -448.f), 448.f), y3 = fminf(fmaxf(hv[i][3] * rs2 * gv[3] * 64.f, -448.f), 448.f);
            int p = 0;
            p = __builtin_amdgcn_cvt_pk_fp8_f32(y0, y1, p, false);
            p = __builtin_amdgcn_cvt_pk_fp8_f32(y2, y3, p, true);
            w[i] = (unsigned)p; }
        *(u32x4*)(XN2g + (size_t)tok * 1024 + 16 * lane) = w;
    }
    {
        const int L = lane >> 2, q = lane & 3;
        unsigned k0[16], k1[16];
#pragma unroll
        for (int i = 0; i < 4; ++i) {
            const bf16x8 v = in.sv[i];
#pragma unroll
            for (int cI = 0; cI < 8; ++cI) {
                const unsigned u = ((unsigned)(unsigned short)v[cI]) << 16;
                const unsigned mono = (u & 0x80000000u) ? ~u : (u | 0x80000000u);
                const unsigned key = (mono & ~127u) | (unsigned)(127 - (32 * i + 8 * q + cI));
                if (i < 2) k0[8 * i + cI] = key; else k1[8 * (i - 2) + cI] = key;
            }
        }
        sort16_desc(k0); sort16_desc(k1);
        unsigned t[16];
#pragma unroll
        for (int i = 0; i < 16; ++i) t[i] = k0[i] > k1[15 - i] ? k0[i] : k1[15 - i];
        bitonic_clean_desc(t);
#pragma unroll
        for (int i = 0; i < 16; ++i) k0[i] = (unsigned)__builtin_amdgcn_update_dpp(0, (int)t[15 - i], 0xB1, 0xF, 0xF, true);
#pragma unroll
        for (int i = 0; i < 16; ++i) t[i] = t[i] > k0[i] ? t[i] : k0[i];
        bitonic_clean_desc(t);
#pragma unroll
        for (int i = 0; i < 16; ++i) k0[i] = (unsigned)__builtin_amdgcn_update_dpp(0, (int)t[15 - i], 0x4E, 0xF, 0xF, true);
#pragma unroll
        for (int i = 0; i < 16; ++i) t[i] = t[i] > k0[i] ? t[i] : k0[i];
        bitonic_clean_desc(t);
        if (q == 0) {
#pragma unroll
            for (int i = 0; i < 4; ++i) { u32x4 w; w.x = t[4 * i]; w.y = t[4 * i + 1]; w.z = t[4 * i + 2]; w.w = t[4 * i + 3]; *(LAS u32x4*)(kbuf + L * 16 + 4 * i) = w; }
        }
        asm volatile("s_waitcnt lgkmcnt(0)" ::: "memory");
    }
    {
        const int hd = lane >> 3, sub = lane & 7; const bool odd = sub & 1;
        unsigned ck[8];
#pragma unroll
        for (int k = 0; k < 7; ++k) {
            const int cidx = 7 * sub + k;
            const unsigned tab = ctab[cidx];
            const unsigned ia = tab & 15u, ib = (tab >> 8) & 15u;
            const unsigned ka = kbuf[hd * 32 + ia], kb = kbuf[hd * 32 + 16 + ib];
            const float v = key_value(ka) + key_value(kb);
            const unsigned u = __float_as_uint(v);
            const unsigned mono = (u & 0x80000000u) ? ~u : (u | 0x80000000u);
            ck[k] = (cidx < 50) ? ((mono & ~255u) | (255u - (16u * ia + ib))) : 0u;
        }
        ck[7] = 0u;
        sort8_desc(ck);
        cross_minmax_x1<true>(ck, odd); clean8_desc(ck);
        cross_rev_max<0x1B>(ck); cross_minmax_x1<false>(ck, odd); clean8_desc(ck);
        cross_rev_max<DPP_HMIR>(ck); cross_minmax_x1<false>(ck, odd); clean8_desc(ck);
        const int pr = sub >> 1;
        const unsigned e0 = pr == 0 ? ck[0] : pr == 1 ? ck[2] : pr == 2 ? ck[4] : ck[6];
        const unsigned e1 = pr == 0 ? ck[1] : pr == 1 ? ck[3] : pr == 2 ? ck[5] : ck[7];
        const unsigned id0 = 255u - (e0 & 255u), id1 = 255u - (e1 & 255u);
        const unsigned ka0 = kbuf[hd * 32 + (id0 >> 4)], kb0 = kbuf[hd * 32 + 16 + (id0 & 15u)];
        const unsigned ka1 = kbuf[hd * 32 + (id1 >> 4)], kb1 = kbuf[hd * 32 + 16 + (id1 & 15u)];
        const float v0 = key_value8(e0), v1 = key_value8(e1);
        const float mx = max_oct(fmaxf(v0, v1));
        const float ev0 = __expf((v0 - mx) * rs2), ev1 = __expf((v1 - mx) * rs2);
        const float inv = 1.f / sum_oct(ev0 + ev1);
        const int rank0 = (odd ? 8 : 0) + 2 * pr;
        u32x2 ew; ew.x = (127u - (ka0 & 127u)) * 128u + (127u - (kb0 & 127u)); ew.y = (127u - (ka1 & 127u)) * 128u + (127u - (kb1 & 127u));
        f32x2 gw; gw.x = ev0 * inv; gw.y = ev1 * inv;
        *(u32x2*)(EIDXg + (size_t)tok * 128 + hd * 16 + rank0) = ew;
        *(f32x2*)(GATEg + (size_t)tok * 128 + hd * 16 + rank0) = gw;
    }
}

DI float dot16_fp8(const u32x4& row, const float (&x)[16]) {
    float sacc = 0.f;
#pragma unroll
    for (int w = 0; w < 4; ++w) { const f32x2 lo = __builtin_amdgcn_cvt_pk_f32_fp8((int)row[w], false), hi2 = __builtin_amdgcn_cvt_pk_f32_fp8((int)row[w], true);
        sacc += lo.x * x[4 * w] + lo.y * x[4 * w + 1] + hi2.x * x[4 * w + 2] + hi2.y * x[4 * w + 3]; }
    return sacc;
}
template <class TT> DI TT ldu(const void* ubase, unsigned off) { return *(const TT*)((const char*)ubase + off); }
typedef _Float16 h2_t __attribute__((ext_vector_type(2)));
DI void peer_u_slice(int sl, int tk_first, int tk_step, const unsigned char* XN8g, const int* EIDXg, const unsigned char* U8s, bf16_t* PDOT, int lane) {
    const int es = lane >> 3, c = lane & 7;
    const unsigned char* tb = U8s + (size_t)sl * 16384 * 128;
    const unsigned c16 = 16u * c, eoff = 64u * es, xoff = 128u * sl + 16u * c, poff = (16u * es + c) * 2u;
    const bool b2 = c & 4, b1 = c & 2, b0 = c & 1;
    u32x4 I0[2], I1[2], I2[2], rowsA[8], rowsB[8], rowsC[8], x0, x1, x2;
#define LD_E8(ib, tk, h) do { const int _t = (tk) < T ? (tk) : T - 1; const int* _eb = EIDXg + (size_t)_t * 128 + 8 * (h); ib[0] = ldu<u32x4>(_eb, eoff); ib[1] = ldu<u32x4>(_eb, eoff + 16u); } while (0)
#define LD_R8(rows, ib, tbl) do { _Pragma("unroll") for (int _q = 0; _q < 2; ++_q) _Pragma("unroll") for (int _r = 0; _r < 4; ++_r) rows[4 * _q + _r] = ldu<u32x4>(tbl, ib[_q][_r] * 128u + c16); } while (0)
#define LD_X(xx, tk) do { const int _t = (tk) < T ? (tk) : T - 1; xx = ldu<u32x4>(XN8g + (size_t)_t * 1024, xoff); } while (0)
#define U_COMPUTE8(rows, xx, tk, h) do { h2_t _x[8]; _Pragma("unroll") for (int _w = 0; _w < 4; ++_w) { _x[2 * _w] = __builtin_amdgcn_cvt_scalef32_pk_f16_fp8(xx[_w], 1.0f, false); _x[2 * _w + 1] = __builtin_amdgcn_cvt_scalef32_pk_f16_fp8(xx[_w], 1.0f, true); } \
        float _p[8]; _Pragma("unroll") for (int _i = 0; _i < 8; ++_i) { if (_i > 0) asm volatile("" : "+v"(rows[_i]) : "v"(_p[_i - 1])); float _s = 0.f; \
            _Pragma("unroll") for (int _w = 0; _w < 4; ++_w) { _s = __builtin_amdgcn_fdot2(__builtin_amdgcn_cvt_scalef32_pk_f16_fp8(rows[_i][_w], 1.0f, false), _x[2 * _w], _s, false); \
                _s = __builtin_amdgcn_fdot2(__builtin_amdgcn_cvt_scalef32_pk_f16_fp8(rows[_i][_w], 1.0f, true), _x[2 * _w + 1], _s, false); } _p[_i] = _s; } \
        float _q4[4], _q2[2]; \
        _Pragma("unroll") for (int _k = 0; _k < 4; ++_k) _q4[_k] = tr_x4(_p[_k], _p[_k + 4], b2); \
        _Pragma("unroll") for (int _k = 0; _k < 2; ++_k) _q2[_k] = tr_x2(_q4[_k], _q4[_k + 2], b1); \
        const float _r1 = tr_x1(_q2[0], _q2[1], b0); \
        if ((tk) < T) { bf16_t* _pb = PDOT + ((size_t)sl * T + (tk)) * 128 + 8 * (h); *(bf16_t*)((char*)_pb + poff) = f2bf(_r1); } } while (0)
    int t0 = tk_first;
    LD_E8(I0, t0, 0); LD_E8(I1, t0, 1); LD_E8(I2, t0 + tk_step, 0); LD_X(x0, t0); LD_R8(rowsA, I0, tb); LD_R8(rowsB, I1, tb);
#pragma unroll 1
    for (; t0 < T; t0 += 3 * tk_step) {
        const int t1 = t0 + tk_step, t2 = t1 + tk_step, t3 = t2 + tk_step;
        LD_E8(I0, t1, 1);           LD_R8(rowsC, I2, tb); LD_X(x1, t1); U_COMPUTE8(rowsA, x0, t0, 0);
        LD_E8(I1, t2, 0);           LD_R8(rowsA, I0, tb);               U_COMPUTE8(rowsB, x0, t0, 1);
        LD_E8(I2, t2, 1);           LD_R8(rowsB, I1, tb); LD_X(x2, t2); U_COMPUTE8(rowsC, x1, t1, 0);
        LD_E8(I0, t3, 0);           LD_R8(rowsC, I2, tb);               U_COMPUTE8(rowsA, x1, t1, 1);
        LD_E8(I1, t3, 1);           LD_R8(rowsA, I0, tb); LD_X(x0, t3); U_COMPUTE8(rowsB, x2, t2, 0);
        LD_E8(I2, t3 + tk_step, 0); LD_R8(rowsB, I1, tb);               U_COMPUTE8(rowsC, x2, t2, 1);
    }
#undef U_COMPUTE8
#undef LD_X
}
DI float erf_as(float x) {
    const float ax = fabsf(x), t = __builtin_amdgcn_rcpf(1.f + 0.3275911f * ax);
    const float poly = t * (0.254829592f + t * (-0.284496736f + t * (1.421413741f + t * (-1.453152027f + t * 1.061405429f))));
    const float r = 1.f - poly * __expf(-ax * ax);
    return copysignf(r, x);
}
template <int NT> DI void peer_cj_tokens(int tok0, int tstride, const int* EIDXg, const float* GATEg, const bf16_t* PDOT, const float* usc, const float* vsc, float* CJg, float* CMAXg, int lane) {
    int e[NT][2]; float d[NT][2], g[NT][2];
#pragma unroll
    for (int i = 0; i < NT; ++i) { const int tok = tok0 + i * tstride, tc = tok < T ? tok : T - 1;
#pragma unroll
        for (int hh = 0; hh < 2; ++hh) { const int j = lane + 64 * hh; e[i][hh] = EIDXg[(size_t)tc * 128 + j]; g[i][hh] = GATEg[(size_t)tc * 128 + j]; float a = 0.f;
#pragma unroll
            for (int x = 0; x < 8; ++x) a += bf2f((short)PDOT[((size_t)x * T + tc) * 128 + j]);
            d[i][hh] = a; } }
    float us[NT][2], vs[NT][2];
#pragma unroll
    for (int i = 0; i < NT; ++i)
#pragma unroll
        for (int hh = 0; hh < 2; ++hh) { us[i][hh] = usc[e[i][hh]]; vs[i][hh] = vsc[e[i][hh]]; }
#pragma unroll
    for (int i = 0; i < NT; ++i) { const int tok = tok0 + i * tstride;
        float cv[2], cm = 0.f;
#pragma unroll
        for (int hh = 0; hh < 2; ++hh) {
            const float hraw = d[i][hh] * us[i][hh] * (1.f / 64.f);
            const float hid = 0.5f * hraw * (1.f + erf_as(hraw * 0.70710678118654752f));
            cv[hh] = hid * g[i][hh] * vs[i][hh];
            cm = fmaxf(cm, fabsf(cv[hh]));
        }
        cm = wave_max(cm);
        const float inv = cm > 0.f ? 1.f / cm : 0.f;
        if (tok < T) { CJg[(size_t)tok * 128 + lane] = cv[0] * inv; CJg[(size_t)tok * 128 + 64 + lane] = cv[1] * inv; if (lane == 0) CMAXg[tok] = cm; }
    }
}
DI void peer_v_slice(int sl, int tk_first, int tk_step, const bf16_t* H1b, const int* EIDXg, const float* CJg, const float* CMAXg, const unsigned char* V8s, bf16_t* A4g, float* SSQg, int lane) {
    const int es = lane >> 3, c = lane & 7;
    const unsigned char* tb = V8s + (size_t)sl * 16384 * 128;
    const unsigned c16 = 16u * c, eoff = 64u * es, ob = 128u * sl + 16u * c + 2u * es;
    const bool b5 = lane & 32, b4 = lane & 16, b3 = lane & 8;
    u32x4 I0[2], I1[2], I2[2], rowsA[8], rowsB[8], rowsC[8]; f32x4 cA[2], cB[2], cC[2]; unsigned h0, h1, h2;
#define LD_C8(cc, tk, h) do { const int _t = (tk) < T ? (tk) : T - 1; const float* _cb = CJg + (size_t)_t * 128 + 8 * (h); cc[0] = ldu<f32x4>(_cb, eoff); cc[1] = ldu<f32x4>(_cb, eoff + 16u); } while (0)
#define V_AXPY8(rows, cc) do { _Pragma("unroll") for (int _q = 0; _q < 2; ++_q) _Pragma("unroll") for (int _r = 0; _r < 4; ++_r) { const _Float16 _ch = (_Float16)cc[_q][_r]; const h2_t _c2 = {_ch, _ch}; \
            _Pragma("unroll") for (int _w = 0; _w < 4; ++_w) { acch[2 * _w] = __builtin_amdgcn_cvt_scalef32_pk_f16_fp8(rows[4 * _q + _r][_w], 1.0f, false) * _c2 + acch[2 * _w]; \
                acch[2 * _w + 1] = __builtin_amdgcn_cvt_scalef32_pk_f16_fp8(rows[4 * _q + _r][_w], 1.0f, true) * _c2 + acch[2 * _w + 1]; } \
              \
            if (4 * _q + _r < 7) asm volatile("" : "+v"(acch[0]), "+v"(acch[1]), "+v"(acch[2]), "+v"(acch[3]), "+v"(acch[4]), "+v"(acch[5]), "+v"(acch[6]), "+v"(acch[7]), "+v"(rows[(4 * _q + _r + 1) & 7])); \
            else asm volatile("" : "+v"(acch[0]), "+v"(acch[1]), "+v"(acch[2]), "+v"(acch[3]), "+v"(acch[4]), "+v"(acch[5]), "+v"(acch[6]), "+v"(acch[7])); } } while (0)
#define LD_H(hh, tk) do { const int _t = (tk) < T ? (tk) : T - 1; hh = ldu<unsigned>(H1b + (size_t)_t * 1024, ob * 2u); } while (0)
#define V_ZERO() do { _Pragma("unroll") for (int _i = 0; _i < 8; ++_i) acch[_i] = (h2_t){(_Float16)0.f, (_Float16)0.f}; } while (0)
#define V_FINAL(hh, tk) do { float _a[16]; _Pragma("unroll") for (int _i = 0; _i < 8; ++_i) { _a[2 * _i] = (float)acch[_i].x; _a[2 * _i + 1] = (float)acch[_i].y; } \
        const float _cm = CMAXg[(tk) < T ? (tk) : T - 1]; \
        float _q8[8], _q4[4], _q2[2]; \
        _Pragma("unroll") for (int _k = 0; _k < 8; ++_k) _q8[_k] = tr_x32(_a[_k], _a[_k + 8]); \
        _Pragma("unroll") for (int _k = 0; _k < 4; ++_k) _q4[_k] = tr_x16(_q8[_k], _q8[_k + 4]); \
        _Pragma("unroll") for (int _k = 0; _k < 2; ++_k) _q2[_k] = tr_x8(_q4[_k], _q4[_k + 2], b3); \
        const float _ha = __builtin_bit_cast(float, hh << 16) + _q2[0] * _cm, _hb = __builtin_bit_cast(float, hh & 0xffff0000u) + _q2[1] * _cm; const float _ssq = wave_sum(_ha * _ha + _hb * _hb); \
        if ((tk) < T) { *(unsigned*)((char*)(A4g + (size_t)(tk) * 1024) + ob * 2u) = cvtpk(_ha, _hb); \
            if (lane == 0) SSQg[(size_t)sl * T + (tk)] = _ssq; } } while (0)
    h2_t acch[8];
    int t0 = tk_first;
    LD_E8(I0, t0, 0); LD_E8(I1, t0, 1); LD_E8(I2, t0 + tk_step, 0); LD_H(h0, t0); LD_R8(rowsA, I0, tb); LD_C8(cA, t0, 0); LD_R8(rowsB, I1, tb); LD_C8(cB, t0, 1);
#pragma unroll 1
    for (; t0 < T; t0 += 3 * tk_step) {
        const int t1 = t0 + tk_step, t2 = t1 + tk_step, t3 = t2 + tk_step;
        LD_E8(I0, t1, 1);           LD_R8(rowsC, I2, tb); LD_C8(cC, t1, 0); LD_H(h1, t1); V_ZERO(); V_AXPY8(rowsA, cA);
        LD_E8(I1, t2, 0);           LD_R8(rowsA, I0, tb); LD_C8(cA, t1, 1);                          V_AXPY8(rowsB, cB); V_FINAL(h0, t0);
        LD_E8(I2, t2, 1);           LD_R8(rowsB, I1, tb); LD_C8(cB, t2, 0); LD_H(h2, t2); V_ZERO(); V_AXPY8(rowsC, cC);
        LD_E8(I0, t3, 0);           LD_R8(rowsC, I2, tb); LD_C8(cC, t2, 1);                          V_AXPY8(rowsA, cA); V_FINAL(h1, t1);
        LD_E8(I1, t3, 1);           LD_R8(rowsA, I0, tb); LD_C8(cA, t3, 0); LD_H(h0, t3); V_ZERO(); V_AXPY8(rowsB, cB);
        LD_E8(I2, t3 + tk_step, 0); LD_R8(rowsB, I1, tb); LD_C8(cB, t3, 1);                          V_AXPY8(rowsC, cC); V_FINAL(h2, t2);
    }
#undef V_FINAL
#undef V_ZERO
#undef LD_H
#undef V_AXPY8
#undef LD_C8
#undef LD_R8
#undef LD_E8
}

typedef const __attribute__((address_space(4))) unsigned long long* karg_ptr_t;
DI karg_ptr_t kargs() { karg_ptr_t p = (karg_ptr_t)__builtin_amdgcn_kernarg_segment_ptr(); asm volatile("" : "+s"(p)); return p; }
#define GAS1 __attribute__((address_space(1)))
#define KIN(k) ((const float*)(const GAS1 float*)kargs()[k])
#define KOUT() ((float*)(GAS1 float*)kargs()[18])
#define KWS() ((unsigned char*)(GAS1 unsigned char*)kargs()[19])

__global__ void __launch_bounds__(512, 2) fwd_kernel(Params P) {
    extern __shared__ __attribute__((aligned(16))) unsigned char lds_raw[];
    LAS unsigned char* lds = (LAS unsigned char*)lds_raw;
    const int tid = threadIdx.x, lane = tid & 63, wid = __builtin_amdgcn_readfirstlane(tid >> 6);
    const int wg = blockIdx.x, nwg = gridDim.x;
    const int gwave = wg * 8 + wid, nwaves = nwg * 8;
    const int lo = P.ph_lo, hi = P.ph_hi;

    volatile LAS unsigned* misc = (volatile LAS unsigned*)(lds + LDS_BYTES - 64);
    if (tid < 16) misc[tid] = 0u;
    __syncthreads();
    { unsigned* xcw = (unsigned*)(KWS() + WS_CTL) + CW_XC;
      if (tid == 0) { const unsigned xcc = xb_xcc_id(); misc[5] = xcc; misc[4] = xb_add(xcw + 64 * xcc, 1u); } }
    XcdBarrier bar; bar.bar = (unsigned*)(KWS() + WS_CTL) + CW_BAR; bar.x = 0; bar.st = misc;
    if (hi - lo > 1) bar = xcd_barrier_post((unsigned*)(KWS() + WS_CTL) + CW_BAR, misc);

#define kmean   ((float*)(KWS() + WS_KMEAN))
#define biasTab ((float*)(KWS() + WS_BIAS))
#define WinT    ((bf16_t*)(KWS() + WS_WIN))
#define WoutT   ((bf16_t*)(KWS() + WS_WOUT))
#define WqT     ((bf16_t*)(KWS() + WS_WQ))
#define WgT     ((bf16_t*)(KWS() + WS_WG))
#define WpleT   ((bf16_t*)(KWS() + WS_WPLE))
#define U8      ((unsigned char*)(KWS() + WS_U))
#define V8      ((unsigned char*)(KWS() + WS_V))
#define USC     ((float*)(KWS() + WS_USC))
#define VSC     ((float*)(KWS() + WS_VSC))
#define XN      ((bf16_t*)(KWS() + WS_XN))
#define PB      ((bf16_t*)(KWS() + WS_PB))
#define Qm      ((bf16_t*)(KWS() + WS_QM))
#define Km      ((bf16_t*)(KWS() + WS_KM))
#define VtM     ((bf16_t*)(KWS() + WS_VTM))
#define Qs      ((bf16_t*)(KWS() + WS_QS))
#define Ks      ((bf16_t*)(KWS() + WS_KS))
#define VtS     ((bf16_t*)(KWS() + WS_VTS))
#define Oraw    ((bf16_t*)(KWS() + WS_ORAW))
#define A2      ((bf16_t*)(KWS() + WS_A2))
#define A3      ((bf16_t*)(KWS() + WS_A3))
#define SC      ((float*)(KWS() + WS_SC))
#define EIDXG   ((int*)(KWS() + WS_EIDX))
#define GATEG   ((float*)(KWS() + WS_GATE))
#define CJG     ((float*)(KWS() + WS_CJ))
#define RS2G    ((float*)(KWS() + WS_RS2))
#define SSQG    ((float*)(KWS() + WS_SSQ))
#define PDOTG   ((bf16_t*)(KWS() + WS_PDOT))
#define A4G     ((bf16_t*)(KWS() + WS_A4))
#define XN2G    ((unsigned char*)(KWS() + WS_XN2))

#define IN(k) (lo <= (k) && (k) < hi)
#ifndef PROBE_PHASE
#define PROBE_PHASE -1
#endif
#ifndef PROBE_REPS
#define PROBE_REPS 1
#endif
#define REP(k) for (int _rep = 0; _rep < ((k) == PROBE_PHASE ? PROBE_REPS : 1); ++_rep)
#define SEAM(k) do { if (IN(k) && IN((k) + 1)) { if ((k) == 0 || PROBE_LO_NONZERO) xcd_barrier<true>(bar); else xcd_barrier<false>(bar); } } while (0)
#define PROBE_LO_NONZERO 0

    if (IN(0)) REP(0) {
        {
            LAS float* scr = (LAS float*)lds + wid * (64 * 65);
            const float* win = KIN(IN_WIN); const float* wout = KIN(IN_WOUT); const float* wpg = KIN(IN_WPG); const float* wple = KIN(IN_WPLE); const float* pln = KIN(IN_PLE_NORM);
            bf16_t* wint = WinT; bf16_t* woutt = WoutT; bf16_t* wgt = WgT; bf16_t* wplet = WpleT;
            for (int t = gwave; t < 1344; t += nwaves) {
                const int sel = t < 768 ? 0 : t < 1024 ? 1 : t < 1280 ? 2 : 3;
                const int tt = sel == 0 ? t : sel == 1 ? t - 768 : sel == 2 ? t - 1024 : t - 1280;
                const float* W = sel == 0 ? win : sel == 1 ? wout : sel == 2 ? wpg : wple;
                bf16_t* Wt = sel == 0 ? wint : sel == 1 ? woutt : sel == 2 ? wgt : wplet;
                const int K = sel == 3 ? 256 : 1024, N = sel == 0 ? 3072 : 1024, tn = sel == 0 ? 48 : 16;
                p0_transpose_wave(W, K, N, Wt, scr, lane, (tt / tn) * 64, (tt % tn) * 64, sel == 0, sel == 2 ? pln : nullptr);
            }
        }
        p0_fold(KIN(IN_PQ), KIN(IN_SUBK), KIN(IN_FFN_NORM), WqT, wid, lane, wg, nwg);
        const size_t gtid = (size_t)wg * 512 + tid, nthr = (size_t)nwg * 512;
        p0_convert(KIN(IN_P), PB, (size_t)T * 256, gtid, nthr);
        { const float* xp = KIN(IN_X); const float* gp = KIN(IN_ATTN_NORM); bf16_t* xo = XN;
          for (int row = gwave; row < T; row += 2 * nwaves) rmsnorm_rows2_bf16(xp, gp, xo, row, row + nwaves, lane); }
        if (wg == 0) {
            for (int idx = tid; idx < 8 * 129; idx += 512) {
                const int h = idx / 129, dist = idx % 129;
                int bk;
                if (dist < 16) bk = dist;
                else { const float v = logf((float)dist / 16.f) / 2.0794415416798357f * 16.f; bk = 16 + (int)v; bk = bk > 31 ? 31 : bk; }
                biasTab[h * 132 + dist] = KIN(IN_RELB)[bk * 8 + h] * LOG2E;
            }
        }
    }
    SEAM(0);
    if (IN(1)) REP(1) {
        pg8::Gemm g{XN, WinT, T, NPROJ, 1024}; pg8::StaticOrder S; S.init(T, NPROJ, nwg, wg);
        EpiQKV E{Qm, KIN(IN_QNORM), KIN(IN_KNORM), kmean};
        pg8::gemm_phase<EpiQKV, pg8::StaticOrder, true, true>(lds, g, S, E);
    }
    SEAM(1);
    if (IN(3)) REP(3) {
        const bf16_t* qm_ = Qm; const bf16_t* km_ = Km; const bf16_t* vtm_ = VtM; const bf16_t* qs_ = Qs; const bf16_t* ks_ = Ks; const bf16_t* vts_ = VtS;
        const float* kmn_ = kmean; const float* bt_ = biasTab; bf16_t* a2_ = A2;
        const float* gm_ = KIN(IN_ONM); const float* gs_ = KIN(IN_ONS);
        LAS unsigned char* ot = lds;
        LAS float* biasLds = (LAS float*)(lds + 34816);
        for (int i = tid; i < 8 * 132; i += 512) biasLds[i] = bt_[i];
        __syncthreads();
        for (int u = gwave; u < 8192; u += nwaves) {
            const int grp = u >> 12, i = u & 4095;
            const int half = i >> 11, j = i & 2047;
            const int qt = half ? (j >> 6) : 63 - (j >> 6), bh = j & 63;
            const int b = bh >> 3, h = bh & 7;
            if (grp == 0) moba_unit(b, h, qt, qm_, km_, vtm_, kmn_, biasLds, ot, lane);
            else sb_unit(b, h, qt, qs_, ks_, vts_, ot, lane);
            __syncthreads();
            {
                const float* gg = grp ? gs_ : gm_;
                const f32x4 g0 = *(const f32x4*)(gg + 8 * lane), g1 = *(const f32x4*)(gg + 8 * lane + 4);
#pragma unroll
                for (int rr = 0; rr < 4; ++rr) {
                    const int row = 4 * wid + rr;
                    const bf16x8 v = *(const LAS bf16x8*)(ot + row * OT_PITCH + lane * 16);
                    float f[8], sq = 0.f;
#pragma unroll
                    for (int e = 0; e < 8; ++e) { f[e] = bf2f(v[e]); sq += f[e] * f[e]; }
                    sq = wave_sum(sq);
                    const float rs = rsqrtf(sq * (1.f / 512.f) + EPS);
                    u32x4 w; w.x = cvtpk(f[0] * rs * g0.x, f[1] * rs * g0.y); w.y = cvtpk(f[2] * rs * g0.z, f[3] * rs * g0.w);
                    w.z = cvtpk(f[4] * rs * g1.x, f[5] * rs * g1.y); w.w = cvtpk(f[6] * rs * g1.z, f[7] * rs * g1.w);
                    *(u32x4*)(a2_ + (size_t)(b * 2048 + qt * 32 + row) * 1024 + grp * 512 + 8 * lane) = w;
                }
            }
            __syncthreads();
        }
    }
    SEAM(3);
    if (IN(5)) REP(5) {
        pg8::Gemm g{A2, WoutT, T, 1024, 1024}; pg8::StaticOrder S; S.init(T, 1024, nwg, wg);
        EpiRes E{KIN(IN_X), A3};
        pg8::gemm_phase<EpiRes, pg8::StaticOrder, true, true>(lds, g, S, E);
    }
    SEAM(5);
    if (IN(6)) REP(6) {
        pg8::Gemm g{A3, WqT, T, 2048, 1024}; pg8::StaticOrder S; S.init(T, 2048, nwg, wg);
        EpiBf E{(bf16_t*)SC, 2048};
        pg8::gemm_phase<EpiBf, pg8::StaticOrder, true, true>(lds, g, S, E);
    }
    SEAM(6);
    if (IN(7)) REP(7) {
        LAS float* wl = (LAS float*)(lds + wid * 4096);
        {
            const int c = lane; int ca, cb;
            if (c < 16) { ca = 0; cb = c; } else if (c < 24) { ca = 1; cb = c - 16; } else if (c < 29) { ca = 2; cb = c - 24; } else if (c < 33) { ca = 3; cb = c - 29; }
            else if (c < 36) { ca = 4; cb = c - 33; } else if (c < 42) { ca = 5 + ((c - 36) >> 1); cb = (c - 36) & 1; } else { ca = (c - 34) & 15; cb = 0; }
            ((LAS unsigned*)(wl + 768))[lane] = (unsigned)ca | ((unsigned)cb << 8);
            asm volatile("s_waitcnt lgkmcnt(0)" ::: "memory");
        }
        const bf16_t* h1p = A3; const bf16_t* scp = (const bf16_t*)SC; const float* gfp = KIN(IN_FFN_NORM); int* eip = EIDXG; float* gtp = GATEG; unsigned char* xnp = XN2G;
        TopkIn inA, inB;
        peer_topk_load(inA, gwave, h1p, scp, lane);
        const float* pu = KIN(IN_PU); const float* pv = KIN(IN_PV); unsigned char* u8 = U8; unsigned char* v8 = V8; float* usc_ = USC; float* vsc_ = VSC;
        static_assert(T == 16384, "one expert row per token step");
#pragma unroll 1
        for (int tok = gwave; tok < T; tok += nwaves) {
            f32x4 qa[2][4];
            peer_topk_load(inB, tok + nwaves, h1p, scp, lane);
            p0_quant_issue2(qa, pu, pv, tok, lane); MEM_FENCE();
            peer_topk_token(tok, inA, gfp, eip, gtp, xnp, wl, lane);
            p0_quant_finish(qa[0], u8, usc_, tok, lane); p0_quant_finish(qa[1], v8, vsc_, tok, lane);
            inA = inB;
        }
    }
    SEAM(7);
    int sl_first = 0, sl_step = 1, tk_first = 0, tk_step = 8;
    if (IN(8) || IN(10)) {
        __syncthreads();
        const unsigned myx = misc[5], myrank = misc[4];
        unsigned nx = 0, myidx = 0, nloc = 1;
        unsigned* xc = (unsigned*)(KWS() + WS_CTL) + CW_XC;
#pragma unroll
        for (unsigned j = 0; j < 16; ++j) { const unsigned cj = xb_ld(xc + 64 * j); if (cj > 0u) { if (j < myx) ++myidx; ++nx; } if (j == myx) nloc = cj; }
        sl_first = __builtin_amdgcn_readfirstlane((int)myidx); sl_step = __builtin_amdgcn_readfirstlane((int)(nx > 0u ? nx : 1u));
        tk_first = __builtin_amdgcn_readfirstlane((int)myrank * 8 + wid); tk_step = __builtin_amdgcn_readfirstlane((int)(nloc > 0u ? nloc : 1u) * 8);
    }
    if (IN(8)) REP(8) {
        const unsigned char* xnp = XN2G; const int* eip = EIDXG; const unsigned char* u8p = U8; bf16_t* pdp = PDOTG;
        for (int sl = sl_first; sl < 8; sl += sl_step) peer_u_slice(sl, tk_first, tk_step, xnp, eip, u8p, pdp, lane);
    }
    SEAM(8);
    if (IN(9)) REP(9) {
        const int* eip = EIDXG; const float* gtp = GATEG; const bf16_t* pdp = PDOTG; const float* usp = USC; const float* vsp = VSC; float* cjp = CJG; float* cmp_ = RS2G;
        for (int tok = gwave; tok < T; tok += 8 * nwaves) peer_cj_tokens<8>(tok, nwaves, eip, gtp, pdp, usp, vsp, cjp, cmp_, lane);
    }
    SEAM(9);
    if (IN(10)) REP(10) {
        const bf16_t* outp = A3; const int* eip = EIDXG; const float* cjp = CJG; const float* cmp_ = RS2G; const unsigned char* v8p = V8; bf16_t* a4p = A4G; float* sqp = SSQG;
        for (int sl = sl_first; sl < 8; sl += sl_step) peer_v_slice(sl, tk_first, tk_step, outp, eip, cjp, cmp_, v8p, a4p, sqp, lane);
    }
    SEAM(10);
    if (IN(11)) REP(11) {
        bf16_t* PW = Oraw;
        { int kple = 256; asm volatile("" : "+s"(kple));
          pg8::Gemm g{PB, WpleT, T, 1024, kple}; pg8::StaticOrder S; S.init(T, 1024, nwg, wg);
          EpiBf E{PW, 1024};
          pg8::gemm_phase<EpiBf, pg8::StaticOrder, true, true>(lds, g, S, E); }
        asm volatile("s_waitcnt vmcnt(0)" ::: "memory");
        __syncthreads();
        { pg8::Gemm g{A4G, WgT, T, 1024, 1024}; pg8::StaticOrder S; S.init(T, 1024, nwg, wg);
          EpiGate E{KOUT(), PW, SSQG, A4G};
          pg8::gemm_phase<EpiGate, pg8::StaticOrder, true, true>(lds, g, S, E); }
    }
#undef IN
#undef SEAM
}

extern "C" void kernel_launch(void* const* d_in, const int* in_sizes, int n_in, void* d_out, int out_size, void* d_ws, size_t ws_size, hipStream_t stream) {
    static int grid = 0;
    if (grid == 0) {
        if (n_in != 18 || out_size != T * DM || ws_size < WS_END) { fprintf(stderr, "kernel_launch: unexpected shapes (n_in %d out %d ws %zu)\n", n_in, out_size, ws_size); grid = -1; return; }
        int dev = 0, cus = 0, per_cu = 0;
        if (hipGetDevice(&dev) != hipSuccess || hipDeviceGetAttribute(&cus, hipDeviceAttributeMultiprocessorCount, dev) != hipSuccess) { grid = -1; return; }
        if (hipFuncSetAttribute((const void*)fwd_kernel, hipFuncAttributeMaxDynamicSharedMemorySize, LDS_BYTES) != hipSuccess) { fprintf(stderr, "kernel_launch: hipFuncSetAttribute failed\n"); grid = -1; return; }
        if (hipOccupancyMaxActiveBlocksPerMultiprocessor(&per_cu, (const void*)fwd_kernel, 512, LDS_BYTES) != hipSuccess || per_cu < 1)
            fprintf(stderr, "kernel_launch: note: occupancy query reports %d\n", per_cu);
        (void)hipGetLastError();
        grid = cus - (cus % 8);
    }
    if (grid < 0) return;
    if (hipMemsetAsync((char*)d_ws + WS_CTL, 0, CTL_ZERO_BYTES, stream) != hipSuccess) return;
    Params p{};
    for (int i = 0; i < 18; ++i) p.in[i] = (const float*)d_in[i];
    p.out = (float*)d_out; p.ws = (unsigned char*)d_ws;
    p.ph_lo = 0; p.ph_hi = NPHASE;
    hipLaunchKernelGGL(fwd_kernel, dim3(grid), dim3(512), LDS_BYTES, stream, p);
}
```

```cpp
#include <hip/hip_runtime.h>
#include <stdint.h>
#include <stdio.h>

#ifndef N_LAUNCHES
#define N_LAUNCHES 1
#endif

#define DI __device__ __forceinline__
#define LAS __attribute__((address_space(3)))

typedef unsigned short bf16_t;
typedef short bf16x8 __attribute__((ext_vector_type(8)));
typedef float f32x16 __attribute__((ext_vector_type(16)));
typedef float f32x4 __attribute__((ext_vector_type(4)));
typedef float f32x2 __attribute__((ext_vector_type(2)));
typedef unsigned u32x4 __attribute__((ext_vector_type(4)));
typedef unsigned u32x2 __attribute__((ext_vector_type(2)));
typedef __bf16 bf16x2_t __attribute__((ext_vector_type(2)));

constexpr int BATCH = 8, SEQ = 2048, DM = 1024, T = BATCH * SEQ;
constexpr int NPROJ = 3072;
constexpr float EPS = 1e-6f;
constexpr float LOG2E = 1.4426950408889634f;
constexpr float SCL2 = 0.125f * LOG2E;
constexpr int NPHASE = 12;

constexpr size_t MiB = 1u << 20;
constexpr size_t WS_CTL = 0, CTL_ZERO_BYTES = 256 * 1024 + 128 * 1024;
constexpr size_t WS_KMEAN = 256 * 1024;
constexpr size_t WS_BIAS = 512 * 1024;
constexpr size_t WS_WIN = 1 * MiB, WS_WOUT = 7 * MiB, WS_WQ = 9 * MiB, WS_WG = 13 * MiB, WS_WPLE = 15 * MiB;
constexpr size_t WS_U = 16 * MiB, WS_V = 32 * MiB;
constexpr size_t WS_USC = 640 * 1024, WS_VSC = 704 * 1024;
constexpr size_t WS_XN2 = 48 * MiB;
constexpr size_t WS_XS = 104 * MiB + 512 * 1024;
constexpr size_t WS_XN = 80 * MiB;
constexpr size_t WS_PB = 112 * MiB;
constexpr size_t WS_QM = 120 * MiB, WS_KM = 136 * MiB, WS_VTM = 152 * MiB, WS_QS = 168 * MiB, WS_KS = 184 * MiB, WS_VTS = 200 * MiB;
constexpr size_t WS_ORAW = 216 * MiB;
constexpr size_t WS_A2 = 80 * MiB;
constexpr size_t WS_A3 = 120 * MiB;
constexpr size_t WS_SC = 152 * MiB;
constexpr size_t WS_EIDX = 80 * MiB, WS_GATE = 88 * MiB, WS_CJ = 96 * MiB, WS_RS2 = 104 * MiB, WS_SSQ = 105 * MiB;
constexpr size_t WS_PDOT = 152 * MiB;
constexpr size_t WS_A4 = 184 * MiB;
constexpr size_t WS_END = 248 * MiB;

constexpr int CW_XC = 8192;
constexpr int CW_BAR = 4096;

constexpr int LDS_BYTES = 147456;

#define XB_TMO      128
#define XB_XCNT(j)  (256  + 64 * (j))
#define XB_XSUB(j)  (1280 + 64 * (j))
#define XB_XGEN(j)  (2304 + 64 * (j))
#define XB_TOP      3328
#define XB_TOPGEN   3392
#define XCD_BAR_WORDS 3456
#define XB_SPIN_CAP (1u << 18)

__device__ __forceinline__ unsigned xb_ld(unsigned* p)              { return __hip_atomic_load(p, __ATOMIC_RELAXED, __HIP_MEMORY_SCOPE_AGENT); }
__device__ __forceinline__ unsigned xb_add(unsigned* p, unsigned v) { return __hip_atomic_fetch_add(p, v, __ATOMIC_RELAXED, __HIP_MEMORY_SCOPE_AGENT); }
__device__ __forceinline__ unsigned xb_xcc_id() { return (unsigned)__builtin_amdgcn_s_getreg((3 << 11) | 20) & 0xFu; }
#define XB_SPIN(cond, bar) do { unsigned _sp = 0; while (cond) { __builtin_amdgcn_s_sleep(1); \
    if ((++_sp & 255u) == 0u) { if (xb_ld(&(bar)[XB_TMO])) break; if (_sp > XB_SPIN_CAP) { atomicAdd(&(bar)[XB_TMO], 1u); break; } } } } while (0)

struct XcdBarrier { unsigned* bar; unsigned x; volatile LAS unsigned* st; };

__device__ __forceinline__ XcdBarrier xcd_barrier_post(unsigned* bar, volatile LAS unsigned* st) {
    XcdBarrier b; b.bar = bar; b.x = xb_xcc_id(); b.st = st;
    if (threadIdx.x == 0) (void)xb_add(&bar[XB_XCNT(b.x)], 1u);
    return b;
}
__device__ __forceinline__ void xcd_barrier_complete(unsigned* bar, unsigned x, unsigned& nloc, unsigned& nx) {
    const unsigned G = gridDim.x * gridDim.y * gridDim.z;
    unsigned sum, cnt, mine, sp = 0u;
    for (;;) {
        sum = 0u; cnt = 0u; mine = 0u;
#pragma unroll
        for (unsigned j = 0; j < 16; ++j) { const unsigned c = xb_ld(&bar[XB_XCNT(j)]); sum += c; cnt += (c > 0u) ? 1u : 0u; mine = (j == x) ? c : mine; }
        if (sum == G) break;
        __builtin_amdgcn_s_sleep(1);
        if ((++sp & 255u) == 0u) { if (xb_ld(&bar[XB_TMO])) break; if (sp > XB_SPIN_CAP) { atomicAdd(&bar[XB_TMO], 1u); break; } }
    }
    nloc = mine > 0u ? mine : 1u; nx = cnt > 0u ? cnt : 1u;
}
template <bool CENSUS> __device__ __forceinline__ void xcd_barrier(const XcdBarrier& b) {
    asm volatile("s_waitcnt vmcnt(0)" ::: "memory");
    __syncthreads();
    if (threadIdx.x == 0) {
        unsigned* bar = b.bar;
        __builtin_amdgcn_s_waitcnt(0);
        unsigned nloc = b.st[0], nx = b.st[1];
        if (CENSUS) { if (nloc == 0u) { xcd_barrier_complete(bar, b.x, nloc, nx); b.st[0] = nloc; b.st[1] = nx; } }
        const unsigned old = xb_add(&bar[XB_XSUB(b.x)], 1u);
        const unsigned gen = old / nloc;
        if (old + 1u == (gen + 1u) * nloc) {
            __builtin_amdgcn_fence(__ATOMIC_RELEASE, "agent");
            asm volatile("s_waitcnt vmcnt(0)" ::: "memory");
            const unsigned og = xb_add(&bar[XB_TOP], 1u);
            const unsigned tg = og / nx;
            if (og + 1u == (tg + 1u) * nx) xb_add(&bar[XB_TOPGEN], 1u);
            else XB_SPIN(xb_ld(&bar[XB_TOPGEN]) == tg, bar);
            __builtin_amdgcn_fence(__ATOMIC_ACQUIRE, "agent");
            xb_add(&bar[XB_XGEN(b.x)], 1u);
            asm volatile("s_waitcnt vmcnt(0)" ::: "memory");
        } else {
            XB_SPIN(xb_ld(&bar[XB_XGEN(b.x)]) == gen, bar);
            __builtin_amdgcn_fence(__ATOMIC_ACQUIRE, "agent");
            asm volatile("s_waitcnt vmcnt(0)" ::: "memory");
        }
    }
    __syncthreads();
}

DI float bf2f(short v) { return __builtin_bit_cast(float, ((unsigned)(unsigned short)v) << 16); }
DI unsigned cvtpk(float lo, float hi) { f32x2 v = {lo, hi}; bf16x2_t b = __builtin_convertvector(v, bf16x2_t); return __builtin_bit_cast(unsigned, b); }
DI bf16_t f2bf(float f) { return (bf16_t)(cvtpk(f, 0.f) & 0xffffu); }
template <int CTRL> DI float dppf(float v) { return __builtin_bit_cast(float, __builtin_amdgcn_update_dpp(0, __builtin_bit_cast(int, v), CTRL, 0xF, 0xF, true)); }
#define DPP_XOR1 0xB1
#define DPP_XOR2 0x4E
#define DPP_HMIR 0x141
#define DPP_MIR  0x140
DI void swap16(float v, float& a, float& b) { const auto r = __builtin_amdgcn_permlane16_swap(__builtin_bit_cast(unsigned, v), __builtin_bit_cast(unsigned, v), false, false); const unsigned r0 = r[0], r1 = r[1]; a = __builtin_bit_cast(float, r0); b = __builtin_bit_cast(float, r1); }
DI void swap32(float v, float& a, float& b) { const auto r = __builtin_amdgcn_permlane32_swap(__builtin_bit_cast(unsigned, v), __builtin_bit_cast(unsigned, v), false, false); const unsigned r0 = r[0], r1 = r[1]; a = __builtin_bit_cast(float, r0); b = __builtin_bit_cast(float, r1); }
DI float sum_x16(float v) { float a, b; swap16(v, a, b); return a + b; }
DI float sum_x32(float v) { float a, b; swap32(v, a, b); return a + b; }
DI float max_x32(float v) { float a, b; swap32(v, a, b); return fmaxf(a, b); }
DI float sum_row16(float v) { v += dppf<DPP_XOR1>(v); v += dppf<DPP_XOR2>(v); v += dppf<DPP_HMIR>(v); v += dppf<DPP_MIR>(v); return v; }
DI float max_row16(float v) { v = fmaxf(v, dppf<DPP_XOR1>(v)); v = fmaxf(v, dppf<DPP_XOR2>(v)); v = fmaxf(v, dppf<DPP_HMIR>(v)); v = fmaxf(v, dppf<DPP_MIR>(v)); return v; }
DI float sum_oct(float v) { v += dppf<DPP_XOR1>(v); v += dppf<DPP_XOR2>(v); v += dppf<DPP_HMIR>(v); return v; }
DI float max_oct(float v) { v = fmaxf(v, dppf<DPP_XOR1>(v)); v = fmaxf(v, dppf<DPP_XOR2>(v)); v = fmaxf(v, dppf<DPP_HMIR>(v)); return v; }
DI float wave_sum(float v) { return sum_x32(sum_x16(sum_row16(v))); }
DI float wave_max(float v) { v = max_row16(v); float a, b; swap16(v, a, b); return max_x32(fmaxf(a, b)); }
DI float tr_x32(float lo, float hi) { const auto r = __builtin_amdgcn_permlane32_swap(__builtin_bit_cast(unsigned, lo), __builtin_bit_cast(unsigned, hi), false, false); const unsigned r0 = r[0], r1 = r[1]; return __builtin_bit_cast(float, r0) + __builtin_bit_cast(float, r1); }
DI float tr_x16(float lo, float hi) { const auto r = __builtin_amdgcn_permlane16_swap(__builtin_bit_cast(unsigned, lo), __builtin_bit_cast(unsigned, hi), false, false); const unsigned r0 = r[0], r1 = r[1]; return __builtin_bit_cast(float, r0) + __builtin_bit_cast(float, r1); }
DI float tr_x8(float lo, float hi, bool bit) { const float mine = bit ? hi : lo, send = bit ? lo : hi; return mine + dppf<0x128>(send); }
DI float tr_x4(float lo, float hi, bool bit) {
    const int a = __builtin_amdgcn_update_dpp(0, __builtin_bit_cast(int, hi), 0x114, 0xF, 0xA, false);
    const int b = __builtin_amdgcn_update_dpp(a, __builtin_bit_cast(int, lo), 0x104, 0xF, 0x5, false);
    return (bit ? hi : lo) + __builtin_bit_cast(float, b);
}
DI float tr_x2(float lo, float hi, bool bit) { const float mine = bit ? hi : lo, send = bit ? lo : hi; return mine + dppf<DPP_XOR2>(send); }
DI float tr_x1(float lo, float hi, bool bit) { const float mine = bit ? hi : lo, send = bit ? lo : hi; return mine + dppf<DPP_XOR1>(send); }
DI int crow(int r, int hi) { return (r & 3) + 8 * (r >> 2) + 4 * hi; }
#define MFMA32(a, b, c) __builtin_amdgcn_mfma_f32_32x32x16_bf16((a), (b), (c), 0, 0, 0)
DI f32x16 zero16() { f32x16 z; for (int i = 0; i < 16; ++i) z[i] = 0.f; return z; }

struct Params {
    const float* in[18];
    float* out;
    unsigned char* ws;
    int ph_lo, ph_hi;
};

enum { IN_X = 0, IN_P, IN_RELB, IN_ATTN_NORM, IN_WIN, IN_QNORM, IN_KNORM, IN_ONM, IN_ONS, IN_WOUT, IN_FFN_NORM, IN_PQ, IN_SUBK, IN_PU, IN_PV, IN_PLE_NORM, IN_WPG, IN_WPLE };

DI void p0_transpose_wave(const float* W, int K, int N, bf16_t* Wt, LAS float* scr  , int lane, int k0, int n0, bool headperm, const float* kgain) {
    f32x4 v[16];
    const int lr = lane >> 4, lc = 4 * (lane & 15);
#pragma unroll
    for (int i = 0; i < 16; ++i) v[i] = *(const f32x4*)(W + (size_t)(k0 + 4 * i + lr) * N + n0 + lc);
#pragma unroll
    for (int i = 0; i < 16; ++i) { LAS float* d = scr + (4 * i + lr) * 65 + lc; d[0] = v[i].x; d[1] = v[i].y; d[2] = v[i].z; d[3] = v[i].w; }
    __builtin_amdgcn_wave_barrier();
    const int j = lane & 7, nl = lane >> 3;
    f32x4 g0 = {1.f, 1.f, 1.f, 1.f}, g1 = g0;
    if (kgain) { g0 = *(const f32x4*)(kgain + k0 + 8 * j); g1 = *(const f32x4*)(kgain + k0 + 8 * j + 4); }
#pragma unroll
    for (int q = 0; q < 8; ++q) {
        const int nn = 8 * q + nl;
        int n = n0 + nn;
        if (headperm) { const int w = n & 255; n = (n & ~255) + 128 * ((w >> 5) & 1) + 32 * (w >> 6) + (w & 31); }
        const LAS float* sp = scr + (8 * j) * 65 + nn;
        u32x4 w;
        w.x = cvtpk(sp[0] * g0.x, sp[65] * g0.y); w.y = cvtpk(sp[130] * g0.z, sp[195] * g0.w);
        w.z = cvtpk(sp[260] * g1.x, sp[325] * g1.y); w.w = cvtpk(sp[390] * g1.z, sp[455] * g1.w);
        *(u32x4*)(Wt + (size_t)n * K + k0 + 8 * j) = w;
    }
    __builtin_amdgcn_wave_barrier();
}

DI void split_bf16x8(const f32x4& p, const f32x4& q, bf16x8& hi, bf16x8& lo) {
    u32x4 h, l;
    h.x = cvtpk(p.x, p.y); h.y = cvtpk(p.z, p.w); h.z = cvtpk(q.x, q.y); h.w = cvtpk(q.z, q.w);
    const float r0 = p.x - __builtin_bit_cast(float, h.x << 16), r1 = p.y - __builtin_bit_cast(float, h.x & 0xffff0000u), r2 = p.z - __builtin_bit_cast(float, h.y << 16), r3 = p.w - __builtin_bit_cast(float, h.y & 0xffff0000u);
    const float r4 = q.x - __builtin_bit_cast(float, h.z << 16), r5 = q.y - __builtin_bit_cast(float, h.z & 0xffff0000u), r6 = q.z - __builtin_bit_cast(float, h.w << 16), r7 = q.w - __builtin_bit_cast(float, h.w & 0xffff0000u);
    l.x = cvtpk(r0, r1); l.y = cvtpk(r2, r3); l.z = cvtpk(r4, r5); l.w = cvtpk(r6, r7);
    hi = __builtin_bit_cast(bf16x8, h); lo = __builtin_bit_cast(bf16x8, l);
}
DI void p0_fold(const float* wq, const float* sub, const float* gffn, bf16_t* WqT, int wid, int lane, int wg, int nwg) {
    const int r = lane & 31, hi = lane >> 5, dq = wid & 1, nq = wid >> 1;
    for (int item = wg; item < 256; item += nwg) {
        const int dt = item & 15, hh = item >> 4, d0 = dt * 64 + 32 * dq, h = hh >> 1, half = hh & 1;
        const float* ap = wq + (size_t)(d0 + r) * 2048 + h * 256 + half * 128 + 8 * hi;
        const float* bp = sub + half * 16384 + (size_t)(32 * nq + r) * 128 + 8 * hi;
        f32x16 acc = zero16();
#pragma unroll
        for (int st = 0; st < 8; ++st) {
            const f32x4 a0 = *(const f32x4*)(ap + 16 * st), a1 = *(const f32x4*)(ap + 16 * st + 4), b0 = *(const f32x4*)(bp + 16 * st), b1 = *(const f32x4*)(bp + 16 * st + 4);
            bf16x8 ah, al, bh, bl;
            split_bf16x8(a0, a1, ah, al); split_bf16x8(b0, b1, bh, bl);
            acc = MFMA32(ah, bh, acc); acc = MFMA32(ah, bl, acc); acc = MFMA32(al, bh, acc);
        }
        bf16_t* op = WqT + (size_t)(hh * 128 + 32 * nq + r) * 1024 + d0 + 4 * hi;
#pragma unroll
        for (int g4 = 0; g4 < 4; ++g4) {
            const f32x4 gv = *(const f32x4*)(gffn + d0 + 8 * g4 + 4 * hi);
            u32x2 w; w.x = cvtpk(acc[4 * g4] * gv.x, acc[4 * g4 + 1] * gv.y); w.y = cvtpk(acc[4 * g4 + 2] * gv.z, acc[4 * g4 + 3] * gv.w);
            *(u32x2*)(op + 8 * g4) = w;
        }
    }
}

DI void p0_convert(const float* src, bf16_t* dst, size_t n, size_t gtid, size_t nthreads) {
    for (size_t i = gtid * 8; i < n; i += nthreads * 8) {
        const f32x4 a = *(const f32x4*)(src + i), b = *(const f32x4*)(src + i + 4);
        u32x4 o; o.x = cvtpk(a.x, a.y); o.y = cvtpk(a.z, a.w); o.z = cvtpk(b.x, b.y); o.w = cvtpk(b.z, b.w);
        *(u32x4*)(dst + i) = o;
    }
}


DI void p0_quant_finish(const f32x4 (&a)[4], unsigned char* dst, float* scale, int row, int lane) {
    float m = 0.f;
#pragma unroll
    for (int i = 0; i < 4; ++i) m = fmaxf(fmaxf(m, fmaxf(fabsf(a[i].x), fabsf(a[i].y))), fmaxf(fabsf(a[i].z), fabsf(a[i].w)));
    m = wave_max(m);
    const float sc = m > 0.f ? m * (1.f / 440.f) : 1.f, inv = m > 0.f ? 440.f / m : 0.f;
    u32x4 w;
#pragma unroll
    for (int i = 0; i < 4; ++i) {
        const float q0 = fminf(fmaxf(a[i].x * inv, -448.f), 448.f), q1 = fminf(fmaxf(a[i].y * inv, -448.f), 448.f);
        const float q2 = fminf(fmaxf(a[i].z * inv, -448.f), 448.f), q3 = fminf(fmaxf(a[i].w * inv, -448.f), 448.f);
        int p = 0;
        p = __builtin_amdgcn_cvt_pk_fp8_f32(q0, q1, p, false);
        p = __builtin_amdgcn_cvt_pk_fp8_f32(q2, q3, p, true);
        w[i] = (unsigned)p;
    }
    *(u32x4*)(dst + ((size_t)(lane >> 3) * 16384 + row) * 128 + 16 * (lane & 7)) = w;
    if (lane == 0) scale[row] = sc;
}
DI void quant_u6_finish(const f32x4 (&a)[4], unsigned char* dst, float* scale, int row, int lane) {
    float m = 0.f;
#pragma unroll
    for (int i = 0; i < 4; ++i) m = fmaxf(fmaxf(m, fmaxf(fabsf(a[i].x), fabsf(a[i].y))), fmaxf(fabsf(a[i].z), fabsf(a[i].w)));
    m = wave_max(m);
    const float sc = m > 0.f ? m * (1.f / 31.f) : 1.f, inv = m > 0.f ? 31.f / m : 0.f;
    unsigned hi0 = 0u, hi1 = 0u, lo = 0u;
#pragma unroll
    for (int e = 0; e < 16; ++e) {
        const int q = (int)rintf(a[e >> 2][e & 3] * inv);
        const unsigned h = (unsigned)(q >> 2) & 15u, l = (unsigned)q & 3u;
        if (e < 8) hi0 |= h << (4 * e); else hi1 |= h << (4 * (e - 8));
        lo |= l << (e < 8 ? 4 * e : 4 * (e - 8) + 2);
    }
    u32x2 hw; hw.x = hi0; hw.y = hi1;
    *(u32x2*)(dst + ((size_t)(lane >> 4) * 16384 + row) * 128 + 8 * (lane & 15)) = hw;
    *(unsigned*)(dst + ((size_t)(4 + (lane >> 5)) * 16384 + row) * 128 + 4 * (lane & 31)) = lo;
    if (lane == 0) scale[row] = sc;
}
DI void p0_quant_issue2(f32x4 (&a)[2][4], const float* pu, const float* pv, int r, int lane) {
#pragma unroll
    for (int i = 0; i < 4; ++i) { a[0][i] = *(const f32x4*)(pu + (size_t)r * 1024 + 16 * lane + 4 * i); a[1][i] = *(const f32x4*)(pv + (size_t)r * 1024 + 16 * lane + 4 * i); }
}
DI void p0_quant_rows4(const float* pu, const float* pv, unsigned char* u8, unsigned char* v8, float* usc_, float* vsc_, int r0, int r1, int lane) {
    f32x4 a[4][4];
    const int r1c = r1 < 16384 ? r1 : r0;
#pragma unroll
    for (int i = 0; i < 4; ++i) { a[0][i] = *(const f32x4*)(pu + (size_t)r0 * 1024 + 16 * lane + 4 * i); a[1][i] = *(const f32x4*)(pv + (size_t)r0 * 1024 + 16 * lane + 4 * i);
        a[2][i] = *(const f32x4*)(pu + (size_t)r1c * 1024 + 16 * lane + 4 * i); a[3][i] = *(const f32x4*)(pv + (size_t)r1c * 1024 + 16 * lane + 4 * i); }
    p0_quant_finish(a[0], u8, usc_, r0, lane); p0_quant_finish(a[1], v8, vsc_, r0, lane);
    if (r1 < 16384) { p0_quant_finish(a[2], u8, usc_, r1, lane); p0_quant_finish(a[3], v8, vsc_, r1, lane); }
}

DI void rmsnorm_rows2_bf16(const float* x, const float* g, bf16_t* o, int r0, int r1, int lane) {
    f32x4 v[2][4]; float s[2] = {0.f, 0.f};
    const int rr[2] = {r0, r1 < T ? r1 : r0};
#pragma unroll
    for (int q = 0; q < 2; ++q)
#pragma unroll
        for (int j = 0; j < 4; ++j) v[q][j] = ((const f32x4*)(x + (size_t)rr[q] * 1024))[lane + 64 * j];
#pragma unroll
    for (int q = 0; q < 2; ++q) {
#pragma unroll
        for (int j = 0; j < 4; ++j) s[q] += (v[q][j].x * v[q][j].x + v[q][j].y * v[q][j].y) + (v[q][j].z * v[q][j].z + v[q][j].w * v[q][j].w);
        s[q] = wave_sum(s[q]);
    }
#pragma unroll
    for (int q = 0; q < 2; ++q) {
        if (q == 1 && r1 >= T) break;
        const float rs = rsqrtf(s[q] * (1.f / 1024.f) + EPS);
#pragma unroll
        for (int j = 0; j < 4; ++j) { const f32x4 gv = ((const f32x4*)g)[lane + 64 * j];
            u32x2 w; w.x = cvtpk(v[q][j].x * rs * gv.x, v[q][j].y * rs * gv.y); w.y = cvtpk(v[q][j].z * rs * gv.z, v[q][j].w * rs * gv.w);
            ((u32x2*)(o + (size_t)rr[q] * 1024))[lane + 64 * j] = w; }
    }
}

namespace pg8 {
#define PG8_LAS __attribute__((address_space(3)))
typedef unsigned short bf16_t;
typedef short bf16x8 __attribute__((ext_vector_type(8)));
typedef float f32x4 __attribute__((ext_vector_type(4)));
typedef unsigned u32x4 __attribute__((ext_vector_type(4)));
constexpr int BM = 256, BK = 64, HALF = 128, HTB = HALF * BK * 2  , STAGE_BYTES = 8 * HTB, NXCD = 8, WGM = 8;

__host__ __device__ __forceinline__ int lds_byte(int r, int c) { const int st = (r >> 4) * 2 + (c >> 5), rr = r & 15, cc = c & 31, ob = rr * 64 + cc * 2; return st * 1024 + (ob ^ (((ob >> 9) & 1) << 5)); }
__host__ __device__ __forceinline__ void stage_rc(int b, int& R, int& C) { const int st = b / 1024, sb = b % 1024, swz = sb ^ (((sb >> 9) & 1) << 5); R = (st >> 1) * 16 + swz / 64; C = (st & 1) * 32 + (swz % 64) / 2; }
__host__ __device__ __forceinline__ int perm32(int rho) { const int n = rho >> 4, i = rho & 15; return 8 * (i >> 2) + 4 * n + (i & 3); }

struct Unit { int pm, pn; };
struct Gemm { const bf16_t* A; const bf16_t* Bt; int M, N, K; };

struct StaticOrder {
    int nM, nN, nwg, G, c;
    __host__ __device__ void init(int M, int N, int G_, int c_) { nM = M / BM; nN = N / BM; nwg = nM * nN; G = G_; c = c_; }
    __host__ __device__ bool next(int i, Unit& u) const {
        const long L = (long)i * G + c; if (L >= nwg) return false;
        int wgid = (int)L; { const int q = nwg / NXCD, r = nwg % NXCD, xcd = wgid % NXCD, off = wgid / NXCD; wgid = (xcd < r ? xcd * (q + 1) : r * (q + 1) + (xcd - r) * q) + off; }
        const int nig = WGM * nN, gid = wgid / nig, fm = gid * WGM, gsz = (nM - fm) < WGM ? (nM - fm) : WGM;
        u.pm = fm + ((wgid % nig) % gsz); u.pn = (wgid % nig) / gsz; return true;
    }
    __device__ __forceinline__ void a_ready(const Unit&) const {}
    __device__ __forceinline__ void done(const Unit&) const {}
};

template <class Epi, class Sched, bool ALIGN_EPI = false, bool SP2 = false>
__device__ __forceinline__ void gemm_phase(PG8_LAS unsigned char* lds, const Gemm g, const Sched& S, const Epi& E) {
    int tid_ = threadIdx.x; asm volatile("" : "+v"(tid_));
    const int tid = tid_, wid = __builtin_amdgcn_readfirstlane(tid >> 6), lane = tid & 63, wr = wid >> 2, wc = wid & 3, fr = lane & 15, fq = lane >> 4;
    const int K = g.K, nt = K / BK;
    unsigned voffA[2], voffB[2];
#pragma unroll
    for (int i = 0; i < 2; ++i) { int R, C; stage_rc(tid * 16 + i * 8192, R, C); const int Rb = Epi::PERM ? ((R & ~31) + perm32(R & 31)) : R;
        voffA[i] = (unsigned)(R * K + C) * 2u; voffB[i] = (unsigned)(Rb * K + C) * 2u; }
    const size_t kstep = (size_t)(BK * 2);
    const size_t hstep = (size_t)HALF * K * 2;
    const size_t tstep = 2 * hstep;
    const unsigned ldsw = (unsigned)wid * 1024u;
    const int aoff = lds_byte(wr * 64 + fr, fq * 8), boff = lds_byte(wc * 32 + fr, fq * 8);
#define PG8_SA(b, h) (((b) * 2 + (h)) * HTB)
#define PG8_SB(b, h) ((4 + (b) * 2 + (h)) * HTB)
#define PG8_STAGE(bufoff, gbase, voff) do { _Pragma("unroll") for (int _i = 0; _i < 2; ++_i) \
        __builtin_amdgcn_global_load_lds((const unsigned*)((const char*)(gbase) + (voff)[_i]), (PG8_LAS unsigned*)(lds + (bufoff) + ldsw + _i * 8192), 16, 0, 0); } while (0)
#define PG8_LDA(dst, b, h) do { _Pragma("unroll") for (int m = 0; m < 4; ++m) _Pragma("unroll") for (int k = 0; k < 2; ++k) dst[m][k] = *(const PG8_LAS bf16x8*)(lds + PG8_SA(b, h) + aoff + m * 2048 + k * 1024); } while (0)
#define PG8_LDB(dst, b, h) do { _Pragma("unroll") for (int n = 0; n < 2; ++n) _Pragma("unroll") for (int k = 0; k < 2; ++k) dst[n][k] = *(const PG8_LAS bf16x8*)(lds + PG8_SB(b, h) + boff + n * 2048 + k * 1024); } while (0)
#define PG8_MMA(ai, bj, At, Bt) do { __builtin_amdgcn_s_setprio(1); _Pragma("unroll") for (int m = 0; m < 4; ++m) _Pragma("unroll") for (int n = 0; n < 2; ++n) _Pragma("unroll") for (int k = 0; k < 2; ++k) \
        acc[ai][bj][m][n] = __builtin_amdgcn_mfma_f32_16x16x32_bf16(Bt[n][k], At[m][k], acc[ai][bj][m][n], 0, 0, 0); __builtin_amdgcn_s_setprio(0); } while (0)
#define PG8_WAIT_V(n) asm volatile("s_waitcnt vmcnt(" #n ")" ::: "memory")
#define PG8_WAIT_L(n) asm volatile("s_waitcnt lgkmcnt(" #n ")" ::: "memory")
#define PG8_BAR __builtin_amdgcn_s_barrier()
#define PG8_SCHED __builtin_amdgcn_sched_barrier(0)
    Unit cur, nxt; int ui = 0;
    if (!S.next(0, cur)) return;
    f32x4 acc[2][2][4][2];
#pragma unroll
    for (int a = 0; a < 2; ++a)
#pragma unroll
        for (int b = 0; b < 2; ++b)
#pragma unroll
            for (int m = 0; m < 4; ++m)
#pragma unroll
                for (int n = 0; n < 2; ++n) acc[a][b][m][n] = (f32x4){0.f, 0.f, 0.f, 0.f};
    bf16x8 At[4][2], B0[2][2], B1[2][2];
    const char* cA = (const char*)g.A + (size_t)cur.pm * tstep; const char* cB = (const char*)g.Bt + (size_t)cur.pn * tstep;
    S.a_ready(cur);
    if constexpr (SP2) {
        PG8_STAGE(PG8_SB(0, 0), cB, voffB); PG8_STAGE(PG8_SB(0, 1), cB + hstep, voffB); PG8_STAGE(PG8_SA(0, 0), cA, voffA); PG8_STAGE(PG8_SA(0, 1), cA + hstep, voffA);
        if (wr == 1) PG8_BAR;
        PG8_WAIT_V(2); PG8_BAR;
        PG8_STAGE(PG8_SB(1, 0), cB + kstep, voffB); PG8_STAGE(PG8_SA(1, 0), cA + kstep, voffA); PG8_STAGE(PG8_SB(1, 1), cB + hstep + kstep, voffB);
        PG8_WAIT_V(6); PG8_BAR;
    } else {
        PG8_STAGE(PG8_SB(0, 0), cB, voffB); PG8_STAGE(PG8_SA(0, 0), cA, voffA); PG8_STAGE(PG8_SB(0, 1), cB + hstep, voffB); PG8_STAGE(PG8_SA(0, 1), cA + hstep, voffA);
        if (wr == 1) PG8_BAR;
        PG8_WAIT_V(4); PG8_BAR;
        PG8_STAGE(PG8_SB(1, 0), cB + kstep, voffB); PG8_STAGE(PG8_SA(1, 0), cA + kstep, voffA); PG8_STAGE(PG8_SB(1, 1), cB + hstep + kstep, voffB);
        PG8_WAIT_V(6); PG8_BAR;
    }
    for (;;) {
        const bool has_next = S.next(ui + 1, nxt);
        const char* nA = has_next ? (const char*)g.A + (size_t)nxt.pm * tstep : cA; const char* nB = has_next ? (const char*)g.Bt + (size_t)nxt.pn * tstep : cB;
        for (int t = 0; t < nt; t += 2) {
            const bool last = (t == nt - 2);
            const char* a1 = cA + (size_t)(t + 1) * kstep;
            const char* a2 = last ? nA : cA + (size_t)(t + 2) * kstep; const char* b2 = last ? nB : cB + (size_t)(t + 2) * kstep;
            const char* a3 = a2 + kstep; const char* b3 = b2 + kstep;
            if (last && has_next) S.a_ready(nxt);
            if constexpr (SP2) {
            PG8_LDB(B0, 0, 0); PG8_LDB(B1, 0, 1); PG8_SCHED; PG8_LDA(At, 0, 0); PG8_STAGE(PG8_SA(1, 1), a1 + hstep, voffA);
            PG8_WAIT_V(8); PG8_WAIT_L(0); PG8_BAR; PG8_MMA(0, 0, At, B0); PG8_MMA(0, 1, At, B1); PG8_BAR; PG8_SCHED;
            PG8_LDA(At, 0, 1); PG8_STAGE(PG8_SB(0, 0), b2, voffB); PG8_STAGE(PG8_SB(0, 1), b2 + hstep, voffB); PG8_STAGE(PG8_SA(0, 0), a2, voffA);
            PG8_WAIT_V(8); PG8_WAIT_L(0); PG8_BAR; PG8_MMA(1, 0, At, B0); PG8_MMA(1, 1, At, B1); PG8_BAR; PG8_SCHED;
            PG8_LDB(B0, 1, 0); PG8_LDB(B1, 1, 1); PG8_SCHED; PG8_LDA(At, 1, 0); PG8_STAGE(PG8_SA(0, 1), a2 + hstep, voffA);
            PG8_WAIT_V(8); PG8_WAIT_L(0); PG8_BAR; PG8_MMA(0, 0, At, B0); PG8_MMA(0, 1, At, B1); PG8_BAR; PG8_SCHED;
            PG8_LDA(At, 1, 1); PG8_STAGE(PG8_SB(1, 0), b3, voffB); PG8_STAGE(PG8_SB(1, 1), b3 + hstep, voffB); PG8_STAGE(PG8_SA(1, 0), a3, voffA);
            PG8_WAIT_V(8); PG8_WAIT_L(0); PG8_BAR; PG8_MMA(1, 0, At, B0); PG8_MMA(1, 1, At, B1); PG8_BAR; PG8_SCHED;
            } else {
            PG8_LDB(B0, 0, 0); PG8_SCHED; PG8_LDA(At, 0, 0); PG8_STAGE(PG8_SA(1, 1), a1 + hstep, voffA);
            PG8_WAIT_L(8); PG8_BAR; PG8_WAIT_L(0); PG8_MMA(0, 0, At, B0); PG8_BAR; PG8_SCHED;
            PG8_LDB(B1, 0, 1); PG8_STAGE(PG8_SB(0, 0), b2, voffB);
            PG8_BAR; PG8_WAIT_L(0); PG8_MMA(0, 1, At, B1); PG8_BAR;
            PG8_LDA(At, 0, 1); PG8_STAGE(PG8_SA(0, 0), a2, voffA);
            PG8_BAR; PG8_WAIT_L(0); PG8_MMA(1, 0, At, B0); PG8_BAR; PG8_SCHED;
            PG8_STAGE(PG8_SB(0, 1), b2 + hstep, voffB);
            PG8_WAIT_V(6); PG8_BAR; PG8_MMA(1, 1, At, B1); PG8_BAR;
            PG8_LDB(B0, 1, 0); PG8_SCHED; PG8_LDA(At, 1, 0); PG8_STAGE(PG8_SA(0, 1), a2 + hstep, voffA);
            PG8_WAIT_L(8); PG8_BAR; PG8_WAIT_L(0); PG8_MMA(0, 0, At, B0); PG8_BAR; PG8_SCHED;
            PG8_LDB(B1, 1, 1); PG8_STAGE(PG8_SB(1, 0), b3, voffB);
            PG8_BAR; PG8_WAIT_L(0); PG8_MMA(0, 1, At, B1); PG8_BAR;
            PG8_LDA(At, 1, 1); PG8_STAGE(PG8_SA(1, 0), a3, voffA);
            PG8_BAR; PG8_WAIT_L(0); PG8_MMA(1, 0, At, B0); PG8_BAR; PG8_SCHED;
            PG8_STAGE(PG8_SB(1, 1), b3 + hstep, voffB);
            PG8_WAIT_V(6); PG8_BAR; PG8_MMA(1, 1, At, B1); PG8_BAR;
            }
        }
        if constexpr (ALIGN_EPI) { if (wr == 0) PG8_BAR; }
        if constexpr (!Epi::AFTER_DRAIN) { E(acc, cur, wr, wc, fr, fq); S.done(cur); }
        if (!has_next) break;
#pragma unroll
        for (int a = 0; a < 2; ++a)
#pragma unroll
            for (int b = 0; b < 2; ++b)
#pragma unroll
                for (int m = 0; m < 4; ++m)
#pragma unroll
                    for (int n = 0; n < 2; ++n) acc[a][b][m][n] = (f32x4){0.f, 0.f, 0.f, 0.f};
        cur = nxt; cA = nA; cB = nB; ++ui;
        if constexpr (ALIGN_EPI) { if (wr == 1) PG8_BAR; }
    }
    PG8_WAIT_V(0);
    if constexpr (!ALIGN_EPI) { if (wr == 0) PG8_BAR; }
    PG8_BAR;
    if constexpr (Epi::AFTER_DRAIN) { E.fused(acc, cur, wr, wc, fr, fq, lds, wid, lane); S.done(cur); }
#undef PG8_SA
#undef PG8_SB
#undef PG8_STAGE
#undef PG8_LDA
#undef PG8_LDB
#undef PG8_MMA
#undef PG8_WAIT_V
#undef PG8_WAIT_L
#undef PG8_BAR
#undef PG8_SCHED
}
}


struct EpiQKV {
    static constexpr bool PERM = true, AFTER_DRAIN = false;
    bf16_t* base6; const float *qn, *kn; float* kmean_acc;
    DI void operator()(const f32x4 (&acc)[2][2][4][2], const pg8::Unit& u, int wr, int wc, int fr, int fq) const {
        const int typ = u.pn >> 1, h = (u.pn & 1) * 4 + wc;
        bf16_t* reg = base6 + (size_t)typ * (16u << 19);
        const int row0 = u.pm * 256 + wr * 64 + fr;
        if (typ == 2 || typ == 5) {
#pragma unroll
            for (int ai = 0; ai < 2; ++ai)
#pragma unroll
                for (int m = 0; m < 4; ++m) {
                    const int tok = row0 + ai * 128 + m * 16, b = tok >> 11, sq = tok & 2047, tile = sq >> 5, kap = sq & 31;
                    const int s2 = kap >> 4, hh = (kap >> 2) & 1, jj = ((kap >> 3) & 1) * 4 + (kap & 3);
                    bf16_t* bp = reg + ((((size_t)(b * 8 + h) * 64 + tile) * 4 + s2 * 2) * 64 + hh * 32 + 8 * fq) * 8 + jj;
#pragma unroll
                    for (int bj = 0; bj < 2; ++bj)
#pragma unroll
                        for (int n = 0; n < 2; ++n)
#pragma unroll
                            for (int i = 0; i < 4; ++i) bp[(size_t)bj * 512 + (4 * n + i) * 8] = f2bf(acc[ai][bj][m][n][i]);
                }
        } else {
            const bool nrm = typ < 2;
            const float* g = (typ == 0) ? qn : kn;
            f32x4 gv[2][2];
#pragma unroll
            for (int bj = 0; bj < 2; ++bj)
#pragma unroll
                for (int n = 0; n < 2; ++n) gv[bj][n] = nrm ? *(const f32x4*)(g + 32 * bj + 8 * fq + 4 * n) : (f32x4){1.f, 1.f, 1.f, 1.f};
#pragma unroll
            for (int ai = 0; ai < 2; ++ai)
#pragma unroll
                for (int m = 0; m < 4; ++m) {
                    const int tok = row0 + ai * 128 + m * 16, b = tok >> 11, sq = tok & 2047, tile = sq >> 5, kap = sq & 31;
                    float rs = 1.f;
                    if (nrm) {
                        float ss = 0.f;
#pragma unroll
                        for (int bj = 0; bj < 2; ++bj)
#pragma unroll
                            for (int n = 0; n < 2; ++n) { const f32x4 v = acc[ai][bj][m][n]; ss += (v.x * v.x + v.y * v.y) + (v.z * v.z + v.w * v.w); }
                        ss = sum_x32(sum_x16(ss));
                        rs = rsqrtf(ss * (1.f / 64.f) + EPS);
                    }
                    bf16_t* dst = reg + ((((size_t)(b * 8 + h) * 64 + tile) * 4 + (fq >> 1)) * 64 + (fq & 1) * 32 + kap) * 8;
#pragma unroll
                    for (int bj = 0; bj < 2; ++bj) {
                        const f32x4 v0 = acc[ai][bj][m][0] * rs * gv[bj][0], v1 = acc[ai][bj][m][1] * rs * gv[bj][1];
                        u32x4 w; w.x = cvtpk(v0.x, v0.y); w.y = cvtpk(v0.z, v0.w); w.z = cvtpk(v1.x, v1.y); w.w = cvtpk(v1.z, v1.w);
                        *(u32x4*)(dst + (size_t)bj * 2 * 512) = w;
                    }
                }
            if (typ == 1) {
                asm volatile("" ::: "memory");
                f32x4 ks[2][2];
#pragma unroll
                for (int bj = 0; bj < 2; ++bj)
#pragma unroll
                    for (int n = 0; n < 2; ++n) ks[bj][n] = (f32x4){0.f, 0.f, 0.f, 0.f};
#pragma unroll
                for (int ai = 0; ai < 2; ++ai)
#pragma unroll
                    for (int m = 0; m < 4; ++m) {
                        float ss = 0.f;
#pragma unroll
                        for (int bj = 0; bj < 2; ++bj)
#pragma unroll
                            for (int n = 0; n < 2; ++n) { const f32x4 v = acc[ai][bj][m][n]; ss += (v.x * v.x + v.y * v.y) + (v.z * v.z + v.w * v.w); }
                        ss = sum_x32(sum_x16(ss));
                        const float rs = rsqrtf(ss * (1.f / 64.f) + EPS);
#pragma unroll
                        for (int bj = 0; bj < 2; ++bj)
#pragma unroll
                            for (int n = 0; n < 2; ++n) ks[bj][n] += acc[ai][bj][m][n] * rs * gv[bj][n];
                    }
                const int tok0 = u.pm * 256;
                float* kd = kmean_acc + ((size_t)((tok0 >> 11) * 8 + h) * 8 + ((tok0 & 2047) >> 8)) * 64 + 8 * fq;
#pragma unroll
                for (int bj = 0; bj < 2; ++bj)
#pragma unroll
                    for (int n = 0; n < 2; ++n)
#pragma unroll
                        for (int i = 0; i < 4; ++i) { const float t = sum_row16(ks[bj][n][i]) * (1.f / 256.f); if (fr == 0) atomicAdd(kd + 32 * bj + 4 * n + i, t); }
            }
        }
    }
};

struct EpiRes {
    static constexpr bool PERM = true, AFTER_DRAIN = false;
    const float* x; bf16_t* xn;
    DI void operator()(const f32x4 (&acc)[2][2][4][2], const pg8::Unit& u, int wr, int wc, int fr, int fq) const {
        const int row0 = u.pm * 256 + wr * 64 + fr, col0 = u.pn * 256 + wc * 32 + 8 * fq;
#pragma unroll
        for (int ai = 0; ai < 2; ++ai)
#pragma unroll
            for (int m = 0; m < 4; ++m)
#pragma unroll
                for (int bj = 0; bj < 2; ++bj) {
                    const size_t off = (size_t)(row0 + ai * 128 + m * 16) * 1024 + col0 + bj * 128;
                    const f32x4 h0 = *(const f32x4*)(x + off) + acc[ai][bj][m][0], h1 = *(const f32x4*)(x + off + 4) + acc[ai][bj][m][1];
                    u32x4 w; w.x = cvtpk(h0.x, h0.y); w.y = cvtpk(h0.z, h0.w); w.z = cvtpk(h1.x, h1.y); w.w = cvtpk(h1.z, h1.w);
                    *(u32x4*)(xn + off) = w;
                }
    }
};

struct EpiF32 {
    static constexpr bool PERM = true, AFTER_DRAIN = false;
    float* C; int ldc;
    DI void operator()(const f32x4 (&acc)[2][2][4][2], const pg8::Unit& u, int wr, int wc, int fr, int fq) const {
        const int row0 = u.pm * 256 + wr * 64 + fr, col0 = u.pn * 256 + wc * 32 + 8 * fq;
#pragma unroll
        for (int ai = 0; ai < 2; ++ai)
#pragma unroll
            for (int m = 0; m < 4; ++m)
#pragma unroll
                for (int bj = 0; bj < 2; ++bj) {
                    float* p = C + (size_t)(row0 + ai * 128 + m * 16) * ldc + col0 + bj * 128;
                    *(f32x4*)p = acc[ai][bj][m][0]; *(f32x4*)(p + 4) = acc[ai][bj][m][1];
                }
    }
};

struct EpiBf {
    static constexpr bool PERM = true, AFTER_DRAIN = false;
    bf16_t* C; int ldc;
    DI void operator()(const f32x4 (&acc)[2][2][4][2], const pg8::Unit& u, int wr, int wc, int fr, int fq) const {
        const int row0 = u.pm * 256 + wr * 64 + fr, col0 = u.pn * 256 + wc * 32 + 8 * fq;
#pragma unroll
        for (int ai = 0; ai < 2; ++ai)
#pragma unroll
            for (int m = 0; m < 4; ++m)
#pragma unroll
                for (int bj = 0; bj < 2; ++bj) {
                    const f32x4 v0 = acc[ai][bj][m][0], v1 = acc[ai][bj][m][1];
                    u32x4 w; w.x = cvtpk(v0.x, v0.y); w.y = cvtpk(v0.z, v0.w); w.z = cvtpk(v1.x, v1.y); w.w = cvtpk(v1.z, v1.w);
                    *(u32x4*)(C + (size_t)(row0 + ai * 128 + m * 16) * ldc + col0 + bj * 128) = w;
                }
    }
};

struct EpiGate {
    static constexpr bool PERM = true, AFTER_DRAIN = false;
    float* out; const bf16_t* pw; const float* ssq; const bf16_t* h2b;
    DI void operator()(const f32x4 (&acc)[2][2][4][2], const pg8::Unit& u, int wr, int wc, int fr, int fq) const {
        const int row0 = u.pm * 256 + wr * 64 + fr, col0 = u.pn * 256 + wc * 32 + 8 * fq;
#pragma unroll
        for (int ai = 0; ai < 2; ++ai)
#pragma unroll
            for (int m = 0; m < 4; ++m) {
                const int row = row0 + ai * 128 + m * 16;
                float sq = 0.f;
#pragma unroll
                for (int x = 0; x < 8; ++x) sq += ssq[(size_t)x * T + row];
                const float rs3 = rsqrtf(sq * (1.f / 1024.f) + EPS);
#pragma unroll
                for (int bj = 0; bj < 2; ++bj) {
                    const size_t off = (size_t)row * 1024 + col0 + bj * 128;
                    const bf16x8 pv = *(const bf16x8*)(pw + off);
                    const bf16x8 hb = *(const bf16x8*)(h2b + off);
                    const f32x4 g0 = acc[ai][bj][m][0] * rs3, g1 = acc[ai][bj][m][1] * rs3;
                    f32x4 o0, o1;
#pragma unroll
                    for (int i = 0; i < 4; ++i) { o0[i] = bf2f(hb[i]) + bf2f(pv[i]) * __builtin_amdgcn_rcpf(1.f + __expf(-g0[i])); o1[i] = bf2f(hb[4 + i]) + bf2f(pv[4 + i]) * __builtin_amdgcn_rcpf(1.f + __expf(-g1[i])); }
                    *(f32x4*)(out + off) = o0; *(f32x4*)(out + off + 4) = o1;
                }
            }
    }
};

template <class Epi>
DI void gemm_simple(const bf16_t* A, const bf16_t* Bt, int M, int N, int K, const Epi& epi, int gwave, int nwaves, int lane) {
    const int r32 = lane & 31, hi = lane >> 5;
    const int nNt = N / 64, total = (M / 32) * nNt;
    for (int tile = gwave; tile < total; tile += nwaves) {
        const int mt = tile / nNt, nt = tile - mt * nNt, m0 = mt * 32, n0 = nt * 64;
        const bf16_t* ap = A + (size_t)(m0 + r32) * K + 8 * hi;
        const bf16_t* b0p = Bt + (size_t)(n0 + r32) * K + 8 * hi;
        const bf16_t* b1p = b0p + (size_t)32 * K;
        f32x16 acc0 = zero16(), acc1 = zero16();
#pragma unroll 4
        for (int k = 0; k < K; k += 16) {
            const bf16x8 xa = *(const bf16x8*)(ap + k);
            const bf16x8 w0 = *(const bf16x8*)(b0p + k);
            const bf16x8 w1 = *(const bf16x8*)(b1p + k);
            acc0 = MFMA32(w0, xa, acc0);
            acc1 = MFMA32(w1, xa, acc1);
        }
        epi(m0 + r32, n0, hi, acc0, acc1);
    }
}

struct Epi1 {
    bf16_t* base6;
    const float *qn, *kn;
    DI void operator()(int tok, int n0, int hi, const f32x16& a0, const f32x16& a1) const {
        const int head48 = n0 >> 6, typ = head48 >> 3, h = head48 & 7;
        bf16_t* reg = base6 + (size_t)typ * (16u << 19);
        if (typ == 2 || typ == 5) {
            const int b = tok >> 11, s = tok & 2047;
            const int pos = (s & ~12) | ((s & 4) << 1) | ((s & 8) >> 1);
            bf16_t* base = reg + ((size_t)(b * 8 + h) * 64) * 2048 + pos;
#pragma unroll
            for (int r = 0; r < 16; ++r) { base[(size_t)crow(r, hi) * 2048] = f2bf(a0[r]); base[(size_t)(32 + crow(r, hi)) * 2048] = f2bf(a1[r]); }
        } else {
            float rs = 1.f;
            const bool nrm = (typ == 0 || typ == 1);
            if (nrm) { float ss = 0.f;
#pragma unroll
                for (int r = 0; r < 16; ++r) ss += a0[r] * a0[r] + a1[r] * a1[r];
                ss = sum_x32(ss);
                rs = rsqrtf(ss * (1.f / 64.f) + EPS); }
            const float* g = (typ == 0) ? qn : kn;
            bf16_t* dst = reg + (size_t)tok * 512 + h * 64;
#pragma unroll
            for (int t = 0; t < 2; ++t)
#pragma unroll
                for (int g4 = 0; g4 < 4; ++g4) {
                    const int f0 = 32 * t + 8 * g4 + 4 * hi;
                    float v[4];
#pragma unroll
                    for (int i = 0; i < 4; ++i) { const float a = t ? a1[4 * g4 + i] : a0[4 * g4 + i]; v[i] = nrm ? a * rs * g[f0 + i] : a; }
                    u32x2 w; w.x = cvtpk(v[0], v[1]); w.y = cvtpk(v[2], v[3]);
                    *(u32x2*)(dst + f0) = w;
                }
        }
    }
};

struct Epi2 {
    const float* x; float* out; bf16_t* xn;
    DI void operator()(int tok, int n0, int hi, const f32x16& a0, const f32x16& a1) const {
#pragma unroll
        for (int t = 0; t < 2; ++t)
#pragma unroll
            for (int g4 = 0; g4 < 4; ++g4) {
                const size_t off = (size_t)tok * 1024 + n0 + 32 * t + 8 * g4 + 4 * hi;
                const f32x4 xv = *(const f32x4*)(x + off);
                f32x4 hv;
#pragma unroll
                for (int i = 0; i < 4; ++i) hv[i] = xv[i] + (t ? a1[4 * g4 + i] : a0[4 * g4 + i]);
                *(f32x4*)(out + off) = hv;
                u32x2 w; w.x = cvtpk(hv[0], hv[1]); w.y = cvtpk(hv[2], hv[3]);
                *(u32x2*)(xn + off) = w;
            }
    }
};

struct Epi3 {
    float* sc;
    DI void operator()(int tok, int n0, int hi, const f32x16& a0, const f32x16& a1) const {
#pragma unroll
        for (int t = 0; t < 2; ++t)
#pragma unroll
            for (int g4 = 0; g4 < 4; ++g4) {
                f32x4 v;
#pragma unroll
                for (int i = 0; i < 4; ++i) v[i] = t ? a1[4 * g4 + i] : a0[4 * g4 + i];
                *(f32x4*)(sc + (size_t)tok * 2048 + n0 + 32 * t + 8 * g4 + 4 * hi) = v;
            }
    }
};

DI void pv_accum(f32x16& o0, f32x16& o1, const f32x16& p, const bf16_t* vt_row) {
#pragma unroll
    for (int s = 0; s < 2; ++s) {
        u32x4 pk; pk.x = cvtpk(p[8 * s], p[8 * s + 1]); pk.y = cvtpk(p[8 * s + 2], p[8 * s + 3]); pk.z = cvtpk(p[8 * s + 4], p[8 * s + 5]); pk.w = cvtpk(p[8 * s + 6], p[8 * s + 7]);
        const bf16x8 pb = __builtin_bit_cast(bf16x8, pk);
        const bf16x8 v0 = *(const bf16x8*)(vt_row + 16 * s);
        const bf16x8 v1 = *(const bf16x8*)(vt_row + (size_t)32 * 2048 + 16 * s);
        o0 = MFMA32(v0, pb, o0);
        o1 = MFMA32(v1, pb, o1);
    }
}

DI void store_o(bf16_t* op, const f32x16& o0, const f32x16& o1, float inv, int hi) {
#pragma unroll
    for (int t = 0; t < 2; ++t)
#pragma unroll
        for (int g4 = 0; g4 < 4; ++g4) {
            u32x2 w;
            if (t == 0) { w.x = cvtpk(o0[4 * g4] * inv, o0[4 * g4 + 1] * inv); w.y = cvtpk(o0[4 * g4 + 2] * inv, o0[4 * g4 + 3] * inv); }
            else        { w.x = cvtpk(o1[4 * g4] * inv, o1[4 * g4 + 1] * inv); w.y = cvtpk(o1[4 * g4 + 2] * inv, o1[4 * g4 + 3] * inv); }
            *(u32x2*)(op + 32 * t + 8 * g4 + 4 * hi) = w;
        }
}

constexpr int OT_PITCH = 1040;
DI void store_o_lds(LAS unsigned char* ot, int r32, int h, const f32x16& o0, const f32x16& o1, float inv, int hi) {
    LAS unsigned char* op = ot + r32 * OT_PITCH + h * 128;
#pragma unroll
    for (int t = 0; t < 2; ++t)
#pragma unroll
        for (int g4 = 0; g4 < 4; ++g4) {
            u32x2 w;
            if (t == 0) { w.x = cvtpk(o0[4 * g4] * inv, o0[4 * g4 + 1] * inv); w.y = cvtpk(o0[4 * g4 + 2] * inv, o0[4 * g4 + 3] * inv); }
            else        { w.x = cvtpk(o1[4 * g4] * inv, o1[4 * g4 + 1] * inv); w.y = cvtpk(o1[4 * g4 + 2] * inv, o1[4 * g4 + 3] * inv); }
            *(LAS u32x2*)(op + (32 * t + 8 * g4 + 4 * hi) * 2) = w;
        }
}
DI void load_kfrag(bf16x8 (&kf)[4], const bf16_t* fbase  , int tile) {
    const bf16_t* kp = fbase + (size_t)tile * 2048;
#pragma unroll
    for (int s = 0; s < 4; ++s) kf[s] = *(const bf16x8*)(kp + s * 512);
}
DI void load_vfrag(bf16x8 (&vf)[4], const bf16_t* fbase, int tile) {
    const bf16_t* vp = fbase + (size_t)tile * 2048;
#pragma unroll
    for (int q = 0; q < 4; ++q) vf[q] = *(const bf16x8*)(vp + q * 512);
}
DI void pv_accum2(f32x16& o0, f32x16& o1, const f32x16& p, const bf16x8 (&vf)[4]) {
#pragma unroll
    for (int s = 0; s < 2; ++s) {
        u32x4 pk; pk.x = cvtpk(p[8 * s], p[8 * s + 1]); pk.y = cvtpk(p[8 * s + 2], p[8 * s + 3]); pk.z = cvtpk(p[8 * s + 4], p[8 * s + 5]); pk.w = cvtpk(p[8 * s + 6], p[8 * s + 7]);
        const bf16x8 pb = __builtin_bit_cast(bf16x8, pk);
        o0 = MFMA32(vf[2 * s], pb, o0);
        o1 = MFMA32(vf[2 * s + 1], pb, o1);
    }
}

#define MEM_FENCE() asm volatile("" ::: "memory")
#define PIN1(a) asm volatile("" : "+v"(a) :: "memory")
#define PIN2(a, b) asm volatile("" : "+v"(a), "+v"(b) :: "memory")
DI void vm_drain() { __builtin_amdgcn_s_waitcnt(0x0F70); }
struct KvStream { const bf16_t* kbase; const bf16_t* vbase; };

struct MobaCtx { int q0, tq, blk, hi; unsigned selmask; float bfar; const LAS float* bt; };
DI void moba_tile(bf16x8 (&kf)[4], bf16x8 (&vf)[4], const bf16x8 (&qf)[4], int kt, int next, const KvStream& kv, const MobaCtx& c, float& mrun, float& lsum, f32x16& o0, f32x16& o1) {
    const int n = kt >> 3, key0 = kt * 32;
    f32x16 st = zero16();
#pragma unroll
    for (int s = 0; s < 4; ++s) st = MFMA32(kf[s], qf[s], st);
    PIN1(st); load_kfrag(kf, kv.kbase, next); PIN1(st);
    float x[16];
    if (n != c.blk) {
        const bool selq = (c.selmask >> n) & 1u;
        if ((c.q0 - (key0 + 31)) >= 128) {
            const float addend = selq ? c.bfar : -1e30f;
#pragma unroll
            for (int r = 0; r < 16; ++r) x[r] = st[r] * SCL2 + addend;
        } else {
#pragma unroll
            for (int r = 0; r < 16; ++r) { const int dist = c.tq - (key0 + crow(r, c.hi)); const float v = st[r] * SCL2 + c.bt[dist > 128 ? 128 : dist]; x[r] = selq ? v : -1e30f; }
        }
    } else {
#pragma unroll
        for (int r = 0; r < 16; ++r) { const int dist = c.tq - (key0 + crow(r, c.hi)); const float v = st[r] * SCL2 + c.bt[dist < 0 ? 0 : (dist > 128 ? 128 : dist)]; x[r] = (dist >= 0) ? v : -1e30f; }
    }
    float mx = x[0];
#pragma unroll
    for (int r = 1; r < 16; ++r) mx = fmaxf(mx, x[r]);
    mx = max_x32(mx);
    const float mnew = fmaxf(mrun, mx);
    if (!__all(mnew == mrun)) {
        const float alpha = __builtin_amdgcn_exp2f(mrun - mnew);
        lsum *= alpha;
#pragma unroll
        for (int r = 0; r < 16; ++r) { o0[r] *= alpha; o1[r] *= alpha; }
        mrun = mnew;
    }
    f32x16 pr; float ps = 0.f;
#pragma unroll
    for (int r = 0; r < 16; ++r) { const float e = __builtin_amdgcn_exp2f(x[r] - mrun); pr[r] = e; ps += e; }
    lsum += ps;
    pv_accum2(o0, o1, pr, vf);
    PIN2(o0, o1); load_vfrag(vf, kv.vbase, next); MEM_FENCE();
}
DI int moba_next(int kt, int blk, unsigned anysel) {
    int nkt = kt - 1;
    while (nkt >= 0) { const int nn = nkt >> 3; if (nn == blk || ((anysel >> nn) & 1u)) break; nkt = nn * 8 - 1; }
    return nkt;
}

DI void moba_unit(int b, int h, int qt, const bf16_t* Qm_, const bf16_t* Km_, const bf16_t* VtM_, const float* kmean_, const LAS float* biasLds, LAS unsigned char* ot, int lane) {
    const int r32 = lane & 31, hi = lane >> 5;
    const int q0 = qt * 32, tq = q0 + r32, blk = q0 >> 8;
    const size_t bh = (size_t)(b * 8 + h);
    const bf16_t* qfb = Qm_ + bh * (64 * 2048) + (size_t)qt * 2048;
    KvStream kv; kv.kbase = Km_ + bh * (64 * 2048) + lane * 8; kv.vbase = VtM_ + bh * (64 * 2048) + lane * 8;
    bf16x8 kf[4], vf[4];
    load_kfrag(kf, kv.kbase, qt); load_vfrag(vf, kv.vbase, qt);
    bf16x8 qf[4];
#pragma unroll
    for (int s = 0; s < 4; ++s) qf[s] = *(const bf16x8*)(qfb + s * 512 + lane * 8);
    unsigned selmask = 0;
    if (blk > 0) {
        float qv[32];
#pragma unroll
        for (int c = 0; c < 4; ++c) { const bf16x8 t = *(const bf16x8*)(qfb + (2 * hi + (c >> 1)) * 512 + ((c & 1) * 32 + r32) * 8);
#pragma unroll
            for (int j = 0; j < 8; ++j) qv[8 * c + j] = bf2f(t[j]); }
        const float* km = kmean_ + (size_t)((b * 8 + h) * 8) * 64 + 32 * hi;
        float g[8];
#pragma unroll
        for (int n = 0; n < 8; ++n) {
            float a = 0.f;
            if (n < blk) {
#pragma unroll
                for (int d4 = 0; d4 < 8; ++d4) { const f32x4 kv4 = *(const f32x4*)(km + n * 64 + 4 * d4); a += (qv[4 * d4] * kv4.x + qv[4 * d4 + 1] * kv4.y) + (qv[4 * d4 + 2] * kv4.z + qv[4 * d4 + 3] * kv4.w); }
            }
            a = sum_x32(a);
            g[n] = (n < blk) ? a : -INFINITY;
        }
#pragma unroll
        for (int n = 0; n < 8; ++n) {
            int rank = 0;
#pragma unroll
            for (int m = 0; m < 8; ++m) if (m != n) rank += ((g[m] > g[n]) || (g[m] == g[n] && m < n)) ? 1 : 0;
            if (n < blk && rank < 3) selmask |= 1u << n;
        }
    }
    unsigned anysel = 0;
#pragma unroll
    for (int n = 0; n < 8; ++n) if (__any((selmask >> n) & 1u)) anysel |= 1u << n;
    anysel = __builtin_amdgcn_readfirstlane(anysel);
    float mrun = -1e30f, lsum = 0.f;
    f32x16 o0 = zero16(), o1 = zero16();
    MobaCtx c; c.q0 = q0; c.tq = tq; c.blk = blk; c.hi = hi; c.selmask = selmask; c.bt = biasLds + h * 132; c.bfar = c.bt[128];
    vm_drain();
    int kt = qt;
    for (;;) {
        const int nx = moba_next(kt, blk, anysel);
        moba_tile(kf, vf, qf, kt, nx < 0 ? 0 : nx, kv, c, mrun, lsum, o0, o1);
        if (nx < 0) break;
        kt = nx;
    }
    lsum = sum_x32(lsum);
    const float inv = 1.f / lsum;
    store_o_lds(ot, r32, h, o0, o1, inv, hi);
}

DI void sb_tile(bf16x8 (&kf)[4], bf16x8 (&vf)[4], const bf16x8 (&qf)[4], int kt, int next, const KvStream& kv, int tq, int hi, float& C, f32x16& o0, f32x16& o1) {
    const int key0 = kt * 32;
    f32x16 st = zero16();
#pragma unroll
    for (int s = 0; s < 4; ++s) st = MFMA32(kf[s], qf[s], st);
    PIN1(st); load_kfrag(kf, kv.kbase, next); PIN1(st);
    float rr[16], be[16];
#pragma unroll
    for (int r = 0; r < 16; ++r) {
        const int key = key0 + crow(r, hi);
        const float y = fminf(st[r] * SCL2, 100.f);
        const float e = __builtin_amdgcn_exp2f(y);
        const float ri = __builtin_amdgcn_rcpf(1.f + e);
        const bool ok = key < tq;
        rr[r] = ok ? ri : 1.f;
        be[r] = ok ? e * ri : 0.f;
    }
    float G[4], ex[16], Gp[4], Tt[4], Suf[4];
#pragma unroll
    for (int a = 0; a < 4; ++a) {
        ex[4 * a + 3] = 1.f; ex[4 * a + 2] = rr[4 * a + 3]; ex[4 * a + 1] = ex[4 * a + 2] * rr[4 * a + 2]; ex[4 * a] = ex[4 * a + 1] * rr[4 * a + 1];
        G[a] = ex[4 * a] * rr[4 * a];
    }
#pragma unroll
    for (int a = 0; a < 4; ++a) { float lo_, hi_; swap32(G[a], lo_, hi_); Gp[a] = hi_; Tt[a] = lo_ * hi_; }
    Suf[3] = 1.f; Suf[2] = Tt[3]; Suf[1] = Tt[3] * Tt[2]; Suf[0] = Suf[1] * Tt[1];
    f32x16 pr;
#pragma unroll
    for (int a = 0; a < 4; ++a) {
        const float after = Suf[a] * (hi == 0 ? Gp[a] : 1.f) * C;
#pragma unroll
        for (int i = 0; i < 4; ++i) pr[4 * a + i] = be[4 * a + i] * ex[4 * a + i] * after;
    }
    C = C * (Suf[0] * Tt[0]);
    pv_accum2(o0, o1, pr, vf);
    PIN2(o0, o1); load_vfrag(vf, kv.vbase, next); MEM_FENCE();
}

DI void sb_unit(int b, int h, int qt, const bf16_t* Qs_, const bf16_t* Ks_, const bf16_t* VtS_, LAS unsigned char* ot, int lane) {
    const int r32 = lane & 31, hi = lane >> 5;
    const int q0 = qt * 32, tq = q0 + r32;
    const size_t bh = (size_t)(b * 8 + h);
    const bf16_t* qfb = Qs_ + bh * (64 * 2048) + (size_t)qt * 2048;
    KvStream kv; kv.kbase = Ks_ + bh * (64 * 2048) + lane * 8; kv.vbase = VtS_ + bh * (64 * 2048) + lane * 8;
    bf16x8 kf[4], vf[4];
    load_kfrag(kf, kv.kbase, qt); load_vfrag(vf, kv.vbase, qt);
    bf16x8 qf[4];
#pragma unroll
    for (int s = 0; s < 4; ++s) qf[s] = *(const bf16x8*)(qfb + s * 512 + lane * 8);
    f32x16 o0 = zero16(), o1 = zero16();
    float C = 1.f;
    vm_drain();
    for (int kt = qt; kt >= 0; --kt) {
        sb_tile(kf, vf, qf, kt, kt > 0 ? kt - 1 : 0, kv, tq, hi, C, o0, o1);
        if (__all(C == 0.f ? 1 : 0)) break;
    }
    store_o_lds(ot, r32, h, o0, o1, 1.f, hi);
}

DI void ce_desc(unsigned& a, unsigned& b) { const unsigned hi = a > b ? a : b, lo = a > b ? b : a; a = hi; b = lo; }
DI void bitonic_clean_desc(unsigned (&v)[16]) {
#pragma unroll
    for (int s = 8; s >= 1; s >>= 1)
#pragma unroll
        for (int i = 0; i < 16; ++i) if ((i & s) == 0) ce_desc(v[i], v[i + s]);
}
DI void sort16_desc(unsigned (&v)[16]) {
#pragma unroll
    for (int k = 2; k <= 16; k <<= 1)
#pragma unroll
        for (int j = k >> 1; j >= 1; j >>= 1)
#pragma unroll
            for (int i = 0; i < 16; ++i) { const int l = i ^ j; if (l > i) { if ((i & k) == 0) ce_desc(v[i], v[l]); else ce_desc(v[l], v[i]); } }
}
DI float key_value(unsigned key) { const unsigned kk = key & ~127u; const unsigned u = (kk & 0x80000000u) ? (kk & 0x7fffffffu) : ~kk; return __builtin_bit_cast(float, u); }
DI float key_value8(unsigned key) { const unsigned kk = key & ~255u; const unsigned u = (kk & 0x80000000u) ? (kk & 0x7fffffffu) : ~kk; return __builtin_bit_cast(float, u); }
template <int CTRL> DI unsigned dppu(unsigned v) { return (unsigned)__builtin_amdgcn_update_dpp(0, (int)v, CTRL, 0xF, 0xF, true); }
DI void sort8_desc(unsigned (&v)[8]) {
    ce_desc(v[0], v[2]); ce_desc(v[1], v[3]); ce_desc(v[4], v[6]); ce_desc(v[5], v[7]);
    ce_desc(v[0], v[4]); ce_desc(v[1], v[5]); ce_desc(v[2], v[6]); ce_desc(v[3], v[7]);
    ce_desc(v[0], v[1]); ce_desc(v[2], v[3]); ce_desc(v[4], v[5]); ce_desc(v[6], v[7]);
    ce_desc(v[2], v[4]); ce_desc(v[3], v[5]);
    ce_desc(v[1], v[4]); ce_desc(v[3], v[6]);
    ce_desc(v[1], v[2]); ce_desc(v[3], v[4]); ce_desc(v[5], v[6]);
}
DI void clean8_desc(unsigned (&v)[8]) {
#pragma unroll
    for (int s = 4; s >= 1; s >>= 1)
#pragma unroll
        for (int i = 0; i < 8; ++i) if ((i & s) == 0) ce_desc(v[i], v[i + s]);
}
template <int CTRL> DI void cross_rev_max(unsigned (&v)[8]) {
    unsigned t[8];
#pragma unroll
    for (int i = 0; i < 8; ++i) t[i] = dppu<CTRL>(v[7 - i]);
#pragma unroll
    for (int i = 0; i < 8; ++i) v[i] = v[i] > t[i] ? v[i] : t[i];
}
template <bool REV> DI void cross_minmax_x1(unsigned (&v)[8], bool odd) {
    unsigned t[8];
#pragma unroll
    for (int i = 0; i < 8; ++i) t[i] = dppu<DPP_XOR1>(v[REV ? 7 - i : i]);
#pragma unroll
    for (int i = 0; i < 8; ++i) { const unsigned hi = v[i] > t[i] ? v[i] : t[i], lo = v[i] > t[i] ? t[i] : v[i]; v[i] = odd ? lo : hi; }
}

DI float reduce16(const float (&p)[16], int lane) {
    const bool b3 = lane & 8, b2 = lane & 4, b1 = lane & 2, b0 = lane & 1;
    float q[8], r[4], s[2];
#pragma unroll
    for (int i = 0; i < 8; ++i) { const float mine = b3 ? p[i + 8] : p[i], send = b3 ? p[i] : p[i + 8]; q[i] = mine + __shfl_xor(send, 8); }
#pragma unroll
    for (int i = 0; i < 4; ++i) { const float mine = b2 ? q[i + 4] : q[i], send = b2 ? q[i] : q[i + 4]; r[i] = mine + __shfl_xor(send, 4); }
#pragma unroll
    for (int i = 0; i < 2; ++i) { const float mine = b1 ? r[i + 2] : r[i], send = b1 ? r[i] : r[i + 2]; s[i] = mine + __shfl_xor(send, 2); }
    const float mine = b0 ? s[1] : s[0], send = b0 ? s[0] : s[1];
    float t = mine + __shfl_xor(send, 1);
    t = sum_x32(sum_x16(t));
    return t;
}

#ifndef PEER_REP_TOPK
#define PEER_REP_TOPK 1
#endif
#ifndef PEER_REP_U
#define PEER_REP_U 1
#endif
#ifndef PEER_REP_V
#define PEER_REP_V 1
#endif
struct TopkIn { bf16x8 hv[2]; bf16x8 sv[4]; };
DI void peer_topk_load(TopkIn& in, int tok, const bf16_t* h1b, const bf16_t* scores, int lane) {
    const int tc = tok < T ? tok : T - 1;
    const bf16_t* hrow = h1b + (size_t)tc * 1024 + 16 * lane;
    const bf16_t* sp = scores + (size_t)tc * 2048 + (lane >> 2) * 128 + (lane & 3) * 8;
#pragma unroll
    for (int i = 0; i < 4; ++i) in.sv[i] = *(const bf16x8*)(sp + 32 * i);
    in.hv[0] = *(const bf16x8*)hrow; in.hv[1] = *(const bf16x8*)(hrow + 8);
}
DI void peer_topk_token(int tok, const TopkIn& in, const float* gffn, int* EIDXg, float* GATEg, unsigned char* XN2g, float* XSg, LAS float* wl, int lane) {
    LAS unsigned* kbuf = (LAS unsigned*)wl; const LAS unsigned* ctab = (const LAS unsigned*)(wl + 768);
    f32x4 hv[4];
    float ss = 0.f;
#pragma unroll
    for (int i = 0; i < 4; ++i) { const bf16x8 hb = in.hv[i >> 1]; const int o4 = 4 * (i & 1); hv[i] = (f32x4){bf2f(hb[o4]), bf2f(hb[o4 + 1]), bf2f(hb[o4 + 2]), bf2f(hb[o4 + 3])}; ss += (hv[i].x * hv[i].x + hv[i].y * hv[i].y) + (hv[i].z * hv[i].z + hv[i].w * hv[i].w); }
    ss = wave_sum(ss);
    const float rs2 = rsqrtf(ss * (1.f / 1024.f) + EPS);
    {
        float y[16], m = 0.f;
#pragma unroll
        for (int i = 0; i < 4; ++i) { const f32x4 gv = *(const f32x4*)(gffn + 16 * lane + 4 * i);
#pragma unroll
            for (int e = 0; e < 4; ++e) { y[4 * i + e] = hv[i][e] * rs2 * gv[e]; m = fmaxf(m, fabsf(y[4 * i + e])); } }
        m = wave_max(m);
        const float inv = m > 0.f ? 119.f / m : 0.f;
        unsigned xh0 = 0u, xh1 = 0u, xl0 = 0u, xl1 = 0u;
#pragma unroll
        for (int e = 0; e < 16; ++e) {
            const int q = (int)rintf(y[e] * inv);
            const unsigned nl = (unsigned)q & 15u, nh = (unsigned)((q + 8) >> 4) & 15u;
            if (e < 8) { xl0 |= nl << (4 * e); xh0 |= nh << (4 * e); } else { xl1 |= nl << (4 * (e - 8)); xh1 |= nh << (4 * (e - 8)); }
        }
        u32x2 wh, wl2; wh.x = xh0; wh.y = xh1; wl2.x = xl0; wl2.y = xl1;
        *(u32x2*)(XN2g + (size_t)tok * 1024 + 8 * lane) = wh;
        *(u32x2*)(XN2g + (size_t)tok * 1024 + 512 + 8 * lane) = wl2;
        if (lane == 0) XSg[tok] = m > 0.f ? m * (1.f / 119.f) : 0.f;
    }
    {
        const int L = lane >> 2, q = lane & 3;
        unsigned k0[16], k1[16];
#pragma unroll
        for (int i = 0; i < 4; ++i) {
            const bf16x8 v = in.sv[i];
#pragma unroll
            for (int cI = 0; cI < 8; ++cI) {
                const unsigned u = ((unsigned)(unsigned short)v[cI]) << 16;
                const unsigned mono = (u & 0x80000000u) ? ~u : (u | 0x80000000u);
                const unsigned key = (mono & ~127u) | (unsigned)(127 - (32 * i + 8 * q + cI));
                if (i < 2) k0[8 * i + cI] = key; else k1[8 * (i - 2) + cI] = key;
            }
        }
        sort16_desc(k0); sort16_desc(k1);
        unsigned t[16];
#pragma unroll
        for (int i = 0; i < 16; ++i) t[i] = k0[i] > k1[15 - i] ? k0[i] : k1[15 - i];
        bitonic_clean_desc(t);
#pragma unroll
        for (int i = 0; i < 16; ++i) k0[i] = (unsigned)__builtin_amdgcn_update_dpp(0, (int)t[15 - i], 0xB1, 0xF, 0xF, true);
#pragma unroll
        for (int i = 0; i < 16; ++i) t[i] = t[i] > k0[i] ? t[i] : k0[i];
        bitonic_clean_desc(t);
#pragma unroll
        for (int i = 0; i < 16; ++i) k0[i] = (unsigned)__builtin_amdgcn_update_dpp(0, (int)t[15 - i], 0x4E, 0xF, 0xF, true);
#pragma unroll
        for (int i = 0; i < 16; ++i) t[i] = t[i] > k0[i] ? t[i] : k0[i];
        bitonic_clean_desc(t);
        if (q == 0) {
#pragma unroll
            for (int i = 0; i < 4; ++i) { u32x4 w; w.x = t[4 * i]; w.y = t[4 * i + 1]; w.z = t[4 * i + 2]; w.w = t[4 * i + 3]; *(LAS u32x4*)(kbuf + L * 16 + 4 * i) = w; }
        }
        asm volatile("s_waitcnt lgkmcnt(0)" ::: "memory");
    }
    {
        const int hd = lane >> 3, sub = lane & 7; const bool odd = sub & 1;
        unsigned ck[8];
#pragma unroll
        for (int k = 0; k < 7; ++k) {
            const int cidx = 7 * sub + k;
            const unsigned tab = ctab[cidx];
            const unsigned ia = tab & 15u, ib = (tab >> 8) & 15u;
            const unsigned ka = kbuf[hd * 32 + ia], kb = kbuf[hd * 32 + 16 + ib];
            const float v = key_value(ka) + key_value(kb);
            const unsigned u = __float_as_uint(v);
            const unsigned mono = (u & 0x80000000u) ? ~u : (u | 0x80000000u);
            ck[k] = (cidx < 50) ? ((mono & ~255u) | (255u - (16u * ia + ib))) : 0u;
        }
        ck[7] = 0u;
        sort8_desc(ck);
        cross_minmax_x1<true>(ck, odd); clean8_desc(ck);
        cross_rev_max<0x1B>(ck); cross_minmax_x1<false>(ck, odd); clean8_desc(ck);
        cross_rev_max<DPP_HMIR>(ck); cross_minmax_x1<false>(ck, odd); clean8_desc(ck);
        const int pr = sub >> 1;
        const unsigned e0 = pr == 0 ? ck[0] : pr == 1 ? ck[2] : pr == 2 ? ck[4] : ck[6];
        const unsigned e1 = pr == 0 ? ck[1] : pr == 1 ? ck[3] : pr == 2 ? ck[5] : ck[7];
        const unsigned id0 = 255u - (e0 & 255u), id1 = 255u - (e1 & 255u);
        const unsigned ka0 = kbuf[hd * 32 + (id0 >> 4)], kb0 = kbuf[hd * 32 + 16 + (id0 & 15u)];
        const unsigned ka1 = kbuf[hd * 32 + (id1 >> 4)], kb1 = kbuf[hd * 32 + 16 + (id1 & 15u)];
        const float v0 = key_value8(e0), v1 = key_value8(e1);
        const float mx = max_oct(fmaxf(v0, v1));
        const float ev0 = __expf((v0 - mx) * rs2), ev1 = __expf((v1 - mx) * rs2);
        const float inv = 1.f / sum_oct(ev0 + ev1);
        const int rank0 = (odd ? 8 : 0) + 2 * pr;
        u32x2 ew; ew.x = (127u - (ka0 & 127u)) * 128u + (127u - (kb0 & 127u)); ew.y = (127u - (ka1 & 127u)) * 128u + (127u - (kb1 & 127u));
        f32x2 gw; gw.x = ev0 * inv; gw.y = ev1 * inv;
        *(u32x2*)(EIDXg + (size_t)tok * 128 + hd * 16 + rank0) = ew;
        *(f32x2*)(GATEg + (size_t)tok * 128 + hd * 16 + rank0) = gw;
    }
}

DI float dot16_fp8(const u32x4& row, const float (&x)[16]) {
    float sacc = 0.f;
#pragma unroll
    for (int w = 0; w < 4; ++w) { const f32x2 lo = __builtin_amdgcn_cvt_pk_f32_fp8((int)row[w], false), hi2 = __builtin_amdgcn_cvt_pk_f32_fp8((int)row[w], true);
        sacc += lo.x * x[4 * w] + lo.y * x[4 * w + 1] + hi2.x * x[4 * w + 2] + hi2.y * x[4 * w + 3]; }
    return sacc;
}
template <class TT> DI TT ldu(const void* ubase, unsigned off) { return *(const TT*)((const char*)ubase + off); }
typedef _Float16 h2_t __attribute__((ext_vector_type(2)));
template <bool LO>
DI void peer_u_slice(int sl, int t_lo, int t_hi, int tk_first, int tk_step, const unsigned char* XNg, const int* EIDXg, const unsigned char* U6s, bf16_t* PDOT, int lane) {
    const int es = lane >> 3, c = lane & 7;
    const unsigned char* tb = U6s + (size_t)sl * 16384 * 128;
    const unsigned c16 = 16u * c, eoff = 64u * es, poff = (16u * es + c) * 2u;
    const unsigned xoff = LO ? 256u * (unsigned)(sl - 4) + 32u * c : 128u * (unsigned)sl + 16u * c;
    const bool b2 = c & 4, b1 = c & 2, b0 = c & 1;
    constexpr int NX = LO ? 2 : 1;
    u32x4 I0[2], I1[2], I2[2], rowsA[8], rowsB[8], rowsC[8], xh0[NX], xl0[NX], xh1[NX], xl1[NX], xh2[NX], xl2[NX];
#define LD_E8(ib, tk, h) do { const int _t = (tk) < t_hi ? (tk) : t_hi - 1; const int* _eb = EIDXg + (size_t)_t * 128 + 8 * (h); ib[0] = ldu<u32x4>(_eb, eoff); ib[1] = ldu<u32x4>(_eb, eoff + 16u); } while (0)
#define LD_R8(rows, ib, tbl) do { _Pragma("unroll") for (int _q = 0; _q < 2; ++_q) _Pragma("unroll") for (int _r = 0; _r < 4; ++_r) rows[4 * _q + _r] = ldu<u32x4>(tbl, ib[_q][_r] * 128u + c16); } while (0)
#define LD_X(xh, xl, tk) do { const int _t = (tk) < t_hi ? (tk) : t_hi - 1; const unsigned char* _xb = XNg + (size_t)_t * 1024; \
        _Pragma("unroll") for (int _n = 0; _n < NX; ++_n) { xh[_n] = ldu<u32x4>(_xb, xoff + 16u * _n); xl[_n] = ldu<u32x4>(_xb, 512u + xoff + 16u * _n); } } while (0)
#define U_COMPUTE8(rows, xh, xl, tk, h) do { \
        float _p[8]; _Pragma("unroll") for (int _i = 0; _i < 8; ++_i) { if (_i > 0) asm volatile("" : "+v"(rows[_i]) : "v"(_p[_i - 1])); int _ah = 0, _al = 0; \
            _Pragma("unroll") for (int _w = 0; _w < 4; ++_w) { const unsigned _d = rows[_i][_w]; \
                if (LO) { const int _e = (int)(_d & 0x33333333u), _o = (int)((_d >> 2) & 0x33333333u); const int _n = _w >> 1, _k = 2 * (_w & 1); \
                    _ah = __builtin_amdgcn_sdot8(_e, (int)xh[_n][_k], _ah, false); _ah = __builtin_amdgcn_sdot8(_o, (int)xh[_n][_k + 1], _ah, false); \
                    _al = __builtin_amdgcn_sdot8(_e, (int)xl[_n][_k], _al, false); _al = __builtin_amdgcn_sdot8(_o, (int)xl[_n][_k + 1], _al, false); } \
                else { _ah = __builtin_amdgcn_sdot8((int)_d, (int)xh[0][_w], _ah, false); _al = __builtin_amdgcn_sdot8((int)_d, (int)xl[0][_w], _al, false); } } \
            _p[_i] = LO ? (float)(16 * _ah + _al) : (float)(64 * _ah + 4 * _al); } \
        float _q4[4], _q2[2]; \
        _Pragma("unroll") for (int _k = 0; _k < 4; ++_k) _q4[_k] = tr_x4(_p[_k], _p[_k + 4], b2); \
        _Pragma("unroll") for (int _k = 0; _k < 2; ++_k) _q2[_k] = tr_x2(_q4[_k], _q4[_k + 2], b1); \
        const float _r1 = tr_x1(_q2[0], _q2[1], b0); \
        if ((tk) < t_hi) { bf16_t* _pb = PDOT + ((size_t)sl * T + (tk)) * 128 + 8 * (h); *(bf16_t*)((char*)_pb + poff) = f2bf(_r1); } } while (0)
    int t0 = t_lo + tk_first;
    LD_E8(I0, t0, 0); LD_E8(I1, t0, 1); LD_E8(I2, t0 + tk_step, 0); LD_X(xh0, xl0, t0); LD_R8(rowsA, I0, tb); LD_R8(rowsB, I1, tb);
#pragma unroll 1
    for (; t0 < t_hi; t0 += 3 * tk_step) {
        const int t1 = t0 + tk_step, t2 = t1 + tk_step, t3 = t2 + tk_step;
        LD_E8(I0, t1, 1);           LD_R8(rowsC, I2, tb); LD_X(xh1, xl1, t1); U_COMPUTE8(rowsA, xh0, xl0, t0, 0);
        LD_E8(I1, t2, 0);           LD_R8(rowsA, I0, tb);                     U_COMPUTE8(rowsB, xh0, xl0, t0, 1);
        LD_E8(I2, t2, 1);           LD_R8(rowsB, I1, tb); LD_X(xh2, xl2, t2); U_COMPUTE8(rowsC, xh1, xl1, t1, 0);
        LD_E8(I0, t3, 0);           LD_R8(rowsC, I2, tb);                     U_COMPUTE8(rowsA, xh1, xl1, t1, 1);
        LD_E8(I1, t3, 1);           LD_R8(rowsA, I0, tb); LD_X(xh0, xl0, t3); U_COMPUTE8(rowsB, xh2, xl2, t2, 0);
        LD_E8(I2, t3 + tk_step, 0); LD_R8(rowsB, I1, tb);                     U_COMPUTE8(rowsC, xh2, xl2, t2, 1);
    }
#undef U_COMPUTE8
#undef LD_X
}
DI float erf_as(float x) {
    const float ax = fabsf(x), t = __builtin_amdgcn_rcpf(1.f + 0.3275911f * ax);
    const float poly = t * (0.254829592f + t * (-0.284496736f + t * (1.421413741f + t * (-1.453152027f + t * 1.061405429f))));
    const float r = 1.f - poly * __expf(-ax * ax);
    return copysignf(r, x);
}
template <int NT> DI void peer_cj_tokens(int tok0, int tstride, const int* EIDXg, const float* GATEg, const bf16_t* PDOT, const float* usc, const float* vsc, const float* XSg, float* CJg, float* CMAXg, int lane) {
    int e[NT][2]; float d[NT][2], g[NT][2];
#pragma unroll
    for (int i = 0; i < NT; ++i) { const int tok = tok0 + i * tstride, tc = tok < T ? tok : T - 1;
#pragma unroll
        for (int hh = 0; hh < 2; ++hh) { const int j = lane + 64 * hh; e[i][hh] = EIDXg[(size_t)tc * 128 + j]; g[i][hh] = GATEg[(size_t)tc * 128 + j]; float a = 0.f;
#pragma unroll
            for (int x = 0; x < 6; ++x) a += bf2f((short)PDOT[((size_t)x * T + tc) * 128 + j]);
            d[i][hh] = a * XSg[tc]; } }
    float us[NT][2], vs[NT][2];
#pragma unroll
    for (int i = 0; i < NT; ++i)
#pragma unroll
        for (int hh = 0; hh < 2; ++hh) { us[i][hh] = usc[e[i][hh]]; vs[i][hh] = vsc[e[i][hh]]; }
#pragma unroll
    for (int i = 0; i < NT; ++i) { const int tok = tok0 + i * tstride;
        float cv[2], cm = 0.f;
#pragma unroll
        for (int hh = 0; hh < 2; ++hh) {
            const float hraw = d[i][hh] * us[i][hh];
            const float hid = 0.5f * hraw * (1.f + erf_as(hraw * 0.70710678118654752f));
            cv[hh] = hid * g[i][hh] * vs[i][hh];
            cm = fmaxf(cm, fabsf(cv[hh]));
        }
        cm = wave_max(cm);
        const float inv = cm > 0.f ? 1.f / cm : 0.f;
        if (tok < T) { CJg[(size_t)tok * 128 + lane] = cv[0] * inv; CJg[(size_t)tok * 128 + 64 + lane] = cv[1] * inv; if (lane == 0) CMAXg[tok] = cm; }
    }
}
DI void peer_v_slice(int sl, int tk_first, int tk_step, const bf16_t* H1b, const int* EIDXg, const float* CJg, const float* CMAXg, const unsigned char* V8s, bf16_t* A4g, float* SSQg, int lane) {
    const int es = lane >> 3, c = lane & 7;
    constexpr int t_hi = T;
    const unsigned char* tb = V8s + (size_t)sl * 16384 * 128;
    const unsigned c16 = 16u * c, eoff = 64u * es, ob = 128u * sl + 16u * c + 2u * es;
    const bool b5 = lane & 32, b4 = lane & 16, b3 = lane & 8;
    u32x4 I0[2], I1[2], I2[2], rowsA[8], rowsB[8], rowsC[8]; f32x4 cA[2], cB[2], cC[2]; unsigned h0, h1, h2;
#define LD_C8(cc, tk, h) do { const int _t = (tk) < T ? (tk) : T - 1; const float* _cb = CJg + (size_t)_t * 128 + 8 * (h); cc[0] = ldu<f32x4>(_cb, eoff); cc[1] = ldu<f32x4>(_cb, eoff + 16u); } while (0)
#define V_AXPY8(rows, cc) do { _Pragma("unroll") for (int _q = 0; _q < 2; ++_q) _Pragma("unroll") for (int _r = 0; _r < 4; ++_r) { const _Float16 _ch = (_Float16)cc[_q][_r]; const h2_t _c2 = {_ch, _ch}; \
            _Pragma("unroll") for (int _w = 0; _w < 4; ++_w) { acch[2 * _w] = __builtin_amdgcn_cvt_scalef32_pk_f16_fp8(rows[4 * _q + _r][_w], 1.0f, false) * _c2 + acch[2 * _w]; \
                acch[2 * _w + 1] = __builtin_amdgcn_cvt_scalef32_pk_f16_fp8(rows[4 * _q + _r][_w], 1.0f, true) * _c2 + acch[2 * _w + 1]; } \
              \
            if (4 * _q + _r < 7) asm volatile("" : "+v"(acch[0]), "+v"(acch[1]), "+v"(acch[2]), "+v"(acch[3]), "+v"(acch[4]), "+v"(acch[5]), "+v"(acch[6]), "+v"(acch[7]), "+v"(rows[(4 * _q + _r + 1) & 7])); \
            else asm volatile("" : "+v"(acch[0]), "+v"(acch[1]), "+v"(acch[2]), "+v"(acch[3]), "+v"(acch[4]), "+v"(acch[5]), "+v"(acch[6]), "+v"(acch[7])); } } while (0)
#define LD_H(hh, tk) do { const int _t = (tk) < T ? (tk) : T - 1; hh = ldu<unsigned>(H1b + (size_t)_t * 1024, ob * 2u); } while (0)
#define V_ZERO() do { _Pragma("unroll") for (int _i = 0; _i < 8; ++_i) acch[_i] = (h2_t){(_Float16)0.f, (_Float16)0.f}; } while (0)
#define V_FINAL(hh, tk) do { float _a[16]; _Pragma("unroll") for (int _i = 0; _i < 8; ++_i) { _a[2 * _i] = (float)acch[_i].x; _a[2 * _i + 1] = (float)acch[_i].y; } \
        const float _cm = CMAXg[(tk) < T ? (tk) : T - 1]; \
        float _q8[8], _q4[4], _q2[2]; \
        _Pragma("unroll") for (int _k = 0; _k < 8; ++_k) _q8[_k] = tr_x32(_a[_k], _a[_k + 8]); \
        _Pragma("unroll") for (int _k = 0; _k < 4; ++_k) _q4[_k] = tr_x16(_q8[_k], _q8[_k + 4]); \
        _Pragma("unroll") for (int _k = 0; _k < 2; ++_k) _q2[_k] = tr_x8(_q4[_k], _q4[_k + 2], b3); \
        const float _ha = __builtin_bit_cast(float, hh << 16) + _q2[0] * _cm, _hb = __builtin_bit_cast(float, hh & 0xffff0000u) + _q2[1] * _cm; const float _ssq = wave_sum(_ha * _ha + _hb * _hb); \
        if ((tk) < T) { *(unsigned*)((char*)(A4g + (size_t)(tk) * 1024) + ob * 2u) = cvtpk(_ha, _hb); \
            if (lane == 0) SSQg[(size_t)sl * T + (tk)] = _ssq; } } while (0)
    h2_t acch[8];
    int t0 = tk_first;
    LD_E8(I0, t0, 0); LD_E8(I1, t0, 1); LD_E8(I2, t0 + tk_step, 0); LD_H(h0, t0); LD_R8(rowsA, I0, tb); LD_C8(cA, t0, 0); LD_R8(rowsB, I1, tb); LD_C8(cB, t0, 1);
#pragma unroll 1
    for (; t0 < T; t0 += 3 * tk_step) {
        const int t1 = t0 + tk_step, t2 = t1 + tk_step, t3 = t2 + tk_step;
        LD_E8(I0, t1, 1);           LD_R8(rowsC, I2, tb); LD_C8(cC, t1, 0); LD_H(h1, t1); V_ZERO(); V_AXPY8(rowsA, cA);
        LD_E8(I1, t2, 0);           LD_R8(rowsA, I0, tb); LD_C8(cA, t1, 1);                          V_AXPY8(rowsB, cB); V_FINAL(h0, t0);
        LD_E8(I2, t2, 1);           LD_R8(rowsB, I1, tb); LD_C8(cB, t2, 0); LD_H(h2, t2); V_ZERO(); V_AXPY8(rowsC, cC);
        LD_E8(I0, t3, 0);           LD_R8(rowsC, I2, tb); LD_C8(cC, t2, 1);                          V_AXPY8(rowsA, cA); V_FINAL(h1, t1);
        LD_E8(I1, t3, 1);           LD_R8(rowsA, I0, tb); LD_C8(cA, t3, 0); LD_H(h0, t3); V_ZERO(); V_AXPY8(rowsB, cB);
        LD_E8(I2, t3 + tk_step, 0); LD_R8(rowsB, I1, tb); LD_C8(cB, t3, 1);                          V_AXPY8(rowsC, cC); V_FINAL(h2, t2);
    }
#undef V_FINAL
#undef V_ZERO
#undef LD_H
#undef V_AXPY8
#undef LD_C8
#undef LD_R8
#undef LD_E8
}

typedef const __attribute__((address_space(4))) unsigned long long* karg_ptr_t;
DI karg_ptr_t kargs() { karg_ptr_t p = (karg_ptr_t)__builtin_amdgcn_kernarg_segment_ptr(); asm volatile("" : "+s"(p)); return p; }
#define GAS1 __attribute__((address_space(1)))
#define KIN(k) ((const float*)(const GAS1 float*)kargs()[k])
#define KOUT() ((float*)(GAS1 float*)kargs()[18])
#define KWS() ((unsigned char*)(GAS1 unsigned char*)kargs()[19])

__global__ void __launch_bounds__(512, 2) fwd_kernel(Params P) {
    extern __shared__ __attribute__((aligned(16))) unsigned char lds_raw[];
    LAS unsigned char* lds = (LAS unsigned char*)lds_raw;
    const int tid = threadIdx.x, lane = tid & 63, wid = __builtin_amdgcn_readfirstlane(tid >> 6);
    const int wg = blockIdx.x, nwg = gridDim.x;
    const int gwave = wg * 8 + wid, nwaves = nwg * 8;
    const int lo = P.ph_lo, hi = P.ph_hi;

    volatile LAS unsigned* misc = (volatile LAS unsigned*)(lds + LDS_BYTES - 64);
    if (tid < 16) misc[tid] = 0u;
    __syncthreads();
    { unsigned* xcw = (unsigned*)(KWS() + WS_CTL) + CW_XC;
      if (tid == 0) { const unsigned xcc = xb_xcc_id(); misc[5] = xcc; misc[4] = xb_add(xcw + 64 * xcc, 1u); } }
    XcdBarrier bar; bar.bar = (unsigned*)(KWS() + WS_CTL) + CW_BAR; bar.x = 0; bar.st = misc;
    if (hi - lo > 1) bar = xcd_barrier_post((unsigned*)(KWS() + WS_CTL) + CW_BAR, misc);

#define kmean   ((float*)(KWS() + WS_KMEAN))
#define biasTab ((float*)(KWS() + WS_BIAS))
#define WinT    ((bf16_t*)(KWS() + WS_WIN))
#define WoutT   ((bf16_t*)(KWS() + WS_WOUT))
#define WqT     ((bf16_t*)(KWS() + WS_WQ))
#define WgT     ((bf16_t*)(KWS() + WS_WG))
#define WpleT   ((bf16_t*)(KWS() + WS_WPLE))
#define U8      ((unsigned char*)(KWS() + WS_U))
#define V8      ((unsigned char*)(KWS() + WS_V))
#define USC     ((float*)(KWS() + WS_USC))
#define VSC     ((float*)(KWS() + WS_VSC))
#define XN      ((bf16_t*)(KWS() + WS_XN))
#define PB      ((bf16_t*)(KWS() + WS_PB))
#define Qm      ((bf16_t*)(KWS() + WS_QM))
#define Km      ((bf16_t*)(KWS() + WS_KM))
#define VtM     ((bf16_t*)(KWS() + WS_VTM))
#define Qs      ((bf16_t*)(KWS() + WS_QS))
#define Ks      ((bf16_t*)(KWS() + WS_KS))
#define VtS     ((bf16_t*)(KWS() + WS_VTS))
#define Oraw    ((bf16_t*)(KWS() + WS_ORAW))
#define A2      ((bf16_t*)(KWS() + WS_A2))
#define A3      ((bf16_t*)(KWS() + WS_A3))
#define SC      ((float*)(KWS() + WS_SC))
#define EIDXG   ((int*)(KWS() + WS_EIDX))
#define GATEG   ((float*)(KWS() + WS_GATE))
#define CJG     ((float*)(KWS() + WS_CJ))
#define RS2G    ((float*)(KWS() + WS_RS2))
#define SSQG    ((float*)(KWS() + WS_SSQ))
#define PDOTG   ((bf16_t*)(KWS() + WS_PDOT))
#define A4G     ((bf16_t*)(KWS() + WS_A4))
#define XN2G    ((unsigned char*)(KWS() + WS_XN2))
#define XSG     ((float*)(KWS() + WS_XS))

#define IN(k) (lo <= (k) && (k) < hi)
#ifndef PROBE_PHASE
#define PROBE_PHASE -1
#endif
#ifndef PROBE_REPS
#define PROBE_REPS 1
#endif
#define REP(k) for (int _rep = 0; _rep < ((k) == PROBE_PHASE ? PROBE_REPS : 1); ++_rep)
#define SEAM(k) do { if (IN(k) && IN((k) + 1)) { if ((k) == 0 || PROBE_LO_NONZERO) xcd_barrier<true>(bar); else xcd_barrier<false>(bar); } } while (0)
#define PROBE_LO_NONZERO 0

    if (IN(0)) REP(0) {
        {
            LAS float* scr = (LAS float*)lds + wid * (64 * 65);
            const float* win = KIN(IN_WIN); const float* wout = KIN(IN_WOUT); const float* wpg = KIN(IN_WPG); const float* wple = KIN(IN_WPLE); const float* pln = KIN(IN_PLE_NORM);
            bf16_t* wint = WinT; bf16_t* woutt = WoutT; bf16_t* wgt = WgT; bf16_t* wplet = WpleT;
            for (int t = gwave; t < 1344; t += nwaves) {
                const int sel = t < 768 ? 0 : t < 1024 ? 1 : t < 1280 ? 2 : 3;
                const int tt = sel == 0 ? t : sel == 1 ? t - 768 : sel == 2 ? t - 1024 : t - 1280;
                const float* W = sel == 0 ? win : sel == 1 ? wout : sel == 2 ? wpg : wple;
                bf16_t* Wt = sel == 0 ? wint : sel == 1 ? woutt : sel == 2 ? wgt : wplet;
                const int K = sel == 3 ? 256 : 1024, N = sel == 0 ? 3072 : 1024, tn = sel == 0 ? 48 : 16;
                p0_transpose_wave(W, K, N, Wt, scr, lane, (tt / tn) * 64, (tt % tn) * 64, sel == 0, sel == 2 ? pln : nullptr);
            }
        }
        p0_fold(KIN(IN_PQ), KIN(IN_SUBK), KIN(IN_FFN_NORM), WqT, wid, lane, wg, nwg);
        const size_t gtid = (size_t)wg * 512 + tid, nthr = (size_t)nwg * 512;
        p0_convert(KIN(IN_P), PB, (size_t)T * 256, gtid, nthr);
        { const float* xp = KIN(IN_X); const float* gp = KIN(IN_ATTN_NORM); bf16_t* xo = XN;
          for (int row = gwave; row < T; row += 2 * nwaves) rmsnorm_rows2_bf16(xp, gp, xo, row, row + nwaves, lane); }
        if (wg == 0) {
            for (int idx = tid; idx < 8 * 129; idx += 512) {
                const int h = idx / 129, dist = idx % 129;
                int bk;
                if (dist < 16) bk = dist;
                else { const float v = logf((float)dist / 16.f) / 2.0794415416798357f * 16.f; bk = 16 + (int)v; bk = bk > 31 ? 31 : bk; }
                biasTab[h * 132 + dist] = KIN(IN_RELB)[bk * 8 + h] * LOG2E;
            }
        }
    }
    SEAM(0);
    if (IN(1)) REP(1) {
        pg8::Gemm g{XN, WinT, T, NPROJ, 1024}; pg8::StaticOrder S; S.init(T, NPROJ, nwg, wg);
        EpiQKV E{Qm, KIN(IN_QNORM), KIN(IN_KNORM), kmean};
        pg8::gemm_phase<EpiQKV, pg8::StaticOrder, true, true>(lds, g, S, E);
    }
    SEAM(1);
    if (IN(3)) REP(3) {
        const bf16_t* qm_ = Qm; const bf16_t* km_ = Km; const bf16_t* vtm_ = VtM; const bf16_t* qs_ = Qs; const bf16_t* ks_ = Ks; const bf16_t* vts_ = VtS;
        const float* kmn_ = kmean; const float* bt_ = biasTab; bf16_t* a2_ = A2;
        const float* gm_ = KIN(IN_ONM); const float* gs_ = KIN(IN_ONS);
        LAS unsigned char* ot = lds;
        LAS float* biasLds = (LAS float*)(lds + 34816);
        for (int i = tid; i < 8 * 132; i += 512) biasLds[i] = bt_[i];
        __syncthreads();
        for (int u = gwave; u < 8192; u += nwaves) {
            const int grp = u >> 12, i = u & 4095;
            const int half = i >> 11, j = i & 2047;
            const int qt = half ? (j >> 6) : 63 - (j >> 6), bh = j & 63;
            const int b = bh >> 3, h = bh & 7;
            if (grp == 0) moba_unit(b, h, qt, qm_, km_, vtm_, kmn_, biasLds, ot, lane);
            else sb_unit(b, h, qt, qs_, ks_, vts_, ot, lane);
            __syncthreads();
            {
                const float* gg = grp ? gs_ : gm_;
                const f32x4 g0 = *(const f32x4*)(gg + 8 * lane), g1 = *(const f32x4*)(gg + 8 * lane + 4);
#pragma unroll
                for (int rr = 0; rr < 4; ++rr) {
                    const int row = 4 * wid + rr;
                    const bf16x8 v = *(const LAS bf16x8*)(ot + row * OT_PITCH + lane * 16);
                    float f[8], sq = 0.f;
#pragma unroll
                    for (int e = 0; e < 8; ++e) { f[e] = bf2f(v[e]); sq += f[e] * f[e]; }
                    sq = wave_sum(sq);
                    const float rs = rsqrtf(sq * (1.f / 512.f) + EPS);
                    u32x4 w; w.x = cvtpk(f[0] * rs * g0.x, f[1] * rs * g0.y); w.y = cvtpk(f[2] * rs * g0.z, f[3] * rs * g0.w);
                    w.z = cvtpk(f[4] * rs * g1.x, f[5] * rs * g1.y); w.w = cvtpk(f[6] * rs * g1.z, f[7] * rs * g1.w);
                    *(u32x4*)(a2_ + (size_t)(b * 2048 + qt * 32 + row) * 1024 + grp * 512 + 8 * lane) = w;
                }
            }
            __syncthreads();
        }
    }
    SEAM(3);
    if (IN(5)) REP(5) {
        pg8::Gemm g{A2, WoutT, T, 1024, 1024}; pg8::StaticOrder S; S.init(T, 1024, nwg, wg);
        EpiRes E{KIN(IN_X), A3};
        pg8::gemm_phase<EpiRes, pg8::StaticOrder, true, true>(lds, g, S, E);
    }
    SEAM(5);
    if (IN(6)) REP(6) {
        pg8::Gemm g{A3, WqT, T, 2048, 1024}; pg8::StaticOrder S; S.init(T, 2048, nwg, wg);
        EpiBf E{(bf16_t*)SC, 2048};
        pg8::gemm_phase<EpiBf, pg8::StaticOrder, true, true>(lds, g, S, E);
    }
    SEAM(6);
    if (IN(7)) REP(7) {
        LAS float* wl = (LAS float*)(lds + wid * 4096);
        {
            const int c = lane; int ca, cb;
            if (c < 16) { ca = 0; cb = c; } else if (c < 24) { ca = 1; cb = c - 16; } else if (c < 29) { ca = 2; cb = c - 24; } else if (c < 33) { ca = 3; cb = c - 29; }
            else if (c < 36) { ca = 4; cb = c - 33; } else if (c < 42) { ca = 5 + ((c - 36) >> 1); cb = (c - 36) & 1; } else { ca = (c - 34) & 15; cb = 0; }
            ((LAS unsigned*)(wl + 768))[lane] = (unsigned)ca | ((unsigned)cb << 8);
            asm volatile("s_waitcnt lgkmcnt(0)" ::: "memory");
        }
        const bf16_t* h1p = A3; const bf16_t* scp = (const bf16_t*)SC; const float* gfp = KIN(IN_FFN_NORM); int* eip = EIDXG; float* gtp = GATEG; unsigned char* xnp = XN2G;
        TopkIn inA, inB;
        peer_topk_load(inA, gwave, h1p, scp, lane);
        const float* pu = KIN(IN_PU); const float* pv = KIN(IN_PV); unsigned char* u8 = U8; unsigned char* v8 = V8; float* usc_ = USC; float* vsc_ = VSC;
        static_assert(T == 16384, "one expert row per token step");
#pragma unroll 1
        for (int tok = gwave; tok < T; tok += nwaves) {
            f32x4 qa[2][4];
            peer_topk_load(inB, tok + nwaves, h1p, scp, lane);
            p0_quant_issue2(qa, pu, pv, tok, lane); MEM_FENCE();
            peer_topk_token(tok, inA, gfp, eip, gtp, xnp, XSG, wl, lane);
            quant_u6_finish(qa[0], u8, usc_, tok, lane); p0_quant_finish(qa[1], v8, vsc_, tok, lane);
            inA = inB;
        }
    }
    SEAM(7);
    int sl_first = 0, sl_step = 1, tk_first = 0, tk_step = 8;
    if (IN(8) || IN(10)) {
        __syncthreads();
        const unsigned myx = misc[5], myrank = misc[4];
        unsigned nx = 0, myidx = 0, nloc = 1;
        unsigned* xc = (unsigned*)(KWS() + WS_CTL) + CW_XC;
#pragma unroll
        for (unsigned j = 0; j < 16; ++j) { const unsigned cj = xb_ld(xc + 64 * j); if (cj > 0u) { if (j < myx) ++myidx; ++nx; } if (j == myx) nloc = cj; }
        sl_first = __builtin_amdgcn_readfirstlane((int)myidx); sl_step = __builtin_amdgcn_readfirstlane((int)(nx > 0u ? nx : 1u));
        tk_first = __builtin_amdgcn_readfirstlane((int)myrank * 8 + wid); tk_step = __builtin_amdgcn_readfirstlane((int)(nloc > 0u ? nloc : 1u) * 8);
    }
    if (IN(8)) REP(8) {
        const unsigned char* xnp = XN2G; const int* eip = EIDXG; const unsigned char* u8p = U8; bf16_t* pdp = PDOTG;
        for (int item = sl_first; item < 24; item += sl_step) {
            const int sl = item >> 2, qt4 = item & 3;
            if (sl < 4) peer_u_slice<false>(sl, qt4 * (T / 4), (qt4 + 1) * (T / 4), tk_first, tk_step, xnp, eip, u8p, pdp, lane);
            else        peer_u_slice<true>(sl, qt4 * (T / 4), (qt4 + 1) * (T / 4), tk_first, tk_step, xnp, eip, u8p, pdp, lane);
        }
    }
    SEAM(8);
    if (IN(9)) REP(9) {
        const int* eip = EIDXG; const float* gtp = GATEG; const bf16_t* pdp = PDOTG; const float* usp = USC; const float* vsp = VSC; float* cjp = CJG; float* cmp_ = RS2G;
        for (int tok = gwave; tok < T; tok += 8 * nwaves) peer_cj_tokens<8>(tok, nwaves, eip, gtp, pdp, usp, vsp, XSG, cjp, cmp_, lane);
    }
    SEAM(9);
    if (IN(10)) REP(10) {
        const bf16_t* outp = A3; const int* eip = EIDXG; const float* cjp = CJG; const float* cmp_ = RS2G; const unsigned char* v8p = V8; bf16_t* a4p = A4G; float* sqp = SSQG;
        for (int sl = sl_first; sl < 8; sl += sl_step) peer_v_slice(sl, tk_first, tk_step, outp, eip, cjp, cmp_, v8p, a4p, sqp, lane);
    }
    SEAM(10);
    if (IN(11)) REP(11) {
        bf16_t* PW = Oraw;
        { int kple = 256; asm volatile("" : "+s"(kple));
          pg8::Gemm g{PB, WpleT, T, 1024, kple}; pg8::StaticOrder S; S.init(T, 1024, nwg, wg);
          EpiBf E{PW, 1024};
          pg8::gemm_phase<EpiBf, pg8::StaticOrder, true, true>(lds, g, S, E); }
        asm volatile("s_waitcnt vmcnt(0)" ::: "memory");
        __syncthreads();
        { pg8::Gemm g{A4G, WgT, T, 1024, 1024}; pg8::StaticOrder S; S.init(T, 1024, nwg, wg);
          EpiGate E{KOUT(), PW, SSQG, A4G};
          pg8::gemm_phase<EpiGate, pg8::StaticOrder, true, true>(lds, g, S, E); }
    }
#undef IN
#undef SEAM
}

extern "C" void kernel_launch(void* const* d_in, const int* in_sizes, int n_in, void* d_out, int out_size, void* d_ws, size_t ws_size, hipStream_t stream) {
    static int grid = 0;
    if (grid == 0) {
        if (n_in != 18 || out_size != T * DM || ws_size < WS_END) { fprintf(stderr, "kernel_launch: unexpected shapes (n_in %d out %d ws %zu)\n", n_in, out_size, ws_size); grid = -1; return; }
        int dev = 0, cus = 0, per_cu = 0;
        if (hipGetDevice(&dev) != hipSuccess || hipDeviceGetAttribute(&cus, hipDeviceAttributeMultiprocessorCount, dev) != hipSuccess) { grid = -1; return; }
        if (hipFuncSetAttribute((const void*)fwd_kernel, hipFuncAttributeMaxDynamicSharedMemorySize, LDS_BYTES) != hipSuccess) { fprintf(stderr, "kernel_launch: hipFuncSetAttribute failed\n"); grid = -1; return; }
        if (hipOccupancyMaxActiveBlocksPerMultiprocessor(&per_cu, (const void*)fwd_kernel, 512, LDS_BYTES) != hipSuccess || per_cu < 1)
            fprintf(stderr, "kernel_launch: note: occupancy query reports %d\n", per_cu);
        (void)hipGetLastError();
        grid = cus - (cus % 8);
    }
    if (grid < 0) return;
    if (hipMemsetAsync((char*)d_ws + WS_CTL, 0, CTL_ZERO_BYTES, stream) != hipSuccess) return;
    Params p{};
    for (int i = 0; i < 18; ++i) p.in[i] = (const float*)d_in[i];
    p.out = (float*)d_out; p.ws = (unsigned char*)d_ws;
    p.ph_lo = 0; p.ph_hi = NPHASE;
    hipLaunchKernelGGL(fwd_kernel, dim3(grid), dim3(512), LDS_BYTES, stream, p);
}
```

```cpp
#include <hip/hip_runtime.h>
#include <stdint.h>
#include <stdio.h>

#ifndef N_LAUNCHES
#define N_LAUNCHES 1
#endif

#define DI __device__ __forceinline__
#define LAS __attribute__((address_space(3)))

typedef unsigned short bf16_t;
typedef short bf16x8 __attribute__((ext_vector_type(8)));
typedef float f32x16 __attribute__((ext_vector_type(16)));
typedef float f32x4 __attribute__((ext_vector_type(4)));
typedef float f32x2 __attribute__((ext_vector_type(2)));
typedef unsigned u32x4 __attribute__((ext_vector_type(4)));
typedef unsigned u32x2 __attribute__((ext_vector_type(2)));
typedef __bf16 bf16x2_t __attribute__((ext_vector_type(2)));

constexpr int BATCH = 8, SEQ = 2048, DM = 1024, T = BATCH * SEQ;
constexpr int NPROJ = 3072;
constexpr float EPS = 1e-6f;
constexpr float LOG2E = 1.4426950408889634f;
constexpr float SCL2 = 0.125f * LOG2E;
constexpr int NPHASE = 12;

constexpr size_t MiB = 1u << 20;
constexpr size_t WS_CTL = 0, CTL_ZERO_BYTES = 256 * 1024 + 128 * 1024;
constexpr size_t WS_KMEAN = 256 * 1024;
constexpr size_t WS_BIAS = 512 * 1024;
constexpr size_t WS_WIN = 1 * MiB, WS_WOUT = 7 * MiB, WS_WQ = 9 * MiB, WS_WG = 13 * MiB, WS_WPLE = 15 * MiB;
constexpr size_t WS_U = 16 * MiB, WS_V = 32 * MiB;
constexpr size_t WS_USC = 640 * 1024, WS_VSC = 704 * 1024;
constexpr size_t WS_XN2 = 48 * MiB;
constexpr size_t WS_XS = 104 * MiB + 512 * 1024;
constexpr size_t WS_XN = 80 * MiB;
constexpr size_t WS_PB = 112 * MiB;
constexpr size_t WS_QM = 120 * MiB, WS_KM = 136 * MiB, WS_VTM = 152 * MiB, WS_QS = 168 * MiB, WS_KS = 184 * MiB, WS_VTS = 200 * MiB;
constexpr size_t WS_ORAW = 216 * MiB;
constexpr size_t WS_A2 = 80 * MiB;
constexpr size_t WS_A3 = 120 * MiB;
constexpr size_t WS_SC = 152 * MiB;
constexpr size_t WS_EIDX = 80 * MiB, WS_GATE = 88 * MiB, WS_CJ = 96 * MiB, WS_RS2 = 104 * MiB, WS_SSQ = 105 * MiB;
constexpr size_t WS_PDOT = 152 * MiB;
constexpr size_t WS_A4 = 184 * MiB;
constexpr size_t WS_END = 248 * MiB;

constexpr int CW_XC = 8192;
constexpr int CW_BAR = 4096;

constexpr int LDS_BYTES = 147456;

#define XB_TMO      128
#define XB_XCNT(j)  (256  + 64 * (j))
#define XB_XSUB(j)  (1280 + 64 * (j))
#define XB_XGEN(j)  (2304 + 64 * (j))
#define XB_TOP      3328
#define XB_TOPGEN   3392
#define XCD_BAR_WORDS 3456
#define XB_SPIN_CAP (1u << 18)

__device__ __forceinline__ unsigned xb_ld(unsigned* p)              { return __hip_atomic_load(p, __ATOMIC_RELAXED, __HIP_MEMORY_SCOPE_AGENT); }
__device__ __forceinline__ unsigned xb_add(unsigned* p, unsigned v) { return __hip_atomic_fetch_add(p, v, __ATOMIC_RELAXED, __HIP_MEMORY_SCOPE_AGENT); }
__device__ __forceinline__ unsigned xb_xcc_id() { return (unsigned)__builtin_amdgcn_s_getreg((3 << 11) | 20) & 0xFu; }
#define XB_SPIN(cond, bar) do { unsigned _sp = 0; while (cond) { __builtin_amdgcn_s_sleep(1); \
    if ((++_sp & 255u) == 0u) { if (xb_ld(&(bar)[XB_TMO])) break; if (_sp > XB_SPIN_CAP) { atomicAdd(&(bar)[XB_TMO], 1u); break; } } } } while (0)

struct XcdBarrier { unsigned* bar; unsigned x; volatile LAS unsigned* st; };

__device__ __forceinline__ XcdBarrier xcd_barrier_post(unsigned* bar, volatile LAS unsigned* st) {
    XcdBarrier b; b.bar = bar; b.x = xb_xcc_id(); b.st = st;
    if (threadIdx.x == 0) (void)xb_add(&bar[XB_XCNT(b.x)], 1u);
    return b;
}
__device__ __forceinline__ void xcd_barrier_complete(unsigned* bar, unsigned x, unsigned& nloc, unsigned& nx) {
    const unsigned G = gridDim.x * gridDim.y * gridDim.z;
    unsigned sum, cnt, mine, sp = 0u;
    for (;;) {
        sum = 0u; cnt = 0u; mine = 0u;
#pragma unroll
        for (unsigned j = 0; j < 16; ++j) { const unsigned c = xb_ld(&bar[XB_XCNT(j)]); sum += c; cnt += (c > 0u) ? 1u : 0u; mine = (j == x) ? c : mine; }
        if (sum == G) break;
        __builtin_amdgcn_s_sleep(1);
        if ((++sp & 255u) == 0u) { if (xb_ld(&bar[XB_TMO])) break; if (sp > XB_SPIN_CAP) { atomicAdd(&bar[XB_TMO], 1u); break; } }
    }
    nloc = mine > 0u ? mine : 1u; nx = cnt > 0u ? cnt : 1u;
}
template <bool CENSUS> __device__ __forceinline__ void xcd_barrier(const XcdBarrier& b) {
    asm volatile("s_waitcnt vmcnt(0)" ::: "memory");
    __syncthreads();
    if (threadIdx.x == 0) {
        unsigned* bar = b.bar;
        __builtin_amdgcn_s_waitcnt(0);
        unsigned nloc = b.st[0], nx = b.st[1];
        if (CENSUS) { if (nloc == 0u) { xcd_barrier_complete(bar, b.x, nloc, nx); b.st[0] = nloc; b.st[1] = nx; } }
        const unsigned old = xb_add(&bar[XB_XSUB(b.x)], 1u);
        const unsigned gen = old / nloc;
        if (old + 1u == (gen + 1u) * nloc) {
            __builtin_amdgcn_fence(__ATOMIC_RELEASE, "agent");
            asm volatile("s_waitcnt vmcnt(0)" ::: "memory");
            const unsigned og = xb_add(&bar[XB_TOP], 1u);
            const unsigned tg = og / nx;
            if (og + 1u == (tg + 1u) * nx) xb_add(&bar[XB_TOPGEN], 1u);
            else XB_SPIN(xb_ld(&bar[XB_TOPGEN]) == tg, bar);
            __builtin_amdgcn_fence(__ATOMIC_ACQUIRE, "agent");
            xb_add(&bar[XB_XGEN(b.x)], 1u);
            asm volatile("s_waitcnt vmcnt(0)" ::: "memory");
        } else {
            XB_SPIN(xb_ld(&bar[XB_XGEN(b.x)]) == gen, bar);
            __builtin_amdgcn_fence(__ATOMIC_ACQUIRE, "agent");
            asm volatile("s_waitcnt vmcnt(0)" ::: "memory");
        }
    }
    __syncthreads();
}

DI float bf2f(short v) { return __builtin_bit_cast(float, ((unsigned)(unsigned short)v) << 16); }
DI unsigned cvtpk(float lo, float hi) { f32x2 v = {lo, hi}; bf16x2_t b = __builtin_convertvector(v, bf16x2_t); return __builtin_bit_cast(unsigned, b); }
DI bf16_t f2bf(float f) { return (bf16_t)(cvtpk(f, 0.f) & 0xffffu); }
template <int CTRL> DI float dppf(float v) { return __builtin_bit_cast(float, __builtin_amdgcn_update_dpp(0, __builtin_bit_cast(int, v), CTRL, 0xF, 0xF, true)); }
#define DPP_XOR1 0xB1
#define DPP_XOR2 0x4E
#define DPP_HMIR 0x141
#define DPP_MIR  0x140
DI void swap16(float v, float& a, float& b) { const auto r = __builtin_amdgcn_permlane16_swap(__builtin_bit_cast(unsigned, v), __builtin_bit_cast(unsigned, v), false, false); const unsigned r0 = r[0], r1 = r[1]; a = __builtin_bit_cast(float, r0); b = __builtin_bit_cast(float, r1); }
DI void swap32(float v, float& a, float& b) { const auto r = __builtin_amdgcn_permlane32_swap(__builtin_bit_cast(unsigned, v), __builtin_bit_cast(unsigned, v), false, false); const unsigned r0 = r[0], r1 = r[1]; a = __builtin_bit_cast(float, r0); b = __builtin_bit_cast(float, r1); }
DI float sum_x16(float v) { float a, b; swap16(v, a, b); return a + b; }
DI float sum_x32(float v) { float a, b; swap32(v, a, b); return a + b; }
DI float max_x32(float v) { float a, b; swap32(v, a, b); return fmaxf(a, b); }
DI float sum_row16(float v) { v += dppf<DPP_XOR1>(v); v += dppf<DPP_XOR2>(v); v += dppf<DPP_HMIR>(v); v += dppf<DPP_MIR>(v); return v; }
DI float max_row16(float v) { v = fmaxf(v, dppf<DPP_XOR1>(v)); v = fmaxf(v, dppf<DPP_XOR2>(v)); v = fmaxf(v, dppf<DPP_HMIR>(v)); v = fmaxf(v, dppf<DPP_MIR>(v)); return v; }
DI float sum_oct(float v) { v += dppf<DPP_XOR1>(v); v += dppf<DPP_XOR2>(v); v += dppf<DPP_HMIR>(v); return v; }
DI float max_oct(float v) { v = fmaxf(v, dppf<DPP_XOR1>(v)); v = fmaxf(v, dppf<DPP_XOR2>(v)); v = fmaxf(v, dppf<DPP_HMIR>(v)); return v; }
DI float wave_sum(float v) { return sum_x32(sum_x16(sum_row16(v))); }
DI float wave_max(float v) { v = max_row16(v); float a, b; swap16(v, a, b); return max_x32(fmaxf(a, b)); }
DI float tr_x32(float lo, float hi) { const auto r = __builtin_amdgcn_permlane32_swap(__builtin_bit_cast(unsigned, lo), __builtin_bit_cast(unsigned, hi), false, false); const unsigned r0 = r[0], r1 = r[1]; return __builtin_bit_cast(float, r0) + __builtin_bit_cast(float, r1); }
DI float tr_x16(float lo, float hi) { const auto r = __builtin_amdgcn_permlane16_swap(__builtin_bit_cast(unsigned, lo), __builtin_bit_cast(unsigned, hi), false, false); const unsigned r0 = r[0], r1 = r[1]; return __builtin_bit_cast(float, r0) + __builtin_bit_cast(float, r1); }
DI float tr_x8(float lo, float hi, bool bit) { const float mine = bit ? hi : lo, send = bit ? lo : hi; return mine + dppf<0x128>(send); }
DI float tr_x4(float lo, float hi, bool bit) {
    const int a = __builtin_amdgcn_update_dpp(0, __builtin_bit_cast(int, hi), 0x114, 0xF, 0xA, false);
    const int b = __builtin_amdgcn_update_dpp(a, __builtin_bit_cast(int, lo), 0x104, 0xF, 0x5, false);
    return (bit ? hi : lo) + __builtin_bit_cast(float, b);
}
typedef _Float16 h2_t __attribute__((ext_vector_type(2)));
DI h2_t trp_x32(h2_t lo, h2_t hi) { const auto r = __builtin_amdgcn_permlane32_swap(__builtin_bit_cast(unsigned, lo), __builtin_bit_cast(unsigned, hi), false, false); const unsigned r0 = r[0], r1 = r[1]; return __builtin_bit_cast(h2_t, r0) + __builtin_bit_cast(h2_t, r1); }
DI h2_t trp_x16(h2_t lo, h2_t hi) { const auto r = __builtin_amdgcn_permlane16_swap(__builtin_bit_cast(unsigned, lo), __builtin_bit_cast(unsigned, hi), false, false); const unsigned r0 = r[0], r1 = r[1]; return __builtin_bit_cast(h2_t, r0) + __builtin_bit_cast(h2_t, r1); }
DI h2_t trp_x8(h2_t lo, h2_t hi, bool bit) { const unsigned l = __builtin_bit_cast(unsigned, lo), h = __builtin_bit_cast(unsigned, hi); const unsigned mine = bit ? h : l, send = bit ? l : h;
    const unsigned got = (unsigned)__builtin_amdgcn_update_dpp(0, (int)send, 0x128, 0xF, 0xF, true); return __builtin_bit_cast(h2_t, mine) + __builtin_bit_cast(h2_t, got); }
DI float tr_x2(float lo, float hi, bool bit) { const float mine = bit ? hi : lo, send = bit ? lo : hi; return mine + dppf<DPP_XOR2>(send); }
DI float tr_x1(float lo, float hi, bool bit) { const float mine = bit ? hi : lo, send = bit ? lo : hi; return mine + dppf<DPP_XOR1>(send); }
DI int crow(int r, int hi) { return (r & 3) + 8 * (r >> 2) + 4 * hi; }
#define MFMA32(a, b, c) __builtin_amdgcn_mfma_f32_32x32x16_bf16((a), (b), (c), 0, 0, 0)
DI f32x16 zero16() { f32x16 z; for (int i = 0; i < 16; ++i) z[i] = 0.f; return z; }

struct Params {
    const float* in[18];
    float* out;
    unsigned char* ws;
    int ph_lo, ph_hi;
};

enum { IN_X = 0, IN_P, IN_RELB, IN_ATTN_NORM, IN_WIN, IN_QNORM, IN_KNORM, IN_ONM, IN_ONS, IN_WOUT, IN_FFN_NORM, IN_PQ, IN_SUBK, IN_PU, IN_PV, IN_PLE_NORM, IN_WPG, IN_WPLE };

DI void p0_transpose_wave(const float* W, int K, int N, bf16_t* Wt, LAS float* scr  , int lane, int k0, int n0, bool headperm, const float* kgain) {
    f32x4 v[16];
    const int lr = lane >> 4, lc = 4 * (lane & 15);
#pragma unroll
    for (int i = 0; i < 16; ++i) v[i] = *(const f32x4*)(W + (size_t)(k0 + 4 * i + lr) * N + n0 + lc);
#pragma unroll
    for (int i = 0; i < 16; ++i) { LAS float* d = scr + (4 * i + lr) * 65 + lc; d[0] = v[i].x; d[1] = v[i].y; d[2] = v[i].z; d[3] = v[i].w; }
    __builtin_amdgcn_wave_barrier();
    const int j = lane & 7, nl = lane >> 3;
    f32x4 g0 = {1.f, 1.f, 1.f, 1.f}, g1 = g0;
    if (kgain) { g0 = *(const f32x4*)(kgain + k0 + 8 * j); g1 = *(const f32x4*)(kgain + k0 + 8 * j + 4); }
#pragma unroll
    for (int q = 0; q < 8; ++q) {
        const int nn = 8 * q + nl;
        int n = n0 + nn;
        if (headperm) { const int w = n & 255; n = (n & ~255) + 128 * ((w >> 5) & 1) + 32 * (w >> 6) + (w & 31); }
        const LAS float* sp = scr + (8 * j) * 65 + nn;
        u32x4 w;
        w.x = cvtpk(sp[0] * g0.x, sp[65] * g0.y); w.y = cvtpk(sp[130] * g0.z, sp[195] * g0.w);
        w.z = cvtpk(sp[260] * g1.x, sp[325] * g1.y); w.w = cvtpk(sp[390] * g1.z, sp[455] * g1.w);
        *(u32x4*)(Wt + (size_t)n * K + k0 + 8 * j) = w;
    }
    __builtin_amdgcn_wave_barrier();
}

DI void split_bf16x8(const f32x4& p, const f32x4& q, bf16x8& hi, bf16x8& lo) {
    u32x4 h, l;
    h.x = cvtpk(p.x, p.y); h.y = cvtpk(p.z, p.w); h.z = cvtpk(q.x, q.y); h.w = cvtpk(q.z, q.w);
    const float r0 = p.x - __builtin_bit_cast(float, h.x << 16), r1 = p.y - __builtin_bit_cast(float, h.x & 0xffff0000u), r2 = p.z - __builtin_bit_cast(float, h.y << 16), r3 = p.w - __builtin_bit_cast(float, h.y & 0xffff0000u);
    const float r4 = q.x - __builtin_bit_cast(float, h.z << 16), r5 = q.y - __builtin_bit_cast(float, h.z & 0xffff0000u), r6 = q.z - __builtin_bit_cast(float, h.w << 16), r7 = q.w - __builtin_bit_cast(float, h.w & 0xffff0000u);
    l.x = cvtpk(r0, r1); l.y = cvtpk(r2, r3); l.z = cvtpk(r4, r5); l.w = cvtpk(r6, r7);
    hi = __builtin_bit_cast(bf16x8, h); lo = __builtin_bit_cast(bf16x8, l);
}
DI void p0_fold(const float* wq, const float* sub, const float* gffn, bf16_t* WqT, int wid, int lane, int wg, int nwg) {
    const int r = lane & 31, hi = lane >> 5, dq = wid & 1, nq = wid >> 1;
    for (int item = wg; item < 256; item += nwg) {
        const int dt = item & 15, hh = item >> 4, d0 = dt * 64 + 32 * dq, h = hh >> 1, half = hh & 1;
        const float* ap = wq + (size_t)(d0 + r) * 2048 + h * 256 + half * 128 + 8 * hi;
        const float* bp = sub + half * 16384 + (size_t)(32 * nq + r) * 128 + 8 * hi;
        f32x16 acc = zero16();
#pragma unroll
        for (int st = 0; st < 8; ++st) {
            const f32x4 a0 = *(const f32x4*)(ap + 16 * st), a1 = *(const f32x4*)(ap + 16 * st + 4), b0 = *(const f32x4*)(bp + 16 * st), b1 = *(const f32x4*)(bp + 16 * st + 4);
            bf16x8 ah, al, bh, bl;
            split_bf16x8(a0, a1, ah, al); split_bf16x8(b0, b1, bh, bl);
            acc = MFMA32(ah, bh, acc); acc = MFMA32(ah, bl, acc); acc = MFMA32(al, bh, acc);
        }
        bf16_t* op = WqT + (size_t)(hh * 128 + 32 * nq + r) * 1024 + d0 + 4 * hi;
#pragma unroll
        for (int g4 = 0; g4 < 4; ++g4) {
            const f32x4 gv = *(const f32x4*)(gffn + d0 + 8 * g4 + 4 * hi);
            u32x2 w; w.x = cvtpk(acc[4 * g4] * gv.x, acc[4 * g4 + 1] * gv.y); w.y = cvtpk(acc[4 * g4 + 2] * gv.z, acc[4 * g4 + 3] * gv.w);
            *(u32x2*)(op + 8 * g4) = w;
        }
    }
}

DI void p0_convert(const float* src, bf16_t* dst, size_t n, size_t gtid, size_t nthreads) {
    for (size_t i = gtid * 8; i < n; i += nthreads * 8) {
        const f32x4 a = *(const f32x4*)(src + i), b = *(const f32x4*)(src + i + 4);
        u32x4 o; o.x = cvtpk(a.x, a.y); o.y = cvtpk(a.z, a.w); o.z = cvtpk(b.x, b.y); o.w = cvtpk(b.z, b.w);
        *(u32x4*)(dst + i) = o;
    }
}


DI void p0_quant_finish(const f32x4 (&a)[4], unsigned char* dst, float* scale, int row, int lane) {
    float m = 0.f;
#pragma unroll
    for (int i = 0; i < 4; ++i) m = fmaxf(fmaxf(m, fmaxf(fabsf(a[i].x), fabsf(a[i].y))), fmaxf(fabsf(a[i].z), fabsf(a[i].w)));
    m = wave_max(m);
    const float sc = m > 0.f ? m * (1.f / 440.f) : 1.f, inv = m > 0.f ? 440.f / m : 0.f;
    u32x4 w;
#pragma unroll
    for (int i = 0; i < 4; ++i) {
        const float q0 = fminf(fmaxf(a[i].x * inv, -448.f), 448.f), q1 = fminf(fmaxf(a[i].y * inv, -448.f), 448.f);
        const float q2 = fminf(fmaxf(a[i].z * inv, -448.f), 448.f), q3 = fminf(fmaxf(a[i].w * inv, -448.f), 448.f);
        int p = 0;
        p = __builtin_amdgcn_cvt_pk_fp8_f32(q0, q1, p, false);
        p = __builtin_amdgcn_cvt_pk_fp8_f32(q2, q3, p, true);
        w[i] = (unsigned)p;
    }
    *(u32x4*)(dst + ((size_t)(lane >> 3) * 16384 + row) * 128 + 16 * (lane & 7)) = w;
    if (lane == 0) scale[row] = sc;
}
DI void quant_u6_finish(const f32x4 (&a)[4], unsigned char* dst, float* scale, int row, int lane) {
    float m = 0.f;
#pragma unroll
    for (int i = 0; i < 4; ++i) m = fmaxf(fmaxf(m, fmaxf(fabsf(a[i].x), fabsf(a[i].y))), fmaxf(fabsf(a[i].z), fabsf(a[i].w)));
    m = wave_max(m);
    const float sc = m > 0.f ? m * (1.f / 31.f) : 1.f, inv = m > 0.f ? 31.f / m : 0.f;
    unsigned hi0 = 0u, hi1 = 0u, lo = 0u;
#pragma unroll
    for (int e = 0; e < 16; ++e) {
        const int q = (int)rintf(a[e >> 2][e & 3] * inv);
        const unsigned h = (unsigned)(q >> 2) & 15u, l = (unsigned)q & 3u;
        if (e < 8) hi0 |= h << (4 * e); else hi1 |= h << (4 * (e - 8));
        lo |= l << (e < 8 ? 4 * e : 4 * (e - 8) + 2);
    }
    u32x2 hw; hw.x = hi0; hw.y = hi1;
    *(u32x2*)(dst + ((size_t)(lane >> 4) * 16384 + row) * 128 + 8 * (lane & 15)) = hw;
    *(unsigned*)(dst + ((size_t)(4 + (lane >> 5)) * 16384 + row) * 128 + 4 * (lane & 31)) = lo;
    if (lane == 0) scale[row] = sc;
}
DI void p0_quant_issue2(f32x4 (&a)[2][4], const float* pu, const float* pv, int r, int lane) {
#pragma unroll
    for (int i = 0; i < 4; ++i) { a[0][i] = *(const f32x4*)(pu + (size_t)r * 1024 + 16 * lane + 4 * i); a[1][i] = *(const f32x4*)(pv + (size_t)r * 1024 + 16 * lane + 4 * i); }
}
DI void p0_quant_rows4(const float* pu, const float* pv, unsigned char* u8, unsigned char* v8, float* usc_, float* vsc_, int r0, int r1, int lane) {
    f32x4 a[4][4];
    const int r1c = r1 < 16384 ? r1 : r0;
#pragma unroll
    for (int i = 0; i < 4; ++i) { a[0][i] = *(const f32x4*)(pu + (size_t)r0 * 1024 + 16 * lane + 4 * i); a[1][i] = *(const f32x4*)(pv + (size_t)r0 * 1024 + 16 * lane + 4 * i);
        a[2][i] = *(const f32x4*)(pu + (size_t)r1c * 1024 + 16 * lane + 4 * i); a[3][i] = *(const f32x4*)(pv + (size_t)r1c * 1024 + 16 * lane + 4 * i); }
    p0_quant_finish(a[0], u8, usc_, r0, lane); p0_quant_finish(a[1], v8, vsc_, r0, lane);
    if (r1 < 16384) { p0_quant_finish(a[2], u8, usc_, r1, lane); p0_quant_finish(a[3], v8, vsc_, r1, lane); }
}

DI void rmsnorm_rows2_bf16(const float* x, const float* g, bf16_t* o, int r0, int r1, int lane) {
    f32x4 v[2][4]; float s[2] = {0.f, 0.f};
    const int rr[2] = {r0, r1 < T ? r1 : r0};
#pragma unroll
    for (int q = 0; q < 2; ++q)
#pragma unroll
        for (int j = 0; j < 4; ++j) v[q][j] = ((const f32x4*)(x + (size_t)rr[q] * 1024))[lane + 64 * j];
#pragma unroll
    for (int q = 0; q < 2; ++q) {
#pragma unroll
        for (int j = 0; j < 4; ++j) s[q] += (v[q][j].x * v[q][j].x + v[q][j].y * v[q][j].y) + (v[q][j].z * v[q][j].z + v[q][j].w * v[q][j].w);
        s[q] = wave_sum(s[q]);
    }
#pragma unroll
    for (int q = 0; q < 2; ++q) {
        if (q == 1 && r1 >= T) break;
        const float rs = rsqrtf(s[q] * (1.f / 1024.f) + EPS);
#pragma unroll
        for (int j = 0; j < 4; ++j) { const f32x4 gv = ((const f32x4*)g)[lane + 64 * j];
            u32x2 w; w.x = cvtpk(v[q][j].x * rs * gv.x, v[q][j].y * rs * gv.y); w.y = cvtpk(v[q][j].z * rs * gv.z, v[q][j].w * rs * gv.w);
            ((u32x2*)(o + (size_t)rr[q] * 1024))[lane + 64 * j] = w; }
    }
}

namespace pg8 {
#define PG8_LAS __attribute__((address_space(3)))
typedef unsigned short bf16_t;
typedef short bf16x8 __attribute__((ext_vector_type(8)));
typedef float f32x4 __attribute__((ext_vector_type(4)));
typedef unsigned u32x4 __attribute__((ext_vector_type(4)));
constexpr int BM = 256, BK = 64, HALF = 128, HTB = HALF * BK * 2  , STAGE_BYTES = 8 * HTB, NXCD = 8, WGM = 8;

__host__ __device__ __forceinline__ int lds_byte(int r, int c) { const int st = (r >> 4) * 2 + (c >> 5), rr = r & 15, cc = c & 31, ob = rr * 64 + cc * 2; return st * 1024 + (ob ^ (((ob >> 9) & 1) << 5)); }
__host__ __device__ __forceinline__ void stage_rc(int b, int& R, int& C) { const int st = b / 1024, sb = b % 1024, swz = sb ^ (((sb >> 9) & 1) << 5); R = (st >> 1) * 16 + swz / 64; C = (st & 1) * 32 + (swz % 64) / 2; }
__host__ __device__ __forceinline__ int perm32(int rho) { const int n = rho >> 4, i = rho & 15; return 8 * (i >> 2) + 4 * n + (i & 3); }

struct Unit { int pm, pn; };
struct Gemm { const bf16_t* A; const bf16_t* Bt; int M, N, K; };

struct StaticOrder {
    int nM, nN, nwg, G, c;
    __host__ __device__ void init(int M, int N, int G_, int c_) { nM = M / BM; nN = N / BM; nwg = nM * nN; G = G_; c = c_; }
    __host__ __device__ bool next(int i, Unit& u) const {
        const long L = (long)i * G + c; if (L >= nwg) return false;
        int wgid = (int)L; { const int q = nwg / NXCD, r = nwg % NXCD, xcd = wgid % NXCD, off = wgid / NXCD; wgid = (xcd < r ? xcd * (q + 1) : r * (q + 1) + (xcd - r) * q) + off; }
        const int nig = WGM * nN, gid = wgid / nig, fm = gid * WGM, gsz = (nM - fm) < WGM ? (nM - fm) : WGM;
        u.pm = fm + ((wgid % nig) % gsz); u.pn = (wgid % nig) / gsz; return true;
    }
    __device__ __forceinline__ void a_ready(const Unit&) const {}
    __device__ __forceinline__ void done(const Unit&) const {}
};

template <class Epi, class Sched, bool ALIGN_EPI = false, bool SP2 = false>
__device__ __forceinline__ void gemm_phase(PG8_LAS unsigned char* lds, const Gemm g, const Sched& S, const Epi& E) {
    int tid_ = threadIdx.x; asm volatile("" : "+v"(tid_));
    const int tid = tid_, wid = __builtin_amdgcn_readfirstlane(tid >> 6), lane = tid & 63, wr = wid >> 2, wc = wid & 3, fr = lane & 15, fq = lane >> 4;
    const int K = g.K, nt = K / BK;
    unsigned voffA[2], voffB[2];
#pragma unroll
    for (int i = 0; i < 2; ++i) { int R, C; stage_rc(tid * 16 + i * 8192, R, C); const int Rb = Epi::PERM ? ((R & ~31) + perm32(R & 31)) : R;
        voffA[i] = (unsigned)(R * K + C) * 2u; voffB[i] = (unsigned)(Rb * K + C) * 2u; }
    const size_t kstep = (size_t)(BK * 2);
    const size_t hstep = (size_t)HALF * K * 2;
    const size_t tstep = 2 * hstep;
    const unsigned ldsw = (unsigned)wid * 1024u;
    const int aoff = lds_byte(wr * 64 + fr, fq * 8), boff = lds_byte(wc * 32 + fr, fq * 8);
#define PG8_SA(b, h) (((b) * 2 + (h)) * HTB)
#define PG8_SB(b, h) ((4 + (b) * 2 + (h)) * HTB)
#define PG8_STAGE(bufoff, gbase, voff) do { _Pragma("unroll") for (int _i = 0; _i < 2; ++_i) \
        __builtin_amdgcn_global_load_lds((const unsigned*)((const char*)(gbase) + (voff)[_i]), (PG8_LAS unsigned*)(lds + (bufoff) + ldsw + _i * 8192), 16, 0, 0); } while (0)
#define PG8_LDA(dst, b, h) do { _Pragma("unroll") for (int m = 0; m < 4; ++m) _Pragma("unroll") for (int k = 0; k < 2; ++k) dst[m][k] = *(const PG8_LAS bf16x8*)(lds + PG8_SA(b, h) + aoff + m * 2048 + k * 1024); } while (0)
#define PG8_LDB(dst, b, h) do { _Pragma("unroll") for (int n = 0; n < 2; ++n) _Pragma("unroll") for (int k = 0; k < 2; ++k) dst[n][k] = *(const PG8_LAS bf16x8*)(lds + PG8_SB(b, h) + boff + n * 2048 + k * 1024); } while (0)
#define PG8_MMA(ai, bj, At, Bt) do { __builtin_amdgcn_s_setprio(1); _Pragma("unroll") for (int m = 0; m < 4; ++m) _Pragma("unroll") for (int n = 0; n < 2; ++n) _Pragma("unroll") for (int k = 0; k < 2; ++k) \
        acc[ai][bj][m][n] = __builtin_amdgcn_mfma_f32_16x16x32_bf16(Bt[n][k], At[m][k], acc[ai][bj][m][n], 0, 0, 0); __builtin_amdgcn_s_setprio(0); } while (0)
#define PG8_WAIT_V(n) asm volatile("s_waitcnt vmcnt(" #n ")" ::: "memory")
#define PG8_WAIT_L(n) asm volatile("s_waitcnt lgkmcnt(" #n ")" ::: "memory")
#define PG8_BAR __builtin_amdgcn_s_barrier()
#define PG8_SCHED __builtin_amdgcn_sched_barrier(0)
    Unit cur, nxt; int ui = 0;
    if (!S.next(0, cur)) return;
    f32x4 acc[2][2][4][2];
#pragma unroll
    for (int a = 0; a < 2; ++a)
#pragma unroll
        for (int b = 0; b < 2; ++b)
#pragma unroll
            for (int m = 0; m < 4; ++m)
#pragma unroll
                for (int n = 0; n < 2; ++n) acc[a][b][m][n] = (f32x4){0.f, 0.f, 0.f, 0.f};
    bf16x8 At[4][2], B0[2][2], B1[2][2];
    const char* cA = (const char*)g.A + (size_t)cur.pm * tstep; const char* cB = (const char*)g.Bt + (size_t)cur.pn * tstep;
    S.a_ready(cur);
    if constexpr (SP2) {
        PG8_STAGE(PG8_SB(0, 0), cB, voffB); PG8_STAGE(PG8_SB(0, 1), cB + hstep, voffB); PG8_STAGE(PG8_SA(0, 0), cA, voffA); PG8_STAGE(PG8_SA(0, 1), cA + hstep, voffA);
        if (wr == 1) PG8_BAR;
        PG8_WAIT_V(2); PG8_BAR;
        PG8_STAGE(PG8_SB(1, 0), cB + kstep, voffB); PG8_STAGE(PG8_SA(1, 0), cA + kstep, voffA); PG8_STAGE(PG8_SB(1, 1), cB + hstep + kstep, voffB);
        PG8_WAIT_V(6); PG8_BAR;
    } else {
        PG8_STAGE(PG8_SB(0, 0), cB, voffB); PG8_STAGE(PG8_SA(0, 0), cA, voffA); PG8_STAGE(PG8_SB(0, 1), cB + hstep, voffB); PG8_STAGE(PG8_SA(0, 1), cA + hstep, voffA);
        if (wr == 1) PG8_BAR;
        PG8_WAIT_V(4); PG8_BAR;
        PG8_STAGE(PG8_SB(1, 0), cB + kstep, voffB); PG8_STAGE(PG8_SA(1, 0), cA + kstep, voffA); PG8_STAGE(PG8_SB(1, 1), cB + hstep + kstep, voffB);
        PG8_WAIT_V(6); PG8_BAR;
    }
    for (;;) {
        const bool has_next = S.next(ui + 1, nxt);
        const char* nA = has_next ? (const char*)g.A + (size_t)nxt.pm * tstep : cA; const char* nB = has_next ? (const char*)g.Bt + (size_t)nxt.pn * tstep : cB;
        for (int t = 0; t < nt; t += 2) {
            const bool last = (t == nt - 2);
            const char* a1 = cA + (size_t)(t + 1) * kstep;
            const char* a2 = last ? nA : cA + (size_t)(t + 2) * kstep; const char* b2 = last ? nB : cB + (size_t)(t + 2) * kstep;
            const char* a3 = a2 + kstep; const char* b3 = b2 + kstep;
            if (last && has_next) S.a_ready(nxt);
            if constexpr (SP2) {
            PG8_LDB(B0, 0, 0); PG8_LDB(B1, 0, 1); PG8_SCHED; PG8_LDA(At, 0, 0); PG8_STAGE(PG8_SA(1, 1), a1 + hstep, voffA);
            PG8_WAIT_V(8); PG8_WAIT_L(0); PG8_BAR; PG8_MMA(0, 0, At, B0); PG8_MMA(0, 1, At, B1); PG8_BAR; PG8_SCHED;
            PG8_LDA(At, 0, 1); PG8_STAGE(PG8_SB(0, 0), b2, voffB); PG8_STAGE(PG8_SB(0, 1), b2 + hstep, voffB); PG8_STAGE(PG8_SA(0, 0), a2, voffA);
            PG8_WAIT_V(8); PG8_WAIT_L(0); PG8_BAR; PG8_MMA(1, 0, At, B0); PG8_MMA(1, 1, At, B1); PG8_BAR; PG8_SCHED;
            PG8_LDB(B0, 1, 0); PG8_LDB(B1, 1, 1); PG8_SCHED; PG8_LDA(At, 1, 0); PG8_STAGE(PG8_SA(0, 1), a2 + hstep, voffA);
            PG8_WAIT_V(8); PG8_WAIT_L(0); PG8_BAR; PG8_MMA(0, 0, At, B0); PG8_MMA(0, 1, At, B1); PG8_BAR; PG8_SCHED;
            PG8_LDA(At, 1, 1); PG8_STAGE(PG8_SB(1, 0), b3, voffB); PG8_STAGE(PG8_SB(1, 1), b3 + hstep, voffB); PG8_STAGE(PG8_SA(1, 0), a3, voffA);
            PG8_WAIT_V(8); PG8_WAIT_L(0); PG8_BAR; PG8_MMA(1, 0, At, B0); PG8_MMA(1, 1, At, B1); PG8_BAR; PG8_SCHED;
            } else {
            PG8_LDB(B0, 0, 0); PG8_SCHED; PG8_LDA(At, 0, 0); PG8_STAGE(PG8_SA(1, 1), a1 + hstep, voffA);
            PG8_WAIT_L(8); PG8_BAR; PG8_WAIT_L(0); PG8_MMA(0, 0, At, B0); PG8_BAR; PG8_SCHED;
            PG8_LDB(B1, 0, 1); PG8_STAGE(PG8_SB(0, 0), b2, voffB);
            PG8_BAR; PG8_WAIT_L(0); PG8_MMA(0, 1, At, B1); PG8_BAR;
            PG8_LDA(At, 0, 1); PG8_STAGE(PG8_SA(0, 0), a2, voffA);
            PG8_BAR; PG8_WAIT_L(0); PG8_MMA(1, 0, At, B0); PG8_BAR; PG8_SCHED;
            PG8_STAGE(PG8_SB(0, 1), b2 + hstep, voffB);
            PG8_WAIT_V(6); PG8_BAR; PG8_MMA(1, 1, At, B1); PG8_BAR;
            PG8_LDB(B0, 1, 0); PG8_SCHED; PG8_LDA(At, 1, 0); PG8_STAGE(PG8_SA(0, 1), a2 + hstep, voffA);
            PG8_WAIT_L(8); PG8_BAR; PG8_WAIT_L(0); PG8_MMA(0, 0, At, B0); PG8_BAR; PG8_SCHED;
            PG8_LDB(B1, 1, 1); PG8_STAGE(PG8_SB(1, 0), b3, voffB);
            PG8_BAR; PG8_WAIT_L(0); PG8_MMA(0, 1, At, B1); PG8_BAR;
            PG8_LDA(At, 1, 1); PG8_STAGE(PG8_SA(1, 0), a3, voffA);
            PG8_BAR; PG8_WAIT_L(0); PG8_MMA(1, 0, At, B0); PG8_BAR; PG8_SCHED;
            PG8_STAGE(PG8_SB(1, 1), b3 + hstep, voffB);
            PG8_WAIT_V(6); PG8_BAR; PG8_MMA(1, 1, At, B1); PG8_BAR;
            }
        }
        if constexpr (ALIGN_EPI) { if (wr == 0) PG8_BAR; }
        if constexpr (!Epi::AFTER_DRAIN) { E(acc, cur, wr, wc, fr, fq); S.done(cur); }
        if (!has_next) break;
#pragma unroll
        for (int a = 0; a < 2; ++a)
#pragma unroll
            for (int b = 0; b < 2; ++b)
#pragma unroll
                for (int m = 0; m < 4; ++m)
#pragma unroll
                    for (int n = 0; n < 2; ++n) acc[a][b][m][n] = (f32x4){0.f, 0.f, 0.f, 0.f};
        cur = nxt; cA = nA; cB = nB; ++ui;
        if constexpr (ALIGN_EPI) { if (wr == 1) PG8_BAR; }
    }
    PG8_WAIT_V(0);
    if constexpr (!ALIGN_EPI) { if (wr == 0) PG8_BAR; }
    PG8_BAR;
    if constexpr (Epi::AFTER_DRAIN) { E.fused(acc, cur, wr, wc, fr, fq, lds, wid, lane); S.done(cur); }
#undef PG8_SA
#undef PG8_SB
#undef PG8_STAGE
#undef PG8_LDA
#undef PG8_LDB
#undef PG8_MMA
#undef PG8_WAIT_V
#undef PG8_WAIT_L
#undef PG8_BAR
#undef PG8_SCHED
}
}


struct EpiQKV {
    static constexpr bool PERM = true, AFTER_DRAIN = false;
    bf16_t* base6; const float *qn, *kn; float* kmean_acc;
    DI void operator()(const f32x4 (&acc)[2][2][4][2], const pg8::Unit& u, int wr, int wc, int fr, int fq) const {
        const int typ = u.pn >> 1, h = (u.pn & 1) * 4 + wc;
        bf16_t* reg = base6 + (size_t)typ * (16u << 19);
        const int row0 = u.pm * 256 + wr * 64 + fr;
        if (typ == 2 || typ == 5) {
#pragma unroll
            for (int ai = 0; ai < 2; ++ai)
#pragma unroll
                for (int m = 0; m < 4; ++m) {
                    const int tok = row0 + ai * 128 + m * 16, b = tok >> 11, sq = tok & 2047, tile = sq >> 5, kap = sq & 31;
                    const int s2 = kap >> 4, hh = (kap >> 2) & 1, jj = ((kap >> 3) & 1) * 4 + (kap & 3);
                    bf16_t* bp = reg + ((((size_t)(b * 8 + h) * 64 + tile) * 4 + s2 * 2) * 64 + hh * 32 + 8 * fq) * 8 + jj;
#pragma unroll
                    for (int bj = 0; bj < 2; ++bj)
#pragma unroll
                        for (int n = 0; n < 2; ++n)
#pragma unroll
                            for (int i = 0; i < 4; ++i) bp[(size_t)bj * 512 + (4 * n + i) * 8] = f2bf(acc[ai][bj][m][n][i]);
                }
        } else {
            const bool nrm = typ < 2;
            const float* g = (typ == 0) ? qn : kn;
            f32x4 gv[2][2];
#pragma unroll
            for (int bj = 0; bj < 2; ++bj)
#pragma unroll
                for (int n = 0; n < 2; ++n) gv[bj][n] = nrm ? *(const f32x4*)(g + 32 * bj + 8 * fq + 4 * n) : (f32x4){1.f, 1.f, 1.f, 1.f};
#pragma unroll
            for (int ai = 0; ai < 2; ++ai)
#pragma unroll
                for (int m = 0; m < 4; ++m) {
                    const int tok = row0 + ai * 128 + m * 16, b = tok >> 11, sq = tok & 2047, tile = sq >> 5, kap = sq & 31;
                    float rs = 1.f;
                    if (nrm) {
                        float ss = 0.f;
#pragma unroll
                        for (int bj = 0; bj < 2; ++bj)
#pragma unroll
                            for (int n = 0; n < 2; ++n) { const f32x4 v = acc[ai][bj][m][n]; ss += (v.x * v.x + v.y * v.y) + (v.z * v.z + v.w * v.w); }
                        ss = sum_x32(sum_x16(ss));
                        rs = rsqrtf(ss * (1.f / 64.f) + EPS);
                    }
                    bf16_t* dst = reg + ((((size_t)(b * 8 + h) * 64 + tile) * 4 + (fq >> 1)) * 64 + (fq & 1) * 32 + kap) * 8;
#pragma unroll
                    for (int bj = 0; bj < 2; ++bj) {
                        const f32x4 v0 = acc[ai][bj][m][0] * rs * gv[bj][0], v1 = acc[ai][bj][m][1] * rs * gv[bj][1];
                        u32x4 w; w.x = cvtpk(v0.x, v0.y); w.y = cvtpk(v0.z, v0.w); w.z = cvtpk(v1.x, v1.y); w.w = cvtpk(v1.z, v1.w);
                        *(u32x4*)(dst + (size_t)bj * 2 * 512) = w;
                    }
                }
            if (typ == 1) {
                asm volatile("" ::: "memory");
                f32x4 ks[2][2];
#pragma unroll
                for (int bj = 0; bj < 2; ++bj)
#pragma unroll
                    for (int n = 0; n < 2; ++n) ks[bj][n] = (f32x4){0.f, 0.f, 0.f, 0.f};
#pragma unroll
                for (int ai = 0; ai < 2; ++ai)
#pragma unroll
                    for (int m = 0; m < 4; ++m) {
                        float ss = 0.f;
#pragma unroll
                        for (int bj = 0; bj < 2; ++bj)
#pragma unroll
                            for (int n = 0; n < 2; ++n) { const f32x4 v = acc[ai][bj][m][n]; ss += (v.x * v.x + v.y * v.y) + (v.z * v.z + v.w * v.w); }
                        ss = sum_x32(sum_x16(ss));
                        const float rs = rsqrtf(ss * (1.f / 64.f) + EPS);
#pragma unroll
                        for (int bj = 0; bj < 2; ++bj)
#pragma unroll
                            for (int n = 0; n < 2; ++n) ks[bj][n] += acc[ai][bj][m][n] * rs * gv[bj][n];
                    }
                const int tok0 = u.pm * 256;
                float* kd = kmean_acc + ((size_t)((tok0 >> 11) * 8 + h) * 8 + ((tok0 & 2047) >> 8)) * 64 + 8 * fq;
#pragma unroll
                for (int bj = 0; bj < 2; ++bj)
#pragma unroll
                    for (int n = 0; n < 2; ++n)
#pragma unroll
                        for (int i = 0; i < 4; ++i) { const float t = sum_row16(ks[bj][n][i]) * (1.f / 256.f); if (fr == 0) atomicAdd(kd + 32 * bj + 4 * n + i, t); }
            }
        }
    }
};

struct EpiRes {
    static constexpr bool PERM = true, AFTER_DRAIN = false;
    const float* x; bf16_t* xn;
    DI void operator()(const f32x4 (&acc)[2][2][4][2], const pg8::Unit& u, int wr, int wc, int fr, int fq) const {
        const int row0 = u.pm * 256 + wr * 64 + fr, col0 = u.pn * 256 + wc * 32 + 8 * fq;
#pragma unroll
        for (int ai = 0; ai < 2; ++ai)
#pragma unroll
            for (int m = 0; m < 4; ++m)
#pragma unroll
                for (int bj = 0; bj < 2; ++bj) {
                    const size_t off = (size_t)(row0 + ai * 128 + m * 16) * 1024 + col0 + bj * 128;
                    const f32x4 h0 = *(const f32x4*)(x + off) + acc[ai][bj][m][0], h1 = *(const f32x4*)(x + off + 4) + acc[ai][bj][m][1];
                    u32x4 w; w.x = cvtpk(h0.x, h0.y); w.y = cvtpk(h0.z, h0.w); w.z = cvtpk(h1.x, h1.y); w.w = cvtpk(h1.z, h1.w);
                    *(u32x4*)(xn + off) = w;
                }
    }
};

struct EpiF32 {
    static constexpr bool PERM = true, AFTER_DRAIN = false;
    float* C; int ldc;
    DI void operator()(const f32x4 (&acc)[2][2][4][2], const pg8::Unit& u, int wr, int wc, int fr, int fq) const {
        const int row0 = u.pm * 256 + wr * 64 + fr, col0 = u.pn * 256 + wc * 32 + 8 * fq;
#pragma unroll
        for (int ai = 0; ai < 2; ++ai)
#pragma unroll
            for (int m = 0; m < 4; ++m)
#pragma unroll
                for (int bj = 0; bj < 2; ++bj) {
                    float* p = C + (size_t)(row0 + ai * 128 + m * 16) * ldc + col0 + bj * 128;
                    *(f32x4*)p = acc[ai][bj][m][0]; *(f32x4*)(p + 4) = acc[ai][bj][m][1];
                }
    }
};

struct EpiBf {
    static constexpr bool PERM = true, AFTER_DRAIN = false;
    bf16_t* C; int ldc;
    DI void operator()(const f32x4 (&acc)[2][2][4][2], const pg8::Unit& u, int wr, int wc, int fr, int fq) const {
        const int row0 = u.pm * 256 + wr * 64 + fr, col0 = u.pn * 256 + wc * 32 + 8 * fq;
#pragma unroll
        for (int ai = 0; ai < 2; ++ai)
#pragma unroll
            for (int m = 0; m < 4; ++m)
#pragma unroll
                for (int bj = 0; bj < 2; ++bj) {
                    const f32x4 v0 = acc[ai][bj][m][0], v1 = acc[ai][bj][m][1];
                    u32x4 w; w.x = cvtpk(v0.x, v0.y); w.y = cvtpk(v0.z, v0.w); w.z = cvtpk(v1.x, v1.y); w.w = cvtpk(v1.z, v1.w);
                    *(u32x4*)(C + (size_t)(row0 + ai * 128 + m * 16) * ldc + col0 + bj * 128) = w;
                }
    }
};

struct EpiGate {
    static constexpr bool PERM = true, AFTER_DRAIN = false;
    float* out; const bf16_t* pw; const float* ssq; const bf16_t* h2b;
    DI void operator()(const f32x4 (&acc)[2][2][4][2], const pg8::Unit& u, int wr, int wc, int fr, int fq) const {
        const int row0 = u.pm * 256 + wr * 64 + fr, col0 = u.pn * 256 + wc * 32 + 8 * fq;
#pragma unroll
        for (int ai = 0; ai < 2; ++ai)
#pragma unroll
            for (int m = 0; m < 4; ++m) {
                const int row = row0 + ai * 128 + m * 16;
                float sq = 0.f;
#pragma unroll
                for (int x = 0; x < 8; ++x) sq += ssq[(size_t)x * T + row];
                const float rs3 = rsqrtf(sq * (1.f / 1024.f) + EPS);
#pragma unroll
                for (int bj = 0; bj < 2; ++bj) {
                    const size_t off = (size_t)row * 1024 + col0 + bj * 128;
                    const bf16x8 pv = *(const bf16x8*)(pw + off);
                    const bf16x8 hb = *(const bf16x8*)(h2b + off);
                    const f32x4 g0 = acc[ai][bj][m][0] * rs3, g1 = acc[ai][bj][m][1] * rs3;
                    f32x4 o0, o1;
#pragma unroll
                    for (int i = 0; i < 4; ++i) { o0[i] = bf2f(hb[i]) + bf2f(pv[i]) * __builtin_amdgcn_rcpf(1.f + __expf(-g0[i])); o1[i] = bf2f(hb[4 + i]) + bf2f(pv[4 + i]) * __builtin_amdgcn_rcpf(1.f + __expf(-g1[i])); }
                    *(f32x4*)(out + off) = o0; *(f32x4*)(out + off + 4) = o1;
                }
            }
    }
};

template <class Epi>
DI void gemm_simple(const bf16_t* A, const bf16_t* Bt, int M, int N, int K, const Epi& epi, int gwave, int nwaves, int lane) {
    const int r32 = lane & 31, hi = lane >> 5;
    const int nNt = N / 64, total = (M / 32) * nNt;
    for (int tile = gwave; tile < total; tile += nwaves) {
        const int mt = tile / nNt, nt = tile - mt * nNt, m0 = mt * 32, n0 = nt * 64;
        const bf16_t* ap = A + (size_t)(m0 + r32) * K + 8 * hi;
        const bf16_t* b0p = Bt + (size_t)(n0 + r32) * K + 8 * hi;
        const bf16_t* b1p = b0p + (size_t)32 * K;
        f32x16 acc0 = zero16(), acc1 = zero16();
#pragma unroll 4
        for (int k = 0; k < K; k += 16) {
            const bf16x8 xa = *(const bf16x8*)(ap + k);
            const bf16x8 w0 = *(const bf16x8*)(b0p + k);
            const bf16x8 w1 = *(const bf16x8*)(b1p + k);
            acc0 = MFMA32(w0, xa, acc0);
            acc1 = MFMA32(w1, xa, acc1);
        }
        epi(m0 + r32, n0, hi, acc0, acc1);
    }
}

struct Epi1 {
    bf16_t* base6;
    const float *qn, *kn;
    DI void operator()(int tok, int n0, int hi, const f32x16& a0, const f32x16& a1) const {
        const int head48 = n0 >> 6, typ = head48 >> 3, h = head48 & 7;
        bf16_t* reg = base6 + (size_t)typ * (16u << 19);
        if (typ == 2 || typ == 5) {
            const int b = tok >> 11, s = tok & 2047;
            const int pos = (s & ~12) | ((s & 4) << 1) | ((s & 8) >> 1);
            bf16_t* base = reg + ((size_t)(b * 8 + h) * 64) * 2048 + pos;
#pragma unroll
            for (int r = 0; r < 16; ++r) { base[(size_t)crow(r, hi) * 2048] = f2bf(a0[r]); base[(size_t)(32 + crow(r, hi)) * 2048] = f2bf(a1[r]); }
        } else {
            float rs = 1.f;
            const bool nrm = (typ == 0 || typ == 1);
            if (nrm) { float ss = 0.f;
#pragma unroll
                for (int r = 0; r < 16; ++r) ss += a0[r] * a0[r] + a1[r] * a1[r];
                ss = sum_x32(ss);
                rs = rsqrtf(ss * (1.f / 64.f) + EPS); }
            const float* g = (typ == 0) ? qn : kn;
            bf16_t* dst = reg + (size_t)tok * 512 + h * 64;
#pragma unroll
            for (int t = 0; t < 2; ++t)
#pragma unroll
                for (int g4 = 0; g4 < 4; ++g4) {
                    const int f0 = 32 * t + 8 * g4 + 4 * hi;
                    float v[4];
#pragma unroll
                    for (int i = 0; i < 4; ++i) { const float a = t ? a1[4 * g4 + i] : a0[4 * g4 + i]; v[i] = nrm ? a * rs * g[f0 + i] : a; }
                    u32x2 w; w.x = cvtpk(v[0], v[1]); w.y = cvtpk(v[2], v[3]);
                    *(u32x2*)(dst + f0) = w;
                }
        }
    }
};

struct Epi2 {
    const float* x; float* out; bf16_t* xn;
    DI void operator()(int tok, int n0, int hi, const f32x16& a0, const f32x16& a1) const {
#pragma unroll
        for (int t = 0; t < 2; ++t)
#pragma unroll
            for (int g4 = 0; g4 < 4; ++g4) {
                const size_t off = (size_t)tok * 1024 + n0 + 32 * t + 8 * g4 + 4 * hi;
                const f32x4 xv = *(const f32x4*)(x + off);
                f32x4 hv;
#pragma unroll
                for (int i = 0; i < 4; ++i) hv[i] = xv[i] + (t ? a1[4 * g4 + i] : a0[4 * g4 + i]);
                *(f32x4*)(out + off) = hv;
                u32x2 w; w.x = cvtpk(hv[0], hv[1]); w.y = cvtpk(hv[2], hv[3]);
                *(u32x2*)(xn + off) = w;
            }
    }
};

struct Epi3 {
    float* sc;
    DI void operator()(int tok, int n0, int hi, const f32x16& a0, const f32x16& a1) const {
#pragma unroll
        for (int t = 0; t < 2; ++t)
#pragma unroll
            for (int g4 = 0; g4 < 4; ++g4) {
                f32x4 v;
#pragma unroll
                for (int i = 0; i < 4; ++i) v[i] = t ? a1[4 * g4 + i] : a0[4 * g4 + i];
                *(f32x4*)(sc + (size_t)tok * 2048 + n0 + 32 * t + 8 * g4 + 4 * hi) = v;
            }
    }
};

DI void pv_accum(f32x16& o0, f32x16& o1, const f32x16& p, const bf16_t* vt_row) {
#pragma unroll
    for (int s = 0; s < 2; ++s) {
        u32x4 pk; pk.x = cvtpk(p[8 * s], p[8 * s + 1]); pk.y = cvtpk(p[8 * s + 2], p[8 * s + 3]); pk.z = cvtpk(p[8 * s + 4], p[8 * s + 5]); pk.w = cvtpk(p[8 * s + 6], p[8 * s + 7]);
        const bf16x8 pb = __builtin_bit_cast(bf16x8, pk);
        const bf16x8 v0 = *(const bf16x8*)(vt_row + 16 * s);
        const bf16x8 v1 = *(const bf16x8*)(vt_row + (size_t)32 * 2048 + 16 * s);
        o0 = MFMA32(v0, pb, o0);
        o1 = MFMA32(v1, pb, o1);
    }
}

DI void store_o(bf16_t* op, const f32x16& o0, const f32x16& o1, float inv, int hi) {
#pragma unroll
    for (int t = 0; t < 2; ++t)
#pragma unroll
        for (int g4 = 0; g4 < 4; ++g4) {
            u32x2 w;
            if (t == 0) { w.x = cvtpk(o0[4 * g4] * inv, o0[4 * g4 + 1] * inv); w.y = cvtpk(o0[4 * g4 + 2] * inv, o0[4 * g4 + 3] * inv); }
            else        { w.x = cvtpk(o1[4 * g4] * inv, o1[4 * g4 + 1] * inv); w.y = cvtpk(o1[4 * g4 + 2] * inv, o1[4 * g4 + 3] * inv); }
            *(u32x2*)(op + 32 * t + 8 * g4 + 4 * hi) = w;
        }
}

constexpr int OT_PITCH = 1040;
DI void store_o_lds(LAS unsigned char* ot, int r32, int h, const f32x16& o0, const f32x16& o1, float inv, int hi) {
    LAS unsigned char* op = ot + r32 * OT_PITCH + h * 128;
#pragma unroll
    for (int t = 0; t < 2; ++t)
#pragma unroll
        for (int g4 = 0; g4 < 4; ++g4) {
            u32x2 w;
            if (t == 0) { w.x = cvtpk(o0[4 * g4] * inv, o0[4 * g4 + 1] * inv); w.y = cvtpk(o0[4 * g4 + 2] * inv, o0[4 * g4 + 3] * inv); }
            else        { w.x = cvtpk(o1[4 * g4] * inv, o1[4 * g4 + 1] * inv); w.y = cvtpk(o1[4 * g4 + 2] * inv, o1[4 * g4 + 3] * inv); }
            *(LAS u32x2*)(op + (32 * t + 8 * g4 + 4 * hi) * 2) = w;
        }
}
DI void load_kfrag(bf16x8 (&kf)[4], const bf16_t* fbase  , int tile) {
    const bf16_t* kp = fbase + (size_t)tile * 2048;
#pragma unroll
    for (int s = 0; s < 4; ++s) kf[s] = *(const bf16x8*)(kp + s * 512);
}
DI void load_vfrag(bf16x8 (&vf)[4], const bf16_t* fbase, int tile) {
    const bf16_t* vp = fbase + (size_t)tile * 2048;
#pragma unroll
    for (int q = 0; q < 4; ++q) vf[q] = *(const bf16x8*)(vp + q * 512);
}
DI void pv_accum2(f32x16& o0, f32x16& o1, const f32x16& p, const bf16x8 (&vf)[4]) {
#pragma unroll
    for (int s = 0; s < 2; ++s) {
        u32x4 pk; pk.x = cvtpk(p[8 * s], p[8 * s + 1]); pk.y = cvtpk(p[8 * s + 2], p[8 * s + 3]); pk.z = cvtpk(p[8 * s + 4], p[8 * s + 5]); pk.w = cvtpk(p[8 * s + 6], p[8 * s + 7]);
        const bf16x8 pb = __builtin_bit_cast(bf16x8, pk);
        o0 = MFMA32(vf[2 * s], pb, o0);
        o1 = MFMA32(vf[2 * s + 1], pb, o1);
    }
}

#define MEM_FENCE() asm volatile("" ::: "memory")
#define PIN1(a) asm volatile("" : "+v"(a) :: "memory")
#define PIN2(a, b) asm volatile("" : "+v"(a), "+v"(b) :: "memory")
DI void vm_drain() { __builtin_amdgcn_s_waitcnt(0x0F70); }
struct KvStream { const bf16_t* kbase; const bf16_t* vbase; };

struct MobaCtx { int q0, tq, blk, hi; unsigned selmask; float bfar; const LAS float* bt; };
DI void moba_tile(bf16x8 (&kf)[4], bf16x8 (&vf)[4], const bf16x8 (&qf)[4], int kt, int next, const KvStream& kv, const MobaCtx& c, float& mrun, float& lsum, f32x16& o0, f32x16& o1) {
    const int n = kt >> 3, key0 = kt * 32;
    f32x16 st = zero16();
#pragma unroll
    for (int s = 0; s < 4; ++s) st = MFMA32(kf[s], qf[s], st);
    PIN1(st); load_kfrag(kf, kv.kbase, next); PIN1(st);
    float x[16];
    if (n != c.blk) {
        const bool selq = (c.selmask >> n) & 1u;
        if ((c.q0 - (key0 + 31)) >= 128) {
            const float addend = selq ? c.bfar : -1e30f;
#pragma unroll
            for (int r = 0; r < 16; ++r) x[r] = st[r] * SCL2 + addend;
        } else {
#pragma unroll
            for (int r = 0; r < 16; ++r) { const int dist = c.tq - (key0 + crow(r, c.hi)); const float v = st[r] * SCL2 + c.bt[dist > 128 ? 128 : dist]; x[r] = selq ? v : -1e30f; }
        }
    } else {
#pragma unroll
        for (int r = 0; r < 16; ++r) { const int dist = c.tq - (key0 + crow(r, c.hi)); const float v = st[r] * SCL2 + c.bt[dist < 0 ? 0 : (dist > 128 ? 128 : dist)]; x[r] = (dist >= 0) ? v : -1e30f; }
    }
    float mx = x[0];
#pragma unroll
    for (int r = 1; r < 16; ++r) mx = fmaxf(mx, x[r]);
    mx = max_x32(mx);
    const float mnew = fmaxf(mrun, mx);
    if (!__all(mnew == mrun)) {
        const float alpha = __builtin_amdgcn_exp2f(mrun - mnew);
        lsum *= alpha;
#pragma unroll
        for (int r = 0; r < 16; ++r) { o0[r] *= alpha; o1[r] *= alpha; }
        mrun = mnew;
    }
    f32x16 pr; float ps = 0.f;
#pragma unroll
    for (int r = 0; r < 16; ++r) { const float e = __builtin_amdgcn_exp2f(x[r] - mrun); pr[r] = e; ps += e; }
    lsum += ps;
    pv_accum2(o0, o1, pr, vf);
    PIN2(o0, o1); load_vfrag(vf, kv.vbase, next); MEM_FENCE();
}
DI int moba_next(int kt, int blk, unsigned anysel) {
    int nkt = kt - 1;
    while (nkt >= 0) { const int nn = nkt >> 3; if (nn == blk || ((anysel >> nn) & 1u)) break; nkt = nn * 8 - 1; }
    return nkt;
}

DI void moba_unit(int b, int h, int qt, const bf16_t* Qm_, const bf16_t* Km_, const bf16_t* VtM_, const float* kmean_, const LAS float* biasLds, LAS unsigned char* ot, int lane) {
    const int r32 = lane & 31, hi = lane >> 5;
    const int q0 = qt * 32, tq = q0 + r32, blk = q0 >> 8;
    const size_t bh = (size_t)(b * 8 + h);
    const bf16_t* qfb = Qm_ + bh * (64 * 2048) + (size_t)qt * 2048;
    KvStream kv; kv.kbase = Km_ + bh * (64 * 2048) + lane * 8; kv.vbase = VtM_ + bh * (64 * 2048) + lane * 8;
    bf16x8 kf[4], vf[4];
    load_kfrag(kf, kv.kbase, qt); load_vfrag(vf, kv.vbase, qt);
    bf16x8 qf[4];
#pragma unroll
    for (int s = 0; s < 4; ++s) qf[s] = *(const bf16x8*)(qfb + s * 512 + lane * 8);
    unsigned selmask = 0;
    if (blk > 0) {
        float qv[32];
#pragma unroll
        for (int c = 0; c < 4; ++c) { const bf16x8 t = *(const bf16x8*)(qfb + (2 * hi + (c >> 1)) * 512 + ((c & 1) * 32 + r32) * 8);
#pragma unroll
            for (int j = 0; j < 8; ++j) qv[8 * c + j] = bf2f(t[j]); }
        const float* km = kmean_ + (size_t)((b * 8 + h) * 8) * 64 + 32 * hi;
        float g[8];
#pragma unroll
        for (int n = 0; n < 8; ++n) {
            float a = 0.f;
            if (n < blk) {
#pragma unroll
                for (int d4 = 0; d4 < 8; ++d4) { const f32x4 kv4 = *(const f32x4*)(km + n * 64 + 4 * d4); a += (qv[4 * d4] * kv4.x + qv[4 * d4 + 1] * kv4.y) + (qv[4 * d4 + 2] * kv4.z + qv[4 * d4 + 3] * kv4.w); }
            }
            a = sum_x32(a);
            g[n] = (n < blk) ? a : -INFINITY;
        }
#pragma unroll
        for (int n = 0; n < 8; ++n) {
            int rank = 0;
#pragma unroll
            for (int m = 0; m < 8; ++m) if (m != n) rank += ((g[m] > g[n]) || (g[m] == g[n] && m < n)) ? 1 : 0;
            if (n < blk && rank < 3) selmask |= 1u << n;
        }
    }
    unsigned anysel = 0;
#pragma unroll
    for (int n = 0; n < 8; ++n) if (__any((selmask >> n) & 1u)) anysel |= 1u << n;
    anysel = __builtin_amdgcn_readfirstlane(anysel);
    float mrun = -1e30f, lsum = 0.f;
    f32x16 o0 = zero16(), o1 = zero16();
    MobaCtx c; c.q0 = q0; c.tq = tq; c.blk = blk; c.hi = hi; c.selmask = selmask; c.bt = biasLds + h * 132; c.bfar = c.bt[128];
    vm_drain();
    int kt = qt;
    for (;;) {
        const int nx = moba_next(kt, blk, anysel);
        moba_tile(kf, vf, qf, kt, nx < 0 ? 0 : nx, kv, c, mrun, lsum, o0, o1);
        if (nx < 0) break;
        kt = nx;
    }
    lsum = sum_x32(lsum);
    const float inv = 1.f / lsum;
    store_o_lds(ot, r32, h, o0, o1, inv, hi);
}

DI void sb_tile(bf16x8 (&kf)[4], bf16x8 (&vf)[4], const bf16x8 (&qf)[4], int kt, int next, const KvStream& kv, int tq, int hi, float& C, f32x16& o0, f32x16& o1) {
    const int key0 = kt * 32;
    f32x16 st = zero16();
#pragma unroll
    for (int s = 0; s < 4; ++s) st = MFMA32(kf[s], qf[s], st);
    PIN1(st); load_kfrag(kf, kv.kbase, next); PIN1(st);
    float rr[16], be[16];
#pragma unroll
    for (int r = 0; r < 16; ++r) {
        const int key = key0 + crow(r, hi);
        const float y = fminf(st[r] * SCL2, 100.f);
        const float e = __builtin_amdgcn_exp2f(y);
        const float ri = __builtin_amdgcn_rcpf(1.f + e);
        const bool ok = key < tq;
        rr[r] = ok ? ri : 1.f;
        be[r] = ok ? e * ri : 0.f;
    }
    float G[4], ex[16], Gp[4], Tt[4], Suf[4];
#pragma unroll
    for (int a = 0; a < 4; ++a) {
        ex[4 * a + 3] = 1.f; ex[4 * a + 2] = rr[4 * a + 3]; ex[4 * a + 1] = ex[4 * a + 2] * rr[4 * a + 2]; ex[4 * a] = ex[4 * a + 1] * rr[4 * a + 1];
        G[a] = ex[4 * a] * rr[4 * a];
    }
#pragma unroll
    for (int a = 0; a < 4; ++a) { float lo_, hi_; swap32(G[a], lo_, hi_); Gp[a] = hi_; Tt[a] = lo_ * hi_; }
    Suf[3] = 1.f; Suf[2] = Tt[3]; Suf[1] = Tt[3] * Tt[2]; Suf[0] = Suf[1] * Tt[1];
    f32x16 pr;
#pragma unroll
    for (int a = 0; a < 4; ++a) {
        const float after = Suf[a] * (hi == 0 ? Gp[a] : 1.f) * C;
#pragma unroll
        for (int i = 0; i < 4; ++i) pr[4 * a + i] = be[4 * a + i] * ex[4 * a + i] * after;
    }
    C = C * (Suf[0] * Tt[0]);
    pv_accum2(o0, o1, pr, vf);
    PIN2(o0, o1); load_vfrag(vf, kv.vbase, next); MEM_FENCE();
}

DI void sb_unit(int b, int h, int qt, const bf16_t* Qs_, const bf16_t* Ks_, const bf16_t* VtS_, LAS unsigned char* ot, int lane) {
    const int r32 = lane & 31, hi = lane >> 5;
    const int q0 = qt * 32, tq = q0 + r32;
    const size_t bh = (size_t)(b * 8 + h);
    const bf16_t* qfb = Qs_ + bh * (64 * 2048) + (size_t)qt * 2048;
    KvStream kv; kv.kbase = Ks_ + bh * (64 * 2048) + lane * 8; kv.vbase = VtS_ + bh * (64 * 2048) + lane * 8;
    bf16x8 kf[4], vf[4];
    load_kfrag(kf, kv.kbase, qt); load_vfrag(vf, kv.vbase, qt);
    bf16x8 qf[4];
#pragma unroll
    for (int s = 0; s < 4; ++s) qf[s] = *(const bf16x8*)(qfb + s * 512 + lane * 8);
    f32x16 o0 = zero16(), o1 = zero16();
    float C = 1.f;
    vm_drain();
    for (int kt = qt; kt >= 0; --kt) {
        sb_tile(kf, vf, qf, kt, kt > 0 ? kt - 1 : 0, kv, tq, hi, C, o0, o1);
        if (__all(C == 0.f ? 1 : 0)) break;
    }
    store_o_lds(ot, r32, h, o0, o1, 1.f, hi);
}

DI void ce_desc(unsigned& a, unsigned& b) { const unsigned hi = a > b ? a : b, lo = a > b ? b : a; a = hi; b = lo; }
DI void bitonic_clean_desc(unsigned (&v)[16]) {
#pragma unroll
    for (int s = 8; s >= 1; s >>= 1)
#pragma unroll
        for (int i = 0; i < 16; ++i) if ((i & s) == 0) ce_desc(v[i], v[i + s]);
}
DI void sort16_desc(unsigned (&v)[16]) {
#pragma unroll
    for (int k = 2; k <= 16; k <<= 1)
#pragma unroll
        for (int j = k >> 1; j >= 1; j >>= 1)
#pragma unroll
            for (int i = 0; i < 16; ++i) { const int l = i ^ j; if (l > i) { if ((i & k) == 0) ce_desc(v[i], v[l]); else ce_desc(v[l], v[i]); } }
}
DI float key_value(unsigned key) { const unsigned kk = key & ~127u; const unsigned u = (kk & 0x80000000u) ? (kk & 0x7fffffffu) : ~kk; return __builtin_bit_cast(float, u); }
DI float key_value8(unsigned key) { const unsigned kk = key & ~255u; const unsigned u = (kk & 0x80000000u) ? (kk & 0x7fffffffu) : ~kk; return __builtin_bit_cast(float, u); }
template <int CTRL> DI unsigned dppu(unsigned v) { return (unsigned)__builtin_amdgcn_update_dpp(0, (int)v, CTRL, 0xF, 0xF, true); }
DI void sort8_desc(unsigned (&v)[8]) {
    ce_desc(v[0], v[2]); ce_desc(v[1], v[3]); ce_desc(v[4], v[6]); ce_desc(v[5], v[7]);
    ce_desc(v[0], v[4]); ce_desc(v[1], v[5]); ce_desc(v[2], v[6]); ce_desc(v[3], v[7]);
    ce_desc(v[0], v[1]); ce_desc(v[2], v[3]); ce_desc(v[4], v[5]); ce_desc(v[6], v[7]);
    ce_desc(v[2], v[4]); ce_desc(v[3], v[5]);
    ce_desc(v[1], v[4]); ce_desc(v[3], v[6]);
    ce_desc(v[1], v[2]); ce_desc(v[3], v[4]); ce_desc(v[5], v[6]);
}
DI void clean8_desc(unsigned (&v)[8]) {
#pragma unroll
    for (int s = 4; s >= 1; s >>= 1)
#pragma unroll
        for (int i = 0; i < 8; ++i) if ((i & s) == 0) ce_desc(v[i], v[i + s]);
}
template <int CTRL> DI void cross_rev_max(unsigned (&v)[8]) {
    unsigned t[8];
#pragma unroll
    for (int i = 0; i < 8; ++i) t[i] = dppu<CTRL>(v[7 - i]);
#pragma unroll
    for (int i = 0; i < 8; ++i) v[i] = v[i] > t[i] ? v[i] : t[i];
}
template <bool REV> DI void cross_minmax_x1(unsigned (&v)[8], bool odd) {
    unsigned t[8];
#pragma unroll
    for (int i = 0; i < 8; ++i) t[i] = dppu<DPP_XOR1>(v[REV ? 7 - i : i]);
#pragma unroll
    for (int i = 0; i < 8; ++i) { const unsigned hi = v[i] > t[i] ? v[i] : t[i], lo = v[i] > t[i] ? t[i] : v[i]; v[i] = odd ? lo : hi; }
}

DI float reduce16(const float (&p)[16], int lane) {
    const bool b3 = lane & 8, b2 = lane & 4, b1 = lane & 2, b0 = lane & 1;
    float q[8], r[4], s[2];
#pragma unroll
    for (int i = 0; i < 8; ++i) { const float mine = b3 ? p[i + 8] : p[i], send = b3 ? p[i] : p[i + 8]; q[i] = mine + __shfl_xor(send, 8); }
#pragma unroll
    for (int i = 0; i < 4; ++i) { const float mine = b2 ? q[i + 4] : q[i], send = b2 ? q[i] : q[i + 4]; r[i] = mine + __shfl_xor(send, 4); }
#pragma unroll
    for (int i = 0; i < 2; ++i) { const float mine = b1 ? r[i + 2] : r[i], send = b1 ? r[i] : r[i + 2]; s[i] = mine + __shfl_xor(send, 2); }
    const float mine = b0 ? s[1] : s[0], send = b0 ? s[0] : s[1];
    float t = mine + __shfl_xor(send, 1);
    t = sum_x32(sum_x16(t));
    return t;
}

#ifndef PEER_REP_TOPK
#define PEER_REP_TOPK 1
#endif
#ifndef PEER_REP_U
#define PEER_REP_U 1
#endif
#ifndef PEER_REP_V
#define PEER_REP_V 1
#endif
struct TopkIn { bf16x8 hv[2]; bf16x8 sv[4]; };
DI void peer_topk_load(TopkIn& in, int tok, const bf16_t* h1b, const bf16_t* scores, int lane) {
    const int tc = tok < T ? tok : T - 1;
    const bf16_t* hrow = h1b + (size_t)tc * 1024 + 16 * lane;
    const bf16_t* sp = scores + (size_t)tc * 2048 + (lane >> 2) * 128 + (lane & 3) * 8;
#pragma unroll
    for (int i = 0; i < 4; ++i) in.sv[i] = *(const bf16x8*)(sp + 32 * i);
    in.hv[0] = *(const bf16x8*)hrow; in.hv[1] = *(const bf16x8*)(hrow + 8);
}
DI void peer_topk_token(int tok, const TopkIn& in, const float* gffn, int* EIDXg, float* GATEg, unsigned char* XN2g, float* XSg, LAS float* wl, int lane) {
    LAS unsigned* kbuf = (LAS unsigned*)wl; const LAS unsigned* ctab = (const LAS unsigned*)(wl + 768);
    f32x4 hv[4];
    float ss = 0.f;
#pragma unroll
    for (int i = 0; i < 4; ++i) { const bf16x8 hb = in.hv[i >> 1]; const int o4 = 4 * (i & 1); hv[i] = (f32x4){bf2f(hb[o4]), bf2f(hb[o4 + 1]), bf2f(hb[o4 + 2]), bf2f(hb[o4 + 3])}; ss += (hv[i].x * hv[i].x + hv[i].y * hv[i].y) + (hv[i].z * hv[i].z + hv[i].w * hv[i].w); }
    ss = wave_sum(ss);
    const float rs2 = rsqrtf(ss * (1.f / 1024.f) + EPS);
    {
        float y[16], m = 0.f;
#pragma unroll
        for (int i = 0; i < 4; ++i) { const f32x4 gv = *(const f32x4*)(gffn + 16 * lane + 4 * i);
#pragma unroll
            for (int e = 0; e < 4; ++e) { y[4 * i + e] = hv[i][e] * rs2 * gv[e]; m = fmaxf(m, fabsf(y[4 * i + e])); } }
        m = wave_max(m);
        const float inv = m > 0.f ? 119.f / m : 0.f;
        unsigned xh0 = 0u, xh1 = 0u, xl0 = 0u, xl1 = 0u;
#pragma unroll
        for (int e = 0; e < 16; ++e) {
            const int q = (int)rintf(y[e] * inv);
            const unsigned nl = (unsigned)q & 15u, nh = (unsigned)((q + 8) >> 4) & 15u;
            if (e < 8) { xl0 |= nl << (4 * e); xh0 |= nh << (4 * e); } else { xl1 |= nl << (4 * (e - 8)); xh1 |= nh << (4 * (e - 8)); }
        }
        u32x2 wh, wl2; wh.x = xh0; wh.y = xh1; wl2.x = xl0; wl2.y = xl1;
        *(u32x2*)(XN2g + (size_t)tok * 1024 + 8 * lane) = wh;
        *(u32x2*)(XN2g + (size_t)tok * 1024 + 512 + 8 * lane) = wl2;
        if (lane == 0) XSg[tok] = m > 0.f ? m * (1.f / 119.f) : 0.f;
    }
    {
        const int L = lane >> 2, q = lane & 3;
        unsigned k0[16], k1[16];
#pragma unroll
        for (int i = 0; i < 4; ++i) {
            const bf16x8 v = in.sv[i];
#pragma unroll
            for (int cI = 0; cI < 8; ++cI) {
                const unsigned u = ((unsigned)(unsigned short)v[cI]) << 16;
                const unsigned mono = (u & 0x80000000u) ? ~u : (u | 0x80000000u);
                const unsigned key = (mono & ~127u) | (unsigned)(127 - (32 * i + 8 * q + cI));
                if (i < 2) k0[8 * i + cI] = key; else k1[8 * (i - 2) + cI] = key;
            }
        }
        sort16_desc(k0); sort16_desc(k1);
        unsigned t[16];
#pragma unroll
        for (int i = 0; i < 16; ++i) t[i] = k0[i] > k1[15 - i] ? k0[i] : k1[15 - i];
        bitonic_clean_desc(t);
#pragma unroll
        for (int i = 0; i < 16; ++i) k0[i] = (unsigned)__builtin_amdgcn_update_dpp(0, (int)t[15 - i], 0xB1, 0xF, 0xF, true);
#pragma unroll
        for (int i = 0; i < 16; ++i) t[i] = t[i] > k0[i] ? t[i] : k0[i];
        bitonic_clean_desc(t);
#pragma unroll
        for (int i = 0; i < 16; ++i) k0[i] = (unsigned)__builtin_amdgcn_update_dpp(0, (int)t[15 - i], 0x4E, 0xF, 0xF, true);
#pragma unroll
        for (int i = 0; i < 16; ++i) t[i] = t[i] > k0[i] ? t[i] : k0[i];
        bitonic_clean_desc(t);
        if (q == 0) {
#pragma unroll
            for (int i = 0; i < 4; ++i) { u32x4 w; w.x = t[4 * i]; w.y = t[4 * i + 1]; w.z = t[4 * i + 2]; w.w = t[4 * i + 3]; *(LAS u32x4*)(kbuf + L * 16 + 4 * i) = w; }
        }
        asm volatile("s_waitcnt lgkmcnt(0)" ::: "memory");
    }
    {
        const int hd = lane >> 3, sub = lane & 7; const bool odd = sub & 1;
        unsigned ck[8];
#pragma unroll
        for (int k = 0; k < 7; ++k) {
            const int cidx = 7 * sub + k;
            const unsigned tab = ctab[cidx];
            const unsigned ia = tab & 15u, ib = (tab >> 8) & 15u;
            const unsigned ka = kbuf[hd * 32 + ia], kb = kbuf[hd * 32 + 16 + ib];
            const float v = key_value(ka) + key_value(kb);
            const unsigned u = __float_as_uint(v);
            const unsigned mono = (u & 0x80000000u) ? ~u : (u | 0x80000000u);
            ck[k] = (cidx < 50) ? ((mono & ~255u) | (255u - (16u * ia + ib))) : 0u;
        }
        ck[7] = 0u;
        sort8_desc(ck);
        cross_minmax_x1<true>(ck, odd); clean8_desc(ck);
        cross_rev_max<0x1B>(ck); cross_minmax_x1<false>(ck, odd); clean8_desc(ck);
        cross_rev_max<DPP_HMIR>(ck); cross_minmax_x1<false>(ck, odd); clean8_desc(ck);
        const int pr = sub >> 1;
        const unsigned e0 = pr == 0 ? ck[0] : pr == 1 ? ck[2] : pr == 2 ? ck[4] : ck[6];
        const unsigned e1 = pr == 0 ? ck[1] : pr == 1 ? ck[3] : pr == 2 ? ck[5] : ck[7];
        const unsigned id0 = 255u - (e0 & 255u), id1 = 255u - (e1 & 255u);
        const unsigned ka0 = kbuf[hd * 32 + (id0 >> 4)], kb0 = kbuf[hd * 32 + 16 + (id0 & 15u)];
        const unsigned ka1 = kbuf[hd * 32 + (id1 >> 4)], kb1 = kbuf[hd * 32 + 16 + (id1 & 15u)];
        const float v0 = key_value8(e0), v1 = key_value8(e1);
        const float mx = max_oct(fmaxf(v0, v1));
        const float ev0 = __expf((v0 - mx) * rs2), ev1 = __expf((v1 - mx) * rs2);
        const float inv = 1.f / sum_oct(ev0 + ev1);
        const int rank0 = (odd ? 8 : 0) + 2 * pr;
        u32x2 ew; ew.x = (127u - (ka0 & 127u)) * 128u + (127u - (kb0 & 127u)); ew.y = (127u - (ka1 & 127u)) * 128u + (127u - (kb1 & 127u));
        f32x2 gw; gw.x = ev0 * inv; gw.y = ev1 * inv;
        *(u32x2*)(EIDXg + (size_t)tok * 128 + hd * 16 + rank0) = ew;
        *(f32x2*)(GATEg + (size_t)tok * 128 + hd * 16 + rank0) = gw;
    }
}

DI float dot16_fp8(const u32x4& row, const float (&x)[16]) {
    float sacc = 0.f;
#pragma unroll
    for (int w = 0; w < 4; ++w) { const f32x2 lo = __builtin_amdgcn_cvt_pk_f32_fp8((int)row[w], false), hi2 = __builtin_amdgcn_cvt_pk_f32_fp8((int)row[w], true);
        sacc += lo.x * x[4 * w] + lo.y * x[4 * w + 1] + hi2.x * x[4 * w + 2] + hi2.y * x[4 * w + 3]; }
    return sacc;
}
template <class TT> DI TT ldu(const void* ubase, unsigned off) { return *(const TT*)((const char*)ubase + off); }
template <bool LO>
DI void peer_u_slice(int sl, int t_lo, int t_hi, int tk_first, int tk_step, const unsigned char* XNg, const int* EIDXg, const unsigned char* U6s, bf16_t* PDOT, int lane) {
    const int es = lane >> 3, c = lane & 7;
    const unsigned char* tb = U6s + (size_t)sl * 16384 * 128;
    const unsigned c16 = 16u * c, eoff = 64u * es, poff = (16u * es + c) * 2u;
    const unsigned xoff = LO ? 256u * (unsigned)(sl - 4) + 32u * c : 128u * (unsigned)sl + 16u * c;
    const bool b2 = c & 4, b1 = c & 2, b0 = c & 1;
    constexpr int NX = LO ? 2 : 1;
    u32x4 I0[2], I1[2], I2[2], rowsA[8], rowsB[8], rowsC[8], xh0[NX], xl0[NX], xh1[NX], xl1[NX], xh2[NX], xl2[NX];
#define LD_E8(ib, tk, h) do { const int _t = (tk) < t_hi ? (tk) : t_hi - 1; const int* _eb = EIDXg + (size_t)_t * 128 + 8 * (h); ib[0] = ldu<u32x4>(_eb, eoff); ib[1] = ldu<u32x4>(_eb, eoff + 16u); } while (0)
#define LD_R8(rows, ib, tbl) do { _Pragma("unroll") for (int _q = 0; _q < 2; ++_q) _Pragma("unroll") for (int _r = 0; _r < 4; ++_r) rows[4 * _q + _r] = ldu<u32x4>(tbl, ib[_q][_r] * 128u + c16); } while (0)
#define LD_X(xh, xl, tk) do { const int _t = (tk) < t_hi ? (tk) : t_hi - 1; const unsigned char* _xb = XNg + (size_t)_t * 1024; \
        _Pragma("unroll") for (int _n = 0; _n < NX; ++_n) { xh[_n] = ldu<u32x4>(_xb, xoff + 16u * _n); xl[_n] = ldu<u32x4>(_xb, 512u + xoff + 16u * _n); } } while (0)
#define U_COMPUTE8(rows, xh, xl, tk, h) do { \
        float _p[8]; _Pragma("unroll") for (int _i = 0; _i < 8; ++_i) { if (_i > 0) asm volatile("" : "+v"(rows[_i]) : "v"(_p[_i - 1])); int _ah = 0, _al = 0; \
            _Pragma("unroll") for (int _w = 0; _w < 4; ++_w) { const unsigned _d = rows[_i][_w]; \
                if (LO) { const int _e = (int)(_d & 0x33333333u), _o = (int)((_d >> 2) & 0x33333333u); const int _n = _w >> 1, _k = 2 * (_w & 1); \
                    _ah = __builtin_amdgcn_sdot8(_e, (int)xh[_n][_k], _ah, false); _ah = __builtin_amdgcn_sdot8(_o, (int)xh[_n][_k + 1], _ah, false); \
                    _al = __builtin_amdgcn_sdot8(_e, (int)xl[_n][_k], _al, false); _al = __builtin_amdgcn_sdot8(_o, (int)xl[_n][_k + 1], _al, false); } \
                else { _ah = __builtin_amdgcn_sdot8((int)_d, (int)xh[0][_w], _ah, false); _al = __builtin_amdgcn_sdot8((int)_d, (int)xl[0][_w], _al, false); } } \
            _p[_i] = LO ? (float)(16 * _ah + _al) : (float)(64 * _ah + 4 * _al); } \
        float _q4[4], _q2[2]; \
        _Pragma("unroll") for (int _k = 0; _k < 4; ++_k) _q4[_k] = tr_x4(_p[_k], _p[_k + 4], b2); \
        _Pragma("unroll") for (int _k = 0; _k < 2; ++_k) _q2[_k] = tr_x2(_q4[_k], _q4[_k + 2], b1); \
        const float _r1 = tr_x1(_q2[0], _q2[1], b0); \
        if ((tk) < t_hi) { bf16_t* _pb = PDOT + ((size_t)sl * T + (tk)) * 128 + 8 * (h); *(bf16_t*)((char*)_pb + poff) = f2bf(_r1); } } while (0)
    int t0 = t_lo + tk_first;
    LD_E8(I0, t0, 0); LD_E8(I1, t0, 1); LD_E8(I2, t0 + tk_step, 0); LD_X(xh0, xl0, t0); LD_R8(rowsA, I0, tb); LD_R8(rowsB, I1, tb);
#pragma unroll 1
    for (; t0 < t_hi; t0 += 3 * tk_step) {
        const int t1 = t0 + tk_step, t2 = t1 + tk_step, t3 = t2 + tk_step;
        LD_E8(I0, t1, 1);           LD_R8(rowsC, I2, tb); LD_X(xh1, xl1, t1); U_COMPUTE8(rowsA, xh0, xl0, t0, 0);
        LD_E8(I1, t2, 0);           LD_R8(rowsA, I0, tb);                     U_COMPUTE8(rowsB, xh0, xl0, t0, 1);
        LD_E8(I2, t2, 1);           LD_R8(rowsB, I1, tb); LD_X(xh2, xl2, t2); U_COMPUTE8(rowsC, xh1, xl1, t1, 0);
        LD_E8(I0, t3, 0);           LD_R8(rowsC, I2, tb);                     U_COMPUTE8(rowsA, xh1, xl1, t1, 1);
        LD_E8(I1, t3, 1);           LD_R8(rowsA, I0, tb); LD_X(xh0, xl0, t3); U_COMPUTE8(rowsB, xh2, xl2, t2, 0);
        LD_E8(I2, t3 + tk_step, 0); LD_R8(rowsB, I1, tb);                     U_COMPUTE8(rowsC, xh2, xl2, t2, 1);
    }
#undef U_COMPUTE8
#undef LD_X
}
DI unsigned pk_f16_dup(float v) { const _Float16 h = (_Float16)v; const unsigned b = (unsigned)__builtin_bit_cast(unsigned short, h); return b | (b << 16); }
DI float erf_as(float x) {
    const float ax = fabsf(x), t = __builtin_amdgcn_rcpf(1.f + 0.3275911f * ax);
    const float poly = t * (0.254829592f + t * (-0.284496736f + t * (1.421413741f + t * (-1.453152027f + t * 1.061405429f))));
    const float r = 1.f - poly * __expf(-ax * ax);
    return copysignf(r, x);
}
template <int NT> DI void peer_cj_tokens(int tok0, int tstride, const int* EIDXg, const float* GATEg, const bf16_t* PDOT, const float* usc, const float* vsc, const float* XSg, unsigned* CJg, float* CMAXg, int lane) {
    int e[NT][2]; float d[NT][2], g[NT][2];
#pragma unroll
    for (int i = 0; i < NT; ++i) { const int tok = tok0 + i * tstride, tc = tok < T ? tok : T - 1;
#pragma unroll
        for (int hh = 0; hh < 2; ++hh) { const int j = lane + 64 * hh; e[i][hh] = EIDXg[(size_t)tc * 128 + j]; g[i][hh] = GATEg[(size_t)tc * 128 + j]; float a = 0.f;
#pragma unroll
            for (int x = 0; x < 6; ++x) a += bf2f((short)PDOT[((size_t)x * T + tc) * 128 + j]);
            d[i][hh] = a * XSg[tc]; } }
    float us[NT][2], vs[NT][2];
#pragma unroll
    for (int i = 0; i < NT; ++i)
#pragma unroll
        for (int hh = 0; hh < 2; ++hh) { us[i][hh] = usc[e[i][hh]]; vs[i][hh] = vsc[e[i][hh]]; }
#pragma unroll
    for (int i = 0; i < NT; ++i) { const int tok = tok0 + i * tstride;
        float cv[2], cm = 0.f;
#pragma unroll
        for (int hh = 0; hh < 2; ++hh) {
            const float hraw = d[i][hh] * us[i][hh];
            const float hid = 0.5f * hraw * (1.f + erf_as(hraw * 0.70710678118654752f));
            cv[hh] = hid * g[i][hh] * vs[i][hh];
            cm = fmaxf(cm, fabsf(cv[hh]));
        }
        cm = wave_max(cm);
        const float inv = cm > 0.f ? 1.f / cm : 0.f;
        if (tok < T) { CJg[(size_t)tok * 128 + lane] = pk_f16_dup(cv[0] * inv); CJg[(size_t)tok * 128 + 64 + lane] = pk_f16_dup(cv[1] * inv); if (lane == 0) CMAXg[tok] = cm; }
    }
}
DI void peer_v_slice(int sl, int tk_first, int tk_step, const bf16_t* H1b, const int* EIDXg, const unsigned* CJg, const float* CMAXg, const unsigned char* V8s, bf16_t* A4g, float* SSQg, int lane) {
    const int es = lane >> 3, c = lane & 7;
    constexpr int t_hi = T;
    const unsigned char* tb = V8s + (size_t)sl * 16384 * 128;
    const unsigned c16 = 16u * c, eoff = 64u * es, ob = 128u * sl + 16u * c + 2u * es;
    const bool b5 = lane & 32, b4 = lane & 16, b3 = lane & 8;
    u32x4 I0[2], I1[2], I2[2], rowsA[8], rowsB[8], rowsC[8], cA[2], cB[2], cC[2]; unsigned h0, h1, h2;
#define LD_C8(cc, tk, h) do { const int _t = (tk) < T ? (tk) : T - 1; const unsigned* _cb = CJg + (size_t)_t * 128 + 8 * (h); cc[0] = ldu<u32x4>(_cb, eoff); cc[1] = ldu<u32x4>(_cb, eoff + 16u); } while (0)
#define V_AXPY8(rows, cc, FIRST) do { _Pragma("unroll") for (int _q = 0; _q < 2; ++_q) _Pragma("unroll") for (int _r = 0; _r < 4; ++_r) { const unsigned _cu = cc[_q][_r]; const h2_t _c2 = __builtin_bit_cast(h2_t, _cu); \
            _Pragma("unroll") for (int _w = 0; _w < 4; ++_w) { \
                if ((FIRST) && _q == 0 && _r == 0) { acch[2 * _w] = __builtin_amdgcn_cvt_scalef32_pk_f16_fp8(rows[0][_w], 1.0f, false) * _c2; acch[2 * _w + 1] = __builtin_amdgcn_cvt_scalef32_pk_f16_fp8(rows[0][_w], 1.0f, true) * _c2; } \
                else { acch[2 * _w] = __builtin_amdgcn_cvt_scalef32_pk_f16_fp8(rows[4 * _q + _r][_w], 1.0f, false) * _c2 + acch[2 * _w]; \
                       acch[2 * _w + 1] = __builtin_amdgcn_cvt_scalef32_pk_f16_fp8(rows[4 * _q + _r][_w], 1.0f, true) * _c2 + acch[2 * _w + 1]; } } \
              \
            if (4 * _q + _r < 7) asm volatile("" : "+v"(acch[0]), "+v"(acch[1]), "+v"(acch[2]), "+v"(acch[3]), "+v"(acch[4]), "+v"(acch[5]), "+v"(acch[6]), "+v"(acch[7]), "+v"(rows[(4 * _q + _r + 1) & 7])); \
            else asm volatile("" : "+v"(acch[0]), "+v"(acch[1]), "+v"(acch[2]), "+v"(acch[3]), "+v"(acch[4]), "+v"(acch[5]), "+v"(acch[6]), "+v"(acch[7])); } } while (0)
#define LD_H(hh, tk) do { const int _t = (tk) < T ? (tk) : T - 1; hh = ldu<unsigned>(H1b + (size_t)_t * 1024, ob * 2u); } while (0)
#define V_FINAL(hh, tk) do { \
        const float _cm = CMAXg[(tk) < T ? (tk) : T - 1]; \
          \
        h2_t _q8[4], _q4[2]; \
        _Pragma("unroll") for (int _k = 0; _k < 4; ++_k) _q8[_k] = trp_x32(acch[_k], acch[_k + 4]); \
        _Pragma("unroll") for (int _k = 0; _k < 2; ++_k) _q4[_k] = trp_x16(_q8[_k], _q8[_k + 2]); \
        const h2_t _q2p = trp_x8(_q4[0], _q4[1], b3); \
        const float _q2[2] = {(float)_q2p.x, (float)_q2p.y}; \
        const float _ha = __builtin_bit_cast(float, hh << 16) + _q2[0] * _cm, _hb = __builtin_bit_cast(float, hh & 0xffff0000u) + _q2[1] * _cm; const float _ssq = wave_sum(_ha * _ha + _hb * _hb); \
        if ((tk) < T) { *(unsigned*)((char*)(A4g + (size_t)(tk) * 1024) + ob * 2u) = cvtpk(_ha, _hb); \
            if (lane == 0) SSQg[(size_t)sl * T + (tk)] = _ssq; } } while (0)
    h2_t acch[8];
    int t0 = tk_first;
    LD_E8(I0, t0, 0); LD_E8(I1, t0, 1); LD_E8(I2, t0 + tk_step, 0); LD_H(h0, t0); LD_R8(rowsA, I0, tb); LD_C8(cA, t0, 0); LD_R8(rowsB, I1, tb); LD_C8(cB, t0, 1);
#pragma unroll 1
    for (; t0 < T; t0 += 3 * tk_step) {
        const int t1 = t0 + tk_step, t2 = t1 + tk_step, t3 = t2 + tk_step;
        LD_E8(I0, t1, 1);           LD_R8(rowsC, I2, tb); LD_C8(cC, t1, 0); LD_H(h1, t1); V_AXPY8(rowsA, cA, true);
        LD_E8(I1, t2, 0);           LD_R8(rowsA, I0, tb); LD_C8(cA, t1, 1);                          V_AXPY8(rowsB, cB, false); V_FINAL(h0, t0);
        LD_E8(I2, t2, 1);           LD_R8(rowsB, I1, tb); LD_C8(cB, t2, 0); LD_H(h2, t2); V_AXPY8(rowsC, cC, true);
        LD_E8(I0, t3, 0);           LD_R8(rowsC, I2, tb); LD_C8(cC, t2, 1);                          V_AXPY8(rowsA, cA, false); V_FINAL(h1, t1);
        LD_E8(I1, t3, 1);           LD_R8(rowsA, I0, tb); LD_C8(cA, t3, 0); LD_H(h0, t3); V_AXPY8(rowsB, cB, true);
        LD_E8(I2, t3 + tk_step, 0); LD_R8(rowsB, I1, tb); LD_C8(cB, t3, 1);                          V_AXPY8(rowsC, cC, false); V_FINAL(h2, t2);
    }
#undef V_FINAL
#undef LD_H
#undef V_AXPY8
#undef LD_C8
#undef LD_R8
#undef LD_E8
}

typedef const __attribute__((address_space(4))) unsigned long long* karg_ptr_t;
DI karg_ptr_t kargs() { karg_ptr_t p = (karg_ptr_t)__builtin_amdgcn_kernarg_segment_ptr(); asm volatile("" : "+s"(p)); return p; }
#define GAS1 __attribute__((address_space(1)))
#define KIN(k) ((const float*)(const GAS1 float*)kargs()[k])
#define KOUT() ((float*)(GAS1 float*)kargs()[18])
#define KWS() ((unsigned char*)(GAS1 unsigned char*)kargs()[19])

__global__ void __launch_bounds__(512, 2) fwd_kernel(Params P) {
    extern __shared__ __attribute__((aligned(16))) unsigned char lds_raw[];
    LAS unsigned char* lds = (LAS unsigned char*)lds_raw;
    const int tid = threadIdx.x, lane = tid & 63, wid = __builtin_amdgcn_readfirstlane(tid >> 6);
    const int wg = blockIdx.x, nwg = gridDim.x;
    const int gwave = wg * 8 + wid, nwaves = nwg * 8;
    const int lo = P.ph_lo, hi = P.ph_hi;

    volatile LAS unsigned* misc = (volatile LAS unsigned*)(lds + LDS_BYTES - 64);
    if (tid < 16) misc[tid] = 0u;
    __syncthreads();
    { unsigned* xcw = (unsigned*)(KWS() + WS_CTL) + CW_XC;
      if (tid == 0) { const unsigned xcc = xb_xcc_id(); misc[5] = xcc; misc[4] = xb_add(xcw + 64 * xcc, 1u); } }
    XcdBarrier bar; bar.bar = (unsigned*)(KWS() + WS_CTL) + CW_BAR; bar.x = 0; bar.st = misc;
    if (hi - lo > 1) bar = xcd_barrier_post((unsigned*)(KWS() + WS_CTL) + CW_BAR, misc);

#define kmean   ((float*)(KWS() + WS_KMEAN))
#define biasTab ((float*)(KWS() + WS_BIAS))
#define WinT    ((bf16_t*)(KWS() + WS_WIN))
#define WoutT   ((bf16_t*)(KWS() + WS_WOUT))
#define WqT     ((bf16_t*)(KWS() + WS_WQ))
#define WgT     ((bf16_t*)(KWS() + WS_WG))
#define WpleT   ((bf16_t*)(KWS() + WS_WPLE))
#define U8      ((unsigned char*)(KWS() + WS_U))
#define V8      ((unsigned char*)(KWS() + WS_V))
#define USC     ((float*)(KWS() + WS_USC))
#define VSC     ((float*)(KWS() + WS_VSC))
#define XN      ((bf16_t*)(KWS() + WS_XN))
#define PB      ((bf16_t*)(KWS() + WS_PB))
#define Qm      ((bf16_t*)(KWS() + WS_QM))
#define Km      ((bf16_t*)(KWS() + WS_KM))
#define VtM     ((bf16_t*)(KWS() + WS_VTM))
#define Qs      ((bf16_t*)(KWS() + WS_QS))
#define Ks      ((bf16_t*)(KWS() + WS_KS))
#define VtS     ((bf16_t*)(KWS() + WS_VTS))
#define Oraw    ((bf16_t*)(KWS() + WS_ORAW))
#define A2      ((bf16_t*)(KWS() + WS_A2))
#define A3      ((bf16_t*)(KWS() + WS_A3))
#define SC      ((float*)(KWS() + WS_SC))
#define EIDXG   ((int*)(KWS() + WS_EIDX))
#define GATEG   ((float*)(KWS() + WS_GATE))
#define CJG     ((float*)(KWS() + WS_CJ))
#define RS2G    ((float*)(KWS() + WS_RS2))
#define SSQG    ((float*)(KWS() + WS_SSQ))
#define PDOTG   ((bf16_t*)(KWS() + WS_PDOT))
#define A4G     ((bf16_t*)(KWS() + WS_A4))
#define XN2G    ((unsigned char*)(KWS() + WS_XN2))
#define XSG     ((float*)(KWS() + WS_XS))

#define IN(k) (lo <= (k) && (k) < hi)
#ifndef PROBE_PHASE
#define PROBE_PHASE -1
#endif
#ifndef PROBE_REPS
#define PROBE_REPS 1
#endif
#define REP(k) for (int _rep = 0; _rep < ((k) == PROBE_PHASE ? PROBE_REPS : 1); ++_rep)
#define SEAM(k) do { if (IN(k) && IN((k) + 1)) { if ((k) == 0 || PROBE_LO_NONZERO) xcd_barrier<true>(bar); else xcd_barrier<false>(bar); } } while (0)
#define PROBE_LO_NONZERO 0

    if (IN(0)) REP(0) {
        {
            LAS float* scr = (LAS float*)lds + wid * (64 * 65);
            const float* win = KIN(IN_WIN); const float* wout = KIN(IN_WOUT); const float* wpg = KIN(IN_WPG); const float* wple = KIN(IN_WPLE); const float* pln = KIN(IN_PLE_NORM);
            bf16_t* wint = WinT; bf16_t* woutt = WoutT; bf16_t* wgt = WgT; bf16_t* wplet = WpleT;
            for (int t = gwave; t < 1344; t += nwaves) {
                const int sel = t < 768 ? 0 : t < 1024 ? 1 : t < 1280 ? 2 : 3;
                const int tt = sel == 0 ? t : sel == 1 ? t - 768 : sel == 2 ? t - 1024 : t - 1280;
                const float* W = sel == 0 ? win : sel == 1 ? wout : sel == 2 ? wpg : wple;
                bf16_t* Wt = sel == 0 ? wint : sel == 1 ? woutt : sel == 2 ? wgt : wplet;
                const int K = sel == 3 ? 256 : 1024, N = sel == 0 ? 3072 : 1024, tn = sel == 0 ? 48 : 16;
                p0_transpose_wave(W, K, N, Wt, scr, lane, (tt / tn) * 64, (tt % tn) * 64, sel == 0, sel == 2 ? pln : nullptr);
            }
        }
        p0_fold(KIN(IN_PQ), KIN(IN_SUBK), KIN(IN_FFN_NORM), WqT, wid, lane, wg, nwg);
        const size_t gtid = (size_t)wg * 512 + tid, nthr = (size_t)nwg * 512;
        p0_convert(KIN(IN_P), PB, (size_t)T * 256, gtid, nthr);
        { const float* xp = KIN(IN_X); const float* gp = KIN(IN_ATTN_NORM); bf16_t* xo = XN;
          for (int row = gwave; row < T; row += 2 * nwaves) rmsnorm_rows2_bf16(xp, gp, xo, row, row + nwaves, lane); }
        if (wg == 0) {
            for (int idx = tid; idx < 8 * 129; idx += 512) {
                const int h = idx / 129, dist = idx % 129;
                int bk;
                if (dist < 16) bk = dist;
                else { const float v = logf((float)dist / 16.f) / 2.0794415416798357f * 16.f; bk = 16 + (int)v; bk = bk > 31 ? 31 : bk; }
                biasTab[h * 132 + dist] = KIN(IN_RELB)[bk * 8 + h] * LOG2E;
            }
        }
    }
    SEAM(0);
    if (IN(1)) REP(1) {
        pg8::Gemm g{XN, WinT, T, NPROJ, 1024}; pg8::StaticOrder S; S.init(T, NPROJ, nwg, wg);
        EpiQKV E{Qm, KIN(IN_QNORM), KIN(IN_KNORM), kmean};
        pg8::gemm_phase<EpiQKV, pg8::StaticOrder, true, true>(lds, g, S, E);
    }
    SEAM(1);
    if (IN(3)) REP(3) {
        const bf16_t* qm_ = Qm; const bf16_t* km_ = Km; const bf16_t* vtm_ = VtM; const bf16_t* qs_ = Qs; const bf16_t* ks_ = Ks; const bf16_t* vts_ = VtS;
        const float* kmn_ = kmean; const float* bt_ = biasTab; bf16_t* a2_ = A2;
        const float* gm_ = KIN(IN_ONM); const float* gs_ = KIN(IN_ONS);
        LAS unsigned char* ot = lds;
        LAS float* biasLds = (LAS float*)(lds + 34816);
        for (int i = tid; i < 8 * 132; i += 512) biasLds[i] = bt_[i];
        __syncthreads();
        for (int u = gwave; u < 8192; u += nwaves) {
            const int grp = u >> 12, i = u & 4095;
            const int half = i >> 11, j = i & 2047;
            const int qt = half ? (j >> 6) : 63 - (j >> 6), bh = j & 63;
            const int b = bh >> 3, h = bh & 7;
            if (grp == 0) moba_unit(b, h, qt, qm_, km_, vtm_, kmn_, biasLds, ot, lane);
            else sb_unit(b, h, qt, qs_, ks_, vts_, ot, lane);
            __syncthreads();
            {
                const float* gg = grp ? gs_ : gm_;
                const f32x4 g0 = *(const f32x4*)(gg + 8 * lane), g1 = *(const f32x4*)(gg + 8 * lane + 4);
#pragma unroll
                for (int rr = 0; rr < 4; ++rr) {
                    const int row = 4 * wid + rr;
                    const bf16x8 v = *(const LAS bf16x8*)(ot + row * OT_PITCH + lane * 16);
                    float f[8], sq = 0.f;
#pragma unroll
                    for (int e = 0; e < 8; ++e) { f[e] = bf2f(v[e]); sq += f[e] * f[e]; }
                    sq = wave_sum(sq);
                    const float rs = rsqrtf(sq * (1.f / 512.f) + EPS);
                    u32x4 w; w.x = cvtpk(f[0] * rs * g0.x, f[1] * rs * g0.y); w.y = cvtpk(f[2] * rs * g0.z, f[3] * rs * g0.w);
                    w.z = cvtpk(f[4] * rs * g1.x, f[5] * rs * g1.y); w.w = cvtpk(f[6] * rs * g1.z, f[7] * rs * g1.w);
                    *(u32x4*)(a2_ + (size_t)(b * 2048 + qt * 32 + row) * 1024 + grp * 512 + 8 * lane) = w;
                }
            }
            __syncthreads();
        }
    }
    SEAM(3);
    if (IN(5)) REP(5) {
        pg8::Gemm g{A2, WoutT, T, 1024, 1024}; pg8::StaticOrder S; S.init(T, 1024, nwg, wg);
        EpiRes E{KIN(IN_X), A3};
        pg8::gemm_phase<EpiRes, pg8::StaticOrder, true, true>(lds, g, S, E);
    }
    SEAM(5);
    if (IN(6)) REP(6) {
        pg8::Gemm g{A3, WqT, T, 2048, 1024}; pg8::StaticOrder S; S.init(T, 2048, nwg, wg);
        EpiBf E{(bf16_t*)SC, 2048};
        pg8::gemm_phase<EpiBf, pg8::StaticOrder, true, true>(lds, g, S, E);
    }
    SEAM(6);
    if (IN(7)) REP(7) {
        LAS float* wl = (LAS float*)(lds + wid * 4096);
        {
            const int c = lane; int ca, cb;
            if (c < 16) { ca = 0; cb = c; } else if (c < 24) { ca = 1; cb = c - 16; } else if (c < 29) { ca = 2; cb = c - 24; } else if (c < 33) { ca = 3; cb = c - 29; }
            else if (c < 36) { ca = 4; cb = c - 33; } else if (c < 42) { ca = 5 + ((c - 36) >> 1); cb = (c - 36) & 1; } else { ca = (c - 34) & 15; cb = 0; }
            ((LAS unsigned*)(wl + 768))[lane] = (unsigned)ca | ((unsigned)cb << 8);
            asm volatile("s_waitcnt lgkmcnt(0)" ::: "memory");
        }
        const bf16_t* h1p = A3; const bf16_t* scp = (const bf16_t*)SC; const float* gfp = KIN(IN_FFN_NORM); int* eip = EIDXG; float* gtp = GATEG; unsigned char* xnp = XN2G;
        TopkIn inA, inB;
        peer_topk_load(inA, gwave, h1p, scp, lane);
        const float* pu = KIN(IN_PU); const float* pv = KIN(IN_PV); unsigned char* u8 = U8; unsigned char* v8 = V8; float* usc_ = USC; float* vsc_ = VSC;
        static_assert(T == 16384, "one expert row per token step");
#pragma unroll 1
        for (int tok = gwave; tok < T; tok += nwaves) {
            f32x4 qa[2][4];
            peer_topk_load(inB, tok + nwaves, h1p, scp, lane);
            p0_quant_issue2(qa, pu, pv, tok, lane); MEM_FENCE();
            peer_topk_token(tok, inA, gfp, eip, gtp, xnp, XSG, wl, lane);
            quant_u6_finish(qa[0], u8, usc_, tok, lane); p0_quant_finish(qa[1], v8, vsc_, tok, lane);
            inA = inB;
        }
    }
    SEAM(7);
    int sl_first = 0, sl_step = 1, tk_first = 0, tk_step = 8;
    if (IN(8) || IN(10)) {
        __syncthreads();
        const unsigned myx = misc[5], myrank = misc[4];
        unsigned nx = 0, myidx = 0, nloc = 1;
        unsigned* xc = (unsigned*)(KWS() + WS_CTL) + CW_XC;
#pragma unroll
        for (unsigned j = 0; j < 16; ++j) { const unsigned cj = xb_ld(xc + 64 * j); if (cj > 0u) { if (j < myx) ++myidx; ++nx; } if (j == myx) nloc = cj; }
        sl_first = __builtin_amdgcn_readfirstlane((int)myidx); sl_step = __builtin_amdgcn_readfirstlane((int)(nx > 0u ? nx : 1u));
        tk_first = __builtin_amdgcn_readfirstlane((int)myrank * 8 + wid); tk_step = __builtin_amdgcn_readfirstlane((int)(nloc > 0u ? nloc : 1u) * 8);
    }
    if (IN(8)) REP(8) {
        const unsigned char* xnp = XN2G; const int* eip = EIDXG; const unsigned char* u8p = U8; bf16_t* pdp = PDOTG;
        for (int item = sl_first; item < 24; item += sl_step) {
            const int sl = item >> 2, qt4 = item & 3;
            if (sl < 4) peer_u_slice<false>(sl, qt4 * (T / 4), (qt4 + 1) * (T / 4), tk_first, tk_step, xnp, eip, u8p, pdp, lane);
            else        peer_u_slice<true>(sl, qt4 * (T / 4), (qt4 + 1) * (T / 4), tk_first, tk_step, xnp, eip, u8p, pdp, lane);
        }
    }
    SEAM(8);
    if (IN(9)) REP(9) {
        const int* eip = EIDXG; const float* gtp = GATEG; const bf16_t* pdp = PDOTG; const float* usp = USC; const float* vsp = VSC; unsigned* cjp = (unsigned*)CJG; float* cmp_ = RS2G;
        for (int tok = gwave; tok < T; tok += 8 * nwaves) peer_cj_tokens<8>(tok, nwaves, eip, gtp, pdp, usp, vsp, XSG, cjp, cmp_, lane);
    }
    SEAM(9);
    if (IN(10)) REP(10) {
        const bf16_t* outp = A3; const int* eip = EIDXG; const unsigned* cjp = (const unsigned*)CJG; const float* cmp_ = RS2G; const unsigned char* v8p = V8; bf16_t* a4p = A4G; float* sqp = SSQG;
        for (int sl = sl_first; sl < 8; sl += sl_step) peer_v_slice(sl, tk_first, tk_step, outp, eip, cjp, cmp_, v8p, a4p, sqp, lane);
    }
    SEAM(10);
    if (IN(11)) REP(11) {
        bf16_t* PW = Oraw;
        { int kple = 256; asm volatile("" : "+s"(kple));
          pg8::Gemm g{PB, WpleT, T, 1024, kple}; pg8::StaticOrder S; S.init(T, 1024, nwg, wg);
          EpiBf E{PW, 1024};
          pg8::gemm_phase<EpiBf, pg8::StaticOrder, true, true>(lds, g, S, E); }
        asm volatile("s_waitcnt vmcnt(0)" ::: "memory");
        __syncthreads();
        { pg8::Gemm g{A4G, WgT, T, 1024, 1024}; pg8::StaticOrder S; S.init(T, 1024, nwg, wg);
          EpiGate E{KOUT(), PW, SSQG, A4G};
          pg8::gemm_phase<EpiGate, pg8::StaticOrder, true, true>(lds, g, S, E); }
    }
#undef IN
#undef SEAM
}

extern "C" void kernel_launch(void* const* d_in, const int* in_sizes, int n_in, void* d_out, int out_size, void* d_ws, size_t ws_size, hipStream_t stream) {
    static int grid = 0;
    if (grid == 0) {
        if (n_in != 18 || out_size != T * DM || ws_size < WS_END) { fprintf(stderr, "kernel_launch: unexpected shapes (n_in %d out %d ws %zu)\n", n_in, out_size, ws_size); grid = -1; return; }
        int dev = 0, cus = 0, per_cu = 0;
        if (hipGetDevice(&dev) != hipSuccess || hipDeviceGetAttribute(&cus, hipDeviceAttributeMultiprocessorCount, dev) != hipSuccess) { grid = -1; return; }
        if (hipFuncSetAttribute((const void*)fwd_kernel, hipFuncAttributeMaxDynamicSharedMemorySize, LDS_BYTES) != hipSuccess) { fprintf(stderr, "kernel_launch: hipFuncSetAttribute failed\n"); grid = -1; return; }
        if (hipOccupancyMaxActiveBlocksPerMultiprocessor(&per_cu, (const void*)fwd_kernel, 512, LDS_BYTES) != hipSuccess || per_cu < 1)
            fprintf(stderr, "kernel_launch: note: occupancy query reports %d\n", per_cu);
        (void)hipGetLastError();
        grid = cus - (cus % 8);
    }
    if (grid < 0) return;
    if (hipMemsetAsync((char*)d_ws + WS_CTL, 0, CTL_ZERO_BYTES, stream) != hipSuccess) return;
    Params p{};
    for (int i = 0; i < 18; ++i) p.in[i] = (const float*)d_in[i];
    p.out = (float*)d_out; p.ws = (unsigned char*)d_ws;
    p.ph_lo = 0; p.ph_hi = NPHASE;
    hipLaunchKernelGGL(fwd_kernel, dim3(grid), dim3(512), LDS_BYTES, stream, p);
}
```

```cpp
#include <hip/hip_runtime.h>
#include <stdint.h>
#include <stdio.h>

#ifndef N_LAUNCHES
#define N_LAUNCHES 1
#endif

#define DI __device__ __forceinline__
#define LAS __attribute__((address_space(3)))

typedef unsigned short bf16_t;
typedef short bf16x8 __attribute__((ext_vector_type(8)));
typedef float f32x16 __attribute__((ext_vector_type(16)));
typedef float f32x4 __attribute__((ext_vector_type(4)));
typedef float f32x2 __attribute__((ext_vector_type(2)));
typedef unsigned u32x4 __attribute__((ext_vector_type(4)));
typedef unsigned u32x2 __attribute__((ext_vector_type(2)));
typedef __bf16 bf16x2_t __attribute__((ext_vector_type(2)));

constexpr int BATCH = 8, SEQ = 2048, DM = 1024, T = BATCH * SEQ;
constexpr int NPROJ = 3072;
constexpr float EPS = 1e-6f;
constexpr float LOG2E = 1.4426950408889634f;
constexpr float SCL2 = 0.125f * LOG2E;
constexpr int NPHASE = 12;

constexpr size_t MiB = 1u << 20;
constexpr size_t WS_CTL = 0, CTL_ZERO_BYTES = 256 * 1024 + 128 * 1024;
constexpr size_t WS_KMEAN = 256 * 1024;
constexpr size_t WS_BIAS = 512 * 1024;
constexpr size_t WS_WIN = 1 * MiB, WS_WOUT = 7 * MiB, WS_WQ = 9 * MiB, WS_WG = 13 * MiB, WS_WPLE = 15 * MiB;
constexpr size_t WS_U = 16 * MiB, WS_V = 32 * MiB;
constexpr size_t WS_USC = 640 * 1024, WS_VSC = 704 * 1024;
constexpr size_t WS_XN2 = 48 * MiB;
constexpr size_t WS_XS = 104 * MiB + 512 * 1024;
constexpr size_t WS_XN = 216 * MiB;
constexpr size_t WS_RSX = 64 * MiB;
constexpr size_t WS_PB = 112 * MiB;
constexpr size_t WS_QM = 120 * MiB, WS_KM = 136 * MiB, WS_VTM = 152 * MiB, WS_QS = 168 * MiB, WS_KS = 184 * MiB, WS_VTS = 200 * MiB;
constexpr size_t WS_ORAW = 216 * MiB;
constexpr size_t WS_A2 = 80 * MiB;
constexpr size_t WS_A3 = 120 * MiB;
constexpr size_t WS_SC = 152 * MiB;
constexpr size_t WS_EIDX = 80 * MiB, WS_GATE = 88 * MiB, WS_CJ = 96 * MiB, WS_RS2 = 104 * MiB, WS_SSQ = 105 * MiB;
constexpr size_t WS_PDOT = 152 * MiB;
constexpr size_t WS_A4 = 184 * MiB;
constexpr size_t WS_END = 248 * MiB;

constexpr int CW_XC = 8192;
constexpr int CW_BAR = 4096;

constexpr int LDS_BYTES = 147456;

#define XB_TMO      128
#define XB_XCNT(j)  (256  + 64 * (j))
#define XB_XSUB(j)  (1280 + 64 * (j))
#define XB_XGEN(j)  (2304 + 64 * (j))
#define XB_TOP      3328
#define XB_TOPGEN   3392
#define XCD_BAR_WORDS 3456
#define XB_SPIN_CAP (1u << 18)

__device__ __forceinline__ unsigned xb_ld(unsigned* p)              { return __hip_atomic_load(p, __ATOMIC_RELAXED, __HIP_MEMORY_SCOPE_AGENT); }
__device__ __forceinline__ unsigned xb_add(unsigned* p, unsigned v) { return __hip_atomic_fetch_add(p, v, __ATOMIC_RELAXED, __HIP_MEMORY_SCOPE_AGENT); }
__device__ __forceinline__ unsigned xb_xcc_id() { return (unsigned)__builtin_amdgcn_s_getreg((3 << 11) | 20) & 0xFu; }
#define XB_SPIN(cond, bar) do { unsigned _sp = 0; while (cond) { __builtin_amdgcn_s_sleep(1); \
    if ((++_sp & 255u) == 0u) { if (xb_ld(&(bar)[XB_TMO])) break; if (_sp > XB_SPIN_CAP) { atomicAdd(&(bar)[XB_TMO], 1u); break; } } } } while (0)

struct XcdBarrier { unsigned* bar; unsigned x; volatile LAS unsigned* st; };

__device__ __forceinline__ XcdBarrier xcd_barrier_post(unsigned* bar, volatile LAS unsigned* st) {
    XcdBarrier b; b.bar = bar; b.x = xb_xcc_id(); b.st = st;
    if (threadIdx.x == 0) (void)xb_add(&bar[XB_XCNT(b.x)], 1u);
    return b;
}
__device__ __forceinline__ void xcd_barrier_complete(unsigned* bar, unsigned x, unsigned& nloc, unsigned& nx) {
    const unsigned G = gridDim.x * gridDim.y * gridDim.z;
    unsigned sum, cnt, mine, sp = 0u;
    for (;;) {
        sum = 0u; cnt = 0u; mine = 0u;
#pragma unroll
        for (unsigned j = 0; j < 16; ++j) { const unsigned c = xb_ld(&bar[XB_XCNT(j)]); sum += c; cnt += (c > 0u) ? 1u : 0u; mine = (j == x) ? c : mine; }
        if (sum == G) break;
        __builtin_amdgcn_s_sleep(1);
        if ((++sp & 255u) == 0u) { if (xb_ld(&bar[XB_TMO])) break; if (sp > XB_SPIN_CAP) { atomicAdd(&bar[XB_TMO], 1u); break; } }
    }
    nloc = mine > 0u ? mine : 1u; nx = cnt > 0u ? cnt : 1u;
}
template <bool CENSUS> __device__ __forceinline__ void xcd_barrier(const XcdBarrier& b) {
    asm volatile("s_waitcnt vmcnt(0)" ::: "memory");
    __syncthreads();
    if (threadIdx.x == 0) {
        unsigned* bar = b.bar;
        __builtin_amdgcn_s_waitcnt(0);
        unsigned nloc = b.st[0], nx = b.st[1];
        if (CENSUS) { if (nloc == 0u) { xcd_barrier_complete(bar, b.x, nloc, nx); b.st[0] = nloc; b.st[1] = nx; } }
        const unsigned old = xb_add(&bar[XB_XSUB(b.x)], 1u);
        const unsigned gen = old / nloc;
        if (old + 1u == (gen + 1u) * nloc) {
            __builtin_amdgcn_fence(__ATOMIC_RELEASE, "agent");
            asm volatile("s_waitcnt vmcnt(0)" ::: "memory");
            const unsigned og = xb_add(&bar[XB_TOP], 1u);
            const unsigned tg = og / nx;
            if (og + 1u == (tg + 1u) * nx) xb_add(&bar[XB_TOPGEN], 1u);
            else XB_SPIN(xb_ld(&bar[XB_TOPGEN]) == tg, bar);
            __builtin_amdgcn_fence(__ATOMIC_ACQUIRE, "agent");
            xb_add(&bar[XB_XGEN(b.x)], 1u);
            asm volatile("s_waitcnt vmcnt(0)" ::: "memory");
        } else {
            XB_SPIN(xb_ld(&bar[XB_XGEN(b.x)]) == gen, bar);
            __builtin_amdgcn_fence(__ATOMIC_ACQUIRE, "agent");
            asm volatile("s_waitcnt vmcnt(0)" ::: "memory");
        }
    }
    __syncthreads();
}

DI float bf2f(short v) { return __builtin_bit_cast(float, ((unsigned)(unsigned short)v) << 16); }
DI unsigned cvtpk(float lo, float hi) { f32x2 v = {lo, hi}; bf16x2_t b = __builtin_convertvector(v, bf16x2_t); return __builtin_bit_cast(unsigned, b); }
DI bf16_t f2bf(float f) { return (bf16_t)(cvtpk(f, 0.f) & 0xffffu); }
template <int CTRL> DI float dppf(float v) { return __builtin_bit_cast(float, __builtin_amdgcn_update_dpp(0, __builtin_bit_cast(int, v), CTRL, 0xF, 0xF, true)); }
#define DPP_XOR1 0xB1
#define DPP_XOR2 0x4E
#define DPP_HMIR 0x141
#define DPP_MIR  0x140
DI void swap16(float v, float& a, float& b) { const auto r = __builtin_amdgcn_permlane16_swap(__builtin_bit_cast(unsigned, v), __builtin_bit_cast(unsigned, v), false, false); const unsigned r0 = r[0], r1 = r[1]; a = __builtin_bit_cast(float, r0); b = __builtin_bit_cast(float, r1); }
DI void swap32(float v, float& a, float& b) { const auto r = __builtin_amdgcn_permlane32_swap(__builtin_bit_cast(unsigned, v), __builtin_bit_cast(unsigned, v), false, false); const unsigned r0 = r[0], r1 = r[1]; a = __builtin_bit_cast(float, r0); b = __builtin_bit_cast(float, r1); }
DI float sum_x16(float v) { float a, b; swap16(v, a, b); return a + b; }
DI float sum_x32(float v) { float a, b; swap32(v, a, b); return a + b; }
DI float max_x32(float v) { float a, b; swap32(v, a, b); return fmaxf(a, b); }
DI float sum_row16(float v) { v += dppf<DPP_XOR1>(v); v += dppf<DPP_XOR2>(v); v += dppf<DPP_HMIR>(v); v += dppf<DPP_MIR>(v); return v; }
DI float max_row16(float v) { v = fmaxf(v, dppf<DPP_XOR1>(v)); v = fmaxf(v, dppf<DPP_XOR2>(v)); v = fmaxf(v, dppf<DPP_HMIR>(v)); v = fmaxf(v, dppf<DPP_MIR>(v)); return v; }
DI float sum_oct(float v) { v += dppf<DPP_XOR1>(v); v += dppf<DPP_XOR2>(v); v += dppf<DPP_HMIR>(v); return v; }
DI float max_oct(float v) { v = fmaxf(v, dppf<DPP_XOR1>(v)); v = fmaxf(v, dppf<DPP_XOR2>(v)); v = fmaxf(v, dppf<DPP_HMIR>(v)); return v; }
DI float wave_sum(float v) { return sum_x32(sum_x16(sum_row16(v))); }
DI float wave_max(float v) { v = max_row16(v); float a, b; swap16(v, a, b); return max_x32(fmaxf(a, b)); }
DI float tr_x32(float lo, float hi) { const auto r = __builtin_amdgcn_permlane32_swap(__builtin_bit_cast(unsigned, lo), __builtin_bit_cast(unsigned, hi), false, false); const unsigned r0 = r[0], r1 = r[1]; return __builtin_bit_cast(float, r0) + __builtin_bit_cast(float, r1); }
DI float tr_x16(float lo, float hi) { const auto r = __builtin_amdgcn_permlane16_swap(__builtin_bit_cast(unsigned, lo), __builtin_bit_cast(unsigned, hi), false, false); const unsigned r0 = r[0], r1 = r[1]; return __builtin_bit_cast(float, r0) + __builtin_bit_cast(float, r1); }
DI float tr_x8(float lo, float hi, bool bit) { const float mine = bit ? hi : lo, send = bit ? lo : hi; return mine + dppf<0x128>(send); }
DI float tr_x4(float lo, float hi, bool bit) {
    const int a = __builtin_amdgcn_update_dpp(0, __builtin_bit_cast(int, hi), 0x114, 0xF, 0xA, false);
    const int b = __builtin_amdgcn_update_dpp(a, __builtin_bit_cast(int, lo), 0x104, 0xF, 0x5, false);
    return (bit ? hi : lo) + __builtin_bit_cast(float, b);
}
typedef _Float16 h2_t __attribute__((ext_vector_type(2)));
DI h2_t trp_x32(h2_t lo, h2_t hi) { const auto r = __builtin_amdgcn_permlane32_swap(__builtin_bit_cast(unsigned, lo), __builtin_bit_cast(unsigned, hi), false, false); const unsigned r0 = r[0], r1 = r[1]; return __builtin_bit_cast(h2_t, r0) + __builtin_bit_cast(h2_t, r1); }
DI h2_t trp_x16(h2_t lo, h2_t hi) { const auto r = __builtin_amdgcn_permlane16_swap(__builtin_bit_cast(unsigned, lo), __builtin_bit_cast(unsigned, hi), false, false); const unsigned r0 = r[0], r1 = r[1]; return __builtin_bit_cast(h2_t, r0) + __builtin_bit_cast(h2_t, r1); }
DI h2_t trp_x8(h2_t lo, h2_t hi, bool bit) { const unsigned l = __builtin_bit_cast(unsigned, lo), h = __builtin_bit_cast(unsigned, hi); const unsigned mine = bit ? h : l, send = bit ? l : h;
    const unsigned got = (unsigned)__builtin_amdgcn_update_dpp(0, (int)send, 0x128, 0xF, 0xF, true); return __builtin_bit_cast(h2_t, mine) + __builtin_bit_cast(h2_t, got); }
DI float tr_x2(float lo, float hi, bool bit) { const float mine = bit ? hi : lo, send = bit ? lo : hi; return mine + dppf<DPP_XOR2>(send); }
DI float tr_x1(float lo, float hi, bool bit) { const float mine = bit ? hi : lo, send = bit ? lo : hi; return mine + dppf<DPP_XOR1>(send); }
DI int crow(int r, int hi) { return (r & 3) + 8 * (r >> 2) + 4 * hi; }
#define MFMA32(a, b, c) __builtin_amdgcn_mfma_f32_32x32x16_bf16((a), (b), (c), 0, 0, 0)
DI f32x16 zero16() { f32x16 z; for (int i = 0; i < 16; ++i) z[i] = 0.f; return z; }

struct Params {
    const float* in[18];
    float* out;
    unsigned char* ws;
    int ph_lo, ph_hi;
};

enum { IN_X = 0, IN_P, IN_RELB, IN_ATTN_NORM, IN_WIN, IN_QNORM, IN_KNORM, IN_ONM, IN_ONS, IN_WOUT, IN_FFN_NORM, IN_PQ, IN_SUBK, IN_PU, IN_PV, IN_PLE_NORM, IN_WPG, IN_WPLE };

DI void p0_transpose_wave(const float* W, int K, int N, bf16_t* Wt, LAS float* scr  , int lane, int k0, int n0, bool headperm, const float* kgain) {
    f32x4 v[16];
    const int lr = lane >> 4, lc = 4 * (lane & 15);
#pragma unroll
    for (int i = 0; i < 16; ++i) v[i] = *(const f32x4*)(W + (size_t)(k0 + 4 * i + lr) * N + n0 + lc);
#pragma unroll
    for (int i = 0; i < 16; ++i) { LAS float* d = scr + (4 * i + lr) * 65 + lc; d[0] = v[i].x; d[1] = v[i].y; d[2] = v[i].z; d[3] = v[i].w; }
    __builtin_amdgcn_wave_barrier();
    const int j = lane & 7, nl = lane >> 3;
    f32x4 g0 = {1.f, 1.f, 1.f, 1.f}, g1 = g0;
    if (kgain) { g0 = *(const f32x4*)(kgain + k0 + 8 * j); g1 = *(const f32x4*)(kgain + k0 + 8 * j + 4); }
#pragma unroll
    for (int q = 0; q < 8; ++q) {
        const int nn = 8 * q + nl;
        int n = n0 + nn;
        if (headperm) { const int w = n & 255; n = (n & ~255) + 128 * ((w >> 5) & 1) + 32 * (w >> 6) + (w & 31); }
        const LAS float* sp = scr + (8 * j) * 65 + nn;
        u32x4 w;
        w.x = cvtpk(sp[0] * g0.x, sp[65] * g0.y); w.y = cvtpk(sp[130] * g0.z, sp[195] * g0.w);
        w.z = cvtpk(sp[260] * g1.x, sp[325] * g1.y); w.w = cvtpk(sp[390] * g1.z, sp[455] * g1.w);
        *(u32x4*)(Wt + (size_t)n * K + k0 + 8 * j) = w;
    }
    __builtin_amdgcn_wave_barrier();
}

DI void split_bf16x8(const f32x4& p, const f32x4& q, bf16x8& hi, bf16x8& lo) {
    u32x4 h, l;
    h.x = cvtpk(p.x, p.y); h.y = cvtpk(p.z, p.w); h.z = cvtpk(q.x, q.y); h.w = cvtpk(q.z, q.w);
    const float r0 = p.x - __builtin_bit_cast(float, h.x << 16), r1 = p.y - __builtin_bit_cast(float, h.x & 0xffff0000u), r2 = p.z - __builtin_bit_cast(float, h.y << 16), r3 = p.w - __builtin_bit_cast(float, h.y & 0xffff0000u);
    const float r4 = q.x - __builtin_bit_cast(float, h.z << 16), r5 = q.y - __builtin_bit_cast(float, h.z & 0xffff0000u), r6 = q.z - __builtin_bit_cast(float, h.w << 16), r7 = q.w - __builtin_bit_cast(float, h.w & 0xffff0000u);
    l.x = cvtpk(r0, r1); l.y = cvtpk(r2, r3); l.z = cvtpk(r4, r5); l.w = cvtpk(r6, r7);
    hi = __builtin_bit_cast(bf16x8, h); lo = __builtin_bit_cast(bf16x8, l);
}
DI void p0_fold(const float* wq, const float* sub, const float* gffn, bf16_t* WqT, int wid, int lane, int wg, int nwg) {
    const int r = lane & 31, hi = lane >> 5, dq = wid & 1, nq = wid >> 1;
    for (int item = wg; item < 256; item += nwg) {
        const int dt = item & 15, hh = item >> 4, d0 = dt * 64 + 32 * dq, h = hh >> 1, half = hh & 1;
        const float* ap = wq + (size_t)(d0 + r) * 2048 + h * 256 + half * 128 + 8 * hi;
        const float* bp = sub + half * 16384 + (size_t)(32 * nq + r) * 128 + 8 * hi;
        f32x16 acc = zero16();
        f32x4 av[8][2], bv[8][2], gq[4];
#pragma unroll
        for (int st = 0; st < 8; ++st) { av[st][0] = *(const f32x4*)(ap + 16 * st); av[st][1] = *(const f32x4*)(ap + 16 * st + 4); bv[st][0] = *(const f32x4*)(bp + 16 * st); bv[st][1] = *(const f32x4*)(bp + 16 * st + 4); }
#pragma unroll
        for (int g4 = 0; g4 < 4; ++g4) gq[g4] = *(const f32x4*)(gffn + d0 + 8 * g4 + 4 * hi);
#pragma unroll
        for (int st = 0; st < 8; ++st) {
            bf16x8 ah, al, bh, bl;
            split_bf16x8(av[st][0], av[st][1], ah, al); split_bf16x8(bv[st][0], bv[st][1], bh, bl);
            acc = MFMA32(ah, bh, acc); acc = MFMA32(ah, bl, acc); acc = MFMA32(al, bh, acc);
        }
        bf16_t* op = WqT + (size_t)(hh * 128 + 32 * nq + r) * 1024 + d0 + 4 * hi;
#pragma unroll
        for (int g4 = 0; g4 < 4; ++g4) {
            const f32x4 gv = gq[g4];
            u32x2 w; w.x = cvtpk(acc[4 * g4] * gv.x, acc[4 * g4 + 1] * gv.y); w.y = cvtpk(acc[4 * g4 + 2] * gv.z, acc[4 * g4 + 3] * gv.w);
            *(u32x2*)(op + 8 * g4) = w;
        }
    }
}

DI void p0_convert(const float* src, bf16_t* dst, size_t n, size_t gtid, size_t nthreads) {
    for (size_t i = gtid * 8; i < n; i += nthreads * 8) {
        const f32x4 a = *(const f32x4*)(src + i), b = *(const f32x4*)(src + i + 4);
        u32x4 o; o.x = cvtpk(a.x, a.y); o.y = cvtpk(a.z, a.w); o.z = cvtpk(b.x, b.y); o.w = cvtpk(b.z, b.w);
        *(u32x4*)(dst + i) = o;
    }
}


DI void p0_quant_finish(const f32x4 (&a)[4], unsigned char* dst, float* scale, int row, int lane) {
    float m = 0.f;
#pragma unroll
    for (int i = 0; i < 4; ++i) m = fmaxf(fmaxf(m, fmaxf(fabsf(a[i].x), fabsf(a[i].y))), fmaxf(fabsf(a[i].z), fabsf(a[i].w)));
    m = wave_max(m);
    const float sc = m > 0.f ? m * (1.f / 440.f) : 1.f, inv = m > 0.f ? 440.f * __builtin_amdgcn_rcpf(m) : 0.f;
    u32x4 w;
#pragma unroll
    for (int i = 0; i < 4; ++i) {
        const float q0 = a[i].x * inv, q1 = a[i].y * inv, q2 = a[i].z * inv, q3 = a[i].w * inv;
        int p = 0;
        p = __builtin_amdgcn_cvt_pk_fp8_f32(q0, q1, p, false);
        p = __builtin_amdgcn_cvt_pk_fp8_f32(q2, q3, p, true);
        w[i] = (unsigned)p;
    }
    *(u32x4*)(dst + ((size_t)(lane >> 3) * 16384 + row) * 128 + 16 * (lane & 7)) = w;
    if (lane == 0) scale[row] = sc;
}
DI void quant_u6_finish(const f32x4 (&a)[4], unsigned char* dst, float* scale, int row, int lane) {
    float m = 0.f;
#pragma unroll
    for (int i = 0; i < 4; ++i) m = fmaxf(fmaxf(m, fmaxf(fabsf(a[i].x), fabsf(a[i].y))), fmaxf(fabsf(a[i].z), fabsf(a[i].w)));
    m = wave_max(m);
    const float sc = m > 0.f ? m * (1.f / 31.f) : 1.f, inv = m > 0.f ? 30.999f * __builtin_amdgcn_rcpf(m) : 0.f;
    unsigned hi0 = 0u, hi1 = 0u, lo = 0u;
#pragma unroll
    for (int e = 0; e < 16; ++e) {
        const unsigned bq = __builtin_bit_cast(unsigned, fmaf(a[e >> 2][e & 3], inv, 12582912.f));
        const unsigned h = (bq >> 2) & 15u, l = bq & 3u;
        if (e < 8) hi0 |= h << (4 * e); else hi1 |= h << (4 * (e - 8));
        lo |= l << (e < 8 ? 4 * e : 4 * (e - 8) + 2);
    }
    u32x2 hw; hw.x = hi0; hw.y = hi1;
    *(u32x2*)(dst + ((size_t)(lane >> 4) * 16384 + row) * 128 + 8 * (lane & 15)) = hw;
    *(unsigned*)(dst + ((size_t)(4 + (lane >> 5)) * 16384 + row) * 128 + 4 * (lane & 31)) = lo;
    if (lane == 0) scale[row] = sc;
}
DI void p0_quant_issue2(f32x4 (&a)[2][4], const float* pu, const float* pv, int r, int lane) {
#pragma unroll
    for (int i = 0; i < 4; ++i) { a[0][i] = *(const f32x4*)(pu + (size_t)r * 1024 + 16 * lane + 4 * i); a[1][i] = *(const f32x4*)(pv + (size_t)r * 1024 + 16 * lane + 4 * i); }
}
DI void p0_quant_rows4(const float* pu, const float* pv, unsigned char* u8, unsigned char* v8, float* usc_, float* vsc_, int r0, int r1, int lane) {
    f32x4 a[4][4];
    const int r1c = r1 < 16384 ? r1 : r0;
#pragma unroll
    for (int i = 0; i < 4; ++i) { a[0][i] = *(const f32x4*)(pu + (size_t)r0 * 1024 + 16 * lane + 4 * i); a[1][i] = *(const f32x4*)(pv + (size_t)r0 * 1024 + 16 * lane + 4 * i);
        a[2][i] = *(const f32x4*)(pu + (size_t)r1c * 1024 + 16 * lane + 4 * i); a[3][i] = *(const f32x4*)(pv + (size_t)r1c * 1024 + 16 * lane + 4 * i); }
    p0_quant_finish(a[0], u8, usc_, r0, lane); p0_quant_finish(a[1], v8, vsc_, r0, lane);
    if (r1 < 16384) { p0_quant_finish(a[2], u8, usc_, r1, lane); p0_quant_finish(a[3], v8, vsc_, r1, lane); }
}

DI void rmsnorm_rows2_bf16(const float* x, float* rsx, bf16_t* o, int r0, int r1, int lane) {
    f32x4 v[2][4]; float s[2] = {0.f, 0.f};
    const int rr[2] = {r0, r1 < T ? r1 : r0};
#pragma unroll
    for (int q = 0; q < 2; ++q)
#pragma unroll
        for (int j = 0; j < 4; ++j) v[q][j] = ((const f32x4*)(x + (size_t)rr[q] * 1024))[lane + 64 * j];
#pragma unroll
    for (int q = 0; q < 2; ++q) {
#pragma unroll
        for (int j = 0; j < 4; ++j) s[q] += (v[q][j].x * v[q][j].x + v[q][j].y * v[q][j].y) + (v[q][j].z * v[q][j].z + v[q][j].w * v[q][j].w);
        s[q] = wave_sum(s[q]);
    }
#pragma unroll
    for (int q = 0; q < 2; ++q) {
        if (q == 1 && r1 >= T) break;
        if (lane == 0) rsx[rr[q]] = rsqrtf(s[q] * (1.f / 1024.f) + EPS);
#pragma unroll
        for (int j = 0; j < 4; ++j) { u32x2 w; w.x = cvtpk(v[q][j].x, v[q][j].y); w.y = cvtpk(v[q][j].z, v[q][j].w);
            ((u32x2*)(o + (size_t)rr[q] * 1024))[lane + 64 * j] = w; }
    }
}

namespace pg8 {
#define PG8_LAS __attribute__((address_space(3)))
typedef unsigned short bf16_t;
typedef short bf16x8 __attribute__((ext_vector_type(8)));
typedef float f32x4 __attribute__((ext_vector_type(4)));
typedef unsigned u32x4 __attribute__((ext_vector_type(4)));
constexpr int BM = 256, BK = 64, HALF = 128, HTB = HALF * BK * 2  , STAGE_BYTES = 8 * HTB, NXCD = 8, WGM = 8;

__host__ __device__ __forceinline__ int lds_byte(int r, int c) { const int st = (r >> 4) * 2 + (c >> 5), rr = r & 15, cc = c & 31, ob = rr * 64 + cc * 2; return st * 1024 + (ob ^ (((ob >> 9) & 1) << 5)); }
__host__ __device__ __forceinline__ void stage_rc(int b, int& R, int& C) { const int st = b / 1024, sb = b % 1024, swz = sb ^ (((sb >> 9) & 1) << 5); R = (st >> 1) * 16 + swz / 64; C = (st & 1) * 32 + (swz % 64) / 2; }
__host__ __device__ __forceinline__ int perm32(int rho) { const int n = rho >> 4, i = rho & 15; return 8 * (i >> 2) + 4 * n + (i & 3); }

struct Unit { int pm, pn; };
struct Gemm { const bf16_t* A; const bf16_t* Bt; int M, N, K; };

struct StaticOrder {
    int nM, nN, nwg, G, c;
    __host__ __device__ void init(int M, int N, int G_, int c_) { nM = M / BM; nN = N / BM; nwg = nM * nN; G = G_; c = c_; }
    __host__ __device__ bool next(int i, Unit& u) const {
        const long L = (long)i * G + c; if (L >= nwg) return false;
        int wgid = (int)L; { const int q = nwg / NXCD, r = nwg % NXCD, xcd = wgid % NXCD, off = wgid / NXCD; wgid = (xcd < r ? xcd * (q + 1) : r * (q + 1) + (xcd - r) * q) + off; }
        const int nig = WGM * nN, gid = wgid / nig, fm = gid * WGM, gsz = (nM - fm) < WGM ? (nM - fm) : WGM;
        u.pm = fm + ((wgid % nig) % gsz); u.pn = (wgid % nig) / gsz; return true;
    }
    __device__ __forceinline__ void a_ready(const Unit&) const {}
    __device__ __forceinline__ void done(const Unit&) const {}
};

template <class Epi, class Sched, bool ALIGN_EPI = false, bool SP2 = false>
__device__ __forceinline__ void gemm_phase(PG8_LAS unsigned char* lds, const Gemm g, const Sched& S, const Epi& E) {
    int tid_ = threadIdx.x; asm volatile("" : "+v"(tid_));
    const int tid = tid_, wid = __builtin_amdgcn_readfirstlane(tid >> 6), lane = tid & 63, wr = wid >> 2, wc = wid & 3, fr = lane & 15, fq = lane >> 4;
    const int K = g.K, nt = K / BK;
    unsigned voffA[2], voffB[2];
#pragma unroll
    for (int i = 0; i < 2; ++i) { int R, C; stage_rc(tid * 16 + i * 8192, R, C); const int Rb = Epi::PERM ? ((R & ~31) + perm32(R & 31)) : R;
        voffA[i] = (unsigned)(R * K + C) * 2u; voffB[i] = (unsigned)(Rb * K + C) * 2u; }
    const size_t kstep = (size_t)(BK * 2);
    const size_t hstep = (size_t)HALF * K * 2;
    const size_t tstep = 2 * hstep;
    const unsigned ldsw = (unsigned)wid * 1024u;
    const int aoff = lds_byte(wr * 64 + fr, fq * 8), boff = lds_byte(wc * 32 + fr, fq * 8);
#define PG8_SA(b, h) (((b) * 2 + (h)) * HTB)
#define PG8_SB(b, h) ((4 + (b) * 2 + (h)) * HTB)
#define PG8_STAGE(bufoff, gbase, voff) do { _Pragma("unroll") for (int _i = 0; _i < 2; ++_i) \
        __builtin_amdgcn_global_load_lds((const unsigned*)((const char*)(gbase) + (voff)[_i]), (PG8_LAS unsigned*)(lds + (bufoff) + ldsw + _i * 8192), 16, 0, 0); } while (0)
#define PG8_LDA(dst, b, h) do { _Pragma("unroll") for (int m = 0; m < 4; ++m) _Pragma("unroll") for (int k = 0; k < 2; ++k) dst[m][k] = *(const PG8_LAS bf16x8*)(lds + PG8_SA(b, h) + aoff + m * 2048 + k * 1024); } while (0)
#define PG8_LDB(dst, b, h) do { _Pragma("unroll") for (int n = 0; n < 2; ++n) _Pragma("unroll") for (int k = 0; k < 2; ++k) dst[n][k] = *(const PG8_LAS bf16x8*)(lds + PG8_SB(b, h) + boff + n * 2048 + k * 1024); } while (0)
#define PG8_MMA(ai, bj, At, Bt) do { __builtin_amdgcn_s_setprio(1); _Pragma("unroll") for (int m = 0; m < 4; ++m) _Pragma("unroll") for (int n = 0; n < 2; ++n) _Pragma("unroll") for (int k = 0; k < 2; ++k) \
        acc[ai][bj][m][n] = __builtin_amdgcn_mfma_f32_16x16x32_bf16(Bt[n][k], At[m][k], acc[ai][bj][m][n], 0, 0, 0); __builtin_amdgcn_s_setprio(0); } while (0)
#define PG8_WAIT_V(n) asm volatile("s_waitcnt vmcnt(" #n ")" ::: "memory")
#define PG8_WAIT_L(n) asm volatile("s_waitcnt lgkmcnt(" #n ")" ::: "memory")
#define PG8_BAR __builtin_amdgcn_s_barrier()
#define PG8_SCHED __builtin_amdgcn_sched_barrier(0)
    Unit cur, nxt; int ui = 0;
    if (!S.next(0, cur)) return;
    f32x4 acc[2][2][4][2];
#pragma unroll
    for (int a = 0; a < 2; ++a)
#pragma unroll
        for (int b = 0; b < 2; ++b)
#pragma unroll
            for (int m = 0; m < 4; ++m)
#pragma unroll
                for (int n = 0; n < 2; ++n) acc[a][b][m][n] = (f32x4){0.f, 0.f, 0.f, 0.f};
    bf16x8 At[4][2], B0[2][2], B1[2][2];
    const char* cA = (const char*)g.A + (size_t)cur.pm * tstep; const char* cB = (const char*)g.Bt + (size_t)cur.pn * tstep;
    S.a_ready(cur);
    if constexpr (SP2) {
        PG8_STAGE(PG8_SB(0, 0), cB, voffB); PG8_STAGE(PG8_SB(0, 1), cB + hstep, voffB); PG8_STAGE(PG8_SA(0, 0), cA, voffA); PG8_STAGE(PG8_SA(0, 1), cA + hstep, voffA);
        if (wr == 1) PG8_BAR;
        PG8_WAIT_V(2); PG8_BAR;
        PG8_STAGE(PG8_SB(1, 0), cB + kstep, voffB); PG8_STAGE(PG8_SA(1, 0), cA + kstep, voffA); PG8_STAGE(PG8_SB(1, 1), cB + hstep + kstep, voffB);
        PG8_WAIT_V(6); PG8_BAR;
    } else {
        PG8_STAGE(PG8_SB(0, 0), cB, voffB); PG8_STAGE(PG8_SA(0, 0), cA, voffA); PG8_STAGE(PG8_SB(0, 1), cB + hstep, voffB); PG8_STAGE(PG8_SA(0, 1), cA + hstep, voffA);
        if (wr == 1) PG8_BAR;
        PG8_WAIT_V(4); PG8_BAR;
        PG8_STAGE(PG8_SB(1, 0), cB + kstep, voffB); PG8_STAGE(PG8_SA(1, 0), cA + kstep, voffA); PG8_STAGE(PG8_SB(1, 1), cB + hstep + kstep, voffB);
        PG8_WAIT_V(6); PG8_BAR;
    }
    for (;;) {
        const bool has_next = S.next(ui + 1, nxt);
        const char* nA = has_next ? (const char*)g.A + (size_t)nxt.pm * tstep : cA; const char* nB = has_next ? (const char*)g.Bt + (size_t)nxt.pn * tstep : cB;
        for (int t = 0; t < nt; t += 2) {
            const bool last = (t == nt - 2);
            const char* a1 = cA + (size_t)(t + 1) * kstep;
            const char* a2 = last ? nA : cA + (size_t)(t + 2) * kstep; const char* b2 = last ? nB : cB + (size_t)(t + 2) * kstep;
            const char* a3 = a2 + kstep; const char* b3 = b2 + kstep;
            if (last && has_next) S.a_ready(nxt);
            if constexpr (SP2) {
            PG8_LDB(B0, 0, 0); PG8_LDB(B1, 0, 1); PG8_SCHED; PG8_LDA(At, 0, 0); PG8_STAGE(PG8_SA(1, 1), a1 + hstep, voffA);
            PG8_WAIT_V(8); PG8_WAIT_L(0); PG8_BAR; PG8_MMA(0, 0, At, B0); PG8_MMA(0, 1, At, B1); PG8_BAR; PG8_SCHED;
            PG8_LDA(At, 0, 1); PG8_STAGE(PG8_SB(0, 0), b2, voffB); PG8_STAGE(PG8_SB(0, 1), b2 + hstep, voffB); PG8_STAGE(PG8_SA(0, 0), a2, voffA);
            PG8_WAIT_V(8); PG8_WAIT_L(0); PG8_BAR; PG8_MMA(1, 0, At, B0); PG8_MMA(1, 1, At, B1); PG8_BAR; PG8_SCHED;
            PG8_LDB(B0, 1, 0); PG8_LDB(B1, 1, 1); PG8_SCHED; PG8_LDA(At, 1, 0); PG8_STAGE(PG8_SA(0, 1), a2 + hstep, voffA);
            PG8_WAIT_V(8); PG8_WAIT_L(0); PG8_BAR; PG8_MMA(0, 0, At, B0); PG8_MMA(0, 1, At, B1); PG8_BAR; PG8_SCHED;
            PG8_LDA(At, 1, 1); PG8_STAGE(PG8_SB(1, 0), b3, voffB); PG8_STAGE(PG8_SB(1, 1), b3 + hstep, voffB); PG8_STAGE(PG8_SA(1, 0), a3, voffA);
            PG8_WAIT_V(8); PG8_WAIT_L(0); PG8_BAR; PG8_MMA(1, 0, At, B0); PG8_MMA(1, 1, At, B1); PG8_BAR; PG8_SCHED;
            } else {
            PG8_LDB(B0, 0, 0); PG8_SCHED; PG8_LDA(At, 0, 0); PG8_STAGE(PG8_SA(1, 1), a1 + hstep, voffA);
            PG8_WAIT_L(8); PG8_BAR; PG8_WAIT_L(0); PG8_MMA(0, 0, At, B0); PG8_BAR; PG8_SCHED;
            PG8_LDB(B1, 0, 1); PG8_STAGE(PG8_SB(0, 0), b2, voffB);
            PG8_BAR; PG8_WAIT_L(0); PG8_MMA(0, 1, At, B1); PG8_BAR;
            PG8_LDA(At, 0, 1); PG8_STAGE(PG8_SA(0, 0), a2, voffA);
            PG8_BAR; PG8_WAIT_L(0); PG8_MMA(1, 0, At, B0); PG8_BAR; PG8_SCHED;
            PG8_STAGE(PG8_SB(0, 1), b2 + hstep, voffB);
            PG8_WAIT_V(6); PG8_BAR; PG8_MMA(1, 1, At, B1); PG8_BAR;
            PG8_LDB(B0, 1, 0); PG8_SCHED; PG8_LDA(At, 1, 0); PG8_STAGE(PG8_SA(0, 1), a2 + hstep, voffA);
            PG8_WAIT_L(8); PG8_BAR; PG8_WAIT_L(0); PG8_MMA(0, 0, At, B0); PG8_BAR; PG8_SCHED;
            PG8_LDB(B1, 1, 1); PG8_STAGE(PG8_SB(1, 0), b3, voffB);
            PG8_BAR; PG8_WAIT_L(0); PG8_MMA(0, 1, At, B1); PG8_BAR;
            PG8_LDA(At, 1, 1); PG8_STAGE(PG8_SA(1, 0), a3, voffA);
            PG8_BAR; PG8_WAIT_L(0); PG8_MMA(1, 0, At, B0); PG8_BAR; PG8_SCHED;
            PG8_STAGE(PG8_SB(1, 1), b3 + hstep, voffB);
            PG8_WAIT_V(6); PG8_BAR; PG8_MMA(1, 1, At, B1); PG8_BAR;
            }
        }
        if constexpr (ALIGN_EPI) { if (wr == 0) PG8_BAR; }
        if constexpr (!Epi::AFTER_DRAIN) { E(acc, cur, wr, wc, fr, fq); S.done(cur); }
        if (!has_next) break;
#pragma unroll
        for (int a = 0; a < 2; ++a)
#pragma unroll
            for (int b = 0; b < 2; ++b)
#pragma unroll
                for (int m = 0; m < 4; ++m)
#pragma unroll
                    for (int n = 0; n < 2; ++n) acc[a][b][m][n] = (f32x4){0.f, 0.f, 0.f, 0.f};
        cur = nxt; cA = nA; cB = nB; ++ui;
        if constexpr (ALIGN_EPI) { if (wr == 1) PG8_BAR; }
    }
    PG8_WAIT_V(0);
    if constexpr (!ALIGN_EPI) { if (wr == 0) PG8_BAR; }
    PG8_BAR;
    if constexpr (Epi::AFTER_DRAIN) { E.fused(acc, cur, wr, wc, fr, fq, lds, wid, lane); S.done(cur); }
#undef PG8_SA
#undef PG8_SB
#undef PG8_STAGE
#undef PG8_LDA
#undef PG8_LDB
#undef PG8_MMA
#undef PG8_WAIT_V
#undef PG8_WAIT_L
#undef PG8_BAR
#undef PG8_SCHED
}
}


struct EpiQKV {
    static constexpr bool PERM = true, AFTER_DRAIN = false;
    bf16_t* base6; const float *qn, *kn; float* kmean_acc; const float* rsx;
    DI void operator()(const f32x4 (&acc)[2][2][4][2], const pg8::Unit& u, int wr, int wc, int fr, int fq) const {
        const int typ = u.pn >> 1, h = (u.pn & 1) * 4 + wc;
        bf16_t* reg = base6 + (size_t)typ * (16u << 19);
        const int row0 = u.pm * 256 + wr * 64 + fr;
        float rr[8];
#pragma unroll
        for (int i = 0; i < 8; ++i) rr[i] = rsx[row0 + (i >> 2) * 128 + (i & 3) * 16];
        if (typ == 2 || typ == 5) {
#pragma unroll
            for (int ai = 0; ai < 2; ++ai)
#pragma unroll
                for (int m = 0; m < 4; ++m) {
                    const int tok = row0 + ai * 128 + m * 16, b = tok >> 11, sq = tok & 2047, tile = sq >> 5, kap = sq & 31;
                    const int s2 = kap >> 4, hh = (kap >> 2) & 1, jj = ((kap >> 3) & 1) * 4 + (kap & 3);
                    const float rrow = rr[ai * 4 + m];
                    bf16_t* bp = reg + ((((size_t)(b * 8 + h) * 64 + tile) * 4 + s2 * 2) * 64 + hh * 32 + 8 * fq) * 8 + jj;
#pragma unroll
                    for (int bj = 0; bj < 2; ++bj)
#pragma unroll
                        for (int n = 0; n < 2; ++n)
#pragma unroll
                            for (int i = 0; i < 4; ++i) bp[(size_t)bj * 512 + (4 * n + i) * 8] = f2bf(acc[ai][bj][m][n][i] * rrow);
                }
        } else {
            const bool nrm = typ < 2;
            const float* g = (typ == 0) ? qn : kn;
            f32x4 gv[2][2];
#pragma unroll
            for (int bj = 0; bj < 2; ++bj)
#pragma unroll
                for (int n = 0; n < 2; ++n) gv[bj][n] = *(const f32x4*)(g + 32 * bj + 8 * fq + 4 * n);
#pragma unroll
            for (int bj = 0; bj < 2; ++bj)
#pragma unroll
                for (int n = 0; n < 2; ++n) asm volatile("" : "+v"(gv[bj][n]));
#pragma unroll
            for (int bj = 0; bj < 2; ++bj)
#pragma unroll
                for (int n = 0; n < 2; ++n) gv[bj][n] = nrm ? gv[bj][n] * (typ == 0 ? SCL2 : 1.f) : (typ == 3 ? (f32x4){SCL2, SCL2, SCL2, SCL2} : (f32x4){1.f, 1.f, 1.f, 1.f});
#pragma unroll
            for (int ai = 0; ai < 2; ++ai)
#pragma unroll
                for (int m = 0; m < 4; ++m) {
                    const int tok = row0 + ai * 128 + m * 16, b = tok >> 11, sq = tok & 2047, tile = sq >> 5, kap = sq & 31;
                    const float rrow = rr[ai * 4 + m];
                    float rs = rrow;
                    if (nrm) {
                        float ss = 0.f;
#pragma unroll
                        for (int bj = 0; bj < 2; ++bj)
#pragma unroll
                            for (int n = 0; n < 2; ++n) { const f32x4 v = acc[ai][bj][m][n]; ss += (v.x * v.x + v.y * v.y) + (v.z * v.z + v.w * v.w); }
                        ss = sum_x32(sum_x16(ss));
                        rs = rrow * rsqrtf(ss * (1.f / 64.f) * rrow * rrow + EPS);
                    }
                    bf16_t* dst = reg + ((((size_t)(b * 8 + h) * 64 + tile) * 4 + (fq >> 1)) * 64 + (fq & 1) * 32 + kap) * 8;
#pragma unroll
                    for (int bj = 0; bj < 2; ++bj) {
                        const f32x4 v0 = acc[ai][bj][m][0] * rs * gv[bj][0], v1 = acc[ai][bj][m][1] * rs * gv[bj][1];
                        u32x4 w; w.x = cvtpk(v0.x, v0.y); w.y = cvtpk(v0.z, v0.w); w.z = cvtpk(v1.x, v1.y); w.w = cvtpk(v1.z, v1.w);
                        *(u32x4*)(dst + (size_t)bj * 2 * 512) = w;
                    }
                }
            if (typ == 1) {
                asm volatile("" ::: "memory");
                f32x4 ks[2][2];
#pragma unroll
                for (int bj = 0; bj < 2; ++bj)
#pragma unroll
                    for (int n = 0; n < 2; ++n) ks[bj][n] = (f32x4){0.f, 0.f, 0.f, 0.f};
#pragma unroll
                for (int ai = 0; ai < 2; ++ai)
#pragma unroll
                    for (int m = 0; m < 4; ++m) {
                        float ss = 0.f;
#pragma unroll
                        for (int bj = 0; bj < 2; ++bj)
#pragma unroll
                            for (int n = 0; n < 2; ++n) { const f32x4 v = acc[ai][bj][m][n]; ss += (v.x * v.x + v.y * v.y) + (v.z * v.z + v.w * v.w); }
                        ss = sum_x32(sum_x16(ss));
                        const float rrow = rr[ai * 4 + m];
                        const float rs = rrow * rsqrtf(ss * (1.f / 64.f) * rrow * rrow + EPS);
#pragma unroll
                        for (int bj = 0; bj < 2; ++bj)
#pragma unroll
                            for (int n = 0; n < 2; ++n) ks[bj][n] += acc[ai][bj][m][n] * rs * gv[bj][n];
                    }
                const int tok0 = u.pm * 256;
                float* kd = kmean_acc + ((size_t)((tok0 >> 11) * 8 + h) * 8 + ((tok0 & 2047) >> 8)) * 64 + 8 * fq;
#pragma unroll
                for (int bj = 0; bj < 2; ++bj)
#pragma unroll
                    for (int n = 0; n < 2; ++n)
#pragma unroll
                        for (int i = 0; i < 4; ++i) { const float t = sum_row16(ks[bj][n][i]) * (1.f / 256.f); if (fr == 0) atomicAdd(kd + 32 * bj + 4 * n + i, t); }
            }
        }
    }
};

struct EpiRes {
    static constexpr bool PERM = true, AFTER_DRAIN = false;
    const bf16_t* x; bf16_t* xn;
    DI void operator()(const f32x4 (&acc)[2][2][4][2], const pg8::Unit& u, int wr, int wc, int fr, int fq) const {
        const int row0 = u.pm * 256 + wr * 64 + fr, col0 = u.pn * 256 + wc * 32 + 8 * fq;
        bf16x8 xv[2][2];
#define RES_LOAD(i, slot) do { const size_t _o = (size_t)(row0 + ((i) >> 2) * 128 + ((i) & 3) * 16) * 1024 + col0; \
        xv[slot][0] = *(const bf16x8*)(x + _o); xv[slot][1] = *(const bf16x8*)(x + _o + 128); } while (0)
        RES_LOAD(0, 0);
#pragma unroll
        for (int i = 0; i < 8; ++i) {
            const int ai = i >> 2, m = i & 3;
            if (i < 7) RES_LOAD(i + 1, (i + 1) & 1);
#pragma unroll
            for (int bj = 0; bj < 2; ++bj) {
                const size_t off = (size_t)(row0 + ai * 128 + m * 16) * 1024 + col0 + bj * 128;
                const bf16x8 xb = xv[i & 1][bj];
                const f32x4 h0 = (f32x4){bf2f(xb[0]), bf2f(xb[1]), bf2f(xb[2]), bf2f(xb[3])} + acc[ai][bj][m][0], h1 = (f32x4){bf2f(xb[4]), bf2f(xb[5]), bf2f(xb[6]), bf2f(xb[7])} + acc[ai][bj][m][1];
                u32x4 w; w.x = cvtpk(h0.x, h0.y); w.y = cvtpk(h0.z, h0.w); w.z = cvtpk(h1.x, h1.y); w.w = cvtpk(h1.z, h1.w);
                *(u32x4*)(xn + off) = w;
            }
        }
#undef RES_LOAD
    }
};

struct EpiF32 {
    static constexpr bool PERM = true, AFTER_DRAIN = false;
    float* C; int ldc;
    DI void operator()(const f32x4 (&acc)[2][2][4][2], const pg8::Unit& u, int wr, int wc, int fr, int fq) const {
        const int row0 = u.pm * 256 + wr * 64 + fr, col0 = u.pn * 256 + wc * 32 + 8 * fq;
#pragma unroll
        for (int ai = 0; ai < 2; ++ai)
#pragma unroll
            for (int m = 0; m < 4; ++m)
#pragma unroll
                for (int bj = 0; bj < 2; ++bj) {
                    float* p = C + (size_t)(row0 + ai * 128 + m * 16) * ldc + col0 + bj * 128;
                    *(f32x4*)p = acc[ai][bj][m][0]; *(f32x4*)(p + 4) = acc[ai][bj][m][1];
                }
    }
};

template <bool MONO> struct EpiBfT {
    static constexpr bool PERM = true, AFTER_DRAIN = false;
    bf16_t* C; int ldc;
    DI void operator()(const f32x4 (&acc)[2][2][4][2], const pg8::Unit& u, int wr, int wc, int fr, int fq) const {
        const int row0 = u.pm * 256 + wr * 64 + fr, col0 = u.pn * 256 + wc * 32 + 8 * fq;
#pragma unroll
        for (int ai = 0; ai < 2; ++ai)
#pragma unroll
            for (int m = 0; m < 4; ++m)
#pragma unroll
                for (int bj = 0; bj < 2; ++bj) {
                    const f32x4 v0 = acc[ai][bj][m][0], v1 = acc[ai][bj][m][1];
                    u32x4 w; w.x = cvtpk(v0.x, v0.y); w.y = cvtpk(v0.z, v0.w); w.z = cvtpk(v1.x, v1.y); w.w = cvtpk(v1.z, v1.w);
                    if (MONO) {
#pragma unroll
                        for (int e = 0; e < 4; ++e) { const unsigned sg = (w[e] >> 15) & 0x00010001u; w[e] ^= sg * 0x7fffu + 0x80008000u; }
                    }
                    *(u32x4*)(C + (size_t)(row0 + ai * 128 + m * 16) * ldc + col0 + bj * 128) = w;
                }
    }
};

struct EpiGate {
    static constexpr bool PERM = true, AFTER_DRAIN = false;
    float* out; const bf16_t* pw; const float* ssq; const bf16_t* h2b;
    DI void operator()(const f32x4 (&acc)[2][2][4][2], const pg8::Unit& u, int wr, int wc, int fr, int fq) const {
        const int row0 = u.pm * 256 + wr * 64 + fr, col0 = u.pn * 256 + wc * 32 + 8 * fq;
        float sq8[2][8]; bf16x8 pvv[2][2], hbv[2][2];
#define GATE_LOAD(i, slot) do { const int _row = row0 + ((i) >> 2) * 128 + ((i) & 3) * 16; const size_t _o = (size_t)_row * 1024 + col0; \
        _Pragma("unroll") for (int _x = 0; _x < 8; ++_x) sq8[slot][_x] = ssq[(size_t)_x * T + _row]; \
        pvv[slot][0] = *(const bf16x8*)(pw + _o); pvv[slot][1] = *(const bf16x8*)(pw + _o + 128); hbv[slot][0] = *(const bf16x8*)(h2b + _o); hbv[slot][1] = *(const bf16x8*)(h2b + _o + 128); } while (0)
        GATE_LOAD(0, 0);
#pragma unroll
        for (int i = 0; i < 8; ++i) {
            const int ai = i >> 2, m = i & 3, row = row0 + ai * 128 + m * 16;
            if (i < 7) GATE_LOAD(i + 1, (i + 1) & 1);
            float sq = 0.f;
#pragma unroll
            for (int x = 0; x < 8; ++x) sq += sq8[i & 1][x];
            const float rs3 = rsqrtf(sq * (1.f / 1024.f) + EPS);
#pragma unroll
            for (int bj = 0; bj < 2; ++bj) {
                const size_t off = (size_t)row * 1024 + col0 + bj * 128;
                const bf16x8 pv = pvv[i & 1][bj], hb = hbv[i & 1][bj];
                const f32x4 g0 = acc[ai][bj][m][0] * rs3, g1 = acc[ai][bj][m][1] * rs3;
                f32x4 o0, o1;
#pragma unroll
                for (int e = 0; e < 4; ++e) { o0[e] = bf2f(hb[e]) + bf2f(pv[e]) * __builtin_amdgcn_rcpf(1.f + __expf(-g0[e])); o1[e] = bf2f(hb[4 + e]) + bf2f(pv[4 + e]) * __builtin_amdgcn_rcpf(1.f + __expf(-g1[e])); }
                *(f32x4*)(out + off) = o0; *(f32x4*)(out + off + 4) = o1;
            }
        }
#undef GATE_LOAD
    }
};

template <class Epi>
DI void gemm_simple(const bf16_t* A, const bf16_t* Bt, int M, int N, int K, const Epi& epi, int gwave, int nwaves, int lane) {
    const int r32 = lane & 31, hi = lane >> 5;
    const int nNt = N / 64, total = (M / 32) * nNt;
    for (int tile = gwave; tile < total; tile += nwaves) {
        const int mt = tile / nNt, nt = tile - mt * nNt, m0 = mt * 32, n0 = nt * 64;
        const bf16_t* ap = A + (size_t)(m0 + r32) * K + 8 * hi;
        const bf16_t* b0p = Bt + (size_t)(n0 + r32) * K + 8 * hi;
        const bf16_t* b1p = b0p + (size_t)32 * K;
        f32x16 acc0 = zero16(), acc1 = zero16();
#pragma unroll 4
        for (int k = 0; k < K; k += 16) {
            const bf16x8 xa = *(const bf16x8*)(ap + k);
            const bf16x8 w0 = *(const bf16x8*)(b0p + k);
            const bf16x8 w1 = *(const bf16x8*)(b1p + k);
            acc0 = MFMA32(w0, xa, acc0);
            acc1 = MFMA32(w1, xa, acc1);
        }
        epi(m0 + r32, n0, hi, acc0, acc1);
    }
}

struct Epi1 {
    bf16_t* base6;
    const float *qn, *kn;
    DI void operator()(int tok, int n0, int hi, const f32x16& a0, const f32x16& a1) const {
        const int head48 = n0 >> 6, typ = head48 >> 3, h = head48 & 7;
        bf16_t* reg = base6 + (size_t)typ * (16u << 19);
        if (typ == 2 || typ == 5) {
            const int b = tok >> 11, s = tok & 2047;
            const int pos = (s & ~12) | ((s & 4) << 1) | ((s & 8) >> 1);
            bf16_t* base = reg + ((size_t)(b * 8 + h) * 64) * 2048 + pos;
#pragma unroll
            for (int r = 0; r < 16; ++r) { base[(size_t)crow(r, hi) * 2048] = f2bf(a0[r]); base[(size_t)(32 + crow(r, hi)) * 2048] = f2bf(a1[r]); }
        } else {
            float rs = 1.f;
            const bool nrm = (typ == 0 || typ == 1);
            if (nrm) { float ss = 0.f;
#pragma unroll
                for (int r = 0; r < 16; ++r) ss += a0[r] * a0[r] + a1[r] * a1[r];
                ss = sum_x32(ss);
                rs = rsqrtf(ss * (1.f / 64.f) + EPS); }
            const float* g = (typ == 0) ? qn : kn;
            bf16_t* dst = reg + (size_t)tok * 512 + h * 64;
#pragma unroll
            for (int t = 0; t < 2; ++t)
#pragma unroll
                for (int g4 = 0; g4 < 4; ++g4) {
                    const int f0 = 32 * t + 8 * g4 + 4 * hi;
                    float v[4];
#pragma unroll
                    for (int i = 0; i < 4; ++i) { const float a = t ? a1[4 * g4 + i] : a0[4 * g4 + i]; v[i] = nrm ? a * rs * g[f0 + i] : a; }
                    u32x2 w; w.x = cvtpk(v[0], v[1]); w.y = cvtpk(v[2], v[3]);
                    *(u32x2*)(dst + f0) = w;
                }
        }
    }
};

struct Epi2 {
    const float* x; float* out; bf16_t* xn;
    DI void operator()(int tok, int n0, int hi, const f32x16& a0, const f32x16& a1) const {
#pragma unroll
        for (int t = 0; t < 2; ++t)
#pragma unroll
            for (int g4 = 0; g4 < 4; ++g4) {
                const size_t off = (size_t)tok * 1024 + n0 + 32 * t + 8 * g4 + 4 * hi;
                const f32x4 xv = *(const f32x4*)(x + off);
                f32x4 hv;
#pragma unroll
                for (int i = 0; i < 4; ++i) hv[i] = xv[i] + (t ? a1[4 * g4 + i] : a0[4 * g4 + i]);
                *(f32x4*)(out + off) = hv;
                u32x2 w; w.x = cvtpk(hv[0], hv[1]); w.y = cvtpk(hv[2], hv[3]);
                *(u32x2*)(xn + off) = w;
            }
    }
};

struct Epi3 {
    float* sc;
    DI void operator()(int tok, int n0, int hi, const f32x16& a0, const f32x16& a1) const {
#pragma unroll
        for (int t = 0; t < 2; ++t)
#pragma unroll
            for (int g4 = 0; g4 < 4; ++g4) {
                f32x4 v;
#pragma unroll
                for (int i = 0; i < 4; ++i) v[i] = t ? a1[4 * g4 + i] : a0[4 * g4 + i];
                *(f32x4*)(sc + (size_t)tok * 2048 + n0 + 32 * t + 8 * g4 + 4 * hi) = v;
            }
    }
};

DI void pv_accum(f32x16& o0, f32x16& o1, const f32x16& p, const bf16_t* vt_row) {
#pragma unroll
    for (int s = 0; s < 2; ++s) {
        u32x4 pk; pk.x = cvtpk(p[8 * s], p[8 * s + 1]); pk.y = cvtpk(p[8 * s + 2], p[8 * s + 3]); pk.z = cvtpk(p[8 * s + 4], p[8 * s + 5]); pk.w = cvtpk(p[8 * s + 6], p[8 * s + 7]);
        const bf16x8 pb = __builtin_bit_cast(bf16x8, pk);
        const bf16x8 v0 = *(const bf16x8*)(vt_row + 16 * s);
        const bf16x8 v1 = *(const bf16x8*)(vt_row + (size_t)32 * 2048 + 16 * s);
        o0 = MFMA32(v0, pb, o0);
        o1 = MFMA32(v1, pb, o1);
    }
}

DI void store_o(bf16_t* op, const f32x16& o0, const f32x16& o1, float inv, int hi) {
#pragma unroll
    for (int t = 0; t < 2; ++t)
#pragma unroll
        for (int g4 = 0; g4 < 4; ++g4) {
            u32x2 w;
            if (t == 0) { w.x = cvtpk(o0[4 * g4] * inv, o0[4 * g4 + 1] * inv); w.y = cvtpk(o0[4 * g4 + 2] * inv, o0[4 * g4 + 3] * inv); }
            else        { w.x = cvtpk(o1[4 * g4] * inv, o1[4 * g4 + 1] * inv); w.y = cvtpk(o1[4 * g4 + 2] * inv, o1[4 * g4 + 3] * inv); }
            *(u32x2*)(op + 32 * t + 8 * g4 + 4 * hi) = w;
        }
}

constexpr int OT_PITCH = 1040;
DI void store_o_lds(LAS unsigned char* ot, int r32, int h, const f32x16& o0, const f32x16& o1, float inv, int hi) {
    LAS unsigned char* op = ot + r32 * OT_PITCH + h * 128;
#pragma unroll
    for (int t = 0; t < 2; ++t)
#pragma unroll
        for (int g4 = 0; g4 < 4; ++g4) {
            u32x2 w;
            if (t == 0) { w.x = cvtpk(o0[4 * g4] * inv, o0[4 * g4 + 1] * inv); w.y = cvtpk(o0[4 * g4 + 2] * inv, o0[4 * g4 + 3] * inv); }
            else        { w.x = cvtpk(o1[4 * g4] * inv, o1[4 * g4 + 1] * inv); w.y = cvtpk(o1[4 * g4 + 2] * inv, o1[4 * g4 + 3] * inv); }
            *(LAS u32x2*)(op + (32 * t + 8 * g4 + 4 * hi) * 2) = w;
        }
}
DI void load_kfrag(bf16x8 (&kf)[4], const bf16_t* fbase  , int tile) {
    const bf16_t* kp = fbase + (size_t)tile * 2048;
#pragma unroll
    for (int s = 0; s < 4; ++s) kf[s] = *(const bf16x8*)(kp + s * 512);
}
DI void load_vfrag(bf16x8 (&vf)[4], const bf16_t* fbase, int tile) {
    const bf16_t* vp = fbase + (size_t)tile * 2048;
#pragma unroll
    for (int q = 0; q < 4; ++q) vf[q] = *(const bf16x8*)(vp + q * 512);
}
DI void pv_accum2(f32x16& o0, f32x16& o1, const f32x16& p, const bf16x8 (&vf)[4]) {
#pragma unroll
    for (int s = 0; s < 2; ++s) {
        u32x4 pk; pk.x = cvtpk(p[8 * s], p[8 * s + 1]); pk.y = cvtpk(p[8 * s + 2], p[8 * s + 3]); pk.z = cvtpk(p[8 * s + 4], p[8 * s + 5]); pk.w = cvtpk(p[8 * s + 6], p[8 * s + 7]);
        const bf16x8 pb = __builtin_bit_cast(bf16x8, pk);
        o0 = MFMA32(vf[2 * s], pb, o0);
        o1 = MFMA32(vf[2 * s + 1], pb, o1);
    }
}

#define MEM_FENCE() asm volatile("" ::: "memory")
#define PIN1(a) asm volatile("" : "+v"(a) :: "memory")
#define PIN2(a, b) asm volatile("" : "+v"(a), "+v"(b) :: "memory")
DI void vm_drain() { __builtin_amdgcn_s_waitcnt(0x0F70); }
struct KvStream { const bf16_t* kbase; const bf16_t* vbase; };

struct MobaCtx { int q0, tq, blk, hi; unsigned selmask; float bfar; const LAS float* bt; };
typedef __bf16 bf2_t __attribute__((ext_vector_type(2)));
constexpr float MOBA_THR = 8.f;
DI void moba_tile(bf16x8 (&kf)[4], const bf16x8 (&vf)[4], bf16x8 (&vo)[4], const bf16x8 (&qf)[4], const bf16x8& ones, int kt, int nextk, int nextv, bool first, const KvStream& kv, const MobaCtx& c, float& mrun, float& lsum, f32x16& o0, f32x16& o1) {
    const int n = kt >> 3, key0 = kt * 32;
    const bool own = n == c.blk, far = !own && (c.q0 - (key0 + 31)) >= 128;
    const bool selq = own || ((c.selmask >> n) & 1u);
    const float coff = (selq ? (far ? c.bfar : 0.f) : -1e30f) - mrun;
    const unsigned hl = cvtpk(coff, 0.f) & 0xffffu;
    const unsigned lo = cvtpk(coff - __builtin_bit_cast(float, hl << 16), 0.f) & 0xffffu;
    u32x4 bo; bo.x = c.hi == 0 ? (hl | (lo << 16)) : 0u; bo.y = 0u; bo.z = 0u; bo.w = 0u;
    f32x16 st = MFMA32(ones, __builtin_bit_cast(bf16x8, bo), zero16());
#pragma unroll
    for (int s = 0; s < 4; ++s) st = MFMA32(kf[s], qf[s], st);
    PIN1(st); load_kfrag(kf, kv.kbase, nextk); load_vfrag(vo, kv.vbase, nextv); PIN1(st);
    if (own) {
        float bv[16];
#pragma unroll
        for (int r = 0; r < 16; ++r) { const int dist = c.tq - (key0 + crow(r, c.hi)); bv[r] = c.bt[dist < 0 ? 0 : (dist > 128 ? 128 : dist)]; }
#pragma unroll
        for (int r = 0; r < 16; ++r) asm volatile("" : "+v"(bv[r]));
#pragma unroll
        for (int r = 0; r < 16; ++r) { const int dist = c.tq - (key0 + crow(r, c.hi)); st[r] = (dist >= 0) ? st[r] + bv[r] : -1e30f; }
    } else if (!far) {
#pragma unroll
        for (int r = 0; r < 16; ++r) { const int dist = c.tq - (key0 + crow(r, c.hi)); st[r] += c.bt[dist > 128 ? 128 : dist]; }
    }
    float tm = fmaxf(st[0], st[1]);
#pragma unroll
    for (int r = 2; r < 16; r += 2) tm = fmaxf(fmaxf(tm, st[r]), st[r + 1]);
    if (first || __any(tm > MOBA_THR)) {
        tm = max_x32(tm);
        const float delta = first ? tm : fmaxf(tm, 0.f);
        mrun += delta; const float sc = __builtin_amdgcn_exp2f(-delta); lsum *= sc;
#pragma unroll
        for (int r = 0; r < 16; ++r) { o0[r] *= sc; o1[r] *= sc; st[r] -= delta; }
    }
    float ps = 0.f;
#pragma unroll
    for (int s = 0; s < 2; ++s) {
        u32x4 pk;
        pk.x = cvtpk(__builtin_amdgcn_exp2f(st[8 * s]), __builtin_amdgcn_exp2f(st[8 * s + 1])); pk.y = cvtpk(__builtin_amdgcn_exp2f(st[8 * s + 2]), __builtin_amdgcn_exp2f(st[8 * s + 3]));
        pk.z = cvtpk(__builtin_amdgcn_exp2f(st[8 * s + 4]), __builtin_amdgcn_exp2f(st[8 * s + 5])); pk.w = cvtpk(__builtin_amdgcn_exp2f(st[8 * s + 6]), __builtin_amdgcn_exp2f(st[8 * s + 7]));
#pragma unroll
        for (int w = 0; w < 4; ++w) { const unsigned pw = pk[w]; ps = __builtin_amdgcn_fdot2_f32_bf16(__builtin_bit_cast(bf2_t, pw), __builtin_bit_cast(bf2_t, 0x3F803F80u), ps, false); }
        const bf16x8 pb = __builtin_bit_cast(bf16x8, pk);
        o0 = MFMA32(vf[2 * s], pb, o0); o1 = MFMA32(vf[2 * s + 1], pb, o1);
    }
    lsum += ps;
}
DI int moba_next(int kt, int blk, unsigned anysel) {
    if (kt & 7) return kt - 1;
    const unsigned m = anysel & ((1u << (kt >> 3)) - 1u);
    return m ? (31 - __builtin_clz(m)) * 8 + 7 : -1;
}

DI void unit_issue(bf16x8 (&kf)[4], bf16x8 (&vf)[4], bf16x8 (&qf)[4], int u, const bf16_t* qm, const bf16_t* km, const bf16_t* vm, const bf16_t* qs, const bf16_t* ks, const bf16_t* vs, int lane) {
    const int grp = u >> 12, i = u & 4095, half = i >> 11, j = i & 2047;
    const int qt = half ? (j >> 6) : 63 - (j >> 6);
    const size_t off = (size_t)(j & 63) * (64 * 2048) + lane * 8;
    load_kfrag(kf, (grp ? ks : km) + off, qt); load_vfrag(vf, (grp ? vs : vm) + off, qt);
    const bf16_t* qfb = (grp ? qs : qm) + (size_t)(j & 63) * (64 * 2048) + (size_t)qt * 2048;
#pragma unroll
    for (int s = 0; s < 4; ++s) qf[s] = *(const bf16x8*)(qfb + s * 512 + lane * 8);
}
DI void moba_unit(bf16x8 (&kf)[4], bf16x8 (&vf)[4], const bf16x8 (&qf)[4], int b, int h, int qt, const bf16_t* Km_, const bf16_t* VtM_, const float* kmean_, const LAS float* biasLds, LAS unsigned char* ot, int lane) {
    const int r32 = lane & 31, hi = lane >> 5;
    const int q0 = qt * 32, tq = q0 + r32, blk = q0 >> 8;
    const size_t bh = (size_t)(b * 8 + h);
    KvStream kv; kv.kbase = Km_ + bh * (64 * 2048) + lane * 8; kv.vbase = VtM_ + bh * (64 * 2048) + lane * 8;
    bf16x8 kg[4], vg[4];
    unsigned selmask = 0;
    if (blk > 0) {
        f32x16 gs = zero16();
        const bool ld = r32 < 8;
        const float* kmrow = kmean_ + ((size_t)((b * 8 + h) * 8) + (ld ? r32 : 0)) * 64 + 8 * hi;
        f32x4 ka[4][2];
#pragma unroll
        for (int s = 0; s < 4; ++s) { ka[s][0] = *(const f32x4*)(kmrow + 16 * s); ka[s][1] = *(const f32x4*)(kmrow + 16 * s + 4); }
#pragma unroll
        for (int s = 0; s < 4; ++s) {
            const f32x4 z = {0.f, 0.f, 0.f, 0.f};
            bf16x8 ah, al;
            split_bf16x8(ld ? ka[s][0] : z, ld ? ka[s][1] : z, ah, al);
            gs = MFMA32(ah, qf[s], gs); gs = MFMA32(al, qf[s], gs);
        }
        float g[8];
#pragma unroll
        for (int r = 0; r < 4; ++r) { float lo_, hi_; swap32(gs[r], lo_, hi_); g[r] = lo_; g[4 + r] = hi_; }
#pragma unroll
        for (int n = 0; n < 8; ++n) g[n] = (n < blk) ? g[n] : -INFINITY;
#pragma unroll
        for (int n = 0; n < 8; ++n) {
            int rank = 0;
#pragma unroll
            for (int m = 0; m < 8; ++m) if (m != n) rank += ((g[m] > g[n]) || (g[m] == g[n] && m < n)) ? 1 : 0;
            if (n < blk && rank < 3) selmask |= 1u << n;
        }
    }
    unsigned anysel = 0;
#pragma unroll
    for (int n = 0; n < 8; ++n) if (__any((selmask >> n) & 1u)) anysel |= 1u << n;
    anysel = __builtin_amdgcn_readfirstlane(anysel);
    float mrun = 0.f, lsum = 0.f;
    f32x16 o0 = zero16(), o1 = zero16();
    bf16x8 ones;
#pragma unroll
    for (int j = 0; j < 8; ++j) ones[j] = (short)((hi == 0 && j < 2) ? 0x3F80 : 0);
    MobaCtx c; c.q0 = q0; c.tq = tq; c.blk = blk; c.hi = hi; c.selmask = selmask; c.bt = biasLds + h * 132; c.bfar = c.bt[128];
    int kt = qt, n1 = moba_next(kt, blk, anysel);
    { const int t = n1 < 0 ? 0 : n1; load_kfrag(kg, kv.kbase, t); }
    vm_drain();
    bool first = true;
    for (;;) {
        const int n2 = n1 >= 0 ? moba_next(n1, blk, anysel) : -1;
        moba_tile(kf, vf, vg, qf, ones, kt, n2 < 0 ? 0 : n2, n1 < 0 ? 0 : n1, first, kv, c, mrun, lsum, o0, o1);
        if (n1 < 0) break;
        const int n3 = n2 >= 0 ? moba_next(n2, blk, anysel) : -1;
        moba_tile(kg, vg, vf, qf, ones, n1, n3 < 0 ? 0 : n3, n2 < 0 ? 0 : n2, false, kv, c, mrun, lsum, o0, o1);
        if (n2 < 0) break;
        kt = n2; n1 = n3; first = false;
    }
    lsum = sum_x32(lsum);
    const float inv = 1.f / lsum;
    store_o_lds(ot, r32, h, o0, o1, inv, hi);
}

template <bool DIAG> DI void sb_tile(bf16x8 (&kf)[4], bf16x8 (&vf)[4], const bf16x8 (&qf)[4], int kt, int next, const KvStream& kv, int tq, int hi, float& C, f32x16& o0, f32x16& o1) {
    const int key0 = kt * 32;
    f32x16 st = zero16();
#pragma unroll
    for (int s = 0; s < 4; ++s) st = MFMA32(kf[s], qf[s], st);
    PIN1(st); load_kfrag(kf, kv.kbase, next); PIN1(st);
    float rr[16], be[16];
#pragma unroll
    for (int r = 0; r < 16; ++r) {
        const int key = key0 + crow(r, hi);
        const float y = fminf(st[r], 100.f);
        const float e = __builtin_amdgcn_exp2f(y);
        const float ri = __builtin_amdgcn_rcpf(1.f + e);
        const bool ok = DIAG ? key < tq : true;
        rr[r] = ok ? ri : 1.f;
        be[r] = ok ? e * ri : 0.f;
    }
    float G[4], ex[16], Gp[4], Tt[4], Suf[4];
#pragma unroll
    for (int a = 0; a < 4; ++a) {
        ex[4 * a + 3] = 1.f; ex[4 * a + 2] = rr[4 * a + 3]; ex[4 * a + 1] = ex[4 * a + 2] * rr[4 * a + 2]; ex[4 * a] = ex[4 * a + 1] * rr[4 * a + 1];
        G[a] = ex[4 * a] * rr[4 * a];
    }
#pragma unroll
    for (int a = 0; a < 4; ++a) { float lo_, hi_; swap32(G[a], lo_, hi_); Gp[a] = hi_; Tt[a] = lo_ * hi_; }
    Suf[3] = 1.f; Suf[2] = Tt[3]; Suf[1] = Tt[3] * Tt[2]; Suf[0] = Suf[1] * Tt[1];
    f32x16 pr;
#pragma unroll
    for (int a = 0; a < 4; ++a) {
        const float after = Suf[a] * (hi == 0 ? Gp[a] : 1.f) * C;
#pragma unroll
        for (int i = 0; i < 4; ++i) pr[4 * a + i] = be[4 * a + i] * ex[4 * a + i] * after;
    }
    C = C * (Suf[0] * Tt[0]);
    pv_accum2(o0, o1, pr, vf);
    PIN2(o0, o1); load_vfrag(vf, kv.vbase, next); MEM_FENCE();
}

DI void sb_unit(bf16x8 (&kf)[4], bf16x8 (&vf)[4], const bf16x8 (&qf)[4], int b, int h, int qt, const bf16_t* Ks_, const bf16_t* VtS_, LAS unsigned char* ot, int lane) {
    const int r32 = lane & 31, hi = lane >> 5;
    const int q0 = qt * 32, tq = q0 + r32;
    const size_t bh = (size_t)(b * 8 + h);
    KvStream kv; kv.kbase = Ks_ + bh * (64 * 2048) + lane * 8; kv.vbase = VtS_ + bh * (64 * 2048) + lane * 8;
    f32x16 o0 = zero16(), o1 = zero16();
    float C = 1.f;
    vm_drain();
    sb_tile<true>(kf, vf, qf, qt, qt > 0 ? qt - 1 : 0, kv, tq, hi, C, o0, o1);
    if (!__all(C == 0.f ? 1 : 0))
        for (int kt = qt - 1; kt >= 0; --kt) {
            sb_tile<false>(kf, vf, qf, kt, kt > 0 ? kt - 1 : 0, kv, tq, hi, C, o0, o1);
            if (__all(C == 0.f ? 1 : 0)) break;
        }
    store_o_lds(ot, r32, h, o0, o1, 1.f, hi);
}

DI void ce_desc(unsigned& a, unsigned& b) { const unsigned hi = a > b ? a : b, lo = a > b ? b : a; a = hi; b = lo; }
DI void bitonic_clean_desc(unsigned (&v)[16]) {
#pragma unroll
    for (int s = 8; s >= 1; s >>= 1)
#pragma unroll
        for (int i = 0; i < 16; ++i) if ((i & s) == 0) ce_desc(v[i], v[i + s]);
}
DI void sort16_desc(unsigned (&v)[16]) {
#define C(i, j) ce_desc(v[i], v[j]);
    C(0,1) C(2,3) C(4,5) C(6,7) C(8,9) C(10,11) C(12,13) C(14,15) C(0,2) C(1,3) C(4,6) C(5,7) C(8,10) C(9,11) C(12,14) C(13,15) C(0,4) C(1,5) C(2,6) C(3,7) C(8,12) C(9,13) C(10,14) C(11,15) C(0,8) C(1,9) C(2,10) C(3,11) C(4,12) C(5,13) C(6,14) C(7,15) C(6,10) C(5,9) C(7,11) C(4,8) C(5,6) C(9,10) C(13,14) C(1,2) C(3,12) C(2,8) C(6,9) C(7,13) C(1,4) C(7,12) C(3,8) C(11,14) C(6,8) C(7,9) C(3,5) C(10,12) C(11,13) C(2,4) C(8,10) C(11,12) C(3,4) C(9,10) C(7,8) C(5,6) C(6,7)
#undef C
}
DI float key_value(unsigned key) { const unsigned u = (key & 0x80000000u) ? (key & 0x7fff0000u) : (~key & 0xffff0000u); return __builtin_bit_cast(float, u); }
DI float key_value8(unsigned key) { const unsigned kk = key & ~255u; const unsigned u = (kk & 0x80000000u) ? (kk & 0x7fffffffu) : ~kk; return __builtin_bit_cast(float, u); }
template <int CTRL> DI unsigned dppu(unsigned v) { return (unsigned)__builtin_amdgcn_update_dpp(0, (int)v, CTRL, 0xF, 0xF, true); }
DI void sort8_desc(unsigned (&v)[8]) {
    ce_desc(v[0], v[2]); ce_desc(v[1], v[3]); ce_desc(v[4], v[6]); ce_desc(v[5], v[7]);
    ce_desc(v[0], v[4]); ce_desc(v[1], v[5]); ce_desc(v[2], v[6]); ce_desc(v[3], v[7]);
    ce_desc(v[0], v[1]); ce_desc(v[2], v[3]); ce_desc(v[4], v[5]); ce_desc(v[6], v[7]);
    ce_desc(v[2], v[4]); ce_desc(v[3], v[5]);
    ce_desc(v[1], v[4]); ce_desc(v[3], v[6]);
    ce_desc(v[1], v[2]); ce_desc(v[3], v[4]); ce_desc(v[5], v[6]);
}
DI void clean8_desc(unsigned (&v)[8]) {
#pragma unroll
    for (int s = 4; s >= 1; s >>= 1)
#pragma unroll
        for (int i = 0; i < 8; ++i) if ((i & s) == 0) ce_desc(v[i], v[i + s]);
}
template <int CTRL> DI void cross_rev_max(unsigned (&v)[8]) {
    unsigned t[8];
#pragma unroll
    for (int i = 0; i < 8; ++i) t[i] = dppu<CTRL>(v[7 - i]);
#pragma unroll
    for (int i = 0; i < 8; ++i) v[i] = v[i] > t[i] ? v[i] : t[i];
}
template <bool REV> DI void cross_minmax_x1(unsigned (&v)[8], bool odd) {
    unsigned t[8];
#pragma unroll
    for (int i = 0; i < 8; ++i) t[i] = dppu<DPP_XOR1>(v[REV ? 7 - i : i]);
#pragma unroll
    for (int i = 0; i < 8; ++i) { const unsigned hi = v[i] > t[i] ? v[i] : t[i], lo = v[i] > t[i] ? t[i] : v[i]; v[i] = odd ? lo : hi; }
}

DI float reduce16(const float (&p)[16], int lane) {
    const bool b3 = lane & 8, b2 = lane & 4, b1 = lane & 2, b0 = lane & 1;
    float q[8], r[4], s[2];
#pragma unroll
    for (int i = 0; i < 8; ++i) { const float mine = b3 ? p[i + 8] : p[i], send = b3 ? p[i] : p[i + 8]; q[i] = mine + __shfl_xor(send, 8); }
#pragma unroll
    for (int i = 0; i < 4; ++i) { const float mine = b2 ? q[i + 4] : q[i], send = b2 ? q[i] : q[i + 4]; r[i] = mine + __shfl_xor(send, 4); }
#pragma unroll
    for (int i = 0; i < 2; ++i) { const float mine = b1 ? r[i + 2] : r[i], send = b1 ? r[i] : r[i + 2]; s[i] = mine + __shfl_xor(send, 2); }
    const float mine = b0 ? s[1] : s[0], send = b0 ? s[0] : s[1];
    float t = mine + __shfl_xor(send, 1);
    t = sum_x32(sum_x16(t));
    return t;
}

#ifndef PEER_REP_TOPK
#define PEER_REP_TOPK 1
#endif
#ifndef PEER_REP_U
#define PEER_REP_U 1
#endif
#ifndef PEER_REP_V
#define PEER_REP_V 1
#endif
struct TopkIn { bf16x8 hv[2]; bf16x8 sv[4]; };
DI void peer_topk_load(TopkIn& in, int tok, const bf16_t* h1b, const bf16_t* scores, int lane) {
    const int tc = tok < T ? tok : T - 1;
    const bf16_t* hrow = h1b + (size_t)tc * 1024 + 16 * lane;
    const bf16_t* sp = scores + (size_t)tc * 2048 + (lane >> 2) * 128 + (lane & 3) * 8;
#pragma unroll
    for (int i = 0; i < 4; ++i) in.sv[i] = *(const bf16x8*)(sp + 32 * i);
    in.hv[0] = *(const bf16x8*)hrow; in.hv[1] = *(const bf16x8*)(hrow + 8);
}
DI void peer_topk_token(int tok, const TopkIn& in, const f32x4 (&gq)[4], const unsigned (&cand)[21], int* EIDXg, float* GATEg, unsigned char* XN2g, float* XSg, LAS float* wl, int lane) {
    LAS unsigned* kbuf = (LAS unsigned*)wl; const LAS unsigned* ctab = (const LAS unsigned*)(wl + 768);
    f32x4 hv[4];
    float ss = 0.f;
#pragma unroll
    for (int i = 0; i < 4; ++i) { const bf16x8 hb = in.hv[i >> 1]; const int o4 = 4 * (i & 1); hv[i] = (f32x4){bf2f(hb[o4]), bf2f(hb[o4 + 1]), bf2f(hb[o4 + 2]), bf2f(hb[o4 + 3])}; ss += (hv[i].x * hv[i].x + hv[i].y * hv[i].y) + (hv[i].z * hv[i].z + hv[i].w * hv[i].w); }
    ss = wave_sum(ss);
    const float rs2 = rsqrtf(ss * (1.f / 1024.f) + EPS);
    {
        float y[16], m = 0.f;
#pragma unroll
        for (int i = 0; i < 4; ++i) { const f32x4 gv = gq[i];
#pragma unroll
            for (int e = 0; e < 4; ++e) { y[4 * i + e] = hv[i][e] * gv[e]; m = fmaxf(m, fabsf(y[4 * i + e])); } }
        m = wave_max(m);
        const float inv = m > 0.f ? 118.99f * __builtin_amdgcn_rcpf(m) : 0.f;
        unsigned xh0 = 0u, xh1 = 0u, xl0 = 0u, xl1 = 0u;
#pragma unroll
        for (int e = 0; e < 16; ++e) {
            const unsigned bq = __builtin_bit_cast(unsigned, fmaf(y[e], inv, 12582920.f));
            const unsigned nl = bq & 15u, nh = (bq >> 4) & 15u;
            if (e < 8) { xl0 |= nl << (4 * e); xh0 |= nh << (4 * e); } else { xl1 |= nl << (4 * (e - 8)); xh1 |= nh << (4 * (e - 8)); }
        }
        xl0 ^= 0x88888888u; xl1 ^= 0x88888888u;
        u32x2 wh, wl2; wh.x = xh0; wh.y = xh1; wl2.x = xl0; wl2.y = xl1;
        *(u32x2*)(XN2g + (size_t)tok * 1024 + 8 * lane) = wh;
        *(u32x2*)(XN2g + (size_t)tok * 1024 + 512 + 8 * lane) = wl2;
        if (lane == 0) XSg[tok] = m > 0.f ? m * rs2 * (1.f / 119.f) : 0.f;
    }
    {
        const int L = lane >> 2, q = lane & 3;
        unsigned k0[16], k1[16];
#pragma unroll
        for (int i = 0; i < 4; ++i) {
            const bf16x8 v = in.sv[i];
#pragma unroll
            for (int cI = 0; cI < 8; ++cI) {
                const unsigned key = (((unsigned)(unsigned short)v[cI]) << 16) | (unsigned)(((3 - i) << 5) | (7 - cI));
                if (i < 2) k0[8 * i + cI] = key; else k1[8 * (i - 2) + cI] = key;
            }
        }
        sort16_desc(k0); sort16_desc(k1);
        unsigned t[16];
#pragma unroll
        for (int i = 0; i < 16; ++i) t[i] = k0[i] > k1[15 - i] ? k0[i] : k1[15 - i];
        bitonic_clean_desc(t);
        { const unsigned qb = (unsigned)(3 - q) << 3;
#pragma unroll
          for (int i = 0; i < 16; ++i) t[i] |= qb; }
#pragma unroll
        for (int i = 0; i < 16; ++i) k0[i] = (unsigned)__builtin_amdgcn_update_dpp(0, (int)t[15 - i], 0xB1, 0xF, 0xF, true);
#pragma unroll
        for (int i = 0; i < 16; ++i) t[i] = t[i] > k0[i] ? t[i] : k0[i];
        bitonic_clean_desc(t);
#pragma unroll
        for (int i = 0; i < 16; ++i) k0[i] = (unsigned)__builtin_amdgcn_update_dpp(0, (int)t[15 - i], 0x4E, 0xF, 0xF, true);
#pragma unroll
        for (int i = 0; i < 16; ++i) t[i] = t[i] > k0[i] ? t[i] : k0[i];
        bitonic_clean_desc(t);
        if (q == 0) {
#pragma unroll
            for (int i = 0; i < 4; ++i) { u32x4 w; w.x = t[4 * i]; w.y = t[4 * i + 1]; w.z = t[4 * i + 2]; w.w = t[4 * i + 3]; *(LAS u32x4*)(kbuf + L * 16 + 4 * i) = w; }
        }
        asm volatile("s_waitcnt lgkmcnt(0)" ::: "memory");
    }
    {
        const int hd = lane >> 3, sub = lane & 7; const bool odd = sub & 1;
        unsigned ck[8], ka[7], kb[7];
#pragma unroll
        for (int k = 0; k < 7; ++k) { ka[k] = kbuf[cand[k]]; kb[k] = kbuf[cand[7 + k]]; }
#pragma unroll
        for (int k = 0; k < 7; ++k) asm volatile("" : "+v"(ka[k]), "+v"(kb[k]));
#pragma unroll
        for (int k = 0; k < 7; ++k) {
            const int cidx = 7 * sub + k;
            const float v = key_value(ka[k]) + key_value(kb[k]);
            const unsigned u = __float_as_uint(v);
            const unsigned mono = (u & 0x80000000u) ? ~u : (u | 0x80000000u);
            ck[k] = (cidx < 50) ? ((mono & ~255u) | cand[14 + k]) : 0u;
        }
        ck[7] = 0u;
        sort8_desc(ck);
        cross_minmax_x1<true>(ck, odd); clean8_desc(ck);
        cross_rev_max<0x1B>(ck); cross_minmax_x1<false>(ck, odd); clean8_desc(ck);
        cross_rev_max<DPP_HMIR>(ck); cross_minmax_x1<false>(ck, odd); clean8_desc(ck);
        const int pr = sub >> 1;
        const unsigned e0 = pr == 0 ? ck[0] : pr == 1 ? ck[2] : pr == 2 ? ck[4] : ck[6];
        const unsigned e1 = pr == 0 ? ck[1] : pr == 1 ? ck[3] : pr == 2 ? ck[5] : ck[7];
        const unsigned id0 = 255u - (e0 & 255u), id1 = 255u - (e1 & 255u);
        const unsigned ka0 = kbuf[hd * 32 + (id0 >> 4)], kb0 = kbuf[hd * 32 + 16 + (id0 & 15u)];
        const unsigned ka1 = kbuf[hd * 32 + (id1 >> 4)], kb1 = kbuf[hd * 32 + 16 + (id1 & 15u)];
        const float v0 = key_value8(e0), v1 = key_value8(e1);
        const float mx = max_oct(fmaxf(v0, v1));
        const float ev0 = __expf((v0 - mx) * rs2), ev1 = __expf((v1 - mx) * rs2);
        const float inv = __builtin_amdgcn_rcpf(sum_oct(ev0 + ev1));
        const int rank0 = (odd ? 8 : 0) + 2 * pr;
        u32x2 ew; ew.x = (127u - (ka0 & 127u)) * 128u + (127u - (kb0 & 127u)); ew.y = (127u - (ka1 & 127u)) * 128u + (127u - (kb1 & 127u));
        f32x2 gw; gw.x = ev0 * inv; gw.y = ev1 * inv;
        *(unsigned*)((unsigned short*)EIDXg + (size_t)tok * 128 + hd * 16 + rank0) = ew.x | (ew.y << 16);
        *(f32x2*)(GATEg + (size_t)tok * 128 + hd * 16 + rank0) = gw;
    }
}

DI float dot16_fp8(const u32x4& row, const float (&x)[16]) {
    float sacc = 0.f;
#pragma unroll
    for (int w = 0; w < 4; ++w) { const f32x2 lo = __builtin_amdgcn_cvt_pk_f32_fp8((int)row[w], false), hi2 = __builtin_amdgcn_cvt_pk_f32_fp8((int)row[w], true);
        sacc += lo.x * x[4 * w] + lo.y * x[4 * w + 1] + hi2.x * x[4 * w + 2] + hi2.y * x[4 * w + 3]; }
    return sacc;
}
template <class TT> DI TT ldu(const void* ubase, unsigned off) { return *(const TT*)((const char*)ubase + off); }
template <bool LO>
DI void peer_u_slice(int slA, int t_loA, int slB, int t_loB, int t_hi  , int tk_first, int tk_step, const unsigned char* XNg, const int* EIDXg, const unsigned char* U6s, bf16_t* PDOT, int lane) {
    const int es = lane >> 3, c = lane & 7;
    const unsigned c16 = 16u * c, eoff = 64u * es, poff = (16u * es + c) * 2u;
    const unsigned xlane = LO ? 32u * c : 16u * c;
#define V_SL(v) ((v) < 4096 ? slA : slB)
#define V_TOK(v) ((v) < 4096 ? t_loA + (v) : t_loB + (v) - 4096)
#define V_TB(v) (U6s + (size_t)V_SL(v) * 16384 * 128)
#define V_XS(v) (LO ? 256u * (unsigned)(V_SL(v) - 4) : 128u * (unsigned)V_SL(v))
    const bool b2 = c & 4, b1 = c & 2, b0 = c & 1;
    constexpr int NX = LO ? 2 : 1;
    u32x4 I0[2], I1[2], I2[2], rowsA[8], rowsB[8], rowsC[8], xh0[NX], xl0[NX], xh1[NX], xl1[NX], xh2[NX], xl2[NX];
#define LD_E8(ib, tk, h) do { const int _v = (tk) < t_hi ? (tk) : t_hi - 1; const int _t = V_TOK(_v); const unsigned short* _eb = (const unsigned short*)EIDXg + (size_t)_t * 128 + 8 * (h); ib[0] = ldu<u32x4>(_eb, eoff >> 1); } while (0)
#define LD_R8(rows, ib, tbl) do { _Pragma("unroll") for (int _k = 0; _k < 8; ++_k) { const unsigned _w = ib[0][_k >> 1]; const unsigned _id = (_k & 1) ? (_w >> 16) : (_w & 0xffffu); rows[_k] = ldu<u32x4>(tbl, _id * 128u + c16); } } while (0)
#define LD_X(xh, xl, tk) do { const int _v = (tk) < t_hi ? (tk) : t_hi - 1; const unsigned char* _xb = XNg + (size_t)V_TOK(_v) * 1024 + V_XS(_v); \
        _Pragma("unroll") for (int _n = 0; _n < NX; ++_n) { xh[_n] = ldu<u32x4>(_xb, xlane + 16u * _n); xl[_n] = ldu<u32x4>(_xb, 512u + xlane + 16u * _n); } } while (0)
#define U_COMPUTE8(rows, xh, xl, tk, h) do { \
        float _p[8]; _Pragma("unroll") for (int _i = 0; _i < 8; ++_i) { if (_i > 0) asm volatile("" : "+v"(rows[_i]) : "v"(_p[_i - 1])); int _ah = 0, _al = 0; \
            _Pragma("unroll") for (int _w = 0; _w < 4; ++_w) { const unsigned _d = rows[_i][_w]; \
                if (LO) { const int _e = (int)(_d & 0x33333333u), _o = (int)((_d >> 2) & 0x33333333u); const int _n = _w >> 1, _k = 2 * (_w & 1); \
                    _ah = __builtin_amdgcn_sdot8(_e, (int)xh[_n][_k], _ah, false); _ah = __builtin_amdgcn_sdot8(_o, (int)xh[_n][_k + 1], _ah, false); \
                    _al = __builtin_amdgcn_sdot8(_e, (int)xl[_n][_k], _al, false); _al = __builtin_amdgcn_sdot8(_o, (int)xl[_n][_k + 1], _al, false); } \
                else { _ah = __builtin_amdgcn_sdot8((int)_d, (int)xh[0][_w], _ah, false); _al = __builtin_amdgcn_sdot8((int)_d, (int)xl[0][_w], _al, false); } } \
            _p[_i] = LO ? (float)(16 * _ah + _al) : (float)(64 * _ah + 4 * _al); } \
        float _q4[4], _q2[2]; \
        _Pragma("unroll") for (int _k = 0; _k < 4; ++_k) _q4[_k] = tr_x4(_p[_k], _p[_k + 4], b2); \
        _Pragma("unroll") for (int _k = 0; _k < 2; ++_k) _q2[_k] = tr_x2(_q4[_k], _q4[_k + 2], b1); \
        const float _r1 = tr_x1(_q2[0], _q2[1], b0); \
        if ((tk) < t_hi) { bf16_t* _pb = PDOT + ((size_t)V_SL(tk) * T + V_TOK(tk)) * 128 + 8 * (h); *(bf16_t*)((char*)_pb + poff) = f2bf(_r1); } } while (0)
#define CL(v) ((v) < t_hi ? (v) : t_hi - 1)
    int t0 = tk_first;
    LD_E8(I0, t0, 0); LD_E8(I1, t0, 1); LD_E8(I2, t0 + tk_step, 0); MEM_FENCE();
    LD_X(xh0, xl0, t0); MEM_FENCE(); LD_R8(rowsA, I0, V_TB(CL(t0))); MEM_FENCE(); LD_R8(rowsB, I1, V_TB(CL(t0))); MEM_FENCE();
#pragma unroll 1
    for (; t0 < t_hi; t0 += 3 * tk_step) {
        const int t1 = t0 + tk_step, t2 = t1 + tk_step, t3 = t2 + tk_step;
        LD_E8(I0, t1, 1);           LD_R8(rowsC, I2, V_TB(CL(t1))); LD_X(xh1, xl1, t1); U_COMPUTE8(rowsA, xh0, xl0, t0, 0);
        LD_E8(I1, t2, 0);           LD_R8(rowsA, I0, V_TB(CL(t1)));                     U_COMPUTE8(rowsB, xh0, xl0, t0, 1);
        LD_E8(I2, t2, 1);           LD_R8(rowsB, I1, V_TB(CL(t2))); LD_X(xh2, xl2, t2); U_COMPUTE8(rowsC, xh1, xl1, t1, 0);
        LD_E8(I0, t3, 0);           LD_R8(rowsC, I2, V_TB(CL(t2)));                     U_COMPUTE8(rowsA, xh1, xl1, t1, 1);
        LD_E8(I1, t3, 1);           LD_R8(rowsA, I0, V_TB(CL(t3))); LD_X(xh0, xl0, t3); U_COMPUTE8(rowsB, xh2, xl2, t2, 0);
        LD_E8(I2, t3 + tk_step, 0); LD_R8(rowsB, I1, V_TB(CL(t3)));                     U_COMPUTE8(rowsC, xh2, xl2, t2, 1);
    }
#undef U_COMPUTE8
#undef LD_X
#undef V_XS
#undef V_TB
#undef V_TOK
#undef V_SL
#undef CL
}
DI unsigned short f16_bits(float v) { const _Float16 h = (_Float16)v; return __builtin_bit_cast(unsigned short, h); }
DI float erf_as(float x) {
    const float ax = fabsf(x), t = __builtin_amdgcn_rcpf(1.f + 0.3275911f * ax);
    const float poly = t * (0.254829592f + t * (-0.284496736f + t * (1.421413741f + t * (-1.453152027f + t * 1.061405429f))));
    const float r = 1.f - poly * __expf(-ax * ax);
    return copysignf(r, x);
}
template <int NT> DI void peer_cj_tokens(int tok0, int tstride, const int* EIDXg, const float* GATEg, const bf16_t* PDOT, const float* usc, const float* vsc, const float* XSg, unsigned short* CJg, float* CMAXg, int lane) {
    unsigned ew[NT]; float d[NT][2]; f32x2 g[NT];
#pragma unroll
    for (int i = 0; i < NT; ++i) { const int tok = tok0 + i * tstride, tc = tok < T ? tok : T - 1;
        ew[i] = ((const unsigned*)EIDXg)[(size_t)tc * 64 + lane]; g[i] = ((const f32x2*)GATEg)[(size_t)tc * 64 + lane];
        float a0 = 0.f, a1 = 0.f;
#pragma unroll
        for (int x = 0; x < 6; ++x) { const unsigned pw = ((const unsigned*)PDOT)[((size_t)x * T + tc) * 64 + lane]; a0 += __builtin_bit_cast(float, pw << 16); a1 += __builtin_bit_cast(float, pw & 0xffff0000u); }
        const float xs = XSg[tc];
        d[i][0] = a0 * xs; d[i][1] = a1 * xs; }
    float us[NT][2], vs[NT][2];
#pragma unroll
    for (int i = 0; i < NT; ++i) { const unsigned e0 = ew[i] & 0xffffu, e1 = ew[i] >> 16; us[i][0] = usc[e0]; us[i][1] = usc[e1]; vs[i][0] = vsc[e0]; vs[i][1] = vsc[e1]; }
#pragma unroll
    for (int i = 0; i < NT; ++i) { const int tok = tok0 + i * tstride;
        float cv[2], cm = 0.f;
#pragma unroll
        for (int hh = 0; hh < 2; ++hh) {
            const float hraw = d[i][hh] * us[i][hh];
            const float hid = 0.5f * hraw * (1.f + erf_as(hraw * 0.70710678118654752f));
            cv[hh] = hid * g[i][hh] * vs[i][hh];
            cm = fmaxf(cm, fabsf(cv[hh]));
        }
        cm = wave_max(cm);
        const float inv = cm > 0.f ? 0.9999f * __builtin_amdgcn_rcpf(cm) : 0.f;
        if (tok < T) { ((unsigned*)CJg)[(size_t)tok * 64 + lane] = (unsigned)f16_bits(cv[0] * inv) | ((unsigned)f16_bits(cv[1] * inv) << 16); if (lane == 0) CMAXg[tok] = cm; }
    }
}
DI void peer_v_slice(int sl, int tk_first, int tk_step, const bf16_t* H1b, const int* EIDXg, const unsigned short* CJg, const float* CMAXg, const unsigned char* V8s, bf16_t* A4g, float* SSQg, int lane) {
    const int es = lane >> 3, c = lane & 7;
    constexpr int t_hi = T;
#define V_TOK(v) (v)
    const unsigned char* tb = V8s + (size_t)sl * 16384 * 128;
    const unsigned c16 = 16u * c, eoff = 64u * es, ob = 128u * sl + 16u * c + 2u * es;
    const bool b5 = lane & 32, b4 = lane & 16, b3 = lane & 8;
    u32x4 I0[2], I1[2], I2[2], rowsA[8], rowsB[8], rowsC[8], cA, cB, cC; unsigned h0, h1, h2; float m0, m1, m2;
#define LD_C8(cc, tk, h) do { const int _t = (tk) < T ? (tk) : T - 1; const unsigned short* _cb = CJg + (size_t)_t * 128 + 8 * (h); cc = ldu<u32x4>(_cb, eoff >> 1); } while (0)
#define V_AXPY8(rows, cc, FIRST) do { _Pragma("unroll") for (int _q = 0; _q < 2; ++_q) _Pragma("unroll") for (int _r = 0; _r < 4; ++_r) { const unsigned _cw = cc[2 * _q + (_r >> 1)]; const unsigned _cu = __builtin_amdgcn_perm(_cw, _cw, (_r & 1) ? 0x03020302u : 0x01000100u); const h2_t _c2 = __builtin_bit_cast(h2_t, _cu); \
            _Pragma("unroll") for (int _w = 0; _w < 4; ++_w) { \
                if ((FIRST) && _q == 0 && _r == 0) { acch[2 * _w] = __builtin_amdgcn_cvt_scalef32_pk_f16_fp8(rows[0][_w], 1.0f, false) * _c2; acch[2 * _w + 1] = __builtin_amdgcn_cvt_scalef32_pk_f16_fp8(rows[0][_w], 1.0f, true) * _c2; } \
                else { acch[2 * _w] = __builtin_amdgcn_cvt_scalef32_pk_f16_fp8(rows[4 * _q + _r][_w], 1.0f, false) * _c2 + acch[2 * _w]; \
                       acch[2 * _w + 1] = __builtin_amdgcn_cvt_scalef32_pk_f16_fp8(rows[4 * _q + _r][_w], 1.0f, true) * _c2 + acch[2 * _w + 1]; } } \
              \
            if (4 * _q + _r < 7) asm volatile("" : "+v"(acch[0]), "+v"(acch[1]), "+v"(acch[2]), "+v"(acch[3]), "+v"(acch[4]), "+v"(acch[5]), "+v"(acch[6]), "+v"(acch[7]), "+v"(rows[(4 * _q + _r + 1) & 7])); \
            else asm volatile("" : "+v"(acch[0]), "+v"(acch[1]), "+v"(acch[2]), "+v"(acch[3]), "+v"(acch[4]), "+v"(acch[5]), "+v"(acch[6]), "+v"(acch[7])); } } while (0)
#define LD_H(hh, cm, tk) do { const int _t = (tk) < T ? (tk) : T - 1; hh = ldu<unsigned>(H1b + (size_t)_t * 1024, ob * 2u); cm = CMAXg[_t]; } while (0)
#define V_FINAL(hh, cm, tk) do { \
        const float _cm = cm; \
          \
        h2_t _q8[4], _q4[2]; \
        _Pragma("unroll") for (int _k = 0; _k < 4; ++_k) _q8[_k] = trp_x32(acch[_k], acch[_k + 4]); \
        _Pragma("unroll") for (int _k = 0; _k < 2; ++_k) _q4[_k] = trp_x16(_q8[_k], _q8[_k + 2]); \
        const h2_t _q2p = trp_x8(_q4[0], _q4[1], b3); \
        const float _q2[2] = {(float)_q2p.x, (float)_q2p.y}; \
        const float _ha = __builtin_bit_cast(float, hh << 16) + _q2[0] * _cm, _hb = __builtin_bit_cast(float, hh & 0xffff0000u) + _q2[1] * _cm; const float _ssq = wave_sum(_ha * _ha + _hb * _hb); \
        if ((tk) < T) { *(unsigned*)((char*)(A4g + (size_t)(tk) * 1024) + ob * 2u) = cvtpk(_ha, _hb); \
            if (lane == 0) SSQg[(size_t)sl * T + (tk)] = _ssq; } } while (0)
    h2_t acch[8];
    int t0 = tk_first;
    LD_E8(I0, t0, 0); LD_E8(I1, t0, 1); LD_E8(I2, t0 + tk_step, 0); MEM_FENCE();
    LD_H(h0, m0, t0); MEM_FENCE(); LD_R8(rowsA, I0, tb); LD_C8(cA, t0, 0); MEM_FENCE(); LD_R8(rowsB, I1, tb); LD_C8(cB, t0, 1); MEM_FENCE();
#pragma unroll 1
    for (; t0 < T; t0 += 3 * tk_step) {
        const int t1 = t0 + tk_step, t2 = t1 + tk_step, t3 = t2 + tk_step;
        LD_E8(I0, t1, 1);           LD_R8(rowsC, I2, tb); LD_C8(cC, t1, 0); LD_H(h1, m1, t1); V_AXPY8(rowsA, cA, true);
        LD_E8(I1, t2, 0);           LD_R8(rowsA, I0, tb); LD_C8(cA, t1, 1);                          V_AXPY8(rowsB, cB, false); V_FINAL(h0, m0, t0);
        LD_E8(I2, t2, 1);           LD_R8(rowsB, I1, tb); LD_C8(cB, t2, 0); LD_H(h2, m2, t2); V_AXPY8(rowsC, cC, true);
        LD_E8(I0, t3, 0);           LD_R8(rowsC, I2, tb); LD_C8(cC, t2, 1);                          V_AXPY8(rowsA, cA, false); V_FINAL(h1, m1, t1);
        LD_E8(I1, t3, 1);           LD_R8(rowsA, I0, tb); LD_C8(cA, t3, 0); LD_H(h0, m0, t3); V_AXPY8(rowsB, cB, true);
        LD_E8(I2, t3 + tk_step, 0); LD_R8(rowsB, I1, tb); LD_C8(cB, t3, 1);                          V_AXPY8(rowsC, cC, false); V_FINAL(h2, m2, t2);
    }
#undef V_FINAL
#undef LD_H
#undef V_AXPY8
#undef LD_C8
#undef LD_R8
#undef LD_E8
#undef V_TOK
}

typedef const __attribute__((address_space(4))) unsigned long long* karg_ptr_t;
DI karg_ptr_t kargs() { karg_ptr_t p = (karg_ptr_t)__builtin_amdgcn_kernarg_segment_ptr(); asm volatile("" : "+s"(p)); return p; }
#define GAS1 __attribute__((address_space(1)))
#define KIN(k) ((const float*)(const GAS1 float*)kargs()[k])
#define KOUT() ((float*)(GAS1 float*)kargs()[18])
#define KWS() ((unsigned char*)(GAS1 unsigned char*)kargs()[19])

__global__ void __launch_bounds__(512, 2) fwd_kernel(Params P) {
    extern __shared__ __attribute__((aligned(16))) unsigned char lds_raw[];
    LAS unsigned char* lds = (LAS unsigned char*)lds_raw;
    const int tid = threadIdx.x, lane = tid & 63, wid = __builtin_amdgcn_readfirstlane(tid >> 6);
    const int wg = blockIdx.x, nwg = gridDim.x;
    const int gwave = wg * 8 + wid, nwaves = nwg * 8;
    const int lo = P.ph_lo, hi = P.ph_hi;

    volatile LAS unsigned* misc = (volatile LAS unsigned*)(lds + LDS_BYTES - 64);
    if (tid < 16) misc[tid] = 0u;
    __syncthreads();
    { unsigned* xcw = (unsigned*)(KWS() + WS_CTL) + CW_XC;
      if (tid == 0) { const unsigned xcc = xb_xcc_id(); misc[5] = xcc; misc[4] = xb_add(xcw + 64 * xcc, 1u); } }
    XcdBarrier bar; bar.bar = (unsigned*)(KWS() + WS_CTL) + CW_BAR; bar.x = 0; bar.st = misc;
    if (hi - lo > 1) bar = xcd_barrier_post((unsigned*)(KWS() + WS_CTL) + CW_BAR, misc);

#define kmean   ((float*)(KWS() + WS_KMEAN))
#define biasTab ((float*)(KWS() + WS_BIAS))
#define WinT    ((bf16_t*)(KWS() + WS_WIN))
#define WoutT   ((bf16_t*)(KWS() + WS_WOUT))
#define WqT     ((bf16_t*)(KWS() + WS_WQ))
#define WgT     ((bf16_t*)(KWS() + WS_WG))
#define WpleT   ((bf16_t*)(KWS() + WS_WPLE))
#define U8      ((unsigned char*)(KWS() + WS_U))
#define V8      ((unsigned char*)(KWS() + WS_V))
#define USC     ((float*)(KWS() + WS_USC))
#define VSC     ((float*)(KWS() + WS_VSC))
#define XN      ((bf16_t*)(KWS() + WS_XN))
#define RSX     ((float*)(KWS() + WS_RSX))
#define PB      ((bf16_t*)(KWS() + WS_PB))
#define Qm      ((bf16_t*)(KWS() + WS_QM))
#define Km      ((bf16_t*)(KWS() + WS_KM))
#define VtM     ((bf16_t*)(KWS() + WS_VTM))
#define Qs      ((bf16_t*)(KWS() + WS_QS))
#define Ks      ((bf16_t*)(KWS() + WS_KS))
#define VtS     ((bf16_t*)(KWS() + WS_VTS))
#define Oraw    ((bf16_t*)(KWS() + WS_ORAW))
#define A2      ((bf16_t*)(KWS() + WS_A2))
#define A3      ((bf16_t*)(KWS() + WS_A3))
#define SC      ((float*)(KWS() + WS_SC))
#define EIDXG   ((int*)(KWS() + WS_EIDX))
#define GATEG   ((float*)(KWS() + WS_GATE))
#define CJG     ((float*)(KWS() + WS_CJ))
#define RS2G    ((float*)(KWS() + WS_RS2))
#define SSQG    ((float*)(KWS() + WS_SSQ))
#define PDOTG   ((bf16_t*)(KWS() + WS_PDOT))
#define A4G     ((bf16_t*)(KWS() + WS_A4))
#define XN2G    ((unsigned char*)(KWS() + WS_XN2))
#define XSG     ((float*)(KWS() + WS_XS))

#define IN(k) (lo <= (k) && (k) < hi)
#ifndef PROBE_PHASE
#define PROBE_PHASE -1
#endif
#ifndef PROBE_REPS
#define PROBE_REPS 1
#endif
#define REP(k) for (int _rep = 0; _rep < ((k) == PROBE_PHASE ? PROBE_REPS : 1); ++_rep)
#define SEAM(k) do { if (IN(k) && IN((k) + 1)) { if ((k) == 0 || PROBE_LO_NONZERO) xcd_barrier<true>(bar); else xcd_barrier<false>(bar); } } while (0)
#define PROBE_LO_NONZERO 0

    if (IN(0)) REP(0) {
        {
            LAS float* scr = (LAS float*)lds + wid * (64 * 65);
            const float* win = KIN(IN_WIN); const float* wout = KIN(IN_WOUT); const float* wpg = KIN(IN_WPG); const float* wple = KIN(IN_WPLE); const float* pln = KIN(IN_PLE_NORM); const float* atn = KIN(IN_ATTN_NORM);
            bf16_t* wint = WinT; bf16_t* woutt = WoutT; bf16_t* wgt = WgT; bf16_t* wplet = WpleT;
            for (int t = gwave; t < 1344; t += nwaves) {
                const int sel = t < 768 ? 0 : t < 1024 ? 1 : t < 1280 ? 2 : 3;
                const int tt = sel == 0 ? t : sel == 1 ? t - 768 : sel == 2 ? t - 1024 : t - 1280;
                const float* W = sel == 0 ? win : sel == 1 ? wout : sel == 2 ? wpg : wple;
                bf16_t* Wt = sel == 0 ? wint : sel == 1 ? woutt : sel == 2 ? wgt : wplet;
                const int K = sel == 3 ? 256 : 1024, N = sel == 0 ? 3072 : 1024, tn = sel == 0 ? 48 : 16;
                p0_transpose_wave(W, K, N, Wt, scr, lane, (tt / tn) * 64, (tt % tn) * 64, sel == 0, sel == 2 ? pln : sel == 0 ? atn : nullptr);
            }
        }
        p0_fold(KIN(IN_PQ), KIN(IN_SUBK), KIN(IN_FFN_NORM), WqT, wid, lane, wg, nwg);
        const size_t gtid = (size_t)wg * 512 + tid, nthr = (size_t)nwg * 512;
        p0_convert(KIN(IN_P), PB, (size_t)T * 256, gtid, nthr);
        { const float* xp = KIN(IN_X); float* gp = RSX; bf16_t* xo = XN;
          if (nwaves == 2048) {
              const int p0 = gwave < 1344 ? 3 * gwave : 4032 + 6 * (gwave - 1344), np = gwave < 1344 ? 3 : 6;
              for (int i = 0; i < np; ++i) { const int pr = p0 + i; if (pr < T / 2) rmsnorm_rows2_bf16(xp, gp, xo, pr, pr + T / 2, lane); }
          } else {
              for (int row = gwave; row < T; row += 2 * nwaves) rmsnorm_rows2_bf16(xp, gp, xo, row, row + nwaves, lane);
          } }
        if (wg == 0) {
            for (int idx = tid; idx < 8 * 129; idx += 512) {
                const int h = idx / 129, dist = idx % 129;
                int bk;
                if (dist < 16) bk = dist;
                else { const float v = logf((float)dist / 16.f) / 2.0794415416798357f * 16.f; bk = 16 + (int)v; bk = bk > 31 ? 31 : bk; }
                biasTab[h * 132 + dist] = KIN(IN_RELB)[bk * 8 + h] * LOG2E;
            }
        }
    }
    SEAM(0);
    if (IN(1)) REP(1) {
        pg8::Gemm g{XN, WinT, T, NPROJ, 1024}; pg8::StaticOrder S; S.init(T, NPROJ, nwg, wg);
        EpiQKV E{Qm, KIN(IN_QNORM), KIN(IN_KNORM), kmean, RSX};
        pg8::gemm_phase<EpiQKV, pg8::StaticOrder, true, true>(lds, g, S, E);
    }
    SEAM(1);
    if (IN(3)) REP(3) {
        const bf16_t* qm_ = Qm; const bf16_t* km_ = Km; const bf16_t* vtm_ = VtM; const bf16_t* qs_ = Qs; const bf16_t* ks_ = Ks; const bf16_t* vts_ = VtS;
        const float* kmn_ = kmean; const float* bt_ = biasTab; bf16_t* a2_ = A2;
        const float* gm_ = KIN(IN_ONM); const float* gs_ = KIN(IN_ONS);
        LAS unsigned char* ot = lds;
        LAS float* biasLds = (LAS float*)(lds + 34816);
        for (int i = tid; i < 8 * 132; i += 512) biasLds[i] = bt_[i];
        __syncthreads();
        bf16x8 ukf[4], uvf[4], uqf[4];
        unit_issue(ukf, uvf, uqf, gwave, qm_, km_, vtm_, qs_, ks_, vts_, lane);
        for (int u = gwave; u < 8192; u += nwaves) {
            const int grp = u >> 12, i = u & 4095;
            const int half = i >> 11, j = i & 2047;
            const int qt = half ? (j >> 6) : 63 - (j >> 6), bh = j & 63;
            const int b = bh >> 3, h = bh & 7;
            if (grp == 0) moba_unit(ukf, uvf, uqf, b, h, qt, km_, vtm_, kmn_, biasLds, ot, lane);
            else sb_unit(ukf, uvf, uqf, b, h, qt, ks_, vts_, ot, lane);
            { const int un = u + nwaves < 8192 ? u + nwaves : u; unit_issue(ukf, uvf, uqf, un, qm_, km_, vtm_, qs_, ks_, vts_, lane); }
            __syncthreads();
            {
                const float* gg = grp ? gs_ : gm_;
                const f32x4 g0 = *(const f32x4*)(gg + 8 * lane), g1 = *(const f32x4*)(gg + 8 * lane + 4);
#pragma unroll
                for (int rr = 0; rr < 4; ++rr) {
                    const int row = 4 * wid + rr;
                    const bf16x8 v = *(const LAS bf16x8*)(ot + row * OT_PITCH + lane * 16);
                    float f[8], sq = 0.f;
#pragma unroll
                    for (int e = 0; e < 8; ++e) { f[e] = bf2f(v[e]); sq += f[e] * f[e]; }
                    sq = wave_sum(sq);
                    const float rs = rsqrtf(sq * (1.f / 512.f) + EPS);
                    u32x4 w; w.x = cvtpk(f[0] * rs * g0.x, f[1] * rs * g0.y); w.y = cvtpk(f[2] * rs * g0.z, f[3] * rs * g0.w);
                    w.z = cvtpk(f[4] * rs * g1.x, f[5] * rs * g1.y); w.w = cvtpk(f[6] * rs * g1.z, f[7] * rs * g1.w);
                    *(u32x4*)(a2_ + (size_t)(b * 2048 + qt * 32 + row) * 1024 + grp * 512 + 8 * lane) = w;
                }
            }
            __syncthreads();
        }
    }
    SEAM(3);
    if (IN(5)) REP(5) {
        pg8::Gemm g{A2, WoutT, T, 1024, 1024}; pg8::StaticOrder S; S.init(T, 1024, nwg, wg);
        EpiRes E{XN, A3};
        pg8::gemm_phase<EpiRes, pg8::StaticOrder, true, true>(lds, g, S, E);
    }
    SEAM(5);
    if (IN(6)) REP(6) {
        pg8::Gemm g{A3, WqT, T, 2048, 1024}; pg8::StaticOrder S; S.init(T, 2048, nwg, wg);
        EpiBfT<true> E{(bf16_t*)SC, 2048};
        pg8::gemm_phase<EpiBfT<true>, pg8::StaticOrder, true, true>(lds, g, S, E);
    }
    SEAM(6);
    if (IN(7)) REP(7) {
        LAS float* wl = (LAS float*)(lds + wid * 4096);
        {
            const int c = lane; int ca, cb;
            if (c < 16) { ca = 0; cb = c; } else if (c < 24) { ca = 1; cb = c - 16; } else if (c < 29) { ca = 2; cb = c - 24; } else if (c < 33) { ca = 3; cb = c - 29; }
            else if (c < 36) { ca = 4; cb = c - 33; } else if (c < 42) { ca = 5 + ((c - 36) >> 1); cb = (c - 36) & 1; } else { ca = (c - 34) & 15; cb = 0; }
            ((LAS unsigned*)(wl + 768))[lane] = (unsigned)ca | ((unsigned)cb << 8);
            asm volatile("s_waitcnt lgkmcnt(0)" ::: "memory");
        }
        const bf16_t* h1p = A3; const bf16_t* scp = (const bf16_t*)SC; const float* gfp = KIN(IN_FFN_NORM); int* eip = EIDXG; float* gtp = GATEG; unsigned char* xnp = XN2G;
        TopkIn inA, inB;
        peer_topk_load(inA, gwave, h1p, scp, lane);
        const float* pu = KIN(IN_PU); const float* pv = KIN(IN_PV); unsigned char* u8 = U8; unsigned char* v8 = V8; float* usc_ = USC; float* vsc_ = VSC;
        static_assert(T == 16384, "one expert row per token step");
        f32x4 gq[4];
#pragma unroll
        for (int i = 0; i < 4; ++i) gq[i] = *(const f32x4*)(gfp + 16 * lane + 4 * i);
        unsigned cand[21];
#pragma unroll
        for (int k = 0; k < 7; ++k) { const unsigned tb = ((const LAS unsigned*)(wl + 768))[7 * (lane & 7) + k]; const unsigned ia = tb & 15u, ib = (tb >> 8) & 15u;
            cand[k] = (unsigned)(lane >> 3) * 32u + ia; cand[7 + k] = (unsigned)(lane >> 3) * 32u + 16u + ib; cand[14 + k] = 255u - (16u * ia + ib); }
#pragma unroll 1
        for (int tok = gwave; tok < T; tok += nwaves) {
            f32x4 qa[2][4];
            peer_topk_load(inB, tok + nwaves, h1p, scp, lane);
            p0_quant_issue2(qa, pu, pv, tok, lane); MEM_FENCE();
            peer_topk_token(tok, inA, gq, cand, eip, gtp, xnp, XSG, wl, lane);
            quant_u6_finish(qa[0], u8, usc_, tok, lane); p0_quant_finish(qa[1], v8, vsc_, tok, lane);
            inA = inB;
        }
    }
    SEAM(7);
    int sl_first = 0, sl_step = 1, tk_first = 0, tk_step = 8;
    if (IN(8) || IN(10)) {
        __syncthreads();
        const unsigned myx = misc[5], myrank = misc[4];
        unsigned nx = 0, myidx = 0, nloc = 1;
        unsigned* xc = (unsigned*)(KWS() + WS_CTL) + CW_XC;
#pragma unroll
        for (unsigned j = 0; j < 16; ++j) { const unsigned cj = xb_ld(xc + 64 * j); if (cj > 0u) { if (j < myx) ++myidx; ++nx; } if (j == myx) nloc = cj; }
        sl_first = __builtin_amdgcn_readfirstlane((int)myidx); sl_step = __builtin_amdgcn_readfirstlane((int)(nx > 0u ? nx : 1u));
        tk_first = __builtin_amdgcn_readfirstlane((int)myrank * 8 + wid); tk_step = __builtin_amdgcn_readfirstlane((int)(nloc > 0u ? nloc : 1u) * 8);
    }
    if (IN(8)) REP(8) {
        const unsigned char* xnp = XN2G; const int* eip = EIDXG; const unsigned char* u8p = U8; bf16_t* pdp = PDOTG;
        for (int item = sl_first; item < 24; item += sl_step)
            if (item >= 16) peer_u_slice<true>(item >> 2, (item & 3) * (T / 4), 4, 0, 4096, tk_first, tk_step, xnp, eip, u8p, pdp, lane);
        for (int item = sl_first; item < 16; ) {
            const int nxt = item + sl_step;
            if (nxt < 16) { peer_u_slice<false>(item >> 2, (item & 3) * (T / 4), nxt >> 2, (nxt & 3) * (T / 4), 8192, tk_first, tk_step, xnp, eip, u8p, pdp, lane); item = nxt + sl_step; }
            else          { peer_u_slice<false>(item >> 2, (item & 3) * (T / 4), 0, 0, 4096, tk_first, tk_step, xnp, eip, u8p, pdp, lane); item = nxt; }
        }
    }
    SEAM(8);
    if (IN(9)) REP(9) {
        const int* eip = EIDXG; const float* gtp = GATEG; const bf16_t* pdp = PDOTG; const float* usp = USC; const float* vsp = VSC; unsigned short* cjp = (unsigned short*)CJG; float* cmp_ = RS2G;
        for (int tok = gwave * 8; tok < T; tok += 8 * nwaves) peer_cj_tokens<8>(tok, 1, eip, gtp, pdp, usp, vsp, XSG, cjp, cmp_, lane);
    }
    SEAM(9);
    if (IN(10)) REP(10) {
        const bf16_t* outp = A3; const int* eip = EIDXG; const unsigned short* cjp = (const unsigned short*)CJG; const float* cmp_ = RS2G; const unsigned char* v8p = V8; bf16_t* a4p = A4G; float* sqp = SSQG;
        for (int sl = sl_first; sl < 8; sl += sl_step) peer_v_slice(sl, tk_first, tk_step, outp, eip, cjp, cmp_, v8p, a4p, sqp, lane);
    }
    SEAM(10);
    if (IN(11)) REP(11) {
        bf16_t* PW = Oraw;
        { int kple = 256; asm volatile("" : "+s"(kple));
          pg8::Gemm g{PB, WpleT, T, 1024, kple}; pg8::StaticOrder S; S.init(T, 1024, nwg, wg);
          EpiBfT<false> E{PW, 1024};
          pg8::gemm_phase<EpiBfT<false>, pg8::StaticOrder, true, true>(lds, g, S, E); }
        asm volatile("s_waitcnt vmcnt(0)" ::: "memory");
        __syncthreads();
        { pg8::Gemm g{A4G, WgT, T, 1024, 1024}; pg8::StaticOrder S; S.init(T, 1024, nwg, wg);
          EpiGate E{KOUT(), PW, SSQG, A4G};
          pg8::gemm_phase<EpiGate, pg8::StaticOrder, true, true>(lds, g, S, E); }
    }
#undef IN
#undef SEAM
}

extern "C" void kernel_launch(void* const* d_in, const int* in_sizes, int n_in, void* d_out, int out_size, void* d_ws, size_t ws_size, hipStream_t stream) {
    static int grid = 0;
    if (grid == 0) {
        if (n_in != 18 || out_size != T * DM || ws_size < WS_END) { fprintf(stderr, "kernel_launch: unexpected shapes (n_in %d out %d ws %zu)\n", n_in, out_size, ws_size); grid = -1; return; }
        int dev = 0, cus = 0, per_cu = 0;
        if (hipGetDevice(&dev) != hipSuccess || hipDeviceGetAttribute(&cus, hipDeviceAttributeMultiprocessorCount, dev) != hipSuccess) { grid = -1; return; }
        if (hipFuncSetAttribute((const void*)fwd_kernel, hipFuncAttributeMaxDynamicSharedMemorySize, LDS_BYTES) != hipSuccess) { fprintf(stderr, "kernel_launch: hipFuncSetAttribute failed\n"); grid = -1; return; }
        if (hipOccupancyMaxActiveBlocksPerMultiprocessor(&per_cu, (const void*)fwd_kernel, 512, LDS_BYTES) != hipSuccess || per_cu < 1)
            fprintf(stderr, "kernel_launch: note: occupancy query reports %d\n", per_cu);
        (void)hipGetLastError();
        grid = cus - (cus % 8);
    }
    if (grid < 0) return;
    if (hipMemsetAsync((char*)d_ws + WS_CTL, 0, CTL_ZERO_BYTES, stream) != hipSuccess) return;
    Params p{};
    for (int i = 0; i < 18; ++i) p.in[i] = (const float*)d_in[i];
    p.out = (float*)d_out; p.ws = (unsigned char*)d_ws;
    p.ph_lo = 0; p.ph_hi = NPHASE;
    hipLaunchKernelGGL(fwd_kernel, dim3(grid), dim3(512), LDS_BYTES, stream, p);
}
```
